# Optimizing an MI355X kernel written in HIP

```python
import math
import jax, jax.numpy as jnp
from jax import lax
import numpy as np

D_MODEL = 1024
BATCH = 4
SEQ = 4096
DEPTH = 1

MEM_LEN = 256
DSA_HEADS = 8
DSA_HEAD_DIM = 64
DSA_WIDTH = DSA_HEADS * DSA_HEAD_DIM
DSA_Q_RANK = 256
DSA_KV_RANK = 128
IDX_HEADS = 8
IDX_DIM = 32
INDEX_TOPK_MAX = 256
QBLOCK = 128
NUM_BUCKETS = 32
MAX_DISTANCE = 128
RWKV_HEADS = 8
RWKV_HEAD_DIM = 64
RWKV_WIDTH = RWKV_HEADS * RWKV_HEAD_DIM
DECAY_RANK = 64
AAA_RANK = 64
GATE_RANK = 128
RWKV_COLS = 3 * RWKV_WIDTH + DECAY_RANK + AAA_RANK + GATE_RANK
GN_EPS = 64e-5
MEM_HEADS = 4
MEM_HEAD_DIM = 128
MEM_WIDTH = MEM_HEADS * MEM_HEAD_DIM
N_BRANCHES = 3
IN_COLS = (DSA_Q_RANK, DSA_KV_RANK, IDX_DIM, IDX_HEADS, RWKV_COLS, MEM_WIDTH, N_BRANCHES * D_MODEL)
IN_WIDTH = DSA_Q_RANK + DSA_KV_RANK + IDX_DIM + IDX_HEADS + RWKV_COLS + MEM_WIDTH + N_BRANCHES * D_MODEL
PEER_HEADS = 8
PEER_N_KEYS = 128
PEER_N_EXPERTS = PEER_N_KEYS * PEER_N_KEYS
PEER_QUERY_DIM = 256
PEER_HALF = PEER_QUERY_DIM // 2
PEER_TOPK = 16
PEER_BLOCK = 128
DEEPNORM_ALPHA = (2 * DEPTH) ** 0.25
DEEPNORM_BETA = (8 * DEPTH) ** -0.25
LN_EPS = 1e-5
RMS_EPS = 1e-6

kernel_name = "hybrid_dsa_rwkv7_mem_peer_deepnorm"


def split_cols(a, widths):
    offsets = np.cumsum(np.array(widths))[:-1].tolist()
    return jnp.split(a, offsets, axis=-1)


def layernorm(x, g, b):
    xf = x.astype(jnp.float32)
    mu = xf.mean(-1, keepdims=True)
    var = jnp.square(xf - mu).mean(-1, keepdims=True)
    return ((xf - mu) * lax.rsqrt(var + LN_EPS) * g + b).astype(x.dtype)


def rmsnorm(x, g):
    xf = x.astype(jnp.float32)
    return (xf * lax.rsqrt(jnp.square(xf).mean(-1, keepdims=True) + RMS_EPS) * g).astype(x.dtype)


def t5_bucket(dist):
    n = jnp.maximum(dist, 0)
    max_exact = NUM_BUCKETS // 2
    nf = jnp.maximum(n, 1).astype(jnp.float32)
    large = max_exact + (jnp.log(nf / max_exact) / math.log(MAX_DISTANCE / max_exact)
                         * (NUM_BUCKETS - max_exact)).astype(jnp.int32)
    large = jnp.minimum(large, NUM_BUCKETS - 1)
    return jnp.where(n < max_exact, n, large)


def dsa_sparse_attention(c_q, c_kv, k_idx, w_idx, q_norm_g, kv_norm_g, w_uq, w_uk, w_uv, w_idx_q, rel_bias):
    B, S, _ = c_q.shape
    f32 = jnp.float32
    topk = min(INDEX_TOPK_MAX, S // 4)
    nblk = S // QBLOCK
    c_q = rmsnorm(c_q, q_norm_g)
    c_kv = rmsnorm(c_kv, kv_norm_g)
    q = (c_q @ w_uq).reshape(B, S, DSA_HEADS, DSA_HEAD_DIM)
    q_lat = jnp.einsum("bshd,chd->bshc", q, w_uk) * (DSA_HEAD_DIM ** -0.5)
    q_idx = (c_q @ w_idx_q).reshape(B, S, IDX_HEADS, IDX_DIM)
    w_idx = w_idx * (IDX_HEADS ** -0.5 * IDX_DIM ** -0.5)
    key_pos = jnp.arange(S)

    def to_blocks(a):
        return jnp.moveaxis(a.reshape((B, nblk, QBLOCK) + a.shape[2:]), 1, 0)

    def block_fn(args):
        blk, qi, wi, ql = args
        q_pos = blk * QBLOCK + jnp.arange(QBLOCK)
        logits = jnp.einsum("bqhd,bsd->bqhs", qi, k_idx)
        score = jnp.einsum("bqh,bqhs->bqs", wi, jax.nn.relu(logits)).astype(f32)
        causal = key_pos[None, :] <= q_pos[:, None]
        score = jnp.where(causal[None], score, -jnp.inf)
        _, idx = lax.top_k(score, topk)
        valid = idx <= q_pos[None, :, None]
        kv_sel = jax.vmap(lambda c, i: c[i])(c_kv, idx)
        att = jnp.einsum("bqhc,bqkc->bqhk", ql, kv_sel).astype(f32)
        bias = jnp.moveaxis(rel_bias[t5_bucket(q_pos[None, :, None] - idx)], -1, 2).astype(f32)
        att = jnp.where(valid[:, :, None, :], att + bias, -jnp.inf)
        p = jax.nn.softmax(att, axis=-1).astype(kv_sel.dtype)
        o_lat = jnp.einsum("bqhk,bqkc->bqhc", p, kv_sel)
        return jnp.einsum("bqhc,chd->bqhd", o_lat, w_uv)

    out = lax.map(block_fn, (jnp.arange(nblk), to_blocks(q_idx), to_blocks(w_idx), to_blocks(q_lat)))
    return jnp.moveaxis(out, 0, 1).reshape(B, S, DSA_WIDTH)


def rwkv7_scan(r, decay, k, v, kk, a):
    B, S, H, N = r.shape

    def step(state, inp):
        r_t, w_t, k_t, v_t, kk_t, a_t = inp
        sa = jnp.einsum("bhvk,bhk->bhv", state, -kk_t)
        state = (state * w_t[:, :, None, :]
                 + sa[..., None] * (kk_t * a_t)[:, :, None, :]
                 + v_t[..., None] * k_t[:, :, None, :])
        return state, jnp.einsum("bhvk,bhk->bhv", state, r_t)

    seqs = (jnp.moveaxis(r, 1, 0), jnp.moveaxis(decay, 1, 0), jnp.moveaxis(k, 1, 0),
            jnp.moveaxis(v, 1, 0), jnp.moveaxis(kk, 1, 0), jnp.moveaxis(a, 1, 0))
    _, ys = lax.scan(step, jnp.zeros((B, H, N, N), jnp.float32), seqs)
    return jnp.moveaxis(ys, 0, 1)


def rwkv7_time_mix(cols, mu, w0, w2, a0, a2, g2, k_k, k_a, r_k, lnx_g, lnx_b):
    B, S, _ = cols.shape
    f32 = jnp.float32
    prev = jnp.pad(cols, ((0, 0), (1, 0), (0, 0)))[:, :-1]
    cols = cols + (prev - cols) * mu
    r, k, v, wl, al, gl = split_cols(cols, (RWKV_WIDTH, RWKV_WIDTH, RWKV_WIDTH, DECAY_RANK, AAA_RANK, GATE_RANK))
    w = -jax.nn.softplus(-(w0 + jnp.tanh(wl) @ w2)) - 0.5
    decay = jnp.exp(-jnp.exp(w.astype(f32)))
    a = jax.nn.sigmoid(a0 + al @ a2)
    g = jax.nn.sigmoid(gl) @ g2

    def heads(t):
        return t.reshape(B, S, RWKV_HEADS, RWKV_HEAD_DIM)

    kk = heads(k * k_k).astype(f32)
    kk = kk / jnp.maximum(jnp.sqrt(jnp.sum(jnp.square(kk), -1, keepdims=True)), 1e-12)
    k = k * (1 + (a - 1) * k_a)
    r_h, k_h, v_h = heads(r), heads(k), heads(v)
    y = rwkv7_scan(r_h.astype(f32), heads(decay), k_h.astype(f32), v_h.astype(f32), kk, heads(a).astype(f32))
    mu_y = y.mean(-1, keepdims=True)
    var_y = jnp.square(y - mu_y).mean(-1, keepdims=True)
    yn = ((y - mu_y) * lax.rsqrt(var_y + GN_EPS)).reshape(B, S, RWKV_WIDTH) * lnx_g + lnx_b
    bonus = (jnp.sum((r_h * k_h * r_k).astype(f32), -1, keepdims=True) * v_h.astype(f32)).reshape(B, S, RWKV_WIDTH)
    return ((yn + bonus) * g).astype(cols.dtype)


def memory_cross_attention(q_cols, mem, w_mem_kv):
    B, S, _ = q_cols.shape
    M = mem.shape[1]
    q = q_cols.reshape(B, S, MEM_HEADS, MEM_HEAD_DIM)
    k, v = split_cols(mem @ w_mem_kv, (MEM_WIDTH, MEM_WIDTH))
    k = k.reshape(B, M, MEM_HEADS, MEM_HEAD_DIM)
    v = v.reshape(B, M, MEM_HEADS, MEM_HEAD_DIM)
    logits = jnp.einsum("bshd,bmhd->bhsm", q, k).astype(jnp.float32) * (MEM_HEAD_DIM ** -0.5)
    p = jax.nn.softmax(logits, axis=-1).astype(v.dtype)
    return jnp.einsum("bhsm,bmhd->bshd", p, v).reshape(B, S, MEM_WIDTH)


def peer_ffn(h, w_peer_q, peer_keys, peer_u, peer_v):
    B, S, D = h.shape
    q = (h @ w_peer_q).reshape(B, S, PEER_HEADS, 2, PEER_HALF)
    sub = jnp.einsum("bshpd,pnd->bshpn", q, peer_keys).astype(jnp.float32)
    s1, i1 = lax.top_k(sub[..., 0, :], PEER_TOPK)
    s2, i2 = lax.top_k(sub[..., 1, :], PEER_TOPK)
    cand_s = (s1[..., :, None] + s2[..., None, :]).reshape(B, S, PEER_HEADS, PEER_TOPK * PEER_TOPK)
    cand_i = (i1[..., :, None] * PEER_N_KEYS + i2[..., None, :]).reshape(B, S, PEER_HEADS, PEER_TOPK * PEER_TOPK)
    top_s, pos = lax.top_k(cand_s, PEER_TOPK)
    experts = jnp.take_along_axis(cand_i, pos, axis=-1)
    gates = jax.nn.softmax(top_s, axis=-1).astype(h.dtype)
    nb = (B * S) // PEER_BLOCK
    hk = PEER_HEADS * PEER_TOPK

    def block_fn(args):
        ht, et, gt = args
        act = jax.nn.gelu(jnp.einsum("td,tkd->tk", ht, peer_u[et]), approximate=False)
        return jnp.einsum("tk,tkd->td", gt * act, peer_v[et])

    y = lax.map(block_fn, (h.reshape(nb, PEER_BLOCK, D), experts.reshape(nb, PEER_BLOCK, hk),
                           gates.reshape(nb, PEER_BLOCK, hk)))
    return y.reshape(B, S, D)


def hybrid_layer(x, mem, rel_bias, w_in, q_norm_g, kv_norm_g, w_uq, w_uk, w_uv, w_idx_q,
                 rwkv_mu, rwkv_w0, rwkv_w2, rwkv_a0, rwkv_a2, rwkv_g2, rwkv_k_k, rwkv_k_a, rwkv_r_k,
                 rwkv_lnx_g, rwkv_lnx_b, w_mem_kv, w_br_dsa, w_br_rwkv, w_br_mem, w_out, ln1_g, ln1_b,
                 w_peer_q, peer_keys, peer_u, peer_v, ln2_g, ln2_b):
    B, S, D = x.shape
    cols = x @ w_in
    c_q, c_kv, k_idx, w_idx, rwkv_cols, mem_q, gate_cols = split_cols(cols, IN_COLS)
    y_dsa = dsa_sparse_attention(c_q, c_kv, k_idx, w_idx, q_norm_g, kv_norm_g, w_uq, w_uk, w_uv, w_idx_q, rel_bias)
    y_rwkv = rwkv7_time_mix(rwkv_cols, rwkv_mu, rwkv_w0, rwkv_w2, rwkv_a0, rwkv_a2, rwkv_g2,
                            rwkv_k_k, rwkv_k_a, rwkv_r_k, rwkv_lnx_g, rwkv_lnx_b)
    y_mem = memory_cross_attention(mem_q, mem, w_mem_kv)
    gates = jax.nn.sigmoid(gate_cols.astype(jnp.float32)).astype(x.dtype).reshape(B, S, N_BRANCHES, D)
    merged = (gates[:, :, 0] * (y_dsa @ w_br_dsa)
              + gates[:, :, 1] * (y_rwkv @ w_br_rwkv)
              + gates[:, :, 2] * (y_mem @ w_br_mem))
    x = layernorm(DEEPNORM_ALPHA * x + merged @ w_out, ln1_g, ln1_b)
    x = layernorm(DEEPNORM_ALPHA * x + peer_ffn(x, w_peer_q, peer_keys, peer_u, peer_v), ln2_g, ln2_b)
    return x


def setup_inputs(seed: int = 0) -> dict:
    key = jax.random.key(seed)
    ks = jax.random.split(key, 48)
    counter = [0]
    f32 = jnp.float32
    L = DEPTH

    def nxt():
        counter[0] += 1
        return ks[counter[0] - 1]

    def nrm(shape, scale):
        return jax.random.normal(nxt(), shape, f32) * scale

    def gain(shape):
        return 1.0 + 0.02 * jax.random.normal(nxt(), shape, f32)

    return {
        "x": nrm((BATCH, SEQ, D_MODEL), 1.0),
        "mem": nrm((BATCH, MEM_LEN, D_MODEL), 1.0),
        "rel_bias": nrm((NUM_BUCKETS, DSA_HEADS), 0.5),
        "w_in": nrm((L, D_MODEL, IN_WIDTH), D_MODEL ** -0.5),
        "q_norm_g": gain((L, DSA_Q_RANK)),
        "kv_norm_g": gain((L, DSA_KV_RANK)),
        "w_uq": nrm((L, DSA_Q_RANK, DSA_WIDTH), DSA_Q_RANK ** -0.5),
        "w_uk": nrm((L, DSA_KV_RANK, DSA_HEADS, DSA_HEAD_DIM), DSA_HEAD_DIM ** -0.5),
        "w_uv": nrm((L, DSA_KV_RANK, DSA_HEADS, DSA_HEAD_DIM), DSA_KV_RANK ** -0.5),
        "w_idx_q": nrm((L, DSA_Q_RANK, IDX_HEADS * IDX_DIM), DSA_Q_RANK ** -0.5),
        "rwkv_mu": jax.random.uniform(nxt(), (L, RWKV_COLS), f32),
        "rwkv_w0": nrm((L, RWKV_WIDTH), 0.5),
        "rwkv_w2": nrm((L, DECAY_RANK, RWKV_WIDTH), 0.1),
        "rwkv_a0": nrm((L, RWKV_WIDTH), 0.1),
        "rwkv_a2": nrm((L, AAA_RANK, RWKV_WIDTH), 0.1),
        "rwkv_g2": nrm((L, GATE_RANK, RWKV_WIDTH), GATE_RANK ** -0.5),
        "rwkv_k_k": 0.85 + nrm((L, RWKV_WIDTH), 0.02),
        "rwkv_k_a": gain((L, RWKV_WIDTH)),
        "rwkv_r_k": nrm((L, RWKV_HEADS, RWKV_HEAD_DIM), 0.1),
        "rwkv_lnx_g": gain((L, RWKV_WIDTH)),
        "rwkv_lnx_b": nrm((L, RWKV_WIDTH), 0.02),
        "w_mem_kv": nrm((L, D_MODEL, 2 * MEM_WIDTH), D_MODEL ** -0.5),
        "w_br_dsa": nrm((L, DSA_WIDTH, D_MODEL), DSA_WIDTH ** -0.5),
        "w_br_rwkv": nrm((L, RWKV_WIDTH, D_MODEL), RWKV_WIDTH ** -0.5),
        "w_br_mem": nrm((L, MEM_WIDTH, D_MODEL), MEM_WIDTH ** -0.5),
        "w_out": nrm((L, D_MODEL, D_MODEL), D_MODEL ** -0.5 * DEEPNORM_BETA),
        "ln1_g": gain((L, D_MODEL)),
        "ln1_b": nrm((L, D_MODEL), 0.02),
        "w_peer_q": nrm((L, D_MODEL, PEER_HEADS * PEER_QUERY_DIM), D_MODEL ** -0.5),
        "peer_keys": nrm((L, 2, PEER_N_KEYS, PEER_HALF), PEER_HALF ** -0.5),
        "peer_u": nrm((L, PEER_N_EXPERTS, D_MODEL), D_MODEL ** -0.5),
        "peer_v": nrm((L, PEER_N_EXPERTS, D_MODEL), PEER_HEADS ** -0.5 * DEEPNORM_BETA),
        "ln2_g": gain((L, D_MODEL)),
        "ln2_b": nrm((L, D_MODEL), 0.02),
    }


def reference(x, mem, rel_bias, w_in, q_norm_g, kv_norm_g, w_uq, w_uk, w_uv, w_idx_q,
              rwkv_mu, rwkv_w0, rwkv_w2, rwkv_a0, rwkv_a2, rwkv_g2, rwkv_k_k, rwkv_k_a, rwkv_r_k,
              rwkv_lnx_g, rwkv_lnx_b, w_mem_kv, w_br_dsa, w_br_rwkv, w_br_mem, w_out, ln1_g, ln1_b,
              w_peer_q, peer_keys, peer_u, peer_v, ln2_g, ln2_b):
    for l in range(DEPTH):
        x = hybrid_layer(x, mem, rel_bias, w_in[l], q_norm_g[l], kv_norm_g[l], w_uq[l], w_uk[l], w_uv[l],
                         w_idx_q[l], rwkv_mu[l], rwkv_w0[l], rwkv_w2[l], rwkv_a0[l], rwkv_a2[l], rwkv_g2[l],
                         rwkv_k_k[l], rwkv_k_a[l], rwkv_r_k[l], rwkv_lnx_g[l], rwkv_lnx_b[l], w_mem_kv[l],
                         w_br_dsa[l], w_br_rwkv[l], w_br_mem[l], w_out[l], ln1_g[l], ln1_b[l],
                         w_peer_q[l], peer_keys[l], peer_u[l], peer_v[l], ln2_g[l], ln2_b[l])
    return x
```

```cpp
#include <hip/hip_runtime.h>
#include <stdint.h>
#include <stdio.h>

#ifndef MK_N_LAUNCHES
#define MK_N_LAUNCHES 1
#endif

#define LAS __attribute__((address_space(3)))
typedef unsigned short bf16_t;
typedef short bf16x8 __attribute__((ext_vector_type(8)));
typedef float f32x4 __attribute__((ext_vector_type(4)));
typedef float f32x2 __attribute__((ext_vector_type(2)));
typedef unsigned u32x4 __attribute__((ext_vector_type(4)));
typedef unsigned u32x2 __attribute__((ext_vector_type(2)));

constexpr int NB = 4, SEQ = 4096, T = NB * SEQ, D = 1024;
constexpr int IN_W = 5800;
constexpr int RW = 512;
constexpr int NWAVES = 8, NTHREADS = 512;
constexpr float ALPHA = 1.189207115002721f;
constexpr int RCH = 32, RL = SEQ / RCH;

constexpr size_t MiB = 1u << 20;
constexpr size_t WS_CTL = 0;
constexpr size_t WS_WIN = 1 * MiB, WS_WG = 7 * MiB, WS_WLORA = 13 * MiB, WS_WQ = 14 * MiB, WS_WMEMKV = 15 * MiB, WS_WOV = 17 * MiB,
                 WS_WBRR = 19 * MiB, WS_WBRM = 20 * MiB, WS_WOUT = 21 * MiB, WS_WPEER = 23 * MiB, WS_KEYS = 27 * MiB;
constexpr size_t WS_CSMALL = 29 * MiB, WS_QLAT = 29 * MiB, WS_MERGEDB = 29 * MiB, WS_UB = 29 * MiB;
constexpr size_t WS_RCOLS = 61 * MiB, WS_QIDX = 61 * MiB, WS_YMEM = 69 * MiB, WS_OLAT = 85 * MiB, WS_VB = 61 * MiB, WS_EXPERTS = 93 * MiB, WS_PGATES = 101 * MiB;
constexpr size_t WS_MEMQ = 117 * MiB, WS_YRWKV = 117 * MiB;
constexpr size_t WS_RW_R = 133 * MiB, WS_RW_K = 149 * MiB, WS_RW_V = 165 * MiB, WS_RW_A = 181 * MiB, WS_RW_E = 197 * MiB, WS_RW_G = 213 * MiB;
constexpr size_t WS_GATES = 133 * MiB, WS_X1B = 133 * MiB, WS_X1 = 165 * MiB;
constexpr size_t WS_CQN = 229 * MiB, WS_KVL = 237 * MiB, WS_KIDX = 241 * MiB, WS_WIDX = 242 * MiB, WS_LORAA = 243 * MiB, WS_IDX = 243 * MiB,
                 WS_KMEM = 251 * MiB, WS_VMEMT = 252 * MiB, WS_MEMB = 253 * MiB, WS_END = 256 * MiB;
constexpr size_t DO_XB = 0, DO_PQ = 32 * MiB;

__device__ __forceinline__ unsigned f2bf(float f) { unsigned u = __float_as_uint(f); return (u + 0x7fffu + ((u >> 16) & 1u)) >> 16; }
__device__ __forceinline__ unsigned pk2(float lo, float hi) { return f2bf(lo) | (f2bf(hi) << 16); }
__device__ __forceinline__ float bflo(unsigned w) { return __uint_as_float(w << 16); }
__device__ __forceinline__ float bfhi(unsigned w) { return __uint_as_float(w & 0xffff0000u); }
__device__ __forceinline__ float bf1(bf16_t h) { return __uint_as_float(((unsigned)h) << 16); }
__device__ __forceinline__ float wave_sum(float v) {
#pragma unroll
    for (int o = 1; o < 64; o <<= 1) v += __shfl_xor(v, o);
    return v;
}
__device__ __forceinline__ float sigmoidf_(float x) { return 1.0f / (1.0f + __expf(-x)); }
__device__ __forceinline__ unsigned f2key(float f) { unsigned b = __float_as_uint(f); if (f == 0.0f) b = 0u; return (b & 0x80000000u) ? ~b : (b | 0x80000000u); }
__device__ __forceinline__ u32x4 pack8(const float* v) { u32x4 w; w.x = pk2(v[0], v[1]); w.y = pk2(v[2], v[3]); w.z = pk2(v[4], v[5]); w.w = pk2(v[6], v[7]); return w; }
__device__ __forceinline__ void unpack8(u32x4 w, float* v) { v[0] = bflo(w.x); v[1] = bfhi(w.x); v[2] = bflo(w.y); v[3] = bfhi(w.y); v[4] = bflo(w.z); v[5] = bfhi(w.z); v[6] = bflo(w.w); v[7] = bfhi(w.w); }

#define XB_TMO      128
#define XB_XCNT(j)  (256  + 64 * (j))
#define XB_XSUB(j)  (1280 + 64 * (j))
#define XB_XGEN(j)  (2304 + 64 * (j))
#define XB_TOP      3328
#define XB_TOPGEN   3392
#define XCD_BAR_WORDS 3456
#define XB_SPIN_CAP (1u << 18)

__device__ __forceinline__ unsigned xb_ld(unsigned* p)              { return __hip_atomic_load(p, __ATOMIC_RELAXED, __HIP_MEMORY_SCOPE_AGENT); }
__device__ __forceinline__ unsigned xb_add(unsigned* p, unsigned v) { return __hip_atomic_fetch_add(p, v, __ATOMIC_RELAXED, __HIP_MEMORY_SCOPE_AGENT); }
__device__ __forceinline__ unsigned xb_xcc_id() { return (unsigned)__builtin_amdgcn_s_getreg((3 << 11) | 20) & 0xFu; }
#define XB_SPIN(cond, bar) do { unsigned _sp = 0; while (cond) { __builtin_amdgcn_s_sleep(1); \
    if ((++_sp & 255u) == 0u) { if (xb_ld(&(bar)[XB_TMO])) break; if (_sp > XB_SPIN_CAP) { atomicAdd(&(bar)[XB_TMO], 1u); break; } } } } while (0)

struct XcdBarrier {
    unsigned* bar; unsigned x;
    volatile LAS unsigned* st;
};
__device__ __forceinline__ XcdBarrier xcd_barrier_post(unsigned* bar, volatile LAS unsigned* st) {
    XcdBarrier b; b.bar = bar; b.x = xb_xcc_id(); b.st = st;
    if (threadIdx.x == 0) (void)xb_add(&bar[XB_XCNT(b.x)], 1u);
    return b;
}
__device__ __forceinline__ void xcd_barrier_complete(unsigned* bar, unsigned x, unsigned& nloc, unsigned& nx) {
    const unsigned G = gridDim.x * gridDim.y * gridDim.z;
    unsigned sum, cnt, mine, sp = 0u;
    for (;;) {
        sum = 0u; cnt = 0u; mine = 0u;
#pragma unroll
        for (unsigned j = 0; j < 16; ++j) { const unsigned c = xb_ld(&bar[XB_XCNT(j)]); sum += c; cnt += (c > 0u) ? 1u : 0u; mine = (j == x) ? c : mine; }
        if (sum == G) break;
        __builtin_amdgcn_s_sleep(1);
        if ((++sp & 255u) == 0u) { if (xb_ld(&bar[XB_TMO])) break; if (sp > XB_SPIN_CAP) { atomicAdd(&bar[XB_TMO], 1u); break; } }
    }
    nloc = mine > 0u ? mine : 1u; nx = cnt > 0u ? cnt : 1u;
}
__device__ __forceinline__ void xcd_barrier(const XcdBarrier& b) {
    asm volatile("s_waitcnt vmcnt(0)" ::: "memory");
    __syncthreads();
    if (threadIdx.x == 0) {
        unsigned* bar = b.bar;
        __builtin_amdgcn_s_waitcnt(0);
        unsigned nloc = b.st[0], nx = b.st[1];
        if (nloc == 0u) { xcd_barrier_complete(bar, b.x, nloc, nx); b.st[0] = nloc; b.st[1] = nx; }
        const unsigned old = xb_add(&bar[XB_XSUB(b.x)], 1u);
        const unsigned gen = old / nloc;
        if (old + 1u == (gen + 1u) * nloc) {
            __builtin_amdgcn_fence(__ATOMIC_RELEASE, "agent");
            asm volatile("s_waitcnt vmcnt(0)" ::: "memory");
            const unsigned og = xb_add(&bar[XB_TOP], 1u);
            const unsigned tg = og / nx;
            if (og + 1u == (tg + 1u) * nx) xb_add(&bar[XB_TOPGEN], 1u);
            else XB_SPIN(xb_ld(&bar[XB_TOPGEN]) == tg, bar);
            __builtin_amdgcn_fence(__ATOMIC_ACQUIRE, "agent");
            xb_add(&bar[XB_XGEN(b.x)], 1u);
            asm volatile("s_waitcnt vmcnt(0)" ::: "memory");
        } else {
            XB_SPIN(xb_ld(&bar[XB_XGEN(b.x)]) == gen, bar);
            __builtin_amdgcn_fence(__ATOMIC_ACQUIRE, "agent");
            asm volatile("s_waitcnt vmcnt(0)" ::: "memory");
        }
    }
    __syncthreads();
}

namespace pg8 {
constexpr int BM = 256, BK = 64, HALF = 128, HTB = HALF * BK * 2, STAGE_BYTES = 8 * HTB, NXCD = 8, WGM = 8;
__device__ __forceinline__ int lds_byte(int r, int c) { const int st = (r >> 4) * 2 + (c >> 5), rr = r & 15, cc = c & 31, ob = rr * 64 + cc * 2; return st * 1024 + (ob ^ (((ob >> 9) & 1) << 5)); }
__device__ __forceinline__ void stage_rc(int b, int& R, int& C) { const int st = b / 1024, sb = b % 1024, swz = sb ^ (((sb >> 9) & 1) << 5); R = (st >> 1) * 16 + swz / 64; C = (st & 1) * 32 + (swz % 64) / 2; }
__device__ __forceinline__ int perm32(int rho) { const int n = rho >> 4, i = rho & 15; return 8 * (i >> 2) + 4 * n + (i & 3); }
struct Unit { int pm, pn; };
struct Gemm { const bf16_t* A; const bf16_t* Bt; int M, N, K; };
struct StaticOrder {
    int nM, nN, nwg, G, c;
    __device__ void init(int M, int N, int G_, int c_) { nM = M / BM; nN = N / BM; nwg = nM * nN; G = G_; c = c_; }
    __device__ bool next(int i, Unit& u) const {
        const long L = (long)i * G + c; if (L >= nwg) return false;
        int wgid = (int)L; { const int q = nwg / NXCD, r = nwg % NXCD, xcd = wgid % NXCD, off = wgid / NXCD; wgid = (xcd < r ? xcd * (q + 1) : r * (q + 1) + (xcd - r) * q) + off; }
        const int nig = WGM * nN, gid = wgid / nig, fm = gid * WGM, gsz = (nM - fm) < WGM ? (nM - fm) : WGM;
        u.pm = fm + ((wgid % nig) % gsz); u.pn = (wgid % nig) / gsz; return true;
    }
};
template <class Epi>
__device__ __forceinline__ void gemm_phase(LAS unsigned char* lds, const Gemm g, const StaticOrder& S, const Epi& E) {
    const int tid = threadIdx.x, wid = __builtin_amdgcn_readfirstlane(tid >> 6), lane = tid & 63, wr = wid >> 2, wc = wid & 3, fr = lane & 15, fq = lane >> 4;
    const int K = g.K, nt = K / BK;
    unsigned voffA[2], voffB[2];
#pragma unroll
    for (int i = 0; i < 2; ++i) { int R, C; stage_rc(tid * 16 + i * 8192, R, C); const int Rb = (R & ~31) + perm32(R & 31);
        voffA[i] = (unsigned)(R * K + C) * 2u; voffB[i] = (unsigned)(Rb * K + C) * 2u; }
    const size_t kstep = (size_t)(BK * 2);
    const size_t hstep = (size_t)HALF * K * 2;
    const size_t tstep = 2 * hstep;
    const unsigned ldsw = (unsigned)wid * 1024u;
    const int aoff = lds_byte(wr * 64 + fr, fq * 8), boff = lds_byte(wc * 32 + fr, fq * 8);
#define PG8_SA(b, h) (((b) * 2 + (h)) * HTB)
#define PG8_SB(b, h) ((4 + (b) * 2 + (h)) * HTB)
#define PG8_STAGE(bufoff, gbase, voff) do { _Pragma("unroll") for (int _i = 0; _i < 2; ++_i) \
        __builtin_amdgcn_global_load_lds((const unsigned*)((const char*)(gbase) + (voff)[_i]), (LAS unsigned*)(lds + (bufoff) + ldsw + _i * 8192), 16, 0, 0); } while (0)
#define PG8_LDA(dst, b, h) do { _Pragma("unroll") for (int m = 0; m < 4; ++m) _Pragma("unroll") for (int k = 0; k < 2; ++k) dst[m][k] = *(const LAS bf16x8*)(lds + PG8_SA(b, h) + aoff + m * 2048 + k * 1024); } while (0)
#define PG8_LDB(dst, b, h) do { _Pragma("unroll") for (int n = 0; n < 2; ++n) _Pragma("unroll") for (int k = 0; k < 2; ++k) dst[n][k] = *(const LAS bf16x8*)(lds + PG8_SB(b, h) + boff + n * 2048 + k * 1024); } while (0)
#define PG8_MMA(ai, bj, At, Bt) do { __builtin_amdgcn_s_setprio(1); _Pragma("unroll") for (int m = 0; m < 4; ++m) _Pragma("unroll") for (int n = 0; n < 2; ++n) _Pragma("unroll") for (int k = 0; k < 2; ++k) \
        acc[ai][bj][m][n] = __builtin_amdgcn_mfma_f32_16x16x32_bf16(Bt[n][k], At[m][k], acc[ai][bj][m][n], 0, 0, 0); __builtin_amdgcn_s_setprio(0); } while (0)
#define PG8_WAIT_V(n) asm volatile("s_waitcnt vmcnt(" #n ")" ::: "memory")
#define PG8_WAIT_L(n) asm volatile("s_waitcnt lgkmcnt(" #n ")" ::: "memory")
#define PG8_BAR __builtin_amdgcn_s_barrier()
#define PG8_SCHED __builtin_amdgcn_sched_barrier(0)
    Unit cur, nxt; int ui = 0;
    if (!S.next(0, cur)) return;
    f32x4 acc[2][2][4][2];
#pragma unroll
    for (int a = 0; a < 2; ++a)
#pragma unroll
        for (int b = 0; b < 2; ++b)
#pragma unroll
            for (int m = 0; m < 4; ++m)
#pragma unroll
                for (int n = 0; n < 2; ++n) acc[a][b][m][n] = (f32x4){0.f, 0.f, 0.f, 0.f};
    bf16x8 At[4][2], B0[2][2], B1[2][2];
    const char* cA = (const char*)g.A + (size_t)cur.pm * tstep; const char* cB = (const char*)g.Bt + (size_t)cur.pn * tstep;
    PG8_STAGE(PG8_SB(0, 0), cB, voffB); PG8_STAGE(PG8_SA(0, 0), cA, voffA); PG8_STAGE(PG8_SB(0, 1), cB + hstep, voffB); PG8_STAGE(PG8_SA(0, 1), cA + hstep, voffA);
    if (wr == 1) PG8_BAR;
    PG8_WAIT_V(4); PG8_BAR;
    PG8_STAGE(PG8_SB(1, 0), cB + kstep, voffB); PG8_STAGE(PG8_SA(1, 0), cA + kstep, voffA); PG8_STAGE(PG8_SB(1, 1), cB + hstep + kstep, voffB);
    PG8_WAIT_V(6); PG8_BAR;
    for (;;) {
        const bool has_next = S.next(ui + 1, nxt);
        const char* nA = has_next ? (const char*)g.A + (size_t)nxt.pm * tstep : cA; const char* nB = has_next ? (const char*)g.Bt + (size_t)nxt.pn * tstep : cB;
#pragma unroll 1
        for (int t = 0; t < nt; t += 2) {
            const bool last = (t == nt - 2);
            const char* a1 = cA + (size_t)(t + 1) * kstep;
            const char* a2 = last ? nA : cA + (size_t)(t + 2) * kstep; const char* b2 = last ? nB : cB + (size_t)(t + 2) * kstep;
            const char* a3 = a2 + kstep; const char* b3 = b2 + kstep;
            PG8_LDB(B0, 0, 0); PG8_SCHED; PG8_LDA(At, 0, 0); PG8_STAGE(PG8_SA(1, 1), a1 + hstep, voffA);
            PG8_WAIT_L(8); PG8_BAR; PG8_WAIT_L(0); PG8_MMA(0, 0, At, B0); PG8_BAR; PG8_SCHED;
            PG8_LDB(B1, 0, 1); PG8_STAGE(PG8_SB(0, 0), b2, voffB);
            PG8_BAR; PG8_WAIT_L(0); PG8_MMA(0, 1, At, B1); PG8_BAR;
            PG8_LDA(At, 0, 1); PG8_STAGE(PG8_SA(0, 0), a2, voffA);
            PG8_BAR; PG8_WAIT_L(0); PG8_MMA(1, 0, At, B0); PG8_BAR; PG8_SCHED;
            PG8_STAGE(PG8_SB(0, 1), b2 + hstep, voffB);
            PG8_WAIT_V(6); PG8_BAR; PG8_MMA(1, 1, At, B1); PG8_BAR;
            PG8_LDB(B0, 1, 0); PG8_SCHED; PG8_LDA(At, 1, 0); PG8_STAGE(PG8_SA(0, 1), a2 + hstep, voffA);
            PG8_WAIT_L(8); PG8_BAR; PG8_WAIT_L(0); PG8_MMA(0, 0, At, B0); PG8_BAR; PG8_SCHED;
            PG8_LDB(B1, 1, 1); PG8_STAGE(PG8_SB(1, 0), b3, voffB);
            PG8_BAR; PG8_WAIT_L(0); PG8_MMA(0, 1, At, B1); PG8_BAR;
            PG8_LDA(At, 1, 1); PG8_STAGE(PG8_SA(1, 0), a3, voffA);
            PG8_BAR; PG8_WAIT_L(0); PG8_MMA(1, 0, At, B0); PG8_BAR; PG8_SCHED;
            PG8_STAGE(PG8_SB(1, 1), b3 + hstep, voffB);
            PG8_WAIT_V(6); PG8_BAR; PG8_MMA(1, 1, At, B1); PG8_BAR;
        }
        {
            const int row0 = cur.pm * BM + wr * 64 + fr, col0 = cur.pn * BM + wc * 32 + 8 * fq;
#pragma unroll
            for (int ai = 0; ai < 2; ++ai)
#pragma unroll
                for (int m = 0; m < 4; ++m)
#pragma unroll
                    for (int bj = 0; bj < 2; ++bj) { E(row0 + ai * HALF + m * 16, col0 + bj * HALF, cur.pn, acc[ai][bj][m][0], acc[ai][bj][m][1]); if (Epi::SERIAL) __builtin_amdgcn_sched_barrier(0); }
        }
        if (!has_next) break;
#pragma unroll
        for (int a = 0; a < 2; ++a)
#pragma unroll
            for (int b = 0; b < 2; ++b)
#pragma unroll
                for (int m = 0; m < 4; ++m)
#pragma unroll
                    for (int n = 0; n < 2; ++n) acc[a][b][m][n] = (f32x4){0.f, 0.f, 0.f, 0.f};
        cur = nxt; cA = nA; cB = nB; ++ui;
    }
    PG8_WAIT_V(0);
    if (wr == 0) PG8_BAR;
    PG8_BAR;
#undef PG8_SA
#undef PG8_SB
#undef PG8_STAGE
#undef PG8_LDA
#undef PG8_LDB
#undef PG8_MMA
#undef PG8_WAIT_V
#undef PG8_WAIT_L
#undef PG8_BAR
#undef PG8_SCHED
}
}

struct Args { const float* in[34]; float* out; unsigned char* ws; int ph_lo, ph_hi, li, pad; };

struct Ctx {
    LAS unsigned char* lds;
    int tid, lane, wave, gw, ngw, gt, ngt, G;
    const float* const* in; unsigned char* ws; unsigned char* dout;
};

__device__ __forceinline__ void st8_bf16(bf16_t* p, f32x4 a, f32x4 b) { u32x4 w; w.x = pk2(a.x, a.y); w.y = pk2(a.z, a.w); w.z = pk2(b.x, b.y); w.w = pk2(b.z, b.w); *(u32x4*)p = w; }
struct EpiP1 { static constexpr bool SERIAL = false;
    float* cs; bf16_t* rc; bf16_t* mq;
    __device__ __forceinline__ void operator()(int row, int col, int pn, f32x4 a, f32x4 b) const {
        if (pn < 2) { float* p = cs + (size_t)row * 512 + col; *(f32x4*)p = a; *(f32x4*)(p + 4) = b; }
        else if (pn < 9) st8_bf16(rc + (size_t)row * 1792 + (col - 512), a, b);
        else st8_bf16(mq + (size_t)row * 512 + (col - 2304), a, b);
    }
};
struct EpiMemKV { static constexpr bool SERIAL = false;
    bf16_t* km; bf16_t* vt;
    __device__ __forceinline__ void operator()(int row, int col, int pn, f32x4 a, f32x4 b) const {
        const int bb = row >> 8, m = row & 255;
        if (col < 512) { const int h = col >> 7, d = col & 127; st8_bf16(km + ((size_t)((bb * 4 + h) * 256 + m)) * 128 + d, a, b); }
        else { const int c2 = col - 512, h = c2 >> 7, d = c2 & 127; bf16_t* p = vt + ((size_t)((bb * 4 + h) * 128 + d)) * 256 + m;
            p[0] = (bf16_t)f2bf(a.x); p[256] = (bf16_t)f2bf(a.y); p[512] = (bf16_t)f2bf(a.z); p[768] = (bf16_t)f2bf(a.w);
            p[1024] = (bf16_t)f2bf(b.x); p[1280] = (bf16_t)f2bf(b.y); p[1536] = (bf16_t)f2bf(b.z); p[1792] = (bf16_t)f2bf(b.w); }
    }
};
struct EpiLora { static constexpr bool SERIAL = true;
    bf16_t* e; bf16_t* a; bf16_t* g; const float* w0; const float* a0;
    __device__ __forceinline__ void operator()(int row, int col, int pn, f32x4 x, f32x4 y) const {
        float v[8] = {x.x, x.y, x.z, x.w, y.x, y.y, y.z, y.w};
        if (pn < 4) { const int c = col & 511; const float* bp = (pn < 2 ? w0 : a0) + c; const f32x4 b0 = *(const f32x4*)bp, b1 = *(const f32x4*)(bp + 4);
            const float bb[8] = {b0.x, b0.y, b0.z, b0.w, b1.x, b1.y, b1.z, b1.w}; const float sc = pn < 2 ? 0.6065306597126334f : 1.0f;
#pragma unroll
            for (int j = 0; j < 8; ++j) v[j] = sc * sigmoidf_(v[j] + bb[j]);
            *(u32x4*)((pn < 2 ? e : a) + (size_t)row * 512 + c) = pack8(v);
        } else *(u32x4*)(g + (size_t)row * 512 + (col - 1024)) = pack8(v);
    }
};
struct EpiQ { static constexpr bool SERIAL = false;
    bf16_t* ql; bf16_t* qi;
    __device__ __forceinline__ void operator()(int row, int col, int pn, f32x4 a, f32x4 b) const {
        if (pn < 4) st8_bf16(ql + (size_t)row * 1024 + col, a, b); else st8_bf16(qi + (size_t)row * 256 + (col - 1024), a, b);
    }
};
struct EpiGates { static constexpr bool SERIAL = true;
    bf16_t* o;
    __device__ __forceinline__ void operator()(int row, int col, int pn, f32x4 a, f32x4 b) const {
        float v[8] = {a.x, a.y, a.z, a.w, b.x, b.y, b.z, b.w};
#pragma unroll
        for (int j = 0; j < 8; ++j) v[j] = sigmoidf_(v[j]);
        *(u32x4*)(o + (size_t)row * 3072 + col) = pack8(v);
    }
};
template <int WHICH> struct EpiMerge { static constexpr bool SERIAL = true;
    const bf16_t* gates; float* mf; bf16_t* mb;
    __device__ __forceinline__ void operator()(int row, int col, int pn, f32x4 a, f32x4 b) const {
        float v[8] = {a.x, a.y, a.z, a.w, b.x, b.y, b.z, b.w}, gv[8];
        unpack8(*(const u32x4*)(gates + (size_t)row * 3072 + WHICH * 1024 + col), gv);
        float* p = mf + (size_t)row * 1024 + col;
        if (WHICH == 0) {
#pragma unroll
            for (int j = 0; j < 8; ++j) v[j] *= gv[j];
        } else { const f32x4 p0 = *(const f32x4*)p, p1 = *(const f32x4*)(p + 4); const float pv[8] = {p0.x, p0.y, p0.z, p0.w, p1.x, p1.y, p1.z, p1.w};
#pragma unroll
            for (int j = 0; j < 8; ++j) v[j] = pv[j] + v[j] * gv[j];
        }
        if (WHICH == 2) *(u32x4*)(mb + (size_t)row * 1024 + col) = pack8(v);
        else { *(f32x4*)p = (f32x4){v[0], v[1], v[2], v[3]}; *(f32x4*)(p + 4) = (f32x4){v[4], v[5], v[6], v[7]}; }
    }
};
struct EpiWout { static constexpr bool SERIAL = false;
    const float* x; float* pre;
    __device__ __forceinline__ void operator()(int row, int col, int pn, f32x4 a, f32x4 b) const {
        const float* xp = x + (size_t)row * 1024 + col; float* p = pre + (size_t)row * 1024 + col;
        *(f32x4*)p = *(const f32x4*)xp * ALPHA + a; *(f32x4*)(p + 4) = *(const f32x4*)(xp + 4) * ALPHA + b;
    }
};
struct EpiPeerQ { static constexpr bool SERIAL = false; bf16_t* o; __device__ __forceinline__ void operator()(int row, int col, int pn, f32x4 a, f32x4 b) const { st8_bf16(o + (size_t)row * 2048 + col, a, b); } };

template <int N, int K, class F> __device__ __forceinline__ void build_bt(bf16_t* dst, const F& f, int gt, int ngt) {
    constexpr int items = N * (K / 8);
    for (int i = gt; i < items; i += ngt) { const int n = i % N, k0 = (i / N) * 8; float v[8];
#pragma unroll
        for (int j = 0; j < 8; ++j) v[j] = f(n, k0 + j);
        *(u32x4*)(dst + (size_t)n * K + k0) = pack8(v); }
}
struct FWin { const float* w; __device__ __forceinline__ float operator()(int n, int k) const { if (n < 424) return w[(size_t)k * IN_W + n]; if (n < 512) return 0.f; return w[(size_t)k * IN_W + n - 88]; } };
struct FWg { const float* w; __device__ __forceinline__ float operator()(int n, int k) const { return w[(size_t)k * IN_W + 2728 + n]; } };
struct FLora { const float *w2, *a2, *g2; __device__ __forceinline__ float operator()(int n, int k) const {
    if (n < 512) return k < 64 ? w2[k * 512 + n] : 0.f;
    if (n < 1024) return (k >= 64 && k < 128) ? a2[(k - 64) * 512 + n - 512] : 0.f;
    return k >= 128 ? g2[(k - 128) * 512 + n - 1024] : 0.f; } };
struct FWq { const float *uq, *uk, *iq; __device__ __forceinline__ float operator()(int n, int k) const {
    if (n >= 1024) return iq[k * 256 + n - 1024];
    const int h = n >> 7, c = n & 127; const float* a = uq + (size_t)k * 512 + h * 64; const float* b = uk + (size_t)(c * 8 + h) * 64; float s = 0.f;
#pragma unroll 8
    for (int d = 0; d < 64; ++d) s = fmaf(a[d], b[d], s);
    return s * 0.125f; } };
struct FWov { const float *uv, *br; __device__ __forceinline__ float operator()(int n, int k) const {
    const int h = k >> 7, c = k & 127; const float* a = uv + (size_t)(c * 8 + h) * 64; const float* b = br + (size_t)(h * 64) * 1024 + n; float s = 0.f;
#pragma unroll 8
    for (int d = 0; d < 64; ++d) s = fmaf(a[d], b[(size_t)d * 1024], s);
    return s; } };
struct FT { const float* w; int ld; __device__ __forceinline__ float operator()(int n, int k) const { return w[(size_t)k * ld + n]; } };

__device__ __forceinline__ void cvt_rows(const float* src, bf16_t* dst, size_t n8, int gt, int ngt) {
    for (size_t i = gt; i < n8; i += ngt) { const f32x4 a = *(const f32x4*)(src + i * 8), b = *(const f32x4*)(src + i * 8 + 4); st8_bf16(dst + i * 8, a, b); }
}
__device__ __forceinline__ void p0_prologue(const Ctx& C) {
    const float* const* in = C.in; unsigned char* ws = C.ws;
    cvt_rows(in[0], (bf16_t*)(C.dout + DO_XB), (size_t)T * D / 8, C.gt, C.ngt);
    cvt_rows(in[1], (bf16_t*)(ws + WS_MEMB), (size_t)1024 * 1024 / 8, C.gt, C.ngt);
    cvt_rows(in[29], (bf16_t*)(ws + WS_KEYS), (size_t)2 * 128 * 128 / 8, C.gt, C.ngt);
    build_bt<2816, 1024>((bf16_t*)(ws + WS_WIN), FWin{in[3]}, C.gt, C.ngt);
    build_bt<3072, 1024>((bf16_t*)(ws + WS_WG), FWg{in[3]}, C.gt, C.ngt);
    build_bt<1536, 256>((bf16_t*)(ws + WS_WLORA), FLora{in[12], in[14], in[15]}, C.gt, C.ngt);
    build_bt<1280, 256>((bf16_t*)(ws + WS_WQ), FWq{in[6], in[7], in[9]}, C.gt, C.ngt);
    build_bt<1024, 1024>((bf16_t*)(ws + WS_WMEMKV), FT{in[21], 1024}, C.gt, C.ngt);
    build_bt<1024, 1024>((bf16_t*)(ws + WS_WOV), FWov{in[8], in[22]}, C.gt, C.ngt);
    build_bt<1024, 512>((bf16_t*)(ws + WS_WBRR), FT{in[23], 1024}, C.gt, C.ngt);
    build_bt<1024, 512>((bf16_t*)(ws + WS_WBRM), FT{in[24], 1024}, C.gt, C.ngt);
    build_bt<1024, 1024>((bf16_t*)(ws + WS_WOUT), FT{in[25], 1024}, C.gt, C.ngt);
    build_bt<2048, 1024>((bf16_t*)(ws + WS_WPEER), FT{in[28], 2048}, C.gt, C.ngt);
}

__device__ __forceinline__ void p2_prep(const Ctx& C) {
    const float* const* in = C.in; unsigned char* ws = C.ws; const int lane = C.lane;
    const float* csmall = (const float*)(ws + WS_CSMALL); const bf16_t* rcols = (const bf16_t*)(ws + WS_RCOLS);
    bf16_t* cqn = (bf16_t*)(ws + WS_CQN); bf16_t* kvl = (bf16_t*)(ws + WS_KVL); bf16_t* kidx = (bf16_t*)(ws + WS_KIDX); float* widx = (float*)(ws + WS_WIDX);
    bf16_t* rr = (bf16_t*)(ws + WS_RW_R); bf16_t* rk = (bf16_t*)(ws + WS_RW_K); bf16_t* rv = (bf16_t*)(ws + WS_RW_V); bf16_t* la = (bf16_t*)(ws + WS_LORAA);
    const float* mu = in[10];
    const f32x4 gq = *(const f32x4*)(in[4] + 4 * lane); const f32x2 gk = *(const f32x2*)(in[5] + 2 * lane);
    for (int t = C.gw; t < T; t += C.ngw) {
        const float* cs = csmall + (size_t)t * 512;
        {
            const f32x4 q = *(const f32x4*)(cs + 4 * lane);
            const float ss = wave_sum(q.x * q.x + q.y * q.y + q.z * q.z + q.w * q.w);
            const float rs = rsqrtf(ss * (1.0f / 256.0f) + 1e-6f);
            u32x2 w; w.x = pk2(q.x * rs * gq.x, q.y * rs * gq.y); w.y = pk2(q.z * rs * gq.z, q.w * rs * gq.w);
            *(u32x2*)(cqn + (size_t)t * 256 + 4 * lane) = w;
        }
        {
            const f32x2 k = *(const f32x2*)(cs + 256 + 2 * lane);
            const float ss = wave_sum(k.x * k.x + k.y * k.y);
            const float rs = rsqrtf(ss * (1.0f / 128.0f) + 1e-6f);
            *(unsigned*)(kvl + (size_t)t * 128 + 2 * lane) = pk2(k.x * rs * gk.x, k.y * rs * gk.y);
        }
        if (lane < 16) { const f32x2 k = *(const f32x2*)(cs + 384 + 2 * lane); *(unsigned*)(kidx + (size_t)t * 32 + 2 * lane) = pk2(k.x, k.y); }
        if (lane < 8) widx[(size_t)t * 8 + lane] = cs[416 + lane] * 0.0625f;
        const bf16_t* rc = rcols + (size_t)t * 1792; const bool hp = (t & (SEQ - 1)) != 0; const bf16_t* rp = hp ? rc - 1792 : rc;
#pragma unroll
        for (int seg = 0; seg < 3; ++seg) {
            float c[8], p[8], o[8];
            unpack8(*(const u32x4*)(rc + seg * 512 + 8 * lane), c); unpack8(*(const u32x4*)(rp + seg * 512 + 8 * lane), p);
            const f32x4 m0 = *(const f32x4*)(mu + seg * 512 + 8 * lane), m1 = *(const f32x4*)(mu + seg * 512 + 8 * lane + 4);
            const float mm[8] = {m0.x, m0.y, m0.z, m0.w, m1.x, m1.y, m1.z, m1.w};
#pragma unroll
            for (int j = 0; j < 8; ++j) { const float pv = hp ? p[j] : 0.f; o[j] = c[j] + (pv - c[j]) * mm[j]; }
            bf16_t* dst = (seg == 0 ? rr : (seg == 1 ? rk : rv)) + (size_t)t * 512 + 8 * lane;
            *(u32x4*)dst = pack8(o);
        }
        {
            const float cw = bf1(rc[1536 + lane]), pw = hp ? bf1(rp[1536 + lane]) : 0.f; const float wl = cw + (pw - cw) * mu[1536 + lane];
            const float ca = bf1(rc[1600 + lane]), pa = hp ? bf1(rp[1600 + lane]) : 0.f; const float al = ca + (pa - ca) * mu[1600 + lane];
            const unsigned cgw = *(const unsigned*)(rc + 1664 + 2 * lane), pgw = *(const unsigned*)(rp + 1664 + 2 * lane);
            const float cg0 = bflo(cgw), cg1 = bfhi(cgw), pg0 = hp ? bflo(pgw) : 0.f, pg1 = hp ? bfhi(pgw) : 0.f;
            const float g0 = cg0 + (pg0 - cg0) * mu[1664 + 2 * lane], g1 = cg1 + (pg1 - cg1) * mu[1664 + 2 * lane + 1];
            bf16_t* l = la + (size_t)t * 256;
            l[lane] = (bf16_t)f2bf(tanhf(wl)); l[64 + lane] = (bf16_t)f2bf(al);
            *(unsigned*)(l + 128 + 2 * lane) = pk2(sigmoidf_(g0), sigmoidf_(g1));
        }
    }
}

template <int NV> __device__ __forceinline__ unsigned kth_largest(const unsigned (&u)[NV], int k) {
    unsigned Tk = 0u;
    for (int bit = 31; bit >= 0; --bit) {
        const unsigned cand = Tk | (1u << bit); int cnt = 0;
#pragma unroll
        for (int j = 0; j < NV; ++j) cnt += __popcll(__ballot(u[j] >= cand));
        if (cnt >= k) Tk = cand;
    }
    return Tk;
}

__device__ __forceinline__ void p4_indexer(const Ctx& C) {
    unsigned char* ws = C.ws; const int lane = C.lane, wave = C.wave, g = lane >> 4, fr = lane & 15;
    const bf16_t* qidx = (const bf16_t*)(ws + WS_QIDX); const bf16_t* kidx = (const bf16_t*)(ws + WS_KIDX); const float* widx = (const float*)(ws + WS_WIDX);
    bf16_t* idxo = (bf16_t*)(ws + WS_IDX);
    LAS unsigned* SC = (LAS unsigned*)C.lds;
    for (int u = blockIdx.x; u < 2048; u += C.G) {
        const int i8 = u >> 8, cc = u & 255, b = cc & 3, j = cc >> 2, qb = (i8 & 1) ? 64 * i8 + 63 - j : 64 * i8 + j;
        const int t0 = qb * 8, ntile = (t0 + 8 + 15) >> 4; const size_t tb = (size_t)b * SEQ;
        const int qn = fr & 7;
        bf16x8 Bq[8];
#pragma unroll
        for (int h = 0; h < 8; ++h) Bq[h] = *(const bf16x8*)(qidx + (tb + t0 + qn) * 256 + h * 32 + 8 * g);
        const f32x4 w0 = *(const f32x4*)(widx + (tb + t0 + qn) * 8), w1 = *(const f32x4*)(widx + (tb + t0 + qn) * 8 + 4);
        const float wq[8] = {w0.x, w0.y, w0.z, w0.w, w1.x, w1.y, w1.z, w1.w};
        for (int i = wave; i < ntile; i += NWAVES) {
            const bf16x8 A = *(const bf16x8*)(kidx + (tb + 16 * i + fr) * 32 + 8 * g);
            f32x4 sc = (f32x4){0.f, 0.f, 0.f, 0.f};
#pragma unroll
            for (int h = 0; h < 8; ++h) { const f32x4 d = __builtin_amdgcn_mfma_f32_16x16x32_bf16(A, Bq[h], (f32x4){0.f, 0.f, 0.f, 0.f}, 0, 0, 0);
#pragma unroll
                for (int r = 0; r < 4; ++r) sc[r] = fmaf(wq[h], fmaxf(d[r], 0.f), sc[r]); }
            if (fr < 8) { const int tq = t0 + fr, s0 = 16 * i + 4 * g; u32x4 key;
#pragma unroll
                for (int r = 0; r < 4; ++r) key[r] = (s0 + r <= tq) ? f2key(sc[r]) : 0u;
                *(LAS u32x4*)(SC + fr * 4096 + s0) = key; }
        }
        __syncthreads();
        {
            const int tq = t0 + wave; bf16_t* out = idxo + (tb + tq) * 256;
            if (tq < 256) {
#pragma unroll
                for (int jj = 0; jj < 4; ++jj) { const int s = jj * 64 + lane; if (s <= tq) out[s] = (bf16_t)s; }
            } else {
                unsigned uk[64];
#pragma unroll
                for (int jj = 0; jj < 64; ++jj) { const int s = jj * 64 + lane; const unsigned v = SC[wave * 4096 + s]; uk[jj] = (s <= tq) ? v : 0u; }
                const unsigned Tk = kth_largest<64>(uk, 256);
                int cgt = 0;
#pragma unroll
                for (int jj = 0; jj < 64; ++jj) cgt += __popcll(__ballot(uk[jj] > Tk));
                const int need = 256 - cgt; int eqb = 0, pos = 0;
#pragma unroll
                for (int jj = 0; jj < 64; ++jj) {
                    const bool gt = uk[jj] > Tk, eq = uk[jj] == Tk;
                    const unsigned long long me = __ballot(eq);
                    const int er = eqb + (int)__builtin_amdgcn_mbcnt_hi((unsigned)(me >> 32), __builtin_amdgcn_mbcnt_lo((unsigned)me, 0u));
                    const bool take = gt || (eq && er < need);
                    eqb += __popcll(me);
                    const unsigned long long mt = __ballot(take);
                    const int pr = pos + (int)__builtin_amdgcn_mbcnt_hi((unsigned)(mt >> 32), __builtin_amdgcn_mbcnt_lo((unsigned)mt, 0u));
                    if (take) out[pr] = (bf16_t)(jj * 64 + lane);
                    pos += __popcll(mt);
                }
            }
        }
        __syncthreads();
    }
}

__device__ __forceinline__ void p4_memattn(const Ctx& C) {
    unsigned char* ws = C.ws; const int lane = C.lane, g = lane >> 4, fr = lane & 15;
    const bf16_t* memq = (const bf16_t*)(ws + WS_MEMQ); const bf16_t* kmem = (const bf16_t*)(ws + WS_KMEM); const bf16_t* vmt = (const bf16_t*)(ws + WS_VMEMT);
    bf16_t* ymem = (bf16_t*)(ws + WS_YMEM);
    for (int task = C.gw; task < 4096; task += C.ngw) {
        const int tt = task >> 2, h = task & 3, t0 = tt * 16, b = t0 >> 12;
        const bf16_t* kb = kmem + (size_t)((b * 4 + h) * 256) * 128; const bf16_t* vb = vmt + (size_t)((b * 4 + h) * 128) * 256;
        bf16x8 Bq[4];
#pragma unroll
        for (int kk = 0; kk < 4; ++kk) Bq[kk] = *(const bf16x8*)(memq + (size_t)(t0 + fr) * 512 + h * 128 + 32 * kk + 8 * g);
        f32x4 sc[16];
#pragma unroll
        for (int i = 0; i < 16; ++i) { sc[i] = (f32x4){0.f, 0.f, 0.f, 0.f};
#pragma unroll
            for (int kk = 0; kk < 4; ++kk) { const bf16x8 A = *(const bf16x8*)(kb + (size_t)(16 * i + fr) * 128 + 32 * kk + 8 * g);
                sc[i] = __builtin_amdgcn_mfma_f32_16x16x32_bf16(A, Bq[kk], sc[i], 0, 0, 0); } }
        const float scale = 0.08838834764831845f;
        float mx = -3.0e38f;
#pragma unroll
        for (int i = 0; i < 16; ++i)
#pragma unroll
            for (int r = 0; r < 4; ++r) { sc[i][r] *= scale; mx = fmaxf(mx, sc[i][r]); }
        mx = fmaxf(mx, __shfl_xor(mx, 16)); mx = fmaxf(mx, __shfl_xor(mx, 32));
        float sum = 0.f;
#pragma unroll
        for (int i = 0; i < 16; ++i)
#pragma unroll
            for (int r = 0; r < 4; ++r) { sc[i][r] = __expf(sc[i][r] - mx); sum += sc[i][r]; }
        sum += __shfl_xor(sum, 16); sum += __shfl_xor(sum, 32);
        const float inv = 1.0f / sum;
        bf16x8 Pb[8];
#pragma unroll
        for (int ks = 0; ks < 8; ++ks) { u32x4 w; w.x = pk2(sc[2 * ks][0] * inv, sc[2 * ks][1] * inv); w.y = pk2(sc[2 * ks][2] * inv, sc[2 * ks][3] * inv);
            w.z = pk2(sc[2 * ks + 1][0] * inv, sc[2 * ks + 1][1] * inv); w.w = pk2(sc[2 * ks + 1][2] * inv, sc[2 * ks + 1][3] * inv); Pb[ks] = __builtin_bit_cast(bf16x8, w); }
#pragma unroll
        for (int dt = 0; dt < 8; ++dt) {
            f32x4 o = (f32x4){0.f, 0.f, 0.f, 0.f};
#pragma unroll
            for (int ks = 0; ks < 8; ++ks) { const bf16_t* vp = vb + (size_t)(16 * dt + fr) * 256 + 32 * ks + 4 * g;
                const u32x2 lo = *(const u32x2*)vp, hi = *(const u32x2*)(vp + 16); u32x4 w; w.x = lo.x; w.y = lo.y; w.z = hi.x; w.w = hi.y;
                o = __builtin_amdgcn_mfma_f32_16x16x32_bf16(__builtin_bit_cast(bf16x8, w), Pb[ks], o, 0, 0, 0); }
            u32x2 w; w.x = pk2(o[0], o[1]); w.y = pk2(o[2], o[3]);
            *(u32x2*)(ymem + (size_t)(t0 + fr) * 512 + h * 128 + 16 * dt + 4 * g) = w;
        }
    }
}

constexpr int LDS_RELB = 131072 + 1024;
constexpr int LDS_LUT = LDS_RELB + 1024;
__device__ __forceinline__ u32x2 tr_read2(unsigned a0, unsigned a1, u32x2& hi) {
    u32x2 lo; asm volatile("ds_read_b64_tr_b16 %0, %2\n\tds_read_b64_tr_b16 %1, %3\n\ts_waitcnt lgkmcnt(0)" : "=&v"(lo), "=&v"(hi) : "v"(a0), "v"(a1) : "memory"); return lo;
}
__device__ __forceinline__ void p5_dsa_attn(const Ctx& C) {
    unsigned char* ws = C.ws; const int lane = C.lane, wave = C.wave, g = lane >> 4, fr = lane & 15;
    const bf16_t* qlat = (const bf16_t*)(ws + WS_QLAT); const bf16_t* kvl = (const bf16_t*)(ws + WS_KVL); const bf16_t* idxb = (const bf16_t*)(ws + WS_IDX);
    bf16_t* olat = (bf16_t*)(ws + WS_OLAT);
    LAS float* relb = (LAS float*)(C.lds + LDS_RELB); LAS int* lut = (LAS int*)(C.lds + LDS_LUT);
    if (C.tid < 256) relb[C.tid] = C.in[2][C.tid];
    if (C.tid < 128) { const int n = C.tid; int bk = n; if (n >= 16) { bk = 16 + (int)(logf((float)n * (1.0f / 16.0f)) / 2.0794415416798357f * 16.0f); bk = bk > 31 ? 31 : bk; } lut[n] = bk; }
    __syncthreads();
    LAS unsigned char* my = C.lds + wave * 16384; const unsigned mybase = (unsigned)(uintptr_t)my;
    for (int q = C.gw; q < T; q += C.ngw) {
        const int b = q >> 12, s = q & (SEQ - 1); const int nvalid = s + 1 < 256 ? s + 1 : 256;
        bf16x8 Bq[4];
#pragma unroll
        for (int kk = 0; kk < 4; ++kk) Bq[kk] = *(const bf16x8*)(qlat + (size_t)q * 1024 + (fr & 7) * 128 + 32 * kk + 8 * g);
        float m_run = -INFINITY, l_run = 0.f;
        f32x4 O[8];
#pragma unroll
        for (int cc = 0; cc < 8; ++cc) O[cc] = (f32x4){0.f, 0.f, 0.f, 0.f};
        const int nch = (nvalid + 63) >> 6;
        for (int ch = 0; ch < nch; ++ch) {
            const int slot = ch * 64 + lane; const int ix = slot < nvalid ? (int)idxb[(size_t)q * 256 + slot] : 0;
            const char* kvb = (const char*)(kvl + (size_t)b * SEQ * 128);
#pragma unroll
            for (int p = 0; p < 16; ++p) { const int rrow = 4 * p + g; const int srow = __shfl(ix, rrow); const int c = fr ^ (2 * (rrow & 7));
                __builtin_amdgcn_global_load_lds((const unsigned*)(kvb + (size_t)srow * 256 + 16 * c), (LAS unsigned*)(my + 1024 * p), 16, 0, 0); }
            asm volatile("s_waitcnt vmcnt(0)" ::: "memory");
            f32x4 sc[4];
#pragma unroll
            for (int i = 0; i < 4; ++i) { sc[i] = (f32x4){0.f, 0.f, 0.f, 0.f};
#pragma unroll
                for (int kk = 0; kk < 4; ++kk) { const int row = 16 * i + fr; const int sl = (4 * kk + g) ^ (2 * (row & 7));
                    const bf16x8 A = *(const LAS bf16x8*)(my + row * 256 + 16 * sl);
                    sc[i] = __builtin_amdgcn_mfma_f32_16x16x32_bf16(A, Bq[kk], sc[i], 0, 0, 0); } }
            float mx = -INFINITY;
#pragma unroll
            for (int i = 0; i < 4; ++i)
#pragma unroll
                for (int r = 0; r < 4; ++r) { const int ks = 16 * i + 4 * g + r; const int kpos = __shfl(ix, ks); const int dist = s - kpos;
                    const int bk = dist >= 128 ? 31 : lut[dist < 0 ? 0 : dist]; const float bias = relb[bk * 8 + (fr & 7)];
                    const bool valid = ch * 64 + ks < nvalid; const float v = valid ? sc[i][r] + bias : -INFINITY; sc[i][r] = v; mx = fmaxf(mx, v); }
            mx = fmaxf(mx, __shfl_xor(mx, 16)); mx = fmaxf(mx, __shfl_xor(mx, 32));
            const float m_new = fmaxf(m_run, mx); const float alpha = __expf(m_run - m_new);
            float ps = 0.f;
#pragma unroll
            for (int i = 0; i < 4; ++i)
#pragma unroll
                for (int r = 0; r < 4; ++r) { sc[i][r] = __expf(sc[i][r] - m_new); ps += sc[i][r]; }
            ps += __shfl_xor(ps, 16); ps += __shfl_xor(ps, 32);
            l_run = l_run * alpha + ps; m_run = m_new;
            float ar[4];
#pragma unroll
            for (int r = 0; r < 4; ++r) ar[r] = __shfl(alpha, 4 * g + r);
#pragma unroll
            for (int cc = 0; cc < 8; ++cc)
#pragma unroll
                for (int r = 0; r < 4; ++r) O[cc][r] *= ar[r];
#pragma unroll
            for (int ks = 0; ks < 2; ++ks) {
                u32x4 w; w.x = pk2(sc[2 * ks][0], sc[2 * ks][1]); w.y = pk2(sc[2 * ks][2], sc[2 * ks][3]); w.z = pk2(sc[2 * ks + 1][0], sc[2 * ks + 1][1]); w.w = pk2(sc[2 * ks + 1][2], sc[2 * ks + 1][3]);
                const bf16x8 Pa = __builtin_bit_cast(bf16x8, w);
                const int qq = fr >> 2, p2 = fr & 3;
#pragma unroll
                for (int cc = 0; cc < 8; ++cc) {
                    const int R0 = 32 * ks + 4 * g + qq, R1 = R0 + 16; const int chk = 2 * cc + (p2 >> 1);
                    const unsigned a0 = mybase + R0 * 256 + 16 * (chk ^ (2 * (R0 & 7))) + 8 * (p2 & 1), a1 = mybase + R1 * 256 + 16 * (chk ^ (2 * (R1 & 7))) + 8 * (p2 & 1);
                    u32x2 hi; const u32x2 lo = tr_read2(a0, a1, hi); u32x4 bw; bw.x = lo.x; bw.y = lo.y; bw.z = hi.x; bw.w = hi.y;
                    O[cc] = __builtin_amdgcn_mfma_f32_16x16x32_bf16(Pa, __builtin_bit_cast(bf16x8, bw), O[cc], 0, 0, 0);
                }
            }
        }
        const float inv = 1.0f / l_run; float ir[4];
#pragma unroll
        for (int r = 0; r < 4; ++r) ir[r] = __shfl(inv, 4 * g + r);
        if (g < 2) {
#pragma unroll
            for (int cc = 0; cc < 8; ++cc)
#pragma unroll
                for (int r = 0; r < 4; ++r) olat[(size_t)q * 1024 + (4 * g + r) * 128 + 16 * cc + fr] = (bf16_t)f2bf(O[cc][r] * ir[r]);
        }
    }
}

constexpr int RBLK = 4, RVEC = 5 * 64 + 4;
constexpr int RWAVE_LDS = 2 * RBLK * RVEC * 4;
struct RwRaw { bf16_t a[RBLK], k[RBLK], e[RBLK], r[RBLK]; };
template <int MODE> __device__ __forceinline__ void rw_load_raw(RwRaw& w, const bf16_t* pa, const bf16_t* pk, const bf16_t* pe, const bf16_t* pr, size_t tok0, int col) {
#pragma unroll
    for (int i = 0; i < RBLK; ++i) { const size_t o = (tok0 + i) * 512 + col; w.a[i] = pa[o]; w.k[i] = pk[o]; w.e[i] = pe[o]; if (MODE == 2) w.r[i] = pr[o]; else w.r[i] = 0; }
}
template <int MODE> __device__ __forceinline__ void rw_process(const RwRaw& w, LAS float* buf, int lane, float kk_c, float ka_c, float rk_c) {
#pragma unroll
    for (int i = 0; i < RBLK; ++i) {
        const float a = bf1(w.a[i]), ks = bf1(w.k[i]), e = bf1(w.e[i]);
        const float kr = ks * kk_c; const float n2 = wave_sum(kr * kr); const float kk = kr / fmaxf(sqrtf(n2), 1e-12f);
        const float kx = ks * (1.0f + (a - 1.0f) * ka_c);
        LAS float* s = buf + i * RVEC;
        s[lane] = __expf(-e); s[64 + lane] = -kk; s[128 + lane] = kk * a;
        if (MODE != 1) s[192 + lane] = kx;
        if (MODE == 2) { const float r = bf1(w.r[i]); s[256 + lane] = r; const float bc = wave_sum(r * kx * rk_c); if (lane == 0) s[320] = bc; }
    }
}
template <int MODE> __device__ __forceinline__ void rw_task(const Ctx& C, int bh, int ch) {
    unsigned char* ws = C.ws; const int lane = C.lane; const int b = bh >> 3, h = bh & 7, col = h * 64 + lane;
    const bf16_t* pr = (const bf16_t*)(ws + WS_RW_R); const bf16_t* pk = (const bf16_t*)(ws + WS_RW_K); const bf16_t* pv = (const bf16_t*)(ws + WS_RW_V);
    const bf16_t* pa = (const bf16_t*)(ws + WS_RW_A); const bf16_t* pe = (const bf16_t*)(ws + WS_RW_E); const bf16_t* pg = (const bf16_t*)(ws + WS_RW_G);
    bf16_t* yo = (bf16_t*)(ws + WS_YRWKV);
    float* PQ = (float*)(C.dout + DO_PQ);
    LAS float* buf = (LAS float*)(C.lds + C.wave * RWAVE_LDS);
    const float kk_c = C.in[16][col], ka_c = C.in[17][col], rk_c = C.in[18][col];
    const float lng = C.in[19][col], lnb = C.in[20][col];
    const size_t tok0 = (size_t)b * SEQ + (size_t)ch * RL;
    float s[64];
    if (MODE == 0) {
#pragma unroll
        for (int k = 0; k < 64; ++k) s[k] = 0.f;
    } else if (MODE == 1) {
#pragma unroll
        for (int k = 0; k < 64; ++k) s[k] = (k == lane) ? 1.f : 0.f;
    } else {
        if (ch == 0) {
#pragma unroll
            for (int k = 0; k < 64; ++k) s[k] = 0.f;
        } else { const float* src = PQ + ((size_t)((bh * RCH + ch - 1) * 2)) * 4096 + lane * 64;
#pragma unroll
            for (int k4 = 0; k4 < 16; ++k4) { const f32x4 v = *(const f32x4*)(src + 4 * k4); s[4 * k4] = v.x; s[4 * k4 + 1] = v.y; s[4 * k4 + 2] = v.z; s[4 * k4 + 3] = v.w; }
        }
    }
    RwRaw raw; rw_load_raw<MODE>(raw, pa, pk, pe, pr, tok0, col);
    rw_process<MODE>(raw, buf, lane, kk_c, ka_c, rk_c);
    constexpr int NBLK = RL / RBLK;
#pragma unroll 1
    for (int blk = 0; blk < NBLK; ++blk) {
        LAS float* cur = buf + (blk & 1) * (RBLK * RVEC); LAS float* nxt = buf + ((blk + 1) & 1) * (RBLK * RVEC);
        const size_t tb = tok0 + (size_t)blk * RBLK;
        rw_load_raw<MODE>(raw, pa, pk, pe, pr, tok0 + (size_t)(blk + 1 < NBLK ? blk + 1 : blk) * RBLK, col);
        float vv[RBLK], gg[RBLK];
#pragma unroll
        for (int i = 0; i < RBLK; ++i) { vv[i] = (MODE != 1) ? bf1(pv[(tb + i) * 512 + col]) : 0.f; gg[i] = (MODE == 2) ? bf1(pg[(tb + i) * 512 + col]) : 0.f; }
#pragma unroll
        for (int i = 0; i < RBLK; ++i) {
            const LAS float* sv = cur + i * RVEC;
            __builtin_amdgcn_sched_barrier(0);
            float sa = 0.f;
#pragma unroll
            for (int k4 = 0; k4 < 16; ++k4) { if ((k4 & 3) == 0) __builtin_amdgcn_sched_barrier(0); const f32x4 nk = *(const LAS f32x4*)(sv + 64 + 4 * k4);
                sa = fmaf(s[4 * k4], nk.x, sa); sa = fmaf(s[4 * k4 + 1], nk.y, sa); sa = fmaf(s[4 * k4 + 2], nk.z, sa); sa = fmaf(s[4 * k4 + 3], nk.w, sa); }
            asm volatile("" : "+v"(sa));
            float y = 0.f;
#pragma unroll
            for (int k4 = 0; k4 < 16; ++k4) {
                if ((k4 & 3) == 0) __builtin_amdgcn_sched_barrier(0);
                const f32x4 w = *(const LAS f32x4*)(sv + 4 * k4), ka = *(const LAS f32x4*)(sv + 128 + 4 * k4);
                float t0 = fmaf(sa, ka.x, s[4 * k4] * w.x), t1 = fmaf(sa, ka.y, s[4 * k4 + 1] * w.y), t2 = fmaf(sa, ka.z, s[4 * k4 + 2] * w.z), t3 = fmaf(sa, ka.w, s[4 * k4 + 3] * w.w);
                if (MODE != 1) { const f32x4 kx = *(const LAS f32x4*)(sv + 192 + 4 * k4); t0 = fmaf(vv[i], kx.x, t0); t1 = fmaf(vv[i], kx.y, t1); t2 = fmaf(vv[i], kx.z, t2); t3 = fmaf(vv[i], kx.w, t3); }
                s[4 * k4] = t0; s[4 * k4 + 1] = t1; s[4 * k4 + 2] = t2; s[4 * k4 + 3] = t3;
                asm volatile("" : "+v"(s[4 * k4]), "+v"(s[4 * k4 + 1]), "+v"(s[4 * k4 + 2]), "+v"(s[4 * k4 + 3]));
                if (MODE == 2) { const f32x4 r = *(const LAS f32x4*)(sv + 256 + 4 * k4); y = fmaf(t0, r.x, y); y = fmaf(t1, r.y, y); y = fmaf(t2, r.z, y); y = fmaf(t3, r.w, y); }
            }
            if (MODE == 2) {
                const float mean = wave_sum(y) * (1.0f / 64.0f); const float dy = y - mean; const float var = wave_sum(dy * dy) * (1.0f / 64.0f);
                const float yn = dy * rsqrtf(var + 64e-5f) * lng + lnb; const float bc = sv[320];
                yo[(tb + i) * 512 + col] = (bf16_t)f2bf((yn + bc * vv[i]) * gg[i]);
            }
        }
        rw_process<MODE>(raw, nxt, lane, kk_c, ka_c, rk_c);
    }
    if (MODE != 2) { float* dst = PQ + ((size_t)((bh * RCH + ch) * 2 + MODE)) * 4096 + lane * 64;
#pragma unroll
        for (int k4 = 0; k4 < 16; ++k4) *(f32x4*)(dst + 4 * k4) = (f32x4){s[4 * k4], s[4 * k4 + 1], s[4 * k4 + 2], s[4 * k4 + 3]}; }
}
__device__ __forceinline__ void p4_rwkv_pass1(const Ctx& C) {
    for (int task = C.gw; task < 32 * (RCH - 1) * 2; task += C.ngw) { const int mode = task & 1, r = task >> 1, ch = r % (RCH - 1), bh = r / (RCH - 1);
        if (mode == 0) rw_task<0>(C, bh, ch); else rw_task<1>(C, bh, ch); }
}
__device__ __forceinline__ void p6_rwkv_pass3(const Ctx& C) {
    for (int task = C.gw; task < 32 * RCH; task += C.ngw) rw_task<2>(C, task / RCH, task % RCH);
}
__device__ __forceinline__ void p5_rwkv_carry(const Ctx& C) {
    float* PQ = (float*)(C.dout + DO_PQ); const int lane = C.lane, wave = C.wave;
    LAS float* ST = (LAS float*)C.lds;
    for (int bh = blockIdx.x; bh < 32; bh += C.G) {
        for (int i = C.tid; i < 4096; i += NTHREADS) ST[i] = 0.f;
        __syncthreads();
        for (int ch = 0; ch < RCH - 1; ++ch) {
            LAS float* cur = ST + (ch & 1) * 4096; LAS float* nxt = ST + ((ch + 1) & 1) * 4096;
            float* Q = PQ + ((size_t)((bh * RCH + ch) * 2)) * 4096; const float* P = Q + 4096;
            const f32x4 q0 = *(const f32x4*)(Q + lane * 64 + 8 * wave), q1 = *(const f32x4*)(Q + lane * 64 + 8 * wave + 4);
            float acc[8] = {q0.x, q0.y, q0.z, q0.w, q1.x, q1.y, q1.z, q1.w};
#pragma unroll 8
            for (int j = 0; j < 64; ++j) { const float sj = cur[j * 64 + lane]; const f32x4 p0 = *(const f32x4*)(P + j * 64 + 8 * wave), p1 = *(const f32x4*)(P + j * 64 + 8 * wave + 4);
                acc[0] = fmaf(sj, p0.x, acc[0]); acc[1] = fmaf(sj, p0.y, acc[1]); acc[2] = fmaf(sj, p0.z, acc[2]); acc[3] = fmaf(sj, p0.w, acc[3]);
                acc[4] = fmaf(sj, p1.x, acc[4]); acc[5] = fmaf(sj, p1.y, acc[5]); acc[6] = fmaf(sj, p1.z, acc[6]); acc[7] = fmaf(sj, p1.w, acc[7]); }
            *(f32x4*)(Q + lane * 64 + 8 * wave) = (f32x4){acc[0], acc[1], acc[2], acc[3]}; *(f32x4*)(Q + lane * 64 + 8 * wave + 4) = (f32x4){acc[4], acc[5], acc[6], acc[7]};
#pragma unroll
            for (int kk = 0; kk < 8; ++kk) nxt[(8 * wave + kk) * 64 + lane] = acc[kk];
            __syncthreads();
        }
    }
}

__device__ __forceinline__ void p8_ln1(const Ctx& C) {
    const float* pre = (const float*)C.dout; float* x1 = (float*)(C.ws + WS_X1); bf16_t* x1b = (bf16_t*)(C.ws + WS_X1B); const int lane = C.lane;
    const float* gam = C.in[26]; const float* bet = C.in[27];
    for (int t = C.gw; t < T; t += C.ngw) {
        const float* p = pre + (size_t)t * 1024; float v[16];
#pragma unroll
        for (int hh = 0; hh < 2; ++hh) { const f32x4 a = *(const f32x4*)(p + hh * 512 + 8 * lane), b = *(const f32x4*)(p + hh * 512 + 8 * lane + 4);
            v[8 * hh] = a.x; v[8 * hh + 1] = a.y; v[8 * hh + 2] = a.z; v[8 * hh + 3] = a.w; v[8 * hh + 4] = b.x; v[8 * hh + 5] = b.y; v[8 * hh + 6] = b.z; v[8 * hh + 7] = b.w; }
        float s = 0.f;
#pragma unroll
        for (int j = 0; j < 16; ++j) s += v[j];
        const float mean = wave_sum(s) * (1.0f / 1024.0f); float s2 = 0.f;
#pragma unroll
        for (int j = 0; j < 16; ++j) { v[j] -= mean; s2 += v[j] * v[j]; }
        const float rstd = rsqrtf(wave_sum(s2) * (1.0f / 1024.0f) + 1e-5f);
#pragma unroll
        for (int hh = 0; hh < 2; ++hh) { const int c0 = hh * 512 + 8 * lane; float o[8];
#pragma unroll
            for (int j = 0; j < 8; ++j) o[j] = v[8 * hh + j] * rstd * gam[c0 + j] + bet[c0 + j];
            *(f32x4*)(x1 + (size_t)t * 1024 + c0) = (f32x4){o[0], o[1], o[2], o[3]}; *(f32x4*)(x1 + (size_t)t * 1024 + c0 + 4) = (f32x4){o[4], o[5], o[6], o[7]};
            *(u32x4*)(x1b + (size_t)t * 1024 + c0) = pack8(o); }
    }
    cvt_rows(C.in[30], (bf16_t*)(C.ws + WS_UB), (size_t)16384 * 1024 / 8, C.gt, C.ngt);
    cvt_rows(C.in[31], (bf16_t*)(C.ws + WS_VB), (size_t)16384 * 1024 / 8, C.gt, C.ngt);
}

__device__ __forceinline__ void p10_peer_route(const Ctx& C) {
    unsigned char* ws = C.ws; const int lane = C.lane, g = lane >> 4, fr = lane & 15;
    const bf16_t* qp = (const bf16_t*)C.dout; const bf16_t* keys = (const bf16_t*)(ws + WS_KEYS);
    int* experts = (int*)(ws + WS_EXPERTS); float* pgates = (float*)(ws + WS_PGATES);
    LAS float* SUB = (LAS float*)(C.lds + C.wave * 16384);
    for (int task = C.gw; task < T / 2; task += C.ngw) {
        const int t0 = task * 2;
#pragma unroll
        for (int p = 0; p < 2; ++p) {
            bf16x8 A[4];
#pragma unroll
            for (int kk = 0; kk < 4; ++kk) A[kk] = *(const bf16x8*)(qp + (size_t)(t0 + (fr >> 3)) * 2048 + (fr & 7) * 256 + p * 128 + 32 * kk + 8 * g);
#pragma unroll
            for (int i = 0; i < 8; ++i) { f32x4 acc = (f32x4){0.f, 0.f, 0.f, 0.f};
#pragma unroll
                for (int kk = 0; kk < 4; ++kk) { const bf16x8 Bk = *(const bf16x8*)(keys + (size_t)(p * 128 + 16 * i + fr) * 128 + 32 * kk + 8 * g);
                    acc = __builtin_amdgcn_mfma_f32_16x16x32_bf16(A[kk], Bk, acc, 0, 0, 0); }
#pragma unroll
                for (int r = 0; r < 4; ++r) SUB[(p * 16 + 4 * g + r) * 128 + 16 * i + fr] = acc[r]; }
        }
        for (int row = 0; row < 16; ++row) {
            float sv[2]; int si[2];
            float s1 = 0.f, s2 = 0.f; int i1 = 0, i2 = 0;
#pragma unroll
            for (int p = 0; p < 2; ++p) {
                const float va = SUB[(p * 16 + row) * 128 + lane], vb = SUB[(p * 16 + row) * 128 + 64 + lane];
                unsigned uk[2] = {f2key(va), f2key(vb)};
                const unsigned Tk = kth_largest<2>(uk, 16);
                int cgt = 0;
#pragma unroll
                for (int jj = 0; jj < 2; ++jj) cgt += __popcll(__ballot(uk[jj] > Tk));
                const int need = 16 - cgt; int eqb = 0, pos = 0; float selv = 0.f; int seli = 0;
#pragma unroll
                for (int jj = 0; jj < 2; ++jj) {
                    const bool gt = uk[jj] > Tk, eq = uk[jj] == Tk; const unsigned long long me = __ballot(eq);
                    const int er = eqb + (int)__builtin_amdgcn_mbcnt_hi((unsigned)(me >> 32), __builtin_amdgcn_mbcnt_lo((unsigned)me, 0u));
                    const bool take = gt || (eq && er < need); eqb += __popcll(me);
                    const unsigned long long mt = __ballot(take);
                    const int pr = pos + (int)__builtin_amdgcn_mbcnt_hi((unsigned)(mt >> 32), __builtin_amdgcn_mbcnt_lo((unsigned)mt, 0u));
                    const float pv = __builtin_bit_cast(float, __builtin_amdgcn_ds_permute(4 * (take ? pr : 63), __builtin_bit_cast(int, jj == 0 ? va : vb)));
                    const int pi = __builtin_amdgcn_ds_permute(4 * (take ? pr : 63), jj * 64 + lane);
                    const int cntj = __popcll(mt);
                    if (lane >= pos && lane < pos + cntj) { selv = pv; seli = pi; }
                    pos += cntj;
                }
                sv[p] = selv; si[p] = seli;
            }
            s1 = sv[0]; i1 = si[0]; s2 = sv[1]; i2 = si[1];
            float cv[4]; unsigned ck[4];
#pragma unroll
            for (int m = 0; m < 4; ++m) { const int c = lane + 64 * m; cv[m] = __shfl(s1, c >> 4) + __shfl(s2, c & 15); ck[m] = f2key(cv[m]); }
            const unsigned Tk = kth_largest<4>(ck, 16);
            int cgt = 0;
#pragma unroll
            for (int m = 0; m < 4; ++m) cgt += __popcll(__ballot(ck[m] > Tk));
            const int need = 16 - cgt; int eqb = 0, pos = 0; float fs = 0.f; int fe = 0;
#pragma unroll
            for (int m = 0; m < 4; ++m) {
                const bool gt = ck[m] > Tk, eq = ck[m] == Tk; const unsigned long long me = __ballot(eq);
                const int er = eqb + (int)__builtin_amdgcn_mbcnt_hi((unsigned)(me >> 32), __builtin_amdgcn_mbcnt_lo((unsigned)me, 0u));
                const bool take = gt || (eq && er < need); eqb += __popcll(me);
                const unsigned long long mt = __ballot(take);
                const int pr = pos + (int)__builtin_amdgcn_mbcnt_hi((unsigned)(mt >> 32), __builtin_amdgcn_mbcnt_lo((unsigned)mt, 0u));
                const int c = lane + 64 * m; const int ex = __shfl(i1, c >> 4) * 128 + __shfl(i2, c & 15);
                const float pv = __builtin_bit_cast(float, __builtin_amdgcn_ds_permute(4 * (take ? pr : 63), __builtin_bit_cast(int, cv[m])));
                const int pe = __builtin_amdgcn_ds_permute(4 * (take ? pr : 63), ex);
                const int cntj = __popcll(mt);
                if (lane >= pos && lane < pos + cntj) { fs = pv; fe = pe; }
                pos += cntj;
            }
            float mx = lane < 16 ? fs : -INFINITY;
#pragma unroll
            for (int o = 1; o < 16; o <<= 1) mx = fmaxf(mx, __shfl_xor(mx, o));
            float ev = lane < 16 ? __expf(fs - mx) : 0.f; float sm = ev;
#pragma unroll
            for (int o = 1; o < 16; o <<= 1) sm += __shfl_xor(sm, o);
            if (lane < 16) { const size_t o = (size_t)(t0 + (row >> 3)) * 128 + (row & 7) * 16 + lane; experts[o] = fe; pgates[o] = ev / sm; }
        }
    }
}

__device__ __forceinline__ float gelu_erf(float x) { return 0.5f * x * (1.0f + erff(x * 0.7071067811865476f)); }
__device__ __forceinline__ void p11_peer_experts(const Ctx& C) {
    unsigned char* ws = C.ws; const int lane = C.lane, g = lane >> 4, fr = lane & 15;
    const bf16_t* x1b = (const bf16_t*)(ws + WS_X1B); const float* x1 = (const float*)(ws + WS_X1);
    const bf16_t* ub = (const bf16_t*)(ws + WS_UB); const bf16_t* vb = (const bf16_t*)(ws + WS_VB);
    const int* experts = (const int*)(ws + WS_EXPERTS); const float* pgates = (const float*)(ws + WS_PGATES);
    float* out = (float*)C.dout; const float* gam = C.in[32]; const float* bet = C.in[33];
    LAS unsigned char* my = C.lds + C.wave * 4096;
    LAS float* cf = (LAS float*)(my + 2048); LAS int* eidl = (LAS int*)(my + 2560);
    for (int t = C.gw; t < T; t += C.ngw) {
        { const u32x4 a = *(const u32x4*)(x1b + (size_t)t * 1024 + 16 * lane), b = *(const u32x4*)(x1b + (size_t)t * 1024 + 16 * lane + 8);
          *(LAS u32x4*)(my + 32 * lane) = a; *(LAS u32x4*)(my + 32 * lane + 16) = b; }
        { const int e0 = experts[(size_t)t * 128 + lane], e1 = experts[(size_t)t * 128 + 64 + lane]; eidl[lane] = e0; eidl[64 + lane] = e1; }
        asm volatile("s_waitcnt lgkmcnt(0)" ::: "memory");
#pragma unroll 1
        for (int i = 0; i < 8; ++i) {
            const int e = eidl[16 * i + fr]; const bf16_t* urow = ub + (size_t)e * 1024 + 16 * g;
            f32x4 acc = (f32x4){0.f, 0.f, 0.f, 0.f};
#pragma unroll 4
            for (int m = 0; m < 16; ++m) {
                const bf16x8 a0 = *(const bf16x8*)(urow + 64 * m), a1 = *(const bf16x8*)(urow + 64 * m + 8);
                const bf16x8 b0 = *(const LAS bf16x8*)(my + 2 * (64 * m + 16 * g)), b1 = *(const LAS bf16x8*)(my + 2 * (64 * m + 16 * g + 8));
                acc = __builtin_amdgcn_mfma_f32_16x16x32_bf16(a0, b0, acc, 0, 0, 0);
                acc = __builtin_amdgcn_mfma_f32_16x16x32_bf16(a1, b1, acc, 0, 0, 0);
            }
            const f32x4 pg = *(const f32x4*)(pgates + (size_t)t * 128 + 16 * i + 4 * g);
            if (fr == 0) { *(LAS f32x4*)(cf + 16 * i + 4 * g) = (f32x4){pg.x * gelu_erf(acc[0]), pg.y * gelu_erf(acc[1]), pg.z * gelu_erf(acc[2]), pg.w * gelu_erf(acc[3])}; }
        }
        asm volatile("s_waitcnt lgkmcnt(0)" ::: "memory");
        float o[16];
#pragma unroll
        for (int j = 0; j < 16; ++j) o[j] = 0.f;
#pragma unroll 4
        for (int k = 0; k < 128; ++k) {
            const int e = __builtin_amdgcn_readfirstlane(eidl[k]); const float c = cf[k];
            const bf16_t* vrow = vb + (size_t)e * 1024;
            float a[8], b[8]; unpack8(*(const u32x4*)(vrow + 8 * lane), a); unpack8(*(const u32x4*)(vrow + 512 + 8 * lane), b);
#pragma unroll
            for (int j = 0; j < 8; ++j) { o[j] = fmaf(c, a[j], o[j]); o[8 + j] = fmaf(c, b[j], o[8 + j]); }
        }
        float s = 0.f;
#pragma unroll
        for (int hh = 0; hh < 2; ++hh) { const float* xp = x1 + (size_t)t * 1024 + hh * 512 + 8 * lane; const f32x4 a = *(const f32x4*)xp, b = *(const f32x4*)(xp + 4);
            o[8 * hh] += ALPHA * a.x; o[8 * hh + 1] += ALPHA * a.y; o[8 * hh + 2] += ALPHA * a.z; o[8 * hh + 3] += ALPHA * a.w;
            o[8 * hh + 4] += ALPHA * b.x; o[8 * hh + 5] += ALPHA * b.y; o[8 * hh + 6] += ALPHA * b.z; o[8 * hh + 7] += ALPHA * b.w; }
#pragma unroll
        for (int j = 0; j < 16; ++j) s += o[j];
        const float mean = wave_sum(s) * (1.0f / 1024.0f); float s2 = 0.f;
#pragma unroll
        for (int j = 0; j < 16; ++j) { o[j] -= mean; s2 += o[j] * o[j]; }
        const float rstd = rsqrtf(wave_sum(s2) * (1.0f / 1024.0f) + 1e-5f);
#pragma unroll
        for (int hh = 0; hh < 2; ++hh) { const int c0 = hh * 512 + 8 * lane; float r[8];
#pragma unroll
            for (int j = 0; j < 8; ++j) r[j] = o[8 * hh + j] * rstd * gam[c0 + j] + bet[c0 + j];
            *(f32x4*)(out + (size_t)t * 1024 + c0) = (f32x4){r[0], r[1], r[2], r[3]}; *(f32x4*)(out + (size_t)t * 1024 + c0 + 4) = (f32x4){r[4], r[5], r[6], r[7]}; }
    }
}

constexpr int LDS_BYTES = 147456;
constexpr int LDS_MISC = 131072;
constexpr int NPHASE = 14;
constexpr int CW_BAR = 4096;

__global__ void __launch_bounds__(NTHREADS, 2) hybrid_fwd(Args args) {
    extern __shared__ __attribute__((aligned(16))) unsigned char lds_raw[];
    Ctx C;
    C.lds = (LAS unsigned char*)lds_raw;
    C.tid = threadIdx.x; C.lane = C.tid & 63; C.wave = __builtin_amdgcn_readfirstlane(C.tid >> 6);
    C.G = gridDim.x; C.gw = blockIdx.x * NWAVES + C.wave; C.ngw = C.G * NWAVES; C.gt = blockIdx.x * NTHREADS + C.tid; C.ngt = C.G * NTHREADS;
    C.in = args.in; C.ws = args.ws; C.dout = (unsigned char*)args.out;
    unsigned char* ws = args.ws; const float* const* in = args.in;
    volatile LAS unsigned* MISC = (volatile LAS unsigned*)(C.lds + LDS_MISC);
    if (C.tid < 64) MISC[C.tid] = 0u;
    __syncthreads();
    XcdBarrier bar; bar.bar = (unsigned*)(ws + WS_CTL) + CW_BAR; bar.x = 0; bar.st = nullptr;
    if (MK_N_LAUNCHES == 1) bar = xcd_barrier_post((unsigned*)(ws + WS_CTL) + CW_BAR, MISC + 8);
    const int lo = args.ph_lo, hi = args.ph_hi;
#define IN(k) (lo <= (k) && (k) < hi)
#define SEAM(k) do { if (IN(k) && IN((k) + 1)) xcd_barrier(bar); } while (0)
    bf16_t* xb = (bf16_t*)(C.dout + DO_XB);

    if (IN(0)) { p0_prologue(C); } SEAM(0);
    if (IN(1)) {
        { pg8::Gemm gm{xb, (const bf16_t*)(ws + WS_WIN), T, 2816, 1024}; pg8::StaticOrder S; S.init(T, 2816, C.G, (int)blockIdx.x);
          EpiP1 E{(float*)(ws + WS_CSMALL), (bf16_t*)(ws + WS_RCOLS), (bf16_t*)(ws + WS_MEMQ)}; pg8::gemm_phase(C.lds, gm, S, E); }
        { pg8::Gemm gm{(const bf16_t*)(ws + WS_MEMB), (const bf16_t*)(ws + WS_WMEMKV), 1024, 1024, 1024}; pg8::StaticOrder S; S.init(1024, 1024, C.G, (int)blockIdx.x);
          EpiMemKV E{(bf16_t*)(ws + WS_KMEM), (bf16_t*)(ws + WS_VMEMT)}; pg8::gemm_phase(C.lds, gm, S, E); }
    } SEAM(1);
    if (IN(2)) { p2_prep(C); } SEAM(2);
    if (IN(3)) {
        { pg8::Gemm gm{(const bf16_t*)(ws + WS_LORAA), (const bf16_t*)(ws + WS_WLORA), T, 1536, 256}; pg8::StaticOrder S; S.init(T, 1536, C.G, (int)blockIdx.x);
          EpiLora E{(bf16_t*)(ws + WS_RW_E), (bf16_t*)(ws + WS_RW_A), (bf16_t*)(ws + WS_RW_G), in[11], in[13]}; pg8::gemm_phase(C.lds, gm, S, E); }
        { pg8::Gemm gm{(const bf16_t*)(ws + WS_CQN), (const bf16_t*)(ws + WS_WQ), T, 1280, 256}; pg8::StaticOrder S; S.init(T, 1280, C.G, (int)blockIdx.x);
          EpiQ E{(bf16_t*)(ws + WS_QLAT), (bf16_t*)(ws + WS_QIDX)}; pg8::gemm_phase(C.lds, gm, S, E); }
    } SEAM(3);
    if (IN(4)) { p4_indexer(C); p4_memattn(C); __syncthreads(); p4_rwkv_pass1(C); } SEAM(4);
    if (IN(5)) { p5_rwkv_carry(C); __syncthreads(); p5_dsa_attn(C); } SEAM(5);
    if (IN(6)) { p6_rwkv_pass3(C); } SEAM(6);
    if (IN(7)) {
        pg8::Gemm gm{xb, (const bf16_t*)(ws + WS_WG), T, 3072, 1024}; pg8::StaticOrder S; S.init(T, 3072, C.G, (int)blockIdx.x);
        EpiGates E{(bf16_t*)(ws + WS_GATES)}; pg8::gemm_phase(C.lds, gm, S, E);
    } SEAM(7);
    if (IN(8)) {
        float* mf = (float*)C.dout; const bf16_t* gt = (const bf16_t*)(ws + WS_GATES); bf16_t* mb = (bf16_t*)(ws + WS_MERGEDB);
        { pg8::Gemm gm{(const bf16_t*)(ws + WS_OLAT), (const bf16_t*)(ws + WS_WOV), T, 1024, 1024}; pg8::StaticOrder S; S.init(T, 1024, C.G, (int)blockIdx.x);
          EpiMerge<0> E{gt, mf, mb}; pg8::gemm_phase(C.lds, gm, S, E); }
        { pg8::Gemm gm{(const bf16_t*)(ws + WS_YRWKV), (const bf16_t*)(ws + WS_WBRR), T, 1024, 512}; pg8::StaticOrder S; S.init(T, 1024, C.G, (int)blockIdx.x);
          EpiMerge<1> E{gt, mf, mb}; pg8::gemm_phase(C.lds, gm, S, E); }
        { pg8::Gemm gm{(const bf16_t*)(ws + WS_YMEM), (const bf16_t*)(ws + WS_WBRM), T, 1024, 512}; pg8::StaticOrder S; S.init(T, 1024, C.G, (int)blockIdx.x);
          EpiMerge<2> E{gt, mf, mb}; pg8::gemm_phase(C.lds, gm, S, E); }
    } SEAM(8);
    if (IN(9)) {
        pg8::Gemm gm{(const bf16_t*)(ws + WS_MERGEDB), (const bf16_t*)(ws + WS_WOUT), T, 1024, 1024}; pg8::StaticOrder S; S.init(T, 1024, C.G, (int)blockIdx.x);
        EpiWout E{in[0], (float*)C.dout}; pg8::gemm_phase(C.lds, gm, S, E);
    } SEAM(9);
    if (IN(10)) { p8_ln1(C); } SEAM(10);
    if (IN(11)) {
        pg8::Gemm gm{(const bf16_t*)(ws + WS_X1B), (const bf16_t*)(ws + WS_WPEER), T, 2048, 1024}; pg8::StaticOrder S; S.init(T, 2048, C.G, (int)blockIdx.x);
        EpiPeerQ E{(bf16_t*)C.dout}; pg8::gemm_phase(C.lds, gm, S, E);
    } SEAM(11);
    if (IN(12)) { p10_peer_route(C); } SEAM(12);
    if (IN(13)) { p11_peer_experts(C); }
#undef IN
#undef SEAM
}

extern "C" void kernel_launch(void* const* d_in, const int* in_sizes, int n_in, void* d_out, int out_size, void* d_ws, size_t ws_size, hipStream_t stream) {
    static int grid = 0;
    if (grid == 0) {
        if (n_in != 34 || out_size != T * D || ws_size < WS_END) { fprintf(stderr, "kernel_launch: unexpected problem (n_in %d out %d ws %zu)\n", n_in, out_size, ws_size); grid = -1; return; }
        int dev = 0, cus = 0, per_cu = 0;
        if (hipGetDevice(&dev) != hipSuccess || hipDeviceGetAttribute(&cus, hipDeviceAttributeMultiprocessorCount, dev) != hipSuccess) { grid = -1; return; }
        if (hipFuncSetAttribute((const void*)hybrid_fwd, hipFuncAttributeMaxDynamicSharedMemorySize, LDS_BYTES) != hipSuccess) { fprintf(stderr, "kernel_launch: hipFuncSetAttribute failed\n"); grid = -1; return; }
        if (hipOccupancyMaxActiveBlocksPerMultiprocessor(&per_cu, (const void*)hybrid_fwd, NTHREADS, LDS_BYTES) != hipSuccess || per_cu < 1) { fprintf(stderr, "kernel_launch: occupancy query says %d\n", per_cu); }
        (void)hipGetLastError();
        grid = cus;
    }
    if (grid < 0) return;
    (void)hipMemsetAsync((char*)d_ws + WS_CTL, 0, 1 * MiB, stream);
    Args a{};
    for (int i = 0; i < 34; ++i) a.in[i] = (const float*)d_in[i];
    a.out = (float*)d_out; a.ws = (unsigned char*)d_ws; a.li = 0; a.pad = 0;
    if (MK_N_LAUNCHES == 1) { a.ph_lo = 0; a.ph_hi = NPHASE; hipLaunchKernelGGL(hybrid_fwd, dim3(grid), dim3(NTHREADS), LDS_BYTES, stream, a); }
    else for (int p = 0; p < NPHASE; ++p) { a.ph_lo = p; a.ph_hi = p + 1; a.li = p; hipLaunchKernelGGL(hybrid_fwd, dim3(grid), dim3(NTHREADS), LDS_BYTES, stream, a); }
}
```

```cpp
#include <hip/hip_runtime.h>
#include <stdint.h>
#include <stdio.h>

#ifndef MK_N_LAUNCHES
#define MK_N_LAUNCHES 1
#endif

#ifndef PROBE_MASK
#define PROBE_MASK 0
#endif
#define LAS __attribute__((address_space(3)))
typedef unsigned short bf16_t;
typedef short bf16x8 __attribute__((ext_vector_type(8)));
typedef float f32x4 __attribute__((ext_vector_type(4)));
typedef float f32x2 __attribute__((ext_vector_type(2)));
typedef unsigned u32x4 __attribute__((ext_vector_type(4)));
typedef unsigned u32x2 __attribute__((ext_vector_type(2)));

constexpr int NB = 4, SEQ = 4096, T = NB * SEQ, D = 1024;
constexpr int IN_W = 5800;
constexpr int RW = 512;
constexpr int NWAVES = 8, NTHREADS = 512;
constexpr float ALPHA = 1.189207115002721f;
constexpr int RCH = 64, RL = SEQ / RCH;

constexpr size_t MiB = 1u << 20;
constexpr size_t WS_CTL = 0;
constexpr size_t WS_WIN = 1 * MiB, WS_WG = 7 * MiB, WS_WLORA = 13 * MiB, WS_WQ = 14 * MiB, WS_WMEMKV = 15 * MiB, WS_WOV = 17 * MiB,
                 WS_WBRR = 19 * MiB, WS_WBRM = 20 * MiB, WS_WOUT = 21 * MiB, WS_WPEER = 23 * MiB, WS_KEYS = 27 * MiB;
constexpr size_t WS_CSMALL = 29 * MiB, WS_QLAT = 29 * MiB, WS_MERGEDB = 29 * MiB, WS_UB = 29 * MiB;
constexpr size_t WS_RCOLS = 61 * MiB, WS_QIDX = 61 * MiB, WS_YMEM = 69 * MiB, WS_OLAT = 85 * MiB, WS_VB = 61 * MiB, WS_EXPERTS = 93 * MiB, WS_PGATES = 101 * MiB;
constexpr size_t WS_MEMQ = 117 * MiB, WS_YRWKV = 117 * MiB;
constexpr size_t WS_RW_R = 133 * MiB, WS_RW_K = 149 * MiB, WS_RW_V = 165 * MiB, WS_RW_A = 181 * MiB, WS_RW_E = 197 * MiB, WS_RW_G = 213 * MiB;
constexpr size_t WS_GATES = 133 * MiB, WS_X1B = 133 * MiB, WS_X1 = 165 * MiB;
constexpr size_t WS_CQN = 229 * MiB, WS_KVL = 237 * MiB, WS_KIDX = 241 * MiB, WS_WIDX = 242 * MiB, WS_LORAA = 243 * MiB, WS_IDX = 243 * MiB,
                 WS_KMEM = 251 * MiB, WS_VMEMT = 252 * MiB, WS_MEMB = 253 * MiB, WS_END = 256 * MiB;
constexpr size_t DO_XB = 0, DO_PQ = 0;
constexpr size_t WS_XB2 = 29 * MiB;
constexpr int CW_DSAQ = 64;

__device__ __forceinline__ unsigned f2bf(float f) { unsigned u = __float_as_uint(f); return (u + 0x7fffu + ((u >> 16) & 1u)) >> 16; }
__device__ __forceinline__ unsigned pk2(float lo, float hi) { return f2bf(lo) | (f2bf(hi) << 16); }
__device__ __forceinline__ float bflo(unsigned w) { return __uint_as_float(w << 16); }
__device__ __forceinline__ float bfhi(unsigned w) { return __uint_as_float(w & 0xffff0000u); }
__device__ __forceinline__ float bf1(bf16_t h) { return __uint_as_float(((unsigned)h) << 16); }
template <int CTRL, int RM = 0xF> __device__ __forceinline__ float dpp_f(float v) { return __builtin_bit_cast(float, __builtin_amdgcn_update_dpp(0, __builtin_bit_cast(int, v), CTRL, RM, 0xF, false)); }
template <int CTRL> __device__ __forceinline__ unsigned dpp_u(unsigned v) { return (unsigned)__builtin_amdgcn_update_dpp(0, (int)v, CTRL, 0xF, 0xF, false); }
__device__ __forceinline__ float wave_sum(float v) {
    v += dpp_f<0x111>(v); v += dpp_f<0x112>(v); v += dpp_f<0x114>(v); v += dpp_f<0x118>(v);
    v += dpp_f<0x142, 0xA>(v); v += dpp_f<0x143, 0xC>(v);
    return __builtin_bit_cast(float, __builtin_amdgcn_readlane(__builtin_bit_cast(int, v), 63));
}
__device__ __forceinline__ unsigned row_max_u(unsigned x) {
    unsigned y = dpp_u<0x128>(x); x = x > y ? x : y; y = dpp_u<0x124>(x); x = x > y ? x : y; y = dpp_u<0x122>(x); x = x > y ? x : y; y = dpp_u<0x121>(x); x = x > y ? x : y; return x; }
__device__ __forceinline__ float row_sum_f(float x) { x += dpp_f<0x128>(x); x += dpp_f<0x124>(x); x += dpp_f<0x122>(x); x += dpp_f<0x121>(x); return x; }
__device__ __forceinline__ float key2f(unsigned k) { const unsigned b = (k & 0x80000000u) ? (k & 0x7fffffffu) : ~k; return __uint_as_float(b); }
__device__ __forceinline__ float sigmoidf_(float x) { return 1.0f / (1.0f + __expf(-x)); }
__device__ __forceinline__ unsigned f2key(float f) { unsigned b = __float_as_uint(f); if (f == 0.0f) b = 0u; return (b & 0x80000000u) ? ~b : (b | 0x80000000u); }
__device__ __forceinline__ u32x4 pack8(const float* v) { u32x4 w; w.x = pk2(v[0], v[1]); w.y = pk2(v[2], v[3]); w.z = pk2(v[4], v[5]); w.w = pk2(v[6], v[7]); return w; }
__device__ __forceinline__ void unpack8(u32x4 w, float* v) { v[0] = bflo(w.x); v[1] = bfhi(w.x); v[2] = bflo(w.y); v[3] = bfhi(w.y); v[4] = bflo(w.z); v[5] = bfhi(w.z); v[6] = bflo(w.w); v[7] = bfhi(w.w); }

#define XB_TMO      128
#define XB_XCNT(j)  (256  + 64 * (j))
#define XB_XSUB(j)  (1280 + 64 * (j))
#define XB_XGEN(j)  (2304 + 64 * (j))
#define XB_TOP      3328
#define XB_TOPGEN   3392
#define XCD_BAR_WORDS 3456
#define XB_SPIN_CAP (1u << 18)

__device__ __forceinline__ unsigned xb_ld(unsigned* p)              { return __hip_atomic_load(p, __ATOMIC_RELAXED, __HIP_MEMORY_SCOPE_AGENT); }
__device__ __forceinline__ unsigned xb_add(unsigned* p, unsigned v) { return __hip_atomic_fetch_add(p, v, __ATOMIC_RELAXED, __HIP_MEMORY_SCOPE_AGENT); }
__device__ __forceinline__ unsigned xb_xcc_id() { return (unsigned)__builtin_amdgcn_s_getreg((3 << 11) | 20) & 0xFu; }
#define XB_SPIN(cond, bar) do { unsigned _sp = 0; while (cond) { __builtin_amdgcn_s_sleep(1); \
    if ((++_sp & 255u) == 0u) { if (xb_ld(&(bar)[XB_TMO])) break; if (_sp > XB_SPIN_CAP) { atomicAdd(&(bar)[XB_TMO], 1u); break; } } } } while (0)

struct XcdBarrier {
    unsigned* bar; unsigned x;
    volatile LAS unsigned* st;
};
__device__ __forceinline__ XcdBarrier xcd_barrier_post(unsigned* bar, volatile LAS unsigned* st) {
    XcdBarrier b; b.bar = bar; b.x = xb_xcc_id(); b.st = st;
    if (threadIdx.x == 0) (void)xb_add(&bar[XB_XCNT(b.x)], 1u);
    return b;
}
__device__ __forceinline__ void xcd_barrier_complete(unsigned* bar, unsigned x, unsigned& nloc, unsigned& nx) {
    const unsigned G = gridDim.x * gridDim.y * gridDim.z;
    unsigned sum, cnt, mine, sp = 0u;
    for (;;) {
        sum = 0u; cnt = 0u; mine = 0u;
#pragma unroll
        for (unsigned j = 0; j < 16; ++j) { const unsigned c = xb_ld(&bar[XB_XCNT(j)]); sum += c; cnt += (c > 0u) ? 1u : 0u; mine = (j == x) ? c : mine; }
        if (sum == G) break;
        __builtin_amdgcn_s_sleep(1);
        if ((++sp & 255u) == 0u) { if (xb_ld(&bar[XB_TMO])) break; if (sp > XB_SPIN_CAP) { atomicAdd(&bar[XB_TMO], 1u); break; } }
    }
    nloc = mine > 0u ? mine : 1u; nx = cnt > 0u ? cnt : 1u;
}
__device__ __forceinline__ void xcd_barrier(const XcdBarrier& b) {
    asm volatile("s_waitcnt vmcnt(0)" ::: "memory");
    __syncthreads();
    if (threadIdx.x == 0) {
        unsigned* bar = b.bar;
        __builtin_amdgcn_s_waitcnt(0);
        unsigned nloc = b.st[0], nx = b.st[1];
        if (nloc == 0u) { xcd_barrier_complete(bar, b.x, nloc, nx); b.st[0] = nloc; b.st[1] = nx; }
        const unsigned old = xb_add(&bar[XB_XSUB(b.x)], 1u);
        const unsigned gen = old / nloc;
        if (old + 1u == (gen + 1u) * nloc) {
            __builtin_amdgcn_fence(__ATOMIC_RELEASE, "agent");
            asm volatile("s_waitcnt vmcnt(0)" ::: "memory");
            const unsigned og = xb_add(&bar[XB_TOP], 1u);
            const unsigned tg = og / nx;
            if (og + 1u == (tg + 1u) * nx) xb_add(&bar[XB_TOPGEN], 1u);
            else XB_SPIN(xb_ld(&bar[XB_TOPGEN]) == tg, bar);
            __builtin_amdgcn_fence(__ATOMIC_ACQUIRE, "agent");
            xb_add(&bar[XB_XGEN(b.x)], 1u);
            asm volatile("s_waitcnt vmcnt(0)" ::: "memory");
        } else {
            XB_SPIN(xb_ld(&bar[XB_XGEN(b.x)]) == gen, bar);
            __builtin_amdgcn_fence(__ATOMIC_ACQUIRE, "agent");
            asm volatile("s_waitcnt vmcnt(0)" ::: "memory");
        }
    }
    __syncthreads();
}

namespace pg8 {
constexpr int BM = 256, BK = 64, HALF = 128, HTB = HALF * BK * 2, STAGE_BYTES = 8 * HTB, NXCD = 8, WGM = 8;
__device__ __forceinline__ int lds_byte(int r, int c) { const int st = (r >> 4) * 2 + (c >> 5), rr = r & 15, cc = c & 31, ob = rr * 64 + cc * 2; return st * 1024 + (ob ^ (((ob >> 9) & 1) << 5)); }
__device__ __forceinline__ void stage_rc(int b, int& R, int& C) { const int st = b / 1024, sb = b % 1024, swz = sb ^ (((sb >> 9) & 1) << 5); R = (st >> 1) * 16 + swz / 64; C = (st & 1) * 32 + (swz % 64) / 2; }
__device__ __forceinline__ int perm32(int rho) { const int n = rho >> 4, i = rho & 15; return 8 * (i >> 2) + 4 * n + (i & 3); }
struct Unit { int pm, pn; };
struct Gemm { const bf16_t* A; const bf16_t* Bt; int M, N, K; };
struct StaticOrder {
    int nM, nN, nwg, G, c;
    __device__ void init(int M, int N, int G_, int c_) { nM = M / BM; nN = N / BM; nwg = nM * nN; G = G_; c = c_; }
    __device__ bool next(int i, Unit& u) const {
        const long L = (long)i * G + c; if (L >= nwg) return false;
        int wgid = (int)L; { const int q = nwg / NXCD, r = nwg % NXCD, xcd = wgid % NXCD, off = wgid / NXCD; wgid = (xcd < r ? xcd * (q + 1) : r * (q + 1) + (xcd - r) * q) + off; }
        const int nig = WGM * nN, gid = wgid / nig, fm = gid * WGM, gsz = (nM - fm) < WGM ? (nM - fm) : WGM;
        u.pm = fm + ((wgid % nig) % gsz); u.pn = (wgid % nig) / gsz; return true;
    }
};
template <class Epi>
__device__ __forceinline__ void gemm_phase(LAS unsigned char* lds, const Gemm g, const StaticOrder& S, const Epi& E) {
    const int tid = threadIdx.x, wid = __builtin_amdgcn_readfirstlane(tid >> 6), lane = tid & 63, wr = wid >> 2, wc = wid & 3, fr = lane & 15, fq = lane >> 4;
    const int K = g.K, nt = K / BK;
    unsigned voffA[2], voffB[2];
#pragma unroll
    for (int i = 0; i < 2; ++i) { int R, C; stage_rc(tid * 16 + i * 8192, R, C); const int Rb = (R & ~31) + perm32(R & 31);
        voffA[i] = (unsigned)(R * K + C) * 2u; voffB[i] = (unsigned)(Rb * K + C) * 2u; }
    const size_t kstep = (size_t)(BK * 2);
    const size_t hstep = (size_t)HALF * K * 2;
    const size_t tstep = 2 * hstep;
    const unsigned ldsw = (unsigned)wid * 1024u;
    const int aoff = lds_byte(wr * 64 + fr, fq * 8), boff = lds_byte(wc * 32 + fr, fq * 8);
#define PG8_SA(b, h) (((b) * 2 + (h)) * HTB)
#define PG8_SB(b, h) ((4 + (b) * 2 + (h)) * HTB)
#define PG8_STAGE(bufoff, gbase, voff) do { _Pragma("unroll") for (int _i = 0; _i < 2; ++_i) \
        __builtin_amdgcn_global_load_lds((const unsigned*)((const char*)(gbase) + (voff)[_i]), (LAS unsigned*)(lds + (bufoff) + ldsw + _i * 8192), 16, 0, 0); } while (0)
#define PG8_LDA(dst, b, h) do { _Pragma("unroll") for (int m = 0; m < 4; ++m) _Pragma("unroll") for (int k = 0; k < 2; ++k) dst[m][k] = *(const LAS bf16x8*)(lds + PG8_SA(b, h) + aoff + m * 2048 + k * 1024); } while (0)
#define PG8_LDB(dst, b, h) do { _Pragma("unroll") for (int n = 0; n < 2; ++n) _Pragma("unroll") for (int k = 0; k < 2; ++k) dst[n][k] = *(const LAS bf16x8*)(lds + PG8_SB(b, h) + boff + n * 2048 + k * 1024); } while (0)
#define PG8_MMA(ai, bj, At, Bt) do { __builtin_amdgcn_s_setprio(1); _Pragma("unroll") for (int m = 0; m < 4; ++m) _Pragma("unroll") for (int n = 0; n < 2; ++n) _Pragma("unroll") for (int k = 0; k < 2; ++k) \
        acc[ai][bj][m][n] = __builtin_amdgcn_mfma_f32_16x16x32_bf16(Bt[n][k], At[m][k], acc[ai][bj][m][n], 0, 0, 0); __builtin_amdgcn_s_setprio(0); } while (0)
#define PG8_WAIT_V(n) asm volatile("s_waitcnt vmcnt(" #n ")" ::: "memory")
#define PG8_WAIT_L(n) asm volatile("s_waitcnt lgkmcnt(" #n ")" ::: "memory")
#define PG8_BAR __builtin_amdgcn_s_barrier()
#define PG8_SCHED __builtin_amdgcn_sched_barrier(0)
    Unit cur, nxt; int ui = 0;
    if (!S.next(0, cur)) return;
    f32x4 acc[2][2][4][2];
#pragma unroll
    for (int a = 0; a < 2; ++a)
#pragma unroll
        for (int b = 0; b < 2; ++b)
#pragma unroll
            for (int m = 0; m < 4; ++m)
#pragma unroll
                for (int n = 0; n < 2; ++n) acc[a][b][m][n] = (f32x4){0.f, 0.f, 0.f, 0.f};
    bf16x8 At[4][2], B0[2][2], B1[2][2];
    const char* cA = (const char*)g.A + (size_t)cur.pm * tstep; const char* cB = (const char*)g.Bt + (size_t)cur.pn * tstep;
    PG8_STAGE(PG8_SB(0, 0), cB, voffB); PG8_STAGE(PG8_SA(0, 0), cA, voffA); PG8_STAGE(PG8_SB(0, 1), cB + hstep, voffB); PG8_STAGE(PG8_SA(0, 1), cA + hstep, voffA);
    if (wr == 1) PG8_BAR;
    PG8_WAIT_V(4); PG8_BAR;
    PG8_STAGE(PG8_SB(1, 0), cB + kstep, voffB); PG8_STAGE(PG8_SA(1, 0), cA + kstep, voffA); PG8_STAGE(PG8_SB(1, 1), cB + hstep + kstep, voffB);
    PG8_WAIT_V(6); PG8_BAR;
    for (;;) {
        const bool has_next = S.next(ui + 1, nxt);
        const char* nA = has_next ? (const char*)g.A + (size_t)nxt.pm * tstep : cA; const char* nB = has_next ? (const char*)g.Bt + (size_t)nxt.pn * tstep : cB;
#pragma unroll 1
        for (int t = 0; t < nt; t += 2) {
            const bool last = (t == nt - 2);
            const char* a1 = cA + (size_t)(t + 1) * kstep;
            const char* a2 = last ? nA : cA + (size_t)(t + 2) * kstep; const char* b2 = last ? nB : cB + (size_t)(t + 2) * kstep;
            const char* a3 = a2 + kstep; const char* b3 = b2 + kstep;
            PG8_LDB(B0, 0, 0); PG8_SCHED; PG8_LDA(At, 0, 0); PG8_STAGE(PG8_SA(1, 1), a1 + hstep, voffA);
            PG8_WAIT_L(8); PG8_BAR; PG8_WAIT_L(0); PG8_MMA(0, 0, At, B0); PG8_BAR; PG8_SCHED;
            PG8_LDB(B1, 0, 1); PG8_STAGE(PG8_SB(0, 0), b2, voffB);
            PG8_BAR; PG8_WAIT_L(0); PG8_MMA(0, 1, At, B1); PG8_BAR;
            PG8_LDA(At, 0, 1); PG8_STAGE(PG8_SA(0, 0), a2, voffA);
            PG8_BAR; PG8_WAIT_L(0); PG8_MMA(1, 0, At, B0); PG8_BAR; PG8_SCHED;
            PG8_STAGE(PG8_SB(0, 1), b2 + hstep, voffB);
            PG8_WAIT_V(6); PG8_BAR; PG8_MMA(1, 1, At, B1); PG8_BAR;
            PG8_LDB(B0, 1, 0); PG8_SCHED; PG8_LDA(At, 1, 0); PG8_STAGE(PG8_SA(0, 1), a2 + hstep, voffA);
            PG8_WAIT_L(8); PG8_BAR; PG8_WAIT_L(0); PG8_MMA(0, 0, At, B0); PG8_BAR; PG8_SCHED;
            PG8_LDB(B1, 1, 1); PG8_STAGE(PG8_SB(1, 0), b3, voffB);
            PG8_BAR; PG8_WAIT_L(0); PG8_MMA(0, 1, At, B1); PG8_BAR;
            PG8_LDA(At, 1, 1); PG8_STAGE(PG8_SA(1, 0), a3, voffA);
            PG8_BAR; PG8_WAIT_L(0); PG8_MMA(1, 0, At, B0); PG8_BAR; PG8_SCHED;
            PG8_STAGE(PG8_SB(1, 1), b3 + hstep, voffB);
            PG8_WAIT_V(6); PG8_BAR; PG8_MMA(1, 1, At, B1); PG8_BAR;
        }
        {
            const int row0 = cur.pm * BM + wr * 64 + fr, col0 = cur.pn * BM + wc * 32 + 8 * fq;
#pragma unroll
            for (int ai = 0; ai < 2; ++ai)
#pragma unroll
                for (int m = 0; m < 4; ++m)
#pragma unroll
                    for (int bj = 0; bj < 2; ++bj) { E(row0 + ai * HALF + m * 16, col0 + bj * HALF, cur.pn, acc[ai][bj][m][0], acc[ai][bj][m][1]); if (Epi::SERIAL) __builtin_amdgcn_sched_barrier(0); }
        }
        if (!has_next) break;
#pragma unroll
        for (int a = 0; a < 2; ++a)
#pragma unroll
            for (int b = 0; b < 2; ++b)
#pragma unroll
                for (int m = 0; m < 4; ++m)
#pragma unroll
                    for (int n = 0; n < 2; ++n) acc[a][b][m][n] = (f32x4){0.f, 0.f, 0.f, 0.f};
        cur = nxt; cA = nA; cB = nB; ++ui;
    }
    PG8_WAIT_V(0);
    if (wr == 0) PG8_BAR;
    PG8_BAR;
#undef PG8_SA
#undef PG8_SB
#undef PG8_STAGE
#undef PG8_LDA
#undef PG8_LDB
#undef PG8_MMA
#undef PG8_WAIT_V
#undef PG8_WAIT_L
#undef PG8_BAR
#undef PG8_SCHED
}
}

struct Args { const float* in[34]; float* out; unsigned char* ws; int ph_lo, ph_hi, li, pad; };

struct Ctx {
    LAS unsigned char* lds;
    int tid, lane, wave, gw, ngw, gt, ngt, G;
    const float* const* in; unsigned char* ws; unsigned char* dout;
};

__device__ __forceinline__ void st8_bf16(bf16_t* p, f32x4 a, f32x4 b) { u32x4 w; w.x = pk2(a.x, a.y); w.y = pk2(a.z, a.w); w.z = pk2(b.x, b.y); w.w = pk2(b.z, b.w); *(u32x4*)p = w; }
struct EpiP1 { static constexpr bool SERIAL = false;
    float* cs; bf16_t* rc; bf16_t* mq;
    __device__ __forceinline__ void operator()(int row, int col, int pn, f32x4 a, f32x4 b) const {
        if (pn < 2) { float* p = cs + (size_t)row * 512 + col; *(f32x4*)p = a; *(f32x4*)(p + 4) = b; }
        else if (pn < 9) st8_bf16(rc + (size_t)row * 1792 + (col - 512), a, b);
        else st8_bf16(mq + (size_t)row * 512 + (col - 2304), a, b);
    }
};
struct EpiMemKV { static constexpr bool SERIAL = false;
    bf16_t* km; bf16_t* vt;
    __device__ __forceinline__ void operator()(int row, int col, int pn, f32x4 a, f32x4 b) const {
        const int bb = row >> 8, m = row & 255;
        if (col < 512) { const int h = col >> 7, d = col & 127; st8_bf16(km + ((size_t)((bb * 4 + h) * 256 + m)) * 128 + d, a, b); }
        else { const int c2 = col - 512, h = c2 >> 7, d = c2 & 127; bf16_t* p = vt + ((size_t)((bb * 4 + h) * 128 + d)) * 256 + m;
            p[0] = (bf16_t)f2bf(a.x); p[256] = (bf16_t)f2bf(a.y); p[512] = (bf16_t)f2bf(a.z); p[768] = (bf16_t)f2bf(a.w);
            p[1024] = (bf16_t)f2bf(b.x); p[1280] = (bf16_t)f2bf(b.y); p[1536] = (bf16_t)f2bf(b.z); p[1792] = (bf16_t)f2bf(b.w); }
    }
};
struct EpiLora { static constexpr bool SERIAL = true;
    bf16_t* e; bf16_t* a; bf16_t* g; const float* w0; const float* a0;
    __device__ __forceinline__ void operator()(int row, int col, int pn, f32x4 x, f32x4 y) const {
        float v[8] = {x.x, x.y, x.z, x.w, y.x, y.y, y.z, y.w};
        if (pn < 4) { const int c = col & 511; const float* bp = (pn < 2 ? w0 : a0) + c; const f32x4 b0 = *(const f32x4*)bp, b1 = *(const f32x4*)(bp + 4);
            const float bb[8] = {b0.x, b0.y, b0.z, b0.w, b1.x, b1.y, b1.z, b1.w}; const float sc = pn < 2 ? 0.6065306597126334f : 1.0f;
#pragma unroll
            for (int j = 0; j < 8; ++j) v[j] = sc * sigmoidf_(v[j] + bb[j]);
            *(u32x4*)((pn < 2 ? e : a) + (size_t)row * 512 + c) = pack8(v);
        } else *(u32x4*)(g + (size_t)row * 512 + (col - 1024)) = pack8(v);
    }
};
struct EpiQ { static constexpr bool SERIAL = false;
    bf16_t* ql; bf16_t* qi;
    __device__ __forceinline__ void operator()(int row, int col, int pn, f32x4 a, f32x4 b) const {
        if (pn < 4) st8_bf16(ql + (size_t)row * 1024 + col, a, b); else st8_bf16(qi + (size_t)row * 256 + (col - 1024), a, b);
    }
};
struct EpiGates { static constexpr bool SERIAL = true;
    bf16_t* o;
    __device__ __forceinline__ void operator()(int row, int col, int pn, f32x4 a, f32x4 b) const {
        float v[8] = {a.x, a.y, a.z, a.w, b.x, b.y, b.z, b.w};
#pragma unroll
        for (int j = 0; j < 8; ++j) v[j] = sigmoidf_(v[j]);
        *(u32x4*)(o + (size_t)row * 3072 + col) = pack8(v);
    }
};
template <int WHICH> struct EpiMerge { static constexpr bool SERIAL = true;
    const bf16_t* gates; float* mf; bf16_t* mb;
    __device__ __forceinline__ void operator()(int row, int col, int pn, f32x4 a, f32x4 b) const {
        float v[8] = {a.x, a.y, a.z, a.w, b.x, b.y, b.z, b.w}, gv[8];
        unpack8(*(const u32x4*)(gates + (size_t)row * 3072 + WHICH * 1024 + col), gv);
        float* p = mf + (size_t)row * 1024 + col;
        if (WHICH == 0) {
#pragma unroll
            for (int j = 0; j < 8; ++j) v[j] *= gv[j];
        } else { const f32x4 p0 = *(const f32x4*)p, p1 = *(const f32x4*)(p + 4); const float pv[8] = {p0.x, p0.y, p0.z, p0.w, p1.x, p1.y, p1.z, p1.w};
#pragma unroll
            for (int j = 0; j < 8; ++j) v[j] = pv[j] + v[j] * gv[j];
        }
        if (WHICH == 2) *(u32x4*)(mb + (size_t)row * 1024 + col) = pack8(v);
        else { *(f32x4*)p = (f32x4){v[0], v[1], v[2], v[3]}; *(f32x4*)(p + 4) = (f32x4){v[4], v[5], v[6], v[7]}; }
    }
};
struct EpiWout { static constexpr bool SERIAL = false;
    const float* x; float* pre;
    __device__ __forceinline__ void operator()(int row, int col, int pn, f32x4 a, f32x4 b) const {
        const float* xp = x + (size_t)row * 1024 + col; float* p = pre + (size_t)row * 1024 + col;
        *(f32x4*)p = *(const f32x4*)xp * ALPHA + a; *(f32x4*)(p + 4) = *(const f32x4*)(xp + 4) * ALPHA + b;
    }
};
struct EpiPeerQ { static constexpr bool SERIAL = false; bf16_t* o; __device__ __forceinline__ void operator()(int row, int col, int pn, f32x4 a, f32x4 b) const { st8_bf16(o + (size_t)row * 2048 + col, a, b); } };

template <int N, int K, class F> __device__ __forceinline__ void build_bt(bf16_t* dst, const F& f, int gt, int ngt) {
    constexpr int items = N * (K / 8);
    for (int i = gt; i < items; i += ngt) { const int n = i % N, k0 = (i / N) * 8; float v[8];
#pragma unroll
        for (int j = 0; j < 8; ++j) v[j] = f(n, k0 + j);
        *(u32x4*)(dst + (size_t)n * K + k0) = pack8(v); }
}
struct FWin { const float* w; __device__ __forceinline__ float operator()(int n, int k) const { if (n < 424) return w[(size_t)k * IN_W + n]; if (n < 512) return 0.f; return w[(size_t)k * IN_W + n - 88]; } };
struct FWg { const float* w; __device__ __forceinline__ float operator()(int n, int k) const { return w[(size_t)k * IN_W + 2728 + n]; } };
struct FLora { const float *w2, *a2, *g2; __device__ __forceinline__ float operator()(int n, int k) const {
    if (n < 512) return k < 64 ? w2[k * 512 + n] : 0.f;
    if (n < 1024) return (k >= 64 && k < 128) ? a2[(k - 64) * 512 + n - 512] : 0.f;
    return k >= 128 ? g2[(k - 128) * 512 + n - 1024] : 0.f; } };
struct FWq { const float *uq, *uk, *iq; __device__ __forceinline__ float operator()(int n, int k) const {
    if (n >= 1024) return iq[k * 256 + n - 1024];
    const int h = n >> 7, c = n & 127; const float* a = uq + (size_t)k * 512 + h * 64; const float* b = uk + (size_t)(c * 8 + h) * 64; float s = 0.f;
#pragma unroll 8
    for (int d = 0; d < 64; ++d) s = fmaf(a[d], b[d], s);
    return s * 0.125f; } };
struct FWov { const float *uv, *br; __device__ __forceinline__ float operator()(int n, int k) const {
    const int h = k >> 7, c = k & 127; const float* a = uv + (size_t)(c * 8 + h) * 64; const float* b = br + (size_t)(h * 64) * 1024 + n; float s = 0.f;
#pragma unroll 8
    for (int d = 0; d < 64; ++d) s = fmaf(a[d], b[(size_t)d * 1024], s);
    return s; } };
struct FT { const float* w; int ld; __device__ __forceinline__ float operator()(int n, int k) const { return w[(size_t)k * ld + n]; } };

__device__ __forceinline__ void cvt_rows(const float* src, bf16_t* dst, size_t n8, int gt, int ngt) {
    for (size_t i = gt; i < n8; i += ngt) { const f32x4 a = *(const f32x4*)(src + i * 8), b = *(const f32x4*)(src + i * 8 + 4); st8_bf16(dst + i * 8, a, b); }
}
__device__ __forceinline__ void p0_prologue(const Ctx& C) {
    const float* const* in = C.in; unsigned char* ws = C.ws;
    cvt_rows(in[0], (bf16_t*)(C.dout + DO_XB), (size_t)T * D / 8, C.gt, C.ngt);
    cvt_rows(in[1], (bf16_t*)(ws + WS_MEMB), (size_t)1024 * 1024 / 8, C.gt, C.ngt);
    cvt_rows(in[29], (bf16_t*)(ws + WS_KEYS), (size_t)2 * 128 * 128 / 8, C.gt, C.ngt);
    build_bt<2816, 1024>((bf16_t*)(ws + WS_WIN), FWin{in[3]}, C.gt, C.ngt);
    build_bt<3072, 1024>((bf16_t*)(ws + WS_WG), FWg{in[3]}, C.gt, C.ngt);
    build_bt<1536, 256>((bf16_t*)(ws + WS_WLORA), FLora{in[12], in[14], in[15]}, C.gt, C.ngt);
    build_bt<1280, 256>((bf16_t*)(ws + WS_WQ), FWq{in[6], in[7], in[9]}, C.gt, C.ngt);
    build_bt<1024, 1024>((bf16_t*)(ws + WS_WMEMKV), FT{in[21], 1024}, C.gt, C.ngt);
    build_bt<1024, 1024>((bf16_t*)(ws + WS_WOV), FWov{in[8], in[22]}, C.gt, C.ngt);
    build_bt<1024, 512>((bf16_t*)(ws + WS_WBRR), FT{in[23], 1024}, C.gt, C.ngt);
    build_bt<1024, 512>((bf16_t*)(ws + WS_WBRM), FT{in[24], 1024}, C.gt, C.ngt);
    build_bt<1024, 1024>((bf16_t*)(ws + WS_WOUT), FT{in[25], 1024}, C.gt, C.ngt);
    build_bt<2048, 1024>((bf16_t*)(ws + WS_WPEER), FT{in[28], 2048}, C.gt, C.ngt);
}

__device__ __forceinline__ void p2_prep(const Ctx& C) {
    const float* const* in = C.in; unsigned char* ws = C.ws; const int lane = C.lane;
    const float* csmall = (const float*)(ws + WS_CSMALL); const bf16_t* rcols = (const bf16_t*)(ws + WS_RCOLS);
    bf16_t* cqn = (bf16_t*)(ws + WS_CQN); bf16_t* kvl = (bf16_t*)(ws + WS_KVL); bf16_t* kidx = (bf16_t*)(ws + WS_KIDX); float* widx = (float*)(ws + WS_WIDX);
    bf16_t* rr = (bf16_t*)(ws + WS_RW_R); bf16_t* rk = (bf16_t*)(ws + WS_RW_K); bf16_t* rv = (bf16_t*)(ws + WS_RW_V); bf16_t* la = (bf16_t*)(ws + WS_LORAA);
    const float* mu = in[10];
    const f32x4 gq = *(const f32x4*)(in[4] + 4 * lane); const f32x2 gk = *(const f32x2*)(in[5] + 2 * lane);
    for (int t = C.gw; t < T; t += C.ngw) {
        const float* cs = csmall + (size_t)t * 512;
        {
            const f32x4 q = *(const f32x4*)(cs + 4 * lane);
            const float ss = wave_sum(q.x * q.x + q.y * q.y + q.z * q.z + q.w * q.w);
            const float rs = rsqrtf(ss * (1.0f / 256.0f) + 1e-6f);
            u32x2 w; w.x = pk2(q.x * rs * gq.x, q.y * rs * gq.y); w.y = pk2(q.z * rs * gq.z, q.w * rs * gq.w);
            *(u32x2*)(cqn + (size_t)t * 256 + 4 * lane) = w;
        }
        {
            const f32x2 k = *(const f32x2*)(cs + 256 + 2 * lane);
            const float ss = wave_sum(k.x * k.x + k.y * k.y);
            const float rs = rsqrtf(ss * (1.0f / 128.0f) + 1e-6f);
            *(unsigned*)(kvl + (size_t)t * 128 + 2 * lane) = pk2(k.x * rs * gk.x, k.y * rs * gk.y);
        }
        if (lane < 16) { const f32x2 k = *(const f32x2*)(cs + 384 + 2 * lane); *(unsigned*)(kidx + (size_t)t * 32 + 2 * lane) = pk2(k.x, k.y); }
        if (lane < 8) widx[(size_t)t * 8 + lane] = cs[416 + lane] * 0.0625f;
        const bf16_t* rc = rcols + (size_t)t * 1792; const bool hp = (t & (SEQ - 1)) != 0; const bf16_t* rp = hp ? rc - 1792 : rc;
#pragma unroll
        for (int seg = 0; seg < 3; ++seg) {
            float c[8], p[8], o[8];
            unpack8(*(const u32x4*)(rc + seg * 512 + 8 * lane), c); unpack8(*(const u32x4*)(rp + seg * 512 + 8 * lane), p);
            const f32x4 m0 = *(const f32x4*)(mu + seg * 512 + 8 * lane), m1 = *(const f32x4*)(mu + seg * 512 + 8 * lane + 4);
            const float mm[8] = {m0.x, m0.y, m0.z, m0.w, m1.x, m1.y, m1.z, m1.w};
#pragma unroll
            for (int j = 0; j < 8; ++j) { const float pv = hp ? p[j] : 0.f; o[j] = c[j] + (pv - c[j]) * mm[j]; }
            bf16_t* dst = (seg == 0 ? rr : (seg == 1 ? rk : rv)) + (size_t)t * 512 + 8 * lane;
            *(u32x4*)dst = pack8(o);
        }
        {
            const float cw = bf1(rc[1536 + lane]), pw = hp ? bf1(rp[1536 + lane]) : 0.f; const float wl = cw + (pw - cw) * mu[1536 + lane];
            const float ca = bf1(rc[1600 + lane]), pa = hp ? bf1(rp[1600 + lane]) : 0.f; const float al = ca + (pa - ca) * mu[1600 + lane];
            const unsigned cgw = *(const unsigned*)(rc + 1664 + 2 * lane), pgw = *(const unsigned*)(rp + 1664 + 2 * lane);
            const float cg0 = bflo(cgw), cg1 = bfhi(cgw), pg0 = hp ? bflo(pgw) : 0.f, pg1 = hp ? bfhi(pgw) : 0.f;
            const float g0 = cg0 + (pg0 - cg0) * mu[1664 + 2 * lane], g1 = cg1 + (pg1 - cg1) * mu[1664 + 2 * lane + 1];
            bf16_t* l = la + (size_t)t * 256;
            l[lane] = (bf16_t)f2bf(tanhf(wl)); l[64 + lane] = (bf16_t)f2bf(al);
            *(unsigned*)(l + 128 + 2 * lane) = pk2(sigmoidf_(g0), sigmoidf_(g1));
        }
    }
}

template <int NV> __device__ __forceinline__ unsigned kth_largest(const unsigned (&u)[NV], int k) {
    unsigned Tk = 0u;
    for (int bit = 31; bit >= 0; --bit) {
        const unsigned cand = Tk | (1u << bit); int cnt = 0;
#pragma unroll
        for (int j = 0; j < NV; ++j) cnt += __popcll(__ballot(u[j] >= cand));
        if (cnt >= k) Tk = cand;
    }
    return Tk;
}

__device__ __forceinline__ unsigned wave_max_u(unsigned x) {
    unsigned y;
    y = dpp_u<0x111>(x); x = x > y ? x : y; y = dpp_u<0x112>(x); x = x > y ? x : y; y = dpp_u<0x114>(x); x = x > y ? x : y; y = dpp_u<0x118>(x); x = x > y ? x : y;
    y = (unsigned)__builtin_amdgcn_update_dpp(0, (int)x, 0x142, 0xA, 0xF, false); x = x > y ? x : y;
    y = (unsigned)__builtin_amdgcn_update_dpp(0, (int)x, 0x143, 0xC, 0xF, false); x = x > y ? x : y;
    return (unsigned)__builtin_amdgcn_readlane((int)x, 63);
}
__device__ __forceinline__ int wave_sum_i(int x) {
    x += __builtin_amdgcn_update_dpp(0, x, 0x111, 0xF, 0xF, false); x += __builtin_amdgcn_update_dpp(0, x, 0x112, 0xF, 0xF, false);
    x += __builtin_amdgcn_update_dpp(0, x, 0x114, 0xF, 0xF, false); x += __builtin_amdgcn_update_dpp(0, x, 0x118, 0xF, 0xF, false);
    x += __builtin_amdgcn_update_dpp(0, x, 0x142, 0xA, 0xF, false); x += __builtin_amdgcn_update_dpp(0, x, 0x143, 0xC, 0xF, false);
    return __builtin_amdgcn_readlane(x, 63);
}
__device__ __forceinline__ float wave_max_f(float x) {
    const int ninf = (int)0xff800000u; float y;
    y = __builtin_bit_cast(float, __builtin_amdgcn_update_dpp(ninf, __builtin_bit_cast(int, x), 0x111, 0xF, 0xF, false)); x = fmaxf(x, y);
    y = __builtin_bit_cast(float, __builtin_amdgcn_update_dpp(ninf, __builtin_bit_cast(int, x), 0x112, 0xF, 0xF, false)); x = fmaxf(x, y);
    y = __builtin_bit_cast(float, __builtin_amdgcn_update_dpp(ninf, __builtin_bit_cast(int, x), 0x114, 0xF, 0xF, false)); x = fmaxf(x, y);
    y = __builtin_bit_cast(float, __builtin_amdgcn_update_dpp(ninf, __builtin_bit_cast(int, x), 0x118, 0xF, 0xF, false)); x = fmaxf(x, y);
    y = __builtin_bit_cast(float, __builtin_amdgcn_update_dpp(ninf, __builtin_bit_cast(int, x), 0x142, 0xA, 0xF, false)); x = fmaxf(x, y);
    y = __builtin_bit_cast(float, __builtin_amdgcn_update_dpp(ninf, __builtin_bit_cast(int, x), 0x143, 0xC, 0xF, false)); x = fmaxf(x, y);
    return __builtin_bit_cast(float, __builtin_amdgcn_readlane(__builtin_bit_cast(int, x), 63));
}
__device__ __forceinline__ int wave_scan_i(int x) {
    x += __builtin_amdgcn_update_dpp(0, x, 0x111, 0xF, 0xF, false); x += __builtin_amdgcn_update_dpp(0, x, 0x112, 0xF, 0xF, false);
    x += __builtin_amdgcn_update_dpp(0, x, 0x114, 0xF, 0xF, false); x += __builtin_amdgcn_update_dpp(0, x, 0x118, 0xF, 0xF, false);
    x += __builtin_amdgcn_update_dpp(0, x, 0x142, 0xA, 0xF, false); x += __builtin_amdgcn_update_dpp(0, x, 0x143, 0xC, 0xF, false);
    return x;
}
__device__ __forceinline__ int hist_find(u32x4 h, int K, int lane, int& chi, int& cnt) {
    const int ls = (int)(h.x + h.y + h.z + h.w); const int inc = wave_scan_i(ls); const int tot = __builtin_amdgcn_readlane(inc, 63);
    const int a3 = tot - inc, a2 = a3 + (int)h.w, a1 = a2 + (int)h.z, a0 = a1 + (int)h.y;
    int myb = -1, mya = 0, myc = 0;
    if (a3 < K && K <= a3 + (int)h.w) { myb = 3; mya = a3; myc = (int)h.w; }
    if (a2 < K && K <= a2 + (int)h.z) { myb = 2; mya = a2; myc = (int)h.z; }
    if (a1 < K && K <= a1 + (int)h.y) { myb = 1; mya = a1; myc = (int)h.y; }
    if (a0 < K && K <= a0 + (int)h.x) { myb = 0; mya = a0; myc = (int)h.x; }
    const unsigned long long m = __ballot(myb >= 0); const int src = m ? (int)__builtin_ctzll(m) : 0;
    chi = __builtin_amdgcn_readlane(mya, src); cnt = __builtin_amdgcn_readlane(myc, src);
    return 4 * src + __builtin_amdgcn_readlane(myb, src);
}
constexpr int LDS_HIST = 131072 + 4096;
__device__ __forceinline__ void p4_indexer(const Ctx& C) {
    unsigned char* ws = C.ws; const int lane = C.lane, wave = C.wave, g = lane >> 4, fr = lane & 15;
    const bf16_t* qidx = (const bf16_t*)(ws + WS_QIDX); const bf16_t* kidx = (const bf16_t*)(ws + WS_KIDX); const float* widx = (const float*)(ws + WS_WIDX);
    bf16_t* idxo = (bf16_t*)(ws + WS_IDX);
    LAS float* SC = (LAS float*)C.lds;
    LAS unsigned* H = (LAS unsigned*)(C.lds + LDS_HIST + wave * 1024);
    for (int u = blockIdx.x; u < 2048; u += C.G) {
        const int i8 = u >> 8, cc = u & 255, b = cc & 3, j = cc >> 2, qb = (i8 & 1) ? 64 * i8 + 63 - j : 64 * i8 + j;
        const int t0 = qb * 8, ntile = (t0 + 8 + 15) >> 4; const size_t tb = (size_t)b * SEQ;
        const int qn = fr & 7;
        bf16x8 Bq[8];
#pragma unroll
        for (int h = 0; h < 8; ++h) Bq[h] = *(const bf16x8*)(qidx + (tb + t0 + qn) * 256 + h * 32 + 8 * g);
        const f32x4 w0 = *(const f32x4*)(widx + (tb + t0 + qn) * 8), w1 = *(const f32x4*)(widx + (tb + t0 + qn) * 8 + 4);
        const float wq[8] = {w0.x, w0.y, w0.z, w0.w, w1.x, w1.y, w1.z, w1.w};
        for (int i0 = wave; i0 < ntile; i0 += 4 * NWAVES) {
            bf16x8 A[4];
#pragma unroll
            for (int q = 0; q < 4; ++q) { int i = i0 + q * NWAVES; i = i < ntile ? i : ntile - 1; A[q] = *(const bf16x8*)(kidx + (tb + 16 * i + fr) * 32 + 8 * g); }
#pragma unroll
            for (int q = 0; q < 4; ++q) {
                const int i = i0 + q * NWAVES;
                if (i < ntile) {
                    f32x4 sc = (f32x4){0.f, 0.f, 0.f, 0.f};
#pragma unroll
                    for (int h = 0; h < 8; ++h) { const f32x4 d = __builtin_amdgcn_mfma_f32_16x16x32_bf16(A[q], Bq[h], (f32x4){0.f, 0.f, 0.f, 0.f}, 0, 0, 0);
#pragma unroll
                        for (int r = 0; r < 4; ++r) sc[r] = fmaf(wq[h], fmaxf(d[r], 0.f), sc[r]); }
                    if (fr < 8) { const int tq = t0 + fr, s0 = 16 * i + 4 * g;
#pragma unroll
                        for (int r = 0; r < 4; ++r) sc[r] = (s0 + r <= tq) ? sc[r] : -INFINITY;
                        *(LAS f32x4*)(SC + fr * 4096 + s0) = sc; }
                }
            }
        }
        __syncthreads();
        {
            const int tq = t0 + wave; bf16_t* out = idxo + (tb + tq) * 256;
            if (tq < 256) {
#pragma unroll
                for (int jj = 0; jj < 4; ++jj) { const int s = jj * 64 + lane; if (s <= tq) out[s] = (bf16_t)s; }
            } else {
                float v[64];
#pragma unroll
                for (int jj = 0; jj < 64; ++jj) { const int s = jj * 64 + lane; const float x = SC[wave * 4096 + s]; v[jj] = (s <= tq) ? x : -INFINITY; }
                float mx = -INFINITY, mnn = -INFINITY;
#pragma unroll
                for (int jj = 0; jj < 64; ++jj) { mx = fmaxf(mx, v[jj]); mnn = fmaxf(mnn, v[jj] == -INFINITY ? -INFINITY : -v[jj]); }
                mx = wave_max_f(mx); const float lo = -wave_max_f(mnn);
                const float rng = mx - lo; const float inv = rng > 1e-30f ? 65535.9f / rng : 1.f;
                *(LAS u32x4*)(H + 4 * lane) = (u32x4){0u, 0u, 0u, 0u};
#pragma unroll
                for (int jj = 0; jj < 64; ++jj) { const int bn = (int)((v[jj] - lo) * inv); if (bn >= 0) __hip_atomic_fetch_add(H + (bn >> 8), 1u, __ATOMIC_RELAXED, __HIP_MEMORY_SCOPE_WORKGROUP); }
                asm volatile("s_waitcnt lgkmcnt(0)" ::: "memory");
                int chi1, cnt1; const int b1 = hist_find(*(const LAS u32x4*)(H + 4 * lane), 256, lane, chi1, cnt1);
                asm volatile("s_waitcnt lgkmcnt(0)" ::: "memory");
                *(LAS u32x4*)(H + 4 * lane) = (u32x4){0u, 0u, 0u, 0u};
#pragma unroll
                for (int jj = 0; jj < 64; ++jj) { const int bn = (int)((v[jj] - lo) * inv); if ((bn >> 8) == b1) __hip_atomic_fetch_add(H + (bn & 255), 1u, __ATOMIC_RELAXED, __HIP_MEMORY_SCOPE_WORKGROUP); }
                asm volatile("s_waitcnt lgkmcnt(0)" ::: "memory");
                int chi2, cnt2; const int b2 = hist_find(*(const LAS u32x4*)(H + 4 * lane), 256 - chi1, lane, chi2, cnt2);
                const int T16 = b1 * 256 + b2; const int need = 256 - chi1 - chi2;
                const bool allties = (need == cnt2);
                unsigned mlo = 0u, mhi = 0u;
#pragma unroll
                for (int jj = 0; jj < 32; ++jj) { const int bn = (int)((v[jj] - lo) * inv); const bool sel = allties ? (bn >= T16) : (bn > T16); mlo |= sel ? (1u << jj) : 0u; }
#pragma unroll
                for (int jj = 32; jj < 64; ++jj) { const int bn = (int)((v[jj] - lo) * inv); const bool sel = allties ? (bn >= T16) : (bn > T16); mhi |= sel ? (1u << (jj - 32)) : 0u; }
                LAS bf16_t* stage = (LAS bf16_t*)(SC + wave * 4096);
                const int mycnt = __popc(mlo) + __popc(mhi); int base = wave_scan_i(mycnt) - mycnt;
                while (mlo) { const int bpos = __builtin_ctz(mlo); stage[base++] = (bf16_t)(bpos * 64 + lane); mlo &= mlo - 1u; }
                while (mhi) { const int bpos = __builtin_ctz(mhi); stage[base++] = (bf16_t)((bpos + 32) * 64 + lane); mhi &= mhi - 1u; }
                if (!allties) {
                    int eqb = 0; const int pos0 = 256 - need;
#pragma unroll
                    for (int jj = 0; jj < 64; ++jj) {
                        const int bn = (int)((v[jj] - lo) * inv); const bool eq = (bn == T16);
                        const unsigned long long me = __ballot(eq);
                        const int er = eqb + (int)__builtin_amdgcn_mbcnt_hi((unsigned)(me >> 32), __builtin_amdgcn_mbcnt_lo((unsigned)me, 0u));
                        if (eq && er < need) stage[pos0 + er] = (bf16_t)(jj * 64 + lane);
                        eqb += __popcll(me);
                    }
                }
                asm volatile("s_waitcnt lgkmcnt(0)" ::: "memory");
                *(u32x2*)(out + 4 * lane) = *(const LAS u32x2*)(stage + 4 * lane);
            }
        }
        __syncthreads();
    }
}

__device__ __forceinline__ void p4_memattn(const Ctx& C) {
    unsigned char* ws = C.ws; const int lane = C.lane, g = lane >> 4, fr = lane & 15;
    const bf16_t* memq = (const bf16_t*)(ws + WS_MEMQ); const bf16_t* kmem = (const bf16_t*)(ws + WS_KMEM); const bf16_t* vmt = (const bf16_t*)(ws + WS_VMEMT);
    bf16_t* ymem = (bf16_t*)(ws + WS_YMEM);
    for (int task = C.gw; task < 4096; task += C.ngw) {
        const int tt = task >> 2, h = task & 3, t0 = tt * 16, b = t0 >> 12;
        const bf16_t* kb = kmem + (size_t)((b * 4 + h) * 256) * 128; const bf16_t* vb = vmt + (size_t)((b * 4 + h) * 128) * 256;
        bf16x8 Bq[4];
#pragma unroll
        for (int kk = 0; kk < 4; ++kk) Bq[kk] = *(const bf16x8*)(memq + (size_t)(t0 + fr) * 512 + h * 128 + 32 * kk + 8 * g);
        f32x4 sc[16];
#pragma unroll
        for (int i = 0; i < 16; ++i) { sc[i] = (f32x4){0.f, 0.f, 0.f, 0.f};
#pragma unroll
            for (int kk = 0; kk < 4; ++kk) { const bf16x8 A = *(const bf16x8*)(kb + (size_t)(16 * i + fr) * 128 + 32 * kk + 8 * g);
                sc[i] = __builtin_amdgcn_mfma_f32_16x16x32_bf16(A, Bq[kk], sc[i], 0, 0, 0); } }
        const float scale = 0.08838834764831845f;
        float mx = -3.0e38f;
#pragma unroll
        for (int i = 0; i < 16; ++i)
#pragma unroll
            for (int r = 0; r < 4; ++r) { sc[i][r] *= scale; mx = fmaxf(mx, sc[i][r]); }
        mx = fmaxf(mx, __shfl_xor(mx, 16)); mx = fmaxf(mx, __shfl_xor(mx, 32));
        float sum = 0.f;
#pragma unroll
        for (int i = 0; i < 16; ++i)
#pragma unroll
            for (int r = 0; r < 4; ++r) { sc[i][r] = __expf(sc[i][r] - mx); sum += sc[i][r]; }
        sum += __shfl_xor(sum, 16); sum += __shfl_xor(sum, 32);
        const float inv = 1.0f / sum;
        bf16x8 Pb[8];
#pragma unroll
        for (int ks = 0; ks < 8; ++ks) { u32x4 w; w.x = pk2(sc[2 * ks][0] * inv, sc[2 * ks][1] * inv); w.y = pk2(sc[2 * ks][2] * inv, sc[2 * ks][3] * inv);
            w.z = pk2(sc[2 * ks + 1][0] * inv, sc[2 * ks + 1][1] * inv); w.w = pk2(sc[2 * ks + 1][2] * inv, sc[2 * ks + 1][3] * inv); Pb[ks] = __builtin_bit_cast(bf16x8, w); }
#pragma unroll
        for (int dt = 0; dt < 8; ++dt) {
            f32x4 o = (f32x4){0.f, 0.f, 0.f, 0.f};
#pragma unroll
            for (int ks = 0; ks < 8; ++ks) { const bf16_t* vp = vb + (size_t)(16 * dt + fr) * 256 + 32 * ks + 4 * g;
                const u32x2 lo = *(const u32x2*)vp, hi = *(const u32x2*)(vp + 16); u32x4 w; w.x = lo.x; w.y = lo.y; w.z = hi.x; w.w = hi.y;
                o = __builtin_amdgcn_mfma_f32_16x16x32_bf16(__builtin_bit_cast(bf16x8, w), Pb[ks], o, 0, 0, 0); }
            u32x2 w; w.x = pk2(o[0], o[1]); w.y = pk2(o[2], o[3]);
            *(u32x2*)(ymem + (size_t)(t0 + fr) * 512 + h * 128 + 16 * dt + 4 * g) = w;
        }
    }
}

constexpr int LDS_RELB = 131072 + 1024;
constexpr int LDS_LUT = LDS_RELB + 1024;
__device__ __forceinline__ u32x2 tr_read2(unsigned a0, unsigned a1, u32x2& hi) {
    u32x2 lo; asm volatile("ds_read_b64_tr_b16 %0, %2\n\tds_read_b64_tr_b16 %1, %3\n\ts_waitcnt lgkmcnt(0)" : "=&v"(lo), "=&v"(hi) : "v"(a0), "v"(a1) : "memory"); return lo;
}
__device__ __forceinline__ void p5_dsa_attn(const Ctx& C) {
    unsigned char* ws = C.ws; const int lane = C.lane, wave = C.wave, g = lane >> 4, fr = lane & 15;
    const bf16_t* qlat = (const bf16_t*)(ws + WS_QLAT); const bf16_t* kvl = (const bf16_t*)(ws + WS_KVL); const bf16_t* idxb = (const bf16_t*)(ws + WS_IDX);
    bf16_t* olat = (bf16_t*)(ws + WS_OLAT);
    LAS float* relb = (LAS float*)(C.lds + LDS_RELB); LAS int* lut = (LAS int*)(C.lds + LDS_LUT);
    if (C.tid < 256) relb[C.tid] = C.in[2][C.tid];
    if (C.tid < 128) { const int n = C.tid; int bk = n; if (n >= 16) { bk = 16 + (int)(logf((float)n * (1.0f / 16.0f)) / 2.0794415416798357f * 16.0f); bk = bk > 31 ? 31 : bk; } lut[n] = bk; }
    __syncthreads();
    LAS unsigned char* my = C.lds + wave * 16384; const unsigned mybase = (unsigned)(uintptr_t)my;
    unsigned* qctr = (unsigned*)(ws + WS_CTL) + CW_DSAQ;
    for (;;) {
      int q0 = 0; if (lane == 0) q0 = (int)__hip_atomic_fetch_add(qctr, 4u, __ATOMIC_RELAXED, __HIP_MEMORY_SCOPE_AGENT);
      q0 = __builtin_amdgcn_readfirstlane(q0); if (q0 >= T) break;
      for (int q = q0; q < q0 + 4; ++q) {
        const int b = q >> 12, s = q & (SEQ - 1); const int nvalid = s + 1 < 256 ? s + 1 : 256;
        bf16x8 Bq[4];
#pragma unroll
        for (int kk = 0; kk < 4; ++kk) Bq[kk] = *(const bf16x8*)(qlat + (size_t)q * 1024 + (fr & 7) * 128 + 32 * kk + 8 * g);
        float m_run = -INFINITY, l_run = 0.f;
        f32x4 O[8];
#pragma unroll
        for (int cc = 0; cc < 8; ++cc) O[cc] = (f32x4){0.f, 0.f, 0.f, 0.f};
        const int nch = (nvalid + 63) >> 6;
        for (int ch = 0; ch < nch; ++ch) {
            const int slot = ch * 64 + lane; const int ix = slot < nvalid ? (int)idxb[(size_t)q * 256 + slot] : 0;
            const char* kvb = (const char*)(kvl + (size_t)b * SEQ * 128);
#pragma unroll
            for (int p = 0; p < 16; ++p) { const int rrow = 4 * p + g; const int srow = __shfl(ix, rrow); const int c = fr ^ (2 * (rrow & 7));
                __builtin_amdgcn_global_load_lds((const unsigned*)(kvb + (size_t)srow * 256 + 16 * c), (LAS unsigned*)(my + 1024 * p), 16, 0, 0); }
            asm volatile("s_waitcnt vmcnt(0)" ::: "memory");
            f32x4 sc[4];
#pragma unroll
            for (int i = 0; i < 4; ++i) { sc[i] = (f32x4){0.f, 0.f, 0.f, 0.f};
#pragma unroll
                for (int kk = 0; kk < 4; ++kk) { const int row = 16 * i + fr; const int sl = (4 * kk + g) ^ (2 * (row & 7));
                    const bf16x8 A = *(const LAS bf16x8*)(my + row * 256 + 16 * sl);
                    sc[i] = __builtin_amdgcn_mfma_f32_16x16x32_bf16(A, Bq[kk], sc[i], 0, 0, 0); } }
            float mx = -INFINITY;
#pragma unroll
            for (int i = 0; i < 4; ++i)
#pragma unroll
                for (int r = 0; r < 4; ++r) { const int ks = 16 * i + 4 * g + r; const int kpos = __shfl(ix, ks); const int dist = s - kpos;
                    const int bk = dist >= 128 ? 31 : lut[dist < 0 ? 0 : dist]; const float bias = relb[bk * 8 + (fr & 7)];
                    const bool valid = ch * 64 + ks < nvalid; const float v = valid ? sc[i][r] + bias : -INFINITY; sc[i][r] = v; mx = fmaxf(mx, v); }
            mx = fmaxf(mx, __shfl_xor(mx, 16)); mx = fmaxf(mx, __shfl_xor(mx, 32));
            const float m_new = fmaxf(m_run, mx); const float alpha = __expf(m_run - m_new);
            float ps = 0.f;
#pragma unroll
            for (int i = 0; i < 4; ++i)
#pragma unroll
                for (int r = 0; r < 4; ++r) { sc[i][r] = __expf(sc[i][r] - m_new); ps += sc[i][r]; }
            ps += __shfl_xor(ps, 16); ps += __shfl_xor(ps, 32);
            l_run = l_run * alpha + ps; m_run = m_new;
            float ar[4];
#pragma unroll
            for (int r = 0; r < 4; ++r) ar[r] = __shfl(alpha, 4 * g + r);
#pragma unroll
            for (int cc = 0; cc < 8; ++cc)
#pragma unroll
                for (int r = 0; r < 4; ++r) O[cc][r] *= ar[r];
#pragma unroll
            for (int ks = 0; ks < 2; ++ks) {
                u32x4 w; w.x = pk2(sc[2 * ks][0], sc[2 * ks][1]); w.y = pk2(sc[2 * ks][2], sc[2 * ks][3]); w.z = pk2(sc[2 * ks + 1][0], sc[2 * ks + 1][1]); w.w = pk2(sc[2 * ks + 1][2], sc[2 * ks + 1][3]);
                const bf16x8 Pa = __builtin_bit_cast(bf16x8, w);
                const int qq = fr >> 2, p2 = fr & 3;
#pragma unroll
                for (int cc = 0; cc < 8; ++cc) {
                    const int R0 = 32 * ks + 4 * g + qq, R1 = R0 + 16; const int chk = 2 * cc + (p2 >> 1);
                    const unsigned a0 = mybase + R0 * 256 + 16 * (chk ^ (2 * (R0 & 7))) + 8 * (p2 & 1), a1 = mybase + R1 * 256 + 16 * (chk ^ (2 * (R1 & 7))) + 8 * (p2 & 1);
                    u32x2 hi; const u32x2 lo = tr_read2(a0, a1, hi); u32x4 bw; bw.x = lo.x; bw.y = lo.y; bw.z = hi.x; bw.w = hi.y;
                    O[cc] = __builtin_amdgcn_mfma_f32_16x16x32_bf16(Pa, __builtin_bit_cast(bf16x8, bw), O[cc], 0, 0, 0);
                }
            }
        }
        const float inv = 1.0f / l_run; float ir[4];
#pragma unroll
        for (int r = 0; r < 4; ++r) ir[r] = __shfl(inv, 4 * g + r);
        if (g < 2) {
#pragma unroll
            for (int cc = 0; cc < 8; ++cc)
#pragma unroll
                for (int r = 0; r < 4; ++r) olat[(size_t)q * 1024 + (4 * g + r) * 128 + 16 * cc + fr] = (bf16_t)f2bf(O[cc][r] * ir[r]);
        }
      }
    }
}

constexpr int RBLK = 4, RVEC = 5 * 64 + 4;
constexpr int RWAVE_LDS = 2 * RBLK * RVEC * 4;
struct RwRaw { bf16_t a[RBLK], k[RBLK], e[RBLK], r[RBLK]; };
template <int MODE> __device__ __forceinline__ void rw_load_raw(RwRaw& w, const bf16_t* pa, const bf16_t* pk, const bf16_t* pe, const bf16_t* pr, size_t tok0, int col) {
#pragma unroll
    for (int i = 0; i < RBLK; ++i) { const size_t o = (tok0 + i) * 512 + col; w.a[i] = pa[o]; w.k[i] = pk[o]; w.e[i] = pe[o]; if (MODE == 2) w.r[i] = pr[o]; else w.r[i] = 0; }
}
template <int MODE> __device__ __forceinline__ void rw_process(const RwRaw& w, LAS float* buf, int lane, float kk_c, float ka_c, float rk_c) {
#pragma unroll
    for (int i = 0; i < RBLK; ++i) {
        __builtin_amdgcn_sched_barrier(0);
        const float a = bf1(w.a[i]), ks = bf1(w.k[i]), e = bf1(w.e[i]);
        const float kr = ks * kk_c; const float n2 = wave_sum(kr * kr); const float kk = kr * __builtin_amdgcn_rsqf(fmaxf(n2, 1e-24f));
        const float kx = ks * (1.0f + (a - 1.0f) * ka_c);
        LAS float* s = buf + i * RVEC;
        s[lane] = __expf(-e); s[64 + lane] = -kk; s[128 + lane] = kk * a; s[192 + lane] = kx;
        if (MODE == 2) { const float r = bf1(w.r[i]); s[256 + lane] = r; const float bc = wave_sum(r * kx * rk_c); if (lane == 0) s[320] = bc; }
    }
}
#ifndef RW_NKD2
#define RW_NKD2 8
#define RW_BD2 4
#define RW_NKD3 8
#define RW_BD3 2
#endif
template <int MODE> struct RwCfg { static constexpr int NKD = MODE == 2 ? RW_NKD2 : RW_NKD3, BD = MODE == 2 ? RW_BD2 : RW_BD3; };
__device__ __forceinline__ float fma_s(float a, float b, float c) { float d; asm("v_fma_f32 %0, %1, %2, %3" : "=v"(d) : "v"(a), "v"(b), "v"(c)); return d; }
__device__ __forceinline__ float mul_s(float a, float b) { float d; asm("v_mul_f32 %0, %1, %2" : "=v"(d) : "v"(a), "v"(b)); return d; }
template <int MODE> __device__ __forceinline__ void rw_step(float (&sq)[64], float (&sp)[64], f32x4 (&nk)[RwCfg<MODE>::NKD], const LAS float* sv, const LAS float* svn, float vv, float& yout) {
    constexpr int NKD = RwCfg<MODE>::NKD, BD = RwCfg<MODE>::BD;
    f32x4 bw[BD], bka[BD], bkx[BD], br[BD];
    float sa0 = 0.f, sa1 = 0.f, sb0 = 0.f, sb1 = 0.f;
#pragma unroll
    for (int j = 0; j < 16; ++j) {
        const f32x4 n = nk[j % NKD];
        sa0 = fma_s(sq[4 * j], n.x, sa0); sa1 = fma_s(sq[4 * j + 1], n.y, sa1); sa0 = fma_s(sq[4 * j + 2], n.z, sa0); sa1 = fma_s(sq[4 * j + 3], n.w, sa1);
        if (MODE == 3) { sb0 = fma_s(sp[4 * j], n.x, sb0); sb1 = fma_s(sp[4 * j + 1], n.y, sb1); sb0 = fma_s(sp[4 * j + 2], n.z, sb0); sb1 = fma_s(sp[4 * j + 3], n.w, sb1); }
        if (j + NKD < 16) nk[j % NKD] = *(const LAS f32x4*)(sv + 64 + 4 * (j + NKD));
        if (j >= 16 - BD) { const int gq = j - (16 - BD); bw[gq] = *(const LAS f32x4*)(sv + 4 * gq); bka[gq] = *(const LAS f32x4*)(sv + 128 + 4 * gq); bkx[gq] = *(const LAS f32x4*)(sv + 192 + 4 * gq);
            if (MODE == 2) br[gq] = *(const LAS f32x4*)(sv + 256 + 4 * gq); }
        __builtin_amdgcn_sched_barrier(0);
    }
    const float saq = sa0 + sa1, sap = sb0 + sb1;
    float y0 = 0.f, y1 = 0.f;
#pragma unroll
    for (int gq = 0; gq < 16; ++gq) {
        const f32x4 w = bw[gq % BD], ka = bka[gq % BD], kx = bkx[gq % BD];
        sq[4 * gq] = fma_s(vv, kx.x, fma_s(saq, ka.x, mul_s(sq[4 * gq], w.x))); sq[4 * gq + 1] = fma_s(vv, kx.y, fma_s(saq, ka.y, mul_s(sq[4 * gq + 1], w.y)));
        sq[4 * gq + 2] = fma_s(vv, kx.z, fma_s(saq, ka.z, mul_s(sq[4 * gq + 2], w.z))); sq[4 * gq + 3] = fma_s(vv, kx.w, fma_s(saq, ka.w, mul_s(sq[4 * gq + 3], w.w)));
        if (MODE == 2) { const f32x4 r = br[gq % BD]; y0 = fma_s(sq[4 * gq], r.x, y0); y1 = fma_s(sq[4 * gq + 1], r.y, y1); y0 = fma_s(sq[4 * gq + 2], r.z, y0); y1 = fma_s(sq[4 * gq + 3], r.w, y1); }
        if (MODE == 3) { sp[4 * gq] = fma_s(sap, ka.x, mul_s(sp[4 * gq], w.x)); sp[4 * gq + 1] = fma_s(sap, ka.y, mul_s(sp[4 * gq + 1], w.y));
            sp[4 * gq + 2] = fma_s(sap, ka.z, mul_s(sp[4 * gq + 2], w.z)); sp[4 * gq + 3] = fma_s(sap, ka.w, mul_s(sp[4 * gq + 3], w.w)); }
        if (gq + BD < 16) { const int gn = gq + BD; bw[gq % BD] = *(const LAS f32x4*)(sv + 4 * gn); bka[gq % BD] = *(const LAS f32x4*)(sv + 128 + 4 * gn); bkx[gq % BD] = *(const LAS f32x4*)(sv + 192 + 4 * gn);
            if (MODE == 2) br[gq % BD] = *(const LAS f32x4*)(sv + 256 + 4 * gn); }
        if (gq >= 16 - NKD) nk[gq - (16 - NKD)] = *(const LAS f32x4*)(svn + 64 + 4 * (gq - (16 - NKD)));
        __builtin_amdgcn_sched_barrier(0);
    }
    yout = y0 + y1;
}
template <int MODE> __device__ __forceinline__ void rw_task(const Ctx& C, int bh, int ch) {
    unsigned char* ws = C.ws; const int lane = C.lane; const int b = bh >> 3, h = bh & 7, col = h * 64 + lane;
    const bf16_t* pr = (const bf16_t*)(ws + WS_RW_R); const bf16_t* pk = (const bf16_t*)(ws + WS_RW_K); const bf16_t* pv = (const bf16_t*)(ws + WS_RW_V);
    const bf16_t* pa = (const bf16_t*)(ws + WS_RW_A); const bf16_t* pe = (const bf16_t*)(ws + WS_RW_E); const bf16_t* pg = (const bf16_t*)(ws + WS_RW_G);
    bf16_t* yo = (bf16_t*)(ws + WS_YRWKV);
    float* PQ = (float*)(C.dout + DO_PQ);
    LAS float* buf = (LAS float*)(C.lds + C.wave * RWAVE_LDS);
    const float kk_c = C.in[16][col], ka_c = C.in[17][col], rk_c = C.in[18][col];
    const float lng = C.in[19][col], lnb = C.in[20][col];
    const size_t tok0 = (size_t)b * SEQ + (size_t)ch * RL;
    float sq[64], sp[64];
    int lane_v = lane; asm volatile("" : "+v"(lane_v));
#pragma unroll
    for (int k = 0; k < 64; ++k) { sq[k] = 0.f; sp[k] = (k == lane_v) ? 1.f : 0.f; }
    if (MODE == 2 && ch > 0) { const float* src = PQ + ((size_t)((bh * RCH + ch - 1) * 2)) * 4096 + lane * 64;
#pragma unroll
        for (int k4 = 0; k4 < 16; ++k4) { const f32x4 v = *(const f32x4*)(src + 4 * k4); sq[4 * k4] = v.x; sq[4 * k4 + 1] = v.y; sq[4 * k4 + 2] = v.z; sq[4 * k4 + 3] = v.w; } }
    constexpr int NBLK = RL / RBLK;
    RwRaw raw; rw_load_raw<MODE>(raw, pa, pk, pe, pr, tok0, col);
    rw_process<MODE>(raw, buf, lane, kk_c, ka_c, rk_c);
    rw_load_raw<MODE>(raw, pa, pk, pe, pr, tok0 + RBLK, col);
    constexpr int NKD = RwCfg<MODE>::NKD;
    f32x4 nk[NKD];
#pragma unroll
    for (int j = 0; j < NKD; ++j) nk[j] = *(const LAS f32x4*)(buf + 64 + 4 * j);
#pragma unroll 1
    for (int blk = 0; blk < NBLK; ++blk) {
        LAS float* cur = buf + (blk & 1) * (RBLK * RVEC); LAS float* nxt = buf + ((blk + 1) & 1) * (RBLK * RVEC);
        const size_t tb = tok0 + (size_t)blk * RBLK;
        rw_process<MODE>(raw, nxt, lane, kk_c, ka_c, rk_c);
        rw_load_raw<MODE>(raw, pa, pk, pe, pr, tok0 + (size_t)(blk + 2 < NBLK ? blk + 2 : NBLK - 1) * RBLK, col);
        float vv[RBLK], gg[RBLK];
#pragma unroll
        for (int i = 0; i < RBLK; ++i) { vv[i] = bf1(pv[(tb + i) * 512 + col]); gg[i] = (MODE == 2) ? bf1(pg[(tb + i) * 512 + col]) : 0.f; }
#pragma unroll
        for (int i = 0; i < RBLK; ++i) {
            const LAS float* sv = cur + i * RVEC; const LAS float* svn = (i + 1 < RBLK) ? cur + (i + 1) * RVEC : nxt;
            float y;
            rw_step<MODE>(sq, sp, nk, sv, svn, vv[i], y);
            if (MODE == 2) {
                const float mean = wave_sum(y) * (1.0f / 64.0f); const float dy = y - mean; const float var = wave_sum(dy * dy) * (1.0f / 64.0f);
                const float yn = dy * rsqrtf(var + 64e-5f) * lng + lnb; const float bc = sv[320];
                yo[(tb + i) * 512 + col] = (bf16_t)f2bf((yn + bc * vv[i]) * gg[i]);
            }
        }
    }
    if (MODE == 3) { float* dq = PQ + ((size_t)((bh * RCH + ch) * 2)) * 4096 + lane * 64; float* dp = dq + 4096;
#pragma unroll
        for (int k4 = 0; k4 < 16; ++k4) { *(f32x4*)(dq + 4 * k4) = (f32x4){sq[4 * k4], sq[4 * k4 + 1], sq[4 * k4 + 2], sq[4 * k4 + 3]};
            *(f32x4*)(dp + 4 * k4) = (f32x4){sp[4 * k4], sp[4 * k4 + 1], sp[4 * k4 + 2], sp[4 * k4 + 3]}; } }
}
__device__ __forceinline__ void p4_rwkv_pass1(const Ctx& C) {
    for (int task = C.gw; task < 32 * (RCH - 1); task += C.ngw) rw_task<3>(C, task / (RCH - 1), task % (RCH - 1));
}
__device__ __forceinline__ void p6_rwkv_pass3(const Ctx& C) {
    for (int task = C.gw; task < 32 * RCH; task += C.ngw) rw_task<2>(C, task / RCH, task % RCH);
}
__device__ __forceinline__ void p5_rwkv_carry(const Ctx& C) {
    float* PQ = (float*)(C.dout + DO_PQ); const int lane = C.lane, wave = C.wave, tid = C.tid;
    LAS float* ST = (LAS float*)C.lds;
    LAS float* PL = (LAS float*)(C.lds + 32768);
    for (int bh = blockIdx.x; bh < 32; bh += C.G) {
        for (int i = tid; i < 4096; i += NTHREADS) ST[i] = 0.f;
        const float* base = PQ + (size_t)(bh * RCH) * 2 * 4096;
        f32x4 pa = *(const f32x4*)(base + 4096 + tid * 8), pb = *(const f32x4*)(base + 4096 + tid * 8 + 4);
        f32x4 q0 = *(const f32x4*)(base + lane * 64 + 8 * wave), q1 = *(const f32x4*)(base + lane * 64 + 8 * wave + 4);
        __syncthreads();
        for (int ch = 0; ch < RCH - 1; ++ch) {
            LAS float* cur = ST + (ch & 1) * 4096; LAS float* nxt = ST + ((ch + 1) & 1) * 4096;
            float* Q = PQ + ((size_t)((bh * RCH + ch) * 2)) * 4096;
            *(LAS f32x4*)(PL + tid * 8) = pa; *(LAS f32x4*)(PL + tid * 8 + 4) = pb;
            float acc[8] = {q0.x, q0.y, q0.z, q0.w, q1.x, q1.y, q1.z, q1.w};
            __syncthreads();
            const int cn = ch + 1 < RCH - 1 ? ch + 1 : ch; const float* nb = PQ + ((size_t)((bh * RCH + cn) * 2)) * 4096;
            pa = *(const f32x4*)(nb + 4096 + tid * 8); pb = *(const f32x4*)(nb + 4096 + tid * 8 + 4);
            q0 = *(const f32x4*)(nb + lane * 64 + 8 * wave); q1 = *(const f32x4*)(nb + lane * 64 + 8 * wave + 4);
#pragma unroll 8
            for (int j = 0; j < 64; ++j) { const float sj = cur[j * 64 + lane]; const f32x4 p0 = *(const LAS f32x4*)(PL + j * 64 + 8 * wave), p1 = *(const LAS f32x4*)(PL + j * 64 + 8 * wave + 4);
                acc[0] = fmaf(sj, p0.x, acc[0]); acc[1] = fmaf(sj, p0.y, acc[1]); acc[2] = fmaf(sj, p0.z, acc[2]); acc[3] = fmaf(sj, p0.w, acc[3]);
                acc[4] = fmaf(sj, p1.x, acc[4]); acc[5] = fmaf(sj, p1.y, acc[5]); acc[6] = fmaf(sj, p1.z, acc[6]); acc[7] = fmaf(sj, p1.w, acc[7]); }
            *(f32x4*)(Q + lane * 64 + 8 * wave) = (f32x4){acc[0], acc[1], acc[2], acc[3]}; *(f32x4*)(Q + lane * 64 + 8 * wave + 4) = (f32x4){acc[4], acc[5], acc[6], acc[7]};
#pragma unroll
            for (int kk = 0; kk < 8; ++kk) nxt[(8 * wave + kk) * 64 + lane] = acc[kk];
            __syncthreads();
        }
    }
}

__device__ __forceinline__ void p8_ln1(const Ctx& C) {
    const float* pre = (const float*)C.dout; float* x1 = (float*)(C.ws + WS_X1); bf16_t* x1b = (bf16_t*)(C.ws + WS_X1B); const int lane = C.lane;
    const float* gam = C.in[26]; const float* bet = C.in[27];
    for (int t = C.gw; t < T; t += C.ngw) {
        const float* p = pre + (size_t)t * 1024; float v[16];
#pragma unroll
        for (int hh = 0; hh < 2; ++hh) { const f32x4 a = *(const f32x4*)(p + hh * 512 + 8 * lane), b = *(const f32x4*)(p + hh * 512 + 8 * lane + 4);
            v[8 * hh] = a.x; v[8 * hh + 1] = a.y; v[8 * hh + 2] = a.z; v[8 * hh + 3] = a.w; v[8 * hh + 4] = b.x; v[8 * hh + 5] = b.y; v[8 * hh + 6] = b.z; v[8 * hh + 7] = b.w; }
        float s = 0.f;
#pragma unroll
        for (int j = 0; j < 16; ++j) s += v[j];
        const float mean = wave_sum(s) * (1.0f / 1024.0f); float s2 = 0.f;
#pragma unroll
        for (int j = 0; j < 16; ++j) { v[j] -= mean; s2 += v[j] * v[j]; }
        const float rstd = rsqrtf(wave_sum(s2) * (1.0f / 1024.0f) + 1e-5f);
#pragma unroll
        for (int hh = 0; hh < 2; ++hh) { const int c0 = hh * 512 + 8 * lane; float o[8];
#pragma unroll
            for (int j = 0; j < 8; ++j) o[j] = v[8 * hh + j] * rstd * gam[c0 + j] + bet[c0 + j];
            *(f32x4*)(x1 + (size_t)t * 1024 + c0) = (f32x4){o[0], o[1], o[2], o[3]}; *(f32x4*)(x1 + (size_t)t * 1024 + c0 + 4) = (f32x4){o[4], o[5], o[6], o[7]};
            *(u32x4*)(x1b + (size_t)t * 1024 + c0) = pack8(o); }
    }
    cvt_rows(C.in[30], (bf16_t*)(C.ws + WS_UB), (size_t)16384 * 1024 / 8, C.gt, C.ngt);
    cvt_rows(C.in[31], (bf16_t*)(C.ws + WS_VB), (size_t)16384 * 1024 / 8, C.gt, C.ngt);
}

#define CE_DESC(a, b) do { const unsigned hi_ = k[a] > k[b] ? k[a] : k[b], lo_ = k[a] > k[b] ? k[b] : k[a]; k[a] = hi_; k[b] = lo_; } while (0)
__device__ __forceinline__ unsigned pop16_of8(unsigned (&k)[8], int fr) {
    CE_DESC(0, 1); CE_DESC(2, 3); CE_DESC(4, 5); CE_DESC(6, 7); CE_DESC(0, 2); CE_DESC(1, 3); CE_DESC(4, 6); CE_DESC(5, 7); CE_DESC(1, 2); CE_DESC(5, 6);
    CE_DESC(0, 4); CE_DESC(1, 5); CE_DESC(2, 6); CE_DESC(3, 7); CE_DESC(2, 4); CE_DESC(3, 5); CE_DESC(1, 2); CE_DESC(3, 4); CE_DESC(5, 6);
    unsigned res = 0u;
#pragma unroll
    for (int rd = 0; rd < 16; ++rd) {
        const unsigned m = row_max_u(k[0]); const bool mine = (k[0] == m);
#pragma unroll
        for (int j = 0; j < 7; ++j) k[j] = mine ? k[j + 1] : k[j];
        k[7] = mine ? 0u : k[7];
        res = (fr == rd) ? m : res;
    }
    return res;
}
__device__ __forceinline__ unsigned pop16_of4(unsigned (&k)[4], int fr) {
    CE_DESC(0, 1); CE_DESC(2, 3); CE_DESC(0, 2); CE_DESC(1, 3); CE_DESC(1, 2);
    unsigned res = 0u;
#pragma unroll
    for (int rd = 0; rd < 16; ++rd) {
        const unsigned m = row_max_u(k[0]); const bool mine = (k[0] == m);
        k[0] = mine ? k[1] : k[0]; k[1] = mine ? k[2] : k[1]; k[2] = mine ? k[3] : k[2]; k[3] = mine ? 0u : k[3];
        res = (fr == rd) ? m : res;
    }
    return res;
}
__device__ const unsigned char CAND_AB[64] = {
    0x00, 0x01, 0x02, 0x03, 0x04, 0x05, 0x06, 0x07, 0x08, 0x09, 0x0a, 0x0b, 0x0c, 0x0d, 0x0e, 0x0f,
    0x10, 0x11, 0x12, 0x13, 0x14, 0x15, 0x16, 0x17, 0x20, 0x21, 0x22, 0x23, 0x24, 0x30, 0x31, 0x32,
    0x33, 0x40, 0x41, 0x42, 0x50, 0x51, 0x60, 0x61, 0x70, 0x71, 0x80, 0x90, 0xa0, 0xb0, 0xc0, 0xd0,
    0xe0, 0xf0, 0xff, 0xff, 0xff, 0xff, 0xff, 0xff, 0xff, 0xff, 0xff, 0xff, 0xff, 0xff, 0xff, 0xff};
__device__ __forceinline__ void p10_peer_route(const Ctx& C) {
    unsigned char* ws = C.ws; const int lane = C.lane, g = lane >> 4, fr = lane & 15;
    const bf16_t* qp = (const bf16_t*)C.dout; const bf16_t* keys = (const bf16_t*)(ws + WS_KEYS);
    int* experts = (int*)(ws + WS_EXPERTS); float* pgates = (float*)(ws + WS_PGATES);
    const unsigned cand4 = *(const unsigned*)(CAND_AB + 4 * fr);
    for (int task = C.gw; task < T / 2; task += C.ngw) {
        const int t0 = task * 2;
        unsigned sel[2][4];
#pragma unroll
        for (int p = 0; p < 2; ++p) {
            bf16x8 A[4];
#pragma unroll
            for (int kk = 0; kk < 4; ++kk) A[kk] = *(const bf16x8*)(qp + (size_t)(t0 + (fr >> 3)) * 2048 + (fr & 7) * 256 + p * 128 + 32 * kk + 8 * g);
            f32x4 acc[8];
#pragma unroll
            for (int i = 0; i < 8; ++i) { if ((i & 1) == 0) __builtin_amdgcn_sched_barrier(0); acc[i] = (f32x4){0.f, 0.f, 0.f, 0.f};
#pragma unroll
                for (int kk = 0; kk < 4; ++kk) { const bf16x8 Bk = *(const bf16x8*)(keys + (size_t)(p * 128 + 16 * i + fr) * 128 + 32 * kk + 8 * g);
                    acc[i] = __builtin_amdgcn_mfma_f32_16x16x32_bf16(A[kk], Bk, acc[i], 0, 0, 0); } }
#pragma unroll
            for (int r = 0; r < 4; ++r) { __builtin_amdgcn_sched_barrier(0); unsigned k[8];
#pragma unroll
                for (int i = 0; i < 8; ++i) k[i] = (f2key(acc[i][r]) & 0xffffff80u) | (unsigned)(16 * i + fr);
                sel[p][r] = pop16_of8(k, fr); }
        }
#pragma unroll
        for (int r = 0; r < 4; ++r) {
            __builtin_amdgcn_sched_barrier(0);
            const float s1 = key2f(sel[0][r] & 0xffffff80u), s2 = key2f(sel[1][r] & 0xffffff80u);
            unsigned k[4];
#pragma unroll
            for (int j = 0; j < 4; ++j) {
                const unsigned ab = (cand4 >> (8 * j)) & 0xffu; const unsigned msk = ab == 0xffu ? 0u : 0xffffffffu;
                const float va = __builtin_bit_cast(float, __builtin_amdgcn_ds_bpermute((int)(4u * (16u * g + (ab >> 4))), __builtin_bit_cast(int, s1)));
                const float vb = __builtin_bit_cast(float, __builtin_amdgcn_ds_bpermute((int)(4u * (16u * g + (ab & 15u))), __builtin_bit_cast(int, s2)));
                k[j] = ((f2key(va + vb) & 0xffffff00u) | ab) & msk;
            }
            const unsigned top = pop16_of4(k, fr);
            const int a = (int)((top >> 4) & 15u), b = (int)(top & 15u);
            const int i1 = __builtin_amdgcn_ds_bpermute(4 * (16 * g + a), (int)(sel[0][r] & 0x7fu));
            const int i2 = __builtin_amdgcn_ds_bpermute(4 * (16 * g + b), (int)(sel[1][r] & 0x7fu));
            const float sc = key2f(top & 0xffffff00u);
            const float mx = key2f(row_max_u(top) & 0xffffff00u);
            const float ev = __expf(sc - mx); const float sm = row_sum_f(ev);
            const int row = 4 * g + r; const size_t o = (size_t)(t0 + (row >> 3)) * 128 + (row & 7) * 16 + fr;
            experts[o] = i1 * 128 + i2; pgates[o] = ev / sm;
        }
    }
}
#undef CE_DESC

__device__ __forceinline__ float gelu_erf(float x) { return 0.5f * x * (1.0f + erff(x * 0.7071067811865476f)); }
__device__ __forceinline__ void p11_peer_experts(const Ctx& C) {
    unsigned char* ws = C.ws; const int lane = C.lane, g = lane >> 4, fr = lane & 15;
    const bf16_t* x1b = (const bf16_t*)(ws + WS_X1B); const float* x1 = (const float*)(ws + WS_X1);
    const bf16_t* ub = (const bf16_t*)(ws + WS_UB); const bf16_t* vb = (const bf16_t*)(ws + WS_VB);
    const int* experts = (const int*)(ws + WS_EXPERTS); const float* pgates = (const float*)(ws + WS_PGATES);
    float* out = (float*)C.dout; const float* gam = C.in[32]; const float* bet = C.in[33];
    LAS unsigned char* my = C.lds + C.wave * 4096;
    LAS float* cf = (LAS float*)(my + 2048); LAS int* eidl = (LAS int*)(my + 2560);
    for (int t = C.gw; t < T; t += C.ngw) {
        { const u32x4 a = *(const u32x4*)(x1b + (size_t)t * 1024 + 16 * lane), b = *(const u32x4*)(x1b + (size_t)t * 1024 + 16 * lane + 8);
          *(LAS u32x4*)(my + 32 * lane) = a; *(LAS u32x4*)(my + 32 * lane + 16) = b; }
        { const int e0 = experts[(size_t)t * 128 + lane], e1 = experts[(size_t)t * 128 + 64 + lane]; eidl[lane] = e0; eidl[64 + lane] = e1; }
        asm volatile("s_waitcnt lgkmcnt(0)" ::: "memory");
#pragma unroll 1
        for (int i = 0; i < 8; ++i) {
            const int e = eidl[16 * i + fr]; const bf16_t* urow = ub + (size_t)e * 1024 + 16 * g;
            f32x4 acc = (f32x4){0.f, 0.f, 0.f, 0.f};
#pragma unroll 4
            for (int m = 0; m < 16; ++m) {
                const bf16x8 a0 = *(const bf16x8*)(urow + 64 * m), a1 = *(const bf16x8*)(urow + 64 * m + 8);
                const bf16x8 b0 = *(const LAS bf16x8*)(my + 2 * (64 * m + 16 * g)), b1 = *(const LAS bf16x8*)(my + 2 * (64 * m + 16 * g + 8));
                acc = __builtin_amdgcn_mfma_f32_16x16x32_bf16(a0, b0, acc, 0, 0, 0);
                acc = __builtin_amdgcn_mfma_f32_16x16x32_bf16(a1, b1, acc, 0, 0, 0);
            }
            const f32x4 pg = *(const f32x4*)(pgates + (size_t)t * 128 + 16 * i + 4 * g);
            if (fr == 0) { *(LAS f32x4*)(cf + 16 * i + 4 * g) = (f32x4){pg.x * gelu_erf(acc[0]), pg.y * gelu_erf(acc[1]), pg.z * gelu_erf(acc[2]), pg.w * gelu_erf(acc[3])}; }
        }
        asm volatile("s_waitcnt lgkmcnt(0)" ::: "memory");
        float o[16];
#pragma unroll
        for (int j = 0; j < 16; ++j) o[j] = 0.f;
#pragma unroll 4
        for (int k = 0; k < 128; ++k) {
            const int e = __builtin_amdgcn_readfirstlane(eidl[k]); const float c = cf[k];
            const bf16_t* vrow = vb + (size_t)e * 1024;
            float a[8], b[8]; unpack8(*(const u32x4*)(vrow + 8 * lane), a); unpack8(*(const u32x4*)(vrow + 512 + 8 * lane), b);
#pragma unroll
            for (int j = 0; j < 8; ++j) { o[j] = fmaf(c, a[j], o[j]); o[8 + j] = fmaf(c, b[j], o[8 + j]); }
        }
        float s = 0.f;
#pragma unroll
        for (int hh = 0; hh < 2; ++hh) { const float* xp = x1 + (size_t)t * 1024 + hh * 512 + 8 * lane; const f32x4 a = *(const f32x4*)xp, b = *(const f32x4*)(xp + 4);
            o[8 * hh] += ALPHA * a.x; o[8 * hh + 1] += ALPHA * a.y; o[8 * hh + 2] += ALPHA * a.z; o[8 * hh + 3] += ALPHA * a.w;
            o[8 * hh + 4] += ALPHA * b.x; o[8 * hh + 5] += ALPHA * b.y; o[8 * hh + 6] += ALPHA * b.z; o[8 * hh + 7] += ALPHA * b.w; }
#pragma unroll
        for (int j = 0; j < 16; ++j) s += o[j];
        const float mean = wave_sum(s) * (1.0f / 1024.0f); float s2 = 0.f;
#pragma unroll
        for (int j = 0; j < 16; ++j) { o[j] -= mean; s2 += o[j] * o[j]; }
        const float rstd = rsqrtf(wave_sum(s2) * (1.0f / 1024.0f) + 1e-5f);
#pragma unroll
        for (int hh = 0; hh < 2; ++hh) { const int c0 = hh * 512 + 8 * lane; float r[8];
#pragma unroll
            for (int j = 0; j < 8; ++j) r[j] = o[8 * hh + j] * rstd * gam[c0 + j] + bet[c0 + j];
            *(f32x4*)(out + (size_t)t * 1024 + c0) = (f32x4){r[0], r[1], r[2], r[3]}; *(f32x4*)(out + (size_t)t * 1024 + c0 + 4) = (f32x4){r[4], r[5], r[6], r[7]}; }
    }
}

constexpr int LDS_BYTES = 147456;
constexpr int LDS_MISC = 131072;
constexpr int NPHASE = 14;
constexpr int CW_BAR = 4096;

__global__ void __launch_bounds__(NTHREADS, 2) hybrid_fwd(Args args) {
    extern __shared__ __attribute__((aligned(16))) unsigned char lds_raw[];
    Ctx C;
    C.lds = (LAS unsigned char*)lds_raw;
    C.tid = threadIdx.x; C.lane = C.tid & 63; C.wave = __builtin_amdgcn_readfirstlane(C.tid >> 6);
    C.G = gridDim.x; C.gw = blockIdx.x * NWAVES + C.wave; C.ngw = C.G * NWAVES; C.gt = blockIdx.x * NTHREADS + C.tid; C.ngt = C.G * NTHREADS;
    C.in = args.in; C.ws = args.ws; C.dout = (unsigned char*)args.out;
    unsigned char* ws = args.ws; const float* const* in = args.in;
    volatile LAS unsigned* MISC = (volatile LAS unsigned*)(C.lds + LDS_MISC);
    if (C.tid < 64) MISC[C.tid] = 0u;
    __syncthreads();
    XcdBarrier bar; bar.bar = (unsigned*)(ws + WS_CTL) + CW_BAR; bar.x = 0; bar.st = nullptr;
    if (MK_N_LAUNCHES == 1) bar = xcd_barrier_post((unsigned*)(ws + WS_CTL) + CW_BAR, MISC + 8);
    const int lo = args.ph_lo, hi = args.ph_hi;
#define IN(k) (lo <= (k) && (k) < hi)
#define SEAM(k) do { if (IN(k) && IN((k) + 1)) xcd_barrier(bar); } while (0)
#define REP(k) for (int rep_ = 0; rep_ < (((PROBE_MASK >> (k)) & 1) ? 2 : 1); ++rep_)
    bf16_t* xb = (bf16_t*)(C.dout + DO_XB);

    if (IN(0)) REP(0) { p0_prologue(C); } SEAM(0);
    if (IN(1)) REP(1) {
        { pg8::Gemm gm{xb, (const bf16_t*)(ws + WS_WIN), T, 2816, 1024}; pg8::StaticOrder S; S.init(T, 2816, C.G, (int)blockIdx.x);
          EpiP1 E{(float*)(ws + WS_CSMALL), (bf16_t*)(ws + WS_RCOLS), (bf16_t*)(ws + WS_MEMQ)}; pg8::gemm_phase(C.lds, gm, S, E); }
        { pg8::Gemm gm{(const bf16_t*)(ws + WS_MEMB), (const bf16_t*)(ws + WS_WMEMKV), 1024, 1024, 1024}; pg8::StaticOrder S; S.init(1024, 1024, C.G, (int)blockIdx.x);
          EpiMemKV E{(bf16_t*)(ws + WS_KMEM), (bf16_t*)(ws + WS_VMEMT)}; pg8::gemm_phase(C.lds, gm, S, E); }
    } SEAM(1);
    if (IN(2)) REP(2) { p2_prep(C); } SEAM(2);
    if (IN(3)) REP(3) {
        { pg8::Gemm gm{(const bf16_t*)(ws + WS_LORAA), (const bf16_t*)(ws + WS_WLORA), T, 1536, 256}; pg8::StaticOrder S; S.init(T, 1536, C.G, (int)blockIdx.x);
          EpiLora E{(bf16_t*)(ws + WS_RW_E), (bf16_t*)(ws + WS_RW_A), (bf16_t*)(ws + WS_RW_G), in[11], in[13]}; pg8::gemm_phase(C.lds, gm, S, E); }
        { pg8::Gemm gm{(const bf16_t*)(ws + WS_CQN), (const bf16_t*)(ws + WS_WQ), T, 1280, 256}; pg8::StaticOrder S; S.init(T, 1280, C.G, (int)blockIdx.x);
          EpiQ E{(bf16_t*)(ws + WS_QLAT), (bf16_t*)(ws + WS_QIDX)}; pg8::gemm_phase(C.lds, gm, S, E); }
    } SEAM(3);
    if (IN(4)) { REP(14) { p4_indexer(C); } REP(15) { p4_memattn(C); } __syncthreads(); REP(16) { p4_rwkv_pass1(C); } } SEAM(4);
    if (IN(5)) { p5_rwkv_carry(C); __syncthreads(); REP(5) { p5_dsa_attn(C); } } SEAM(5);
    if (IN(6)) REP(6) { p6_rwkv_pass3(C); cvt_rows(in[0], (bf16_t*)(ws + WS_XB2), (size_t)T * D / 8, C.gt, C.ngt); } SEAM(6);
    if (IN(7)) REP(7) {
        pg8::Gemm gm{(const bf16_t*)(ws + WS_XB2), (const bf16_t*)(ws + WS_WG), T, 3072, 1024}; pg8::StaticOrder S; S.init(T, 3072, C.G, (int)blockIdx.x);
        EpiGates E{(bf16_t*)(ws + WS_GATES)}; pg8::gemm_phase(C.lds, gm, S, E);
    } SEAM(7);
    if (IN(8)) REP(8) {
        float* mf = (float*)C.dout; const bf16_t* gt = (const bf16_t*)(ws + WS_GATES); bf16_t* mb = (bf16_t*)(ws + WS_MERGEDB);
        { pg8::Gemm gm{(const bf16_t*)(ws + WS_OLAT), (const bf16_t*)(ws + WS_WOV), T, 1024, 1024}; pg8::StaticOrder S; S.init(T, 1024, C.G, (int)blockIdx.x);
          EpiMerge<0> E{gt, mf, mb}; pg8::gemm_phase(C.lds, gm, S, E); }
        { pg8::Gemm gm{(const bf16_t*)(ws + WS_YRWKV), (const bf16_t*)(ws + WS_WBRR), T, 1024, 512}; pg8::StaticOrder S; S.init(T, 1024, C.G, (int)blockIdx.x);
          EpiMerge<1> E{gt, mf, mb}; pg8::gemm_phase(C.lds, gm, S, E); }
        { pg8::Gemm gm{(const bf16_t*)(ws + WS_YMEM), (const bf16_t*)(ws + WS_WBRM), T, 1024, 512}; pg8::StaticOrder S; S.init(T, 1024, C.G, (int)blockIdx.x);
          EpiMerge<2> E{gt, mf, mb}; pg8::gemm_phase(C.lds, gm, S, E); }
    } SEAM(8);
    if (IN(9)) REP(9) {
        pg8::Gemm gm{(const bf16_t*)(ws + WS_MERGEDB), (const bf16_t*)(ws + WS_WOUT), T, 1024, 1024}; pg8::StaticOrder S; S.init(T, 1024, C.G, (int)blockIdx.x);
        EpiWout E{in[0], (float*)C.dout}; pg8::gemm_phase(C.lds, gm, S, E);
    } SEAM(9);
    if (IN(10)) REP(10) { p8_ln1(C); } SEAM(10);
    if (IN(11)) REP(11) {
        pg8::Gemm gm{(const bf16_t*)(ws + WS_X1B), (const bf16_t*)(ws + WS_WPEER), T, 2048, 1024}; pg8::StaticOrder S; S.init(T, 2048, C.G, (int)blockIdx.x);
        EpiPeerQ E{(bf16_t*)C.dout}; pg8::gemm_phase(C.lds, gm, S, E);
    } SEAM(11);
    if (IN(12)) REP(12) { p10_peer_route(C); } SEAM(12);
    if (IN(13)) REP(13) { p11_peer_experts(C); }
#undef IN
#undef SEAM
}

extern "C" void kernel_launch(void* const* d_in, const int* in_sizes, int n_in, void* d_out, int out_size, void* d_ws, size_t ws_size, hipStream_t stream) {
    static int grid = 0;
    if (grid == 0) {
        if (n_in != 34 || out_size != T * D || ws_size < WS_END) { fprintf(stderr, "kernel_launch: unexpected problem (n_in %d out %d ws %zu)\n", n_in, out_size, ws_size); grid = -1; return; }
        int dev = 0, cus = 0, per_cu = 0;
        if (hipGetDevice(&dev) != hipSuccess || hipDeviceGetAttribute(&cus, hipDeviceAttributeMultiprocessorCount, dev) != hipSuccess) { grid = -1; return; }
        if (hipFuncSetAttribute((const void*)hybrid_fwd, hipFuncAttributeMaxDynamicSharedMemorySize, LDS_BYTES) != hipSuccess) { fprintf(stderr, "kernel_launch: hipFuncSetAttribute failed\n"); grid = -1; return; }
        if (hipOccupancyMaxActiveBlocksPerMultiprocessor(&per_cu, (const void*)hybrid_fwd, NTHREADS, LDS_BYTES) != hipSuccess || per_cu < 1) { fprintf(stderr, "kernel_launch: occupancy query says %d\n", per_cu); }
        (void)hipGetLastError();
        grid = cus;
    }
    if (grid < 0) return;
    (void)hipMemsetAsync((char*)d_ws + WS_CTL, 0, 1 * MiB, stream);
    Args a{};
    for (int i = 0; i < 34; ++i) a.in[i] = (const float*)d_in[i];
    a.out = (float*)d_out; a.ws = (unsigned char*)d_ws; a.li = 0; a.pad = 0;
    if (MK_N_LAUNCHES == 1) { a.ph_lo = 0; a.ph_hi = NPHASE; hipLaunchKernelGGL(hybrid_fwd, dim3(grid), dim3(NTHREADS), LDS_BYTES, stream, a); }
    else for (int p = 0; p < NPHASE; ++p) { a.ph_lo = p; a.ph_hi = p + 1; a.li = p; hipLaunchKernelGGL(hybrid_fwd, dim3(grid), dim3(NTHREADS), LDS_BYTES, stream, a); }
}
```

```cpp
#include <hip/hip_runtime.h>
#include <stdint.h>
#include <stdio.h>

#ifndef MK_N_LAUNCHES
#define MK_N_LAUNCHES 1
#endif

#ifndef PROBE_MASK
#define PROBE_MASK 0
#endif
#define LAS __attribute__((address_space(3)))
typedef unsigned short bf16_t;
typedef short bf16x8 __attribute__((ext_vector_type(8)));
typedef float f32x4 __attribute__((ext_vector_type(4)));
typedef float f32x2 __attribute__((ext_vector_type(2)));
typedef unsigned u32x4 __attribute__((ext_vector_type(4)));
typedef unsigned u32x2 __attribute__((ext_vector_type(2)));

constexpr int NB = 4, SEQ = 4096, T = NB * SEQ, D = 1024;
constexpr int IN_W = 5800;
constexpr int RW = 512;
constexpr int NWAVES = 8, NTHREADS = 512;
constexpr float ALPHA = 1.189207115002721f;
constexpr int RCH = 64, RL = SEQ / RCH;

constexpr size_t MiB = 1u << 20;
constexpr size_t WS_CTL = 0;
constexpr size_t WS_WIN = 1 * MiB, WS_WG = 7 * MiB, WS_WLORA = 13 * MiB, WS_WQ = 14 * MiB, WS_WMEMKV = 15 * MiB, WS_WOV = 17 * MiB,
                 WS_WBRR = 19 * MiB, WS_WBRM = 20 * MiB, WS_WOUT = 21 * MiB, WS_WPEER = 23 * MiB, WS_KEYS = 27 * MiB;
constexpr size_t WS_CSMALL = 29 * MiB, WS_QLAT = 29 * MiB, WS_MERGEDB = 29 * MiB, WS_UB = 29 * MiB;
constexpr size_t WS_RCOLS = 61 * MiB, WS_QIDX = 61 * MiB, WS_YMEM = 69 * MiB, WS_OLAT = 85 * MiB, WS_VB = 61 * MiB, WS_EXPERTS = 93 * MiB, WS_PGATES = 101 * MiB;
constexpr size_t WS_MEMQ = 117 * MiB, WS_YRWKV = 117 * MiB;
constexpr size_t WS_RW_R = 133 * MiB, WS_RW_K = 149 * MiB, WS_RW_V = 165 * MiB, WS_RW_A = 181 * MiB, WS_RW_E = 197 * MiB, WS_RW_G = 213 * MiB;
constexpr size_t WS_GATES = 133 * MiB, WS_X1B = 133 * MiB, WS_X1 = 165 * MiB;
constexpr size_t WS_CQN = 229 * MiB, WS_KVL = 237 * MiB, WS_KIDX = 241 * MiB, WS_WIDX = 242 * MiB, WS_LORAA = 243 * MiB, WS_IDX = 243 * MiB,
                 WS_KMEM = 251 * MiB, WS_VMEMT = 252 * MiB, WS_MEMB = 253 * MiB, WS_END = 256 * MiB;
constexpr size_t DO_XB = 0, DO_PQ = 0;
constexpr size_t WS_XB2 = 29 * MiB;
constexpr int CW_DSAQ = 64;

__device__ __forceinline__ unsigned f2bf(float f) { unsigned u = __float_as_uint(f); return (u + 0x7fffu + ((u >> 16) & 1u)) >> 16; }
__device__ __forceinline__ unsigned pk2(float lo, float hi) { return f2bf(lo) | (f2bf(hi) << 16); }
__device__ __forceinline__ float bflo(unsigned w) { return __uint_as_float(w << 16); }
__device__ __forceinline__ float bfhi(unsigned w) { return __uint_as_float(w & 0xffff0000u); }
__device__ __forceinline__ float bf1(bf16_t h) { return __uint_as_float(((unsigned)h) << 16); }
template <int CTRL, int RM = 0xF> __device__ __forceinline__ float dpp_f(float v) { return __builtin_bit_cast(float, __builtin_amdgcn_update_dpp(0, __builtin_bit_cast(int, v), CTRL, RM, 0xF, false)); }
template <int CTRL> __device__ __forceinline__ unsigned dpp_u(unsigned v) { return (unsigned)__builtin_amdgcn_update_dpp(0, (int)v, CTRL, 0xF, 0xF, false); }
__device__ __forceinline__ float wave_sum(float v) {
    v += dpp_f<0x111>(v); v += dpp_f<0x112>(v); v += dpp_f<0x114>(v); v += dpp_f<0x118>(v);
    v += dpp_f<0x142, 0xA>(v); v += dpp_f<0x143, 0xC>(v);
    return __builtin_bit_cast(float, __builtin_amdgcn_readlane(__builtin_bit_cast(int, v), 63));
}
__device__ __forceinline__ unsigned row_max_u(unsigned x) {
    unsigned y = dpp_u<0x128>(x); x = x > y ? x : y; y = dpp_u<0x124>(x); x = x > y ? x : y; y = dpp_u<0x122>(x); x = x > y ? x : y; y = dpp_u<0x121>(x); x = x > y ? x : y; return x; }
__device__ __forceinline__ float row_sum_f(float x) { x += dpp_f<0x128>(x); x += dpp_f<0x124>(x); x += dpp_f<0x122>(x); x += dpp_f<0x121>(x); return x; }
__device__ __forceinline__ float key2f(unsigned k) { const unsigned b = (k & 0x80000000u) ? (k & 0x7fffffffu) : ~k; return __uint_as_float(b); }
__device__ __forceinline__ float sigmoidf_(float x) { return 1.0f / (1.0f + __expf(-x)); }
__device__ __forceinline__ unsigned f2key(float f) { unsigned b = __float_as_uint(f); if (f == 0.0f) b = 0u; return (b & 0x80000000u) ? ~b : (b | 0x80000000u); }
__device__ __forceinline__ u32x4 pack8(const float* v) { u32x4 w; w.x = pk2(v[0], v[1]); w.y = pk2(v[2], v[3]); w.z = pk2(v[4], v[5]); w.w = pk2(v[6], v[7]); return w; }
__device__ __forceinline__ void unpack8(u32x4 w, float* v) { v[0] = bflo(w.x); v[1] = bfhi(w.x); v[2] = bflo(w.y); v[3] = bfhi(w.y); v[4] = bflo(w.z); v[5] = bfhi(w.z); v[6] = bflo(w.w); v[7] = bfhi(w.w); }

#define XB_TMO      128
#define XB_XCNT(j)  (256  + 64 * (j))
#define XB_XSUB(j)  (1280 + 64 * (j))
#define XB_XGEN(j)  (2304 + 64 * (j))
#define XB_TOP      3328
#define XB_TOPGEN   3392
#define XCD_BAR_WORDS 3456
#define XB_SPIN_CAP (1u << 18)

__device__ __forceinline__ unsigned xb_ld(unsigned* p)              { return __hip_atomic_load(p, __ATOMIC_RELAXED, __HIP_MEMORY_SCOPE_AGENT); }
__device__ __forceinline__ unsigned xb_add(unsigned* p, unsigned v) { return __hip_atomic_fetch_add(p, v, __ATOMIC_RELAXED, __HIP_MEMORY_SCOPE_AGENT); }
__device__ __forceinline__ unsigned xb_xcc_id() { return (unsigned)__builtin_amdgcn_s_getreg((3 << 11) | 20) & 0xFu; }
#define XB_SPIN(cond, bar) do { unsigned _sp = 0; while (cond) { __builtin_amdgcn_s_sleep(1); \
    if ((++_sp & 255u) == 0u) { if (xb_ld(&(bar)[XB_TMO])) break; if (_sp > XB_SPIN_CAP) { atomicAdd(&(bar)[XB_TMO], 1u); break; } } } } while (0)

struct XcdBarrier {
    unsigned* bar; unsigned x;
    volatile LAS unsigned* st;
};
__device__ __forceinline__ XcdBarrier xcd_barrier_post(unsigned* bar, volatile LAS unsigned* st) {
    XcdBarrier b; b.bar = bar; b.x = xb_xcc_id(); b.st = st;
    if (threadIdx.x == 0) (void)xb_add(&bar[XB_XCNT(b.x)], 1u);
    return b;
}
__device__ __forceinline__ void xcd_barrier_complete(unsigned* bar, unsigned x, unsigned& nloc, unsigned& nx) {
    const unsigned G = gridDim.x * gridDim.y * gridDim.z;
    unsigned sum, cnt, mine, sp = 0u;
    for (;;) {
        sum = 0u; cnt = 0u; mine = 0u;
#pragma unroll
        for (unsigned j = 0; j < 16; ++j) { const unsigned c = xb_ld(&bar[XB_XCNT(j)]); sum += c; cnt += (c > 0u) ? 1u : 0u; mine = (j == x) ? c : mine; }
        if (sum == G) break;
        __builtin_amdgcn_s_sleep(1);
        if ((++sp & 255u) == 0u) { if (xb_ld(&bar[XB_TMO])) break; if (sp > XB_SPIN_CAP) { atomicAdd(&bar[XB_TMO], 1u); break; } }
    }
    nloc = mine > 0u ? mine : 1u; nx = cnt > 0u ? cnt : 1u;
}
__device__ __forceinline__ void xcd_barrier(const XcdBarrier& b) {
    asm volatile("s_waitcnt vmcnt(0)" ::: "memory");
    __syncthreads();
    if (threadIdx.x == 0) {
        unsigned* bar = b.bar;
        __builtin_amdgcn_s_waitcnt(0);
        unsigned nloc = b.st[0], nx = b.st[1];
        if (nloc == 0u) { xcd_barrier_complete(bar, b.x, nloc, nx); b.st[0] = nloc; b.st[1] = nx; }
        const unsigned old = xb_add(&bar[XB_XSUB(b.x)], 1u);
        const unsigned gen = old / nloc;
        if (old + 1u == (gen + 1u) * nloc) {
            __builtin_amdgcn_fence(__ATOMIC_RELEASE, "agent");
            asm volatile("s_waitcnt vmcnt(0)" ::: "memory");
            const unsigned og = xb_add(&bar[XB_TOP], 1u);
            const unsigned tg = og / nx;
            if (og + 1u == (tg + 1u) * nx) xb_add(&bar[XB_TOPGEN], 1u);
            else XB_SPIN(xb_ld(&bar[XB_TOPGEN]) == tg, bar);
            __builtin_amdgcn_fence(__ATOMIC_ACQUIRE, "agent");
            xb_add(&bar[XB_XGEN(b.x)], 1u);
            asm volatile("s_waitcnt vmcnt(0)" ::: "memory");
        } else {
            XB_SPIN(xb_ld(&bar[XB_XGEN(b.x)]) == gen, bar);
            __builtin_amdgcn_fence(__ATOMIC_ACQUIRE, "agent");
            asm volatile("s_waitcnt vmcnt(0)" ::: "memory");
        }
    }
    __syncthreads();
}

namespace pg8 {
constexpr int BM = 256, BK = 64, HALF = 128, HTB = HALF * BK * 2, STAGE_BYTES = 8 * HTB, NXCD = 8, WGM = 8;
__device__ __forceinline__ int lds_byte(int r, int c) { const int st = (r >> 4) * 2 + (c >> 5), rr = r & 15, cc = c & 31, ob = rr * 64 + cc * 2; return st * 1024 + (ob ^ (((ob >> 9) & 1) << 5)); }
__device__ __forceinline__ void stage_rc(int b, int& R, int& C) { const int st = b / 1024, sb = b % 1024, swz = sb ^ (((sb >> 9) & 1) << 5); R = (st >> 1) * 16 + swz / 64; C = (st & 1) * 32 + (swz % 64) / 2; }
__device__ __forceinline__ int perm32(int rho) { const int n = rho >> 4, i = rho & 15; return 8 * (i >> 2) + 4 * n + (i & 3); }
struct Unit { int pm, pn; };
struct Gemm { const bf16_t* A; const bf16_t* Bt; int M, N, K; };
struct StaticOrder {
    int nM, nN, nwg, G, c;
    __device__ void init(int M, int N, int G_, int c_) { nM = M / BM; nN = N / BM; nwg = nM * nN; G = G_; c = c_; }
    __device__ bool next(int i, Unit& u) const {
        const long L = (long)i * G + c; if (L >= nwg) return false;
        int wgid = (int)L; { const int q = nwg / NXCD, r = nwg % NXCD, xcd = wgid % NXCD, off = wgid / NXCD; wgid = (xcd < r ? xcd * (q + 1) : r * (q + 1) + (xcd - r) * q) + off; }
        const int nig = WGM * nN, gid = wgid / nig, fm = gid * WGM, gsz = (nM - fm) < WGM ? (nM - fm) : WGM;
        u.pm = fm + ((wgid % nig) % gsz); u.pn = (wgid % nig) / gsz; return true;
    }
};
template <class Epi>
__device__ __forceinline__ void gemm_phase(LAS unsigned char* lds, const Gemm g, const StaticOrder& S, const Epi& E) {
    const int tid = threadIdx.x, wid = __builtin_amdgcn_readfirstlane(tid >> 6), lane = tid & 63, wr = wid >> 2, wc = wid & 3, fr = lane & 15, fq = lane >> 4;
    const int K = g.K, nt = K / BK;
    unsigned voffA[2], voffB[2];
#pragma unroll
    for (int i = 0; i < 2; ++i) { int R, C; stage_rc(tid * 16 + i * 8192, R, C); const int Rb = (R & ~31) + perm32(R & 31);
        voffA[i] = (unsigned)(R * K + C) * 2u; voffB[i] = (unsigned)(Rb * K + C) * 2u; }
    const size_t kstep = (size_t)(BK * 2);
    const size_t hstep = (size_t)HALF * K * 2;
    const size_t tstep = 2 * hstep;
    const unsigned ldsw = (unsigned)wid * 1024u;
    const int aoff = lds_byte(wr * 64 + fr, fq * 8), boff = lds_byte(wc * 32 + fr, fq * 8);
#define PG8_SA(b, h) (((b) * 2 + (h)) * HTB)
#define PG8_SB(b, h) ((4 + (b) * 2 + (h)) * HTB)
#define PG8_STAGE(bufoff, gbase, voff) do { _Pragma("unroll") for (int _i = 0; _i < 2; ++_i) \
        __builtin_amdgcn_global_load_lds((const unsigned*)((const char*)(gbase) + (voff)[_i]), (LAS unsigned*)(lds + (bufoff) + ldsw + _i * 8192), 16, 0, 0); } while (0)
#define PG8_LDA(dst, b, h) do { _Pragma("unroll") for (int m = 0; m < 4; ++m) _Pragma("unroll") for (int k = 0; k < 2; ++k) dst[m][k] = *(const LAS bf16x8*)(lds + PG8_SA(b, h) + aoff + m * 2048 + k * 1024); } while (0)
#define PG8_LDB(dst, b, h) do { _Pragma("unroll") for (int n = 0; n < 2; ++n) _Pragma("unroll") for (int k = 0; k < 2; ++k) dst[n][k] = *(const LAS bf16x8*)(lds + PG8_SB(b, h) + boff + n * 2048 + k * 1024); } while (0)
#define PG8_MMA(ai, bj, At, Bt) do { __builtin_amdgcn_s_setprio(1); _Pragma("unroll") for (int m = 0; m < 4; ++m) _Pragma("unroll") for (int n = 0; n < 2; ++n) _Pragma("unroll") for (int k = 0; k < 2; ++k) \
        acc[ai][bj][m][n] = __builtin_amdgcn_mfma_f32_16x16x32_bf16(Bt[n][k], At[m][k], acc[ai][bj][m][n], 0, 0, 0); __builtin_amdgcn_s_setprio(0); } while (0)
#define PG8_WAIT_V(n) asm volatile("s_waitcnt vmcnt(" #n ")" ::: "memory")
#define PG8_WAIT_L(n) asm volatile("s_waitcnt lgkmcnt(" #n ")" ::: "memory")
#define PG8_BAR __builtin_amdgcn_s_barrier()
#define PG8_SCHED __builtin_amdgcn_sched_barrier(0)
    Unit cur, nxt; int ui = 0;
    if (!S.next(0, cur)) return;
    f32x4 acc[2][2][4][2];
#pragma unroll
    for (int a = 0; a < 2; ++a)
#pragma unroll
        for (int b = 0; b < 2; ++b)
#pragma unroll
            for (int m = 0; m < 4; ++m)
#pragma unroll
                for (int n = 0; n < 2; ++n) acc[a][b][m][n] = (f32x4){0.f, 0.f, 0.f, 0.f};
    bf16x8 At[4][2], B0[2][2], B1[2][2];
    const char* cA = (const char*)g.A + (size_t)cur.pm * tstep; const char* cB = (const char*)g.Bt + (size_t)cur.pn * tstep;
    PG8_STAGE(PG8_SB(0, 0), cB, voffB); PG8_STAGE(PG8_SA(0, 0), cA, voffA); PG8_STAGE(PG8_SB(0, 1), cB + hstep, voffB); PG8_STAGE(PG8_SA(0, 1), cA + hstep, voffA);
    if (wr == 1) PG8_BAR;
    PG8_WAIT_V(4); PG8_BAR;
    PG8_STAGE(PG8_SB(1, 0), cB + kstep, voffB); PG8_STAGE(PG8_SA(1, 0), cA + kstep, voffA); PG8_STAGE(PG8_SB(1, 1), cB + hstep + kstep, voffB);
    PG8_WAIT_V(6); PG8_BAR;
    for (;;) {
        const bool has_next = S.next(ui + 1, nxt);
        const char* nA = has_next ? (const char*)g.A + (size_t)nxt.pm * tstep : cA; const char* nB = has_next ? (const char*)g.Bt + (size_t)nxt.pn * tstep : cB;
#pragma unroll 1
        for (int t = 0; t < nt; t += 2) {
            const bool last = (t == nt - 2);
            const char* a1 = cA + (size_t)(t + 1) * kstep;
            const char* a2 = last ? nA : cA + (size_t)(t + 2) * kstep; const char* b2 = last ? nB : cB + (size_t)(t + 2) * kstep;
            const char* a3 = a2 + kstep; const char* b3 = b2 + kstep;
            PG8_LDB(B0, 0, 0); PG8_SCHED; PG8_LDA(At, 0, 0); PG8_STAGE(PG8_SA(1, 1), a1 + hstep, voffA);
            PG8_WAIT_L(8); PG8_BAR; PG8_WAIT_L(0); PG8_MMA(0, 0, At, B0); PG8_BAR; PG8_SCHED;
            PG8_LDB(B1, 0, 1); PG8_STAGE(PG8_SB(0, 0), b2, voffB);
            PG8_BAR; PG8_WAIT_L(0); PG8_MMA(0, 1, At, B1); PG8_BAR;
            PG8_LDA(At, 0, 1); PG8_STAGE(PG8_SA(0, 0), a2, voffA);
            PG8_BAR; PG8_WAIT_L(0); PG8_MMA(1, 0, At, B0); PG8_BAR; PG8_SCHED;
            PG8_STAGE(PG8_SB(0, 1), b2 + hstep, voffB);
            PG8_WAIT_V(6); PG8_BAR; PG8_MMA(1, 1, At, B1); PG8_BAR;
            PG8_LDB(B0, 1, 0); PG8_SCHED; PG8_LDA(At, 1, 0); PG8_STAGE(PG8_SA(0, 1), a2 + hstep, voffA);
            PG8_WAIT_L(8); PG8_BAR; PG8_WAIT_L(0); PG8_MMA(0, 0, At, B0); PG8_BAR; PG8_SCHED;
            PG8_LDB(B1, 1, 1); PG8_STAGE(PG8_SB(1, 0), b3, voffB);
            PG8_BAR; PG8_WAIT_L(0); PG8_MMA(0, 1, At, B1); PG8_BAR;
            PG8_LDA(At, 1, 1); PG8_STAGE(PG8_SA(1, 0), a3, voffA);
            PG8_BAR; PG8_WAIT_L(0); PG8_MMA(1, 0, At, B0); PG8_BAR; PG8_SCHED;
            PG8_STAGE(PG8_SB(1, 1), b3 + hstep, voffB);
            PG8_WAIT_V(6); PG8_BAR; PG8_MMA(1, 1, At, B1); PG8_BAR;
        }
        {
            const int row0 = cur.pm * BM + wr * 64 + fr, col0 = cur.pn * BM + wc * 32 + 8 * fq;
#pragma unroll
            for (int ai = 0; ai < 2; ++ai)
#pragma unroll
                for (int m = 0; m < 4; ++m)
#pragma unroll
                    for (int bj = 0; bj < 2; ++bj) { E(row0 + ai * HALF + m * 16, col0 + bj * HALF, cur.pn, acc[ai][bj][m][0], acc[ai][bj][m][1]); if (Epi::SERIAL) __builtin_amdgcn_sched_barrier(0); }
        }
        if (!has_next) break;
#pragma unroll
        for (int a = 0; a < 2; ++a)
#pragma unroll
            for (int b = 0; b < 2; ++b)
#pragma unroll
                for (int m = 0; m < 4; ++m)
#pragma unroll
                    for (int n = 0; n < 2; ++n) acc[a][b][m][n] = (f32x4){0.f, 0.f, 0.f, 0.f};
        cur = nxt; cA = nA; cB = nB; ++ui;
    }
    PG8_WAIT_V(0);
    if (wr == 0) PG8_BAR;
    PG8_BAR;
#undef PG8_SA
#undef PG8_SB
#undef PG8_STAGE
#undef PG8_LDA
#undef PG8_LDB
#undef PG8_MMA
#undef PG8_WAIT_V
#undef PG8_WAIT_L
#undef PG8_BAR
#undef PG8_SCHED
}
}

struct Args { const float* in[34]; float* out; unsigned char* ws; int ph_lo, ph_hi, li, pad; };

struct Ctx {
    LAS unsigned char* lds;
    int tid, lane, wave, gw, ngw, gt, ngt, G;
    const float* const* in; unsigned char* ws; unsigned char* dout;
};

__device__ __forceinline__ void st8_bf16(bf16_t* p, f32x4 a, f32x4 b) { u32x4 w; w.x = pk2(a.x, a.y); w.y = pk2(a.z, a.w); w.z = pk2(b.x, b.y); w.w = pk2(b.z, b.w); *(u32x4*)p = w; }
struct EpiP1 { static constexpr bool SERIAL = false;
    float* cs; bf16_t* rc; bf16_t* mq;
    __device__ __forceinline__ void operator()(int row, int col, int pn, f32x4 a, f32x4 b) const {
        if (pn < 2) { float* p = cs + (size_t)row * 512 + col; *(f32x4*)p = a; *(f32x4*)(p + 4) = b; }
        else if (pn < 9) st8_bf16(rc + (size_t)row * 1792 + (col - 512), a, b);
        else st8_bf16(mq + (size_t)row * 512 + (col - 2304), a, b);
    }
};
struct EpiMemKV { static constexpr bool SERIAL = false;
    bf16_t* km; bf16_t* vt;
    __device__ __forceinline__ void operator()(int row, int col, int pn, f32x4 a, f32x4 b) const {
        const int bb = row >> 8, m = row & 255;
        if (col < 512) { const int h = col >> 7, d = col & 127; st8_bf16(km + ((size_t)((bb * 4 + h) * 256 + m)) * 128 + d, a, b); }
        else { const int c2 = col - 512, h = c2 >> 7, d = c2 & 127; bf16_t* p = vt + ((size_t)((bb * 4 + h) * 128 + d)) * 256 + m;
            p[0] = (bf16_t)f2bf(a.x); p[256] = (bf16_t)f2bf(a.y); p[512] = (bf16_t)f2bf(a.z); p[768] = (bf16_t)f2bf(a.w);
            p[1024] = (bf16_t)f2bf(b.x); p[1280] = (bf16_t)f2bf(b.y); p[1536] = (bf16_t)f2bf(b.z); p[1792] = (bf16_t)f2bf(b.w); }
    }
};
struct EpiLora { static constexpr bool SERIAL = true;
    bf16_t* e; bf16_t* a; bf16_t* g; const float* w0; const float* a0;
    __device__ __forceinline__ void operator()(int row, int col, int pn, f32x4 x, f32x4 y) const {
        float v[8] = {x.x, x.y, x.z, x.w, y.x, y.y, y.z, y.w};
        if (pn < 4) { const int c = col & 511; const float* bp = (pn < 2 ? w0 : a0) + c; const f32x4 b0 = *(const f32x4*)bp, b1 = *(const f32x4*)(bp + 4);
            const float bb[8] = {b0.x, b0.y, b0.z, b0.w, b1.x, b1.y, b1.z, b1.w}; const float sc = pn < 2 ? 0.6065306597126334f : 1.0f;
#pragma unroll
            for (int j = 0; j < 8; ++j) v[j] = sc * sigmoidf_(v[j] + bb[j]);
            *(u32x4*)((pn < 2 ? e : a) + (size_t)row * 512 + c) = pack8(v);
        } else *(u32x4*)(g + (size_t)row * 512 + (col - 1024)) = pack8(v);
    }
};
struct EpiQ { static constexpr bool SERIAL = false;
    bf16_t* ql; bf16_t* qi;
    __device__ __forceinline__ void operator()(int row, int col, int pn, f32x4 a, f32x4 b) const {
        if (pn < 4) st8_bf16(ql + (size_t)row * 1024 + col, a, b); else st8_bf16(qi + (size_t)row * 256 + (col - 1024), a, b);
    }
};
struct EpiGates { static constexpr bool SERIAL = true;
    bf16_t* o;
    __device__ __forceinline__ void operator()(int row, int col, int pn, f32x4 a, f32x4 b) const {
        float v[8] = {a.x, a.y, a.z, a.w, b.x, b.y, b.z, b.w};
#pragma unroll
        for (int j = 0; j < 8; ++j) v[j] = sigmoidf_(v[j]);
        *(u32x4*)(o + (size_t)row * 3072 + col) = pack8(v);
    }
};
template <int WHICH> struct EpiMerge { static constexpr bool SERIAL = true;
    const bf16_t* gates; float* mf; bf16_t* mb;
    __device__ __forceinline__ void operator()(int row, int col, int pn, f32x4 a, f32x4 b) const {
        float v[8] = {a.x, a.y, a.z, a.w, b.x, b.y, b.z, b.w}, gv[8];
        unpack8(*(const u32x4*)(gates + (size_t)row * 3072 + WHICH * 1024 + col), gv);
        float* p = mf + (size_t)row * 1024 + col;
        if (WHICH == 0) {
#pragma unroll
            for (int j = 0; j < 8; ++j) v[j] *= gv[j];
        } else { const f32x4 p0 = *(const f32x4*)p, p1 = *(const f32x4*)(p + 4); const float pv[8] = {p0.x, p0.y, p0.z, p0.w, p1.x, p1.y, p1.z, p1.w};
#pragma unroll
            for (int j = 0; j < 8; ++j) v[j] = pv[j] + v[j] * gv[j];
        }
        if (WHICH == 2) *(u32x4*)(mb + (size_t)row * 1024 + col) = pack8(v);
        else { *(f32x4*)p = (f32x4){v[0], v[1], v[2], v[3]}; *(f32x4*)(p + 4) = (f32x4){v[4], v[5], v[6], v[7]}; }
    }
};
struct EpiWout { static constexpr bool SERIAL = false;
    const float* x; float* pre;
    __device__ __forceinline__ void operator()(int row, int col, int pn, f32x4 a, f32x4 b) const {
        const float* xp = x + (size_t)row * 1024 + col; float* p = pre + (size_t)row * 1024 + col;
        *(f32x4*)p = *(const f32x4*)xp * ALPHA + a; *(f32x4*)(p + 4) = *(const f32x4*)(xp + 4) * ALPHA + b;
    }
};
struct EpiPeerQ { static constexpr bool SERIAL = false; bf16_t* o; __device__ __forceinline__ void operator()(int row, int col, int pn, f32x4 a, f32x4 b) const { st8_bf16(o + (size_t)row * 2048 + col, a, b); } };

template <int N, int K, class F> __device__ __forceinline__ void build_bt(bf16_t* dst, const F& f, int gt, int ngt) {
    constexpr int items = N * (K / 8);
    for (int i = gt; i < items; i += ngt) { const int n = i % N, k0 = (i / N) * 8; float v[8];
#pragma unroll
        for (int j = 0; j < 8; ++j) v[j] = f(n, k0 + j);
        *(u32x4*)(dst + (size_t)n * K + k0) = pack8(v); }
}
struct FWin { const float* w; __device__ __forceinline__ float operator()(int n, int k) const { if (n < 424) return w[(size_t)k * IN_W + n]; if (n < 512) return 0.f; return w[(size_t)k * IN_W + n - 88]; } };
struct FWg { const float* w; __device__ __forceinline__ float operator()(int n, int k) const { return w[(size_t)k * IN_W + 2728 + n]; } };
struct FLora { const float *w2, *a2, *g2; __device__ __forceinline__ float operator()(int n, int k) const {
    if (n < 512) return k < 64 ? w2[k * 512 + n] : 0.f;
    if (n < 1024) return (k >= 64 && k < 128) ? a2[(k - 64) * 512 + n - 512] : 0.f;
    return k >= 128 ? g2[(k - 128) * 512 + n - 1024] : 0.f; } };
struct FWq { const float *uq, *uk, *iq; __device__ __forceinline__ float operator()(int n, int k) const {
    if (n >= 1024) return iq[k * 256 + n - 1024];
    const int h = n >> 7, c = n & 127; const float* a = uq + (size_t)k * 512 + h * 64; const float* b = uk + (size_t)(c * 8 + h) * 64; float s = 0.f;
#pragma unroll 8
    for (int d = 0; d < 64; ++d) s = fmaf(a[d], b[d], s);
    return s * 0.125f; } };
struct FWov { const float *uv, *br; __device__ __forceinline__ float operator()(int n, int k) const {
    const int h = k >> 7, c = k & 127; const float* a = uv + (size_t)(c * 8 + h) * 64; const float* b = br + (size_t)(h * 64) * 1024 + n; float s = 0.f;
#pragma unroll 8
    for (int d = 0; d < 64; ++d) s = fmaf(a[d], b[(size_t)d * 1024], s);
    return s; } };
struct FT { const float* w; int ld; __device__ __forceinline__ float operator()(int n, int k) const { return w[(size_t)k * ld + n]; } };

__device__ __forceinline__ void cvt_rows(const float* src, bf16_t* dst, size_t n8, int gt, int ngt) {
    for (size_t i = gt; i < n8; i += ngt) { const f32x4 a = *(const f32x4*)(src + i * 8), b = *(const f32x4*)(src + i * 8 + 4); st8_bf16(dst + i * 8, a, b); }
}
constexpr float PEER_U_SCALE = 64.0f, PEER_V_SCALE = 8.0f;
__device__ __forceinline__ void cvt_rows_fp8(const float* src, unsigned char* dst, size_t n16, float scale, int gt, int ngt) {
    for (size_t i = gt; i < n16; i += ngt) { const float* p = src + i * 16; u32x4 w;
        const f32x4 a = *(const f32x4*)p * scale, b = *(const f32x4*)(p + 4) * scale, c = *(const f32x4*)(p + 8) * scale, d = *(const f32x4*)(p + 12) * scale;
        int t = 0; t = __builtin_amdgcn_cvt_pk_fp8_f32(a.x, a.y, t, false); t = __builtin_amdgcn_cvt_pk_fp8_f32(a.z, a.w, t, true); w.x = (unsigned)t;
        t = 0; t = __builtin_amdgcn_cvt_pk_fp8_f32(b.x, b.y, t, false); t = __builtin_amdgcn_cvt_pk_fp8_f32(b.z, b.w, t, true); w.y = (unsigned)t;
        t = 0; t = __builtin_amdgcn_cvt_pk_fp8_f32(c.x, c.y, t, false); t = __builtin_amdgcn_cvt_pk_fp8_f32(c.z, c.w, t, true); w.z = (unsigned)t;
        t = 0; t = __builtin_amdgcn_cvt_pk_fp8_f32(d.x, d.y, t, false); t = __builtin_amdgcn_cvt_pk_fp8_f32(d.z, d.w, t, true); w.w = (unsigned)t;
        *(u32x4*)(dst + i * 16) = w; }
}
__device__ __forceinline__ void p0_prologue(const Ctx& C) {
    const float* const* in = C.in; unsigned char* ws = C.ws;
    cvt_rows(in[0], (bf16_t*)(C.dout + DO_XB), (size_t)T * D / 8, C.gt, C.ngt);
    cvt_rows(in[1], (bf16_t*)(ws + WS_MEMB), (size_t)1024 * 1024 / 8, C.gt, C.ngt);
    cvt_rows(in[29], (bf16_t*)(ws + WS_KEYS), (size_t)2 * 128 * 128 / 8, C.gt, C.ngt);
    build_bt<2816, 1024>((bf16_t*)(ws + WS_WIN), FWin{in[3]}, C.gt, C.ngt);
    build_bt<3072, 1024>((bf16_t*)(ws + WS_WG), FWg{in[3]}, C.gt, C.ngt);
    build_bt<1536, 256>((bf16_t*)(ws + WS_WLORA), FLora{in[12], in[14], in[15]}, C.gt, C.ngt);
    build_bt<1280, 256>((bf16_t*)(ws + WS_WQ), FWq{in[6], in[7], in[9]}, C.gt, C.ngt);
    build_bt<1024, 1024>((bf16_t*)(ws + WS_WMEMKV), FT{in[21], 1024}, C.gt, C.ngt);
    build_bt<1024, 1024>((bf16_t*)(ws + WS_WOV), FWov{in[8], in[22]}, C.gt, C.ngt);
    build_bt<1024, 512>((bf16_t*)(ws + WS_WBRR), FT{in[23], 1024}, C.gt, C.ngt);
    build_bt<1024, 512>((bf16_t*)(ws + WS_WBRM), FT{in[24], 1024}, C.gt, C.ngt);
    build_bt<1024, 1024>((bf16_t*)(ws + WS_WOUT), FT{in[25], 1024}, C.gt, C.ngt);
    build_bt<2048, 1024>((bf16_t*)(ws + WS_WPEER), FT{in[28], 2048}, C.gt, C.ngt);
}

__device__ __forceinline__ void p2_prep(const Ctx& C) {
    const float* const* in = C.in; unsigned char* ws = C.ws; const int lane = C.lane;
    const float* csmall = (const float*)(ws + WS_CSMALL); const bf16_t* rcols = (const bf16_t*)(ws + WS_RCOLS);
    bf16_t* cqn = (bf16_t*)(ws + WS_CQN); bf16_t* kvl = (bf16_t*)(ws + WS_KVL); bf16_t* kidx = (bf16_t*)(ws + WS_KIDX); float* widx = (float*)(ws + WS_WIDX);
    bf16_t* rr = (bf16_t*)(ws + WS_RW_R); bf16_t* rk = (bf16_t*)(ws + WS_RW_K); bf16_t* rv = (bf16_t*)(ws + WS_RW_V); bf16_t* la = (bf16_t*)(ws + WS_LORAA);
    const float* mu = in[10];
    const f32x4 gq = *(const f32x4*)(in[4] + 4 * lane); const f32x2 gk = *(const f32x2*)(in[5] + 2 * lane);
    for (int t = C.gw; t < T; t += C.ngw) {
        const float* cs = csmall + (size_t)t * 512;
        {
            const f32x4 q = *(const f32x4*)(cs + 4 * lane);
            const float ss = wave_sum(q.x * q.x + q.y * q.y + q.z * q.z + q.w * q.w);
            const float rs = rsqrtf(ss * (1.0f / 256.0f) + 1e-6f);
            u32x2 w; w.x = pk2(q.x * rs * gq.x, q.y * rs * gq.y); w.y = pk2(q.z * rs * gq.z, q.w * rs * gq.w);
            *(u32x2*)(cqn + (size_t)t * 256 + 4 * lane) = w;
        }
        {
            const f32x2 k = *(const f32x2*)(cs + 256 + 2 * lane);
            const float ss = wave_sum(k.x * k.x + k.y * k.y);
            const float rs = rsqrtf(ss * (1.0f / 128.0f) + 1e-6f);
            *(unsigned*)(kvl + (size_t)t * 128 + 2 * lane) = pk2(k.x * rs * gk.x, k.y * rs * gk.y);
        }
        if (lane < 16) { const f32x2 k = *(const f32x2*)(cs + 384 + 2 * lane); *(unsigned*)(kidx + (size_t)t * 32 + 2 * lane) = pk2(k.x, k.y); }
        if (lane < 8) widx[(size_t)t * 8 + lane] = cs[416 + lane] * 0.0625f;
        const bf16_t* rc = rcols + (size_t)t * 1792; const bool hp = (t & (SEQ - 1)) != 0; const bf16_t* rp = hp ? rc - 1792 : rc;
#pragma unroll
        for (int seg = 0; seg < 3; ++seg) {
            float c[8], p[8], o[8];
            unpack8(*(const u32x4*)(rc + seg * 512 + 8 * lane), c); unpack8(*(const u32x4*)(rp + seg * 512 + 8 * lane), p);
            const f32x4 m0 = *(const f32x4*)(mu + seg * 512 + 8 * lane), m1 = *(const f32x4*)(mu + seg * 512 + 8 * lane + 4);
            const float mm[8] = {m0.x, m0.y, m0.z, m0.w, m1.x, m1.y, m1.z, m1.w};
#pragma unroll
            for (int j = 0; j < 8; ++j) { const float pv = hp ? p[j] : 0.f; o[j] = c[j] + (pv - c[j]) * mm[j]; }
            bf16_t* dst = (seg == 0 ? rr : (seg == 1 ? rk : rv)) + (size_t)t * 512 + 8 * lane;
            *(u32x4*)dst = pack8(o);
        }
        {
            const float cw = bf1(rc[1536 + lane]), pw = hp ? bf1(rp[1536 + lane]) : 0.f; const float wl = cw + (pw - cw) * mu[1536 + lane];
            const float ca = bf1(rc[1600 + lane]), pa = hp ? bf1(rp[1600 + lane]) : 0.f; const float al = ca + (pa - ca) * mu[1600 + lane];
            const unsigned cgw = *(const unsigned*)(rc + 1664 + 2 * lane), pgw = *(const unsigned*)(rp + 1664 + 2 * lane);
            const float cg0 = bflo(cgw), cg1 = bfhi(cgw), pg0 = hp ? bflo(pgw) : 0.f, pg1 = hp ? bfhi(pgw) : 0.f;
            const float g0 = cg0 + (pg0 - cg0) * mu[1664 + 2 * lane], g1 = cg1 + (pg1 - cg1) * mu[1664 + 2 * lane + 1];
            bf16_t* l = la + (size_t)t * 256;
            l[lane] = (bf16_t)f2bf(tanhf(wl)); l[64 + lane] = (bf16_t)f2bf(al);
            *(unsigned*)(l + 128 + 2 * lane) = pk2(sigmoidf_(g0), sigmoidf_(g1));
        }
    }
}

template <int NV> __device__ __forceinline__ unsigned kth_largest(const unsigned (&u)[NV], int k) {
    unsigned Tk = 0u;
    for (int bit = 31; bit >= 0; --bit) {
        const unsigned cand = Tk | (1u << bit); int cnt = 0;
#pragma unroll
        for (int j = 0; j < NV; ++j) cnt += __popcll(__ballot(u[j] >= cand));
        if (cnt >= k) Tk = cand;
    }
    return Tk;
}

__device__ __forceinline__ unsigned wave_max_u(unsigned x) {
    unsigned y;
    y = dpp_u<0x111>(x); x = x > y ? x : y; y = dpp_u<0x112>(x); x = x > y ? x : y; y = dpp_u<0x114>(x); x = x > y ? x : y; y = dpp_u<0x118>(x); x = x > y ? x : y;
    y = (unsigned)__builtin_amdgcn_update_dpp(0, (int)x, 0x142, 0xA, 0xF, false); x = x > y ? x : y;
    y = (unsigned)__builtin_amdgcn_update_dpp(0, (int)x, 0x143, 0xC, 0xF, false); x = x > y ? x : y;
    return (unsigned)__builtin_amdgcn_readlane((int)x, 63);
}
__device__ __forceinline__ int wave_sum_i(int x) {
    x += __builtin_amdgcn_update_dpp(0, x, 0x111, 0xF, 0xF, false); x += __builtin_amdgcn_update_dpp(0, x, 0x112, 0xF, 0xF, false);
    x += __builtin_amdgcn_update_dpp(0, x, 0x114, 0xF, 0xF, false); x += __builtin_amdgcn_update_dpp(0, x, 0x118, 0xF, 0xF, false);
    x += __builtin_amdgcn_update_dpp(0, x, 0x142, 0xA, 0xF, false); x += __builtin_amdgcn_update_dpp(0, x, 0x143, 0xC, 0xF, false);
    return __builtin_amdgcn_readlane(x, 63);
}
__device__ __forceinline__ float wave_max_f(float x) {
    const int ninf = (int)0xff800000u; float y;
    y = __builtin_bit_cast(float, __builtin_amdgcn_update_dpp(ninf, __builtin_bit_cast(int, x), 0x111, 0xF, 0xF, false)); x = fmaxf(x, y);
    y = __builtin_bit_cast(float, __builtin_amdgcn_update_dpp(ninf, __builtin_bit_cast(int, x), 0x112, 0xF, 0xF, false)); x = fmaxf(x, y);
    y = __builtin_bit_cast(float, __builtin_amdgcn_update_dpp(ninf, __builtin_bit_cast(int, x), 0x114, 0xF, 0xF, false)); x = fmaxf(x, y);
    y = __builtin_bit_cast(float, __builtin_amdgcn_update_dpp(ninf, __builtin_bit_cast(int, x), 0x118, 0xF, 0xF, false)); x = fmaxf(x, y);
    y = __builtin_bit_cast(float, __builtin_amdgcn_update_dpp(ninf, __builtin_bit_cast(int, x), 0x142, 0xA, 0xF, false)); x = fmaxf(x, y);
    y = __builtin_bit_cast(float, __builtin_amdgcn_update_dpp(ninf, __builtin_bit_cast(int, x), 0x143, 0xC, 0xF, false)); x = fmaxf(x, y);
    return __builtin_bit_cast(float, __builtin_amdgcn_readlane(__builtin_bit_cast(int, x), 63));
}
__device__ __forceinline__ int wave_scan_i(int x) {
    x += __builtin_amdgcn_update_dpp(0, x, 0x111, 0xF, 0xF, false); x += __builtin_amdgcn_update_dpp(0, x, 0x112, 0xF, 0xF, false);
    x += __builtin_amdgcn_update_dpp(0, x, 0x114, 0xF, 0xF, false); x += __builtin_amdgcn_update_dpp(0, x, 0x118, 0xF, 0xF, false);
    x += __builtin_amdgcn_update_dpp(0, x, 0x142, 0xA, 0xF, false); x += __builtin_amdgcn_update_dpp(0, x, 0x143, 0xC, 0xF, false);
    return x;
}
__device__ __forceinline__ int hist_find(u32x4 h, int K, int lane, int& chi, int& cnt) {
    const int ls = (int)(h.x + h.y + h.z + h.w); const int inc = wave_scan_i(ls); const int tot = __builtin_amdgcn_readlane(inc, 63);
    const int a3 = tot - inc, a2 = a3 + (int)h.w, a1 = a2 + (int)h.z, a0 = a1 + (int)h.y;
    int myb = -1, mya = 0, myc = 0;
    if (a3 < K && K <= a3 + (int)h.w) { myb = 3; mya = a3; myc = (int)h.w; }
    if (a2 < K && K <= a2 + (int)h.z) { myb = 2; mya = a2; myc = (int)h.z; }
    if (a1 < K && K <= a1 + (int)h.y) { myb = 1; mya = a1; myc = (int)h.y; }
    if (a0 < K && K <= a0 + (int)h.x) { myb = 0; mya = a0; myc = (int)h.x; }
    const unsigned long long m = __ballot(myb >= 0); const int src = m ? (int)__builtin_ctzll(m) : 0;
    chi = __builtin_amdgcn_readlane(mya, src); cnt = __builtin_amdgcn_readlane(myc, src);
    return 4 * src + __builtin_amdgcn_readlane(myb, src);
}
constexpr int LDS_HIST = 131072 + 4096;
__device__ __forceinline__ void p4_indexer(const Ctx& C) {
    unsigned char* ws = C.ws; const int lane = C.lane, wave = C.wave, g = lane >> 4, fr = lane & 15;
    const bf16_t* qidx = (const bf16_t*)(ws + WS_QIDX); const bf16_t* kidx = (const bf16_t*)(ws + WS_KIDX); const float* widx = (const float*)(ws + WS_WIDX);
    bf16_t* idxo = (bf16_t*)(ws + WS_IDX);
    LAS float* SC = (LAS float*)C.lds;
    LAS unsigned* H = (LAS unsigned*)(C.lds + LDS_HIST + wave * 1024);
    for (int u = blockIdx.x; u < 2048; u += C.G) {
        const int i8 = u >> 8, cc = u & 255, b = cc & 3, j = cc >> 2, qb = (i8 & 1) ? 64 * i8 + 63 - j : 64 * i8 + j;
        const int t0 = qb * 8, ntile = (t0 + 8 + 15) >> 4; const size_t tb = (size_t)b * SEQ;
        const int qn = fr & 7;
        bf16x8 Bq[8];
#pragma unroll
        for (int h = 0; h < 8; ++h) Bq[h] = *(const bf16x8*)(qidx + (tb + t0 + qn) * 256 + h * 32 + 8 * g);
        const f32x4 w0 = *(const f32x4*)(widx + (tb + t0 + qn) * 8), w1 = *(const f32x4*)(widx + (tb + t0 + qn) * 8 + 4);
        const float wq[8] = {w0.x, w0.y, w0.z, w0.w, w1.x, w1.y, w1.z, w1.w};
        for (int i0 = wave; i0 < ntile; i0 += 4 * NWAVES) {
            bf16x8 A[4];
#pragma unroll
            for (int q = 0; q < 4; ++q) { int i = i0 + q * NWAVES; i = i < ntile ? i : ntile - 1; A[q] = *(const bf16x8*)(kidx + (tb + 16 * i + fr) * 32 + 8 * g); }
#pragma unroll
            for (int q = 0; q < 4; ++q) {
                const int i = i0 + q * NWAVES;
                if (i < ntile) {
                    f32x4 sc = (f32x4){0.f, 0.f, 0.f, 0.f};
#pragma unroll
                    for (int h = 0; h < 8; ++h) { const f32x4 d = __builtin_amdgcn_mfma_f32_16x16x32_bf16(A[q], Bq[h], (f32x4){0.f, 0.f, 0.f, 0.f}, 0, 0, 0);
#pragma unroll
                        for (int r = 0; r < 4; ++r) sc[r] = fmaf(wq[h], fmaxf(d[r], 0.f), sc[r]); }
                    if (fr < 8) { const int tq = t0 + fr, s0 = 16 * i + 4 * g;
#pragma unroll
                        for (int r = 0; r < 4; ++r) sc[r] = (s0 + r <= tq) ? sc[r] : -INFINITY;
                        *(LAS f32x4*)(SC + fr * 4096 + s0) = sc; }
                }
            }
        }
        __syncthreads();
        {
            const int tq = t0 + wave; bf16_t* out = idxo + (tb + tq) * 256;
            if (tq < 256) {
#pragma unroll
                for (int jj = 0; jj < 4; ++jj) { const int s = jj * 64 + lane; if (s <= tq) out[s] = (bf16_t)s; }
            } else {
                float v[64];
#pragma unroll
                for (int jj = 0; jj < 64; ++jj) { const int s = jj * 64 + lane; const float x = SC[wave * 4096 + s]; v[jj] = (s <= tq) ? x : -INFINITY; }
                float mx = -INFINITY, mnn = -INFINITY;
#pragma unroll
                for (int jj = 0; jj < 64; ++jj) { mx = fmaxf(mx, v[jj]); mnn = fmaxf(mnn, v[jj] == -INFINITY ? -INFINITY : -v[jj]); }
                mx = wave_max_f(mx); const float lo = -wave_max_f(mnn);
                const float rng = mx - lo; const float inv = rng > 1e-30f ? 65535.9f / rng : 1.f;
                *(LAS u32x4*)(H + 4 * lane) = (u32x4){0u, 0u, 0u, 0u};
#pragma unroll
                for (int jj = 0; jj < 64; ++jj) { const int bn = (int)((v[jj] - lo) * inv); if (bn >= 0) __hip_atomic_fetch_add(H + (bn >> 8), 1u, __ATOMIC_RELAXED, __HIP_MEMORY_SCOPE_WORKGROUP); }
                asm volatile("s_waitcnt lgkmcnt(0)" ::: "memory");
                int chi1, cnt1; const int b1 = hist_find(*(const LAS u32x4*)(H + 4 * lane), 256, lane, chi1, cnt1);
                asm volatile("s_waitcnt lgkmcnt(0)" ::: "memory");
                *(LAS u32x4*)(H + 4 * lane) = (u32x4){0u, 0u, 0u, 0u};
#pragma unroll
                for (int jj = 0; jj < 64; ++jj) { const int bn = (int)((v[jj] - lo) * inv); if ((bn >> 8) == b1) __hip_atomic_fetch_add(H + (bn & 255), 1u, __ATOMIC_RELAXED, __HIP_MEMORY_SCOPE_WORKGROUP); }
                asm volatile("s_waitcnt lgkmcnt(0)" ::: "memory");
                int chi2, cnt2; const int b2 = hist_find(*(const LAS u32x4*)(H + 4 * lane), 256 - chi1, lane, chi2, cnt2);
                const int T16 = b1 * 256 + b2; const int need = 256 - chi1 - chi2;
                const bool allties = (need == cnt2);
                unsigned mlo = 0u, mhi = 0u;
#pragma unroll
                for (int jj = 0; jj < 32; ++jj) { const int bn = (int)((v[jj] - lo) * inv); const bool sel = allties ? (bn >= T16) : (bn > T16); mlo |= sel ? (1u << jj) : 0u; }
#pragma unroll
                for (int jj = 32; jj < 64; ++jj) { const int bn = (int)((v[jj] - lo) * inv); const bool sel = allties ? (bn >= T16) : (bn > T16); mhi |= sel ? (1u << (jj - 32)) : 0u; }
                LAS bf16_t* stage = (LAS bf16_t*)(SC + wave * 4096);
                const int mycnt = __popc(mlo) + __popc(mhi); int base = wave_scan_i(mycnt) - mycnt;
                while (mlo) { const int bpos = __builtin_ctz(mlo); stage[base++] = (bf16_t)(bpos * 64 + lane); mlo &= mlo - 1u; }
                while (mhi) { const int bpos = __builtin_ctz(mhi); stage[base++] = (bf16_t)((bpos + 32) * 64 + lane); mhi &= mhi - 1u; }
                if (!allties) {
                    int eqb = 0; const int pos0 = 256 - need;
#pragma unroll
                    for (int jj = 0; jj < 64; ++jj) {
                        const int bn = (int)((v[jj] - lo) * inv); const bool eq = (bn == T16);
                        const unsigned long long me = __ballot(eq);
                        const int er = eqb + (int)__builtin_amdgcn_mbcnt_hi((unsigned)(me >> 32), __builtin_amdgcn_mbcnt_lo((unsigned)me, 0u));
                        if (eq && er < need) stage[pos0 + er] = (bf16_t)(jj * 64 + lane);
                        eqb += __popcll(me);
                    }
                }
                asm volatile("s_waitcnt lgkmcnt(0)" ::: "memory");
                *(u32x2*)(out + 4 * lane) = *(const LAS u32x2*)(stage + 4 * lane);
            }
        }
        __syncthreads();
    }
}

__device__ __forceinline__ void p4_memattn(const Ctx& C) {
    unsigned char* ws = C.ws; const int lane = C.lane, g = lane >> 4, fr = lane & 15;
    const bf16_t* memq = (const bf16_t*)(ws + WS_MEMQ); const bf16_t* kmem = (const bf16_t*)(ws + WS_KMEM); const bf16_t* vmt = (const bf16_t*)(ws + WS_VMEMT);
    bf16_t* ymem = (bf16_t*)(ws + WS_YMEM);
    for (int task = C.gw; task < 4096; task += C.ngw) {
        const int tt = task >> 2, h = task & 3, t0 = tt * 16, b = t0 >> 12;
        const bf16_t* kb = kmem + (size_t)((b * 4 + h) * 256) * 128; const bf16_t* vb = vmt + (size_t)((b * 4 + h) * 128) * 256;
        bf16x8 Bq[4];
#pragma unroll
        for (int kk = 0; kk < 4; ++kk) Bq[kk] = *(const bf16x8*)(memq + (size_t)(t0 + fr) * 512 + h * 128 + 32 * kk + 8 * g);
        f32x4 sc[16];
#pragma unroll
        for (int i = 0; i < 16; ++i) { sc[i] = (f32x4){0.f, 0.f, 0.f, 0.f};
#pragma unroll
            for (int kk = 0; kk < 4; ++kk) { const bf16x8 A = *(const bf16x8*)(kb + (size_t)(16 * i + fr) * 128 + 32 * kk + 8 * g);
                sc[i] = __builtin_amdgcn_mfma_f32_16x16x32_bf16(A, Bq[kk], sc[i], 0, 0, 0); } }
        const float scale = 0.08838834764831845f;
        float mx = -3.0e38f;
#pragma unroll
        for (int i = 0; i < 16; ++i)
#pragma unroll
            for (int r = 0; r < 4; ++r) { sc[i][r] *= scale; mx = fmaxf(mx, sc[i][r]); }
        mx = fmaxf(mx, __shfl_xor(mx, 16)); mx = fmaxf(mx, __shfl_xor(mx, 32));
        float sum = 0.f;
#pragma unroll
        for (int i = 0; i < 16; ++i)
#pragma unroll
            for (int r = 0; r < 4; ++r) { sc[i][r] = __expf(sc[i][r] - mx); sum += sc[i][r]; }
        sum += __shfl_xor(sum, 16); sum += __shfl_xor(sum, 32);
        const float inv = 1.0f / sum;
        bf16x8 Pb[8];
#pragma unroll
        for (int ks = 0; ks < 8; ++ks) { u32x4 w; w.x = pk2(sc[2 * ks][0] * inv, sc[2 * ks][1] * inv); w.y = pk2(sc[2 * ks][2] * inv, sc[2 * ks][3] * inv);
            w.z = pk2(sc[2 * ks + 1][0] * inv, sc[2 * ks + 1][1] * inv); w.w = pk2(sc[2 * ks + 1][2] * inv, sc[2 * ks + 1][3] * inv); Pb[ks] = __builtin_bit_cast(bf16x8, w); }
#pragma unroll
        for (int dt = 0; dt < 8; ++dt) {
            f32x4 o = (f32x4){0.f, 0.f, 0.f, 0.f};
#pragma unroll
            for (int ks = 0; ks < 8; ++ks) { const bf16_t* vp = vb + (size_t)(16 * dt + fr) * 256 + 32 * ks + 4 * g;
                const u32x2 lo = *(const u32x2*)vp, hi = *(const u32x2*)(vp + 16); u32x4 w; w.x = lo.x; w.y = lo.y; w.z = hi.x; w.w = hi.y;
                o = __builtin_amdgcn_mfma_f32_16x16x32_bf16(__builtin_bit_cast(bf16x8, w), Pb[ks], o, 0, 0, 0); }
            u32x2 w; w.x = pk2(o[0], o[1]); w.y = pk2(o[2], o[3]);
            *(u32x2*)(ymem + (size_t)(t0 + fr) * 512 + h * 128 + 16 * dt + 4 * g) = w;
        }
    }
}

constexpr int LDS_RELB = 131072 + 1024;
constexpr int LDS_LUT = LDS_RELB + 1024;
__device__ __forceinline__ u32x2 tr_read2(unsigned a0, unsigned a1, u32x2& hi) {
    u32x2 lo; asm volatile("ds_read_b64_tr_b16 %0, %2\n\tds_read_b64_tr_b16 %1, %3\n\ts_waitcnt lgkmcnt(0)" : "=&v"(lo), "=&v"(hi) : "v"(a0), "v"(a1) : "memory"); return lo;
}
__device__ __forceinline__ void p5_dsa_attn(const Ctx& C) {
    unsigned char* ws = C.ws; const int lane = C.lane, wave = C.wave, g = lane >> 4, fr = lane & 15;
    const bf16_t* qlat = (const bf16_t*)(ws + WS_QLAT); const bf16_t* kvl = (const bf16_t*)(ws + WS_KVL); const bf16_t* idxb = (const bf16_t*)(ws + WS_IDX);
    bf16_t* olat = (bf16_t*)(ws + WS_OLAT);
    LAS float* relb = (LAS float*)(C.lds + LDS_RELB); LAS int* lut = (LAS int*)(C.lds + LDS_LUT);
    if (C.tid < 256) relb[C.tid] = C.in[2][C.tid];
    if (C.tid < 128) { const int n = C.tid; int bk = n; if (n >= 16) { bk = 16 + (int)(logf((float)n * (1.0f / 16.0f)) / 2.0794415416798357f * 16.0f); bk = bk > 31 ? 31 : bk; } lut[n] = bk; }
    __syncthreads();
    LAS unsigned char* my = C.lds + wave * 16384; const unsigned mybase = (unsigned)(uintptr_t)my;
    unsigned* qctr = (unsigned*)(ws + WS_CTL) + CW_DSAQ;
    for (;;) {
      int q0 = 0; if (lane == 0) q0 = (int)__hip_atomic_fetch_add(qctr, 4u, __ATOMIC_RELAXED, __HIP_MEMORY_SCOPE_AGENT);
      q0 = __builtin_amdgcn_readfirstlane(q0); if (q0 >= T) break;
      for (int q = q0; q < q0 + 4; ++q) {
        const int b = q >> 12, s = q & (SEQ - 1); const int nvalid = s + 1 < 256 ? s + 1 : 256;
        bf16x8 Bq[4];
#pragma unroll
        for (int kk = 0; kk < 4; ++kk) Bq[kk] = *(const bf16x8*)(qlat + (size_t)q * 1024 + (fr & 7) * 128 + 32 * kk + 8 * g);
        float m_run = -INFINITY, l_run = 0.f;
        f32x4 O[8];
#pragma unroll
        for (int cc = 0; cc < 8; ++cc) O[cc] = (f32x4){0.f, 0.f, 0.f, 0.f};
        const int nch = (nvalid + 63) >> 6;
        for (int ch = 0; ch < nch; ++ch) {
            const int slot = ch * 64 + lane; const int ix = slot < nvalid ? (int)idxb[(size_t)q * 256 + slot] : 0;
            const char* kvb = (const char*)(kvl + (size_t)b * SEQ * 128);
#pragma unroll
            for (int p = 0; p < 16; ++p) { const int rrow = 4 * p + g; const int srow = __shfl(ix, rrow); const int c = fr ^ (2 * (rrow & 7));
                __builtin_amdgcn_global_load_lds((const unsigned*)(kvb + (size_t)srow * 256 + 16 * c), (LAS unsigned*)(my + 1024 * p), 16, 0, 0); }
            asm volatile("s_waitcnt vmcnt(0)" ::: "memory");
            f32x4 sc[4];
#pragma unroll
            for (int i = 0; i < 4; ++i) { sc[i] = (f32x4){0.f, 0.f, 0.f, 0.f};
#pragma unroll
                for (int kk = 0; kk < 4; ++kk) { const int row = 16 * i + fr; const int sl = (4 * kk + g) ^ (2 * (row & 7));
                    const bf16x8 A = *(const LAS bf16x8*)(my + row * 256 + 16 * sl);
                    sc[i] = __builtin_amdgcn_mfma_f32_16x16x32_bf16(A, Bq[kk], sc[i], 0, 0, 0); } }
            float mx = -INFINITY;
#pragma unroll
            for (int i = 0; i < 4; ++i)
#pragma unroll
                for (int r = 0; r < 4; ++r) { const int ks = 16 * i + 4 * g + r; const int kpos = __shfl(ix, ks); const int dist = s - kpos;
                    const int bk = dist >= 128 ? 31 : lut[dist < 0 ? 0 : dist]; const float bias = relb[bk * 8 + (fr & 7)];
                    const bool valid = ch * 64 + ks < nvalid; const float v = valid ? sc[i][r] + bias : -INFINITY; sc[i][r] = v; mx = fmaxf(mx, v); }
            mx = fmaxf(mx, __shfl_xor(mx, 16)); mx = fmaxf(mx, __shfl_xor(mx, 32));
            const float m_new = fmaxf(m_run, mx); const float alpha = __expf(m_run - m_new);
            float ps = 0.f;
#pragma unroll
            for (int i = 0; i < 4; ++i)
#pragma unroll
                for (int r = 0; r < 4; ++r) { sc[i][r] = __expf(sc[i][r] - m_new); ps += sc[i][r]; }
            ps += __shfl_xor(ps, 16); ps += __shfl_xor(ps, 32);
            l_run = l_run * alpha + ps; m_run = m_new;
            float ar[4];
#pragma unroll
            for (int r = 0; r < 4; ++r) ar[r] = __shfl(alpha, 4 * g + r);
#pragma unroll
            for (int cc = 0; cc < 8; ++cc)
#pragma unroll
                for (int r = 0; r < 4; ++r) O[cc][r] *= ar[r];
#pragma unroll
            for (int ks = 0; ks < 2; ++ks) {
                u32x4 w; w.x = pk2(sc[2 * ks][0], sc[2 * ks][1]); w.y = pk2(sc[2 * ks][2], sc[2 * ks][3]); w.z = pk2(sc[2 * ks + 1][0], sc[2 * ks + 1][1]); w.w = pk2(sc[2 * ks + 1][2], sc[2 * ks + 1][3]);
                const bf16x8 Pa = __builtin_bit_cast(bf16x8, w);
                const int qq = fr >> 2, p2 = fr & 3;
#pragma unroll
                for (int cc = 0; cc < 8; ++cc) {
                    const int R0 = 32 * ks + 4 * g + qq, R1 = R0 + 16; const int chk = 2 * cc + (p2 >> 1);
                    const unsigned a0 = mybase + R0 * 256 + 16 * (chk ^ (2 * (R0 & 7))) + 8 * (p2 & 1), a1 = mybase + R1 * 256 + 16 * (chk ^ (2 * (R1 & 7))) + 8 * (p2 & 1);
                    u32x2 hi; const u32x2 lo = tr_read2(a0, a1, hi); u32x4 bw; bw.x = lo.x; bw.y = lo.y; bw.z = hi.x; bw.w = hi.y;
                    O[cc] = __builtin_amdgcn_mfma_f32_16x16x32_bf16(Pa, __builtin_bit_cast(bf16x8, bw), O[cc], 0, 0, 0);
                }
            }
        }
        const float inv = 1.0f / l_run; float ir[4];
#pragma unroll
        for (int r = 0; r < 4; ++r) ir[r] = __shfl(inv, 4 * g + r);
        if (g < 2) {
#pragma unroll
            for (int cc = 0; cc < 8; ++cc)
#pragma unroll
                for (int r = 0; r < 4; ++r) olat[(size_t)q * 1024 + (4 * g + r) * 128 + 16 * cc + fr] = (bf16_t)f2bf(O[cc][r] * ir[r]);
        }
      }
    }
}

constexpr int RBLK = 4, RVEC = 5 * 64 + 4;
constexpr int RWAVE_LDS = 2 * RBLK * RVEC * 4;
struct RwRaw { bf16_t a[RBLK], k[RBLK], e[RBLK], r[RBLK]; };
template <int MODE> __device__ __forceinline__ void rw_load_raw(RwRaw& w, const bf16_t* pa, const bf16_t* pk, const bf16_t* pe, const bf16_t* pr, size_t tok0, int col) {
#pragma unroll
    for (int i = 0; i < RBLK; ++i) { const size_t o = (tok0 + i) * 512 + col; w.a[i] = pa[o]; w.k[i] = pk[o]; w.e[i] = pe[o]; if (MODE == 2) w.r[i] = pr[o]; else w.r[i] = 0; }
}
template <int MODE> __device__ __forceinline__ void rw_process(const RwRaw& w, LAS float* buf, int lane, float kk_c, float ka_c, float rk_c) {
#pragma unroll
    for (int i = 0; i < RBLK; ++i) {
        __builtin_amdgcn_sched_barrier(0);
        const float a = bf1(w.a[i]), ks = bf1(w.k[i]), e = bf1(w.e[i]);
        const float kr = ks * kk_c; const float n2 = wave_sum(kr * kr); const float kk = kr * __builtin_amdgcn_rsqf(fmaxf(n2, 1e-24f));
        const float kx = ks * (1.0f + (a - 1.0f) * ka_c);
        LAS float* s = buf + i * RVEC;
        s[lane] = __expf(-e); s[64 + lane] = -kk; s[128 + lane] = kk * a; s[192 + lane] = kx;
        if (MODE == 2) { const float r = bf1(w.r[i]); s[256 + lane] = r; const float bc = wave_sum(r * kx * rk_c); if (lane == 0) s[320] = bc; }
    }
}
#ifndef RW_NKD2
#define RW_NKD2 8
#define RW_BD2 4
#define RW_NKD3 8
#define RW_BD3 2
#endif
template <int MODE> struct RwCfg { static constexpr int NKD = MODE == 2 ? RW_NKD2 : RW_NKD3, BD = MODE == 2 ? RW_BD2 : RW_BD3; };
__device__ __forceinline__ float fma_s(float a, float b, float c) { float d; asm("v_fma_f32 %0, %1, %2, %3" : "=v"(d) : "v"(a), "v"(b), "v"(c)); return d; }
__device__ __forceinline__ float mul_s(float a, float b) { float d; asm("v_mul_f32 %0, %1, %2" : "=v"(d) : "v"(a), "v"(b)); return d; }
template <int MODE> __device__ __forceinline__ void rw_step(float (&sq)[64], float (&sp)[64], f32x4 (&nk)[RwCfg<MODE>::NKD], const LAS float* sv, const LAS float* svn, float vv, float& yout) {
    constexpr int NKD = RwCfg<MODE>::NKD, BD = RwCfg<MODE>::BD;
    f32x4 bw[BD], bka[BD], bkx[BD], br[BD];
    float sa0 = 0.f, sa1 = 0.f, sb0 = 0.f, sb1 = 0.f;
#pragma unroll
    for (int j = 0; j < 16; ++j) {
        const f32x4 n = nk[j % NKD];
        sa0 = fma_s(sq[4 * j], n.x, sa0); sa1 = fma_s(sq[4 * j + 1], n.y, sa1); sa0 = fma_s(sq[4 * j + 2], n.z, sa0); sa1 = fma_s(sq[4 * j + 3], n.w, sa1);
        if (MODE == 3) { sb0 = fma_s(sp[4 * j], n.x, sb0); sb1 = fma_s(sp[4 * j + 1], n.y, sb1); sb0 = fma_s(sp[4 * j + 2], n.z, sb0); sb1 = fma_s(sp[4 * j + 3], n.w, sb1); }
        if (j + NKD < 16) nk[j % NKD] = *(const LAS f32x4*)(sv + 64 + 4 * (j + NKD));
        if (j >= 16 - BD) { const int gq = j - (16 - BD); bw[gq] = *(const LAS f32x4*)(sv + 4 * gq); bka[gq] = *(const LAS f32x4*)(sv + 128 + 4 * gq); bkx[gq] = *(const LAS f32x4*)(sv + 192 + 4 * gq);
            if (MODE == 2) br[gq] = *(const LAS f32x4*)(sv + 256 + 4 * gq); }
        __builtin_amdgcn_sched_barrier(0);
    }
    const float saq = sa0 + sa1, sap = sb0 + sb1;
    float y0 = 0.f, y1 = 0.f;
#pragma unroll
    for (int gq = 0; gq < 16; ++gq) {
        const f32x4 w = bw[gq % BD], ka = bka[gq % BD], kx = bkx[gq % BD];
        sq[4 * gq] = fma_s(vv, kx.x, fma_s(saq, ka.x, mul_s(sq[4 * gq], w.x))); sq[4 * gq + 1] = fma_s(vv, kx.y, fma_s(saq, ka.y, mul_s(sq[4 * gq + 1], w.y)));
        sq[4 * gq + 2] = fma_s(vv, kx.z, fma_s(saq, ka.z, mul_s(sq[4 * gq + 2], w.z))); sq[4 * gq + 3] = fma_s(vv, kx.w, fma_s(saq, ka.w, mul_s(sq[4 * gq + 3], w.w)));
        if (MODE == 2) { const f32x4 r = br[gq % BD]; y0 = fma_s(sq[4 * gq], r.x, y0); y1 = fma_s(sq[4 * gq + 1], r.y, y1); y0 = fma_s(sq[4 * gq + 2], r.z, y0); y1 = fma_s(sq[4 * gq + 3], r.w, y1); }
        if (MODE == 3) { sp[4 * gq] = fma_s(sap, ka.x, mul_s(sp[4 * gq], w.x)); sp[4 * gq + 1] = fma_s(sap, ka.y, mul_s(sp[4 * gq + 1], w.y));
            sp[4 * gq + 2] = fma_s(sap, ka.z, mul_s(sp[4 * gq + 2], w.z)); sp[4 * gq + 3] = fma_s(sap, ka.w, mul_s(sp[4 * gq + 3], w.w)); }
        if (gq + BD < 16) { const int gn = gq + BD; bw[gq % BD] = *(const LAS f32x4*)(sv + 4 * gn); bka[gq % BD] = *(const LAS f32x4*)(sv + 128 + 4 * gn); bkx[gq % BD] = *(const LAS f32x4*)(sv + 192 + 4 * gn);
            if (MODE == 2) br[gq % BD] = *(const LAS f32x4*)(sv + 256 + 4 * gn); }
        if (gq >= 16 - NKD) nk[gq - (16 - NKD)] = *(const LAS f32x4*)(svn + 64 + 4 * (gq - (16 - NKD)));
        __builtin_amdgcn_sched_barrier(0);
    }
    yout = y0 + y1;
}
template <int MODE> __device__ __forceinline__ void rw_task(const Ctx& C, int bh, int ch) {
    unsigned char* ws = C.ws; const int lane = C.lane; const int b = bh >> 3, h = bh & 7, col = h * 64 + lane;
    const bf16_t* pr = (const bf16_t*)(ws + WS_RW_R); const bf16_t* pk = (const bf16_t*)(ws + WS_RW_K); const bf16_t* pv = (const bf16_t*)(ws + WS_RW_V);
    const bf16_t* pa = (const bf16_t*)(ws + WS_RW_A); const bf16_t* pe = (const bf16_t*)(ws + WS_RW_E); const bf16_t* pg = (const bf16_t*)(ws + WS_RW_G);
    bf16_t* yo = (bf16_t*)(ws + WS_YRWKV);
    float* PQ = (float*)(C.dout + DO_PQ);
    LAS float* buf = (LAS float*)(C.lds + C.wave * RWAVE_LDS);
    const float kk_c = C.in[16][col], ka_c = C.in[17][col], rk_c = C.in[18][col];
    const float lng = C.in[19][col], lnb = C.in[20][col];
    const size_t tok0 = (size_t)b * SEQ + (size_t)ch * RL;
    float sq[64], sp[64];
    int lane_v = lane; asm volatile("" : "+v"(lane_v));
#pragma unroll
    for (int k = 0; k < 64; ++k) { sq[k] = 0.f; sp[k] = (k == lane_v) ? 1.f : 0.f; }
    if (MODE == 2 && ch > 0) { const float* src = PQ + ((size_t)((bh * RCH + ch - 1) * 2)) * 4096 + lane * 64;
#pragma unroll
        for (int k4 = 0; k4 < 16; ++k4) { const f32x4 v = *(const f32x4*)(src + 4 * k4); sq[4 * k4] = v.x; sq[4 * k4 + 1] = v.y; sq[4 * k4 + 2] = v.z; sq[4 * k4 + 3] = v.w; } }
    constexpr int NBLK = RL / RBLK;
    RwRaw raw; rw_load_raw<MODE>(raw, pa, pk, pe, pr, tok0, col);
    rw_process<MODE>(raw, buf, lane, kk_c, ka_c, rk_c);
    rw_load_raw<MODE>(raw, pa, pk, pe, pr, tok0 + RBLK, col);
    constexpr int NKD = RwCfg<MODE>::NKD;
    f32x4 nk[NKD];
#pragma unroll
    for (int j = 0; j < NKD; ++j) nk[j] = *(const LAS f32x4*)(buf + 64 + 4 * j);
#pragma unroll 1
    for (int blk = 0; blk < NBLK; ++blk) {
        LAS float* cur = buf + (blk & 1) * (RBLK * RVEC); LAS float* nxt = buf + ((blk + 1) & 1) * (RBLK * RVEC);
        const size_t tb = tok0 + (size_t)blk * RBLK;
        rw_process<MODE>(raw, nxt, lane, kk_c, ka_c, rk_c);
        rw_load_raw<MODE>(raw, pa, pk, pe, pr, tok0 + (size_t)(blk + 2 < NBLK ? blk + 2 : NBLK - 1) * RBLK, col);
        float vv[RBLK], gg[RBLK];
#pragma unroll
        for (int i = 0; i < RBLK; ++i) { vv[i] = bf1(pv[(tb + i) * 512 + col]); gg[i] = (MODE == 2) ? bf1(pg[(tb + i) * 512 + col]) : 0.f; }
#pragma unroll
        for (int i = 0; i < RBLK; ++i) {
            const LAS float* sv = cur + i * RVEC; const LAS float* svn = (i + 1 < RBLK) ? cur + (i + 1) * RVEC : nxt;
            float y;
            rw_step<MODE>(sq, sp, nk, sv, svn, vv[i], y);
            if (MODE == 2) {
                const float mean = wave_sum(y) * (1.0f / 64.0f); const float dy = y - mean; const float var = wave_sum(dy * dy) * (1.0f / 64.0f);
                const float yn = dy * rsqrtf(var + 64e-5f) * lng + lnb; const float bc = sv[320];
                yo[(tb + i) * 512 + col] = (bf16_t)f2bf((yn + bc * vv[i]) * gg[i]);
            }
        }
    }
    if (MODE == 3) { float* dq = PQ + ((size_t)((bh * RCH + ch) * 2)) * 4096 + lane * 64; float* dp = dq + 4096;
#pragma unroll
        for (int k4 = 0; k4 < 16; ++k4) { *(f32x4*)(dq + 4 * k4) = (f32x4){sq[4 * k4], sq[4 * k4 + 1], sq[4 * k4 + 2], sq[4 * k4 + 3]};
            *(f32x4*)(dp + 4 * k4) = (f32x4){sp[4 * k4], sp[4 * k4 + 1], sp[4 * k4 + 2], sp[4 * k4 + 3]}; } }
}
__device__ __forceinline__ void p4_rwkv_pass1(const Ctx& C) {
    for (int task = C.gw; task < 32 * (RCH - 1); task += C.ngw) rw_task<3>(C, task / (RCH - 1), task % (RCH - 1));
}
__device__ __forceinline__ void p6_rwkv_pass3(const Ctx& C) {
    for (int task = C.gw; task < 32 * RCH; task += C.ngw) rw_task<2>(C, task / RCH, task % RCH);
}
__device__ __forceinline__ void p5_rwkv_carry(const Ctx& C) {
    float* PQ = (float*)(C.dout + DO_PQ); const int lane = C.lane, wave = C.wave, tid = C.tid;
    LAS float* ST = (LAS float*)C.lds;
    LAS float* PL = (LAS float*)(C.lds + 32768);
    for (int bh = blockIdx.x; bh < 32; bh += C.G) {
        for (int i = tid; i < 4096; i += NTHREADS) ST[i] = 0.f;
        const float* base = PQ + (size_t)(bh * RCH) * 2 * 4096;
        f32x4 pa = *(const f32x4*)(base + 4096 + tid * 8), pb = *(const f32x4*)(base + 4096 + tid * 8 + 4);
        f32x4 q0 = *(const f32x4*)(base + lane * 64 + 8 * wave), q1 = *(const f32x4*)(base + lane * 64 + 8 * wave + 4);
        __syncthreads();
        for (int ch = 0; ch < RCH - 1; ++ch) {
            LAS float* cur = ST + (ch & 1) * 4096; LAS float* nxt = ST + ((ch + 1) & 1) * 4096;
            float* Q = PQ + ((size_t)((bh * RCH + ch) * 2)) * 4096;
            *(LAS f32x4*)(PL + tid * 8) = pa; *(LAS f32x4*)(PL + tid * 8 + 4) = pb;
            float acc[8] = {q0.x, q0.y, q0.z, q0.w, q1.x, q1.y, q1.z, q1.w};
            __syncthreads();
            const int cn = ch + 1 < RCH - 1 ? ch + 1 : ch; const float* nb = PQ + ((size_t)((bh * RCH + cn) * 2)) * 4096;
            pa = *(const f32x4*)(nb + 4096 + tid * 8); pb = *(const f32x4*)(nb + 4096 + tid * 8 + 4);
            q0 = *(const f32x4*)(nb + lane * 64 + 8 * wave); q1 = *(const f32x4*)(nb + lane * 64 + 8 * wave + 4);
#pragma unroll 8
            for (int j = 0; j < 64; ++j) { const float sj = cur[j * 64 + lane]; const f32x4 p0 = *(const LAS f32x4*)(PL + j * 64 + 8 * wave), p1 = *(const LAS f32x4*)(PL + j * 64 + 8 * wave + 4);
                acc[0] = fmaf(sj, p0.x, acc[0]); acc[1] = fmaf(sj, p0.y, acc[1]); acc[2] = fmaf(sj, p0.z, acc[2]); acc[3] = fmaf(sj, p0.w, acc[3]);
                acc[4] = fmaf(sj, p1.x, acc[4]); acc[5] = fmaf(sj, p1.y, acc[5]); acc[6] = fmaf(sj, p1.z, acc[6]); acc[7] = fmaf(sj, p1.w, acc[7]); }
            *(f32x4*)(Q + lane * 64 + 8 * wave) = (f32x4){acc[0], acc[1], acc[2], acc[3]}; *(f32x4*)(Q + lane * 64 + 8 * wave + 4) = (f32x4){acc[4], acc[5], acc[6], acc[7]};
#pragma unroll
            for (int kk = 0; kk < 8; ++kk) nxt[(8 * wave + kk) * 64 + lane] = acc[kk];
            __syncthreads();
        }
    }
}

__device__ __forceinline__ void p8_ln1(const Ctx& C) {
    const float* pre = (const float*)C.dout; float* x1 = (float*)(C.ws + WS_X1); bf16_t* x1b = (bf16_t*)(C.ws + WS_X1B); const int lane = C.lane;
    const float* gam = C.in[26]; const float* bet = C.in[27];
    for (int t = C.gw; t < T; t += C.ngw) {
        const float* p = pre + (size_t)t * 1024; float v[16];
#pragma unroll
        for (int hh = 0; hh < 2; ++hh) { const f32x4 a = *(const f32x4*)(p + hh * 512 + 8 * lane), b = *(const f32x4*)(p + hh * 512 + 8 * lane + 4);
            v[8 * hh] = a.x; v[8 * hh + 1] = a.y; v[8 * hh + 2] = a.z; v[8 * hh + 3] = a.w; v[8 * hh + 4] = b.x; v[8 * hh + 5] = b.y; v[8 * hh + 6] = b.z; v[8 * hh + 7] = b.w; }
        float s = 0.f;
#pragma unroll
        for (int j = 0; j < 16; ++j) s += v[j];
        const float mean = wave_sum(s) * (1.0f / 1024.0f); float s2 = 0.f;
#pragma unroll
        for (int j = 0; j < 16; ++j) { v[j] -= mean; s2 += v[j] * v[j]; }
        const float rstd = rsqrtf(wave_sum(s2) * (1.0f / 1024.0f) + 1e-5f);
#pragma unroll
        for (int hh = 0; hh < 2; ++hh) { const int c0 = hh * 512 + 8 * lane; float o[8];
#pragma unroll
            for (int j = 0; j < 8; ++j) o[j] = v[8 * hh + j] * rstd * gam[c0 + j] + bet[c0 + j];
            *(f32x4*)(x1 + (size_t)t * 1024 + c0) = (f32x4){o[0], o[1], o[2], o[3]}; *(f32x4*)(x1 + (size_t)t * 1024 + c0 + 4) = (f32x4){o[4], o[5], o[6], o[7]};
            *(u32x4*)(x1b + (size_t)t * 1024 + c0) = pack8(o); }
    }
    cvt_rows_fp8(C.in[30], C.ws + WS_UB, (size_t)16384 * 1024 / 16, PEER_U_SCALE, C.gt, C.ngt);
    cvt_rows_fp8(C.in[31], C.ws + WS_VB, (size_t)16384 * 1024 / 16, PEER_V_SCALE, C.gt, C.ngt);
}

#define CE_DESC(a, b) do { const unsigned hi_ = k[a] > k[b] ? k[a] : k[b], lo_ = k[a] > k[b] ? k[b] : k[a]; k[a] = hi_; k[b] = lo_; } while (0)
__device__ __forceinline__ unsigned pop16_of8(unsigned (&k)[8], int fr) {
    CE_DESC(0, 1); CE_DESC(2, 3); CE_DESC(4, 5); CE_DESC(6, 7); CE_DESC(0, 2); CE_DESC(1, 3); CE_DESC(4, 6); CE_DESC(5, 7); CE_DESC(1, 2); CE_DESC(5, 6);
    CE_DESC(0, 4); CE_DESC(1, 5); CE_DESC(2, 6); CE_DESC(3, 7); CE_DESC(2, 4); CE_DESC(3, 5); CE_DESC(1, 2); CE_DESC(3, 4); CE_DESC(5, 6);
    unsigned res = 0u;
#pragma unroll
    for (int rd = 0; rd < 16; ++rd) {
        const unsigned m = row_max_u(k[0]); const bool mine = (k[0] == m);
#pragma unroll
        for (int j = 0; j < 7; ++j) k[j] = mine ? k[j + 1] : k[j];
        k[7] = mine ? 0u : k[7];
        res = (fr == rd) ? m : res;
    }
    return res;
}
__device__ __forceinline__ unsigned pop16_of4(unsigned (&k)[4], int fr) {
    CE_DESC(0, 1); CE_DESC(2, 3); CE_DESC(0, 2); CE_DESC(1, 3); CE_DESC(1, 2);
    unsigned res = 0u;
#pragma unroll
    for (int rd = 0; rd < 16; ++rd) {
        const unsigned m = row_max_u(k[0]); const bool mine = (k[0] == m);
        k[0] = mine ? k[1] : k[0]; k[1] = mine ? k[2] : k[1]; k[2] = mine ? k[3] : k[2]; k[3] = mine ? 0u : k[3];
        res = (fr == rd) ? m : res;
    }
    return res;
}
__device__ const unsigned char CAND_AB[64] = {
    0x00, 0x01, 0x02, 0x03, 0x04, 0x05, 0x06, 0x07, 0x08, 0x09, 0x0a, 0x0b, 0x0c, 0x0d, 0x0e, 0x0f,
    0x10, 0x11, 0x12, 0x13, 0x14, 0x15, 0x16, 0x17, 0x20, 0x21, 0x22, 0x23, 0x24, 0x30, 0x31, 0x32,
    0x33, 0x40, 0x41, 0x42, 0x50, 0x51, 0x60, 0x61, 0x70, 0x71, 0x80, 0x90, 0xa0, 0xb0, 0xc0, 0xd0,
    0xe0, 0xf0, 0xff, 0xff, 0xff, 0xff, 0xff, 0xff, 0xff, 0xff, 0xff, 0xff, 0xff, 0xff, 0xff, 0xff};
__device__ __forceinline__ void p10_peer_route(const Ctx& C) {
    unsigned char* ws = C.ws; const int lane = C.lane, g = lane >> 4, fr = lane & 15;
    const bf16_t* qp = (const bf16_t*)C.dout; const bf16_t* keys = (const bf16_t*)(ws + WS_KEYS);
    int* experts = (int*)(ws + WS_EXPERTS); float* pgates = (float*)(ws + WS_PGATES);
    const unsigned cand4 = *(const unsigned*)(CAND_AB + 4 * fr);
    for (int task = C.gw; task < T / 2; task += C.ngw) {
        const int t0 = task * 2;
        unsigned sel[2][4];
#pragma unroll
        for (int p = 0; p < 2; ++p) {
            bf16x8 A[4];
#pragma unroll
            for (int kk = 0; kk < 4; ++kk) A[kk] = *(const bf16x8*)(qp + (size_t)(t0 + (fr >> 3)) * 2048 + (fr & 7) * 256 + p * 128 + 32 * kk + 8 * g);
            f32x4 acc[8];
#pragma unroll
            for (int i = 0; i < 8; ++i) { if ((i & 1) == 0) __builtin_amdgcn_sched_barrier(0); acc[i] = (f32x4){0.f, 0.f, 0.f, 0.f};
#pragma unroll
                for (int kk = 0; kk < 4; ++kk) { const bf16x8 Bk = *(const bf16x8*)(keys + (size_t)(p * 128 + 16 * i + fr) * 128 + 32 * kk + 8 * g);
                    acc[i] = __builtin_amdgcn_mfma_f32_16x16x32_bf16(A[kk], Bk, acc[i], 0, 0, 0); } }
#pragma unroll
            for (int r = 0; r < 4; ++r) { __builtin_amdgcn_sched_barrier(0); unsigned k[8];
#pragma unroll
                for (int i = 0; i < 8; ++i) k[i] = (f2key(acc[i][r]) & 0xffffff80u) | (unsigned)(16 * i + fr);
                sel[p][r] = pop16_of8(k, fr); }
        }
#pragma unroll
        for (int r = 0; r < 4; ++r) {
            __builtin_amdgcn_sched_barrier(0);
            const float s1 = key2f(sel[0][r] & 0xffffff80u), s2 = key2f(sel[1][r] & 0xffffff80u);
            unsigned k[4];
#pragma unroll
            for (int j = 0; j < 4; ++j) {
                const unsigned ab = (cand4 >> (8 * j)) & 0xffu; const unsigned msk = ab == 0xffu ? 0u : 0xffffffffu;
                const float va = __builtin_bit_cast(float, __builtin_amdgcn_ds_bpermute((int)(4u * (16u * g + (ab >> 4))), __builtin_bit_cast(int, s1)));
                const float vb = __builtin_bit_cast(float, __builtin_amdgcn_ds_bpermute((int)(4u * (16u * g + (ab & 15u))), __builtin_bit_cast(int, s2)));
                k[j] = ((f2key(va + vb) & 0xffffff00u) | ab) & msk;
            }
            const unsigned top = pop16_of4(k, fr);
            const int a = (int)((top >> 4) & 15u), b = (int)(top & 15u);
            const int i1 = __builtin_amdgcn_ds_bpermute(4 * (16 * g + a), (int)(sel[0][r] & 0x7fu));
            const int i2 = __builtin_amdgcn_ds_bpermute(4 * (16 * g + b), (int)(sel[1][r] & 0x7fu));
            const float sc = key2f(top & 0xffffff00u);
            const float mx = key2f(row_max_u(top) & 0xffffff00u);
            const float ev = __expf(sc - mx); const float sm = row_sum_f(ev);
            const int row = 4 * g + r; const size_t o = (size_t)(t0 + (row >> 3)) * 128 + (row & 7) * 16 + fr;
            experts[o] = i1 * 128 + i2; pgates[o] = ev / sm;
        }
    }
}
#undef CE_DESC

__device__ __forceinline__ float gelu_erf(float x) { return 0.5f * x * (1.0f + erff(x * 0.7071067811865476f)); }
typedef __bf16 bf2_t __attribute__((ext_vector_type(2)));
__device__ __forceinline__ unsigned fp8x2_to_bf16x2(unsigned w, bool hi) { return hi ? __builtin_bit_cast(unsigned, __builtin_amdgcn_cvt_scalef32_pk_bf16_fp8(w, 1.0f, true)) : __builtin_bit_cast(unsigned, __builtin_amdgcn_cvt_scalef32_pk_bf16_fp8(w, 1.0f, false)); }
__device__ __forceinline__ void p11_peer_experts(const Ctx& C) {
    unsigned char* ws = C.ws; const int lane = C.lane, g = lane >> 4, fr = lane & 15;
    const bf16_t* x1b = (const bf16_t*)(ws + WS_X1B); const float* x1 = (const float*)(ws + WS_X1);
    const unsigned char* ub = ws + WS_UB; const unsigned char* vb = ws + WS_VB;
    const int* experts = (const int*)(ws + WS_EXPERTS); const float* pgates = (const float*)(ws + WS_PGATES);
    float* out = (float*)C.dout; const float* gam = C.in[32]; const float* bet = C.in[33];
    LAS unsigned char* my = C.lds + C.wave * 4096;
    LAS float* cf = (LAS float*)(my + 2048); LAS int* eidl = (LAS int*)(my + 2560);
    for (int t = C.gw; t < T; t += C.ngw) {
        { const u32x4 a = *(const u32x4*)(x1b + (size_t)t * 1024 + 16 * lane), b = *(const u32x4*)(x1b + (size_t)t * 1024 + 16 * lane + 8);
          *(LAS u32x4*)(my + 32 * lane) = a; *(LAS u32x4*)(my + 32 * lane + 16) = b; }
        { const int e0 = experts[(size_t)t * 128 + lane], e1 = experts[(size_t)t * 128 + 64 + lane]; eidl[lane] = e0; eidl[64 + lane] = e1; }
        asm volatile("s_waitcnt lgkmcnt(0)" ::: "memory");
#pragma unroll 1
        for (int i = 0; i < 8; ++i) {
            const int e = eidl[16 * i + fr]; const unsigned char* urow = ub + (size_t)e * 1024 + 16 * g;
            f32x4 acc = (f32x4){0.f, 0.f, 0.f, 0.f};
#pragma unroll 8
            for (int m = 0; m < 16; ++m) {
                const u32x4 raw = *(const u32x4*)(urow + 64 * m);
                u32x4 a0, a1; a0.x = fp8x2_to_bf16x2(raw.x, false); a0.y = fp8x2_to_bf16x2(raw.x, true); a0.z = fp8x2_to_bf16x2(raw.y, false); a0.w = fp8x2_to_bf16x2(raw.y, true);
                a1.x = fp8x2_to_bf16x2(raw.z, false); a1.y = fp8x2_to_bf16x2(raw.z, true); a1.z = fp8x2_to_bf16x2(raw.w, false); a1.w = fp8x2_to_bf16x2(raw.w, true);
                const bf16x8 b0 = *(const LAS bf16x8*)(my + 2 * (64 * m + 16 * g)), b1 = *(const LAS bf16x8*)(my + 2 * (64 * m + 16 * g + 8));
                acc = __builtin_amdgcn_mfma_f32_16x16x32_bf16(__builtin_bit_cast(bf16x8, a0), b0, acc, 0, 0, 0);
                acc = __builtin_amdgcn_mfma_f32_16x16x32_bf16(__builtin_bit_cast(bf16x8, a1), b1, acc, 0, 0, 0);
            }
            const f32x4 pg = *(const f32x4*)(pgates + (size_t)t * 128 + 16 * i + 4 * g);
            constexpr float us = 1.0f / PEER_U_SCALE, vs = 1.0f / PEER_V_SCALE;
            if (fr == 0) { *(LAS f32x4*)(cf + 16 * i + 4 * g) = (f32x4){vs * pg.x * gelu_erf(acc[0] * us), vs * pg.y * gelu_erf(acc[1] * us), vs * pg.z * gelu_erf(acc[2] * us), vs * pg.w * gelu_erf(acc[3] * us)}; }
        }
        asm volatile("s_waitcnt lgkmcnt(0)" ::: "memory");
        float o[16];
#pragma unroll
        for (int j = 0; j < 16; ++j) o[j] = 0.f;
#pragma unroll 8
        for (int k = 0; k < 128; ++k) {
            const int e = __builtin_amdgcn_readfirstlane(eidl[k]); const float c = cf[k];
            const u32x4 raw = *(const u32x4*)(vb + (size_t)e * 1024 + 16 * lane);
            const unsigned rw[4] = {raw.x, raw.y, raw.z, raw.w};
#pragma unroll
            for (int j = 0; j < 4; ++j) { const f32x2 lo = __builtin_amdgcn_cvt_pk_f32_fp8((int)rw[j], false), hi = __builtin_amdgcn_cvt_pk_f32_fp8((int)rw[j], true);
                o[4 * j] = fmaf(c, lo.x, o[4 * j]); o[4 * j + 1] = fmaf(c, lo.y, o[4 * j + 1]); o[4 * j + 2] = fmaf(c, hi.x, o[4 * j + 2]); o[4 * j + 3] = fmaf(c, hi.y, o[4 * j + 3]); }
        }
        float s = 0.f; const float* xp = x1 + (size_t)t * 1024 + 16 * lane;
#pragma unroll
        for (int q = 0; q < 4; ++q) { const f32x4 a = *(const f32x4*)(xp + 4 * q); o[4 * q] += ALPHA * a.x; o[4 * q + 1] += ALPHA * a.y; o[4 * q + 2] += ALPHA * a.z; o[4 * q + 3] += ALPHA * a.w; }
#pragma unroll
        for (int j = 0; j < 16; ++j) s += o[j];
        const float mean = wave_sum(s) * (1.0f / 1024.0f); float s2 = 0.f;
#pragma unroll
        for (int j = 0; j < 16; ++j) { o[j] -= mean; s2 += o[j] * o[j]; }
        const float rstd = rsqrtf(wave_sum(s2) * (1.0f / 1024.0f) + 1e-5f);
#pragma unroll
        for (int q = 0; q < 4; ++q) { const int c0 = 16 * lane + 4 * q; const f32x4 gm = *(const f32x4*)(gam + c0), bt = *(const f32x4*)(bet + c0);
            *(f32x4*)(out + (size_t)t * 1024 + c0) = (f32x4){o[4 * q] * rstd * gm.x + bt.x, o[4 * q + 1] * rstd * gm.y + bt.y, o[4 * q + 2] * rstd * gm.z + bt.z, o[4 * q + 3] * rstd * gm.w + bt.w}; }
    }
}

constexpr int LDS_BYTES = 147456;
constexpr int LDS_MISC = 131072;
constexpr int NPHASE = 14;
constexpr int CW_BAR = 4096;

__global__ void __launch_bounds__(NTHREADS, 2) hybrid_fwd(Args args) {
    extern __shared__ __attribute__((aligned(16))) unsigned char lds_raw[];
    Ctx C;
    C.lds = (LAS unsigned char*)lds_raw;
    C.tid = threadIdx.x; C.lane = C.tid & 63; C.wave = __builtin_amdgcn_readfirstlane(C.tid >> 6);
    C.G = gridDim.x; C.gw = blockIdx.x * NWAVES + C.wave; C.ngw = C.G * NWAVES; C.gt = blockIdx.x * NTHREADS + C.tid; C.ngt = C.G * NTHREADS;
    C.in = args.in; C.ws = args.ws; C.dout = (unsigned char*)args.out;
    unsigned char* ws = args.ws; const float* const* in = args.in;
    volatile LAS unsigned* MISC = (volatile LAS unsigned*)(C.lds + LDS_MISC);
    if (C.tid < 64) MISC[C.tid] = 0u;
    __syncthreads();
    XcdBarrier bar; bar.bar = (unsigned*)(ws + WS_CTL) + CW_BAR; bar.x = 0; bar.st = nullptr;
    if (MK_N_LAUNCHES == 1) bar = xcd_barrier_post((unsigned*)(ws + WS_CTL) + CW_BAR, MISC + 8);
    const int lo = args.ph_lo, hi = args.ph_hi;
#define IN(k) (lo <= (k) && (k) < hi)
#define SEAM(k) do { if (IN(k) && IN((k) + 1)) xcd_barrier(bar); } while (0)
#define REP(k) for (int rep_ = 0; rep_ < (((PROBE_MASK >> (k)) & 1) ? 2 : 1); ++rep_)
    bf16_t* xb = (bf16_t*)(C.dout + DO_XB);

    if (IN(0)) REP(0) { p0_prologue(C); } SEAM(0);
    if (IN(1)) REP(1) {
        { pg8::Gemm gm{xb, (const bf16_t*)(ws + WS_WIN), T, 2816, 1024}; pg8::StaticOrder S; S.init(T, 2816, C.G, (int)blockIdx.x);
          EpiP1 E{(float*)(ws + WS_CSMALL), (bf16_t*)(ws + WS_RCOLS), (bf16_t*)(ws + WS_MEMQ)}; pg8::gemm_phase(C.lds, gm, S, E); }
        { pg8::Gemm gm{(const bf16_t*)(ws + WS_MEMB), (const bf16_t*)(ws + WS_WMEMKV), 1024, 1024, 1024}; pg8::StaticOrder S; S.init(1024, 1024, C.G, (int)blockIdx.x);
          EpiMemKV E{(bf16_t*)(ws + WS_KMEM), (bf16_t*)(ws + WS_VMEMT)}; pg8::gemm_phase(C.lds, gm, S, E); }
    } SEAM(1);
    if (IN(2)) REP(2) { p2_prep(C); } SEAM(2);
    if (IN(3)) REP(3) {
        { pg8::Gemm gm{(const bf16_t*)(ws + WS_LORAA), (const bf16_t*)(ws + WS_WLORA), T, 1536, 256}; pg8::StaticOrder S; S.init(T, 1536, C.G, (int)blockIdx.x);
          EpiLora E{(bf16_t*)(ws + WS_RW_E), (bf16_t*)(ws + WS_RW_A), (bf16_t*)(ws + WS_RW_G), in[11], in[13]}; pg8::gemm_phase(C.lds, gm, S, E); }
        { pg8::Gemm gm{(const bf16_t*)(ws + WS_CQN), (const bf16_t*)(ws + WS_WQ), T, 1280, 256}; pg8::StaticOrder S; S.init(T, 1280, C.G, (int)blockIdx.x);
          EpiQ E{(bf16_t*)(ws + WS_QLAT), (bf16_t*)(ws + WS_QIDX)}; pg8::gemm_phase(C.lds, gm, S, E); }
    } SEAM(3);
    if (IN(4)) { REP(14) { p4_indexer(C); } REP(15) { p4_memattn(C); } __syncthreads(); REP(16) { p4_rwkv_pass1(C); } } SEAM(4);
    if (IN(5)) { p5_rwkv_carry(C); __syncthreads(); REP(5) { p5_dsa_attn(C); } } SEAM(5);
    if (IN(6)) REP(6) { p6_rwkv_pass3(C); cvt_rows(in[0], (bf16_t*)(ws + WS_XB2), (size_t)T * D / 8, C.gt, C.ngt); } SEAM(6);
    if (IN(7)) REP(7) {
        pg8::Gemm gm{(const bf16_t*)(ws + WS_XB2), (const bf16_t*)(ws + WS_WG), T, 3072, 1024}; pg8::StaticOrder S; S.init(T, 3072, C.G, (int)blockIdx.x);
        EpiGates E{(bf16_t*)(ws + WS_GATES)}; pg8::gemm_phase(C.lds, gm, S, E);
    } SEAM(7);
    if (IN(8)) REP(8) {
        float* mf = (float*)C.dout; const bf16_t* gt = (const bf16_t*)(ws + WS_GATES); bf16_t* mb = (bf16_t*)(ws + WS_MERGEDB);
        { pg8::Gemm gm{(const bf16_t*)(ws + WS_OLAT), (const bf16_t*)(ws + WS_WOV), T, 1024, 1024}; pg8::StaticOrder S; S.init(T, 1024, C.G, (int)blockIdx.x);
          EpiMerge<0> E{gt, mf, mb}; pg8::gemm_phase(C.lds, gm, S, E); }
        { pg8::Gemm gm{(const bf16_t*)(ws + WS_YRWKV), (const bf16_t*)(ws + WS_WBRR), T, 1024, 512}; pg8::StaticOrder S; S.init(T, 1024, C.G, (int)blockIdx.x);
          EpiMerge<1> E{gt, mf, mb}; pg8::gemm_phase(C.lds, gm, S, E); }
        { pg8::Gemm gm{(const bf16_t*)(ws + WS_YMEM), (const bf16_t*)(ws + WS_WBRM), T, 1024, 512}; pg8::StaticOrder S; S.init(T, 1024, C.G, (int)blockIdx.x);
          EpiMerge<2> E{gt, mf, mb}; pg8::gemm_phase(C.lds, gm, S, E); }
    } SEAM(8);
    if (IN(9)) REP(9) {
        pg8::Gemm gm{(const bf16_t*)(ws + WS_MERGEDB), (const bf16_t*)(ws + WS_WOUT), T, 1024, 1024}; pg8::StaticOrder S; S.init(T, 1024, C.G, (int)blockIdx.x);
        EpiWout E{in[0], (float*)C.dout}; pg8::gemm_phase(C.lds, gm, S, E);
    } SEAM(9);
    if (IN(10)) REP(10) { p8_ln1(C); } SEAM(10);
    if (IN(11)) REP(11) {
        pg8::Gemm gm{(const bf16_t*)(ws + WS_X1B), (const bf16_t*)(ws + WS_WPEER), T, 2048, 1024}; pg8::StaticOrder S; S.init(T, 2048, C.G, (int)blockIdx.x);
        EpiPeerQ E{(bf16_t*)C.dout}; pg8::gemm_phase(C.lds, gm, S, E);
    } SEAM(11);
    if (IN(12)) REP(12) { p10_peer_route(C); } SEAM(12);
    if (IN(13)) REP(13) { p11_peer_experts(C); }
#undef IN
#undef SEAM
}

extern "C" void kernel_launch(void* const* d_in, const int* in_sizes, int n_in, void* d_out, int out_size, void* d_ws, size_t ws_size, hipStream_t stream) {
    static int grid = 0;
    if (grid == 0) {
        if (n_in != 34 || out_size != T * D || ws_size < WS_END) { fprintf(stderr, "kernel_launch: unexpected problem (n_in %d out %d ws %zu)\n", n_in, out_size, ws_size); grid = -1; return; }
        int dev = 0, cus = 0, per_cu = 0;
        if (hipGetDevice(&dev) != hipSuccess || hipDeviceGetAttribute(&cus, hipDeviceAttributeMultiprocessorCount, dev) != hipSuccess) { grid = -1; return; }
        if (hipFuncSetAttribute((const void*)hybrid_fwd, hipFuncAttributeMaxDynamicSharedMemorySize, LDS_BYTES) != hipSuccess) { fprintf(stderr, "kernel_launch: hipFuncSetAttribute failed\n"); grid = -1; return; }
        if (hipOccupancyMaxActiveBlocksPerMultiprocessor(&per_cu, (const void*)hybrid_fwd, NTHREADS, LDS_BYTES) != hipSuccess || per_cu < 1) { fprintf(stderr, "kernel_launch: occupancy query says %d\n", per_cu); }
        (void)hipGetLastError();
        grid = cus;
    }
    if (grid < 0) return;
    (void)hipMemsetAsync((char*)d_ws + WS_CTL, 0, 1 * MiB, stream);
    Args a{};
    for (int i = 0; i < 34; ++i) a.in[i] = (const float*)d_in[i];
    a.out = (float*)d_out; a.ws = (unsigned char*)d_ws; a.li = 0; a.pad = 0;
    if (MK_N_LAUNCHES == 1) { a.ph_lo = 0; a.ph_hi = NPHASE; hipLaunchKernelGGL(hybrid_fwd, dim3(grid), dim3(NTHREADS), LDS_BYTES, stream, a); }
    else for (int p = 0; p < NPHASE; ++p) { a.ph_lo = p; a.ph_hi = p + 1; a.li = p; hipLaunchKernelGGL(hybrid_fwd, dim3(grid), dim3(NTHREADS), LDS_BYTES, stream, a); }
}
```

```cpp
#include <hip/hip_runtime.h>
#include <stdint.h>
#include <stdio.h>

#ifndef MK_N_LAUNCHES
#define MK_N_LAUNCHES 1
#endif

#ifndef PROBE_MASK
#define PROBE_MASK 0
#endif
#define LAS __attribute__((address_space(3)))
typedef unsigned short bf16_t;
typedef short bf16x8 __attribute__((ext_vector_type(8)));
typedef float f32x4 __attribute__((ext_vector_type(4)));
typedef float f32x2 __attribute__((ext_vector_type(2)));
typedef unsigned u32x4 __attribute__((ext_vector_type(4)));
typedef unsigned u32x2 __attribute__((ext_vector_type(2)));

constexpr int NB = 4, SEQ = 4096, T = NB * SEQ, D = 1024;
constexpr int IN_W = 5800;
constexpr int RW = 512;
constexpr int NWAVES = 8, NTHREADS = 512;
constexpr float ALPHA = 1.189207115002721f;
constexpr int RCH = 32, RL = SEQ / RCH;

constexpr size_t MiB = 1u << 20;
constexpr size_t WS_CTL = 0;
constexpr size_t WS_WIN = 1 * MiB, WS_WG = 7 * MiB, WS_WLORA = 13 * MiB, WS_WQ = 14 * MiB, WS_WMEMKV = 15 * MiB, WS_WOV = 17 * MiB,
                 WS_WBRR = 19 * MiB, WS_WBRM = 20 * MiB, WS_WOUT = 21 * MiB, WS_WPEER = 23 * MiB, WS_KEYS = 27 * MiB;
constexpr size_t WS_CSMALL = 29 * MiB, WS_QLAT = 29 * MiB, WS_MERGEDB = 29 * MiB, WS_UB = 29 * MiB;
constexpr size_t WS_RCOLS = 61 * MiB, WS_QIDX = 61 * MiB, WS_YMEM = 69 * MiB, WS_OLAT = 85 * MiB, WS_VB = 61 * MiB, WS_EXPERTS = 93 * MiB, WS_PGATES = 101 * MiB;
constexpr size_t WS_MEMQ = 117 * MiB, WS_YRWKV = 117 * MiB;
constexpr size_t WS_RW_R = 133 * MiB, WS_RW_K = 149 * MiB, WS_RW_V = 165 * MiB, WS_RW_A = 181 * MiB, WS_RW_E = 197 * MiB, WS_RW_G = 213 * MiB;
constexpr size_t WS_GATES = 133 * MiB, WS_X1B = 133 * MiB, WS_X1 = 165 * MiB;
constexpr size_t WS_CQN = 229 * MiB, WS_KVL = 237 * MiB, WS_KIDX = 241 * MiB, WS_WIDX = 242 * MiB, WS_LORAA = 243 * MiB, WS_IDX = 243 * MiB,
                 WS_KMEM = 251 * MiB, WS_VMEMT = 252 * MiB, WS_MEMB = 253 * MiB, WS_END = 256 * MiB;
constexpr size_t DO_XB = 0, DO_PQ = 32 * MiB;
constexpr size_t WS_XB2 = 29 * MiB;
constexpr int CW_DSAQ = 64;

__device__ __forceinline__ unsigned f2bf(float f) { unsigned u = __float_as_uint(f); return (u + 0x7fffu + ((u >> 16) & 1u)) >> 16; }
__device__ __forceinline__ unsigned pk2(float lo, float hi) { return f2bf(lo) | (f2bf(hi) << 16); }
__device__ __forceinline__ float bflo(unsigned w) { return __uint_as_float(w << 16); }
__device__ __forceinline__ float bfhi(unsigned w) { return __uint_as_float(w & 0xffff0000u); }
__device__ __forceinline__ float bf1(bf16_t h) { return __uint_as_float(((unsigned)h) << 16); }
template <int CTRL, int RM = 0xF> __device__ __forceinline__ float dpp_f(float v) { return __builtin_bit_cast(float, __builtin_amdgcn_update_dpp(0, __builtin_bit_cast(int, v), CTRL, RM, 0xF, false)); }
template <int CTRL> __device__ __forceinline__ unsigned dpp_u(unsigned v) { return (unsigned)__builtin_amdgcn_update_dpp(0, (int)v, CTRL, 0xF, 0xF, false); }
__device__ __forceinline__ float wave_sum(float v) {
    v += dpp_f<0x111>(v); v += dpp_f<0x112>(v); v += dpp_f<0x114>(v); v += dpp_f<0x118>(v);
    v += dpp_f<0x142, 0xA>(v); v += dpp_f<0x143, 0xC>(v);
    return __builtin_bit_cast(float, __builtin_amdgcn_readlane(__builtin_bit_cast(int, v), 63));
}
__device__ __forceinline__ unsigned row_max_u(unsigned x) {
    unsigned y = dpp_u<0x128>(x); x = x > y ? x : y; y = dpp_u<0x124>(x); x = x > y ? x : y; y = dpp_u<0x122>(x); x = x > y ? x : y; y = dpp_u<0x121>(x); x = x > y ? x : y; return x; }
__device__ __forceinline__ float row_sum_f(float x) { x += dpp_f<0x128>(x); x += dpp_f<0x124>(x); x += dpp_f<0x122>(x); x += dpp_f<0x121>(x); return x; }
__device__ __forceinline__ float key2f(unsigned k) { const unsigned b = (k & 0x80000000u) ? (k & 0x7fffffffu) : ~k; return __uint_as_float(b); }
__device__ __forceinline__ float sigmoidf_(float x) { return 1.0f / (1.0f + __expf(-x)); }
__device__ __forceinline__ unsigned f2key(float f) { unsigned b = __float_as_uint(f); if (f == 0.0f) b = 0u; return (b & 0x80000000u) ? ~b : (b | 0x80000000u); }
__device__ __forceinline__ u32x4 pack8(const float* v) { u32x4 w; w.x = pk2(v[0], v[1]); w.y = pk2(v[2], v[3]); w.z = pk2(v[4], v[5]); w.w = pk2(v[6], v[7]); return w; }
__device__ __forceinline__ void unpack8(u32x4 w, float* v) { v[0] = bflo(w.x); v[1] = bfhi(w.x); v[2] = bflo(w.y); v[3] = bfhi(w.y); v[4] = bflo(w.z); v[5] = bfhi(w.z); v[6] = bflo(w.w); v[7] = bfhi(w.w); }

#define XB_TMO      128
#define XB_XCNT(j)  (256  + 64 * (j))
#define XB_XSUB(j)  (1280 + 64 * (j))
#define XB_XGEN(j)  (2304 + 64 * (j))
#define XB_TOP      3328
#define XB_TOPGEN   3392
#define XCD_BAR_WORDS 3456
#define XB_SPIN_CAP (1u << 18)

__device__ __forceinline__ unsigned xb_ld(unsigned* p)              { return __hip_atomic_load(p, __ATOMIC_RELAXED, __HIP_MEMORY_SCOPE_AGENT); }
__device__ __forceinline__ unsigned xb_add(unsigned* p, unsigned v) { return __hip_atomic_fetch_add(p, v, __ATOMIC_RELAXED, __HIP_MEMORY_SCOPE_AGENT); }
__device__ __forceinline__ unsigned xb_xcc_id() { return (unsigned)__builtin_amdgcn_s_getreg((3 << 11) | 20) & 0xFu; }
#define XB_SPIN(cond, bar) do { unsigned _sp = 0; while (cond) { __builtin_amdgcn_s_sleep(1); \
    if ((++_sp & 255u) == 0u) { if (xb_ld(&(bar)[XB_TMO])) break; if (_sp > XB_SPIN_CAP) { atomicAdd(&(bar)[XB_TMO], 1u); break; } } } } while (0)

struct XcdBarrier {
    unsigned* bar; unsigned x;
    volatile LAS unsigned* st;
};
__device__ __forceinline__ XcdBarrier xcd_barrier_post(unsigned* bar, volatile LAS unsigned* st) {
    XcdBarrier b; b.bar = bar; b.x = xb_xcc_id(); b.st = st;
    if (threadIdx.x == 0) (void)xb_add(&bar[XB_XCNT(b.x)], 1u);
    return b;
}
__device__ __forceinline__ void xcd_barrier_complete(unsigned* bar, unsigned x, unsigned& nloc, unsigned& nx) {
    const unsigned G = gridDim.x * gridDim.y * gridDim.z;
    unsigned sum, cnt, mine, sp = 0u;
    for (;;) {
        sum = 0u; cnt = 0u; mine = 0u;
#pragma unroll
        for (unsigned j = 0; j < 16; ++j) { const unsigned c = xb_ld(&bar[XB_XCNT(j)]); sum += c; cnt += (c > 0u) ? 1u : 0u; mine = (j == x) ? c : mine; }
        if (sum == G) break;
        __builtin_amdgcn_s_sleep(1);
        if ((++sp & 255u) == 0u) { if (xb_ld(&bar[XB_TMO])) break; if (sp > XB_SPIN_CAP) { atomicAdd(&bar[XB_TMO], 1u); break; } }
    }
    nloc = mine > 0u ? mine : 1u; nx = cnt > 0u ? cnt : 1u;
}
__device__ __forceinline__ void xcd_barrier(const XcdBarrier& b) {
    asm volatile("s_waitcnt vmcnt(0)" ::: "memory");
    __syncthreads();
    if (threadIdx.x == 0) {
        unsigned* bar = b.bar;
        __builtin_amdgcn_s_waitcnt(0);
        unsigned nloc = b.st[0], nx = b.st[1];
        if (nloc == 0u) { xcd_barrier_complete(bar, b.x, nloc, nx); b.st[0] = nloc; b.st[1] = nx; }
        const unsigned old = xb_add(&bar[XB_XSUB(b.x)], 1u);
        const unsigned gen = old / nloc;
        if (old + 1u == (gen + 1u) * nloc) {
            __builtin_amdgcn_fence(__ATOMIC_RELEASE, "agent");
            asm volatile("s_waitcnt vmcnt(0)" ::: "memory");
            const unsigned og = xb_add(&bar[XB_TOP], 1u);
            const unsigned tg = og / nx;
            if (og + 1u == (tg + 1u) * nx) xb_add(&bar[XB_TOPGEN], 1u);
            else XB_SPIN(xb_ld(&bar[XB_TOPGEN]) == tg, bar);
            __builtin_amdgcn_fence(__ATOMIC_ACQUIRE, "agent");
            xb_add(&bar[XB_XGEN(b.x)], 1u);
            asm volatile("s_waitcnt vmcnt(0)" ::: "memory");
        } else {
            XB_SPIN(xb_ld(&bar[XB_XGEN(b.x)]) == gen, bar);
            __builtin_amdgcn_fence(__ATOMIC_ACQUIRE, "agent");
            asm volatile("s_waitcnt vmcnt(0)" ::: "memory");
        }
    }
    __syncthreads();
}

namespace pg8 {
constexpr int BM = 256, BK = 64, HALF = 128, HTB = HALF * BK * 2, STAGE_BYTES = 8 * HTB, NXCD = 8, WGM = 8;
__device__ __forceinline__ int lds_byte(int r, int c) { const int st = (r >> 4) * 2 + (c >> 5), rr = r & 15, cc = c & 31, ob = rr * 64 + cc * 2; return st * 1024 + (ob ^ (((ob >> 9) & 1) << 5)); }
__device__ __forceinline__ void stage_rc(int b, int& R, int& C) { const int st = b / 1024, sb = b % 1024, swz = sb ^ (((sb >> 9) & 1) << 5); R = (st >> 1) * 16 + swz / 64; C = (st & 1) * 32 + (swz % 64) / 2; }
__device__ __forceinline__ int perm32(int rho) { const int n = rho >> 4, i = rho & 15; return 8 * (i >> 2) + 4 * n + (i & 3); }
struct Unit { int pm, pn; };
struct Gemm { const bf16_t* A; const bf16_t* Bt; int M, N, K; };
struct StaticOrder {
    int nM, nN, nwg, G, c;
    __device__ void init(int M, int N, int G_, int c_) { nM = M / BM; nN = N / BM; nwg = nM * nN; G = G_; c = c_; }
    __device__ bool next(int i, Unit& u) const {
        const long L = (long)i * G + c; if (L >= nwg) return false;
        int wgid = (int)L; { const int q = nwg / NXCD, r = nwg % NXCD, xcd = wgid % NXCD, off = wgid / NXCD; wgid = (xcd < r ? xcd * (q + 1) : r * (q + 1) + (xcd - r) * q) + off; }
        const int nig = WGM * nN, gid = wgid / nig, fm = gid * WGM, gsz = (nM - fm) < WGM ? (nM - fm) : WGM;
        u.pm = fm + ((wgid % nig) % gsz); u.pn = (wgid % nig) / gsz; return true;
    }
};
template <class Epi>
__device__ __forceinline__ void gemm_phase(LAS unsigned char* lds, const Gemm g, const StaticOrder& S, const Epi& E) {
    const int tid = threadIdx.x, wid = __builtin_amdgcn_readfirstlane(tid >> 6), lane = tid & 63, wr = wid >> 2, wc = wid & 3, fr = lane & 15, fq = lane >> 4;
    const int K = g.K, nt = K / BK;
    unsigned voffA[2], voffB[2];
#pragma unroll
    for (int i = 0; i < 2; ++i) { int R, C; stage_rc(tid * 16 + i * 8192, R, C); const int Rb = (R & ~31) + perm32(R & 31);
        voffA[i] = (unsigned)(R * K + C) * 2u; voffB[i] = (unsigned)(Rb * K + C) * 2u; }
    const size_t kstep = (size_t)(BK * 2);
    const size_t hstep = (size_t)HALF * K * 2;
    const size_t tstep = 2 * hstep;
    const unsigned ldsw = (unsigned)wid * 1024u;
    const int aoff = lds_byte(wr * 64 + fr, fq * 8), boff = lds_byte(wc * 32 + fr, fq * 8);
#define PG8_SA(b, h) (((b) * 2 + (h)) * HTB)
#define PG8_SB(b, h) ((4 + (b) * 2 + (h)) * HTB)
#define PG8_STAGE(bufoff, gbase, voff) do { _Pragma("unroll") for (int _i = 0; _i < 2; ++_i) \
        __builtin_amdgcn_global_load_lds((const unsigned*)((const char*)(gbase) + (voff)[_i]), (LAS unsigned*)(lds + (bufoff) + ldsw + _i * 8192), 16, 0, 0); } while (0)
#define PG8_LDA(dst, b, h) do { _Pragma("unroll") for (int m = 0; m < 4; ++m) _Pragma("unroll") for (int k = 0; k < 2; ++k) dst[m][k] = *(const LAS bf16x8*)(lds + PG8_SA(b, h) + aoff + m * 2048 + k * 1024); } while (0)
#define PG8_LDB(dst, b, h) do { _Pragma("unroll") for (int n = 0; n < 2; ++n) _Pragma("unroll") for (int k = 0; k < 2; ++k) dst[n][k] = *(const LAS bf16x8*)(lds + PG8_SB(b, h) + boff + n * 2048 + k * 1024); } while (0)
#define PG8_MMA(ai, bj, At, Bt) do { __builtin_amdgcn_s_setprio(1); _Pragma("unroll") for (int m = 0; m < 4; ++m) _Pragma("unroll") for (int n = 0; n < 2; ++n) _Pragma("unroll") for (int k = 0; k < 2; ++k) \
        acc[ai][bj][m][n] = __builtin_amdgcn_mfma_f32_16x16x32_bf16(Bt[n][k], At[m][k], acc[ai][bj][m][n], 0, 0, 0); __builtin_amdgcn_s_setprio(0); } while (0)
#define PG8_WAIT_V(n) asm volatile("s_waitcnt vmcnt(" #n ")" ::: "memory")
#define PG8_WAIT_L(n) asm volatile("s_waitcnt lgkmcnt(" #n ")" ::: "memory")
#define PG8_BAR __builtin_amdgcn_s_barrier()
#define PG8_SCHED __builtin_amdgcn_sched_barrier(0)
    Unit cur, nxt; int ui = 0;
    if (!S.next(0, cur)) return;
    f32x4 acc[2][2][4][2];
#pragma unroll
    for (int a = 0; a < 2; ++a)
#pragma unroll
        for (int b = 0; b < 2; ++b)
#pragma unroll
            for (int m = 0; m < 4; ++m)
#pragma unroll
                for (int n = 0; n < 2; ++n) acc[a][b][m][n] = (f32x4){0.f, 0.f, 0.f, 0.f};
    bf16x8 At[4][2], B0[2][2], B1[2][2];
    const char* cA = (const char*)g.A + (size_t)cur.pm * tstep; const char* cB = (const char*)g.Bt + (size_t)cur.pn * tstep;
    PG8_STAGE(PG8_SB(0, 0), cB, voffB); PG8_STAGE(PG8_SA(0, 0), cA, voffA); PG8_STAGE(PG8_SB(0, 1), cB + hstep, voffB); PG8_STAGE(PG8_SA(0, 1), cA + hstep, voffA);
    if (wr == 1) PG8_BAR;
    PG8_WAIT_V(4); PG8_BAR;
    PG8_STAGE(PG8_SB(1, 0), cB + kstep, voffB); PG8_STAGE(PG8_SA(1, 0), cA + kstep, voffA); PG8_STAGE(PG8_SB(1, 1), cB + hstep + kstep, voffB);
    PG8_WAIT_V(6); PG8_BAR;
    for (;;) {
        const bool has_next = S.next(ui + 1, nxt);
        const char* nA = has_next ? (const char*)g.A + (size_t)nxt.pm * tstep : cA; const char* nB = has_next ? (const char*)g.Bt + (size_t)nxt.pn * tstep : cB;
#pragma unroll 1
        for (int t = 0; t < nt; t += 2) {
            const bool last = (t == nt - 2);
            const char* a1 = cA + (size_t)(t + 1) * kstep;
            const char* a2 = last ? nA : cA + (size_t)(t + 2) * kstep; const char* b2 = last ? nB : cB + (size_t)(t + 2) * kstep;
            const char* a3 = a2 + kstep; const char* b3 = b2 + kstep;
            PG8_LDB(B0, 0, 0); PG8_SCHED; PG8_LDA(At, 0, 0); PG8_STAGE(PG8_SA(1, 1), a1 + hstep, voffA);
            PG8_WAIT_L(8); PG8_BAR; PG8_WAIT_L(0); PG8_MMA(0, 0, At, B0); PG8_BAR; PG8_SCHED;
            PG8_LDB(B1, 0, 1); PG8_STAGE(PG8_SB(0, 0), b2, voffB);
            PG8_BAR; PG8_WAIT_L(0); PG8_MMA(0, 1, At, B1); PG8_BAR;
            PG8_LDA(At, 0, 1); PG8_STAGE(PG8_SA(0, 0), a2, voffA);
            PG8_BAR; PG8_WAIT_L(0); PG8_MMA(1, 0, At, B0); PG8_BAR; PG8_SCHED;
            PG8_STAGE(PG8_SB(0, 1), b2 + hstep, voffB);
            PG8_WAIT_V(6); PG8_BAR; PG8_MMA(1, 1, At, B1); PG8_BAR;
            PG8_LDB(B0, 1, 0); PG8_SCHED; PG8_LDA(At, 1, 0); PG8_STAGE(PG8_SA(0, 1), a2 + hstep, voffA);
            PG8_WAIT_L(8); PG8_BAR; PG8_WAIT_L(0); PG8_MMA(0, 0, At, B0); PG8_BAR; PG8_SCHED;
            PG8_LDB(B1, 1, 1); PG8_STAGE(PG8_SB(1, 0), b3, voffB);
            PG8_BAR; PG8_WAIT_L(0); PG8_MMA(0, 1, At, B1); PG8_BAR;
            PG8_LDA(At, 1, 1); PG8_STAGE(PG8_SA(1, 0), a3, voffA);
            PG8_BAR; PG8_WAIT_L(0); PG8_MMA(1, 0, At, B0); PG8_BAR; PG8_SCHED;
            PG8_STAGE(PG8_SB(1, 1), b3 + hstep, voffB);
            PG8_WAIT_V(6); PG8_BAR; PG8_MMA(1, 1, At, B1); PG8_BAR;
        }
        {
            const int row0 = cur.pm * BM + wr * 64 + fr, col0 = cur.pn * BM + wc * 32 + 8 * fq;
#pragma unroll
            for (int ai = 0; ai < 2; ++ai)
#pragma unroll
                for (int m = 0; m < 4; ++m)
#pragma unroll
                    for (int bj = 0; bj < 2; ++bj) { E(row0 + ai * HALF + m * 16, col0 + bj * HALF, cur.pn, acc[ai][bj][m][0], acc[ai][bj][m][1]); if (Epi::SERIAL) __builtin_amdgcn_sched_barrier(0); }
        }
        if (!has_next) break;
#pragma unroll
        for (int a = 0; a < 2; ++a)
#pragma unroll
            for (int b = 0; b < 2; ++b)
#pragma unroll
                for (int m = 0; m < 4; ++m)
#pragma unroll
                    for (int n = 0; n < 2; ++n) acc[a][b][m][n] = (f32x4){0.f, 0.f, 0.f, 0.f};
        cur = nxt; cA = nA; cB = nB; ++ui;
    }
    PG8_WAIT_V(0);
    if (wr == 0) PG8_BAR;
    PG8_BAR;
#undef PG8_SA
#undef PG8_SB
#undef PG8_STAGE
#undef PG8_LDA
#undef PG8_LDB
#undef PG8_MMA
#undef PG8_WAIT_V
#undef PG8_WAIT_L
#undef PG8_BAR
#undef PG8_SCHED
}
}

struct Args { const float* in[34]; float* out; unsigned char* ws; int ph_lo, ph_hi, li, pad; };

struct Ctx {
    LAS unsigned char* lds;
    int tid, lane, wave, gw, ngw, gt, ngt, G;
    const float* const* in; unsigned char* ws; unsigned char* dout;
};

__device__ __forceinline__ void st8_bf16(bf16_t* p, f32x4 a, f32x4 b) { u32x4 w; w.x = pk2(a.x, a.y); w.y = pk2(a.z, a.w); w.z = pk2(b.x, b.y); w.w = pk2(b.z, b.w); *(u32x4*)p = w; }
struct EpiP1 { static constexpr bool SERIAL = false;
    float* cs; bf16_t* rc; bf16_t* mq;
    __device__ __forceinline__ void operator()(int row, int col, int pn, f32x4 a, f32x4 b) const {
        if (pn < 2) { float* p = cs + (size_t)row * 512 + col; *(f32x4*)p = a; *(f32x4*)(p + 4) = b; }
        else if (pn < 9) st8_bf16(rc + (size_t)row * 1792 + (col - 512), a, b);
        else st8_bf16(mq + (size_t)row * 512 + (col - 2304), a, b);
    }
};
struct EpiMemKV { static constexpr bool SERIAL = false;
    bf16_t* km; bf16_t* vt;
    __device__ __forceinline__ void operator()(int row, int col, int pn, f32x4 a, f32x4 b) const {
        const int bb = row >> 8, m = row & 255;
        if (col < 512) { const int h = col >> 7, d = col & 127; st8_bf16(km + ((size_t)((bb * 4 + h) * 256 + m)) * 128 + d, a, b); }
        else { const int c2 = col - 512, h = c2 >> 7, d = c2 & 127; bf16_t* p = vt + ((size_t)((bb * 4 + h) * 128 + d)) * 256 + m;
            p[0] = (bf16_t)f2bf(a.x); p[256] = (bf16_t)f2bf(a.y); p[512] = (bf16_t)f2bf(a.z); p[768] = (bf16_t)f2bf(a.w);
            p[1024] = (bf16_t)f2bf(b.x); p[1280] = (bf16_t)f2bf(b.y); p[1536] = (bf16_t)f2bf(b.z); p[1792] = (bf16_t)f2bf(b.w); }
    }
};
struct EpiLora { static constexpr bool SERIAL = true;
    bf16_t* e; bf16_t* a; bf16_t* g; const float* w0; const float* a0;
    __device__ __forceinline__ void operator()(int row, int col, int pn, f32x4 x, f32x4 y) const {
        float v[8] = {x.x, x.y, x.z, x.w, y.x, y.y, y.z, y.w};
        if (pn < 4) { const int c = col & 511; const float* bp = (pn < 2 ? w0 : a0) + c; const f32x4 b0 = *(const f32x4*)bp, b1 = *(const f32x4*)(bp + 4);
            const float bb[8] = {b0.x, b0.y, b0.z, b0.w, b1.x, b1.y, b1.z, b1.w}; const float sc = pn < 2 ? 0.6065306597126334f : 1.0f;
#pragma unroll
            for (int j = 0; j < 8; ++j) v[j] = sc * sigmoidf_(v[j] + bb[j]);
            *(u32x4*)((pn < 2 ? e : a) + (size_t)row * 512 + c) = pack8(v);
        } else *(u32x4*)(g + (size_t)row * 512 + (col - 1024)) = pack8(v);
    }
};
struct EpiQ { static constexpr bool SERIAL = false;
    bf16_t* ql; bf16_t* qi;
    __device__ __forceinline__ void operator()(int row, int col, int pn, f32x4 a, f32x4 b) const {
        if (pn < 4) st8_bf16(ql + (size_t)row * 1024 + col, a, b); else st8_bf16(qi + (size_t)row * 256 + (col - 1024), a, b);
    }
};
struct EpiGates { static constexpr bool SERIAL = true;
    bf16_t* o;
    __device__ __forceinline__ void operator()(int row, int col, int pn, f32x4 a, f32x4 b) const {
        float v[8] = {a.x, a.y, a.z, a.w, b.x, b.y, b.z, b.w};
#pragma unroll
        for (int j = 0; j < 8; ++j) v[j] = sigmoidf_(v[j]);
        *(u32x4*)(o + (size_t)row * 3072 + col) = pack8(v);
    }
};
template <int WHICH> struct EpiMerge { static constexpr bool SERIAL = true;
    const bf16_t* gates; float* mf; bf16_t* mb;
    __device__ __forceinline__ void operator()(int row, int col, int pn, f32x4 a, f32x4 b) const {
        float v[8] = {a.x, a.y, a.z, a.w, b.x, b.y, b.z, b.w}, gv[8];
        unpack8(*(const u32x4*)(gates + (size_t)row * 3072 + WHICH * 1024 + col), gv);
        float* p = mf + (size_t)row * 1024 + col;
        if (WHICH == 0) {
#pragma unroll
            for (int j = 0; j < 8; ++j) v[j] *= gv[j];
        } else { const f32x4 p0 = *(const f32x4*)p, p1 = *(const f32x4*)(p + 4); const float pv[8] = {p0.x, p0.y, p0.z, p0.w, p1.x, p1.y, p1.z, p1.w};
#pragma unroll
            for (int j = 0; j < 8; ++j) v[j] = pv[j] + v[j] * gv[j];
        }
        if (WHICH == 2) *(u32x4*)(mb + (size_t)row * 1024 + col) = pack8(v);
        else { *(f32x4*)p = (f32x4){v[0], v[1], v[2], v[3]}; *(f32x4*)(p + 4) = (f32x4){v[4], v[5], v[6], v[7]}; }
    }
};
struct EpiWout { static constexpr bool SERIAL = false;
    const float* x; float* pre;
    __device__ __forceinline__ void operator()(int row, int col, int pn, f32x4 a, f32x4 b) const {
        const float* xp = x + (size_t)row * 1024 + col; float* p = pre + (size_t)row * 1024 + col;
        *(f32x4*)p = *(const f32x4*)xp * ALPHA + a; *(f32x4*)(p + 4) = *(const f32x4*)(xp + 4) * ALPHA + b;
    }
};
struct EpiPeerQ { static constexpr bool SERIAL = false; bf16_t* o; __device__ __forceinline__ void operator()(int row, int col, int pn, f32x4 a, f32x4 b) const { st8_bf16(o + (size_t)row * 2048 + col, a, b); } };

template <int N, int K, class F> __device__ __forceinline__ void build_bt(bf16_t* dst, const F& f, int gt, int ngt) {
    constexpr int items = N * (K / 8);
    for (int i = gt; i < items; i += ngt) { const int n = i % N, k0 = (i / N) * 8; float v[8];
#pragma unroll
        for (int j = 0; j < 8; ++j) v[j] = f(n, k0 + j);
        *(u32x4*)(dst + (size_t)n * K + k0) = pack8(v); }
}
struct FWin { const float* w; __device__ __forceinline__ float operator()(int n, int k) const { if (n < 424) return w[(size_t)k * IN_W + n]; if (n < 512) return 0.f; return w[(size_t)k * IN_W + n - 88]; } };
struct FWg { const float* w; __device__ __forceinline__ float operator()(int n, int k) const { return w[(size_t)k * IN_W + 2728 + n]; } };
struct FLora { const float *w2, *a2, *g2; __device__ __forceinline__ float operator()(int n, int k) const {
    if (n < 512) return k < 64 ? w2[k * 512 + n] : 0.f;
    if (n < 1024) return (k >= 64 && k < 128) ? a2[(k - 64) * 512 + n - 512] : 0.f;
    return k >= 128 ? g2[(k - 128) * 512 + n - 1024] : 0.f; } };
struct FWq { const float *uq, *uk, *iq; __device__ __forceinline__ float operator()(int n, int k) const {
    if (n >= 1024) return iq[k * 256 + n - 1024];
    const int h = n >> 7, c = n & 127; const float* a = uq + (size_t)k * 512 + h * 64; const float* b = uk + (size_t)(c * 8 + h) * 64; float s = 0.f;
#pragma unroll 8
    for (int d = 0; d < 64; ++d) s = fmaf(a[d], b[d], s);
    return s * 0.125f; } };
struct FWov { const float *uv, *br; __device__ __forceinline__ float operator()(int n, int k) const {
    const int h = k >> 7, c = k & 127; const float* a = uv + (size_t)(c * 8 + h) * 64; const float* b = br + (size_t)(h * 64) * 1024 + n; float s = 0.f;
#pragma unroll 8
    for (int d = 0; d < 64; ++d) s = fmaf(a[d], b[(size_t)d * 1024], s);
    return s; } };
struct FT { const float* w; int ld; __device__ __forceinline__ float operator()(int n, int k) const { return w[(size_t)k * ld + n]; } };

__device__ __forceinline__ void cvt_rows(const float* src, bf16_t* dst, size_t n8, int gt, int ngt) {
    for (size_t i = gt; i < n8; i += ngt) { const f32x4 a = *(const f32x4*)(src + i * 8), b = *(const f32x4*)(src + i * 8 + 4); st8_bf16(dst + i * 8, a, b); }
}
constexpr float PEER_U_SCALE = 64.0f, PEER_V_SCALE = 8.0f;
__device__ __forceinline__ void cvt_rows_fp8(const float* src, unsigned char* dst, size_t n16, float scale, int gt, int ngt) {
    for (size_t i = gt; i < n16; i += ngt) { const float* p = src + i * 16; u32x4 w;
        const f32x4 a = *(const f32x4*)p * scale, b = *(const f32x4*)(p + 4) * scale, c = *(const f32x4*)(p + 8) * scale, d = *(const f32x4*)(p + 12) * scale;
        int t = 0; t = __builtin_amdgcn_cvt_pk_fp8_f32(a.x, a.y, t, false); t = __builtin_amdgcn_cvt_pk_fp8_f32(a.z, a.w, t, true); w.x = (unsigned)t;
        t = 0; t = __builtin_amdgcn_cvt_pk_fp8_f32(b.x, b.y, t, false); t = __builtin_amdgcn_cvt_pk_fp8_f32(b.z, b.w, t, true); w.y = (unsigned)t;
        t = 0; t = __builtin_amdgcn_cvt_pk_fp8_f32(c.x, c.y, t, false); t = __builtin_amdgcn_cvt_pk_fp8_f32(c.z, c.w, t, true); w.z = (unsigned)t;
        t = 0; t = __builtin_amdgcn_cvt_pk_fp8_f32(d.x, d.y, t, false); t = __builtin_amdgcn_cvt_pk_fp8_f32(d.z, d.w, t, true); w.w = (unsigned)t;
        *(u32x4*)(dst + i * 16) = w; }
}
__device__ __forceinline__ void p0_prologue(const Ctx& C) {
    const float* const* in = C.in; unsigned char* ws = C.ws;
    cvt_rows(in[0], (bf16_t*)(C.dout + DO_XB), (size_t)T * D / 8, C.gt, C.ngt);
    cvt_rows(in[1], (bf16_t*)(ws + WS_MEMB), (size_t)1024 * 1024 / 8, C.gt, C.ngt);
    cvt_rows(in[29], (bf16_t*)(ws + WS_KEYS), (size_t)2 * 128 * 128 / 8, C.gt, C.ngt);
    build_bt<2816, 1024>((bf16_t*)(ws + WS_WIN), FWin{in[3]}, C.gt, C.ngt);
    build_bt<3072, 1024>((bf16_t*)(ws + WS_WG), FWg{in[3]}, C.gt, C.ngt);
    build_bt<1536, 256>((bf16_t*)(ws + WS_WLORA), FLora{in[12], in[14], in[15]}, C.gt, C.ngt);
    {
        bf16_t* dst = (bf16_t*)(ws + WS_WQ); const float* uq = in[6]; const float* uk = in[7];
        for (int item = C.gw; item < 4096; item += C.ngw) { const int n = item >> 2, k = (item & 3) * 64 + C.lane, h = n >> 7, c = n & 127;
            const float* a = uq + (size_t)k * 512 + h * 64; const float* bq = uk + (size_t)(c * 8 + h) * 64; float s = 0.f;
#pragma unroll
            for (int d4 = 0; d4 < 16; ++d4) { const f32x4 av = *(const f32x4*)(a + 4 * d4), bv = *(const f32x4*)(bq + 4 * d4); s += av.x * bv.x + av.y * bv.y + av.z * bv.z + av.w * bv.w; }
            dst[(size_t)n * 256 + k] = (bf16_t)f2bf(s * 0.125f); }
        build_bt<256, 256>(dst + 1024 * 256, FT{in[9], 256}, C.gt, C.ngt);
    }
    build_bt<1024, 1024>((bf16_t*)(ws + WS_WMEMKV), FT{in[21], 1024}, C.gt, C.ngt);
    {
        bf16_t* dst = (bf16_t*)(ws + WS_WOV); const float* uv = in[8]; const float* br = in[22];
        for (int i = C.gt; i < 1024 * 128; i += C.ngt) { const int n = i & 1023, k0 = (i >> 10) * 8, h = k0 >> 7, c0 = k0 & 127; float acc[8];
#pragma unroll
            for (int j = 0; j < 8; ++j) acc[j] = 0.f;
            for (int d4 = 0; d4 < 16; ++d4) {
                float b[4];
#pragma unroll
                for (int q = 0; q < 4; ++q) b[q] = br[(size_t)(h * 64 + 4 * d4 + q) * 1024 + n];
#pragma unroll
                for (int j = 0; j < 8; ++j) { const f32x4 a = *(const f32x4*)(uv + (size_t)((c0 + j) * 8 + h) * 64 + 4 * d4); acc[j] += a.x * b[0] + a.y * b[1] + a.z * b[2] + a.w * b[3]; }
            }
            *(u32x4*)(dst + (size_t)n * 1024 + k0) = pack8(acc); }
    }
    build_bt<1024, 512>((bf16_t*)(ws + WS_WBRR), FT{in[23], 1024}, C.gt, C.ngt);
    build_bt<1024, 512>((bf16_t*)(ws + WS_WBRM), FT{in[24], 1024}, C.gt, C.ngt);
    build_bt<1024, 1024>((bf16_t*)(ws + WS_WOUT), FT{in[25], 1024}, C.gt, C.ngt);
    build_bt<2048, 1024>((bf16_t*)(ws + WS_WPEER), FT{in[28], 2048}, C.gt, C.ngt);
}

__device__ __forceinline__ void p2_prep(const Ctx& C) {
    const float* const* in = C.in; unsigned char* ws = C.ws; const int lane = C.lane;
    const float* csmall = (const float*)(ws + WS_CSMALL); const bf16_t* rcols = (const bf16_t*)(ws + WS_RCOLS);
    bf16_t* cqn = (bf16_t*)(ws + WS_CQN); bf16_t* kvl = (bf16_t*)(ws + WS_KVL); bf16_t* kidx = (bf16_t*)(ws + WS_KIDX); float* widx = (float*)(ws + WS_WIDX);
    bf16_t* rr = (bf16_t*)(ws + WS_RW_R); bf16_t* rk = (bf16_t*)(ws + WS_RW_K); bf16_t* rv = (bf16_t*)(ws + WS_RW_V); bf16_t* la = (bf16_t*)(ws + WS_LORAA);
    const float* mu = in[10];
    const f32x4 gq = *(const f32x4*)(in[4] + 4 * lane); const f32x2 gk = *(const f32x2*)(in[5] + 2 * lane);
    for (int t = C.gw; t < T; t += C.ngw) {
        const float* cs = csmall + (size_t)t * 512;
        {
            const f32x4 q = *(const f32x4*)(cs + 4 * lane);
            const float ss = wave_sum(q.x * q.x + q.y * q.y + q.z * q.z + q.w * q.w);
            const float rs = rsqrtf(ss * (1.0f / 256.0f) + 1e-6f);
            u32x2 w; w.x = pk2(q.x * rs * gq.x, q.y * rs * gq.y); w.y = pk2(q.z * rs * gq.z, q.w * rs * gq.w);
            *(u32x2*)(cqn + (size_t)t * 256 + 4 * lane) = w;
        }
        {
            const f32x2 k = *(const f32x2*)(cs + 256 + 2 * lane);
            const float ss = wave_sum(k.x * k.x + k.y * k.y);
            const float rs = rsqrtf(ss * (1.0f / 128.0f) + 1e-6f);
            *(unsigned*)(kvl + (size_t)t * 128 + 2 * lane) = pk2(k.x * rs * gk.x, k.y * rs * gk.y);
        }
        if (lane < 16) { const f32x2 k = *(const f32x2*)(cs + 384 + 2 * lane); *(unsigned*)(kidx + (size_t)t * 32 + 2 * lane) = pk2(k.x, k.y); }
        if (lane < 8) widx[(size_t)t * 8 + lane] = cs[416 + lane] * 0.0625f;
        const bf16_t* rc = rcols + (size_t)t * 1792; const bool hp = (t & (SEQ - 1)) != 0; const bf16_t* rp = hp ? rc - 1792 : rc;
#pragma unroll
        for (int seg = 0; seg < 3; ++seg) {
            float c[8], p[8], o[8];
            unpack8(*(const u32x4*)(rc + seg * 512 + 8 * lane), c); unpack8(*(const u32x4*)(rp + seg * 512 + 8 * lane), p);
            const f32x4 m0 = *(const f32x4*)(mu + seg * 512 + 8 * lane), m1 = *(const f32x4*)(mu + seg * 512 + 8 * lane + 4);
            const float mm[8] = {m0.x, m0.y, m0.z, m0.w, m1.x, m1.y, m1.z, m1.w};
#pragma unroll
            for (int j = 0; j < 8; ++j) { const float pv = hp ? p[j] : 0.f; o[j] = c[j] + (pv - c[j]) * mm[j]; }
            bf16_t* dst = (seg == 0 ? rr : (seg == 1 ? rk : rv)) + (size_t)t * 512 + 8 * lane;
            *(u32x4*)dst = pack8(o);
        }
        {
            const float cw = bf1(rc[1536 + lane]), pw = hp ? bf1(rp[1536 + lane]) : 0.f; const float wl = cw + (pw - cw) * mu[1536 + lane];
            const float ca = bf1(rc[1600 + lane]), pa = hp ? bf1(rp[1600 + lane]) : 0.f; const float al = ca + (pa - ca) * mu[1600 + lane];
            const unsigned cgw = *(const unsigned*)(rc + 1664 + 2 * lane), pgw = *(const unsigned*)(rp + 1664 + 2 * lane);
            const float cg0 = bflo(cgw), cg1 = bfhi(cgw), pg0 = hp ? bflo(pgw) : 0.f, pg1 = hp ? bfhi(pgw) : 0.f;
            const float g0 = cg0 + (pg0 - cg0) * mu[1664 + 2 * lane], g1 = cg1 + (pg1 - cg1) * mu[1664 + 2 * lane + 1];
            bf16_t* l = la + (size_t)t * 256;
            l[lane] = (bf16_t)f2bf(tanhf(wl)); l[64 + lane] = (bf16_t)f2bf(al);
            *(unsigned*)(l + 128 + 2 * lane) = pk2(sigmoidf_(g0), sigmoidf_(g1));
        }
    }
}

template <int NV> __device__ __forceinline__ unsigned kth_largest(const unsigned (&u)[NV], int k) {
    unsigned Tk = 0u;
    for (int bit = 31; bit >= 0; --bit) {
        const unsigned cand = Tk | (1u << bit); int cnt = 0;
#pragma unroll
        for (int j = 0; j < NV; ++j) cnt += __popcll(__ballot(u[j] >= cand));
        if (cnt >= k) Tk = cand;
    }
    return Tk;
}

__device__ __forceinline__ unsigned wave_max_u(unsigned x) {
    unsigned y;
    y = dpp_u<0x111>(x); x = x > y ? x : y; y = dpp_u<0x112>(x); x = x > y ? x : y; y = dpp_u<0x114>(x); x = x > y ? x : y; y = dpp_u<0x118>(x); x = x > y ? x : y;
    y = (unsigned)__builtin_amdgcn_update_dpp(0, (int)x, 0x142, 0xA, 0xF, false); x = x > y ? x : y;
    y = (unsigned)__builtin_amdgcn_update_dpp(0, (int)x, 0x143, 0xC, 0xF, false); x = x > y ? x : y;
    return (unsigned)__builtin_amdgcn_readlane((int)x, 63);
}
__device__ __forceinline__ int wave_sum_i(int x) {
    x += __builtin_amdgcn_update_dpp(0, x, 0x111, 0xF, 0xF, false); x += __builtin_amdgcn_update_dpp(0, x, 0x112, 0xF, 0xF, false);
    x += __builtin_amdgcn_update_dpp(0, x, 0x114, 0xF, 0xF, false); x += __builtin_amdgcn_update_dpp(0, x, 0x118, 0xF, 0xF, false);
    x += __builtin_amdgcn_update_dpp(0, x, 0x142, 0xA, 0xF, false); x += __builtin_amdgcn_update_dpp(0, x, 0x143, 0xC, 0xF, false);
    return __builtin_amdgcn_readlane(x, 63);
}
__device__ __forceinline__ float wave_max_f(float x) {
    const int ninf = (int)0xff800000u; float y;
    y = __builtin_bit_cast(float, __builtin_amdgcn_update_dpp(ninf, __builtin_bit_cast(int, x), 0x111, 0xF, 0xF, false)); x = fmaxf(x, y);
    y = __builtin_bit_cast(float, __builtin_amdgcn_update_dpp(ninf, __builtin_bit_cast(int, x), 0x112, 0xF, 0xF, false)); x = fmaxf(x, y);
    y = __builtin_bit_cast(float, __builtin_amdgcn_update_dpp(ninf, __builtin_bit_cast(int, x), 0x114, 0xF, 0xF, false)); x = fmaxf(x, y);
    y = __builtin_bit_cast(float, __builtin_amdgcn_update_dpp(ninf, __builtin_bit_cast(int, x), 0x118, 0xF, 0xF, false)); x = fmaxf(x, y);
    y = __builtin_bit_cast(float, __builtin_amdgcn_update_dpp(ninf, __builtin_bit_cast(int, x), 0x142, 0xA, 0xF, false)); x = fmaxf(x, y);
    y = __builtin_bit_cast(float, __builtin_amdgcn_update_dpp(ninf, __builtin_bit_cast(int, x), 0x143, 0xC, 0xF, false)); x = fmaxf(x, y);
    return __builtin_bit_cast(float, __builtin_amdgcn_readlane(__builtin_bit_cast(int, x), 63));
}
__device__ __forceinline__ int wave_scan_i(int x) {
    x += __builtin_amdgcn_update_dpp(0, x, 0x111, 0xF, 0xF, false); x += __builtin_amdgcn_update_dpp(0, x, 0x112, 0xF, 0xF, false);
    x += __builtin_amdgcn_update_dpp(0, x, 0x114, 0xF, 0xF, false); x += __builtin_amdgcn_update_dpp(0, x, 0x118, 0xF, 0xF, false);
    x += __builtin_amdgcn_update_dpp(0, x, 0x142, 0xA, 0xF, false); x += __builtin_amdgcn_update_dpp(0, x, 0x143, 0xC, 0xF, false);
    return x;
}
__device__ __forceinline__ int hist_find(u32x4 h, int K, int lane, int& chi, int& cnt) {
    const int ls = (int)(h.x + h.y + h.z + h.w); const int inc = wave_scan_i(ls); const int tot = __builtin_amdgcn_readlane(inc, 63);
    const int a3 = tot - inc, a2 = a3 + (int)h.w, a1 = a2 + (int)h.z, a0 = a1 + (int)h.y;
    int myb = -1, mya = 0, myc = 0;
    if (a3 < K && K <= a3 + (int)h.w) { myb = 3; mya = a3; myc = (int)h.w; }
    if (a2 < K && K <= a2 + (int)h.z) { myb = 2; mya = a2; myc = (int)h.z; }
    if (a1 < K && K <= a1 + (int)h.y) { myb = 1; mya = a1; myc = (int)h.y; }
    if (a0 < K && K <= a0 + (int)h.x) { myb = 0; mya = a0; myc = (int)h.x; }
    const unsigned long long m = __ballot(myb >= 0); const int src = m ? (int)__builtin_ctzll(m) : 0;
    chi = __builtin_amdgcn_readlane(mya, src); cnt = __builtin_amdgcn_readlane(myc, src);
    return 4 * src + __builtin_amdgcn_readlane(myb, src);
}
constexpr int LDS_HIST = 131072 + 4096;
__device__ __forceinline__ void p4_indexer(const Ctx& C) {
    unsigned char* ws = C.ws; const int lane = C.lane, wave = C.wave, g = lane >> 4, fr = lane & 15;
    const bf16_t* qidx = (const bf16_t*)(ws + WS_QIDX); const bf16_t* kidx = (const bf16_t*)(ws + WS_KIDX); const float* widx = (const float*)(ws + WS_WIDX);
    bf16_t* idxo = (bf16_t*)(ws + WS_IDX);
    LAS float* SC = (LAS float*)C.lds;
    LAS unsigned* H = (LAS unsigned*)(C.lds + LDS_HIST + wave * 1024);
    for (int u = blockIdx.x; u < 2048; u += C.G) {
        const int i8 = u >> 8, cc = u & 255, b = cc & 3, j = cc >> 2, qb = (i8 & 1) ? 64 * i8 + 63 - j : 64 * i8 + j;
        const int t0 = qb * 8, ntile = (t0 + 8 + 15) >> 4; const size_t tb = (size_t)b * SEQ;
        const int qn = fr & 7;
        bf16x8 Bq[8];
#pragma unroll
        for (int h = 0; h < 8; ++h) Bq[h] = *(const bf16x8*)(qidx + (tb + t0 + qn) * 256 + h * 32 + 8 * g);
        const f32x4 w0 = *(const f32x4*)(widx + (tb + t0 + qn) * 8), w1 = *(const f32x4*)(widx + (tb + t0 + qn) * 8 + 4);
        const float wq[8] = {w0.x, w0.y, w0.z, w0.w, w1.x, w1.y, w1.z, w1.w};
        for (int i0 = wave; i0 < ntile; i0 += 4 * NWAVES) {
            bf16x8 A[4];
#pragma unroll
            for (int q = 0; q < 4; ++q) { int i = i0 + q * NWAVES; i = i < ntile ? i : ntile - 1; A[q] = *(const bf16x8*)(kidx + (tb + 16 * i + fr) * 32 + 8 * g); }
#pragma unroll
            for (int q = 0; q < 4; ++q) {
                const int i = i0 + q * NWAVES;
                if (i < ntile) {
                    f32x4 sc = (f32x4){0.f, 0.f, 0.f, 0.f};
#pragma unroll
                    for (int h = 0; h < 8; ++h) { const f32x4 d = __builtin_amdgcn_mfma_f32_16x16x32_bf16(A[q], Bq[h], (f32x4){0.f, 0.f, 0.f, 0.f}, 0, 0, 0);
#pragma unroll
                        for (int r = 0; r < 4; ++r) sc[r] = fmaf(wq[h], fmaxf(d[r], 0.f), sc[r]); }
                    if (fr < 8) { const int tq = t0 + fr, s0 = 16 * i + 4 * g;
#pragma unroll
                        for (int r = 0; r < 4; ++r) sc[r] = (s0 + r <= tq) ? sc[r] : -INFINITY;
                        *(LAS f32x4*)(SC + fr * 4096 + s0) = sc; }
                }
            }
        }
        __syncthreads();
        {
            const int tq = t0 + wave; bf16_t* out = idxo + (tb + tq) * 256;
            if (tq < 256) {
#pragma unroll
                for (int jj = 0; jj < 4; ++jj) { const int s = jj * 64 + lane; if (s <= tq) out[s] = (bf16_t)s; }
            } else {
                float v[64];
#pragma unroll
                for (int jj = 0; jj < 64; ++jj) { const int s = jj * 64 + lane; const float x = SC[wave * 4096 + s]; v[jj] = (s <= tq) ? x : -INFINITY; }
                float mx = -INFINITY, mnn = -INFINITY;
#pragma unroll
                for (int jj = 0; jj < 64; ++jj) { mx = fmaxf(mx, v[jj]); mnn = fmaxf(mnn, v[jj] == -INFINITY ? -INFINITY : -v[jj]); }
                mx = wave_max_f(mx); const float lo = -wave_max_f(mnn);
                const float rng = mx - lo; const float inv = rng > 1e-30f ? 65535.9f / rng : 1.f;
                *(LAS u32x4*)(H + 4 * lane) = (u32x4){0u, 0u, 0u, 0u};
#pragma unroll
                for (int jj = 0; jj < 64; ++jj) { const int bn = (int)((v[jj] - lo) * inv); if (bn >= 0) __hip_atomic_fetch_add(H + (bn >> 8), 1u, __ATOMIC_RELAXED, __HIP_MEMORY_SCOPE_WORKGROUP); }
                asm volatile("s_waitcnt lgkmcnt(0)" ::: "memory");
                int chi1, cnt1; const int b1 = hist_find(*(const LAS u32x4*)(H + 4 * lane), 256, lane, chi1, cnt1);
                asm volatile("s_waitcnt lgkmcnt(0)" ::: "memory");
                *(LAS u32x4*)(H + 4 * lane) = (u32x4){0u, 0u, 0u, 0u};
#pragma unroll
                for (int jj = 0; jj < 64; ++jj) { const int bn = (int)((v[jj] - lo) * inv); if ((bn >> 8) == b1) __hip_atomic_fetch_add(H + (bn & 255), 1u, __ATOMIC_RELAXED, __HIP_MEMORY_SCOPE_WORKGROUP); }
                asm volatile("s_waitcnt lgkmcnt(0)" ::: "memory");
                int chi2, cnt2; const int b2 = hist_find(*(const LAS u32x4*)(H + 4 * lane), 256 - chi1, lane, chi2, cnt2);
                const int T16 = b1 * 256 + b2; const int need = 256 - chi1 - chi2;
                const bool allties = (need == cnt2);
                unsigned mlo = 0u, mhi = 0u;
#pragma unroll
                for (int jj = 0; jj < 32; ++jj) { const int bn = (int)((v[jj] - lo) * inv); const bool sel = allties ? (bn >= T16) : (bn > T16); mlo |= sel ? (1u << jj) : 0u; }
#pragma unroll
                for (int jj = 32; jj < 64; ++jj) { const int bn = (int)((v[jj] - lo) * inv); const bool sel = allties ? (bn >= T16) : (bn > T16); mhi |= sel ? (1u << (jj - 32)) : 0u; }
                LAS bf16_t* stage = (LAS bf16_t*)(SC + wave * 4096);
                const int mycnt = __popc(mlo) + __popc(mhi); int base = wave_scan_i(mycnt) - mycnt;
                while (mlo) { const int bpos = __builtin_ctz(mlo); stage[base++] = (bf16_t)(bpos * 64 + lane); mlo &= mlo - 1u; }
                while (mhi) { const int bpos = __builtin_ctz(mhi); stage[base++] = (bf16_t)((bpos + 32) * 64 + lane); mhi &= mhi - 1u; }
                if (!allties) {
                    int eqb = 0; const int pos0 = 256 - need;
#pragma unroll
                    for (int jj = 0; jj < 64; ++jj) {
                        const int bn = (int)((v[jj] - lo) * inv); const bool eq = (bn == T16);
                        const unsigned long long me = __ballot(eq);
                        const int er = eqb + (int)__builtin_amdgcn_mbcnt_hi((unsigned)(me >> 32), __builtin_amdgcn_mbcnt_lo((unsigned)me, 0u));
                        if (eq && er < need) stage[pos0 + er] = (bf16_t)(jj * 64 + lane);
                        eqb += __popcll(me);
                    }
                }
                asm volatile("s_waitcnt lgkmcnt(0)" ::: "memory");
                *(u32x2*)(out + 4 * lane) = *(const LAS u32x2*)(stage + 4 * lane);
            }
        }
        __syncthreads();
    }
}

__device__ __forceinline__ void p4_memattn(const Ctx& C) {
    unsigned char* ws = C.ws; const int lane = C.lane, wave = C.wave, g = lane >> 4, fr = lane & 15;
    const bf16_t* memq = (const bf16_t*)(ws + WS_MEMQ); const bf16_t* kmem = (const bf16_t*)(ws + WS_KMEM); const bf16_t* vmt = (const bf16_t*)(ws + WS_VMEMT);
    bf16_t* ymem = (bf16_t*)(ws + WS_YMEM);
    LAS unsigned char* KL = C.lds; LAS unsigned char* VL = C.lds + 65536;
    for (int su = blockIdx.x; su < 256; su += C.G) {
        const int bh = su >> 4, j = su & 15, b = bh >> 2, h = bh & 3;
        const char* kb = (const char*)(kmem + (size_t)(bh * 256) * 128); const char* vb = (const char*)(vmt + (size_t)(bh * 128) * 256);
#pragma unroll
        for (int pp = 0; pp < 8; ++pp) { const int p = wave + 8 * pp;
            { const int row = 4 * p + g; const int c = fr ^ (2 * (row & 7)); __builtin_amdgcn_global_load_lds((const unsigned*)(kb + row * 256 + 16 * c), (LAS unsigned*)(KL + 1024 * p), 16, 0, 0); }
            { const int row = 2 * p + (lane >> 5); const int c = (lane & 31) ^ (row & 15); __builtin_amdgcn_global_load_lds((const unsigned*)(vb + row * 512 + 16 * c), (LAS unsigned*)(VL + 1024 * p), 16, 0, 0); } }
        asm volatile("s_waitcnt vmcnt(0)" ::: "memory");
        __syncthreads();
#pragma unroll 1
        for (int u = 0; u < 2; ++u) {
            const int t0 = b * SEQ + (2 * j + u) * 128 + wave * 16;
            bf16x8 Bq[4];
#pragma unroll
            for (int kk = 0; kk < 4; ++kk) Bq[kk] = *(const bf16x8*)(memq + (size_t)(t0 + fr) * 512 + h * 128 + 32 * kk + 8 * g);
            f32x4 sc[16];
#pragma unroll
            for (int i = 0; i < 16; ++i) { if ((i & 1) == 0) __builtin_amdgcn_sched_barrier(0); f32x4 a = (f32x4){0.f, 0.f, 0.f, 0.f}; const int row = 16 * i + fr;
#pragma unroll
                for (int kk = 0; kk < 4; ++kk) { const bf16x8 A = *(const LAS bf16x8*)(KL + row * 256 + 16 * ((4 * kk + g) ^ (2 * (row & 7)))); a = __builtin_amdgcn_mfma_f32_16x16x32_bf16(A, Bq[kk], a, 0, 0, 0); }
                sc[i] = a; }
            const float scale = 0.08838834764831845f;
            float mx = -3.0e38f;
#pragma unroll
            for (int i = 0; i < 16; ++i)
#pragma unroll
                for (int r = 0; r < 4; ++r) { sc[i][r] *= scale; mx = fmaxf(mx, sc[i][r]); }
            mx = fmaxf(mx, __shfl_xor(mx, 16)); mx = fmaxf(mx, __shfl_xor(mx, 32));
            float sum = 0.f;
#pragma unroll
            for (int i = 0; i < 16; ++i)
#pragma unroll
                for (int r = 0; r < 4; ++r) { sc[i][r] = __expf(sc[i][r] - mx); sum += sc[i][r]; }
            sum += __shfl_xor(sum, 16); sum += __shfl_xor(sum, 32);
            const float inv = 1.0f / sum;
            bf16x8 Pb[8];
#pragma unroll
            for (int ks = 0; ks < 8; ++ks) { u32x4 w; w.x = pk2(sc[2 * ks][0] * inv, sc[2 * ks][1] * inv); w.y = pk2(sc[2 * ks][2] * inv, sc[2 * ks][3] * inv);
                w.z = pk2(sc[2 * ks + 1][0] * inv, sc[2 * ks + 1][1] * inv); w.w = pk2(sc[2 * ks + 1][2] * inv, sc[2 * ks + 1][3] * inv); Pb[ks] = __builtin_bit_cast(bf16x8, w); }
#pragma unroll
            for (int dt = 0; dt < 8; ++dt) {
                __builtin_amdgcn_sched_barrier(0);
                f32x4 o = (f32x4){0.f, 0.f, 0.f, 0.f}; const int row = 16 * dt + fr;
#pragma unroll
                for (int ks = 0; ks < 8; ++ks) { const int ch = 4 * ks + (g >> 1);
                    const u32x2 lo = *(const LAS u32x2*)(VL + row * 512 + 16 * (ch ^ (row & 15)) + 8 * (g & 1)), hi = *(const LAS u32x2*)(VL + row * 512 + 16 * ((ch + 2) ^ (row & 15)) + 8 * (g & 1));
                    u32x4 w; w.x = lo.x; w.y = lo.y; w.z = hi.x; w.w = hi.y;
                    o = __builtin_amdgcn_mfma_f32_16x16x32_bf16(__builtin_bit_cast(bf16x8, w), Pb[ks], o, 0, 0, 0); }
                u32x2 w; w.x = pk2(o[0], o[1]); w.y = pk2(o[2], o[3]);
                *(u32x2*)(ymem + (size_t)(t0 + fr) * 512 + h * 128 + 16 * dt + 4 * g) = w;
            }
        }
        __syncthreads();
    }
}

constexpr int LDS_RELB = 131072 + 1024;
constexpr int LDS_LUT = LDS_RELB + 1024;
__device__ __forceinline__ void tr_read8(const unsigned (&a)[8], u32x2 (&d)[8]) {
    asm volatile("ds_read_b64_tr_b16 %0, %8\n\tds_read_b64_tr_b16 %1, %9\n\tds_read_b64_tr_b16 %2, %10\n\tds_read_b64_tr_b16 %3, %11\n\t"
                 "ds_read_b64_tr_b16 %4, %12\n\tds_read_b64_tr_b16 %5, %13\n\tds_read_b64_tr_b16 %6, %14\n\tds_read_b64_tr_b16 %7, %15\n\ts_waitcnt lgkmcnt(0)"
                 : "=&v"(d[0]), "=&v"(d[1]), "=&v"(d[2]), "=&v"(d[3]), "=&v"(d[4]), "=&v"(d[5]), "=&v"(d[6]), "=&v"(d[7])
                 : "v"(a[0]), "v"(a[1]), "v"(a[2]), "v"(a[3]), "v"(a[4]), "v"(a[5]), "v"(a[6]), "v"(a[7]) : "memory");
}
__device__ __forceinline__ void p5_dsa_attn(const Ctx& C) {
    unsigned char* ws = C.ws; const int lane = C.lane, wave = C.wave, g = lane >> 4, fr = lane & 15;
    const bf16_t* qlat = (const bf16_t*)(ws + WS_QLAT); const bf16_t* kvl = (const bf16_t*)(ws + WS_KVL); const bf16_t* idxb = (const bf16_t*)(ws + WS_IDX);
    bf16_t* olat = (bf16_t*)(ws + WS_OLAT);
    LAS float* relb = (LAS float*)(C.lds + LDS_RELB); LAS int* lut = (LAS int*)(C.lds + LDS_LUT);
    if (C.tid < 256) relb[C.tid] = C.in[2][C.tid];
    if (C.tid < 128) { const int n = C.tid; int bk = n; if (n >= 16) { bk = 16 + (int)(logf((float)n * (1.0f / 16.0f)) / 2.0794415416798357f * 16.0f); bk = bk > 31 ? 31 : bk; } lut[n] = bk; }
    __syncthreads();
    LAS unsigned char* my = C.lds + wave * 16384; const unsigned mybase = (unsigned)(uintptr_t)my;
    unsigned* qctr = (unsigned*)(ws + WS_CTL) + CW_DSAQ;
    const int qq = fr >> 2, p2 = fr & 3;
    for (;;) {
      int q0 = 0; if (lane == 0) q0 = (int)__hip_atomic_fetch_add(qctr, 4u, __ATOMIC_RELAXED, __HIP_MEMORY_SCOPE_AGENT);
      q0 = __builtin_amdgcn_readfirstlane(q0); if (q0 >= T) break;
      for (int q = q0; q < q0 + 4; ++q) {
        const int b = q >> 12, s = q & (SEQ - 1); const int nvalid = s + 1 < 256 ? s + 1 : 256;
        const char* kvb = (const char*)(kvl + (size_t)b * SEQ * 128);
        int ixr[4];
#pragma unroll
        for (int j = 0; j < 4; ++j) { const int slot = 64 * j + lane; ixr[j] = slot < nvalid ? (int)idxb[(size_t)q * 256 + slot] : 0; }
        bf16x8 Bq[4];
#pragma unroll
        for (int kk = 0; kk < 4; ++kk) Bq[kk] = *(const bf16x8*)(qlat + (size_t)q * 1024 + (fr & 7) * 128 + 32 * kk + 8 * g);
        float m_run = -INFINITY, l_run = 0.f;
        f32x4 O[8];
#pragma unroll
        for (int cc = 0; cc < 8; ++cc) O[cc] = (f32x4){0.f, 0.f, 0.f, 0.f};
        const int nsub = (nvalid + 31) >> 5;
        asm volatile("s_waitcnt vmcnt(0)" ::: "memory");
#pragma unroll
        for (int p = 0; p < 8; ++p) { const int rrow = 4 * p + g; const int srow = __shfl(ixr[0], rrow); const int c = fr ^ (2 * (rrow & 7));
            __builtin_amdgcn_global_load_lds((const unsigned*)(kvb + (size_t)srow * 256 + 16 * c), (LAS unsigned*)(my + 1024 * p), 16, 0, 0); }
#pragma unroll
        for (int sc_ = 0; sc_ < 8; ++sc_) {
          if (sc_ < nsub) {
            LAS unsigned char* cur = my + (sc_ & 1) * 8192; const unsigned curb = mybase + (sc_ & 1) * 8192;
            if (sc_ + 1 < nsub) {
                LAS unsigned char* nb = my + ((sc_ + 1) & 1) * 8192;
#pragma unroll
                for (int p = 0; p < 8; ++p) { const int rrow = 4 * p + g; const int srow = __shfl(ixr[(sc_ + 1) >> 1], 32 * ((sc_ + 1) & 1) + rrow); const int c = fr ^ (2 * (rrow & 7));
                    __builtin_amdgcn_global_load_lds((const unsigned*)(kvb + (size_t)srow * 256 + 16 * c), (LAS unsigned*)(nb + 1024 * p), 16, 0, 0); }
                asm volatile("s_waitcnt vmcnt(8)" ::: "memory");
            } else asm volatile("s_waitcnt vmcnt(0)" ::: "memory");
            f32x4 sc[2];
#pragma unroll
            for (int i = 0; i < 2; ++i) { sc[i] = (f32x4){0.f, 0.f, 0.f, 0.f};
#pragma unroll
                for (int kk = 0; kk < 4; ++kk) { const int row = 16 * i + fr; const int sl = (4 * kk + g) ^ (2 * (row & 7));
                    const bf16x8 A = *(const LAS bf16x8*)(cur + row * 256 + 16 * sl);
                    sc[i] = __builtin_amdgcn_mfma_f32_16x16x32_bf16(A, Bq[kk], sc[i], 0, 0, 0); } }
            float mx = -INFINITY;
#pragma unroll
            for (int i = 0; i < 2; ++i)
#pragma unroll
                for (int r = 0; r < 4; ++r) { const int ks = 16 * i + 4 * g + r; const int kpos = __shfl(ixr[sc_ >> 1], 32 * (sc_ & 1) + ks); const int dist = s - kpos;
                    const int bk = dist >= 128 ? 31 : lut[dist < 0 ? 0 : dist]; const float bias = relb[bk * 8 + (fr & 7)];
                    const bool valid = sc_ * 32 + ks < nvalid; const float v = valid ? sc[i][r] + bias : -INFINITY; sc[i][r] = v; mx = fmaxf(mx, v); }
            mx = fmaxf(mx, __shfl_xor(mx, 16)); mx = fmaxf(mx, __shfl_xor(mx, 32));
            const float m_new = fmaxf(m_run, mx); const float alpha = __expf(m_run - m_new);
            float ps = 0.f;
#pragma unroll
            for (int i = 0; i < 2; ++i)
#pragma unroll
                for (int r = 0; r < 4; ++r) { sc[i][r] = __expf(sc[i][r] - m_new); ps += sc[i][r]; }
            ps += __shfl_xor(ps, 16); ps += __shfl_xor(ps, 32);
            l_run = l_run * alpha + ps; m_run = m_new;
            float ar[4];
#pragma unroll
            for (int r = 0; r < 4; ++r) ar[r] = __shfl(alpha, 4 * g + r);
#pragma unroll
            for (int cc = 0; cc < 8; ++cc)
#pragma unroll
                for (int r = 0; r < 4; ++r) O[cc][r] *= ar[r];
            u32x4 w; w.x = pk2(sc[0][0], sc[0][1]); w.y = pk2(sc[0][2], sc[0][3]); w.z = pk2(sc[1][0], sc[1][1]); w.w = pk2(sc[1][2], sc[1][3]);
            const bf16x8 Pa = __builtin_bit_cast(bf16x8, w);
            const int R0 = 4 * g + qq, R1 = R0 + 16;
#pragma unroll
            for (int hf = 0; hf < 2; ++hf) {
                unsigned ad[8]; u32x2 dd[8];
#pragma unroll
                for (int c4 = 0; c4 < 4; ++c4) { const int chk = 2 * (4 * hf + c4) + (p2 >> 1);
                    ad[2 * c4] = curb + R0 * 256 + 16 * (chk ^ (2 * (R0 & 7))) + 8 * (p2 & 1); ad[2 * c4 + 1] = curb + R1 * 256 + 16 * (chk ^ (2 * (R1 & 7))) + 8 * (p2 & 1); }
                tr_read8(ad, dd);
#pragma unroll
                for (int c4 = 0; c4 < 4; ++c4) { u32x4 bw; bw.x = dd[2 * c4].x; bw.y = dd[2 * c4].y; bw.z = dd[2 * c4 + 1].x; bw.w = dd[2 * c4 + 1].y;
                    O[4 * hf + c4] = __builtin_amdgcn_mfma_f32_16x16x32_bf16(Pa, __builtin_bit_cast(bf16x8, bw), O[4 * hf + c4], 0, 0, 0); }
            }
            asm volatile("" ::: "memory");
          }
        }
        const float inv = 1.0f / l_run; float ir[4];
#pragma unroll
        for (int r = 0; r < 4; ++r) ir[r] = __shfl(inv, 4 * g + r);
        if (g < 2) {
#pragma unroll
            for (int cc = 0; cc < 8; ++cc)
#pragma unroll
                for (int r = 0; r < 4; ++r) olat[(size_t)q * 1024 + (4 * g + r) * 128 + 16 * cc + fr] = (bf16_t)f2bf(O[cc][r] * ir[r]);
        }
      }
    }
}

constexpr int RWM_LDS = 13824;
__device__ __forceinline__ bf16x8 frag_pack(f32x4 lo, f32x4 hi) { u32x4 w; w.x = pk2(lo.x, lo.y); w.y = pk2(lo.z, lo.w); w.z = pk2(hi.x, hi.y); w.w = pk2(hi.z, hi.w); return __builtin_bit_cast(bf16x8, w); }
__device__ __forceinline__ bf16x8 frag_pack_lo(f32x4 lo) { u32x4 w; w.x = pk2(lo.x, lo.y); w.y = pk2(lo.z, lo.w); w.z = 0u; w.w = 0u; return __builtin_bit_cast(bf16x8, w); }
template <int MODE> __device__ __forceinline__ void rwm_task(const Ctx& C, int bh, int ch) {
    unsigned char* ws = C.ws; const int lane = C.lane, g = lane >> 4, fr = lane & 15; const int b = bh >> 3, h = bh & 7;
    const bf16_t* pr = (const bf16_t*)(ws + WS_RW_R); const bf16_t* pk = (const bf16_t*)(ws + WS_RW_K); const bf16_t* pv = (const bf16_t*)(ws + WS_RW_V);
    const bf16_t* pa = (const bf16_t*)(ws + WS_RW_A); const bf16_t* pe = (const bf16_t*)(ws + WS_RW_E); const bf16_t* pg = (const bf16_t*)(ws + WS_RW_G);
    bf16_t* yo = (bf16_t*)(ws + WS_YRWKV);
    float* PQ = (float*)(C.dout + DO_PQ);
    LAS unsigned char* my = C.lds + C.wave * RWM_LDS; const unsigned myb = (unsigned)(uintptr_t)my;
    LAS unsigned char* SI = my; LAS unsigned char* BI = my + 9216; LAS unsigned char* KI = my + 11264; LAS float* CL = (LAS float*)(my + 13312);
    const size_t tok0 = (size_t)b * SEQ + (size_t)ch * RL;
    const f32x4 Z4 = (f32x4){0.f, 0.f, 0.f, 0.f};
    f32x4 S[4][4];
#pragma unroll
    for (int vt = 0; vt < 4; ++vt)
#pragma unroll
        for (int kt = 0; kt < 4; ++kt) {
            if (MODE == 1) { f32x4 x;
#pragma unroll
                for (int r = 0; r < 4; ++r) x[r] = (16 * vt + 4 * g + r == 16 * kt + fr) ? 1.f : 0.f;
                S[vt][kt] = x; }
            else if (MODE == 2 && ch > 0) { const float* src = PQ + ((size_t)((bh * RCH + ch - 1) * 2)) * 4096; f32x4 x;
#pragma unroll
                for (int r = 0; r < 4; ++r) x[r] = src[(16 * vt + 4 * g + r) * 64 + 16 * kt + fr];
                S[vt][kt] = x; }
            else S[vt][kt] = Z4; }
    float lng[4], lnb[4];
#pragma unroll
    for (int vt = 0; vt < 4; ++vt) { lng[vt] = MODE == 2 ? C.in[19][h * 64 + 16 * vt + fr] : 0.f; lnb[vt] = MODE == 2 ? C.in[20][h * 64 + 16 * vt + fr] : 0.f; }
    const bool strict[4] = {4 * g + 0 < fr, 4 * g + 1 < fr, 4 * g + 2 < fr, 4 * g + 3 < fr};
    const bool incl[4] = {4 * g + 0 <= fr, 4 * g + 1 <= fr, 4 * g + 2 <= fr, 4 * g + 3 <= fr};
    const int qq = fr >> 2, p2 = fr & 3;
#pragma unroll 1
    for (int sub = 0; sub < RL / 16; ++sub) {
        const size_t t0 = tok0 + (size_t)sub * 16; const size_t rowoff = (t0 + fr) * 512 + h * 64;
#pragma unroll
        for (int vt = 0; vt < 4; ++vt)
#pragma unroll
            for (int kt = 0; kt < 4; ++kt)
#pragma unroll
                for (int r = 0; r < 4; ++r) *(LAS bf16_t*)(SI + (4 * g) * 144 + 2 * fr + (16 * vt + r) * 144 + 32 * kt) = (bf16_t)f2bf(S[vt][kt][r]);
        bf16x8 kap[2], rtl[2]; float bcoef = 0.f;
        {
            float ssq = 0.f, bsum = 0.f; float kr[16];
#pragma unroll
            for (int k2 = 0; k2 < 2; ++k2) { const int c0 = 32 * k2 + 8 * g; float kv[8]; unpack8(*(const u32x4*)(pk + rowoff + c0), kv);
                const f32x4 kk0 = *(const f32x4*)(C.in[16] + h * 64 + c0), kk1 = *(const f32x4*)(C.in[16] + h * 64 + c0 + 4); const float kkc[8] = {kk0.x, kk0.y, kk0.z, kk0.w, kk1.x, kk1.y, kk1.z, kk1.w};
#pragma unroll
                for (int j = 0; j < 8; ++j) { kr[8 * k2 + j] = kv[j] * kkc[j]; ssq += kr[8 * k2 + j] * kr[8 * k2 + j]; } }
            ssq += __shfl_xor(ssq, 16); ssq += __shfl_xor(ssq, 32);
            const float rn = __builtin_amdgcn_rsqf(fmaxf(ssq, 1e-24f));
#pragma unroll
            for (int k2 = 0; k2 < 2; ++k2) { const int c0 = 32 * k2 + 8 * g; float ev[8], kv[8], aa[8], rv[8];
                __builtin_amdgcn_sched_barrier(0);
                unpack8(*(const u32x4*)(pe + rowoff + c0), ev); unpack8(*(const u32x4*)(pk + rowoff + c0), kv); unpack8(*(const u32x4*)(pa + rowoff + c0), aa);
                if (MODE == 2) unpack8(*(const u32x4*)(pr + rowoff + c0), rv);
                const f32x4 ka0 = *(const f32x4*)(C.in[17] + h * 64 + c0), ka1 = *(const f32x4*)(C.in[17] + h * 64 + c0 + 4); const float kac[8] = {ka0.x, ka0.y, ka0.z, ka0.w, ka1.x, ka1.y, ka1.z, ka1.w};
                float rkc[8];
                if (MODE == 2) { const f32x4 r0 = *(const f32x4*)(C.in[18] + h * 64 + c0), r1 = *(const f32x4*)(C.in[18] + h * 64 + c0 + 4); rkc[0] = r0.x; rkc[1] = r0.y; rkc[2] = r0.z; rkc[3] = r0.w; rkc[4] = r1.x; rkc[5] = r1.y; rkc[6] = r1.z; rkc[7] = r1.w; }
                float kt_[8], bt_[8], kxt_[8], rt_[8];
#pragma unroll
                for (int j = 0; j < 8; ++j) {
                    float c = ev[j]; c += dpp_f<0x111>(c); c += dpp_f<0x112>(c); c += dpp_f<0x114>(c); c += dpp_f<0x118>(c);
                    const float kx = kv[j] * (1.0f + (aa[j] - 1.0f) * kac[j]); const float kk = kr[8 * k2 + j] * rn;
                    const float e2 = __expf(c), e3 = __builtin_amdgcn_rcpf(e2), e1 = e3 * __expf(ev[j]);
                    kt_[j] = kk * e1; bt_[j] = kk * aa[j] * e2; kxt_[j] = kx * e2;
                    if (MODE == 2) { rt_[j] = rv[j] * e3; bsum += rv[j] * kx * rkc[j]; } else rt_[j] = 0.f;
                    if (fr == 15) CL[c0 + j] = c;
                }
                kap[k2] = __builtin_bit_cast(bf16x8, pack8(kt_)); if (MODE == 2) rtl[k2] = __builtin_bit_cast(bf16x8, pack8(rt_));
                *(LAS u32x4*)(BI + fr * 128 + 64 * k2 + 16 * g) = pack8(bt_); *(LAS u32x4*)(KI + fr * 128 + 64 * k2 + 16 * g) = pack8(kxt_);
            }
            if (MODE == 2) { bsum += __shfl_xor(bsum, 16); bsum += __shfl_xor(bsum, 32); bcoef = bsum; }
        }
        bf16x8 bet[2], kxf[2];
#pragma unroll
        for (int k2 = 0; k2 < 2; ++k2) { bet[k2] = *(const LAS bf16x8*)(BI + fr * 128 + 64 * k2 + 16 * g); kxf[k2] = *(const LAS bf16x8*)(KI + fr * 128 + 64 * k2 + 16 * g); }
        f32x4 VT[4];
#pragma unroll
        for (int vt = 0; vt < 4; ++vt) { f32x4 x = Z4;
            if (MODE != 1) {
#pragma unroll
                for (int jj = 0; jj < 4; ++jj) x[jj] = bf1(pv[(t0 + 4 * g + jj) * 512 + h * 64 + 16 * vt + fr]); }
            VT[vt] = x; }
        f32x4 AT = Z4, BmT = Z4, C1T = Z4, C2T = Z4;
#pragma unroll
        for (int k2 = 0; k2 < 2; ++k2) { AT = __builtin_amdgcn_mfma_f32_16x16x32_bf16(bet[k2], kap[k2], AT, 0, 0, 0);
            if (MODE != 1) BmT = __builtin_amdgcn_mfma_f32_16x16x32_bf16(kxf[k2], kap[k2], BmT, 0, 0, 0);
            if (MODE == 2) { C1T = __builtin_amdgcn_mfma_f32_16x16x32_bf16(bet[k2], rtl[k2], C1T, 0, 0, 0); C2T = __builtin_amdgcn_mfma_f32_16x16x32_bf16(kxf[k2], rtl[k2], C2T, 0, 0, 0); } }
#pragma unroll
        for (int r = 0; r < 4; ++r) { AT[r] = strict[r] ? AT[r] : 0.f; BmT[r] = strict[r] ? BmT[r] : 0.f; C1T[r] = incl[r] ? C1T[r] : 0.f; C2T[r] = incl[r] ? C2T[r] : 0.f; }
        float tr[16];
#pragma unroll
        for (int c = 15; c >= 0; --c) { float s = (c == fr) ? 1.f : 0.f;
#pragma unroll
            for (int j = c + 1; j < 16; ++j) { const float ajc = __builtin_bit_cast(float, __builtin_amdgcn_readlane(__builtin_bit_cast(int, AT[c & 3]), j + 16 * (c >> 2))); s = fmaf(-tr[j], ajc, s); }
            tr[c] = s; }
        f32x4 Tq;
#pragma unroll
        for (int jj = 0; jj < 4; ++jj) Tq[jj] = g == 0 ? tr[jj] : (g == 1 ? tr[4 + jj] : (g == 2 ? tr[8 + jj] : tr[12 + jj]));
        const bf16x8 Tf = frag_pack_lo(Tq), Bmf = frag_pack_lo(BmT), Cf = frag_pack(C1T, C2T);
        f32x4 Zt[4], Yt[4];
#pragma unroll
        for (int vt = 0; vt < 4; ++vt) {
            const int v = 16 * vt + fr;
            const bf16x8 s0 = *(const LAS bf16x8*)(SI + v * 144 + 16 * g), s1 = *(const LAS bf16x8*)(SI + v * 144 + 64 + 16 * g);
            f32x4 rhs = __builtin_amdgcn_mfma_f32_16x16x32_bf16(kap[0], s0, Z4, 0, 0, 0); rhs = __builtin_amdgcn_mfma_f32_16x16x32_bf16(kap[1], s1, rhs, 0, 0, 0);
            if (MODE != 1) rhs = __builtin_amdgcn_mfma_f32_16x16x32_bf16(Bmf, frag_pack_lo(VT[vt]), rhs, 0, 0, 0);
            f32x4 z = __builtin_amdgcn_mfma_f32_16x16x32_bf16(Tf, frag_pack_lo(rhs), Z4, 0, 0, 0);
            Zt[vt] = -z;
            if (MODE == 2) { f32x4 y = __builtin_amdgcn_mfma_f32_16x16x32_bf16(rtl[0], s0, Z4, 0, 0, 0); y = __builtin_amdgcn_mfma_f32_16x16x32_bf16(rtl[1], s1, y, 0, 0, 0);
                Yt[vt] = __builtin_amdgcn_mfma_f32_16x16x32_bf16(Cf, frag_pack(Zt[vt], VT[vt]), y, 0, 0, 0); }
        }
        {
            unsigned ad[8]; u32x2 dd[8];
#pragma unroll
            for (int kt = 0; kt < 4; ++kt) { const unsigned o = (unsigned)((4 * g + qq) * 128 + 2 * (16 * kt + 4 * p2)); ad[2 * kt] = myb + 9216 + o; ad[2 * kt + 1] = myb + 11264 + o; }
            tr_read8(ad, dd);
            float gl[4];
#pragma unroll
            for (int kt = 0; kt < 4; ++kt) gl[kt] = __expf(-CL[16 * kt + fr]);
#pragma unroll
            for (int vt = 0; vt < 4; ++vt) { const bf16x8 Af = frag_pack(Zt[vt], VT[vt]);
#pragma unroll
                for (int kt = 0; kt < 4; ++kt) { u32x4 bw; bw.x = dd[2 * kt].x; bw.y = dd[2 * kt].y; bw.z = dd[2 * kt + 1].x; bw.w = dd[2 * kt + 1].y;
                    S[vt][kt] = __builtin_amdgcn_mfma_f32_16x16x32_bf16(Af, __builtin_bit_cast(bf16x8, bw), S[vt][kt], 0, 0, 0) * gl[kt]; } }
        }
        if (MODE == 2) {
#pragma unroll
            for (int r = 0; r < 4; ++r) {
                const float mean = row_sum_f(Yt[0][r] + Yt[1][r] + Yt[2][r] + Yt[3][r]) * (1.0f / 64.0f);
                const float d0 = Yt[0][r] - mean, d1 = Yt[1][r] - mean, d2 = Yt[2][r] - mean, d3 = Yt[3][r] - mean;
                const float rstd = rsqrtf(row_sum_f(d0 * d0 + d1 * d1 + d2 * d2 + d3 * d3) * (1.0f / 64.0f) + 64e-5f);
                const float bc = __shfl(bcoef, 4 * g + r); const float dd_[4] = {d0, d1, d2, d3}; const size_t ro = (t0 + 4 * g + r) * 512 + h * 64 + fr;
#pragma unroll
                for (int vt = 0; vt < 4; ++vt) { const float gate = bf1(pg[ro + 16 * vt]); yo[ro + 16 * vt] = (bf16_t)f2bf((dd_[vt] * rstd * lng[vt] + lnb[vt] + bc * VT[vt][r]) * gate); }
            }
        }
    }
    if (MODE != 2) { float* dst = PQ + ((size_t)((bh * RCH + ch) * 2 + MODE)) * 4096;
#pragma unroll
        for (int vt = 0; vt < 4; ++vt)
#pragma unroll
            for (int kt = 0; kt < 4; ++kt)
#pragma unroll
                for (int r = 0; r < 4; ++r) dst[(16 * vt + 4 * g + r) * 64 + 16 * kt + fr] = S[vt][kt][r]; }
}
__device__ __forceinline__ void p4_rwkv_pass1(const Ctx& C) {
    for (int task = C.gw; task < 32 * (RCH - 1) * 2; task += C.ngw) { const int mode = task & 1, rr = task >> 1, ch = rr % (RCH - 1), bh = rr / (RCH - 1);
        if (mode == 0) rwm_task<0>(C, bh, ch); else rwm_task<1>(C, bh, ch); }
}
__device__ __forceinline__ void p6_rwkv_pass3(const Ctx& C) {
    for (int task = C.gw; task < 32 * RCH; task += C.ngw) rwm_task<2>(C, task / RCH, task % RCH);
}
__device__ __forceinline__ void p5_rwkv_carry(const Ctx& C) {
    float* PQ = (float*)(C.dout + DO_PQ); const int lane = C.lane, wave = C.wave, tid = C.tid;
    LAS float* ST = (LAS float*)C.lds;
    LAS float* PL = (LAS float*)(C.lds + 32768);
    for (int bh = blockIdx.x; bh < 32; bh += C.G) {
        for (int i = tid; i < 4096; i += NTHREADS) ST[i] = 0.f;
        const float* base = PQ + (size_t)(bh * RCH) * 2 * 4096;
        f32x4 pa = *(const f32x4*)(base + 4096 + tid * 8), pb = *(const f32x4*)(base + 4096 + tid * 8 + 4);
        f32x4 q0 = *(const f32x4*)(base + lane * 64 + 8 * wave), q1 = *(const f32x4*)(base + lane * 64 + 8 * wave + 4);
        __syncthreads();
        for (int ch = 0; ch < RCH - 1; ++ch) {
            LAS float* cur = ST + (ch & 1) * 4096; LAS float* nxt = ST + ((ch + 1) & 1) * 4096;
            float* Q = PQ + ((size_t)((bh * RCH + ch) * 2)) * 4096;
            *(LAS f32x4*)(PL + tid * 8) = pa; *(LAS f32x4*)(PL + tid * 8 + 4) = pb;
            float acc[8] = {q0.x, q0.y, q0.z, q0.w, q1.x, q1.y, q1.z, q1.w};
            __syncthreads();
            const int cn = ch + 1 < RCH - 1 ? ch + 1 : ch; const float* nb = PQ + ((size_t)((bh * RCH + cn) * 2)) * 4096;
            pa = *(const f32x4*)(nb + 4096 + tid * 8); pb = *(const f32x4*)(nb + 4096 + tid * 8 + 4);
            q0 = *(const f32x4*)(nb + lane * 64 + 8 * wave); q1 = *(const f32x4*)(nb + lane * 64 + 8 * wave + 4);
#pragma unroll 8
            for (int j = 0; j < 64; ++j) { const float sj = cur[j * 64 + lane]; const f32x4 p0 = *(const LAS f32x4*)(PL + j * 64 + 8 * wave), p1 = *(const LAS f32x4*)(PL + j * 64 + 8 * wave + 4);
                acc[0] = fmaf(sj, p0.x, acc[0]); acc[1] = fmaf(sj, p0.y, acc[1]); acc[2] = fmaf(sj, p0.z, acc[2]); acc[3] = fmaf(sj, p0.w, acc[3]);
                acc[4] = fmaf(sj, p1.x, acc[4]); acc[5] = fmaf(sj, p1.y, acc[5]); acc[6] = fmaf(sj, p1.z, acc[6]); acc[7] = fmaf(sj, p1.w, acc[7]); }
            *(f32x4*)(Q + lane * 64 + 8 * wave) = (f32x4){acc[0], acc[1], acc[2], acc[3]}; *(f32x4*)(Q + lane * 64 + 8 * wave + 4) = (f32x4){acc[4], acc[5], acc[6], acc[7]};
#pragma unroll
            for (int kk = 0; kk < 8; ++kk) nxt[(8 * wave + kk) * 64 + lane] = acc[kk];
            __syncthreads();
        }
    }
}

__device__ __forceinline__ void p8_ln1(const Ctx& C) {
    const float* pre = (const float*)C.dout; float* x1 = (float*)(C.ws + WS_X1); bf16_t* x1b = (bf16_t*)(C.ws + WS_X1B); const int lane = C.lane;
    const float* gam = C.in[26]; const float* bet = C.in[27];
    for (int t = C.gw; t < T; t += C.ngw) {
        const float* p = pre + (size_t)t * 1024; float v[16];
#pragma unroll
        for (int hh = 0; hh < 2; ++hh) { const f32x4 a = *(const f32x4*)(p + hh * 512 + 8 * lane), b = *(const f32x4*)(p + hh * 512 + 8 * lane + 4);
            v[8 * hh] = a.x; v[8 * hh + 1] = a.y; v[8 * hh + 2] = a.z; v[8 * hh + 3] = a.w; v[8 * hh + 4] = b.x; v[8 * hh + 5] = b.y; v[8 * hh + 6] = b.z; v[8 * hh + 7] = b.w; }
        float s = 0.f;
#pragma unroll
        for (int j = 0; j < 16; ++j) s += v[j];
        const float mean = wave_sum(s) * (1.0f / 1024.0f); float s2 = 0.f;
#pragma unroll
        for (int j = 0; j < 16; ++j) { v[j] -= mean; s2 += v[j] * v[j]; }
        const float rstd = rsqrtf(wave_sum(s2) * (1.0f / 1024.0f) + 1e-5f);
#pragma unroll
        for (int hh = 0; hh < 2; ++hh) { const int c0 = hh * 512 + 8 * lane; float o[8];
#pragma unroll
            for (int j = 0; j < 8; ++j) o[j] = v[8 * hh + j] * rstd * gam[c0 + j] + bet[c0 + j];
            *(f32x4*)(x1 + (size_t)t * 1024 + c0) = (f32x4){o[0], o[1], o[2], o[3]}; *(f32x4*)(x1 + (size_t)t * 1024 + c0 + 4) = (f32x4){o[4], o[5], o[6], o[7]};
            *(u32x4*)(x1b + (size_t)t * 1024 + c0) = pack8(o); }
    }
    cvt_rows_fp8(C.in[30], C.ws + WS_UB, (size_t)16384 * 1024 / 16, PEER_U_SCALE, C.gt, C.ngt);
    cvt_rows_fp8(C.in[31], C.ws + WS_VB, (size_t)16384 * 1024 / 16, PEER_V_SCALE, C.gt, C.ngt);
}

#define CE_DESC(a, b) do { const unsigned hi_ = k[a] > k[b] ? k[a] : k[b], lo_ = k[a] > k[b] ? k[b] : k[a]; k[a] = hi_; k[b] = lo_; } while (0)
__device__ __forceinline__ unsigned pop16_of8(unsigned (&k)[8], int fr) {
    CE_DESC(0, 1); CE_DESC(2, 3); CE_DESC(4, 5); CE_DESC(6, 7); CE_DESC(0, 2); CE_DESC(1, 3); CE_DESC(4, 6); CE_DESC(5, 7); CE_DESC(1, 2); CE_DESC(5, 6);
    CE_DESC(0, 4); CE_DESC(1, 5); CE_DESC(2, 6); CE_DESC(3, 7); CE_DESC(2, 4); CE_DESC(3, 5); CE_DESC(1, 2); CE_DESC(3, 4); CE_DESC(5, 6);
    unsigned res = 0u;
#pragma unroll
    for (int rd = 0; rd < 16; ++rd) {
        const unsigned m = row_max_u(k[0]); const bool mine = (k[0] == m);
#pragma unroll
        for (int j = 0; j < 7; ++j) k[j] = mine ? k[j + 1] : k[j];
        k[7] = mine ? 0u : k[7];
        res = (fr == rd) ? m : res;
    }
    return res;
}
__device__ __forceinline__ unsigned pop16_of4(unsigned (&k)[4], int fr) {
    CE_DESC(0, 1); CE_DESC(2, 3); CE_DESC(0, 2); CE_DESC(1, 3); CE_DESC(1, 2);
    unsigned res = 0u;
#pragma unroll
    for (int rd = 0; rd < 16; ++rd) {
        const unsigned m = row_max_u(k[0]); const bool mine = (k[0] == m);
        k[0] = mine ? k[1] : k[0]; k[1] = mine ? k[2] : k[1]; k[2] = mine ? k[3] : k[2]; k[3] = mine ? 0u : k[3];
        res = (fr == rd) ? m : res;
    }
    return res;
}
__device__ const unsigned char CAND_AB[64] = {
    0x00, 0x01, 0x02, 0x03, 0x04, 0x05, 0x06, 0x07, 0x08, 0x09, 0x0a, 0x0b, 0x0c, 0x0d, 0x0e, 0x0f,
    0x10, 0x11, 0x12, 0x13, 0x14, 0x15, 0x16, 0x17, 0x20, 0x21, 0x22, 0x23, 0x24, 0x30, 0x31, 0x32,
    0x33, 0x40, 0x41, 0x42, 0x50, 0x51, 0x60, 0x61, 0x70, 0x71, 0x80, 0x90, 0xa0, 0xb0, 0xc0, 0xd0,
    0xe0, 0xf0, 0xff, 0xff, 0xff, 0xff, 0xff, 0xff, 0xff, 0xff, 0xff, 0xff, 0xff, 0xff, 0xff, 0xff};
__device__ __forceinline__ void p10_peer_route(const Ctx& C) {
    unsigned char* ws = C.ws; const int lane = C.lane, g = lane >> 4, fr = lane & 15;
    const bf16_t* qp = (const bf16_t*)C.dout; const bf16_t* keys = (const bf16_t*)(ws + WS_KEYS);
    int* experts = (int*)(ws + WS_EXPERTS); float* pgates = (float*)(ws + WS_PGATES);
    const unsigned cand4 = *(const unsigned*)(CAND_AB + 4 * fr);
    for (int task = C.gw; task < T / 2; task += C.ngw) {
        const int t0 = task * 2;
        unsigned sel[2][4];
#pragma unroll
        for (int p = 0; p < 2; ++p) {
            bf16x8 A[4];
#pragma unroll
            for (int kk = 0; kk < 4; ++kk) A[kk] = *(const bf16x8*)(qp + (size_t)(t0 + (fr >> 3)) * 2048 + (fr & 7) * 256 + p * 128 + 32 * kk + 8 * g);
            f32x4 acc[8];
#pragma unroll
            for (int i = 0; i < 8; ++i) { if ((i & 1) == 0) __builtin_amdgcn_sched_barrier(0); acc[i] = (f32x4){0.f, 0.f, 0.f, 0.f};
#pragma unroll
                for (int kk = 0; kk < 4; ++kk) { const bf16x8 Bk = *(const bf16x8*)(keys + (size_t)(p * 128 + 16 * i + fr) * 128 + 32 * kk + 8 * g);
                    acc[i] = __builtin_amdgcn_mfma_f32_16x16x32_bf16(A[kk], Bk, acc[i], 0, 0, 0); } }
#pragma unroll
            for (int r = 0; r < 4; ++r) { __builtin_amdgcn_sched_barrier(0); unsigned k[8];
#pragma unroll
                for (int i = 0; i < 8; ++i) k[i] = (f2key(acc[i][r]) & 0xffffff80u) | (unsigned)(16 * i + fr);
                sel[p][r] = pop16_of8(k, fr); }
        }
#pragma unroll
        for (int r = 0; r < 4; ++r) {
            __builtin_amdgcn_sched_barrier(0);
            const float s1 = key2f(sel[0][r] & 0xffffff80u), s2 = key2f(sel[1][r] & 0xffffff80u);
            unsigned k[4];
#pragma unroll
            for (int j = 0; j < 4; ++j) {
                const unsigned ab = (cand4 >> (8 * j)) & 0xffu; const unsigned msk = ab == 0xffu ? 0u : 0xffffffffu;
                const float va = __builtin_bit_cast(float, __builtin_amdgcn_ds_bpermute((int)(4u * (16u * g + (ab >> 4))), __builtin_bit_cast(int, s1)));
                const float vb = __builtin_bit_cast(float, __builtin_amdgcn_ds_bpermute((int)(4u * (16u * g + (ab & 15u))), __builtin_bit_cast(int, s2)));
                k[j] = ((f2key(va + vb) & 0xffffff00u) | ab) & msk;
            }
            const unsigned top = pop16_of4(k, fr);
            const int a = (int)((top >> 4) & 15u), b = (int)(top & 15u);
            const int i1 = __builtin_amdgcn_ds_bpermute(4 * (16 * g + a), (int)(sel[0][r] & 0x7fu));
            const int i2 = __builtin_amdgcn_ds_bpermute(4 * (16 * g + b), (int)(sel[1][r] & 0x7fu));
            const float sc = key2f(top & 0xffffff00u);
            const float mx = key2f(row_max_u(top) & 0xffffff00u);
            const float ev = __expf(sc - mx); const float sm = row_sum_f(ev);
            const int row = 4 * g + r; const size_t o = (size_t)(t0 + (row >> 3)) * 128 + (row & 7) * 16 + fr;
            experts[o] = i1 * 128 + i2; pgates[o] = ev / sm;
        }
    }
}
#undef CE_DESC

__device__ __forceinline__ float gelu_erf(float x) { return 0.5f * x * (1.0f + erff(x * 0.7071067811865476f)); }
typedef __bf16 bf2_t __attribute__((ext_vector_type(2)));
__device__ __forceinline__ unsigned fp8x2_to_bf16x2(unsigned w, bool hi) { return hi ? __builtin_bit_cast(unsigned, __builtin_amdgcn_cvt_scalef32_pk_bf16_fp8(w, 1.0f, true)) : __builtin_bit_cast(unsigned, __builtin_amdgcn_cvt_scalef32_pk_bf16_fp8(w, 1.0f, false)); }
__device__ __forceinline__ void p11_peer_experts(const Ctx& C) {
    unsigned char* ws = C.ws; const int lane = C.lane, g = lane >> 4, fr = lane & 15;
    const bf16_t* x1b = (const bf16_t*)(ws + WS_X1B); const float* x1 = (const float*)(ws + WS_X1);
    const unsigned char* ub = ws + WS_UB; const unsigned char* vb = ws + WS_VB;
    const int* experts = (const int*)(ws + WS_EXPERTS); const float* pgates = (const float*)(ws + WS_PGATES);
    float* out = (float*)C.dout; const float* gam = C.in[32]; const float* bet = C.in[33];
    LAS unsigned char* my = C.lds + C.wave * 4096;
    LAS float* cf = (LAS float*)(my + 2048); LAS int* eidl = (LAS int*)(my + 2560);
    for (int t = C.gw; t < T; t += C.ngw) {
        { const u32x4 a = *(const u32x4*)(x1b + (size_t)t * 1024 + 16 * lane), b = *(const u32x4*)(x1b + (size_t)t * 1024 + 16 * lane + 8);
          *(LAS u32x4*)(my + 32 * lane) = a; *(LAS u32x4*)(my + 32 * lane + 16) = b; }
        { const int e0 = experts[(size_t)t * 128 + lane], e1 = experts[(size_t)t * 128 + 64 + lane]; eidl[lane] = e0; eidl[64 + lane] = e1; }
        asm volatile("s_waitcnt lgkmcnt(0)" ::: "memory");
#pragma unroll 1
        for (int i = 0; i < 8; ++i) {
            const int e = eidl[16 * i + fr]; const unsigned char* urow = ub + (size_t)e * 1024 + 16 * g;
            f32x4 acc = (f32x4){0.f, 0.f, 0.f, 0.f};
#pragma unroll 8
            for (int m = 0; m < 16; ++m) {
                const u32x4 raw = *(const u32x4*)(urow + 64 * m);
                u32x4 a0, a1; a0.x = fp8x2_to_bf16x2(raw.x, false); a0.y = fp8x2_to_bf16x2(raw.x, true); a0.z = fp8x2_to_bf16x2(raw.y, false); a0.w = fp8x2_to_bf16x2(raw.y, true);
                a1.x = fp8x2_to_bf16x2(raw.z, false); a1.y = fp8x2_to_bf16x2(raw.z, true); a1.z = fp8x2_to_bf16x2(raw.w, false); a1.w = fp8x2_to_bf16x2(raw.w, true);
                const bf16x8 b0 = *(const LAS bf16x8*)(my + 2 * (64 * m + 16 * g)), b1 = *(const LAS bf16x8*)(my + 2 * (64 * m + 16 * g + 8));
                acc = __builtin_amdgcn_mfma_f32_16x16x32_bf16(__builtin_bit_cast(bf16x8, a0), b0, acc, 0, 0, 0);
                acc = __builtin_amdgcn_mfma_f32_16x16x32_bf16(__builtin_bit_cast(bf16x8, a1), b1, acc, 0, 0, 0);
            }
            const f32x4 pg = *(const f32x4*)(pgates + (size_t)t * 128 + 16 * i + 4 * g);
            constexpr float us = 1.0f / PEER_U_SCALE, vs = 1.0f / PEER_V_SCALE;
            if (fr == 0) { *(LAS f32x4*)(cf + 16 * i + 4 * g) = (f32x4){vs * pg.x * gelu_erf(acc[0] * us), vs * pg.y * gelu_erf(acc[1] * us), vs * pg.z * gelu_erf(acc[2] * us), vs * pg.w * gelu_erf(acc[3] * us)}; }
        }
        asm volatile("s_waitcnt lgkmcnt(0)" ::: "memory");
        float o[16];
#pragma unroll
        for (int j = 0; j < 16; ++j) o[j] = 0.f;
#pragma unroll 8
        for (int k = 0; k < 128; ++k) {
            const int e = __builtin_amdgcn_readfirstlane(eidl[k]); const float c = cf[k];
            const u32x4 raw = *(const u32x4*)(vb + (size_t)e * 1024 + 16 * lane);
            const unsigned rw[4] = {raw.x, raw.y, raw.z, raw.w};
#pragma unroll
            for (int j = 0; j < 4; ++j) { const f32x2 lo = __builtin_amdgcn_cvt_pk_f32_fp8((int)rw[j], false), hi = __builtin_amdgcn_cvt_pk_f32_fp8((int)rw[j], true);
                o[4 * j] = fmaf(c, lo.x, o[4 * j]); o[4 * j + 1] = fmaf(c, lo.y, o[4 * j + 1]); o[4 * j + 2] = fmaf(c, hi.x, o[4 * j + 2]); o[4 * j + 3] = fmaf(c, hi.y, o[4 * j + 3]); }
        }
        float s = 0.f; const float* xp = x1 + (size_t)t * 1024 + 16 * lane;
#pragma unroll
        for (int q = 0; q < 4; ++q) { const f32x4 a = *(const f32x4*)(xp + 4 * q); o[4 * q] += ALPHA * a.x; o[4 * q + 1] += ALPHA * a.y; o[4 * q + 2] += ALPHA * a.z; o[4 * q + 3] += ALPHA * a.w; }
#pragma unroll
        for (int j = 0; j < 16; ++j) s += o[j];
        const float mean = wave_sum(s) * (1.0f / 1024.0f); float s2 = 0.f;
#pragma unroll
        for (int j = 0; j < 16; ++j) { o[j] -= mean; s2 += o[j] * o[j]; }
        const float rstd = rsqrtf(wave_sum(s2) * (1.0f / 1024.0f) + 1e-5f);
#pragma unroll
        for (int q = 0; q < 4; ++q) { const int c0 = 16 * lane + 4 * q; const f32x4 gm = *(const f32x4*)(gam + c0), bt = *(const f32x4*)(bet + c0);
            *(f32x4*)(out + (size_t)t * 1024 + c0) = (f32x4){o[4 * q] * rstd * gm.x + bt.x, o[4 * q + 1] * rstd * gm.y + bt.y, o[4 * q + 2] * rstd * gm.z + bt.z, o[4 * q + 3] * rstd * gm.w + bt.w}; }
    }
}

constexpr int LDS_BYTES = 147456;
constexpr int LDS_MISC = 131072;
constexpr int NPHASE = 14;
constexpr int CW_BAR = 4096;

__global__ void __launch_bounds__(NTHREADS, 2) hybrid_fwd(Args args) {
    extern __shared__ __attribute__((aligned(16))) unsigned char lds_raw[];
    Ctx C;
    C.lds = (LAS unsigned char*)lds_raw;
    C.tid = threadIdx.x; C.lane = C.tid & 63; C.wave = __builtin_amdgcn_readfirstlane(C.tid >> 6);
    C.G = gridDim.x; C.gw = blockIdx.x * NWAVES + C.wave; C.ngw = C.G * NWAVES; C.gt = blockIdx.x * NTHREADS + C.tid; C.ngt = C.G * NTHREADS;
    C.in = args.in; C.ws = args.ws; C.dout = (unsigned char*)args.out;
    unsigned char* ws = args.ws; const float* const* in = args.in;
    volatile LAS unsigned* MISC = (volatile LAS unsigned*)(C.lds + LDS_MISC);
    if (C.tid < 64) MISC[C.tid] = 0u;
    __syncthreads();
    XcdBarrier bar; bar.bar = (unsigned*)(ws + WS_CTL) + CW_BAR; bar.x = 0; bar.st = nullptr;
    if (MK_N_LAUNCHES == 1) bar = xcd_barrier_post((unsigned*)(ws + WS_CTL) + CW_BAR, MISC + 8);
    const int lo = args.ph_lo, hi = args.ph_hi;
#define IN(k) (lo <= (k) && (k) < hi)
#define SEAM(k) do { if (IN(k) && IN((k) + 1)) xcd_barrier(bar); } while (0)
#define REP(k) for (int rep_ = 0; rep_ < (((PROBE_MASK >> (k)) & 1) ? 2 : 1); ++rep_)
    bf16_t* xb = (bf16_t*)(C.dout + DO_XB);

    if (IN(0)) REP(0) { p0_prologue(C); } SEAM(0);
    if (IN(1)) REP(1) {
        { pg8::Gemm gm{xb, (const bf16_t*)(ws + WS_WIN), T, 2816, 1024}; pg8::StaticOrder S; S.init(T, 2816, C.G, (int)blockIdx.x);
          EpiP1 E{(float*)(ws + WS_CSMALL), (bf16_t*)(ws + WS_RCOLS), (bf16_t*)(ws + WS_MEMQ)}; pg8::gemm_phase(C.lds, gm, S, E); }
        {
          const int nfull = (T / 256) * 11 % C.G; const int c2 = ((int)blockIdx.x - nfull + C.G) % C.G;
          pg8::Gemm gm{(const bf16_t*)(ws + WS_MEMB), (const bf16_t*)(ws + WS_WMEMKV), 1024, 1024, 1024}; pg8::StaticOrder S; S.init(1024, 1024, C.G, c2);
          EpiMemKV E{(bf16_t*)(ws + WS_KMEM), (bf16_t*)(ws + WS_VMEMT)}; pg8::gemm_phase(C.lds, gm, S, E); }
    } SEAM(1);
    if (IN(2)) REP(2) { p2_prep(C); } SEAM(2);
    if (IN(3)) REP(3) {
        { pg8::Gemm gm{(const bf16_t*)(ws + WS_LORAA), (const bf16_t*)(ws + WS_WLORA), T, 1536, 256}; pg8::StaticOrder S; S.init(T, 1536, C.G, (int)blockIdx.x);
          EpiLora E{(bf16_t*)(ws + WS_RW_E), (bf16_t*)(ws + WS_RW_A), (bf16_t*)(ws + WS_RW_G), in[11], in[13]}; pg8::gemm_phase(C.lds, gm, S, E); }
        { pg8::Gemm gm{(const bf16_t*)(ws + WS_CQN), (const bf16_t*)(ws + WS_WQ), T, 1280, 256}; pg8::StaticOrder S; S.init(T, 1280, C.G, C.G - 1 - (int)blockIdx.x);
          EpiQ E{(bf16_t*)(ws + WS_QLAT), (bf16_t*)(ws + WS_QIDX)}; pg8::gemm_phase(C.lds, gm, S, E); }
    } SEAM(3);
    if (IN(4)) { REP(14) { p4_indexer(C); } REP(15) { p4_memattn(C); } __syncthreads(); REP(16) { p4_rwkv_pass1(C); } } SEAM(4);
    if (IN(5)) { p5_rwkv_carry(C); __syncthreads(); REP(5) { p5_dsa_attn(C); } } SEAM(5);
    if (IN(6)) REP(6) { p6_rwkv_pass3(C); } SEAM(6);
    if (IN(7)) REP(7) {
        pg8::Gemm gm{xb, (const bf16_t*)(ws + WS_WG), T, 3072, 1024}; pg8::StaticOrder S; S.init(T, 3072, C.G, (int)blockIdx.x);
        EpiGates E{(bf16_t*)(ws + WS_GATES)}; pg8::gemm_phase(C.lds, gm, S, E);
    } SEAM(7);
    if (IN(8)) REP(8) {
        float* mf = (float*)C.dout; const bf16_t* gt = (const bf16_t*)(ws + WS_GATES); bf16_t* mb = (bf16_t*)(ws + WS_MERGEDB);
        { pg8::Gemm gm{(const bf16_t*)(ws + WS_OLAT), (const bf16_t*)(ws + WS_WOV), T, 1024, 1024}; pg8::StaticOrder S; S.init(T, 1024, C.G, (int)blockIdx.x);
          EpiMerge<0> E{gt, mf, mb}; pg8::gemm_phase(C.lds, gm, S, E); }
        { pg8::Gemm gm{(const bf16_t*)(ws + WS_YRWKV), (const bf16_t*)(ws + WS_WBRR), T, 1024, 512}; pg8::StaticOrder S; S.init(T, 1024, C.G, (int)blockIdx.x);
          EpiMerge<1> E{gt, mf, mb}; pg8::gemm_phase(C.lds, gm, S, E); }
        { pg8::Gemm gm{(const bf16_t*)(ws + WS_YMEM), (const bf16_t*)(ws + WS_WBRM), T, 1024, 512}; pg8::StaticOrder S; S.init(T, 1024, C.G, (int)blockIdx.x);
          EpiMerge<2> E{gt, mf, mb}; pg8::gemm_phase(C.lds, gm, S, E); }
    } SEAM(8);
    if (IN(9)) REP(9) {
        pg8::Gemm gm{(const bf16_t*)(ws + WS_MERGEDB), (const bf16_t*)(ws + WS_WOUT), T, 1024, 1024}; pg8::StaticOrder S; S.init(T, 1024, C.G, (int)blockIdx.x);
        EpiWout E{in[0], (float*)C.dout}; pg8::gemm_phase(C.lds, gm, S, E);
    } SEAM(9);
    if (IN(10)) REP(10) { p8_ln1(C); } SEAM(10);
    if (IN(11)) REP(11) {
        pg8::Gemm gm{(const bf16_t*)(ws + WS_X1B), (const bf16_t*)(ws + WS_WPEER), T, 2048, 1024}; pg8::StaticOrder S; S.init(T, 2048, C.G, (int)blockIdx.x);
        EpiPeerQ E{(bf16_t*)C.dout}; pg8::gemm_phase(C.lds, gm, S, E);
    } SEAM(11);
    if (IN(12)) REP(12) { p10_peer_route(C); } SEAM(12);
    if (IN(13)) REP(13) { p11_peer_experts(C); }
#undef IN
#undef SEAM
}

extern "C" void kernel_launch(void* const* d_in, const int* in_sizes, int n_in, void* d_out, int out_size, void* d_ws, size_t ws_size, hipStream_t stream) {
    static int grid = 0;
    if (grid == 0) {
        if (n_in != 34 || out_size != T * D || ws_size < WS_END) { fprintf(stderr, "kernel_launch: unexpected problem (n_in %d out %d ws %zu)\n", n_in, out_size, ws_size); grid = -1; return; }
        int dev = 0, cus = 0, per_cu = 0;
        if (hipGetDevice(&dev) != hipSuccess || hipDeviceGetAttribute(&cus, hipDeviceAttributeMultiprocessorCount, dev) != hipSuccess) { grid = -1; return; }
        if (hipFuncSetAttribute((const void*)hybrid_fwd, hipFuncAttributeMaxDynamicSharedMemorySize, LDS_BYTES) != hipSuccess) { fprintf(stderr, "kernel_launch: hipFuncSetAttribute failed\n"); grid = -1; return; }
        if (hipOccupancyMaxActiveBlocksPerMultiprocessor(&per_cu, (const void*)hybrid_fwd, NTHREADS, LDS_BYTES) != hipSuccess || per_cu < 1) { fprintf(stderr, "kernel_launch: occupancy query says %d\n", per_cu); }
        (void)hipGetLastError();
        grid = cus;
    }
    if (grid < 0) return;
    (void)hipMemsetAsync((char*)d_ws + WS_CTL, 0, 1 * MiB, stream);
    Args a{};
    for (int i = 0; i < 34; ++i) a.in[i] = (const float*)d_in[i];
    a.out = (float*)d_out; a.ws = (unsigned char*)d_ws; a.li = 0; a.pad = 0;
    if (MK_N_LAUNCHES == 1) { a.ph_lo = 0; a.ph_hi = NPHASE; hipLaunchKernelGGL(hybrid_fwd, dim3(grid), dim3(NTHREADS), LDS_BYTES, stream, a); }
    else for (int p = 0; p < NPHASE; ++p) { a.ph_lo = p; a.ph_hi = p + 1; a.li = p; hipLaunchKernelGGL(hybrid_fwd, dim3(grid), dim3(NTHREADS), LDS_BYTES, stream, a); }
}
```

```cpp
#include <hip/hip_runtime.h>
#include <stdint.h>
#include <stdio.h>

#ifndef MK_N_LAUNCHES
#define MK_N_LAUNCHES 1
#endif

#ifndef PROBE_MASK
#define PROBE_MASK 0
#endif
#define LAS __attribute__((address_space(3)))
typedef unsigned short bf16_t;
typedef short bf16x8 __attribute__((ext_vector_type(8)));
typedef float f32x4 __attribute__((ext_vector_type(4)));
typedef float f32x2 __attribute__((ext_vector_type(2)));
typedef unsigned u32x4 __attribute__((ext_vector_type(4)));
typedef unsigned u32x2 __attribute__((ext_vector_type(2)));

constexpr int NB = 4, SEQ = 4096, T = NB * SEQ, D = 1024;
constexpr int IN_W = 5800;
constexpr int RW = 512;
constexpr int NWAVES = 8, NTHREADS = 512;
constexpr float ALPHA = 1.189207115002721f;
constexpr int RCH = 32, RL = SEQ / RCH;

constexpr size_t MiB = 1u << 20;
constexpr size_t WS_CTL = 0;
constexpr size_t WS_WIN = 1 * MiB, WS_WG = 7 * MiB, WS_WLORA = 13 * MiB, WS_WQ = 14 * MiB, WS_WMEMKV = 15 * MiB, WS_WOV = 17 * MiB,
                 WS_WBRR = 19 * MiB, WS_WBRM = 20 * MiB, WS_WOUT = 21 * MiB, WS_WPEER = 23 * MiB, WS_KEYS = 27 * MiB;
constexpr size_t WS_CSMALL = 29 * MiB, WS_QLAT = 29 * MiB, WS_MERGEDB = 29 * MiB, WS_UB = 29 * MiB;
constexpr size_t WS_RCOLS = 61 * MiB, WS_QIDX = 61 * MiB, WS_YMEM = 69 * MiB, WS_OLAT = 85 * MiB, WS_VB = 61 * MiB, WS_EXPERTS = 93 * MiB, WS_PGATES = 101 * MiB;
constexpr size_t WS_MEMQ = 117 * MiB, WS_YRWKV = 117 * MiB;
constexpr size_t WS_RW_R = 133 * MiB, WS_RW_K = 149 * MiB, WS_RW_V = 165 * MiB, WS_RW_A = 181 * MiB, WS_RW_E = 197 * MiB, WS_RW_G = 213 * MiB;
constexpr size_t WS_GATES = 133 * MiB, WS_X1B = 133 * MiB, WS_X1 = 165 * MiB;
constexpr size_t WS_CQN = 229 * MiB, WS_KVL = 237 * MiB, WS_KIDX = 241 * MiB, WS_WIDX = 242 * MiB, WS_LORAA = 243 * MiB, WS_IDX = 243 * MiB,
                 WS_KMEM = 251 * MiB, WS_VMEMT = 252 * MiB, WS_MEMB = 253 * MiB, WS_END = 256 * MiB;
constexpr size_t DO_XB = 0, DO_PQ = 32 * MiB;
constexpr size_t WS_XB2 = 29 * MiB;
constexpr int CW_DSAQ = 64;

__device__ __forceinline__ unsigned f2bf(float f) { unsigned u = __float_as_uint(f); return (u + 0x7fffu + ((u >> 16) & 1u)) >> 16; }
__device__ __forceinline__ unsigned pk2(float lo, float hi) { return f2bf(lo) | (f2bf(hi) << 16); }
__device__ __forceinline__ float bflo(unsigned w) { return __uint_as_float(w << 16); }
__device__ __forceinline__ float bfhi(unsigned w) { return __uint_as_float(w & 0xffff0000u); }
__device__ __forceinline__ float bf1(bf16_t h) { return __uint_as_float(((unsigned)h) << 16); }
template <int CTRL, int RM = 0xF> __device__ __forceinline__ float dpp_f(float v) { return __builtin_bit_cast(float, __builtin_amdgcn_update_dpp(0, __builtin_bit_cast(int, v), CTRL, RM, 0xF, false)); }
template <int CTRL> __device__ __forceinline__ unsigned dpp_u(unsigned v) { return (unsigned)__builtin_amdgcn_update_dpp(0, (int)v, CTRL, 0xF, 0xF, false); }
__device__ __forceinline__ float wave_sum(float v) {
    v += dpp_f<0x111>(v); v += dpp_f<0x112>(v); v += dpp_f<0x114>(v); v += dpp_f<0x118>(v);
    v += dpp_f<0x142, 0xA>(v); v += dpp_f<0x143, 0xC>(v);
    return __builtin_bit_cast(float, __builtin_amdgcn_readlane(__builtin_bit_cast(int, v), 63));
}
__device__ __forceinline__ unsigned row_max_u(unsigned x) {
    unsigned y = dpp_u<0x128>(x); x = x > y ? x : y; y = dpp_u<0x124>(x); x = x > y ? x : y; y = dpp_u<0x122>(x); x = x > y ? x : y; y = dpp_u<0x121>(x); x = x > y ? x : y; return x; }
__device__ __forceinline__ float row_sum_f(float x) { x += dpp_f<0x128>(x); x += dpp_f<0x124>(x); x += dpp_f<0x122>(x); x += dpp_f<0x121>(x); return x; }
__device__ __forceinline__ float key2f(unsigned k) { const unsigned b = (k & 0x80000000u) ? (k & 0x7fffffffu) : ~k; return __uint_as_float(b); }
__device__ __forceinline__ float sigmoidf_(float x) { return 1.0f / (1.0f + __expf(-x)); }
__device__ __forceinline__ unsigned f2key(float f) { unsigned b = __float_as_uint(f); if (f == 0.0f) b = 0u; return (b & 0x80000000u) ? ~b : (b | 0x80000000u); }
__device__ __forceinline__ u32x4 pack8(const float* v) { u32x4 w; w.x = pk2(v[0], v[1]); w.y = pk2(v[2], v[3]); w.z = pk2(v[4], v[5]); w.w = pk2(v[6], v[7]); return w; }
__device__ __forceinline__ void unpack8(u32x4 w, float* v) { v[0] = bflo(w.x); v[1] = bfhi(w.x); v[2] = bflo(w.y); v[3] = bfhi(w.y); v[4] = bflo(w.z); v[5] = bfhi(w.z); v[6] = bflo(w.w); v[7] = bfhi(w.w); }

#define XB_TMO      128
#define XB_XCNT(j)  (256  + 64 * (j))
#define XB_XSUB(j)  (1280 + 64 * (j))
#define XB_XGEN(j)  (2304 + 64 * (j))
#define XB_TOP      3328
#define XB_TOPGEN   3392
#define XCD_BAR_WORDS 3456
#define XB_SPIN_CAP (1u << 18)

__device__ __forceinline__ unsigned xb_ld(unsigned* p)              { return __hip_atomic_load(p, __ATOMIC_RELAXED, __HIP_MEMORY_SCOPE_AGENT); }
__device__ __forceinline__ unsigned xb_add(unsigned* p, unsigned v) { return __hip_atomic_fetch_add(p, v, __ATOMIC_RELAXED, __HIP_MEMORY_SCOPE_AGENT); }
__device__ __forceinline__ unsigned xb_xcc_id() { return (unsigned)__builtin_amdgcn_s_getreg((3 << 11) | 20) & 0xFu; }
#define XB_SPIN(cond, bar) do { unsigned _sp = 0; while (cond) { __builtin_amdgcn_s_sleep(1); \
    if ((++_sp & 255u) == 0u) { if (xb_ld(&(bar)[XB_TMO])) break; if (_sp > XB_SPIN_CAP) { atomicAdd(&(bar)[XB_TMO], 1u); break; } } } } while (0)

struct XcdBarrier {
    unsigned* bar; unsigned x;
    volatile LAS unsigned* st;
};
__device__ __forceinline__ XcdBarrier xcd_barrier_post(unsigned* bar, volatile LAS unsigned* st) {
    XcdBarrier b; b.bar = bar; b.x = xb_xcc_id(); b.st = st;
    if (threadIdx.x == 0) (void)xb_add(&bar[XB_XCNT(b.x)], 1u);
    return b;
}
__device__ __forceinline__ void xcd_barrier_complete(unsigned* bar, unsigned x, unsigned& nloc, unsigned& nx) {
    const unsigned G = gridDim.x * gridDim.y * gridDim.z;
    unsigned sum, cnt, mine, sp = 0u;
    for (;;) {
        sum = 0u; cnt = 0u; mine = 0u;
#pragma unroll
        for (unsigned j = 0; j < 16; ++j) { const unsigned c = xb_ld(&bar[XB_XCNT(j)]); sum += c; cnt += (c > 0u) ? 1u : 0u; mine = (j == x) ? c : mine; }
        if (sum == G) break;
        __builtin_amdgcn_s_sleep(1);
        if ((++sp & 255u) == 0u) { if (xb_ld(&bar[XB_TMO])) break; if (sp > XB_SPIN_CAP) { atomicAdd(&bar[XB_TMO], 1u); break; } }
    }
    nloc = mine > 0u ? mine : 1u; nx = cnt > 0u ? cnt : 1u;
}
__device__ __forceinline__ void xcd_barrier(const XcdBarrier& b) {
    asm volatile("s_waitcnt vmcnt(0)" ::: "memory");
    __syncthreads();
    if (threadIdx.x == 0) {
        unsigned* bar = b.bar;
        __builtin_amdgcn_s_waitcnt(0);
        unsigned nloc = b.st[0], nx = b.st[1];
        if (nloc == 0u) { xcd_barrier_complete(bar, b.x, nloc, nx); b.st[0] = nloc; b.st[1] = nx; }
        const unsigned old = xb_add(&bar[XB_XSUB(b.x)], 1u);
        const unsigned gen = old / nloc;
        if (old + 1u == (gen + 1u) * nloc) {
            __builtin_amdgcn_fence(__ATOMIC_RELEASE, "agent");
            asm volatile("s_waitcnt vmcnt(0)" ::: "memory");
            const unsigned og = xb_add(&bar[XB_TOP], 1u);
            const unsigned tg = og / nx;
            if (og + 1u == (tg + 1u) * nx) xb_add(&bar[XB_TOPGEN], 1u);
            else XB_SPIN(xb_ld(&bar[XB_TOPGEN]) == tg, bar);
            __builtin_amdgcn_fence(__ATOMIC_ACQUIRE, "agent");
            xb_add(&bar[XB_XGEN(b.x)], 1u);
            asm volatile("s_waitcnt vmcnt(0)" ::: "memory");
        } else {
            XB_SPIN(xb_ld(&bar[XB_XGEN(b.x)]) == gen, bar);
            __builtin_amdgcn_fence(__ATOMIC_ACQUIRE, "agent");
            asm volatile("s_waitcnt vmcnt(0)" ::: "memory");
        }
    }
    __syncthreads();
}

namespace pg8 {
constexpr int BM = 256, BK = 64, HALF = 128, HTB = HALF * BK * 2, STAGE_BYTES = 8 * HTB, NXCD = 8, WGM = 8;
__device__ __forceinline__ int lds_byte(int r, int c) { const int st = (r >> 4) * 2 + (c >> 5), rr = r & 15, cc = c & 31, ob = rr * 64 + cc * 2; return st * 1024 + (ob ^ (((ob >> 9) & 1) << 5)); }
__device__ __forceinline__ void stage_rc(int b, int& R, int& C) { const int st = b / 1024, sb = b % 1024, swz = sb ^ (((sb >> 9) & 1) << 5); R = (st >> 1) * 16 + swz / 64; C = (st & 1) * 32 + (swz % 64) / 2; }
__device__ __forceinline__ int perm32(int rho) { const int n = rho >> 4, i = rho & 15; return 8 * (i >> 2) + 4 * n + (i & 3); }
struct Unit { int pm, pn; };
struct Gemm { const bf16_t* A; const bf16_t* Bt; int M, N, K; };
struct StaticOrder {
    int nM, nN, nwg, G, c;
    __device__ void init(int M, int N, int G_, int c_) { nM = M / BM; nN = N / BM; nwg = nM * nN; G = G_; c = c_; }
    __device__ bool next(int i, Unit& u) const {
        const long L = (long)i * G + c; if (L >= nwg) return false;
        int wgid = (int)L; { const int q = nwg / NXCD, r = nwg % NXCD, xcd = wgid % NXCD, off = wgid / NXCD; wgid = (xcd < r ? xcd * (q + 1) : r * (q + 1) + (xcd - r) * q) + off; }
        const int nig = WGM * nN, gid = wgid / nig, fm = gid * WGM, gsz = (nM - fm) < WGM ? (nM - fm) : WGM;
        u.pm = fm + ((wgid % nig) % gsz); u.pn = (wgid % nig) / gsz; return true;
    }
};
template <class Epi>
__device__ __forceinline__ void gemm_phase(LAS unsigned char* lds, const Gemm g, const StaticOrder& S, const Epi& E) {
    const int tid = threadIdx.x, wid = __builtin_amdgcn_readfirstlane(tid >> 6), lane = tid & 63, wr = wid >> 2, wc = wid & 3, fr = lane & 15, fq = lane >> 4;
    const int K = g.K, nt = K / BK;
    unsigned voffA[2], voffB[2];
#pragma unroll
    for (int i = 0; i < 2; ++i) { int R, C; stage_rc(tid * 16 + i * 8192, R, C); const int Rb = (R & ~31) + perm32(R & 31);
        voffA[i] = (unsigned)(R * K + C) * 2u; voffB[i] = (unsigned)(Rb * K + C) * 2u; }
    const size_t kstep = (size_t)(BK * 2);
    const size_t hstep = (size_t)HALF * K * 2;
    const size_t tstep = 2 * hstep;
    const unsigned ldsw = (unsigned)wid * 1024u;
    const int aoff = lds_byte(wr * 64 + fr, fq * 8), boff = lds_byte(wc * 32 + fr, fq * 8);
#define PG8_SA(b, h) (((b) * 2 + (h)) * HTB)
#define PG8_SB(b, h) ((4 + (b) * 2 + (h)) * HTB)
#define PG8_STAGE(bufoff, gbase, voff) do { _Pragma("unroll") for (int _i = 0; _i < 2; ++_i) \
        __builtin_amdgcn_global_load_lds((const unsigned*)((const char*)(gbase) + (voff)[_i]), (LAS unsigned*)(lds + (bufoff) + ldsw + _i * 8192), 16, 0, 0); } while (0)
#define PG8_LDA(dst, b, h) do { _Pragma("unroll") for (int m = 0; m < 4; ++m) _Pragma("unroll") for (int k = 0; k < 2; ++k) dst[m][k] = *(const LAS bf16x8*)(lds + PG8_SA(b, h) + aoff + m * 2048 + k * 1024); } while (0)
#define PG8_LDB(dst, b, h) do { _Pragma("unroll") for (int n = 0; n < 2; ++n) _Pragma("unroll") for (int k = 0; k < 2; ++k) dst[n][k] = *(const LAS bf16x8*)(lds + PG8_SB(b, h) + boff + n * 2048 + k * 1024); } while (0)
#define PG8_MMA(ai, bj, At, Bt) do { __builtin_amdgcn_s_setprio(1); _Pragma("unroll") for (int m = 0; m < 4; ++m) _Pragma("unroll") for (int n = 0; n < 2; ++n) _Pragma("unroll") for (int k = 0; k < 2; ++k) \
        acc[ai][bj][m][n] = __builtin_amdgcn_mfma_f32_16x16x32_bf16(Bt[n][k], At[m][k], acc[ai][bj][m][n], 0, 0, 0); __builtin_amdgcn_s_setprio(0); } while (0)
#define PG8_WAIT_V(n) asm volatile("s_waitcnt vmcnt(" #n ")" ::: "memory")
#define PG8_WAIT_L(n) asm volatile("s_waitcnt lgkmcnt(" #n ")" ::: "memory")
#define PG8_BAR __builtin_amdgcn_s_barrier()
#define PG8_SCHED __builtin_amdgcn_sched_barrier(0)
    Unit cur, nxt; int ui = 0;
    if (!S.next(0, cur)) return;
    f32x4 acc[2][2][4][2];
#pragma unroll
    for (int a = 0; a < 2; ++a)
#pragma unroll
        for (int b = 0; b < 2; ++b)
#pragma unroll
            for (int m = 0; m < 4; ++m)
#pragma unroll
                for (int n = 0; n < 2; ++n) acc[a][b][m][n] = (f32x4){0.f, 0.f, 0.f, 0.f};
    bf16x8 At[4][2], B0[2][2], B1[2][2];
    const char* cA = (const char*)g.A + (size_t)cur.pm * tstep; const char* cB = (const char*)g.Bt + (size_t)cur.pn * tstep;
    PG8_STAGE(PG8_SB(0, 0), cB, voffB); PG8_STAGE(PG8_SA(0, 0), cA, voffA); PG8_STAGE(PG8_SB(0, 1), cB + hstep, voffB); PG8_STAGE(PG8_SA(0, 1), cA + hstep, voffA);
    if (wr == 1) PG8_BAR;
    PG8_WAIT_V(4); PG8_BAR;
    PG8_STAGE(PG8_SB(1, 0), cB + kstep, voffB); PG8_STAGE(PG8_SA(1, 0), cA + kstep, voffA); PG8_STAGE(PG8_SB(1, 1), cB + hstep + kstep, voffB);
    PG8_WAIT_V(6); PG8_BAR;
    for (;;) {
        const bool has_next = S.next(ui + 1, nxt);
        const char* nA = has_next ? (const char*)g.A + (size_t)nxt.pm * tstep : cA; const char* nB = has_next ? (const char*)g.Bt + (size_t)nxt.pn * tstep : cB;
#pragma unroll 1
        for (int t = 0; t < nt; t += 2) {
            const bool last = (t == nt - 2);
            const char* a1 = cA + (size_t)(t + 1) * kstep;
            const char* a2 = last ? nA : cA + (size_t)(t + 2) * kstep; const char* b2 = last ? nB : cB + (size_t)(t + 2) * kstep;
            const char* a3 = a2 + kstep; const char* b3 = b2 + kstep;
            PG8_LDB(B0, 0, 0); PG8_SCHED; PG8_LDA(At, 0, 0); PG8_STAGE(PG8_SA(1, 1), a1 + hstep, voffA);
            PG8_WAIT_L(8); PG8_BAR; PG8_WAIT_L(0); PG8_MMA(0, 0, At, B0); PG8_BAR; PG8_SCHED;
            PG8_LDB(B1, 0, 1); PG8_STAGE(PG8_SB(0, 0), b2, voffB);
            PG8_BAR; PG8_WAIT_L(0); PG8_MMA(0, 1, At, B1); PG8_BAR;
            PG8_LDA(At, 0, 1); PG8_STAGE(PG8_SA(0, 0), a2, voffA);
            PG8_BAR; PG8_WAIT_L(0); PG8_MMA(1, 0, At, B0); PG8_BAR; PG8_SCHED;
            PG8_STAGE(PG8_SB(0, 1), b2 + hstep, voffB);
            PG8_WAIT_V(6); PG8_BAR; PG8_MMA(1, 1, At, B1); PG8_BAR;
            PG8_LDB(B0, 1, 0); PG8_SCHED; PG8_LDA(At, 1, 0); PG8_STAGE(PG8_SA(0, 1), a2 + hstep, voffA);
            PG8_WAIT_L(8); PG8_BAR; PG8_WAIT_L(0); PG8_MMA(0, 0, At, B0); PG8_BAR; PG8_SCHED;
            PG8_LDB(B1, 1, 1); PG8_STAGE(PG8_SB(1, 0), b3, voffB);
            PG8_BAR; PG8_WAIT_L(0); PG8_MMA(0, 1, At, B1); PG8_BAR;
            PG8_LDA(At, 1, 1); PG8_STAGE(PG8_SA(1, 0), a3, voffA);
            PG8_BAR; PG8_WAIT_L(0); PG8_MMA(1, 0, At, B0); PG8_BAR; PG8_SCHED;
            PG8_STAGE(PG8_SB(1, 1), b3 + hstep, voffB);
            PG8_WAIT_V(6); PG8_BAR; PG8_MMA(1, 1, At, B1); PG8_BAR;
        }
        {
            const int row0 = cur.pm * BM + wr * 64 + fr, col0 = cur.pn * BM + wc * 32 + 8 * fq;
#pragma unroll
            for (int ai = 0; ai < 2; ++ai)
#pragma unroll
                for (int m = 0; m < 4; ++m)
#pragma unroll
                    for (int bj = 0; bj < 2; ++bj) { E(row0 + ai * HALF + m * 16, col0 + bj * HALF, cur.pn, acc[ai][bj][m][0], acc[ai][bj][m][1]); if (Epi::SERIAL) __builtin_amdgcn_sched_barrier(0); }
        }
        if (!has_next) break;
#pragma unroll
        for (int a = 0; a < 2; ++a)
#pragma unroll
            for (int b = 0; b < 2; ++b)
#pragma unroll
                for (int m = 0; m < 4; ++m)
#pragma unroll
                    for (int n = 0; n < 2; ++n) acc[a][b][m][n] = (f32x4){0.f, 0.f, 0.f, 0.f};
        cur = nxt; cA = nA; cB = nB; ++ui;
    }
    PG8_WAIT_V(0);
    if (wr == 0) PG8_BAR;
    PG8_BAR;
#undef PG8_SA
#undef PG8_SB
#undef PG8_STAGE
#undef PG8_LDA
#undef PG8_LDB
#undef PG8_MMA
#undef PG8_WAIT_V
#undef PG8_WAIT_L
#undef PG8_BAR
#undef PG8_SCHED
}
}

struct Args { const float* in[34]; float* out; unsigned char* ws; int ph_lo, ph_hi, li, pad; };

struct Ctx {
    LAS unsigned char* lds;
    int tid, lane, wave, gw, ngw, gt, ngt, G;
    const float* const* in; unsigned char* ws; unsigned char* dout;
};

__device__ __forceinline__ void st8_bf16(bf16_t* p, f32x4 a, f32x4 b) { u32x4 w; w.x = pk2(a.x, a.y); w.y = pk2(a.z, a.w); w.z = pk2(b.x, b.y); w.w = pk2(b.z, b.w); *(u32x4*)p = w; }
struct EpiP1 { static constexpr bool SERIAL = false;
    float* cs; bf16_t* rc; bf16_t* mq;
    __device__ __forceinline__ void operator()(int row, int col, int pn, f32x4 a, f32x4 b) const {
        if (pn < 2) { float* p = cs + (size_t)row * 512 + col; *(f32x4*)p = a; *(f32x4*)(p + 4) = b; }
        else if (pn < 9) st8_bf16(rc + (size_t)row * 1792 + (col - 512), a, b);
        else st8_bf16(mq + (size_t)row * 512 + (col - 2304), a, b);
    }
};
struct EpiMemKV { static constexpr bool SERIAL = false;
    bf16_t* km; bf16_t* vt;
    __device__ __forceinline__ void operator()(int row, int col, int pn, f32x4 a, f32x4 b) const {
        const int bb = row >> 8, m = row & 255;
        if (col < 512) { const int h = col >> 7, d = col & 127; st8_bf16(km + ((size_t)((bb * 4 + h) * 256 + m)) * 128 + d, a, b); }
        else { const int c2 = col - 512, h = c2 >> 7, d = c2 & 127; bf16_t* p = vt + ((size_t)((bb * 4 + h) * 128 + d)) * 256 + m;
            p[0] = (bf16_t)f2bf(a.x); p[256] = (bf16_t)f2bf(a.y); p[512] = (bf16_t)f2bf(a.z); p[768] = (bf16_t)f2bf(a.w);
            p[1024] = (bf16_t)f2bf(b.x); p[1280] = (bf16_t)f2bf(b.y); p[1536] = (bf16_t)f2bf(b.z); p[1792] = (bf16_t)f2bf(b.w); }
    }
};
struct EpiLora { static constexpr bool SERIAL = true;
    bf16_t* e; bf16_t* a; bf16_t* g; const float* w0; const float* a0;
    __device__ __forceinline__ void operator()(int row, int col, int pn, f32x4 x, f32x4 y) const {
        float v[8] = {x.x, x.y, x.z, x.w, y.x, y.y, y.z, y.w};
        if (pn < 4) { const int c = col & 511; const float* bp = (pn < 2 ? w0 : a0) + c; const f32x4 b0 = *(const f32x4*)bp, b1 = *(const f32x4*)(bp + 4);
            const float bb[8] = {b0.x, b0.y, b0.z, b0.w, b1.x, b1.y, b1.z, b1.w}; const float sc = pn < 2 ? 0.6065306597126334f : 1.0f;
#pragma unroll
            for (int j = 0; j < 8; ++j) v[j] = sc * sigmoidf_(v[j] + bb[j]);
            *(u32x4*)((pn < 2 ? e : a) + (size_t)row * 512 + c) = pack8(v);
        } else *(u32x4*)(g + (size_t)row * 512 + (col - 1024)) = pack8(v);
    }
};
struct EpiQ { static constexpr bool SERIAL = false;
    bf16_t* ql; bf16_t* qi;
    __device__ __forceinline__ void operator()(int row, int col, int pn, f32x4 a, f32x4 b) const {
        if (pn < 4) st8_bf16(ql + (size_t)row * 1024 + col, a, b); else st8_bf16(qi + (size_t)row * 256 + (col - 1024), a, b);
    }
};
struct EpiGates { static constexpr bool SERIAL = true;
    bf16_t* o;
    __device__ __forceinline__ void operator()(int row, int col, int pn, f32x4 a, f32x4 b) const {
        float v[8] = {a.x, a.y, a.z, a.w, b.x, b.y, b.z, b.w};
#pragma unroll
        for (int j = 0; j < 8; ++j) v[j] = sigmoidf_(v[j]);
        *(u32x4*)(o + (size_t)row * 3072 + col) = pack8(v);
    }
};
template <int WHICH> struct EpiMerge { static constexpr bool SERIAL = true;
    const bf16_t* gates; float* mf; bf16_t* mb;
    __device__ __forceinline__ void operator()(int row, int col, int pn, f32x4 a, f32x4 b) const {
        float v[8] = {a.x, a.y, a.z, a.w, b.x, b.y, b.z, b.w}, gv[8];
        unpack8(*(const u32x4*)(gates + (size_t)row * 3072 + WHICH * 1024 + col), gv);
        float* p = mf + (size_t)row * 1024 + col;
        if (WHICH == 0) {
#pragma unroll
            for (int j = 0; j < 8; ++j) v[j] *= gv[j];
        } else { const f32x4 p0 = *(const f32x4*)p, p1 = *(const f32x4*)(p + 4); const float pv[8] = {p0.x, p0.y, p0.z, p0.w, p1.x, p1.y, p1.z, p1.w};
#pragma unroll
            for (int j = 0; j < 8; ++j) v[j] = pv[j] + v[j] * gv[j];
        }
        if (WHICH == 2) *(u32x4*)(mb + (size_t)row * 1024 + col) = pack8(v);
        else { *(f32x4*)p = (f32x4){v[0], v[1], v[2], v[3]}; *(f32x4*)(p + 4) = (f32x4){v[4], v[5], v[6], v[7]}; }
    }
};
struct EpiWout { static constexpr bool SERIAL = false;
    const float* x; float* pre;
    __device__ __forceinline__ void operator()(int row, int col, int pn, f32x4 a, f32x4 b) const {
        const float* xp = x + (size_t)row * 1024 + col; float* p = pre + (size_t)row * 1024 + col;
        *(f32x4*)p = *(const f32x4*)xp * ALPHA + a; *(f32x4*)(p + 4) = *(const f32x4*)(xp + 4) * ALPHA + b;
    }
};
struct EpiPeerQ { static constexpr bool SERIAL = false; bf16_t* o; __device__ __forceinline__ void operator()(int row, int col, int pn, f32x4 a, f32x4 b) const { st8_bf16(o + (size_t)row * 2048 + col, a, b); } };

template <int N, int K, class F> __device__ __forceinline__ void build_bt(bf16_t* dst, const F& f, int gt, int ngt) {
    constexpr int items = N * (K / 8);
    for (int i = gt; i < items; i += ngt) { const int n = i % N, k0 = (i / N) * 8; float v[8];
#pragma unroll
        for (int j = 0; j < 8; ++j) v[j] = f(n, k0 + j);
        *(u32x4*)(dst + (size_t)n * K + k0) = pack8(v); }
}
struct FWin { const float* w; __device__ __forceinline__ float operator()(int n, int k) const { if (n < 424) return w[(size_t)k * IN_W + n]; if (n < 512) return 0.f; return w[(size_t)k * IN_W + n - 88]; } };
struct FWg { const float* w; __device__ __forceinline__ float operator()(int n, int k) const { return w[(size_t)k * IN_W + 2728 + n]; } };
struct FLora { const float *w2, *a2, *g2; __device__ __forceinline__ float operator()(int n, int k) const {
    if (n < 512) return k < 64 ? w2[k * 512 + n] : 0.f;
    if (n < 1024) return (k >= 64 && k < 128) ? a2[(k - 64) * 512 + n - 512] : 0.f;
    return k >= 128 ? g2[(k - 128) * 512 + n - 1024] : 0.f; } };
struct FWq { const float *uq, *uk, *iq; __device__ __forceinline__ float operator()(int n, int k) const {
    if (n >= 1024) return iq[k * 256 + n - 1024];
    const int h = n >> 7, c = n & 127; const float* a = uq + (size_t)k * 512 + h * 64; const float* b = uk + (size_t)(c * 8 + h) * 64; float s = 0.f;
#pragma unroll 8
    for (int d = 0; d < 64; ++d) s = fmaf(a[d], b[d], s);
    return s * 0.125f; } };
struct FWov { const float *uv, *br; __device__ __forceinline__ float operator()(int n, int k) const {
    const int h = k >> 7, c = k & 127; const float* a = uv + (size_t)(c * 8 + h) * 64; const float* b = br + (size_t)(h * 64) * 1024 + n; float s = 0.f;
#pragma unroll 8
    for (int d = 0; d < 64; ++d) s = fmaf(a[d], b[(size_t)d * 1024], s);
    return s; } };
struct FT { const float* w; int ld; __device__ __forceinline__ float operator()(int n, int k) const { return w[(size_t)k * ld + n]; } };

__device__ __forceinline__ void cvt_rows(const float* src, bf16_t* dst, size_t n8, int gt, int ngt) {
    for (size_t i = gt; i < n8; i += ngt) { const f32x4 a = *(const f32x4*)(src + i * 8), b = *(const f32x4*)(src + i * 8 + 4); st8_bf16(dst + i * 8, a, b); }
}
constexpr float PEER_U_SCALE = 64.0f, PEER_V_SCALE = 8.0f;
__device__ __forceinline__ void cvt_rows_fp8(const float* src, unsigned char* dst, size_t n16, float scale, int gt, int ngt) {
    for (size_t i = gt; i < n16; i += ngt) { const float* p = src + i * 16; u32x4 w;
        const f32x4 a = *(const f32x4*)p * scale, b = *(const f32x4*)(p + 4) * scale, c = *(const f32x4*)(p + 8) * scale, d = *(const f32x4*)(p + 12) * scale;
        int t = 0; t = __builtin_amdgcn_cvt_pk_fp8_f32(a.x, a.y, t, false); t = __builtin_amdgcn_cvt_pk_fp8_f32(a.z, a.w, t, true); w.x = (unsigned)t;
        t = 0; t = __builtin_amdgcn_cvt_pk_fp8_f32(b.x, b.y, t, false); t = __builtin_amdgcn_cvt_pk_fp8_f32(b.z, b.w, t, true); w.y = (unsigned)t;
        t = 0; t = __builtin_amdgcn_cvt_pk_fp8_f32(c.x, c.y, t, false); t = __builtin_amdgcn_cvt_pk_fp8_f32(c.z, c.w, t, true); w.z = (unsigned)t;
        t = 0; t = __builtin_amdgcn_cvt_pk_fp8_f32(d.x, d.y, t, false); t = __builtin_amdgcn_cvt_pk_fp8_f32(d.z, d.w, t, true); w.w = (unsigned)t;
        *(u32x4*)(dst + i * 16) = w; }
}
__device__ __forceinline__ void p0_prologue(const Ctx& C) {
    const float* const* in = C.in; unsigned char* ws = C.ws;
    cvt_rows(in[0], (bf16_t*)(C.dout + DO_XB), (size_t)T * D / 8, C.gt, C.ngt);
    cvt_rows(in[1], (bf16_t*)(ws + WS_MEMB), (size_t)1024 * 1024 / 8, C.gt, C.ngt);
    cvt_rows(in[29], (bf16_t*)(ws + WS_KEYS), (size_t)2 * 128 * 128 / 8, C.gt, C.ngt);
    build_bt<2816, 1024>((bf16_t*)(ws + WS_WIN), FWin{in[3]}, C.gt, C.ngt);
    build_bt<1536, 256>((bf16_t*)(ws + WS_WLORA), FLora{in[12], in[14], in[15]}, C.gt, C.ngt);
    {
        bf16_t* dst = (bf16_t*)(ws + WS_WQ); const float* uq = in[6]; const float* uk = in[7];
        for (int item = C.gw; item < 4096; item += C.ngw) { const int n = item >> 2, k = (item & 3) * 64 + C.lane, h = n >> 7, c = n & 127;
            const float* a = uq + (size_t)k * 512 + h * 64; const float* bq = uk + (size_t)(c * 8 + h) * 64; float s = 0.f;
#pragma unroll
            for (int d4 = 0; d4 < 16; ++d4) { const f32x4 av = *(const f32x4*)(a + 4 * d4), bv = *(const f32x4*)(bq + 4 * d4); s += av.x * bv.x + av.y * bv.y + av.z * bv.z + av.w * bv.w; }
            dst[(size_t)n * 256 + k] = (bf16_t)f2bf(s * 0.125f); }
        build_bt<256, 256>(dst + 1024 * 256, FT{in[9], 256}, C.gt, C.ngt);
    }
    build_bt<1024, 1024>((bf16_t*)(ws + WS_WMEMKV), FT{in[21], 1024}, C.gt, C.ngt);
}
__device__ __forceinline__ void p6_late_weights(const Ctx& C) {
    const float* const* in = C.in; unsigned char* ws = C.ws;
    build_bt<3072, 1024>((bf16_t*)(ws + WS_WG), FWg{in[3]}, C.gt, C.ngt);
    {
        bf16_t* dst = (bf16_t*)(ws + WS_WOV); const float* uv = in[8]; const float* br = in[22];
        for (int i = C.gt; i < 1024 * 128; i += C.ngt) { const int n = i & 1023, k0 = (i >> 10) * 8, h = k0 >> 7, c0 = k0 & 127; float acc[8];
#pragma unroll
            for (int j = 0; j < 8; ++j) acc[j] = 0.f;
            for (int d4 = 0; d4 < 16; ++d4) {
                float b[4];
#pragma unroll
                for (int q = 0; q < 4; ++q) b[q] = br[(size_t)(h * 64 + 4 * d4 + q) * 1024 + n];
#pragma unroll
                for (int j = 0; j < 8; ++j) { const f32x4 a = *(const f32x4*)(uv + (size_t)((c0 + j) * 8 + h) * 64 + 4 * d4); acc[j] += a.x * b[0] + a.y * b[1] + a.z * b[2] + a.w * b[3]; }
            }
            *(u32x4*)(dst + (size_t)n * 1024 + k0) = pack8(acc); }
    }
    build_bt<1024, 512>((bf16_t*)(ws + WS_WBRR), FT{in[23], 1024}, C.gt, C.ngt);
    build_bt<1024, 512>((bf16_t*)(ws + WS_WBRM), FT{in[24], 1024}, C.gt, C.ngt);
    build_bt<1024, 1024>((bf16_t*)(ws + WS_WOUT), FT{in[25], 1024}, C.gt, C.ngt);
    build_bt<2048, 1024>((bf16_t*)(ws + WS_WPEER), FT{in[28], 2048}, C.gt, C.ngt);
}

__device__ __forceinline__ void p2_prep(const Ctx& C) {
    const float* const* in = C.in; unsigned char* ws = C.ws; const int lane = C.lane;
    const float* csmall = (const float*)(ws + WS_CSMALL); const bf16_t* rcols = (const bf16_t*)(ws + WS_RCOLS);
    bf16_t* cqn = (bf16_t*)(ws + WS_CQN); bf16_t* kvl = (bf16_t*)(ws + WS_KVL); bf16_t* kidx = (bf16_t*)(ws + WS_KIDX); float* widx = (float*)(ws + WS_WIDX);
    bf16_t* rr = (bf16_t*)(ws + WS_RW_R); bf16_t* rk = (bf16_t*)(ws + WS_RW_K); bf16_t* rv = (bf16_t*)(ws + WS_RW_V); bf16_t* la = (bf16_t*)(ws + WS_LORAA);
    const float* mu = in[10];
    const f32x4 gq = *(const f32x4*)(in[4] + 4 * lane); const f32x2 gk = *(const f32x2*)(in[5] + 2 * lane);
    for (int t = C.gw; t < T; t += C.ngw) {
        const float* cs = csmall + (size_t)t * 512;
        {
            const f32x4 q = *(const f32x4*)(cs + 4 * lane);
            const float ss = wave_sum(q.x * q.x + q.y * q.y + q.z * q.z + q.w * q.w);
            const float rs = rsqrtf(ss * (1.0f / 256.0f) + 1e-6f);
            u32x2 w; w.x = pk2(q.x * rs * gq.x, q.y * rs * gq.y); w.y = pk2(q.z * rs * gq.z, q.w * rs * gq.w);
            *(u32x2*)(cqn + (size_t)t * 256 + 4 * lane) = w;
        }
        {
            const f32x2 k = *(const f32x2*)(cs + 256 + 2 * lane);
            const float ss = wave_sum(k.x * k.x + k.y * k.y);
            const float rs = rsqrtf(ss * (1.0f / 128.0f) + 1e-6f);
            *(unsigned*)(kvl + (size_t)t * 128 + 2 * lane) = pk2(k.x * rs * gk.x, k.y * rs * gk.y);
        }
        if (lane < 16) { const f32x2 k = *(const f32x2*)(cs + 384 + 2 * lane); *(unsigned*)(kidx + (size_t)t * 32 + 2 * lane) = pk2(k.x, k.y); }
        if (lane < 8) widx[(size_t)t * 8 + lane] = cs[416 + lane] * 0.0625f;
        const bf16_t* rc = rcols + (size_t)t * 1792; const bool hp = (t & (SEQ - 1)) != 0; const bf16_t* rp = hp ? rc - 1792 : rc;
#pragma unroll
        for (int seg = 0; seg < 3; ++seg) {
            float c[8], p[8], o[8];
            unpack8(*(const u32x4*)(rc + seg * 512 + 8 * lane), c); unpack8(*(const u32x4*)(rp + seg * 512 + 8 * lane), p);
            const f32x4 m0 = *(const f32x4*)(mu + seg * 512 + 8 * lane), m1 = *(const f32x4*)(mu + seg * 512 + 8 * lane + 4);
            const float mm[8] = {m0.x, m0.y, m0.z, m0.w, m1.x, m1.y, m1.z, m1.w};
#pragma unroll
            for (int j = 0; j < 8; ++j) { const float pv = hp ? p[j] : 0.f; o[j] = c[j] + (pv - c[j]) * mm[j]; }
            bf16_t* dst = (seg == 0 ? rr : (seg == 1 ? rk : rv)) + (size_t)t * 512 + 8 * lane;
            *(u32x4*)dst = pack8(o);
        }
        {
            const float cw = bf1(rc[1536 + lane]), pw = hp ? bf1(rp[1536 + lane]) : 0.f; const float wl = cw + (pw - cw) * mu[1536 + lane];
            const float ca = bf1(rc[1600 + lane]), pa = hp ? bf1(rp[1600 + lane]) : 0.f; const float al = ca + (pa - ca) * mu[1600 + lane];
            const unsigned cgw = *(const unsigned*)(rc + 1664 + 2 * lane), pgw = *(const unsigned*)(rp + 1664 + 2 * lane);
            const float cg0 = bflo(cgw), cg1 = bfhi(cgw), pg0 = hp ? bflo(pgw) : 0.f, pg1 = hp ? bfhi(pgw) : 0.f;
            const float g0 = cg0 + (pg0 - cg0) * mu[1664 + 2 * lane], g1 = cg1 + (pg1 - cg1) * mu[1664 + 2 * lane + 1];
            bf16_t* l = la + (size_t)t * 256;
            l[lane] = (bf16_t)f2bf(tanhf(wl)); l[64 + lane] = (bf16_t)f2bf(al);
            *(unsigned*)(l + 128 + 2 * lane) = pk2(sigmoidf_(g0), sigmoidf_(g1));
        }
    }
}

template <int NV> __device__ __forceinline__ unsigned kth_largest(const unsigned (&u)[NV], int k) {
    unsigned Tk = 0u;
    for (int bit = 31; bit >= 0; --bit) {
        const unsigned cand = Tk | (1u << bit); int cnt = 0;
#pragma unroll
        for (int j = 0; j < NV; ++j) cnt += __popcll(__ballot(u[j] >= cand));
        if (cnt >= k) Tk = cand;
    }
    return Tk;
}

__device__ __forceinline__ unsigned wave_max_u(unsigned x) {
    unsigned y;
    y = dpp_u<0x111>(x); x = x > y ? x : y; y = dpp_u<0x112>(x); x = x > y ? x : y; y = dpp_u<0x114>(x); x = x > y ? x : y; y = dpp_u<0x118>(x); x = x > y ? x : y;
    y = (unsigned)__builtin_amdgcn_update_dpp(0, (int)x, 0x142, 0xA, 0xF, false); x = x > y ? x : y;
    y = (unsigned)__builtin_amdgcn_update_dpp(0, (int)x, 0x143, 0xC, 0xF, false); x = x > y ? x : y;
    return (unsigned)__builtin_amdgcn_readlane((int)x, 63);
}
__device__ __forceinline__ int wave_sum_i(int x) {
    x += __builtin_amdgcn_update_dpp(0, x, 0x111, 0xF, 0xF, false); x += __builtin_amdgcn_update_dpp(0, x, 0x112, 0xF, 0xF, false);
    x += __builtin_amdgcn_update_dpp(0, x, 0x114, 0xF, 0xF, false); x += __builtin_amdgcn_update_dpp(0, x, 0x118, 0xF, 0xF, false);
    x += __builtin_amdgcn_update_dpp(0, x, 0x142, 0xA, 0xF, false); x += __builtin_amdgcn_update_dpp(0, x, 0x143, 0xC, 0xF, false);
    return __builtin_amdgcn_readlane(x, 63);
}
__device__ __forceinline__ float wave_max_f(float x) {
    const int ninf = (int)0xff800000u; float y;
    y = __builtin_bit_cast(float, __builtin_amdgcn_update_dpp(ninf, __builtin_bit_cast(int, x), 0x111, 0xF, 0xF, false)); x = fmaxf(x, y);
    y = __builtin_bit_cast(float, __builtin_amdgcn_update_dpp(ninf, __builtin_bit_cast(int, x), 0x112, 0xF, 0xF, false)); x = fmaxf(x, y);
    y = __builtin_bit_cast(float, __builtin_amdgcn_update_dpp(ninf, __builtin_bit_cast(int, x), 0x114, 0xF, 0xF, false)); x = fmaxf(x, y);
    y = __builtin_bit_cast(float, __builtin_amdgcn_update_dpp(ninf, __builtin_bit_cast(int, x), 0x118, 0xF, 0xF, false)); x = fmaxf(x, y);
    y = __builtin_bit_cast(float, __builtin_amdgcn_update_dpp(ninf, __builtin_bit_cast(int, x), 0x142, 0xA, 0xF, false)); x = fmaxf(x, y);
    y = __builtin_bit_cast(float, __builtin_amdgcn_update_dpp(ninf, __builtin_bit_cast(int, x), 0x143, 0xC, 0xF, false)); x = fmaxf(x, y);
    return __builtin_bit_cast(float, __builtin_amdgcn_readlane(__builtin_bit_cast(int, x), 63));
}
__device__ __forceinline__ int wave_scan_i(int x) {
    x += __builtin_amdgcn_update_dpp(0, x, 0x111, 0xF, 0xF, false); x += __builtin_amdgcn_update_dpp(0, x, 0x112, 0xF, 0xF, false);
    x += __builtin_amdgcn_update_dpp(0, x, 0x114, 0xF, 0xF, false); x += __builtin_amdgcn_update_dpp(0, x, 0x118, 0xF, 0xF, false);
    x += __builtin_amdgcn_update_dpp(0, x, 0x142, 0xA, 0xF, false); x += __builtin_amdgcn_update_dpp(0, x, 0x143, 0xC, 0xF, false);
    return x;
}
__device__ __forceinline__ int hist_find(u32x4 h, int K, int lane, int& chi, int& cnt) {
    const int ls = (int)(h.x + h.y + h.z + h.w); const int inc = wave_scan_i(ls); const int tot = __builtin_amdgcn_readlane(inc, 63);
    const int a3 = tot - inc, a2 = a3 + (int)h.w, a1 = a2 + (int)h.z, a0 = a1 + (int)h.y;
    int myb = -1, mya = 0, myc = 0;
    if (a3 < K && K <= a3 + (int)h.w) { myb = 3; mya = a3; myc = (int)h.w; }
    if (a2 < K && K <= a2 + (int)h.z) { myb = 2; mya = a2; myc = (int)h.z; }
    if (a1 < K && K <= a1 + (int)h.y) { myb = 1; mya = a1; myc = (int)h.y; }
    if (a0 < K && K <= a0 + (int)h.x) { myb = 0; mya = a0; myc = (int)h.x; }
    const unsigned long long m = __ballot(myb >= 0); const int src = m ? (int)__builtin_ctzll(m) : 0;
    chi = __builtin_amdgcn_readlane(mya, src); cnt = __builtin_amdgcn_readlane(myc, src);
    return 4 * src + __builtin_amdgcn_readlane(myb, src);
}
constexpr int LDS_HIST = 131072 + 4096;
__device__ __forceinline__ void p4_indexer(const Ctx& C) {
    unsigned char* ws = C.ws; const int lane = C.lane, wave = C.wave, g = lane >> 4, fr = lane & 15;
    const bf16_t* qidx = (const bf16_t*)(ws + WS_QIDX); const bf16_t* kidx = (const bf16_t*)(ws + WS_KIDX); const float* widx = (const float*)(ws + WS_WIDX);
    bf16_t* idxo = (bf16_t*)(ws + WS_IDX);
    LAS float* SC = (LAS float*)C.lds;
    LAS unsigned* H = (LAS unsigned*)(C.lds + LDS_HIST + wave * 1024);
    for (int u = blockIdx.x; u < 2048; u += C.G) {
        const int i8 = u >> 8, cc = u & 255, b = cc & 3, j = cc >> 2, qb = (i8 & 1) ? 64 * i8 + 63 - j : 64 * i8 + j;
        const int t0 = qb * 8, ntile = (t0 + 8 + 15) >> 4; const size_t tb = (size_t)b * SEQ;
        const int qn = fr & 7;
        bf16x8 Bq[8];
#pragma unroll
        for (int h = 0; h < 8; ++h) Bq[h] = *(const bf16x8*)(qidx + (tb + t0 + qn) * 256 + h * 32 + 8 * g);
        const f32x4 w0 = *(const f32x4*)(widx + (tb + t0 + qn) * 8), w1 = *(const f32x4*)(widx + (tb + t0 + qn) * 8 + 4);
        const float wq[8] = {w0.x, w0.y, w0.z, w0.w, w1.x, w1.y, w1.z, w1.w};
        for (int i0 = wave; i0 < ntile; i0 += 4 * NWAVES) {
            bf16x8 A[4];
#pragma unroll
            for (int q = 0; q < 4; ++q) { int i = i0 + q * NWAVES; i = i < ntile ? i : ntile - 1; A[q] = *(const bf16x8*)(kidx + (tb + 16 * i + fr) * 32 + 8 * g); }
#pragma unroll
            for (int q = 0; q < 4; ++q) {
                const int i = i0 + q * NWAVES;
                if (i < ntile) {
                    f32x4 sc = (f32x4){0.f, 0.f, 0.f, 0.f};
#pragma unroll
                    for (int h = 0; h < 8; ++h) { const f32x4 d = __builtin_amdgcn_mfma_f32_16x16x32_bf16(A[q], Bq[h], (f32x4){0.f, 0.f, 0.f, 0.f}, 0, 0, 0);
#pragma unroll
                        for (int r = 0; r < 4; ++r) sc[r] = fmaf(wq[h], fmaxf(d[r], 0.f), sc[r]); }
                    if (fr < 8) { const int tq = t0 + fr, s0 = 16 * i + 4 * g;
#pragma unroll
                        for (int r = 0; r < 4; ++r) sc[r] = (s0 + r <= tq) ? sc[r] : -INFINITY;
                        *(LAS f32x4*)(SC + fr * 4096 + s0) = sc; }
                }
            }
        }
        __syncthreads();
        {
            const int tq = t0 + wave; bf16_t* out = idxo + (tb + tq) * 256;
            if (tq < 256) {
#pragma unroll
                for (int jj = 0; jj < 4; ++jj) { const int s = jj * 64 + lane; if (s <= tq) out[s] = (bf16_t)s; }
            } else {
                float v[64];
#pragma unroll
                for (int jj = 0; jj < 64; ++jj) { const int s = jj * 64 + lane; const float x = SC[wave * 4096 + s]; v[jj] = (s <= tq) ? x : -INFINITY; }
                float mx = -INFINITY, mnn = -INFINITY;
#pragma unroll
                for (int jj = 0; jj < 64; ++jj) { mx = fmaxf(mx, v[jj]); mnn = fmaxf(mnn, v[jj] == -INFINITY ? -INFINITY : -v[jj]); }
                mx = wave_max_f(mx); const float lo = -wave_max_f(mnn);
                const float rng = mx - lo; const float inv = rng > 1e-30f ? 65535.9f / rng : 1.f;
                *(LAS u32x4*)(H + 4 * lane) = (u32x4){0u, 0u, 0u, 0u};
#pragma unroll
                for (int jj = 0; jj < 64; ++jj) { const int bn = (int)((v[jj] - lo) * inv); if (bn >= 0) __hip_atomic_fetch_add(H + (bn >> 8), 1u, __ATOMIC_RELAXED, __HIP_MEMORY_SCOPE_WORKGROUP); }
                asm volatile("s_waitcnt lgkmcnt(0)" ::: "memory");
                int chi1, cnt1; const int b1 = hist_find(*(const LAS u32x4*)(H + 4 * lane), 256, lane, chi1, cnt1);
                asm volatile("s_waitcnt lgkmcnt(0)" ::: "memory");
                *(LAS u32x4*)(H + 4 * lane) = (u32x4){0u, 0u, 0u, 0u};
#pragma unroll
                for (int jj = 0; jj < 64; ++jj) { const int bn = (int)((v[jj] - lo) * inv); if ((bn >> 8) == b1) __hip_atomic_fetch_add(H + (bn & 255), 1u, __ATOMIC_RELAXED, __HIP_MEMORY_SCOPE_WORKGROUP); }
                asm volatile("s_waitcnt lgkmcnt(0)" ::: "memory");
                int chi2, cnt2; const int b2 = hist_find(*(const LAS u32x4*)(H + 4 * lane), 256 - chi1, lane, chi2, cnt2);
                const int T16 = b1 * 256 + b2; const int need = 256 - chi1 - chi2;
                const bool allties = (need == cnt2);
                unsigned mlo = 0u, mhi = 0u;
#pragma unroll
                for (int jj = 0; jj < 32; ++jj) { const int bn = (int)((v[jj] - lo) * inv); const bool sel = allties ? (bn >= T16) : (bn > T16); mlo |= sel ? (1u << jj) : 0u; }
#pragma unroll
                for (int jj = 32; jj < 64; ++jj) { const int bn = (int)((v[jj] - lo) * inv); const bool sel = allties ? (bn >= T16) : (bn > T16); mhi |= sel ? (1u << (jj - 32)) : 0u; }
                LAS bf16_t* stage = (LAS bf16_t*)(SC + wave * 4096);
                const int mycnt = __popc(mlo) + __popc(mhi); int base = wave_scan_i(mycnt) - mycnt;
                while (mlo) { const int bpos = __builtin_ctz(mlo); stage[base++] = (bf16_t)(bpos * 64 + lane); mlo &= mlo - 1u; }
                while (mhi) { const int bpos = __builtin_ctz(mhi); stage[base++] = (bf16_t)((bpos + 32) * 64 + lane); mhi &= mhi - 1u; }
                if (!allties) {
                    int eqb = 0; const int pos0 = 256 - need;
#pragma unroll
                    for (int jj = 0; jj < 64; ++jj) {
                        const int bn = (int)((v[jj] - lo) * inv); const bool eq = (bn == T16);
                        const unsigned long long me = __ballot(eq);
                        const int er = eqb + (int)__builtin_amdgcn_mbcnt_hi((unsigned)(me >> 32), __builtin_amdgcn_mbcnt_lo((unsigned)me, 0u));
                        if (eq && er < need) stage[pos0 + er] = (bf16_t)(jj * 64 + lane);
                        eqb += __popcll(me);
                    }
                }
                asm volatile("s_waitcnt lgkmcnt(0)" ::: "memory");
                *(u32x2*)(out + 4 * lane) = *(const LAS u32x2*)(stage + 4 * lane);
            }
        }
        __syncthreads();
    }
}

__device__ __forceinline__ void p4_memattn(const Ctx& C) {
    unsigned char* ws = C.ws; const int lane = C.lane, wave = C.wave, g = lane >> 4, fr = lane & 15;
    const bf16_t* memq = (const bf16_t*)(ws + WS_MEMQ); const bf16_t* kmem = (const bf16_t*)(ws + WS_KMEM); const bf16_t* vmt = (const bf16_t*)(ws + WS_VMEMT);
    bf16_t* ymem = (bf16_t*)(ws + WS_YMEM);
    LAS unsigned char* KL = C.lds; LAS unsigned char* VL = C.lds + 65536;
    for (int su = blockIdx.x; su < 256; su += C.G) {
        const int bh = su >> 4, j = su & 15, b = bh >> 2, h = bh & 3;
        const char* kb = (const char*)(kmem + (size_t)(bh * 256) * 128); const char* vb = (const char*)(vmt + (size_t)(bh * 128) * 256);
#pragma unroll
        for (int pp = 0; pp < 8; ++pp) { const int p = wave + 8 * pp;
            { const int row = 4 * p + g; const int c = fr ^ (2 * (row & 7)); __builtin_amdgcn_global_load_lds((const unsigned*)(kb + row * 256 + 16 * c), (LAS unsigned*)(KL + 1024 * p), 16, 0, 0); }
            { const int row = 2 * p + (lane >> 5); const int c = (lane & 31) ^ (row & 15); __builtin_amdgcn_global_load_lds((const unsigned*)(vb + row * 512 + 16 * c), (LAS unsigned*)(VL + 1024 * p), 16, 0, 0); } }
        asm volatile("s_waitcnt vmcnt(0)" ::: "memory");
        __syncthreads();
#pragma unroll 1
        for (int u = 0; u < 2; ++u) {
            const int t0 = b * SEQ + (2 * j + u) * 128 + wave * 16;
            bf16x8 Bq[4];
#pragma unroll
            for (int kk = 0; kk < 4; ++kk) Bq[kk] = *(const bf16x8*)(memq + (size_t)(t0 + fr) * 512 + h * 128 + 32 * kk + 8 * g);
            f32x4 sc[16];
#pragma unroll
            for (int i = 0; i < 16; ++i) { if ((i & 1) == 0) __builtin_amdgcn_sched_barrier(0); f32x4 a = (f32x4){0.f, 0.f, 0.f, 0.f}; const int row = 16 * i + fr;
#pragma unroll
                for (int kk = 0; kk < 4; ++kk) { const bf16x8 A = *(const LAS bf16x8*)(KL + row * 256 + 16 * ((4 * kk + g) ^ (2 * (row & 7)))); a = __builtin_amdgcn_mfma_f32_16x16x32_bf16(A, Bq[kk], a, 0, 0, 0); }
                sc[i] = a; }
            const float scale = 0.08838834764831845f;
            float mx = -3.0e38f;
#pragma unroll
            for (int i = 0; i < 16; ++i)
#pragma unroll
                for (int r = 0; r < 4; ++r) { sc[i][r] *= scale; mx = fmaxf(mx, sc[i][r]); }
            mx = fmaxf(mx, __shfl_xor(mx, 16)); mx = fmaxf(mx, __shfl_xor(mx, 32));
            float sum = 0.f;
#pragma unroll
            for (int i = 0; i < 16; ++i)
#pragma unroll
                for (int r = 0; r < 4; ++r) { sc[i][r] = __expf(sc[i][r] - mx); sum += sc[i][r]; }
            sum += __shfl_xor(sum, 16); sum += __shfl_xor(sum, 32);
            const float inv = 1.0f / sum;
            bf16x8 Pb[8];
#pragma unroll
            for (int ks = 0; ks < 8; ++ks) { u32x4 w; w.x = pk2(sc[2 * ks][0] * inv, sc[2 * ks][1] * inv); w.y = pk2(sc[2 * ks][2] * inv, sc[2 * ks][3] * inv);
                w.z = pk2(sc[2 * ks + 1][0] * inv, sc[2 * ks + 1][1] * inv); w.w = pk2(sc[2 * ks + 1][2] * inv, sc[2 * ks + 1][3] * inv); Pb[ks] = __builtin_bit_cast(bf16x8, w); }
#pragma unroll
            for (int dt = 0; dt < 8; ++dt) {
                __builtin_amdgcn_sched_barrier(0);
                f32x4 o = (f32x4){0.f, 0.f, 0.f, 0.f}; const int row = 16 * dt + fr;
#pragma unroll
                for (int ks = 0; ks < 8; ++ks) { const int ch = 4 * ks + (g >> 1);
                    const u32x2 lo = *(const LAS u32x2*)(VL + row * 512 + 16 * (ch ^ (row & 15)) + 8 * (g & 1)), hi = *(const LAS u32x2*)(VL + row * 512 + 16 * ((ch + 2) ^ (row & 15)) + 8 * (g & 1));
                    u32x4 w; w.x = lo.x; w.y = lo.y; w.z = hi.x; w.w = hi.y;
                    o = __builtin_amdgcn_mfma_f32_16x16x32_bf16(__builtin_bit_cast(bf16x8, w), Pb[ks], o, 0, 0, 0); }
                u32x2 w; w.x = pk2(o[0], o[1]); w.y = pk2(o[2], o[3]);
                *(u32x2*)(ymem + (size_t)(t0 + fr) * 512 + h * 128 + 16 * dt + 4 * g) = w;
            }
        }
        __syncthreads();
    }
}

constexpr int LDS_RELB = 131072 + 1024;
constexpr int LDS_LUT = LDS_RELB + 1024;
__device__ __forceinline__ void tr_read8(const unsigned (&a)[8], u32x2 (&d)[8]) {
    asm volatile("ds_read_b64_tr_b16 %0, %8\n\tds_read_b64_tr_b16 %1, %9\n\tds_read_b64_tr_b16 %2, %10\n\tds_read_b64_tr_b16 %3, %11\n\t"
                 "ds_read_b64_tr_b16 %4, %12\n\tds_read_b64_tr_b16 %5, %13\n\tds_read_b64_tr_b16 %6, %14\n\tds_read_b64_tr_b16 %7, %15\n\ts_waitcnt lgkmcnt(0)"
                 : "=&v"(d[0]), "=&v"(d[1]), "=&v"(d[2]), "=&v"(d[3]), "=&v"(d[4]), "=&v"(d[5]), "=&v"(d[6]), "=&v"(d[7])
                 : "v"(a[0]), "v"(a[1]), "v"(a[2]), "v"(a[3]), "v"(a[4]), "v"(a[5]), "v"(a[6]), "v"(a[7]) : "memory");
}
constexpr int LDS_DSAX = 131072 + 4096;
__device__ __forceinline__ void p5_dsa_attn(const Ctx& C, int qsel) {
    unsigned char* ws = C.ws; const int lane = C.lane, wave = C.wave, g = lane >> 4, fr = lane & 15;
    const bf16_t* qlat = (const bf16_t*)(ws + WS_QLAT); const bf16_t* kvl = (const bf16_t*)(ws + WS_KVL); const bf16_t* idxb = (const bf16_t*)(ws + WS_IDX);
    bf16_t* olat = (bf16_t*)(ws + WS_OLAT);
    LAS int* lut = (LAS int*)(C.lds + LDS_LUT);
    if (C.tid < 128) { const int n = C.tid; int bk = n; if (n >= 16) { bk = 16 + (int)(logf((float)n * (1.0f / 16.0f)) / 2.0794415416798357f * 16.0f); bk = bk > 31 ? 31 : bk; } lut[n] = bk; }
    __syncthreads();
    LAS unsigned char* my = C.lds + wave * 16384; const unsigned mybase = (unsigned)(uintptr_t)my;
    LAS bf16_t* IDXL = (LAS bf16_t*)(C.lds + LDS_DSAX + wave * 1024); LAS bf16_t* BKL = IDXL + 256;
    unsigned* qctr = (unsigned*)(ws + WS_CTL) + CW_DSAQ + 64 * qsel;
    const int qq = fr >> 2, p2 = fr & 3;
    bf16x8 Bbias;
    { float bv[8];
#pragma unroll
      for (int j = 0; j < 8; ++j) bv[j] = C.in[2][(8 * g + j) * 8 + (fr & 7)];
      Bbias = __builtin_bit_cast(bf16x8, pack8(bv)); }
    unsigned qkoff[2][4];
#pragma unroll
    for (int i = 0; i < 2; ++i) { const int ph = 4 * (fr & 7) + 2 * i + (fr >> 3);
#pragma unroll
        for (int kk = 0; kk < 4; ++kk) qkoff[i][kk] = (unsigned)(ph * 256 + 16 * ((4 * kk + g) ^ (2 * (ph & 7)))); }
    const int ph0 = 4 * (4 * (g & 1) + qq) + (g >> 1), ph1 = ph0 + 2;
    for (;;) {
      int q0 = 0; if (lane == 0) q0 = (int)__hip_atomic_fetch_add(qctr, 4u, __ATOMIC_RELAXED, __HIP_MEMORY_SCOPE_AGENT);
      q0 = __builtin_amdgcn_readfirstlane(q0); if (q0 >= T) break;
      for (int q = q0; q < q0 + 4; ++q) {
        const int b = q >> 12, s = q & (SEQ - 1); const int nvalid = s + 1 < 256 ? s + 1 : 256;
        const char* kvb = (const char*)(kvl + (size_t)b * SEQ * 128);
        {
            const u32x2 w = *(const u32x2*)(idxb + (size_t)q * 256 + 4 * lane); int ix[4] = {(int)(w.x & 0xffffu), (int)(w.x >> 16), (int)(w.y & 0xffffu), (int)(w.y >> 16)}; unsigned bk[4];
#pragma unroll
            for (int j = 0; j < 4; ++j) { if (4 * lane + j >= nvalid) ix[j] = 0; const int dist = s - ix[j]; bk[j] = (unsigned)(dist >= 128 ? 31 : lut[dist < 0 ? 0 : dist]); }
            u32x2 wi; wi.x = (unsigned)ix[0] | ((unsigned)ix[1] << 16); wi.y = (unsigned)ix[2] | ((unsigned)ix[3] << 16); *(LAS u32x2*)(IDXL + 4 * lane) = wi;
            u32x2 wb; wb.x = bk[0] | (bk[1] << 16); wb.y = bk[2] | (bk[3] << 16); *(LAS u32x2*)(BKL + 4 * lane) = wb;
        }
        bf16x8 Bq[4];
#pragma unroll
        for (int kk = 0; kk < 4; ++kk) Bq[kk] = *(const bf16x8*)(qlat + (size_t)q * 1024 + (fr & 7) * 128 + 32 * kk + 8 * g);
        float m_ref = 0.f, l_part = 0.f;
        f32x4 O[8];
#pragma unroll
        for (int cc = 0; cc < 8; ++cc) O[cc] = (f32x4){0.f, 0.f, 0.f, 0.f};
        const int nsub = (nvalid + 31) >> 5;
        asm volatile("s_waitcnt vmcnt(0) lgkmcnt(0)" ::: "memory");
        {
            const u32x4 rw = *(const LAS u32x4*)(IDXL + 8 * g); const unsigned rws[4] = {rw.x, rw.y, rw.z, rw.w};
#pragma unroll
            for (int p = 0; p < 8; ++p) { const int srow = (int)((rws[p >> 1] >> (16 * (p & 1))) & 0xffffu); const int c = fr ^ (2 * ((4 * p + g) & 7));
                __builtin_amdgcn_global_load_lds((const unsigned*)(kvb + (size_t)srow * 256 + 16 * c), (LAS unsigned*)(my + 1024 * p), 16, 0, 0); }
        }
#pragma unroll
        for (int sc_ = 0; sc_ < 8; ++sc_) {
          if (sc_ < nsub) {
            LAS unsigned char* cur = my + (sc_ & 1) * 8192; const unsigned curb = mybase + (sc_ & 1) * 8192;
            if (sc_ + 1 < nsub) {
                LAS unsigned char* nb = my + ((sc_ + 1) & 1) * 8192;
                const u32x4 rw = *(const LAS u32x4*)(IDXL + 32 * (sc_ + 1) + 8 * g); const unsigned rws[4] = {rw.x, rw.y, rw.z, rw.w};
#pragma unroll
                for (int p = 0; p < 8; ++p) { const int srow = (int)((rws[p >> 1] >> (16 * (p & 1))) & 0xffffu); const int c = fr ^ (2 * ((4 * p + g) & 7));
                    __builtin_amdgcn_global_load_lds((const unsigned*)(kvb + (size_t)srow * 256 + 16 * c), (LAS unsigned*)(nb + 1024 * p), 16, 0, 0); }
                asm volatile("s_waitcnt vmcnt(8)" ::: "memory");
            } else asm volatile("s_waitcnt vmcnt(0)" ::: "memory");
            f32x4 sc[2];
#pragma unroll
            for (int i = 0; i < 2; ++i) {
                const int pos = (int)BKL[32 * sc_ + 16 * i + fr] - 8 * g;
                u32x4 oh; oh.x = (pos == 0 ? 0x3F80u : 0u) | (pos == 1 ? 0x3F800000u : 0u); oh.y = (pos == 2 ? 0x3F80u : 0u) | (pos == 3 ? 0x3F800000u : 0u);
                oh.z = (pos == 4 ? 0x3F80u : 0u) | (pos == 5 ? 0x3F800000u : 0u); oh.w = (pos == 6 ? 0x3F80u : 0u) | (pos == 7 ? 0x3F800000u : 0u);
                f32x4 a = __builtin_amdgcn_mfma_f32_16x16x32_bf16(__builtin_bit_cast(bf16x8, oh), Bbias, (f32x4){0.f, 0.f, 0.f, 0.f}, 0, 0, 0);
#pragma unroll
                for (int kk = 0; kk < 4; ++kk) a = __builtin_amdgcn_mfma_f32_16x16x32_bf16(*(const LAS bf16x8*)(cur + qkoff[i][kk]), Bq[kk], a, 0, 0, 0);
                sc[i] = a; }
            if (nvalid < 256) {
#pragma unroll
                for (int i = 0; i < 2; ++i)
#pragma unroll
                    for (int r = 0; r < 4; ++r) if (sc_ * 32 + 16 * i + 4 * g + r >= nvalid) sc[i][r] = -INFINITY;
            }
            if (sc_ == 0) { float mx = fmaxf(fmaxf(fmaxf(sc[0][0], sc[0][1]), fmaxf(sc[0][2], sc[0][3])), fmaxf(fmaxf(sc[1][0], sc[1][1]), fmaxf(sc[1][2], sc[1][3])));
                mx = fmaxf(mx, __shfl_xor(mx, 16)); mx = fmaxf(mx, __shfl_xor(mx, 32)); m_ref = mx; }
#pragma unroll
            for (int i = 0; i < 2; ++i)
#pragma unroll
                for (int r = 0; r < 4; ++r) { sc[i][r] = __expf(sc[i][r] - m_ref); l_part += sc[i][r]; }
            u32x4 w; w.x = pk2(sc[0][0], sc[0][1]); w.y = pk2(sc[0][2], sc[0][3]); w.z = pk2(sc[1][0], sc[1][1]); w.w = pk2(sc[1][2], sc[1][3]);
            const bf16x8 Pa = __builtin_bit_cast(bf16x8, w);
#pragma unroll
            for (int hf = 0; hf < 2; ++hf) {
                unsigned ad[8]; u32x2 dd[8];
#pragma unroll
                for (int c4 = 0; c4 < 4; ++c4) { const int chk = 2 * (4 * hf + c4) + (p2 >> 1);
                    ad[2 * c4] = curb + ph0 * 256 + 16 * (chk ^ (2 * (ph0 & 7))) + 8 * (p2 & 1); ad[2 * c4 + 1] = curb + ph1 * 256 + 16 * (chk ^ (2 * (ph1 & 7))) + 8 * (p2 & 1); }
                tr_read8(ad, dd);
#pragma unroll
                for (int c4 = 0; c4 < 4; ++c4) { u32x4 bw; bw.x = dd[2 * c4].x; bw.y = dd[2 * c4].y; bw.z = dd[2 * c4 + 1].x; bw.w = dd[2 * c4 + 1].y;
                    O[4 * hf + c4] = __builtin_amdgcn_mfma_f32_16x16x32_bf16(Pa, __builtin_bit_cast(bf16x8, bw), O[4 * hf + c4], 0, 0, 0); }
            }
            asm volatile("" ::: "memory");
          }
        }
        float l_run = l_part; l_run += __shfl_xor(l_run, 16); l_run += __shfl_xor(l_run, 32);
        const float inv = 1.0f / l_run; float ir[4];
#pragma unroll
        for (int r = 0; r < 4; ++r) ir[r] = __shfl(inv, 4 * g + r);
        if (g < 2) {
#pragma unroll
            for (int cc = 0; cc < 8; ++cc)
#pragma unroll
                for (int r = 0; r < 4; ++r) olat[(size_t)q * 1024 + (4 * g + r) * 128 + 16 * cc + fr] = (bf16_t)f2bf(O[cc][r] * ir[r]);
        }
      }
    }
}

constexpr int RWM_LDS = 13824;
__device__ __forceinline__ bf16x8 frag_pack(f32x4 lo, f32x4 hi) { u32x4 w; w.x = pk2(lo.x, lo.y); w.y = pk2(lo.z, lo.w); w.z = pk2(hi.x, hi.y); w.w = pk2(hi.z, hi.w); return __builtin_bit_cast(bf16x8, w); }
__device__ __forceinline__ bf16x8 frag_pack_lo(f32x4 lo) { u32x4 w; w.x = pk2(lo.x, lo.y); w.y = pk2(lo.z, lo.w); w.z = 0u; w.w = 0u; return __builtin_bit_cast(bf16x8, w); }
template <int MODE> __device__ __forceinline__ void rwm_task(const Ctx& C, int bh, int ch) {
    unsigned char* ws = C.ws; const int lane = C.lane, g = lane >> 4, fr = lane & 15; const int b = bh >> 3, h = bh & 7;
    const bf16_t* pr = (const bf16_t*)(ws + WS_RW_R); const bf16_t* pk = (const bf16_t*)(ws + WS_RW_K); const bf16_t* pv = (const bf16_t*)(ws + WS_RW_V);
    const bf16_t* pa = (const bf16_t*)(ws + WS_RW_A); const bf16_t* pe = (const bf16_t*)(ws + WS_RW_E); const bf16_t* pg = (const bf16_t*)(ws + WS_RW_G);
    bf16_t* yo = (bf16_t*)(ws + WS_YRWKV);
    float* PQ = (float*)(C.dout + DO_PQ);
    LAS unsigned char* my = C.lds + C.wave * RWM_LDS; const unsigned myb = (unsigned)(uintptr_t)my;
    LAS unsigned char* SI = my; LAS unsigned char* BI = my + 9216; LAS unsigned char* KI = my + 11264; LAS float* CL = (LAS float*)(my + 13312);
    const size_t tok0 = (size_t)b * SEQ + (size_t)ch * RL;
    const f32x4 Z4 = (f32x4){0.f, 0.f, 0.f, 0.f};
    f32x4 S[4][4];
#pragma unroll
    for (int vt = 0; vt < 4; ++vt)
#pragma unroll
        for (int kt = 0; kt < 4; ++kt) {
            if (MODE == 1) { f32x4 x;
#pragma unroll
                for (int r = 0; r < 4; ++r) x[r] = (16 * vt + 4 * g + r == 16 * kt + fr) ? 1.f : 0.f;
                S[vt][kt] = x; }
            else if (MODE == 2 && ch > 0) { const float* src = PQ + ((size_t)((bh * RCH + ch - 1) * 2)) * 4096; f32x4 x;
#pragma unroll
                for (int r = 0; r < 4; ++r) x[r] = src[(16 * vt + 4 * g + r) * 64 + 16 * kt + fr];
                S[vt][kt] = x; }
            else S[vt][kt] = Z4; }
    float lng[4], lnb[4];
#pragma unroll
    for (int vt = 0; vt < 4; ++vt) { lng[vt] = MODE == 2 ? C.in[19][h * 64 + 16 * vt + fr] : 0.f; lnb[vt] = MODE == 2 ? C.in[20][h * 64 + 16 * vt + fr] : 0.f; }
    const bool strict[4] = {4 * g + 0 < fr, 4 * g + 1 < fr, 4 * g + 2 < fr, 4 * g + 3 < fr};
    const bool incl[4] = {4 * g + 0 <= fr, 4 * g + 1 <= fr, 4 * g + 2 <= fr, 4 * g + 3 <= fr};
    const int qq = fr >> 2, p2 = fr & 3;
#pragma unroll 1
    for (int sub = 0; sub < RL / 16; ++sub) {
        const size_t t0 = tok0 + (size_t)sub * 16; const size_t rowoff = (t0 + fr) * 512 + h * 64;
#pragma unroll
        for (int vt = 0; vt < 4; ++vt)
#pragma unroll
            for (int kt = 0; kt < 4; ++kt)
#pragma unroll
                for (int r = 0; r < 4; ++r) *(LAS bf16_t*)(SI + (4 * g) * 144 + 2 * fr + (16 * vt + r) * 144 + 32 * kt) = (bf16_t)f2bf(S[vt][kt][r]);
        bf16x8 kap[2], rtl[2]; float bcoef = 0.f;
        {
            float ssq = 0.f, bsum = 0.f; float kr[16];
#pragma unroll
            for (int k2 = 0; k2 < 2; ++k2) { const int c0 = 32 * k2 + 8 * g; float kv[8]; unpack8(*(const u32x4*)(pk + rowoff + c0), kv);
                const f32x4 kk0 = *(const f32x4*)(C.in[16] + h * 64 + c0), kk1 = *(const f32x4*)(C.in[16] + h * 64 + c0 + 4); const float kkc[8] = {kk0.x, kk0.y, kk0.z, kk0.w, kk1.x, kk1.y, kk1.z, kk1.w};
#pragma unroll
                for (int j = 0; j < 8; ++j) { kr[8 * k2 + j] = kv[j] * kkc[j]; ssq += kr[8 * k2 + j] * kr[8 * k2 + j]; } }
            ssq += __shfl_xor(ssq, 16); ssq += __shfl_xor(ssq, 32);
            const float rn = __builtin_amdgcn_rsqf(fmaxf(ssq, 1e-24f));
#pragma unroll
            for (int k2 = 0; k2 < 2; ++k2) { const int c0 = 32 * k2 + 8 * g; float ev[8], kv[8], aa[8], rv[8];
                __builtin_amdgcn_sched_barrier(0);
                unpack8(*(const u32x4*)(pe + rowoff + c0), ev); unpack8(*(const u32x4*)(pk + rowoff + c0), kv); unpack8(*(const u32x4*)(pa + rowoff + c0), aa);
                if (MODE == 2) unpack8(*(const u32x4*)(pr + rowoff + c0), rv);
                const f32x4 ka0 = *(const f32x4*)(C.in[17] + h * 64 + c0), ka1 = *(const f32x4*)(C.in[17] + h * 64 + c0 + 4); const float kac[8] = {ka0.x, ka0.y, ka0.z, ka0.w, ka1.x, ka1.y, ka1.z, ka1.w};
                float rkc[8];
                if (MODE == 2) { const f32x4 r0 = *(const f32x4*)(C.in[18] + h * 64 + c0), r1 = *(const f32x4*)(C.in[18] + h * 64 + c0 + 4); rkc[0] = r0.x; rkc[1] = r0.y; rkc[2] = r0.z; rkc[3] = r0.w; rkc[4] = r1.x; rkc[5] = r1.y; rkc[6] = r1.z; rkc[7] = r1.w; }
                float kt_[8], bt_[8], kxt_[8], rt_[8];
#pragma unroll
                for (int j = 0; j < 8; ++j) {
                    float c = ev[j]; c += dpp_f<0x111>(c); c += dpp_f<0x112>(c); c += dpp_f<0x114>(c); c += dpp_f<0x118>(c);
                    const float kx = kv[j] * (1.0f + (aa[j] - 1.0f) * kac[j]); const float kk = kr[8 * k2 + j] * rn;
                    const float e2 = __expf(c), e3 = __builtin_amdgcn_rcpf(e2), e1 = e3 * __expf(ev[j]);
                    kt_[j] = kk * e1; bt_[j] = kk * aa[j] * e2; kxt_[j] = kx * e2;
                    if (MODE == 2) { rt_[j] = rv[j] * e3; bsum += rv[j] * kx * rkc[j]; } else rt_[j] = 0.f;
                    if (fr == 15) CL[c0 + j] = c;
                }
                kap[k2] = __builtin_bit_cast(bf16x8, pack8(kt_)); if (MODE == 2) rtl[k2] = __builtin_bit_cast(bf16x8, pack8(rt_));
                *(LAS u32x4*)(BI + fr * 128 + 64 * k2 + 16 * g) = pack8(bt_); *(LAS u32x4*)(KI + fr * 128 + 64 * k2 + 16 * g) = pack8(kxt_);
            }
            if (MODE == 2) { bsum += __shfl_xor(bsum, 16); bsum += __shfl_xor(bsum, 32); bcoef = bsum; }
        }
        bf16x8 bet[2], kxf[2];
#pragma unroll
        for (int k2 = 0; k2 < 2; ++k2) { bet[k2] = *(const LAS bf16x8*)(BI + fr * 128 + 64 * k2 + 16 * g); kxf[k2] = *(const LAS bf16x8*)(KI + fr * 128 + 64 * k2 + 16 * g); }
        f32x4 VT[4];
#pragma unroll
        for (int vt = 0; vt < 4; ++vt) { f32x4 x = Z4;
            if (MODE != 1) {
#pragma unroll
                for (int jj = 0; jj < 4; ++jj) x[jj] = bf1(pv[(t0 + 4 * g + jj) * 512 + h * 64 + 16 * vt + fr]); }
            VT[vt] = x; }
        f32x4 AT = Z4, BmT = Z4, C1T = Z4, C2T = Z4;
#pragma unroll
        for (int k2 = 0; k2 < 2; ++k2) { AT = __builtin_amdgcn_mfma_f32_16x16x32_bf16(bet[k2], kap[k2], AT, 0, 0, 0);
            if (MODE != 1) BmT = __builtin_amdgcn_mfma_f32_16x16x32_bf16(kxf[k2], kap[k2], BmT, 0, 0, 0);
            if (MODE == 2) { C1T = __builtin_amdgcn_mfma_f32_16x16x32_bf16(bet[k2], rtl[k2], C1T, 0, 0, 0); C2T = __builtin_amdgcn_mfma_f32_16x16x32_bf16(kxf[k2], rtl[k2], C2T, 0, 0, 0); } }
#pragma unroll
        for (int r = 0; r < 4; ++r) { AT[r] = strict[r] ? AT[r] : 0.f; BmT[r] = strict[r] ? BmT[r] : 0.f; C1T[r] = incl[r] ? C1T[r] : 0.f; C2T[r] = incl[r] ? C2T[r] : 0.f; }
        float tr[16];
#pragma unroll
        for (int c = 15; c >= 0; --c) { float s = (c == fr) ? 1.f : 0.f;
#pragma unroll
            for (int j = c + 1; j < 16; ++j) { const float ajc = __builtin_bit_cast(float, __builtin_amdgcn_readlane(__builtin_bit_cast(int, AT[c & 3]), j + 16 * (c >> 2))); s = fmaf(-tr[j], ajc, s); }
            tr[c] = s; }
        f32x4 Tq;
#pragma unroll
        for (int jj = 0; jj < 4; ++jj) Tq[jj] = g == 0 ? tr[jj] : (g == 1 ? tr[4 + jj] : (g == 2 ? tr[8 + jj] : tr[12 + jj]));
        const bf16x8 Tf = frag_pack_lo(Tq), Bmf = frag_pack_lo(BmT), Cf = frag_pack(C1T, C2T);
        f32x4 Zt[4], Yt[4];
#pragma unroll
        for (int vt = 0; vt < 4; ++vt) {
            const int v = 16 * vt + fr;
            const bf16x8 s0 = *(const LAS bf16x8*)(SI + v * 144 + 16 * g), s1 = *(const LAS bf16x8*)(SI + v * 144 + 64 + 16 * g);
            f32x4 rhs = __builtin_amdgcn_mfma_f32_16x16x32_bf16(kap[0], s0, Z4, 0, 0, 0); rhs = __builtin_amdgcn_mfma_f32_16x16x32_bf16(kap[1], s1, rhs, 0, 0, 0);
            if (MODE != 1) rhs = __builtin_amdgcn_mfma_f32_16x16x32_bf16(Bmf, frag_pack_lo(VT[vt]), rhs, 0, 0, 0);
            f32x4 z = __builtin_amdgcn_mfma_f32_16x16x32_bf16(Tf, frag_pack_lo(rhs), Z4, 0, 0, 0);
            Zt[vt] = -z;
            if (MODE == 2) { f32x4 y = __builtin_amdgcn_mfma_f32_16x16x32_bf16(rtl[0], s0, Z4, 0, 0, 0); y = __builtin_amdgcn_mfma_f32_16x16x32_bf16(rtl[1], s1, y, 0, 0, 0);
                Yt[vt] = __builtin_amdgcn_mfma_f32_16x16x32_bf16(Cf, frag_pack(Zt[vt], VT[vt]), y, 0, 0, 0); }
        }
        {
            unsigned ad[8]; u32x2 dd[8];
#pragma unroll
            for (int kt = 0; kt < 4; ++kt) { const unsigned o = (unsigned)((4 * g + qq) * 128 + 2 * (16 * kt + 4 * p2)); ad[2 * kt] = myb + 9216 + o; ad[2 * kt + 1] = myb + 11264 + o; }
            tr_read8(ad, dd);
            float gl[4];
#pragma unroll
            for (int kt = 0; kt < 4; ++kt) gl[kt] = __expf(-CL[16 * kt + fr]);
#pragma unroll
            for (int vt = 0; vt < 4; ++vt) { const bf16x8 Af = frag_pack(Zt[vt], VT[vt]);
#pragma unroll
                for (int kt = 0; kt < 4; ++kt) { u32x4 bw; bw.x = dd[2 * kt].x; bw.y = dd[2 * kt].y; bw.z = dd[2 * kt + 1].x; bw.w = dd[2 * kt + 1].y;
                    S[vt][kt] = __builtin_amdgcn_mfma_f32_16x16x32_bf16(Af, __builtin_bit_cast(bf16x8, bw), S[vt][kt], 0, 0, 0) * gl[kt]; } }
        }
        if (MODE == 2) {
#pragma unroll
            for (int r = 0; r < 4; ++r) {
                const float mean = row_sum_f(Yt[0][r] + Yt[1][r] + Yt[2][r] + Yt[3][r]) * (1.0f / 64.0f);
                const float d0 = Yt[0][r] - mean, d1 = Yt[1][r] - mean, d2 = Yt[2][r] - mean, d3 = Yt[3][r] - mean;
                const float rstd = rsqrtf(row_sum_f(d0 * d0 + d1 * d1 + d2 * d2 + d3 * d3) * (1.0f / 64.0f) + 64e-5f);
                const float bc = __shfl(bcoef, 4 * g + r); const float dd_[4] = {d0, d1, d2, d3}; const size_t ro = (t0 + 4 * g + r) * 512 + h * 64 + fr;
#pragma unroll
                for (int vt = 0; vt < 4; ++vt) { const float gate = bf1(pg[ro + 16 * vt]); yo[ro + 16 * vt] = (bf16_t)f2bf((dd_[vt] * rstd * lng[vt] + lnb[vt] + bc * VT[vt][r]) * gate); }
            }
        }
    }
    if (MODE != 2) { float* dst = PQ + ((size_t)((bh * RCH + ch) * 2 + MODE)) * 4096;
#pragma unroll
        for (int vt = 0; vt < 4; ++vt)
#pragma unroll
            for (int kt = 0; kt < 4; ++kt)
#pragma unroll
                for (int r = 0; r < 4; ++r) dst[(16 * vt + 4 * g + r) * 64 + 16 * kt + fr] = S[vt][kt][r]; }
}
__device__ __forceinline__ void p4_rwkv_pass1(const Ctx& C) {
    for (int task = C.gw; task < 32 * (RCH - 1) * 2; task += C.ngw) { const int mode = task & 1, rr = task >> 1, ch = rr % (RCH - 1), bh = rr / (RCH - 1);
        if (mode == 0) rwm_task<0>(C, bh, ch); else rwm_task<1>(C, bh, ch); }
}
__device__ __forceinline__ void p6_rwkv_pass3(const Ctx& C) {
    for (int task = C.gw; task < 32 * RCH; task += C.ngw) rwm_task<2>(C, task / RCH, task % RCH);
}
__device__ __forceinline__ void p5_rwkv_carry(const Ctx& C) {
    float* PQ = (float*)(C.dout + DO_PQ); const int lane = C.lane, wave = C.wave, tid = C.tid;
    LAS float* ST = (LAS float*)C.lds;
    LAS float* PL = (LAS float*)(C.lds + 32768);
    for (int bh = blockIdx.x; bh < 32; bh += C.G) {
        for (int i = tid; i < 4096; i += NTHREADS) ST[i] = 0.f;
        const float* base = PQ + (size_t)(bh * RCH) * 2 * 4096;
        f32x4 pa = *(const f32x4*)(base + 4096 + tid * 8), pb = *(const f32x4*)(base + 4096 + tid * 8 + 4);
        f32x4 q0 = *(const f32x4*)(base + lane * 64 + 8 * wave), q1 = *(const f32x4*)(base + lane * 64 + 8 * wave + 4);
        __syncthreads();
        for (int ch = 0; ch < RCH - 1; ++ch) {
            LAS float* cur = ST + (ch & 1) * 4096; LAS float* nxt = ST + ((ch + 1) & 1) * 4096;
            float* Q = PQ + ((size_t)((bh * RCH + ch) * 2)) * 4096;
            *(LAS f32x4*)(PL + tid * 8) = pa; *(LAS f32x4*)(PL + tid * 8 + 4) = pb;
            float acc[8] = {q0.x, q0.y, q0.z, q0.w, q1.x, q1.y, q1.z, q1.w};
            __syncthreads();
            const int cn = ch + 1 < RCH - 1 ? ch + 1 : ch; const float* nb = PQ + ((size_t)((bh * RCH + cn) * 2)) * 4096;
            pa = *(const f32x4*)(nb + 4096 + tid * 8); pb = *(const f32x4*)(nb + 4096 + tid * 8 + 4);
            q0 = *(const f32x4*)(nb + lane * 64 + 8 * wave); q1 = *(const f32x4*)(nb + lane * 64 + 8 * wave + 4);
#pragma unroll 8
            for (int j = 0; j < 64; ++j) { const float sj = cur[j * 64 + lane]; const f32x4 p0 = *(const LAS f32x4*)(PL + j * 64 + 8 * wave), p1 = *(const LAS f32x4*)(PL + j * 64 + 8 * wave + 4);
                acc[0] = fmaf(sj, p0.x, acc[0]); acc[1] = fmaf(sj, p0.y, acc[1]); acc[2] = fmaf(sj, p0.z, acc[2]); acc[3] = fmaf(sj, p0.w, acc[3]);
                acc[4] = fmaf(sj, p1.x, acc[4]); acc[5] = fmaf(sj, p1.y, acc[5]); acc[6] = fmaf(sj, p1.z, acc[6]); acc[7] = fmaf(sj, p1.w, acc[7]); }
            *(f32x4*)(Q + lane * 64 + 8 * wave) = (f32x4){acc[0], acc[1], acc[2], acc[3]}; *(f32x4*)(Q + lane * 64 + 8 * wave + 4) = (f32x4){acc[4], acc[5], acc[6], acc[7]};
#pragma unroll
            for (int kk = 0; kk < 8; ++kk) nxt[(8 * wave + kk) * 64 + lane] = acc[kk];
            __syncthreads();
        }
    }
}

__device__ __forceinline__ void p8_ln1(const Ctx& C) {
    const float* pre = (const float*)C.dout; float* x1 = (float*)(C.ws + WS_X1); bf16_t* x1b = (bf16_t*)(C.ws + WS_X1B); const int lane = C.lane;
    const float* gam = C.in[26]; const float* bet = C.in[27];
    for (int t = C.gw; t < T; t += C.ngw) {
        const float* p = pre + (size_t)t * 1024; float v[16];
#pragma unroll
        for (int hh = 0; hh < 2; ++hh) { const f32x4 a = *(const f32x4*)(p + hh * 512 + 8 * lane), b = *(const f32x4*)(p + hh * 512 + 8 * lane + 4);
            v[8 * hh] = a.x; v[8 * hh + 1] = a.y; v[8 * hh + 2] = a.z; v[8 * hh + 3] = a.w; v[8 * hh + 4] = b.x; v[8 * hh + 5] = b.y; v[8 * hh + 6] = b.z; v[8 * hh + 7] = b.w; }
        float s = 0.f;
#pragma unroll
        for (int j = 0; j < 16; ++j) s += v[j];
        const float mean = wave_sum(s) * (1.0f / 1024.0f); float s2 = 0.f;
#pragma unroll
        for (int j = 0; j < 16; ++j) { v[j] -= mean; s2 += v[j] * v[j]; }
        const float rstd = rsqrtf(wave_sum(s2) * (1.0f / 1024.0f) + 1e-5f);
#pragma unroll
        for (int hh = 0; hh < 2; ++hh) { const int c0 = hh * 512 + 8 * lane; float o[8];
#pragma unroll
            for (int j = 0; j < 8; ++j) o[j] = v[8 * hh + j] * rstd * gam[c0 + j] + bet[c0 + j];
            *(f32x4*)(x1 + (size_t)t * 1024 + c0) = (f32x4){o[0], o[1], o[2], o[3]}; *(f32x4*)(x1 + (size_t)t * 1024 + c0 + 4) = (f32x4){o[4], o[5], o[6], o[7]};
            *(u32x4*)(x1b + (size_t)t * 1024 + c0) = pack8(o); }
    }
    cvt_rows_fp8(C.in[30], C.ws + WS_UB, (size_t)16384 * 1024 / 16, PEER_U_SCALE, C.gt, C.ngt);
    cvt_rows_fp8(C.in[31], C.ws + WS_VB, (size_t)16384 * 1024 / 16, PEER_V_SCALE, C.gt, C.ngt);
}

#define CE_DESC(a, b) do { const unsigned hi_ = k[a] > k[b] ? k[a] : k[b], lo_ = k[a] > k[b] ? k[b] : k[a]; k[a] = hi_; k[b] = lo_; } while (0)
__device__ __forceinline__ unsigned pop16_of8(unsigned (&k)[8], int fr) {
    CE_DESC(0, 1); CE_DESC(2, 3); CE_DESC(4, 5); CE_DESC(6, 7); CE_DESC(0, 2); CE_DESC(1, 3); CE_DESC(4, 6); CE_DESC(5, 7); CE_DESC(1, 2); CE_DESC(5, 6);
    CE_DESC(0, 4); CE_DESC(1, 5); CE_DESC(2, 6); CE_DESC(3, 7); CE_DESC(2, 4); CE_DESC(3, 5); CE_DESC(1, 2); CE_DESC(3, 4); CE_DESC(5, 6);
    unsigned res = 0u;
#pragma unroll
    for (int rd = 0; rd < 16; ++rd) {
        const unsigned m = row_max_u(k[0]); const bool mine = (k[0] == m);
#pragma unroll
        for (int j = 0; j < 7; ++j) k[j] = mine ? k[j + 1] : k[j];
        k[7] = mine ? 0u : k[7];
        res = (fr == rd) ? m : res;
    }
    return res;
}
__device__ __forceinline__ unsigned pop16_of4(unsigned (&k)[4], int fr) {
    CE_DESC(0, 1); CE_DESC(2, 3); CE_DESC(0, 2); CE_DESC(1, 3); CE_DESC(1, 2);
    unsigned res = 0u;
#pragma unroll
    for (int rd = 0; rd < 16; ++rd) {
        const unsigned m = row_max_u(k[0]); const bool mine = (k[0] == m);
        k[0] = mine ? k[1] : k[0]; k[1] = mine ? k[2] : k[1]; k[2] = mine ? k[3] : k[2]; k[3] = mine ? 0u : k[3];
        res = (fr == rd) ? m : res;
    }
    return res;
}
__device__ const unsigned char CAND_AB[64] = {
    0x00, 0x01, 0x02, 0x03, 0x04, 0x05, 0x06, 0x07, 0x08, 0x09, 0x0a, 0x0b, 0x0c, 0x0d, 0x0e, 0x0f,
    0x10, 0x11, 0x12, 0x13, 0x14, 0x15, 0x16, 0x17, 0x20, 0x21, 0x22, 0x23, 0x24, 0x30, 0x31, 0x32,
    0x33, 0x40, 0x41, 0x42, 0x50, 0x51, 0x60, 0x61, 0x70, 0x71, 0x80, 0x90, 0xa0, 0xb0, 0xc0, 0xd0,
    0xe0, 0xf0, 0xff, 0xff, 0xff, 0xff, 0xff, 0xff, 0xff, 0xff, 0xff, 0xff, 0xff, 0xff, 0xff, 0xff};
__device__ __forceinline__ void p10_peer_route(const Ctx& C) {
    unsigned char* ws = C.ws; const int lane = C.lane, g = lane >> 4, fr = lane & 15;
    const bf16_t* qp = (const bf16_t*)C.dout; const bf16_t* keys = (const bf16_t*)(ws + WS_KEYS);
    int* experts = (int*)(ws + WS_EXPERTS); float* pgates = (float*)(ws + WS_PGATES);
    const unsigned cand4 = *(const unsigned*)(CAND_AB + 4 * fr);
    LAS unsigned char* KL = C.lds;
#pragma unroll
    for (int pp = 0; pp < 8; ++pp) { const int p = C.wave + 8 * pp; const int row = 4 * p + g; const int c = fr ^ (2 * (row & 7));
        __builtin_amdgcn_global_load_lds((const unsigned*)((const char*)keys + row * 256 + 16 * c), (LAS unsigned*)(KL + 1024 * p), 16, 0, 0); }
    asm volatile("s_waitcnt vmcnt(0)" ::: "memory");
    __syncthreads();
    for (int task = C.gw; task < T / 2; task += C.ngw) {
        const int t0 = task * 2;
        unsigned sel[2][4];
#pragma unroll
        for (int p = 0; p < 2; ++p) {
            bf16x8 A[4];
#pragma unroll
            for (int kk = 0; kk < 4; ++kk) A[kk] = *(const bf16x8*)(qp + (size_t)(t0 + (fr >> 3)) * 2048 + (fr & 7) * 256 + p * 128 + 32 * kk + 8 * g);
            f32x4 acc[8];
#pragma unroll
            for (int i = 0; i < 8; ++i) { if ((i & 1) == 0) __builtin_amdgcn_sched_barrier(0); acc[i] = (f32x4){0.f, 0.f, 0.f, 0.f};
#pragma unroll
                for (int kk = 0; kk < 4; ++kk) { const int row = p * 128 + 16 * i + fr; const bf16x8 Bk = *(const LAS bf16x8*)(KL + row * 256 + 16 * ((4 * kk + g) ^ (2 * (row & 7))));
                    acc[i] = __builtin_amdgcn_mfma_f32_16x16x32_bf16(A[kk], Bk, acc[i], 0, 0, 0); } }
#pragma unroll
            for (int r = 0; r < 4; ++r) { __builtin_amdgcn_sched_barrier(0); unsigned k[8];
#pragma unroll
                for (int i = 0; i < 8; ++i) k[i] = (f2key(acc[i][r]) & 0xffffff80u) | (unsigned)(16 * i + fr);
                sel[p][r] = pop16_of8(k, fr); }
        }
#pragma unroll
        for (int r = 0; r < 4; ++r) {
            __builtin_amdgcn_sched_barrier(0);
            const float s1 = key2f(sel[0][r] & 0xffffff80u), s2 = key2f(sel[1][r] & 0xffffff80u);
            unsigned k[4];
#pragma unroll
            for (int j = 0; j < 4; ++j) {
                const unsigned ab = (cand4 >> (8 * j)) & 0xffu; const unsigned msk = ab == 0xffu ? 0u : 0xffffffffu;
                const float va = __builtin_bit_cast(float, __builtin_amdgcn_ds_bpermute((int)(4u * (16u * g + (ab >> 4))), __builtin_bit_cast(int, s1)));
                const float vb = __builtin_bit_cast(float, __builtin_amdgcn_ds_bpermute((int)(4u * (16u * g + (ab & 15u))), __builtin_bit_cast(int, s2)));
                k[j] = ((f2key(va + vb) & 0xffffff00u) | ab) & msk;
            }
            const unsigned top = pop16_of4(k, fr);
            const int a = (int)((top >> 4) & 15u), b = (int)(top & 15u);
            const int i1 = __builtin_amdgcn_ds_bpermute(4 * (16 * g + a), (int)(sel[0][r] & 0x7fu));
            const int i2 = __builtin_amdgcn_ds_bpermute(4 * (16 * g + b), (int)(sel[1][r] & 0x7fu));
            const float sc = key2f(top & 0xffffff00u);
            const float mx = key2f(row_max_u(top) & 0xffffff00u);
            const float ev = __expf(sc - mx); const float sm = row_sum_f(ev);
            const int row = 4 * g + r; const size_t o = (size_t)(t0 + (row >> 3)) * 128 + (row & 7) * 16 + fr;
            experts[o] = i1 * 128 + i2; pgates[o] = ev / sm;
        }
    }
}
#undef CE_DESC

__device__ __forceinline__ float gelu_erf(float x) { return 0.5f * x * (1.0f + erff(x * 0.7071067811865476f)); }
typedef __bf16 bf2_t __attribute__((ext_vector_type(2)));
__device__ __forceinline__ unsigned fp8x2_to_bf16x2(unsigned w, bool hi) { return hi ? __builtin_bit_cast(unsigned, __builtin_amdgcn_cvt_scalef32_pk_bf16_fp8(w, 1.0f, true)) : __builtin_bit_cast(unsigned, __builtin_amdgcn_cvt_scalef32_pk_bf16_fp8(w, 1.0f, false)); }
__device__ __forceinline__ void p11_peer_experts(const Ctx& C) {
    unsigned char* ws = C.ws; const int lane = C.lane, g = lane >> 4, fr = lane & 15;
    const bf16_t* x1b = (const bf16_t*)(ws + WS_X1B); const float* x1 = (const float*)(ws + WS_X1);
    const unsigned char* ub = ws + WS_UB; const unsigned char* vb = ws + WS_VB;
    const int* experts = (const int*)(ws + WS_EXPERTS); const float* pgates = (const float*)(ws + WS_PGATES);
    float* out = (float*)C.dout; const float* gam = C.in[32]; const float* bet = C.in[33];
    LAS unsigned char* my = C.lds + C.wave * 4096;
    LAS float* cf = (LAS float*)(my + 2048); LAS int* eidl = (LAS int*)(my + 2560);
    for (int t = C.gw; t < T; t += C.ngw) {
        { const u32x4 a = *(const u32x4*)(x1b + (size_t)t * 1024 + 16 * lane), b = *(const u32x4*)(x1b + (size_t)t * 1024 + 16 * lane + 8);
          *(LAS u32x4*)(my + 32 * lane) = a; *(LAS u32x4*)(my + 32 * lane + 16) = b; }
        { const int e0 = experts[(size_t)t * 128 + lane], e1 = experts[(size_t)t * 128 + 64 + lane]; eidl[lane] = e0; eidl[64 + lane] = e1; }
        asm volatile("s_waitcnt lgkmcnt(0)" ::: "memory");
#pragma unroll 1
        for (int i = 0; i < 8; ++i) {
            const int e = eidl[16 * i + fr]; const unsigned char* urow = ub + (size_t)e * 1024 + 16 * g;
            f32x4 acc = (f32x4){0.f, 0.f, 0.f, 0.f};
#pragma unroll 8
            for (int m = 0; m < 16; ++m) {
                const u32x4 raw = *(const u32x4*)(urow + 64 * m);
                u32x4 a0, a1; a0.x = fp8x2_to_bf16x2(raw.x, false); a0.y = fp8x2_to_bf16x2(raw.x, true); a0.z = fp8x2_to_bf16x2(raw.y, false); a0.w = fp8x2_to_bf16x2(raw.y, true);
                a1.x = fp8x2_to_bf16x2(raw.z, false); a1.y = fp8x2_to_bf16x2(raw.z, true); a1.z = fp8x2_to_bf16x2(raw.w, false); a1.w = fp8x2_to_bf16x2(raw.w, true);
                const bf16x8 b0 = *(const LAS bf16x8*)(my + 2 * (64 * m + 16 * g)), b1 = *(const LAS bf16x8*)(my + 2 * (64 * m + 16 * g + 8));
                acc = __builtin_amdgcn_mfma_f32_16x16x32_bf16(__builtin_bit_cast(bf16x8, a0), b0, acc, 0, 0, 0);
                acc = __builtin_amdgcn_mfma_f32_16x16x32_bf16(__builtin_bit_cast(bf16x8, a1), b1, acc, 0, 0, 0);
            }
            const f32x4 pg = *(const f32x4*)(pgates + (size_t)t * 128 + 16 * i + 4 * g);
            constexpr float us = 1.0f / PEER_U_SCALE, vs = 1.0f / PEER_V_SCALE;
            if (fr == 0) { *(LAS f32x4*)(cf + 16 * i + 4 * g) = (f32x4){vs * pg.x * gelu_erf(acc[0] * us), vs * pg.y * gelu_erf(acc[1] * us), vs * pg.z * gelu_erf(acc[2] * us), vs * pg.w * gelu_erf(acc[3] * us)}; }
        }
        asm volatile("s_waitcnt lgkmcnt(0)" ::: "memory");
        float o[16];
#pragma unroll
        for (int j = 0; j < 16; ++j) o[j] = 0.f;
#pragma unroll 8
        for (int k = 0; k < 128; ++k) {
            const int e = __builtin_amdgcn_readfirstlane(eidl[k]); const float c = cf[k];
            const u32x4 raw = *(const u32x4*)(vb + (size_t)e * 1024 + 16 * lane);
            const unsigned rw[4] = {raw.x, raw.y, raw.z, raw.w};
#pragma unroll
            for (int j = 0; j < 4; ++j) { const f32x2 lo = __builtin_amdgcn_cvt_pk_f32_fp8((int)rw[j], false), hi = __builtin_amdgcn_cvt_pk_f32_fp8((int)rw[j], true);
                o[4 * j] = fmaf(c, lo.x, o[4 * j]); o[4 * j + 1] = fmaf(c, lo.y, o[4 * j + 1]); o[4 * j + 2] = fmaf(c, hi.x, o[4 * j + 2]); o[4 * j + 3] = fmaf(c, hi.y, o[4 * j + 3]); }
        }
        float s = 0.f; const float* xp = x1 + (size_t)t * 1024 + 16 * lane;
#pragma unroll
        for (int q = 0; q < 4; ++q) { const f32x4 a = *(const f32x4*)(xp + 4 * q); o[4 * q] += ALPHA * a.x; o[4 * q + 1] += ALPHA * a.y; o[4 * q + 2] += ALPHA * a.z; o[4 * q + 3] += ALPHA * a.w; }
#pragma unroll
        for (int j = 0; j < 16; ++j) s += o[j];
        const float mean = wave_sum(s) * (1.0f / 1024.0f); float s2 = 0.f;
#pragma unroll
        for (int j = 0; j < 16; ++j) { o[j] -= mean; s2 += o[j] * o[j]; }
        const float rstd = rsqrtf(wave_sum(s2) * (1.0f / 1024.0f) + 1e-5f);
#pragma unroll
        for (int q = 0; q < 4; ++q) { const int c0 = 16 * lane + 4 * q; const f32x4 gm = *(const f32x4*)(gam + c0), bt = *(const f32x4*)(bet + c0);
            *(f32x4*)(out + (size_t)t * 1024 + c0) = (f32x4){o[4 * q] * rstd * gm.x + bt.x, o[4 * q + 1] * rstd * gm.y + bt.y, o[4 * q + 2] * rstd * gm.z + bt.z, o[4 * q + 3] * rstd * gm.w + bt.w}; }
    }
}

constexpr int LDS_BYTES = 147456;
constexpr int LDS_MISC = 131072;
constexpr int NPHASE = 14;
constexpr int CW_BAR = 4096;

__global__ void __launch_bounds__(NTHREADS, 2) hybrid_fwd(Args args) {
    extern __shared__ __attribute__((aligned(16))) unsigned char lds_raw[];
    Ctx C;
    C.lds = (LAS unsigned char*)lds_raw;
    C.tid = threadIdx.x; C.lane = C.tid & 63; C.wave = __builtin_amdgcn_readfirstlane(C.tid >> 6);
    C.G = gridDim.x; C.gw = blockIdx.x * NWAVES + C.wave; C.ngw = C.G * NWAVES; C.gt = blockIdx.x * NTHREADS + C.tid; C.ngt = C.G * NTHREADS;
    C.in = args.in; C.ws = args.ws; C.dout = (unsigned char*)args.out;
    unsigned char* ws = args.ws; const float* const* in = args.in;
    volatile LAS unsigned* MISC = (volatile LAS unsigned*)(C.lds + LDS_MISC);
    if (C.tid < 64) MISC[C.tid] = 0u;
    __syncthreads();
    XcdBarrier bar; bar.bar = (unsigned*)(ws + WS_CTL) + CW_BAR; bar.x = 0; bar.st = nullptr;
    if (MK_N_LAUNCHES == 1) bar = xcd_barrier_post((unsigned*)(ws + WS_CTL) + CW_BAR, MISC + 8);
    const int lo = args.ph_lo, hi = args.ph_hi;
#define IN(k) (lo <= (k) && (k) < hi)
#define SEAM(k) do { if (IN(k) && IN((k) + 1)) xcd_barrier(bar); } while (0)
#define REP(k) for (int rep_ = 0; rep_ < (((PROBE_MASK >> (k)) & 1) ? 2 : 1); ++rep_)
    bf16_t* xb = (bf16_t*)(C.dout + DO_XB);

    if (IN(0)) REP(0) { p0_prologue(C); } SEAM(0);
    if (IN(1)) REP(1) {
        { pg8::Gemm gm{xb, (const bf16_t*)(ws + WS_WIN), T, 2816, 1024}; pg8::StaticOrder S; S.init(T, 2816, C.G, (int)blockIdx.x);
          EpiP1 E{(float*)(ws + WS_CSMALL), (bf16_t*)(ws + WS_RCOLS), (bf16_t*)(ws + WS_MEMQ)}; pg8::gemm_phase(C.lds, gm, S, E); }
        {
          const int nfull = (T / 256) * 11 % C.G; const int c2 = ((int)blockIdx.x - nfull + C.G) % C.G;
          pg8::Gemm gm{(const bf16_t*)(ws + WS_MEMB), (const bf16_t*)(ws + WS_WMEMKV), 1024, 1024, 1024}; pg8::StaticOrder S; S.init(1024, 1024, C.G, c2);
          EpiMemKV E{(bf16_t*)(ws + WS_KMEM), (bf16_t*)(ws + WS_VMEMT)}; pg8::gemm_phase(C.lds, gm, S, E); }
    } SEAM(1);
    if (IN(2)) REP(2) { p2_prep(C); } SEAM(2);
    if (IN(3)) REP(3) {
        { pg8::Gemm gm{(const bf16_t*)(ws + WS_LORAA), (const bf16_t*)(ws + WS_WLORA), T, 1536, 256}; pg8::StaticOrder S; S.init(T, 1536, C.G, (int)blockIdx.x);
          EpiLora E{(bf16_t*)(ws + WS_RW_E), (bf16_t*)(ws + WS_RW_A), (bf16_t*)(ws + WS_RW_G), in[11], in[13]}; pg8::gemm_phase(C.lds, gm, S, E); }
        { pg8::Gemm gm{(const bf16_t*)(ws + WS_CQN), (const bf16_t*)(ws + WS_WQ), T, 1280, 256}; pg8::StaticOrder S; S.init(T, 1280, C.G, C.G - 1 - (int)blockIdx.x);
          EpiQ E{(bf16_t*)(ws + WS_QLAT), (bf16_t*)(ws + WS_QIDX)}; pg8::gemm_phase(C.lds, gm, S, E); }
    } SEAM(3);
    if (IN(4)) { REP(14) { p4_indexer(C); } REP(15) { p4_memattn(C); } __syncthreads(); REP(16) { p4_rwkv_pass1(C); } } SEAM(4);
    if (IN(5)) { p5_rwkv_carry(C); __syncthreads(); REP(5) { p5_dsa_attn(C, rep_); } } SEAM(5);
    if (IN(6)) REP(6) { p6_rwkv_pass3(C); p6_late_weights(C); } SEAM(6);
    if (IN(7)) REP(7) {
        pg8::Gemm gm{xb, (const bf16_t*)(ws + WS_WG), T, 3072, 1024}; pg8::StaticOrder S; S.init(T, 3072, C.G, (int)blockIdx.x);
        EpiGates E{(bf16_t*)(ws + WS_GATES)}; pg8::gemm_phase(C.lds, gm, S, E);
    } SEAM(7);
    if (IN(8)) REP(8) {
        float* mf = (float*)C.dout; const bf16_t* gt = (const bf16_t*)(ws + WS_GATES); bf16_t* mb = (bf16_t*)(ws + WS_MERGEDB);
        { pg8::Gemm gm{(const bf16_t*)(ws + WS_OLAT), (const bf16_t*)(ws + WS_WOV), T, 1024, 1024}; pg8::StaticOrder S; S.init(T, 1024, C.G, (int)blockIdx.x);
          EpiMerge<0> E{gt, mf, mb}; pg8::gemm_phase(C.lds, gm, S, E); }
        { pg8::Gemm gm{(const bf16_t*)(ws + WS_YRWKV), (const bf16_t*)(ws + WS_WBRR), T, 1024, 512}; pg8::StaticOrder S; S.init(T, 1024, C.G, (int)blockIdx.x);
          EpiMerge<1> E{gt, mf, mb}; pg8::gemm_phase(C.lds, gm, S, E); }
        { pg8::Gemm gm{(const bf16_t*)(ws + WS_YMEM), (const bf16_t*)(ws + WS_WBRM), T, 1024, 512}; pg8::StaticOrder S; S.init(T, 1024, C.G, (int)blockIdx.x);
          EpiMerge<2> E{gt, mf, mb}; pg8::gemm_phase(C.lds, gm, S, E); }
    } SEAM(8);
    if (IN(9)) REP(9) {
        pg8::Gemm gm{(const bf16_t*)(ws + WS_MERGEDB), (const bf16_t*)(ws + WS_WOUT), T, 1024, 1024}; pg8::StaticOrder S; S.init(T, 1024, C.G, (int)blockIdx.x);
        EpiWout E{in[0], (float*)C.dout}; pg8::gemm_phase(C.lds, gm, S, E);
    } SEAM(9);
    if (IN(10)) REP(10) { p8_ln1(C); } SEAM(10);
    if (IN(11)) REP(11) {
        pg8::Gemm gm{(const bf16_t*)(ws + WS_X1B), (const bf16_t*)(ws + WS_WPEER), T, 2048, 1024}; pg8::StaticOrder S; S.init(T, 2048, C.G, (int)blockIdx.x);
        EpiPeerQ E{(bf16_t*)C.dout}; pg8::gemm_phase(C.lds, gm, S, E);
    } SEAM(11);
    if (IN(12)) REP(12) { p10_peer_route(C); } SEAM(12);
    if (IN(13)) REP(13) { p11_peer_experts(C); }
#undef IN
#undef SEAM
}

extern "C" void kernel_launch(void* const* d_in, const int* in_sizes, int n_in, void* d_out, int out_size, void* d_ws, size_t ws_size, hipStream_t stream) {
    static int grid = 0;
    if (grid == 0) {
        if (n_in != 34 || out_size != T * D || ws_size < WS_END) { fprintf(stderr, "kernel_launch: unexpected problem (n_in %d out %d ws %zu)\n", n_in, out_size, ws_size); grid = -1; return; }
        int dev = 0, cus = 0, per_cu = 0;
        if (hipGetDevice(&dev) != hipSuccess || hipDeviceGetAttribute(&cus, hipDeviceAttributeMultiprocessorCount, dev) != hipSuccess) { grid = -1; return; }
        if (hipFuncSetAttribute((const void*)hybrid_fwd, hipFuncAttributeMaxDynamicSharedMemorySize, LDS_BYTES) != hipSuccess) { fprintf(stderr, "kernel_launch: hipFuncSetAttribute failed\n"); grid = -1; return; }
        if (hipOccupancyMaxActiveBlocksPerMultiprocessor(&per_cu, (const void*)hybrid_fwd, NTHREADS, LDS_BYTES) != hipSuccess || per_cu < 1) { fprintf(stderr, "kernel_launch: occupancy query says %d\n", per_cu); }
        (void)hipGetLastError();
        grid = cus;
    }
    if (grid < 0) return;
    (void)hipMemsetAsync((char*)d_ws + WS_CTL, 0, 1 * MiB, stream);
    Args a{};
    for (int i = 0; i < 34; ++i) a.in[i] = (const float*)d_in[i];
    a.out = (float*)d_out; a.ws = (unsigned char*)d_ws; a.li = 0; a.pad = 0;
    if (MK_N_LAUNCHES == 1) { a.ph_lo = 0; a.ph_hi = NPHASE; hipLaunchKernelGGL(hybrid_fwd, dim3(grid), dim3(NTHREADS), LDS_BYTES, stream, a); }
    else for (int p = 0; p < NPHASE; ++p) { a.ph_lo = p; a.ph_hi = p + 1; a.li = p; hipLaunchKernelGGL(hybrid_fwd, dim3(grid), dim3(NTHREADS), LDS_BYTES, stream, a); }
}
```

```cpp
#include <hip/hip_runtime.h>
#include <stdint.h>
#include <stdio.h>

#ifndef MK_N_LAUNCHES
#define MK_N_LAUNCHES 1
#endif

#ifndef PROBE_MASK
#define PROBE_MASK 0
#endif
#define LAS __attribute__((address_space(3)))
typedef unsigned short bf16_t;
typedef const __attribute__((address_space(1))) float* gfp;
#define G_(p) ((gfp)(p))
typedef short bf16x8 __attribute__((ext_vector_type(8)));
typedef float f32x4 __attribute__((ext_vector_type(4)));
typedef float f32x2 __attribute__((ext_vector_type(2)));
typedef unsigned u32x4 __attribute__((ext_vector_type(4)));
typedef unsigned u32x2 __attribute__((ext_vector_type(2)));

constexpr int NB = 4, SEQ = 4096, T = NB * SEQ, D = 1024;
constexpr int IN_W = 5800;
constexpr int RW = 512;
constexpr int NWAVES = 8, NTHREADS = 512;
constexpr float ALPHA = 1.189207115002721f;
constexpr int RCH = 32, RL = SEQ / RCH;

constexpr size_t MiB = 1u << 20;
constexpr size_t WS_CTL = 0;
constexpr size_t WS_WIN = 1 * MiB, WS_WG = 7 * MiB, WS_WLORA = 13 * MiB, WS_WQ = 14 * MiB, WS_WMEMKV = 15 * MiB, WS_WOV = 17 * MiB,
                 WS_WBRR = 19 * MiB, WS_WBRM = 20 * MiB, WS_WOUT = 21 * MiB, WS_WPEER = 23 * MiB, WS_KEYS = 27 * MiB;
constexpr size_t WS_CSMALL = 29 * MiB, WS_QLAT = 29 * MiB, WS_MERGEDB = 29 * MiB, WS_UB = 29 * MiB;
constexpr size_t WS_RCOLS = 61 * MiB, WS_QIDX = 61 * MiB, WS_YMEM = 69 * MiB, WS_OLAT = 85 * MiB, WS_VB = 61 * MiB, WS_EXPERTS = 93 * MiB, WS_PGATES = 101 * MiB;
constexpr size_t WS_MEMQ = 117 * MiB, WS_YRWKV = 117 * MiB;
constexpr size_t WS_RW_R = 133 * MiB, WS_RW_K = 149 * MiB, WS_RW_V = 165 * MiB, WS_RW_A = 181 * MiB, WS_RW_E = 197 * MiB, WS_RW_G = 213 * MiB;
constexpr size_t WS_GATES = 133 * MiB, WS_X1B = 133 * MiB, WS_X1 = 165 * MiB;
constexpr size_t WS_CQN = 229 * MiB, WS_KVL = 237 * MiB, WS_KIDX = 241 * MiB, WS_WIDX = 242 * MiB, WS_LORAA = 243 * MiB, WS_IDX = 243 * MiB,
                 WS_KMEM = 251 * MiB, WS_VMEMT = 252 * MiB, WS_MEMB = 253 * MiB, WS_END = 256 * MiB;
constexpr size_t DO_XB = 0, DO_PQ = 32 * MiB;
constexpr size_t WS_XB2 = 29 * MiB;
constexpr int CW_DSAQ = 64;

typedef __bf16 bf2_hw __attribute__((ext_vector_type(2)));
__device__ __forceinline__ unsigned f2bf(float f) { return (unsigned)__builtin_bit_cast(unsigned short, (__bf16)f); }
__device__ __forceinline__ unsigned pk2(float lo, float hi) { bf2_hw r; r.x = (__bf16)lo; r.y = (__bf16)hi; return __builtin_bit_cast(unsigned, r); }
__device__ __forceinline__ float bflo(unsigned w) { return __uint_as_float(w << 16); }
__device__ __forceinline__ float bfhi(unsigned w) { return __uint_as_float(w & 0xffff0000u); }
__device__ __forceinline__ float bf1(bf16_t h) { return __uint_as_float(((unsigned)h) << 16); }
template <int CTRL, int RM = 0xF> __device__ __forceinline__ float dpp_f(float v) { return __builtin_bit_cast(float, __builtin_amdgcn_update_dpp(0, __builtin_bit_cast(int, v), CTRL, RM, 0xF, false)); }
template <int CTRL> __device__ __forceinline__ unsigned dpp_u(unsigned v) { return (unsigned)__builtin_amdgcn_update_dpp(0, (int)v, CTRL, 0xF, 0xF, false); }
__device__ __forceinline__ float wave_sum(float v) {
    v += dpp_f<0x111>(v); v += dpp_f<0x112>(v); v += dpp_f<0x114>(v); v += dpp_f<0x118>(v);
    v += dpp_f<0x142, 0xA>(v); v += dpp_f<0x143, 0xC>(v);
    return __builtin_bit_cast(float, __builtin_amdgcn_readlane(__builtin_bit_cast(int, v), 63));
}
__device__ __forceinline__ unsigned row_max_u(unsigned x) {
    unsigned y = dpp_u<0x128>(x); x = x > y ? x : y; y = dpp_u<0x124>(x); x = x > y ? x : y; y = dpp_u<0x122>(x); x = x > y ? x : y; y = dpp_u<0x121>(x); x = x > y ? x : y; return x; }
__device__ __forceinline__ float row_sum_f(float x) { x += dpp_f<0x128>(x); x += dpp_f<0x124>(x); x += dpp_f<0x122>(x); x += dpp_f<0x121>(x); return x; }
__device__ __forceinline__ float key2f(unsigned k) { const unsigned b = (k & 0x80000000u) ? (k & 0x7fffffffu) : ~k; return __uint_as_float(b); }
__device__ __forceinline__ float sigmoidf_(float x) { return 1.0f / (1.0f + __expf(-x)); }
__device__ __forceinline__ unsigned f2key(float f) { unsigned b = __float_as_uint(f); if (f == 0.0f) b = 0u; return (b & 0x80000000u) ? ~b : (b | 0x80000000u); }
__device__ __forceinline__ u32x4 pack8(const float* v) { u32x4 w; w.x = pk2(v[0], v[1]); w.y = pk2(v[2], v[3]); w.z = pk2(v[4], v[5]); w.w = pk2(v[6], v[7]); return w; }
__device__ __forceinline__ void unpack8(u32x4 w, float* v) { v[0] = bflo(w.x); v[1] = bfhi(w.x); v[2] = bflo(w.y); v[3] = bfhi(w.y); v[4] = bflo(w.z); v[5] = bfhi(w.z); v[6] = bflo(w.w); v[7] = bfhi(w.w); }

#define XB_TMO      128
#define XB_XCNT(j)  (256  + 64 * (j))
#define XB_XSUB(j)  (1280 + 64 * (j))
#define XB_XGEN(j)  (2304 + 64 * (j))
#define XB_TOP      3328
#define XB_TOPGEN   3392
#define XCD_BAR_WORDS 3456
#define XB_SPIN_CAP (1u << 18)

__device__ __forceinline__ unsigned xb_ld(unsigned* p)              { return __hip_atomic_load(p, __ATOMIC_RELAXED, __HIP_MEMORY_SCOPE_AGENT); }
__device__ __forceinline__ unsigned xb_add(unsigned* p, unsigned v) { return __hip_atomic_fetch_add(p, v, __ATOMIC_RELAXED, __HIP_MEMORY_SCOPE_AGENT); }
__device__ __forceinline__ unsigned xb_xcc_id() { return (unsigned)__builtin_amdgcn_s_getreg((3 << 11) | 20) & 0xFu; }
#define XB_SPIN(cond, bar) do { unsigned _sp = 0; while (cond) { __builtin_amdgcn_s_sleep(1); \
    if ((++_sp & 255u) == 0u) { if (xb_ld(&(bar)[XB_TMO])) break; if (_sp > XB_SPIN_CAP) { atomicAdd(&(bar)[XB_TMO], 1u); break; } } } } while (0)

struct XcdBarrier {
    unsigned* bar; unsigned x;
    volatile LAS unsigned* st;
};
__device__ __forceinline__ XcdBarrier xcd_barrier_post(unsigned* bar, volatile LAS unsigned* st) {
    XcdBarrier b; b.bar = bar; b.x = xb_xcc_id(); b.st = st;
    if (threadIdx.x == 0) (void)xb_add(&bar[XB_XCNT(b.x)], 1u);
    return b;
}
__device__ __forceinline__ void xcd_barrier_complete(unsigned* bar, unsigned x, unsigned& nloc, unsigned& nx) {
    const unsigned G = gridDim.x * gridDim.y * gridDim.z;
    unsigned sum, cnt, mine, sp = 0u;
    for (;;) {
        sum = 0u; cnt = 0u; mine = 0u;
#pragma unroll
        for (unsigned j = 0; j < 16; ++j) { const unsigned c = xb_ld(&bar[XB_XCNT(j)]); sum += c; cnt += (c > 0u) ? 1u : 0u; mine = (j == x) ? c : mine; }
        if (sum == G) break;
        __builtin_amdgcn_s_sleep(1);
        if ((++sp & 255u) == 0u) { if (xb_ld(&bar[XB_TMO])) break; if (sp > XB_SPIN_CAP) { atomicAdd(&bar[XB_TMO], 1u); break; } }
    }
    nloc = mine > 0u ? mine : 1u; nx = cnt > 0u ? cnt : 1u;
}
__device__ __forceinline__ void xcd_barrier(const XcdBarrier& b) {
    asm volatile("s_waitcnt vmcnt(0)" ::: "memory");
    __syncthreads();
    if (threadIdx.x == 0) {
        unsigned* bar = b.bar;
        __builtin_amdgcn_s_waitcnt(0);
        unsigned nloc = b.st[0], nx = b.st[1];
        if (nloc == 0u) { xcd_barrier_complete(bar, b.x, nloc, nx); b.st[0] = nloc; b.st[1] = nx; }
        const unsigned old = xb_add(&bar[XB_XSUB(b.x)], 1u);
        const unsigned gen = old / nloc;
        if (old + 1u == (gen + 1u) * nloc) {
            __builtin_amdgcn_fence(__ATOMIC_RELEASE, "agent");
            asm volatile("s_waitcnt vmcnt(0)" ::: "memory");
            const unsigned og = xb_add(&bar[XB_TOP], 1u);
            const unsigned tg = og / nx;
            if (og + 1u == (tg + 1u) * nx) xb_add(&bar[XB_TOPGEN], 1u);
            else XB_SPIN(xb_ld(&bar[XB_TOPGEN]) == tg, bar);
            __builtin_amdgcn_fence(__ATOMIC_ACQUIRE, "agent");
            xb_add(&bar[XB_XGEN(b.x)], 1u);
            asm volatile("s_waitcnt vmcnt(0)" ::: "memory");
        } else {
            XB_SPIN(xb_ld(&bar[XB_XGEN(b.x)]) == gen, bar);
            __builtin_amdgcn_fence(__ATOMIC_ACQUIRE, "agent");
            asm volatile("s_waitcnt vmcnt(0)" ::: "memory");
        }
    }
    __syncthreads();
}

namespace pg8 {
constexpr int BM = 256, BK = 64, HALF = 128, HTB = HALF * BK * 2, STAGE_BYTES = 8 * HTB, NXCD = 8, WGM = 8;
__device__ __forceinline__ int lds_byte(int r, int c) { const int st = (r >> 4) * 2 + (c >> 5), rr = r & 15, cc = c & 31, ob = rr * 64 + cc * 2; return st * 1024 + (ob ^ (((ob >> 9) & 1) << 5)); }
__device__ __forceinline__ void stage_rc(int b, int& R, int& C) { const int st = b / 1024, sb = b % 1024, swz = sb ^ (((sb >> 9) & 1) << 5); R = (st >> 1) * 16 + swz / 64; C = (st & 1) * 32 + (swz % 64) / 2; }
__device__ __forceinline__ int perm32(int rho) { const int n = rho >> 4, i = rho & 15; return 8 * (i >> 2) + 4 * n + (i & 3); }
struct Unit { int pm, pn; };
struct Gemm { const bf16_t* A; const bf16_t* Bt; int M, N, K; };
struct StaticOrder {
    int nM, nN, nwg, G, c;
    __device__ void init(int M, int N, int G_, int c_) { nM = M / BM; nN = N / BM; nwg = nM * nN; G = G_; c = c_; }
    __device__ bool next(int i, Unit& u) const {
        const long L = (long)i * G + c; if (L >= nwg) return false;
        int wgid = (int)L; { const int q = nwg / NXCD, r = nwg % NXCD, xcd = wgid % NXCD, off = wgid / NXCD; wgid = (xcd < r ? xcd * (q + 1) : r * (q + 1) + (xcd - r) * q) + off; }
        const int nig = WGM * nN, gid = wgid / nig, fm = gid * WGM, gsz = (nM - fm) < WGM ? (nM - fm) : WGM;
        u.pm = fm + ((wgid % nig) % gsz); u.pn = (wgid % nig) / gsz; return true;
    }
};
template <class Epi>
__device__ __forceinline__ void gemm_phase(LAS unsigned char* lds, const Gemm g, const StaticOrder& S, const Epi& E) {
    const int tid = threadIdx.x, wid = __builtin_amdgcn_readfirstlane(tid >> 6), lane = tid & 63, wr = wid >> 2, wc = wid & 3, fr = lane & 15, fq = lane >> 4;
    const int K = g.K, nt = K / BK;
    unsigned voffA[2], voffB[2];
#pragma unroll
    for (int i = 0; i < 2; ++i) { int R, C; stage_rc(tid * 16 + i * 8192, R, C); const int Rb = (R & ~31) + perm32(R & 31);
        voffA[i] = (unsigned)(R * K + C) * 2u; voffB[i] = (unsigned)(Rb * K + C) * 2u; }
    const size_t kstep = (size_t)(BK * 2);
    const size_t hstep = (size_t)HALF * K * 2;
    const size_t tstep = 2 * hstep;
    const unsigned ldsw = (unsigned)wid * 1024u;
    const int aoff = lds_byte(wr * 64 + fr, fq * 8), boff = lds_byte(wc * 32 + fr, fq * 8);
#define PG8_SA(b, h) (((b) * 2 + (h)) * HTB)
#define PG8_SB(b, h) ((4 + (b) * 2 + (h)) * HTB)
#define PG8_STAGE(bufoff, gbase, voff) do { _Pragma("unroll") for (int _i = 0; _i < 2; ++_i) \
        __builtin_amdgcn_global_load_lds((const unsigned*)((const char*)(gbase) + (voff)[_i]), (LAS unsigned*)(lds + (bufoff) + ldsw + _i * 8192), 16, 0, 0); } while (0)
#define PG8_LDA(dst, b, h) do { _Pragma("unroll") for (int m = 0; m < 4; ++m) _Pragma("unroll") for (int k = 0; k < 2; ++k) dst[m][k] = *(const LAS bf16x8*)(lds + PG8_SA(b, h) + aoff + m * 2048 + k * 1024); } while (0)
#define PG8_LDB(dst, b, h) do { _Pragma("unroll") for (int n = 0; n < 2; ++n) _Pragma("unroll") for (int k = 0; k < 2; ++k) dst[n][k] = *(const LAS bf16x8*)(lds + PG8_SB(b, h) + boff + n * 2048 + k * 1024); } while (0)
#define PG8_MMA(ai, bj, At, Bt) do { __builtin_amdgcn_s_setprio(1); _Pragma("unroll") for (int m = 0; m < 4; ++m) _Pragma("unroll") for (int n = 0; n < 2; ++n) _Pragma("unroll") for (int k = 0; k < 2; ++k) \
        acc[ai][bj][m][n] = __builtin_amdgcn_mfma_f32_16x16x32_bf16(Bt[n][k], At[m][k], acc[ai][bj][m][n], 0, 0, 0); __builtin_amdgcn_s_setprio(0); } while (0)
#define PG8_WAIT_V(n) asm volatile("s_waitcnt vmcnt(" #n ")" ::: "memory")
#define PG8_WAIT_L(n) asm volatile("s_waitcnt lgkmcnt(" #n ")" ::: "memory")
#define PG8_BAR __builtin_amdgcn_s_barrier()
#define PG8_SCHED __builtin_amdgcn_sched_barrier(0)
    Unit cur, nxt; int ui = 0;
    if (!S.next(0, cur)) return;
    f32x4 acc[2][2][4][2];
#pragma unroll
    for (int a = 0; a < 2; ++a)
#pragma unroll
        for (int b = 0; b < 2; ++b)
#pragma unroll
            for (int m = 0; m < 4; ++m)
#pragma unroll
                for (int n = 0; n < 2; ++n) acc[a][b][m][n] = (f32x4){0.f, 0.f, 0.f, 0.f};
    bf16x8 At[4][2], B0[2][2], B1[2][2];
    const char* cA = (const char*)g.A + (size_t)cur.pm * tstep; const char* cB = (const char*)g.Bt + (size_t)cur.pn * tstep;
    PG8_STAGE(PG8_SB(0, 0), cB, voffB); PG8_STAGE(PG8_SA(0, 0), cA, voffA); PG8_STAGE(PG8_SB(0, 1), cB + hstep, voffB); PG8_STAGE(PG8_SA(0, 1), cA + hstep, voffA);
    if (wr == 1) PG8_BAR;
    PG8_WAIT_V(4); PG8_BAR;
    PG8_STAGE(PG8_SB(1, 0), cB + kstep, voffB); PG8_STAGE(PG8_SA(1, 0), cA + kstep, voffA); PG8_STAGE(PG8_SB(1, 1), cB + hstep + kstep, voffB);
    PG8_WAIT_V(6); PG8_BAR;
    for (;;) {
        const bool has_next = S.next(ui + 1, nxt);
        const char* nA = has_next ? (const char*)g.A + (size_t)nxt.pm * tstep : cA; const char* nB = has_next ? (const char*)g.Bt + (size_t)nxt.pn * tstep : cB;
#pragma unroll 1
        for (int t = 0; t < nt; t += 2) {
            const bool last = (t == nt - 2);
            const char* a1 = cA + (size_t)(t + 1) * kstep;
            const char* a2 = last ? nA : cA + (size_t)(t + 2) * kstep; const char* b2 = last ? nB : cB + (size_t)(t + 2) * kstep;
            const char* a3 = a2 + kstep; const char* b3 = b2 + kstep;
            PG8_LDB(B0, 0, 0); PG8_SCHED; PG8_LDA(At, 0, 0); PG8_STAGE(PG8_SA(1, 1), a1 + hstep, voffA);
            PG8_WAIT_L(8); PG8_BAR; PG8_WAIT_L(0); PG8_MMA(0, 0, At, B0); PG8_BAR; PG8_SCHED;
            PG8_LDB(B1, 0, 1); PG8_STAGE(PG8_SB(0, 0), b2, voffB);
            PG8_BAR; PG8_WAIT_L(0); PG8_MMA(0, 1, At, B1); PG8_BAR;
            PG8_LDA(At, 0, 1); PG8_STAGE(PG8_SA(0, 0), a2, voffA);
            PG8_BAR; PG8_WAIT_L(0); PG8_MMA(1, 0, At, B0); PG8_BAR; PG8_SCHED;
            PG8_STAGE(PG8_SB(0, 1), b2 + hstep, voffB);
            PG8_WAIT_V(6); PG8_BAR; PG8_MMA(1, 1, At, B1); PG8_BAR;
            PG8_LDB(B0, 1, 0); PG8_SCHED; PG8_LDA(At, 1, 0); PG8_STAGE(PG8_SA(0, 1), a2 + hstep, voffA);
            PG8_WAIT_L(8); PG8_BAR; PG8_WAIT_L(0); PG8_MMA(0, 0, At, B0); PG8_BAR; PG8_SCHED;
            PG8_LDB(B1, 1, 1); PG8_STAGE(PG8_SB(1, 0), b3, voffB);
            PG8_BAR; PG8_WAIT_L(0); PG8_MMA(0, 1, At, B1); PG8_BAR;
            PG8_LDA(At, 1, 1); PG8_STAGE(PG8_SA(1, 0), a3, voffA);
            PG8_BAR; PG8_WAIT_L(0); PG8_MMA(1, 0, At, B0); PG8_BAR; PG8_SCHED;
            PG8_STAGE(PG8_SB(1, 1), b3 + hstep, voffB);
            PG8_WAIT_V(6); PG8_BAR; PG8_MMA(1, 1, At, B1); PG8_BAR;
        }
        {
            const int row0 = cur.pm * BM + wr * 64 + fr, col0 = cur.pn * BM + wc * 32 + 8 * fq;
#pragma unroll
            for (int ai = 0; ai < 2; ++ai)
#pragma unroll
                for (int m = 0; m < 4; ++m)
#pragma unroll
                    for (int bj = 0; bj < 2; ++bj) { E(row0 + ai * HALF + m * 16, col0 + bj * HALF, cur.pn, acc[ai][bj][m][0], acc[ai][bj][m][1]); if (Epi::SERIAL) __builtin_amdgcn_sched_barrier(0); }
        }
        if (!has_next) break;
#pragma unroll
        for (int a = 0; a < 2; ++a)
#pragma unroll
            for (int b = 0; b < 2; ++b)
#pragma unroll
                for (int m = 0; m < 4; ++m)
#pragma unroll
                    for (int n = 0; n < 2; ++n) acc[a][b][m][n] = (f32x4){0.f, 0.f, 0.f, 0.f};
        cur = nxt; cA = nA; cB = nB; ++ui;
    }
    PG8_WAIT_V(0);
    if (wr == 0) PG8_BAR;
    PG8_BAR;
#undef PG8_SA
#undef PG8_SB
#undef PG8_STAGE
#undef PG8_LDA
#undef PG8_LDB
#undef PG8_MMA
#undef PG8_WAIT_V
#undef PG8_WAIT_L
#undef PG8_BAR
#undef PG8_SCHED
}
}

struct Args { const float* in[34]; float* out; unsigned char* ws; int ph_lo, ph_hi, li, pad; };

struct Ctx {
    LAS unsigned char* lds;
    int tid, lane, wave, gw, ngw, gt, ngt, G;
    const float* const* in; unsigned char* ws; unsigned char* dout;
};

__device__ __forceinline__ void st8_bf16(bf16_t* p, f32x4 a, f32x4 b) { u32x4 w; w.x = pk2(a.x, a.y); w.y = pk2(a.z, a.w); w.z = pk2(b.x, b.y); w.w = pk2(b.z, b.w); *(u32x4*)p = w; }
struct EpiP1 { static constexpr bool SERIAL = false;
    float* cs; bf16_t* rc; bf16_t* mq;
    __device__ __forceinline__ void operator()(int row, int col, int pn, f32x4 a, f32x4 b) const {
        if (pn < 2) { float* p = cs + (size_t)row * 512 + col; *(f32x4*)p = a; *(f32x4*)(p + 4) = b; }
        else if (pn < 9) st8_bf16(rc + (size_t)row * 1792 + (col - 512), a, b);
        else st8_bf16(mq + (size_t)row * 512 + (col - 2304), a, b);
    }
};
struct EpiMemKV { static constexpr bool SERIAL = false;
    bf16_t* km; bf16_t* vt;
    __device__ __forceinline__ void operator()(int row, int col, int pn, f32x4 a, f32x4 b) const {
        const int bb = row >> 8, m = row & 255;
        if (col < 512) { const int h = col >> 7, d = col & 127; st8_bf16(km + ((size_t)((bb * 4 + h) * 256 + m)) * 128 + d, a, b); }
        else { const int c2 = col - 512, h = c2 >> 7, d = c2 & 127; bf16_t* p = vt + ((size_t)((bb * 4 + h) * 128 + d)) * 256 + m;
            p[0] = (bf16_t)f2bf(a.x); p[256] = (bf16_t)f2bf(a.y); p[512] = (bf16_t)f2bf(a.z); p[768] = (bf16_t)f2bf(a.w);
            p[1024] = (bf16_t)f2bf(b.x); p[1280] = (bf16_t)f2bf(b.y); p[1536] = (bf16_t)f2bf(b.z); p[1792] = (bf16_t)f2bf(b.w); }
    }
};
struct EpiLora { static constexpr bool SERIAL = true;
    bf16_t* e; bf16_t* a; bf16_t* g; const float* w0; const float* a0;
    __device__ __forceinline__ void operator()(int row, int col, int pn, f32x4 x, f32x4 y) const {
        float v[8] = {x.x, x.y, x.z, x.w, y.x, y.y, y.z, y.w};
        if (pn < 4) { const int c = col & 511; const float* bp = (pn < 2 ? w0 : a0) + c; const f32x4 b0 = *(const f32x4*)bp, b1 = *(const f32x4*)(bp + 4);
            const float bb[8] = {b0.x, b0.y, b0.z, b0.w, b1.x, b1.y, b1.z, b1.w}; const float sc = pn < 2 ? 0.6065306597126334f : 1.0f;
#pragma unroll
            for (int j = 0; j < 8; ++j) v[j] = sc * sigmoidf_(v[j] + bb[j]);
            *(u32x4*)((pn < 2 ? e : a) + (size_t)row * 512 + c) = pack8(v);
        } else *(u32x4*)(g + (size_t)row * 512 + (col - 1024)) = pack8(v);
    }
};
struct EpiQ { static constexpr bool SERIAL = false;
    bf16_t* ql; bf16_t* qi;
    __device__ __forceinline__ void operator()(int row, int col, int pn, f32x4 a, f32x4 b) const {
        if (pn < 4) st8_bf16(ql + (size_t)row * 1024 + col, a, b); else st8_bf16(qi + (size_t)row * 256 + (col - 1024), a, b);
    }
};
struct EpiGates { static constexpr bool SERIAL = true;
    bf16_t* o;
    __device__ __forceinline__ void operator()(int row, int col, int pn, f32x4 a, f32x4 b) const {
        float v[8] = {a.x, a.y, a.z, a.w, b.x, b.y, b.z, b.w};
#pragma unroll
        for (int j = 0; j < 8; ++j) v[j] = sigmoidf_(v[j]);
        *(u32x4*)(o + (size_t)row * 3072 + col) = pack8(v);
    }
};
template <int WHICH> struct EpiMerge { static constexpr bool SERIAL = true;
    const bf16_t* gates; float* mf; bf16_t* mb;
    __device__ __forceinline__ void operator()(int row, int col, int pn, f32x4 a, f32x4 b) const {
        float v[8] = {a.x, a.y, a.z, a.w, b.x, b.y, b.z, b.w}, gv[8];
        unpack8(*(const u32x4*)(gates + (size_t)row * 3072 + WHICH * 1024 + col), gv);
        float* p = mf + (size_t)row * 1024 + col;
        if (WHICH == 0) {
#pragma unroll
            for (int j = 0; j < 8; ++j) v[j] *= gv[j];
        } else { const f32x4 p0 = *(const f32x4*)p, p1 = *(const f32x4*)(p + 4); const float pv[8] = {p0.x, p0.y, p0.z, p0.w, p1.x, p1.y, p1.z, p1.w};
#pragma unroll
            for (int j = 0; j < 8; ++j) v[j] = pv[j] + v[j] * gv[j];
        }
        if (WHICH == 2) *(u32x4*)(mb + (size_t)row * 1024 + col) = pack8(v);
        else { *(f32x4*)p = (f32x4){v[0], v[1], v[2], v[3]}; *(f32x4*)(p + 4) = (f32x4){v[4], v[5], v[6], v[7]}; }
    }
};
struct EpiWout { static constexpr bool SERIAL = false;
    gfp x; float* pre;
    __device__ __forceinline__ void operator()(int row, int col, int pn, f32x4 a, f32x4 b) const {
        gfp xp = x + (size_t)row * 1024 + col; float* p = pre + (size_t)row * 1024 + col; typedef const __attribute__((address_space(1))) f32x4* g4p;
        *(f32x4*)p = *(g4p)xp * ALPHA + a; *(f32x4*)(p + 4) = *(g4p)(xp + 4) * ALPHA + b;
    }
};
struct EpiPeerQ { static constexpr bool SERIAL = false; bf16_t* o; __device__ __forceinline__ void operator()(int row, int col, int pn, f32x4 a, f32x4 b) const { st8_bf16(o + (size_t)row * 2048 + col, a, b); } };

template <int N, int K, class F> __device__ __forceinline__ void build_bt(bf16_t* dst, const F& f, int gt, int ngt) {
    constexpr int items = N * (K / 8);
    for (int i = gt; i < items; i += ngt) { const int n = i % N, k0 = (i / N) * 8; float v[8];
#pragma unroll
        for (int j = 0; j < 8; ++j) v[j] = f(n, k0 + j);
        *(u32x4*)(dst + (size_t)n * K + k0) = pack8(v); }
}
struct FWin { gfp w; __device__ __forceinline__ float operator()(int n, int k) const { if (n < 424) return w[(size_t)k * IN_W + n]; if (n < 512) return 0.f; return w[(size_t)k * IN_W + n - 88]; } };
struct FWg { gfp w; __device__ __forceinline__ float operator()(int n, int k) const { return w[(size_t)k * IN_W + 2728 + n]; } };
struct FLora { gfp w2, a2, g2; __device__ __forceinline__ float operator()(int n, int k) const {
    if (n < 512) return k < 64 ? w2[k * 512 + n] : 0.f;
    if (n < 1024) return (k >= 64 && k < 128) ? a2[(k - 64) * 512 + n - 512] : 0.f;
    return k >= 128 ? g2[(k - 128) * 512 + n - 1024] : 0.f; } };
struct FWq { const float *uq, *uk, *iq; __device__ __forceinline__ float operator()(int n, int k) const {
    if (n >= 1024) return iq[k * 256 + n - 1024];
    const int h = n >> 7, c = n & 127; const float* a = uq + (size_t)k * 512 + h * 64; const float* b = uk + (size_t)(c * 8 + h) * 64; float s = 0.f;
#pragma unroll 8
    for (int d = 0; d < 64; ++d) s = fmaf(a[d], b[d], s);
    return s * 0.125f; } };
struct FWov { const float *uv, *br; __device__ __forceinline__ float operator()(int n, int k) const {
    const int h = k >> 7, c = k & 127; const float* a = uv + (size_t)(c * 8 + h) * 64; const float* b = br + (size_t)(h * 64) * 1024 + n; float s = 0.f;
#pragma unroll 8
    for (int d = 0; d < 64; ++d) s = fmaf(a[d], b[(size_t)d * 1024], s);
    return s; } };
struct FT { gfp w; int ld; __device__ __forceinline__ float operator()(int n, int k) const { return w[(size_t)k * ld + n]; } };

__device__ __forceinline__ void cvt_rows(gfp src, bf16_t* dst, size_t n8, int gt, int ngt) {
    for (size_t i = gt; i < n8; i += ngt) { const f32x4 a = *(const __attribute__((address_space(1))) f32x4*)(src + i * 8), b = *(const __attribute__((address_space(1))) f32x4*)(src + i * 8 + 4); st8_bf16(dst + i * 8, a, b); }
}
constexpr float PEER_U_SCALE = 64.0f, PEER_V_SCALE = 8.0f;
__device__ __forceinline__ void cvt_rows_fp8(gfp src, unsigned char* dst, size_t n16, float scale, int gt, int ngt) {
    for (size_t i = gt; i < n16; i += ngt) { typedef const __attribute__((address_space(1))) f32x4* g4p; gfp p = src + i * 16; u32x4 w;
        const f32x4 a = *(g4p)p * scale, b = *(g4p)(p + 4) * scale, c = *(g4p)(p + 8) * scale, d = *(g4p)(p + 12) * scale;
        int t = 0; t = __builtin_amdgcn_cvt_pk_fp8_f32(a.x, a.y, t, false); t = __builtin_amdgcn_cvt_pk_fp8_f32(a.z, a.w, t, true); w.x = (unsigned)t;
        t = 0; t = __builtin_amdgcn_cvt_pk_fp8_f32(b.x, b.y, t, false); t = __builtin_amdgcn_cvt_pk_fp8_f32(b.z, b.w, t, true); w.y = (unsigned)t;
        t = 0; t = __builtin_amdgcn_cvt_pk_fp8_f32(c.x, c.y, t, false); t = __builtin_amdgcn_cvt_pk_fp8_f32(c.z, c.w, t, true); w.z = (unsigned)t;
        t = 0; t = __builtin_amdgcn_cvt_pk_fp8_f32(d.x, d.y, t, false); t = __builtin_amdgcn_cvt_pk_fp8_f32(d.z, d.w, t, true); w.w = (unsigned)t;
        *(u32x4*)(dst + i * 16) = w; }
}
__device__ __forceinline__ void p0_prologue(const Ctx& C) {
    const float* const* in = C.in; unsigned char* ws = C.ws;
    cvt_rows(G_(in[0]), (bf16_t*)(C.dout + DO_XB), (size_t)T * D / 8, C.gt, C.ngt);
    cvt_rows(G_(in[1]), (bf16_t*)(ws + WS_MEMB), (size_t)1024 * 1024 / 8, C.gt, C.ngt);
    cvt_rows(G_(in[29]), (bf16_t*)(ws + WS_KEYS), (size_t)2 * 128 * 128 / 8, C.gt, C.ngt);
    build_bt<2816, 1024>((bf16_t*)(ws + WS_WIN), FWin{G_(in[3])}, C.gt, C.ngt);
    build_bt<1536, 256>((bf16_t*)(ws + WS_WLORA), FLora{G_(in[12]), G_(in[14]), G_(in[15])}, C.gt, C.ngt);
    {
        bf16_t* dst = (bf16_t*)(ws + WS_WQ); const float* uq = in[6]; const float* uk = in[7];
        for (int item = C.gw; item < 4096; item += C.ngw) { const int n = item >> 2, k = (item & 3) * 64 + C.lane, h = n >> 7, c = n & 127;
            const float* a = uq + (size_t)k * 512 + h * 64; const float* bq = uk + (size_t)(c * 8 + h) * 64; float s = 0.f;
#pragma unroll
            for (int d4 = 0; d4 < 16; ++d4) { const f32x4 av = *(const f32x4*)(a + 4 * d4), bv = *(const f32x4*)(bq + 4 * d4); s += av.x * bv.x + av.y * bv.y + av.z * bv.z + av.w * bv.w; }
            dst[(size_t)n * 256 + k] = (bf16_t)f2bf(s * 0.125f); }
        build_bt<256, 256>(dst + 1024 * 256, FT{G_(in[9]), 256}, C.gt, C.ngt);
    }
    build_bt<1024, 1024>((bf16_t*)(ws + WS_WMEMKV), FT{G_(in[21]), 1024}, C.gt, C.ngt);
}
__device__ __forceinline__ void p6_late_weights(const Ctx& C) {
    const float* const* in = C.in; unsigned char* ws = C.ws;
    build_bt<3072, 1024>((bf16_t*)(ws + WS_WG), FWg{G_(in[3])}, C.gt, C.ngt);
    {
        bf16_t* dst = (bf16_t*)(ws + WS_WOV); const float* uv = in[8]; const float* br = in[22];
        for (int i = C.gt; i < 1024 * 128; i += C.ngt) { const int n = i & 1023, k0 = (i >> 10) * 8, h = k0 >> 7, c0 = k0 & 127; float acc[8];
#pragma unroll
            for (int j = 0; j < 8; ++j) acc[j] = 0.f;
            for (int d4 = 0; d4 < 16; ++d4) {
                float b[4];
#pragma unroll
                for (int q = 0; q < 4; ++q) b[q] = br[(size_t)(h * 64 + 4 * d4 + q) * 1024 + n];
#pragma unroll
                for (int j = 0; j < 8; ++j) { const f32x4 a = *(const f32x4*)(uv + (size_t)((c0 + j) * 8 + h) * 64 + 4 * d4); acc[j] += a.x * b[0] + a.y * b[1] + a.z * b[2] + a.w * b[3]; }
            }
            *(u32x4*)(dst + (size_t)n * 1024 + k0) = pack8(acc); }
    }
    build_bt<1024, 512>((bf16_t*)(ws + WS_WBRR), FT{G_(in[23]), 1024}, C.gt, C.ngt);
    build_bt<1024, 512>((bf16_t*)(ws + WS_WBRM), FT{G_(in[24]), 1024}, C.gt, C.ngt);
    build_bt<1024, 1024>((bf16_t*)(ws + WS_WOUT), FT{G_(in[25]), 1024}, C.gt, C.ngt);
    build_bt<2048, 1024>((bf16_t*)(ws + WS_WPEER), FT{G_(in[28]), 2048}, C.gt, C.ngt);
}

__device__ __forceinline__ void p2_prep(const Ctx& C) {
    const float* const* in = C.in; unsigned char* ws = C.ws; const int lane = C.lane;
    const float* csmall = (const float*)(ws + WS_CSMALL); const bf16_t* rcols = (const bf16_t*)(ws + WS_RCOLS);
    bf16_t* cqn = (bf16_t*)(ws + WS_CQN); bf16_t* kvl = (bf16_t*)(ws + WS_KVL); bf16_t* kidx = (bf16_t*)(ws + WS_KIDX); float* widx = (float*)(ws + WS_WIDX);
    bf16_t* rr = (bf16_t*)(ws + WS_RW_R); bf16_t* rk = (bf16_t*)(ws + WS_RW_K); bf16_t* rv = (bf16_t*)(ws + WS_RW_V); bf16_t* la = (bf16_t*)(ws + WS_LORAA);
    const float* mu = in[10];
    const f32x4 gq = *(const f32x4*)(in[4] + 4 * lane); const f32x2 gk = *(const f32x2*)(in[5] + 2 * lane);
    for (int t = C.gw; t < T; t += C.ngw) {
        const float* cs = csmall + (size_t)t * 512;
        {
            const f32x4 q = *(const f32x4*)(cs + 4 * lane);
            const float ss = wave_sum(q.x * q.x + q.y * q.y + q.z * q.z + q.w * q.w);
            const float rs = rsqrtf(ss * (1.0f / 256.0f) + 1e-6f);
            u32x2 w; w.x = pk2(q.x * rs * gq.x, q.y * rs * gq.y); w.y = pk2(q.z * rs * gq.z, q.w * rs * gq.w);
            *(u32x2*)(cqn + (size_t)t * 256 + 4 * lane) = w;
        }
        {
            const f32x2 k = *(const f32x2*)(cs + 256 + 2 * lane);
            const float ss = wave_sum(k.x * k.x + k.y * k.y);
            const float rs = rsqrtf(ss * (1.0f / 128.0f) + 1e-6f);
            *(unsigned*)(kvl + (size_t)t * 128 + 2 * lane) = pk2(k.x * rs * gk.x, k.y * rs * gk.y);
        }
        if (lane < 16) { const f32x2 k = *(const f32x2*)(cs + 384 + 2 * lane); *(unsigned*)(kidx + (size_t)t * 32 + 2 * lane) = pk2(k.x, k.y); }
        if (lane < 8) widx[(size_t)t * 8 + lane] = cs[416 + lane] * 0.0625f;
        const bf16_t* rc = rcols + (size_t)t * 1792; const bool hp = (t & (SEQ - 1)) != 0; const bf16_t* rp = hp ? rc - 1792 : rc;
#pragma unroll
        for (int seg = 0; seg < 3; ++seg) {
            float c[8], p[8], o[8];
            unpack8(*(const u32x4*)(rc + seg * 512 + 8 * lane), c); unpack8(*(const u32x4*)(rp + seg * 512 + 8 * lane), p);
            const f32x4 m0 = *(const f32x4*)(mu + seg * 512 + 8 * lane), m1 = *(const f32x4*)(mu + seg * 512 + 8 * lane + 4);
            const float mm[8] = {m0.x, m0.y, m0.z, m0.w, m1.x, m1.y, m1.z, m1.w};
#pragma unroll
            for (int j = 0; j < 8; ++j) { const float pv = hp ? p[j] : 0.f; o[j] = c[j] + (pv - c[j]) * mm[j]; }
            bf16_t* dst = (seg == 0 ? rr : (seg == 1 ? rk : rv)) + (size_t)t * 512 + 8 * lane;
            *(u32x4*)dst = pack8(o);
        }
        {
            const float cw = bf1(rc[1536 + lane]), pw = hp ? bf1(rp[1536 + lane]) : 0.f; const float wl = cw + (pw - cw) * mu[1536 + lane];
            const float ca = bf1(rc[1600 + lane]), pa = hp ? bf1(rp[1600 + lane]) : 0.f; const float al = ca + (pa - ca) * mu[1600 + lane];
            const unsigned cgw = *(const unsigned*)(rc + 1664 + 2 * lane), pgw = *(const unsigned*)(rp + 1664 + 2 * lane);
            const float cg0 = bflo(cgw), cg1 = bfhi(cgw), pg0 = hp ? bflo(pgw) : 0.f, pg1 = hp ? bfhi(pgw) : 0.f;
            const float g0 = cg0 + (pg0 - cg0) * mu[1664 + 2 * lane], g1 = cg1 + (pg1 - cg1) * mu[1664 + 2 * lane + 1];
            bf16_t* l = la + (size_t)t * 256;
            l[lane] = (bf16_t)f2bf(tanhf(wl)); l[64 + lane] = (bf16_t)f2bf(al);
            *(unsigned*)(l + 128 + 2 * lane) = pk2(sigmoidf_(g0), sigmoidf_(g1));
        }
    }
}

template <int NV> __device__ __forceinline__ unsigned kth_largest(const unsigned (&u)[NV], int k) {
    unsigned Tk = 0u;
    for (int bit = 31; bit >= 0; --bit) {
        const unsigned cand = Tk | (1u << bit); int cnt = 0;
#pragma unroll
        for (int j = 0; j < NV; ++j) cnt += __popcll(__ballot(u[j] >= cand));
        if (cnt >= k) Tk = cand;
    }
    return Tk;
}

__device__ __forceinline__ unsigned wave_max_u(unsigned x) {
    unsigned y;
    y = dpp_u<0x111>(x); x = x > y ? x : y; y = dpp_u<0x112>(x); x = x > y ? x : y; y = dpp_u<0x114>(x); x = x > y ? x : y; y = dpp_u<0x118>(x); x = x > y ? x : y;
    y = (unsigned)__builtin_amdgcn_update_dpp(0, (int)x, 0x142, 0xA, 0xF, false); x = x > y ? x : y;
    y = (unsigned)__builtin_amdgcn_update_dpp(0, (int)x, 0x143, 0xC, 0xF, false); x = x > y ? x : y;
    return (unsigned)__builtin_amdgcn_readlane((int)x, 63);
}
__device__ __forceinline__ int wave_sum_i(int x) {
    x += __builtin_amdgcn_update_dpp(0, x, 0x111, 0xF, 0xF, false); x += __builtin_amdgcn_update_dpp(0, x, 0x112, 0xF, 0xF, false);
    x += __builtin_amdgcn_update_dpp(0, x, 0x114, 0xF, 0xF, false); x += __builtin_amdgcn_update_dpp(0, x, 0x118, 0xF, 0xF, false);
    x += __builtin_amdgcn_update_dpp(0, x, 0x142, 0xA, 0xF, false); x += __builtin_amdgcn_update_dpp(0, x, 0x143, 0xC, 0xF, false);
    return __builtin_amdgcn_readlane(x, 63);
}
__device__ __forceinline__ float wave_max_f(float x) {
    const int ninf = (int)0xff800000u; float y;
    y = __builtin_bit_cast(float, __builtin_amdgcn_update_dpp(ninf, __builtin_bit_cast(int, x), 0x111, 0xF, 0xF, false)); x = fmaxf(x, y);
    y = __builtin_bit_cast(float, __builtin_amdgcn_update_dpp(ninf, __builtin_bit_cast(int, x), 0x112, 0xF, 0xF, false)); x = fmaxf(x, y);
    y = __builtin_bit_cast(float, __builtin_amdgcn_update_dpp(ninf, __builtin_bit_cast(int, x), 0x114, 0xF, 0xF, false)); x = fmaxf(x, y);
    y = __builtin_bit_cast(float, __builtin_amdgcn_update_dpp(ninf, __builtin_bit_cast(int, x), 0x118, 0xF, 0xF, false)); x = fmaxf(x, y);
    y = __builtin_bit_cast(float, __builtin_amdgcn_update_dpp(ninf, __builtin_bit_cast(int, x), 0x142, 0xA, 0xF, false)); x = fmaxf(x, y);
    y = __builtin_bit_cast(float, __builtin_amdgcn_update_dpp(ninf, __builtin_bit_cast(int, x), 0x143, 0xC, 0xF, false)); x = fmaxf(x, y);
    return __builtin_bit_cast(float, __builtin_amdgcn_readlane(__builtin_bit_cast(int, x), 63));
}
__device__ __forceinline__ int wave_scan_i(int x) {
    x += __builtin_amdgcn_update_dpp(0, x, 0x111, 0xF, 0xF, false); x += __builtin_amdgcn_update_dpp(0, x, 0x112, 0xF, 0xF, false);
    x += __builtin_amdgcn_update_dpp(0, x, 0x114, 0xF, 0xF, false); x += __builtin_amdgcn_update_dpp(0, x, 0x118, 0xF, 0xF, false);
    x += __builtin_amdgcn_update_dpp(0, x, 0x142, 0xA, 0xF, false); x += __builtin_amdgcn_update_dpp(0, x, 0x143, 0xC, 0xF, false);
    return x;
}
__device__ __forceinline__ int hist_find(u32x4 h, int K, int lane, int& chi, int& cnt) {
    const int ls = (int)(h.x + h.y + h.z + h.w); const int inc = wave_scan_i(ls); const int tot = __builtin_amdgcn_readlane(inc, 63);
    const int a3 = tot - inc, a2 = a3 + (int)h.w, a1 = a2 + (int)h.z, a0 = a1 + (int)h.y;
    int myb = -1, mya = 0, myc = 0;
    if (a3 < K && K <= a3 + (int)h.w) { myb = 3; mya = a3; myc = (int)h.w; }
    if (a2 < K && K <= a2 + (int)h.z) { myb = 2; mya = a2; myc = (int)h.z; }
    if (a1 < K && K <= a1 + (int)h.y) { myb = 1; mya = a1; myc = (int)h.y; }
    if (a0 < K && K <= a0 + (int)h.x) { myb = 0; mya = a0; myc = (int)h.x; }
    const unsigned long long m = __ballot(myb >= 0); const int src = m ? (int)__builtin_ctzll(m) : 0;
    chi = __builtin_amdgcn_readlane(mya, src); cnt = __builtin_amdgcn_readlane(myc, src);
    return 4 * src + __builtin_amdgcn_readlane(myb, src);
}
constexpr int LDS_HIST = 131072 + 4096;
__device__ __forceinline__ void p4_indexer(const Ctx& C) {
    unsigned char* ws = C.ws; const int lane = C.lane, wave = C.wave, g = lane >> 4, fr = lane & 15;
    const bf16_t* qidx = (const bf16_t*)(ws + WS_QIDX); const bf16_t* kidx = (const bf16_t*)(ws + WS_KIDX); const float* widx = (const float*)(ws + WS_WIDX);
    bf16_t* idxo = (bf16_t*)(ws + WS_IDX);
    constexpr int SCP = 4100;
    LAS float* SC = (LAS float*)C.lds;
    LAS unsigned* H = (LAS unsigned*)(C.lds + LDS_HIST + wave * 1024);
    const int qn = fr & 7;
    bf16x8 Bq[8]; f32x4 w0, w1;
    { const int u = blockIdx.x; if (u < 2048) { const int i8 = u >> 8, cc = u & 255, b = cc & 3, j = cc >> 2, qb = (i8 & 1) ? 64 * i8 + 63 - j : 64 * i8 + j; const size_t row = (size_t)b * SEQ + qb * 8 + qn;
#pragma unroll
        for (int h = 0; h < 8; ++h) Bq[h] = *(const bf16x8*)(qidx + row * 256 + h * 32 + 8 * g);
        w0 = *(const f32x4*)(widx + row * 8); w1 = *(const f32x4*)(widx + row * 8 + 4); } }
    for (int u = blockIdx.x; u < 2048; u += C.G) {
        const int i8 = u >> 8, cc = u & 255, b = cc & 3, j = cc >> 2, qb = (i8 & 1) ? 64 * i8 + 63 - j : 64 * i8 + j;
        const int t0 = qb * 8, ntile = (t0 + 8 + 15) >> 4; const size_t tb = (size_t)b * SEQ;
        const float wq[8] = {w0.x, w0.y, w0.z, w0.w, w1.x, w1.y, w1.z, w1.w};
        bf16x8 An[4];
#pragma unroll
        for (int q = 0; q < 4; ++q) { int i = wave + q * NWAVES; i = i < ntile ? i : ntile - 1; An[q] = *(const bf16x8*)(kidx + (tb + 16 * i + fr) * 32 + 8 * g); }
        for (int i0 = wave; i0 < ntile; i0 += 4 * NWAVES) {
            bf16x8 A[4];
#pragma unroll
            for (int q = 0; q < 4; ++q) A[q] = An[q];
#pragma unroll
            for (int q = 0; q < 4; ++q) { int i = i0 + 4 * NWAVES + q * NWAVES; i = i < ntile ? i : ntile - 1; An[q] = *(const bf16x8*)(kidx + (tb + 16 * i + fr) * 32 + 8 * g); }
#pragma unroll
            for (int q = 0; q < 4; ++q) {
                const int i = i0 + q * NWAVES;
                if (i < ntile) {
                    f32x4 sc = (f32x4){0.f, 0.f, 0.f, 0.f};
#pragma unroll
                    for (int h = 0; h < 8; ++h) { const f32x4 d = __builtin_amdgcn_mfma_f32_16x16x32_bf16(A[q], Bq[h], (f32x4){0.f, 0.f, 0.f, 0.f}, 0, 0, 0);
#pragma unroll
                        for (int r = 0; r < 4; ++r) sc[r] = fmaf(wq[h], fmaxf(d[r], 0.f), sc[r]); }
                    if (fr < 8) { const int tq = t0 + fr, s0 = 16 * i + 4 * g;
#pragma unroll
                        for (int r = 0; r < 4; ++r) sc[r] = (s0 + r <= tq) ? sc[r] : -INFINITY;
                        *(LAS f32x4*)(SC + fr * SCP + s0) = sc; }
                }
            }
        }
        __syncthreads();
        { const int un = u + C.G; if (un < 2048) { const int i8n = un >> 8, ccn = un & 255, bn_ = ccn & 3, jn = ccn >> 2, qbn = (i8n & 1) ? 64 * i8n + 63 - jn : 64 * i8n + jn; const size_t row = (size_t)bn_ * SEQ + qbn * 8 + qn;
#pragma unroll
            for (int h = 0; h < 8; ++h) Bq[h] = *(const bf16x8*)(qidx + row * 256 + h * 32 + 8 * g);
            w0 = *(const f32x4*)(widx + row * 8); w1 = *(const f32x4*)(widx + row * 8 + 4); } }
        {
            const int tq = t0 + wave; bf16_t* out = idxo + (tb + tq) * 256;
            if (tq < 256) {
#pragma unroll
                for (int jj = 0; jj < 4; ++jj) { const int s = jj * 64 + lane; if (s <= tq) out[s] = (bf16_t)s; }
            } else {
                float v[64];
#pragma unroll
                for (int jj = 0; jj < 64; ++jj) { const int s = jj * 64 + lane; const float x = SC[wave * SCP + s]; v[jj] = (s <= tq) ? x : -INFINITY; }
                float mx = -INFINITY, mnn = -INFINITY;
#pragma unroll
                for (int jj = 0; jj < 64; ++jj) { mx = fmaxf(mx, v[jj]); mnn = fmaxf(mnn, v[jj] == -INFINITY ? -INFINITY : -v[jj]); }
                mx = wave_max_f(mx); const float lo = -wave_max_f(mnn);
                const float rng = mx - lo; const float inv = rng > 1e-30f ? 65535.9f / rng : 1.f;
                *(LAS u32x4*)(H + 4 * lane) = (u32x4){0u, 0u, 0u, 0u};
                int bnv[64];
#pragma unroll
                for (int jj = 0; jj < 64; ++jj) { const int bn = (int)((v[jj] - lo) * inv); bnv[jj] = bn; if (bn >= 0) __hip_atomic_fetch_add(H + (bn >> 8), 1u, __ATOMIC_RELAXED, __HIP_MEMORY_SCOPE_WORKGROUP); }
                asm volatile("s_waitcnt lgkmcnt(0)" ::: "memory");
                int chi1, cnt1; const int b1 = hist_find(*(const LAS u32x4*)(H + 4 * lane), 256, lane, chi1, cnt1);
                asm volatile("s_waitcnt lgkmcnt(0)" ::: "memory");
                *(LAS u32x4*)(H + 4 * lane) = (u32x4){0u, 0u, 0u, 0u};
#pragma unroll
                for (int jj = 0; jj < 64; ++jj) { const int bn = bnv[jj]; if ((bn >> 8) == b1) __hip_atomic_fetch_add(H + (bn & 255), 1u, __ATOMIC_RELAXED, __HIP_MEMORY_SCOPE_WORKGROUP); }
                asm volatile("s_waitcnt lgkmcnt(0)" ::: "memory");
                int chi2, cnt2; const int b2 = hist_find(*(const LAS u32x4*)(H + 4 * lane), 256 - chi1, lane, chi2, cnt2);
                const int T16 = b1 * 256 + b2; const int need = 256 - chi1 - chi2;
                const bool allties = (need == cnt2);
                unsigned mlo = 0u, mhi = 0u;
#pragma unroll
                for (int jj = 0; jj < 32; ++jj) { const int bn = bnv[jj]; const bool sel = allties ? (bn >= T16) : (bn > T16); mlo |= sel ? (1u << jj) : 0u; }
#pragma unroll
                for (int jj = 32; jj < 64; ++jj) { const int bn = bnv[jj]; const bool sel = allties ? (bn >= T16) : (bn > T16); mhi |= sel ? (1u << (jj - 32)) : 0u; }
                LAS bf16_t* stage = (LAS bf16_t*)(SC + wave * SCP);
                const int mycnt = __popc(mlo) + __popc(mhi); int base = wave_scan_i(mycnt) - mycnt;
                while (mlo) { const int bpos = __builtin_ctz(mlo); stage[base++] = (bf16_t)(bpos * 64 + lane); mlo &= mlo - 1u; }
                while (mhi) { const int bpos = __builtin_ctz(mhi); stage[base++] = (bf16_t)((bpos + 32) * 64 + lane); mhi &= mhi - 1u; }
                if (!allties) {
                    int eqb = 0; const int pos0 = 256 - need;
#pragma unroll
                    for (int jj = 0; jj < 64; ++jj) {
                        const int bn = bnv[jj]; const bool eq = (bn == T16);
                        const unsigned long long me = __ballot(eq);
                        const int er = eqb + (int)__builtin_amdgcn_mbcnt_hi((unsigned)(me >> 32), __builtin_amdgcn_mbcnt_lo((unsigned)me, 0u));
                        if (eq && er < need) stage[pos0 + er] = (bf16_t)(jj * 64 + lane);
                        eqb += __popcll(me);
                    }
                }
                asm volatile("s_waitcnt lgkmcnt(0)" ::: "memory");
                *(u32x2*)(out + 4 * lane) = *(const LAS u32x2*)(stage + 4 * lane);
            }
        }
        __syncthreads();
    }
}

__device__ __forceinline__ void p4_memattn(const Ctx& C) {
    unsigned char* ws = C.ws; const int lane = C.lane, wave = C.wave, g = lane >> 4, fr = lane & 15;
    const bf16_t* memq = (const bf16_t*)(ws + WS_MEMQ); const bf16_t* kmem = (const bf16_t*)(ws + WS_KMEM); const bf16_t* vmt = (const bf16_t*)(ws + WS_VMEMT);
    bf16_t* ymem = (bf16_t*)(ws + WS_YMEM);
    LAS unsigned char* KL = C.lds; LAS unsigned char* VL = C.lds + 65536;
    for (int su = blockIdx.x; su < 256; su += C.G) {
        const int bh = su >> 4, j = su & 15, b = bh >> 2, h = bh & 3;
        const char* kb = (const char*)(kmem + (size_t)(bh * 256) * 128); const char* vb = (const char*)(vmt + (size_t)(bh * 128) * 256);
#pragma unroll
        for (int pp = 0; pp < 8; ++pp) { const int p = wave + 8 * pp;
            { const int row = 4 * p + g; const int c = fr ^ (2 * (row & 7)); __builtin_amdgcn_global_load_lds((const unsigned*)(kb + row * 256 + 16 * c), (LAS unsigned*)(KL + 1024 * p), 16, 0, 0); }
            { const int row = 2 * p + (lane >> 5); const int c = (lane & 31) ^ (row & 15); __builtin_amdgcn_global_load_lds((const unsigned*)(vb + row * 512 + 16 * c), (LAS unsigned*)(VL + 1024 * p), 16, 0, 0); } }
        asm volatile("s_waitcnt vmcnt(0)" ::: "memory");
        __syncthreads();
#pragma unroll 1
        for (int u = 0; u < 2; ++u) {
            const int t0 = b * SEQ + (2 * j + u) * 128 + wave * 16;
            bf16x8 Bq[4];
#pragma unroll
            for (int kk = 0; kk < 4; ++kk) Bq[kk] = *(const bf16x8*)(memq + (size_t)(t0 + fr) * 512 + h * 128 + 32 * kk + 8 * g);
            f32x4 sc[16];
#pragma unroll
            for (int i = 0; i < 16; ++i) { if ((i & 1) == 0) __builtin_amdgcn_sched_barrier(0); f32x4 a = (f32x4){0.f, 0.f, 0.f, 0.f}; const int row = 16 * i + fr;
#pragma unroll
                for (int kk = 0; kk < 4; ++kk) { const bf16x8 A = *(const LAS bf16x8*)(KL + row * 256 + 16 * ((4 * kk + g) ^ (2 * (row & 7)))); a = __builtin_amdgcn_mfma_f32_16x16x32_bf16(A, Bq[kk], a, 0, 0, 0); }
                sc[i] = a; }
            const float scale = 0.08838834764831845f;
            float mx = -3.0e38f;
#pragma unroll
            for (int i = 0; i < 16; ++i)
#pragma unroll
                for (int r = 0; r < 4; ++r) { sc[i][r] *= scale; mx = fmaxf(mx, sc[i][r]); }
            mx = fmaxf(mx, __shfl_xor(mx, 16)); mx = fmaxf(mx, __shfl_xor(mx, 32));
            float sum = 0.f;
#pragma unroll
            for (int i = 0; i < 16; ++i)
#pragma unroll
                for (int r = 0; r < 4; ++r) { sc[i][r] = __expf(sc[i][r] - mx); sum += sc[i][r]; }
            sum += __shfl_xor(sum, 16); sum += __shfl_xor(sum, 32);
            const float inv = 1.0f / sum;
            bf16x8 Pb[8];
#pragma unroll
            for (int ks = 0; ks < 8; ++ks) { u32x4 w; w.x = pk2(sc[2 * ks][0] * inv, sc[2 * ks][1] * inv); w.y = pk2(sc[2 * ks][2] * inv, sc[2 * ks][3] * inv);
                w.z = pk2(sc[2 * ks + 1][0] * inv, sc[2 * ks + 1][1] * inv); w.w = pk2(sc[2 * ks + 1][2] * inv, sc[2 * ks + 1][3] * inv); Pb[ks] = __builtin_bit_cast(bf16x8, w); }
#pragma unroll
            for (int dt = 0; dt < 8; ++dt) {
                __builtin_amdgcn_sched_barrier(0);
                f32x4 o = (f32x4){0.f, 0.f, 0.f, 0.f}; const int row = 16 * dt + fr;
#pragma unroll
                for (int ks = 0; ks < 8; ++ks) { const int ch = 4 * ks + (g >> 1);
                    const u32x2 lo = *(const LAS u32x2*)(VL + row * 512 + 16 * (ch ^ (row & 15)) + 8 * (g & 1)), hi = *(const LAS u32x2*)(VL + row * 512 + 16 * ((ch + 2) ^ (row & 15)) + 8 * (g & 1));
                    u32x4 w; w.x = lo.x; w.y = lo.y; w.z = hi.x; w.w = hi.y;
                    o = __builtin_amdgcn_mfma_f32_16x16x32_bf16(__builtin_bit_cast(bf16x8, w), Pb[ks], o, 0, 0, 0); }
                u32x2 w; w.x = pk2(o[0], o[1]); w.y = pk2(o[2], o[3]);
                *(u32x2*)(ymem + (size_t)(t0 + fr) * 512 + h * 128 + 16 * dt + 4 * g) = w;
            }
        }
        __syncthreads();
    }
}

constexpr int LDS_RELB = 131072 + 1024;
constexpr int LDS_LUT = LDS_RELB + 1024;
__device__ __forceinline__ void tr_read8(const unsigned (&a)[8], u32x2 (&d)[8]) {
    asm volatile("ds_read_b64_tr_b16 %0, %8\n\tds_read_b64_tr_b16 %1, %9\n\tds_read_b64_tr_b16 %2, %10\n\tds_read_b64_tr_b16 %3, %11\n\t"
                 "ds_read_b64_tr_b16 %4, %12\n\tds_read_b64_tr_b16 %5, %13\n\tds_read_b64_tr_b16 %6, %14\n\tds_read_b64_tr_b16 %7, %15\n\ts_waitcnt lgkmcnt(0)"
                 : "=&v"(d[0]), "=&v"(d[1]), "=&v"(d[2]), "=&v"(d[3]), "=&v"(d[4]), "=&v"(d[5]), "=&v"(d[6]), "=&v"(d[7])
                 : "v"(a[0]), "v"(a[1]), "v"(a[2]), "v"(a[3]), "v"(a[4]), "v"(a[5]), "v"(a[6]), "v"(a[7]) : "memory");
}
constexpr int LDS_DSAX = 131072 + 4096;
__device__ __forceinline__ void p5_dsa_attn(const Ctx& C, int qsel) {
    unsigned char* ws = C.ws; const int lane = C.lane, wave = C.wave, g = lane >> 4, fr = lane & 15;
    const bf16_t* qlat = (const bf16_t*)(ws + WS_QLAT); const bf16_t* kvl = (const bf16_t*)(ws + WS_KVL); const bf16_t* idxb = (const bf16_t*)(ws + WS_IDX);
    bf16_t* olat = (bf16_t*)(ws + WS_OLAT);
    LAS int* lut = (LAS int*)(C.lds + LDS_LUT);
    if (C.tid < 128) { const int n = C.tid; int bk = n; if (n >= 16) { bk = 16 + (int)(logf((float)n * (1.0f / 16.0f)) / 2.0794415416798357f * 16.0f); bk = bk > 31 ? 31 : bk; } lut[n] = bk; }
    __syncthreads();
    LAS unsigned char* my = C.lds + wave * 16384; const unsigned mybase = (unsigned)(uintptr_t)my;
    LAS bf16_t* IDXL = (LAS bf16_t*)(C.lds + LDS_DSAX + wave * 1024); LAS bf16_t* BKL = IDXL + 256;
    unsigned* qctr = (unsigned*)(ws + WS_CTL) + CW_DSAQ + 64 * qsel;
    const int qq = fr >> 2, p2 = fr & 3;
    bf16x8 Bbias;
    { float bv[8];
#pragma unroll
      for (int j = 0; j < 8; ++j) bv[j] = C.in[2][(8 * g + j) * 8 + (fr & 7)];
      Bbias = __builtin_bit_cast(bf16x8, pack8(bv)); }
    unsigned qkoff[2][4];
#pragma unroll
    for (int i = 0; i < 2; ++i) { const int ph = 4 * (fr & 7) + 2 * i + (fr >> 3);
#pragma unroll
        for (int kk = 0; kk < 4; ++kk) qkoff[i][kk] = (unsigned)(ph * 256 + 16 * ((4 * kk + g) ^ (2 * (ph & 7)))); }
    const int ph0 = 4 * (4 * (g & 1) + qq) + (g >> 1), ph1 = ph0 + 2;
    for (;;) {
      int q0 = 0; if (lane == 0) q0 = (int)__hip_atomic_fetch_add(qctr, 4u, __ATOMIC_RELAXED, __HIP_MEMORY_SCOPE_AGENT);
      q0 = __builtin_amdgcn_readfirstlane(q0); if (q0 >= T) break;
      for (int q = q0; q < q0 + 4; ++q) {
        const int b = q >> 12, s = q & (SEQ - 1); const int nvalid = s + 1 < 256 ? s + 1 : 256;
        const char* kvb = (const char*)(kvl + (size_t)b * SEQ * 128);
        {
            const u32x2 w = *(const u32x2*)(idxb + (size_t)q * 256 + 4 * lane); int ix[4] = {(int)(w.x & 0xffffu), (int)(w.x >> 16), (int)(w.y & 0xffffu), (int)(w.y >> 16)}; unsigned bk[4];
#pragma unroll
            for (int j = 0; j < 4; ++j) { if (4 * lane + j >= nvalid) ix[j] = 0; const int dist = s - ix[j]; bk[j] = (unsigned)(dist >= 128 ? 31 : lut[dist < 0 ? 0 : dist]); }
            u32x2 wi; wi.x = (unsigned)ix[0] | ((unsigned)ix[1] << 16); wi.y = (unsigned)ix[2] | ((unsigned)ix[3] << 16); *(LAS u32x2*)(IDXL + 4 * lane) = wi;
            u32x2 wb; wb.x = bk[0] | (bk[1] << 16); wb.y = bk[2] | (bk[3] << 16); *(LAS u32x2*)(BKL + 4 * lane) = wb;
        }
        bf16x8 Bq[4];
#pragma unroll
        for (int kk = 0; kk < 4; ++kk) Bq[kk] = *(const bf16x8*)(qlat + (size_t)q * 1024 + (fr & 7) * 128 + 32 * kk + 8 * g);
        float m_ref = 0.f, l_part = 0.f;
        f32x4 O[8];
#pragma unroll
        for (int cc = 0; cc < 8; ++cc) O[cc] = (f32x4){0.f, 0.f, 0.f, 0.f};
        const int nsub = (nvalid + 31) >> 5;
        asm volatile("s_waitcnt vmcnt(0) lgkmcnt(0)" ::: "memory");
        {
            const u32x4 rw = *(const LAS u32x4*)(IDXL + 8 * g); const unsigned rws[4] = {rw.x, rw.y, rw.z, rw.w};
#pragma unroll
            for (int p = 0; p < 8; ++p) { const int srow = (int)((rws[p >> 1] >> (16 * (p & 1))) & 0xffffu); const int c = fr ^ (2 * ((4 * p + g) & 7));
                __builtin_amdgcn_global_load_lds((const unsigned*)(kvb + (size_t)srow * 256 + 16 * c), (LAS unsigned*)(my + 1024 * p), 16, 0, 0); }
        }
#pragma unroll
        for (int sc_ = 0; sc_ < 8; ++sc_) {
          if (sc_ < nsub) {
            LAS unsigned char* cur = my + (sc_ & 1) * 8192; const unsigned curb = mybase + (sc_ & 1) * 8192;
            if (sc_ + 1 < nsub) {
                LAS unsigned char* nb = my + ((sc_ + 1) & 1) * 8192;
                const u32x4 rw = *(const LAS u32x4*)(IDXL + 32 * (sc_ + 1) + 8 * g); const unsigned rws[4] = {rw.x, rw.y, rw.z, rw.w};
#pragma unroll
                for (int p = 0; p < 8; ++p) { const int srow = (int)((rws[p >> 1] >> (16 * (p & 1))) & 0xffffu); const int c = fr ^ (2 * ((4 * p + g) & 7));
                    __builtin_amdgcn_global_load_lds((const unsigned*)(kvb + (size_t)srow * 256 + 16 * c), (LAS unsigned*)(nb + 1024 * p), 16, 0, 0); }
                asm volatile("s_waitcnt vmcnt(8)" ::: "memory");
            } else asm volatile("s_waitcnt vmcnt(0)" ::: "memory");
            f32x4 sc[2];
#pragma unroll
            for (int i = 0; i < 2; ++i) {
                const int pos = (int)BKL[32 * sc_ + 16 * i + fr] - 8 * g;
                u32x4 oh; oh.x = (pos == 0 ? 0x3F80u : 0u) | (pos == 1 ? 0x3F800000u : 0u); oh.y = (pos == 2 ? 0x3F80u : 0u) | (pos == 3 ? 0x3F800000u : 0u);
                oh.z = (pos == 4 ? 0x3F80u : 0u) | (pos == 5 ? 0x3F800000u : 0u); oh.w = (pos == 6 ? 0x3F80u : 0u) | (pos == 7 ? 0x3F800000u : 0u);
                f32x4 a = __builtin_amdgcn_mfma_f32_16x16x32_bf16(__builtin_bit_cast(bf16x8, oh), Bbias, (f32x4){0.f, 0.f, 0.f, 0.f}, 0, 0, 0);
#pragma unroll
                for (int kk = 0; kk < 4; ++kk) a = __builtin_amdgcn_mfma_f32_16x16x32_bf16(*(const LAS bf16x8*)(cur + qkoff[i][kk]), Bq[kk], a, 0, 0, 0);
                sc[i] = a; }
            if (nvalid < 256) {
#pragma unroll
                for (int i = 0; i < 2; ++i)
#pragma unroll
                    for (int r = 0; r < 4; ++r) if (sc_ * 32 + 16 * i + 4 * g + r >= nvalid) sc[i][r] = -INFINITY;
            }
            if (sc_ == 0) { float mx = fmaxf(fmaxf(fmaxf(sc[0][0], sc[0][1]), fmaxf(sc[0][2], sc[0][3])), fmaxf(fmaxf(sc[1][0], sc[1][1]), fmaxf(sc[1][2], sc[1][3])));
                mx = fmaxf(mx, __shfl_xor(mx, 16)); mx = fmaxf(mx, __shfl_xor(mx, 32)); m_ref = mx; }
#pragma unroll
            for (int i = 0; i < 2; ++i)
#pragma unroll
                for (int r = 0; r < 4; ++r) { sc[i][r] = __expf(sc[i][r] - m_ref); l_part += sc[i][r]; }
            u32x4 w; w.x = pk2(sc[0][0], sc[0][1]); w.y = pk2(sc[0][2], sc[0][3]); w.z = pk2(sc[1][0], sc[1][1]); w.w = pk2(sc[1][2], sc[1][3]);
            const bf16x8 Pa = __builtin_bit_cast(bf16x8, w);
#pragma unroll
            for (int hf = 0; hf < 2; ++hf) {
                unsigned ad[8]; u32x2 dd[8];
#pragma unroll
                for (int c4 = 0; c4 < 4; ++c4) { const int chk = 2 * (4 * hf + c4) + (p2 >> 1);
                    ad[2 * c4] = curb + ph0 * 256 + 16 * (chk ^ (2 * (ph0 & 7))) + 8 * (p2 & 1); ad[2 * c4 + 1] = curb + ph1 * 256 + 16 * (chk ^ (2 * (ph1 & 7))) + 8 * (p2 & 1); }
                tr_read8(ad, dd);
#pragma unroll
                for (int c4 = 0; c4 < 4; ++c4) { u32x4 bw; bw.x = dd[2 * c4].x; bw.y = dd[2 * c4].y; bw.z = dd[2 * c4 + 1].x; bw.w = dd[2 * c4 + 1].y;
                    O[4 * hf + c4] = __builtin_amdgcn_mfma_f32_16x16x32_bf16(Pa, __builtin_bit_cast(bf16x8, bw), O[4 * hf + c4], 0, 0, 0); }
            }
            asm volatile("" ::: "memory");
          }
        }
        float l_run = l_part; l_run += __shfl_xor(l_run, 16); l_run += __shfl_xor(l_run, 32);
        const float inv = 1.0f / l_run; float ir[4];
#pragma unroll
        for (int r = 0; r < 4; ++r) ir[r] = __shfl(inv, 4 * g + r);
        if (g < 2) {
#pragma unroll
            for (int cc = 0; cc < 8; ++cc)
#pragma unroll
                for (int r = 0; r < 4; ++r) olat[(size_t)q * 1024 + (4 * g + r) * 128 + 16 * cc + fr] = (bf16_t)f2bf(O[cc][r] * ir[r]);
        }
      }
    }
}

constexpr int RWM_LDS = 15872;
__device__ __forceinline__ bf16x8 frag_pack(f32x4 lo, f32x4 hi) { u32x4 w; w.x = pk2(lo.x, lo.y); w.y = pk2(lo.z, lo.w); w.z = pk2(hi.x, hi.y); w.w = pk2(hi.z, hi.w); return __builtin_bit_cast(bf16x8, w); }
__device__ __forceinline__ bf16x8 frag_pack_lo(f32x4 lo) { u32x4 w; w.x = pk2(lo.x, lo.y); w.y = pk2(lo.z, lo.w); w.z = 0u; w.w = 0u; return __builtin_bit_cast(bf16x8, w); }
struct RwIn { u32x4 e[2], k[2], a[2]; };
template <int MODE> __device__ __forceinline__ void rwm_fetch(RwIn& w, const bf16_t* pe, const bf16_t* pk, const bf16_t* pa, const bf16_t* pr, const bf16_t* pv, const bf16_t* pg, size_t t0, int h, int g, int fr) {
    const size_t rowoff = (t0 + fr) * 512 + h * 64;
#pragma unroll
    for (int k2 = 0; k2 < 2; ++k2) { const int c0 = 32 * k2 + 8 * g; w.e[k2] = *(const u32x4*)(pe + rowoff + c0); w.k[k2] = *(const u32x4*)(pk + rowoff + c0); w.a[k2] = *(const u32x4*)(pa + rowoff + c0);
        }
}
__device__ __forceinline__ void tr_read4(const unsigned (&a)[4], u32x2 (&d)[4]) {
    asm volatile("ds_read_b64_tr_b16 %0, %4\n\tds_read_b64_tr_b16 %1, %5\n\tds_read_b64_tr_b16 %2, %6\n\tds_read_b64_tr_b16 %3, %7\n\ts_waitcnt lgkmcnt(0)"
                 : "=&v"(d[0]), "=&v"(d[1]), "=&v"(d[2]), "=&v"(d[3]) : "v"(a[0]), "v"(a[1]), "v"(a[2]), "v"(a[3]) : "memory");
}
template <int O0, int O1, int O2, int O3> __device__ __forceinline__ void tr_read4_off(unsigned base, u32x2 (&d)[4]) {
    asm volatile("ds_read_b64_tr_b16 %0, %4 offset:%5\n\tds_read_b64_tr_b16 %1, %4 offset:%6\n\tds_read_b64_tr_b16 %2, %4 offset:%7\n\tds_read_b64_tr_b16 %3, %4 offset:%8\n\ts_waitcnt lgkmcnt(0)"
                 : "=&v"(d[0]), "=&v"(d[1]), "=&v"(d[2]), "=&v"(d[3]) : "v"(base), "i"(O0), "i"(O1), "i"(O2), "i"(O3) : "memory");
}
__device__ __forceinline__ bf16x8 frag_lo_raw(u32x2 lo) { u32x4 w; w.x = lo.x; w.y = lo.y; w.z = 0u; w.w = 0u; return __builtin_bit_cast(bf16x8, w); }
__device__ __forceinline__ bf16x8 frag_pack_raw(f32x4 lo, u32x2 hi) { u32x4 w; w.x = pk2(lo.x, lo.y); w.y = pk2(lo.z, lo.w); w.z = hi.x; w.w = hi.y; return __builtin_bit_cast(bf16x8, w); }
template <int MODE> __device__ __forceinline__ void rwm_task(const Ctx& C, int bh, int ch) {
    unsigned char* ws = C.ws; const int lane = C.lane, g = lane >> 4, fr = lane & 15; const int b = bh >> 3, h = bh & 7;
    const bf16_t* pr = (const bf16_t*)(ws + WS_RW_R); const bf16_t* pk = (const bf16_t*)(ws + WS_RW_K); const bf16_t* pv = (const bf16_t*)(ws + WS_RW_V);
    const bf16_t* pa = (const bf16_t*)(ws + WS_RW_A); const bf16_t* pe = (const bf16_t*)(ws + WS_RW_E); const bf16_t* pg = (const bf16_t*)(ws + WS_RW_G);
    bf16_t* yo = (bf16_t*)(ws + WS_YRWKV);
    float* PQ = (float*)(C.dout + DO_PQ);
    LAS unsigned char* my = C.lds + C.wave * RWM_LDS; const unsigned myb = (unsigned)(uintptr_t)my;
    LAS unsigned char* SI = my; LAS unsigned char* BI = my + 9216; LAS unsigned char* KI = my + 11264; LAS float* CL = (LAS float*)(my + 13312); LAS unsigned char* VI = my + 13824;
    const gfp in16 = (gfp)C.in[16], in17 = (gfp)C.in[17], in18 = (gfp)C.in[18], in19 = (gfp)C.in[19], in20 = (gfp)C.in[20];
    const size_t tok0 = (size_t)b * SEQ + (size_t)ch * RL;
    const f32x4 Z4 = (f32x4){0.f, 0.f, 0.f, 0.f};
    const float* sbase = PQ + ((size_t)((bh * RCH + (ch > 0 ? ch - 1 : 0)) * 2)) * 4096 + (4 * g) * 64 + fr;
    int gv = g; asm volatile("" : "+v"(gv));
    f32x4 S[4][4];
#pragma unroll
    for (int vt = 0; vt < 4; ++vt)
#pragma unroll
        for (int kt = 0; kt < 4; ++kt) {
            if (MODE == 1) { f32x4 x;
#pragma unroll
                for (int r = 0; r < 4; ++r) x[r] = (vt == kt && 4 * gv + r == fr) ? 1.f : 0.f;
                S[vt][kt] = x; }
            else if (MODE == 2 && ch > 0) { f32x4 x; gfp sp = (gfp)(sbase + 1024 * vt); asm volatile("" : "+v"(sp));
#pragma unroll
                for (int r = 0; r < 4; ++r) x[r] = sp[r * 64 + 16 * kt];
                S[vt][kt] = x; }
            else S[vt][kt] = Z4; }
    const bool strict[4] = {4 * g + 0 < fr, 4 * g + 1 < fr, 4 * g + 2 < fr, 4 * g + 3 < fr};
    const bool incl[4] = {4 * g + 0 <= fr, 4 * g + 1 <= fr, 4 * g + 2 <= fr, 4 * g + 3 <= fr};
    const int qq = fr >> 2, p2 = fr & 3; const unsigned trb = myb + (unsigned)((4 * g + qq) * 128 + 8 * p2);
    RwIn nxt; rwm_fetch<MODE>(nxt, pe, pk, pa, pr, pv, pg, tok0, h, g, fr);
#pragma unroll 1
    for (int sub = 0; sub < RL / 16; ++sub) {
        const size_t t0 = tok0 + (size_t)sub * 16;
        int frl = fr, gl_ = g; asm volatile("" : "+v"(frl), "+v"(gl_));
        u32x4 gq[2], rq[2], vq[2];
        { const size_t ro0 = (t0 + frl) * 512 + h * 64 + 8 * gl_;
          if (MODE == 2) { gq[0] = *(const u32x4*)(pg + ro0); gq[1] = *(const u32x4*)(pg + ro0 + 32); rq[0] = *(const u32x4*)(pr + ro0); rq[1] = *(const u32x4*)(pr + ro0 + 32); }
          if (MODE != 1) { vq[0] = *(const u32x4*)(pv + ro0); vq[1] = *(const u32x4*)(pv + ro0 + 32); } }
        const RwIn cur = nxt; rwm_fetch<MODE>(nxt, pe, pk, pa, pr, pv, pg, tok0 + (size_t)(sub + 1 < RL / 16 ? sub + 1 : sub) * 16, h, gl_, frl);
#pragma unroll
        for (int vt = 0; vt < 4; ++vt)
#pragma unroll
            for (int kt = 0; kt < 4; ++kt)
#pragma unroll
                for (int r = 0; r < 4; ++r) *(LAS bf16_t*)(SI + (4 * g) * 144 + 2 * fr + (16 * vt + r) * 144 + 32 * kt) = (bf16_t)f2bf(S[vt][kt][r]);
        bf16x8 kap[2], rtl[2]; float bcoef = 0.f;
        {
            float ssq = 0.f, bsum = 0.f;
#pragma unroll
            for (int k2 = 0; k2 < 2; ++k2) { const int c0 = 32 * k2 + 8 * g; float kv[8]; unpack8(cur.k[k2], kv);
                const f32x4 kk0 = *(const __attribute__((address_space(1))) f32x4*)(in16 + h * 64 + c0), kk1 = *(const __attribute__((address_space(1))) f32x4*)(in16 + h * 64 + c0 + 4); const float kkc[8] = {kk0.x, kk0.y, kk0.z, kk0.w, kk1.x, kk1.y, kk1.z, kk1.w};
#pragma unroll
                for (int j = 0; j < 8; ++j) { const float x = kv[j] * kkc[j]; ssq += x * x; } }
            ssq += __shfl_xor(ssq, 16); ssq += __shfl_xor(ssq, 32);
            const float rn = __builtin_amdgcn_rsqf(fmaxf(ssq, 1e-24f));
#pragma unroll
            for (int k2 = 0; k2 < 2; ++k2) { const int c0 = 32 * k2 + 8 * g; float ev[8], kv[8], aa[8], rv[8];
                __builtin_amdgcn_sched_barrier(0);
                unpack8(cur.e[k2], ev); unpack8(cur.k[k2], kv); unpack8(cur.a[k2], aa);
                if (MODE == 2) unpack8(rq[k2], rv);
                const f32x4 ka0 = *(const __attribute__((address_space(1))) f32x4*)(in17 + h * 64 + c0), ka1 = *(const __attribute__((address_space(1))) f32x4*)(in17 + h * 64 + c0 + 4); const float kac[8] = {ka0.x, ka0.y, ka0.z, ka0.w, ka1.x, ka1.y, ka1.z, ka1.w};
                const f32x4 kk0 = *(const __attribute__((address_space(1))) f32x4*)(in16 + h * 64 + c0), kk1 = *(const __attribute__((address_space(1))) f32x4*)(in16 + h * 64 + c0 + 4); const float kkc[8] = {kk0.x, kk0.y, kk0.z, kk0.w, kk1.x, kk1.y, kk1.z, kk1.w};
                float rkc[8];
                if (MODE == 2) { const f32x4 r0 = *(const __attribute__((address_space(1))) f32x4*)(in18 + h * 64 + c0), r1 = *(const __attribute__((address_space(1))) f32x4*)(in18 + h * 64 + c0 + 4); rkc[0] = r0.x; rkc[1] = r0.y; rkc[2] = r0.z; rkc[3] = r0.w; rkc[4] = r1.x; rkc[5] = r1.y; rkc[6] = r1.z; rkc[7] = r1.w; }
                float kt_[8], bt_[8], kxt_[8], rt_[8];
#pragma unroll
                for (int j = 0; j < 8; ++j) {
                    float c = ev[j]; c += dpp_f<0x111>(c); c += dpp_f<0x112>(c); c += dpp_f<0x114>(c); c += dpp_f<0x118>(c);
                    const float kx = kv[j] * (1.0f + (aa[j] - 1.0f) * kac[j]); const float kk = kv[j] * kkc[j] * rn;
                    const float e2 = __expf(c), e3 = __builtin_amdgcn_rcpf(e2), e1 = e3 * __expf(ev[j]);
                    kt_[j] = kk * e1; bt_[j] = kk * aa[j] * e2; kxt_[j] = kx * e2;
                    if (MODE == 2) { rt_[j] = rv[j] * e3; bsum += rv[j] * kx * rkc[j]; } else rt_[j] = 0.f;
                    if (fr == 15) CL[c0 + j] = c;
                }
                kap[k2] = __builtin_bit_cast(bf16x8, pack8(kt_)); if (MODE == 2) rtl[k2] = __builtin_bit_cast(bf16x8, pack8(rt_));
                *(LAS u32x4*)(BI + fr * 128 + 64 * k2 + 16 * g) = pack8(bt_); *(LAS u32x4*)(KI + fr * 128 + 64 * k2 + 16 * g) = pack8(kxt_);
            }
            if (MODE == 2) { bsum += __shfl_xor(bsum, 16); bsum += __shfl_xor(bsum, 32); bcoef = bsum; }
        }
        bf16x8 bet[2], kxf[2];
#pragma unroll
        for (int k2 = 0; k2 < 2; ++k2) { bet[k2] = *(const LAS bf16x8*)(BI + fr * 128 + 64 * k2 + 16 * g); kxf[k2] = *(const LAS bf16x8*)(KI + fr * 128 + 64 * k2 + 16 * g); }
        u32x2 VT[4];
        if (MODE != 1) {
#pragma unroll
            for (int k2 = 0; k2 < 2; ++k2) *(LAS u32x4*)(VI + fr * 128 + 64 * k2 + 16 * g) = vq[k2];
            tr_read4_off<13824, 13824 + 32, 13824 + 64, 13824 + 96>(trb, VT);
        } else {
#pragma unroll
            for (int vt = 0; vt < 4; ++vt) { VT[vt].x = 0u; VT[vt].y = 0u; }
        }
        f32x4 AT = Z4, BmT = Z4, C1T = Z4, C2T = Z4;
#pragma unroll
        for (int k2 = 0; k2 < 2; ++k2) { AT = __builtin_amdgcn_mfma_f32_16x16x32_bf16(bet[k2], kap[k2], AT, 0, 0, 0);
            if (MODE != 1) BmT = __builtin_amdgcn_mfma_f32_16x16x32_bf16(kxf[k2], kap[k2], BmT, 0, 0, 0);
            if (MODE == 2) { C1T = __builtin_amdgcn_mfma_f32_16x16x32_bf16(bet[k2], rtl[k2], C1T, 0, 0, 0); C2T = __builtin_amdgcn_mfma_f32_16x16x32_bf16(kxf[k2], rtl[k2], C2T, 0, 0, 0); } }
#pragma unroll
        for (int r = 0; r < 4; ++r) { AT[r] = strict[r] ? AT[r] : 0.f; BmT[r] = strict[r] ? BmT[r] : 0.f; C1T[r] = incl[r] ? C1T[r] : 0.f; C2T[r] = incl[r] ? C2T[r] : 0.f; }
        float tr[16];
        int frv = fr; asm volatile("" : "+v"(frv));
#pragma unroll
        for (int c = 15; c >= 0; --c) { float s = (c == frv) ? 1.f : 0.f;
#pragma unroll
            for (int j = c + 1; j < 16; ++j) { const float ajc = __builtin_bit_cast(float, __builtin_amdgcn_readlane(__builtin_bit_cast(int, AT[c & 3]), j + 16 * (c >> 2))); s = fmaf(-tr[j], ajc, s); }
            tr[c] = s; }
        f32x4 Tq;
#pragma unroll
        for (int jj = 0; jj < 4; ++jj) Tq[jj] = g == 0 ? tr[jj] : (g == 1 ? tr[4 + jj] : (g == 2 ? tr[8 + jj] : tr[12 + jj]));
        const bf16x8 Tf = frag_pack_lo(Tq), Bmf = frag_pack_lo(BmT), Cf = frag_pack(C1T, C2T);
        f32x4 Zt[4], Yt[4];
#pragma unroll
        for (int vt = 0; vt < 4; ++vt) {
            const int v = 16 * vt + fr;
            const bf16x8 s0 = *(const LAS bf16x8*)(SI + v * 144 + 16 * g), s1 = *(const LAS bf16x8*)(SI + v * 144 + 64 + 16 * g);
            f32x4 rhs = __builtin_amdgcn_mfma_f32_16x16x32_bf16(kap[0], s0, Z4, 0, 0, 0); rhs = __builtin_amdgcn_mfma_f32_16x16x32_bf16(kap[1], s1, rhs, 0, 0, 0);
            if (MODE != 1) rhs = __builtin_amdgcn_mfma_f32_16x16x32_bf16(Bmf, frag_lo_raw(VT[vt]), rhs, 0, 0, 0);
            f32x4 z = __builtin_amdgcn_mfma_f32_16x16x32_bf16(Tf, frag_pack_lo(rhs), Z4, 0, 0, 0);
            Zt[vt] = -z;
            if (MODE == 2) { f32x4 y = __builtin_amdgcn_mfma_f32_16x16x32_bf16(rtl[0], s0, Z4, 0, 0, 0); y = __builtin_amdgcn_mfma_f32_16x16x32_bf16(rtl[1], s1, y, 0, 0, 0);
                Yt[vt] = __builtin_amdgcn_mfma_f32_16x16x32_bf16(Cf, frag_pack_raw(Zt[vt], VT[vt]), y, 0, 0, 0); }
        }
        if (MODE == 2) {
            u32x2 GT[4];
            {
#pragma unroll
                for (int k2 = 0; k2 < 2; ++k2) *(LAS u32x4*)(VI + fr * 128 + 64 * k2 + 16 * g) = gq[k2];
                tr_read4_off<13824, 13824 + 32, 13824 + 64, 13824 + 96>(trb, GT);
            }
#pragma unroll
            for (int r = 0; r < 4; ++r) {
                const float mean = row_sum_f(Yt[0][r] + Yt[1][r] + Yt[2][r] + Yt[3][r]) * (1.0f / 64.0f);
                const float d0 = Yt[0][r] - mean, d1 = Yt[1][r] - mean, d2 = Yt[2][r] - mean, d3 = Yt[3][r] - mean;
                const float rstd = rsqrtf(row_sum_f(d0 * d0 + d1 * d1 + d2 * d2 + d3 * d3) * (1.0f / 64.0f) + 64e-5f);
                const float bc = __shfl(bcoef, 4 * g + r); const float dd_[4] = {d0, d1, d2, d3}; const size_t ro = (t0 + 4 * gl_ + r) * 512 + h * 64 + frl;
#pragma unroll
                for (int vt = 0; vt < 4; ++vt) { const unsigned gw2 = r < 2 ? GT[vt].x : GT[vt].y, vw2 = r < 2 ? VT[vt].x : VT[vt].y; const float gate = (r & 1) ? bfhi(gw2) : bflo(gw2), vval = (r & 1) ? bfhi(vw2) : bflo(vw2);
                    yo[ro + 16 * vt] = (bf16_t)f2bf((dd_[vt] * rstd * in19[h * 64 + 16 * vt + frl] + in20[h * 64 + 16 * vt + frl] + bc * vval) * gate); }
            }
        }
        {
            u32x2 db[4], dk[4], dd[8];
            tr_read4_off<9216, 9216 + 32, 9216 + 64, 9216 + 96>(trb, db); tr_read4_off<11264, 11264 + 32, 11264 + 64, 11264 + 96>(trb, dk);
#pragma unroll
            for (int kt = 0; kt < 4; ++kt) { dd[2 * kt] = db[kt]; dd[2 * kt + 1] = dk[kt]; }
            float gl[4];
#pragma unroll
            for (int kt = 0; kt < 4; ++kt) gl[kt] = __expf(-CL[16 * kt + fr]);
#pragma unroll
            for (int vt = 0; vt < 4; ++vt) { const bf16x8 Af = frag_pack_raw(Zt[vt], VT[vt]);
#pragma unroll
                for (int kt = 0; kt < 4; ++kt) { u32x4 bw; bw.x = dd[2 * kt].x; bw.y = dd[2 * kt].y; bw.z = dd[2 * kt + 1].x; bw.w = dd[2 * kt + 1].y;
                    S[vt][kt] = __builtin_amdgcn_mfma_f32_16x16x32_bf16(Af, __builtin_bit_cast(bf16x8, bw), S[vt][kt], 0, 0, 0) * gl[kt]; } }
        }
    }
    if (MODE != 2) { float* dst = PQ + ((size_t)((bh * RCH + ch) * 2 + MODE)) * 4096 + (4 * g) * 64 + fr;
#pragma unroll
        for (int vt = 0; vt < 4; ++vt)
#pragma unroll
            for (int kt = 0; kt < 4; ++kt)
#pragma unroll
                for (int r = 0; r < 4; ++r) dst[(16 * vt + r) * 64 + 16 * kt] = S[vt][kt][r]; }
}
__device__ __forceinline__ void p4_rwkv_pass1(const Ctx& C) {
    for (int task = C.gw; task < 32 * (RCH - 1) * 2; task += C.ngw) { const int mode = task & 1, rr = task >> 1, ch = rr % (RCH - 1), bh = rr / (RCH - 1);
        if (mode == 0) rwm_task<0>(C, bh, ch); else rwm_task<1>(C, bh, ch); }
}
__device__ __forceinline__ void p6_rwkv_pass3(const Ctx& C) {
    for (int task = (int)blockIdx.x + C.G * C.wave; task < 32 * RCH; task += C.G * NWAVES) rwm_task<2>(C, task / RCH, task % RCH);
}
__device__ __forceinline__ void p5_rwkv_carry(const Ctx& C) {
    float* PQ = (float*)(C.dout + DO_PQ); const int lane = C.lane, wave = C.wave, tid = C.tid;
    LAS float* ST = (LAS float*)C.lds;
    LAS float* PL = (LAS float*)(C.lds + 32768);
    for (int bh = blockIdx.x; bh < 32; bh += C.G) {
        for (int i = tid; i < 4096; i += NTHREADS) ST[i] = 0.f;
        const float* base = PQ + (size_t)(bh * RCH) * 2 * 4096;
        f32x4 pa = *(const f32x4*)(base + 4096 + tid * 8), pb = *(const f32x4*)(base + 4096 + tid * 8 + 4);
        f32x4 q0 = *(const f32x4*)(base + lane * 64 + 8 * wave), q1 = *(const f32x4*)(base + lane * 64 + 8 * wave + 4);
        __syncthreads();
        for (int ch = 0; ch < RCH - 1; ++ch) {
            LAS float* cur = ST + (ch & 1) * 4096; LAS float* nxt = ST + ((ch + 1) & 1) * 4096;
            float* Q = PQ + ((size_t)((bh * RCH + ch) * 2)) * 4096;
            *(LAS f32x4*)(PL + tid * 8) = pa; *(LAS f32x4*)(PL + tid * 8 + 4) = pb;
            float acc[8] = {q0.x, q0.y, q0.z, q0.w, q1.x, q1.y, q1.z, q1.w};
            __syncthreads();
            const int cn = ch + 1 < RCH - 1 ? ch + 1 : ch; const float* nb = PQ + ((size_t)((bh * RCH + cn) * 2)) * 4096;
            pa = *(const f32x4*)(nb + 4096 + tid * 8); pb = *(const f32x4*)(nb + 4096 + tid * 8 + 4);
            q0 = *(const f32x4*)(nb + lane * 64 + 8 * wave); q1 = *(const f32x4*)(nb + lane * 64 + 8 * wave + 4);
#pragma unroll 8
            for (int j = 0; j < 64; ++j) { const float sj = cur[j * 64 + lane]; const f32x4 p0 = *(const LAS f32x4*)(PL + j * 64 + 8 * wave), p1 = *(const LAS f32x4*)(PL + j * 64 + 8 * wave + 4);
                acc[0] = fmaf(sj, p0.x, acc[0]); acc[1] = fmaf(sj, p0.y, acc[1]); acc[2] = fmaf(sj, p0.z, acc[2]); acc[3] = fmaf(sj, p0.w, acc[3]);
                acc[4] = fmaf(sj, p1.x, acc[4]); acc[5] = fmaf(sj, p1.y, acc[5]); acc[6] = fmaf(sj, p1.z, acc[6]); acc[7] = fmaf(sj, p1.w, acc[7]); }
            *(f32x4*)(Q + lane * 64 + 8 * wave) = (f32x4){acc[0], acc[1], acc[2], acc[3]}; *(f32x4*)(Q + lane * 64 + 8 * wave + 4) = (f32x4){acc[4], acc[5], acc[6], acc[7]};
#pragma unroll
            for (int kk = 0; kk < 8; ++kk) nxt[(8 * wave + kk) * 64 + lane] = acc[kk];
            __syncthreads();
        }
    }
}

__device__ __forceinline__ void p8_ln1(const Ctx& C) {
    const float* pre = (const float*)C.dout; float* x1 = (float*)(C.ws + WS_X1); bf16_t* x1b = (bf16_t*)(C.ws + WS_X1B); const int lane = C.lane;
    const float* gam = C.in[26]; const float* bet = C.in[27];
    for (int t = C.gw; t < T; t += C.ngw) {
        const float* p = pre + (size_t)t * 1024; float v[16];
#pragma unroll
        for (int hh = 0; hh < 2; ++hh) { const f32x4 a = *(const f32x4*)(p + hh * 512 + 8 * lane), b = *(const f32x4*)(p + hh * 512 + 8 * lane + 4);
            v[8 * hh] = a.x; v[8 * hh + 1] = a.y; v[8 * hh + 2] = a.z; v[8 * hh + 3] = a.w; v[8 * hh + 4] = b.x; v[8 * hh + 5] = b.y; v[8 * hh + 6] = b.z; v[8 * hh + 7] = b.w; }
        float s = 0.f;
#pragma unroll
        for (int j = 0; j < 16; ++j) s += v[j];
        const float mean = wave_sum(s) * (1.0f / 1024.0f); float s2 = 0.f;
#pragma unroll
        for (int j = 0; j < 16; ++j) { v[j] -= mean; s2 += v[j] * v[j]; }
        const float rstd = rsqrtf(wave_sum(s2) * (1.0f / 1024.0f) + 1e-5f);
#pragma unroll
        for (int hh = 0; hh < 2; ++hh) { const int c0 = hh * 512 + 8 * lane; float o[8];
#pragma unroll
            for (int j = 0; j < 8; ++j) o[j] = v[8 * hh + j] * rstd * gam[c0 + j] + bet[c0 + j];
            *(f32x4*)(x1 + (size_t)t * 1024 + c0) = (f32x4){o[0], o[1], o[2], o[3]}; *(f32x4*)(x1 + (size_t)t * 1024 + c0 + 4) = (f32x4){o[4], o[5], o[6], o[7]};
            *(u32x4*)(x1b + (size_t)t * 1024 + c0) = pack8(o); }
    }
    cvt_rows_fp8(G_(C.in[30]), C.ws + WS_UB, (size_t)16384 * 1024 / 16, PEER_U_SCALE, C.gt, C.ngt);
    cvt_rows_fp8(G_(C.in[31]), C.ws + WS_VB, (size_t)16384 * 1024 / 16, PEER_V_SCALE, C.gt, C.ngt);
}

#define CE_DESC(a, b) do { const unsigned hi_ = k[a] > k[b] ? k[a] : k[b], lo_ = k[a] > k[b] ? k[b] : k[a]; k[a] = hi_; k[b] = lo_; } while (0)
__device__ __forceinline__ unsigned pop16_of8(unsigned (&k)[8], int fr) {
    CE_DESC(0, 1); CE_DESC(2, 3); CE_DESC(4, 5); CE_DESC(6, 7); CE_DESC(0, 2); CE_DESC(1, 3); CE_DESC(4, 6); CE_DESC(5, 7); CE_DESC(1, 2); CE_DESC(5, 6);
    CE_DESC(0, 4); CE_DESC(1, 5); CE_DESC(2, 6); CE_DESC(3, 7); CE_DESC(2, 4); CE_DESC(3, 5); CE_DESC(1, 2); CE_DESC(3, 4); CE_DESC(5, 6);
    unsigned res = 0u;
#pragma unroll
    for (int rd = 0; rd < 16; ++rd) {
        const unsigned m = row_max_u(k[0]); const bool mine = (k[0] == m);
#pragma unroll
        for (int j = 0; j < 7; ++j) k[j] = mine ? k[j + 1] : k[j];
        k[7] = mine ? 0u : k[7];
        res = (fr == rd) ? m : res;
    }
    return res;
}
__device__ __forceinline__ unsigned pop16_of4(unsigned (&k)[4], int fr) {
    CE_DESC(0, 1); CE_DESC(2, 3); CE_DESC(0, 2); CE_DESC(1, 3); CE_DESC(1, 2);
    unsigned res = 0u;
#pragma unroll
    for (int rd = 0; rd < 16; ++rd) {
        const unsigned m = row_max_u(k[0]); const bool mine = (k[0] == m);
        k[0] = mine ? k[1] : k[0]; k[1] = mine ? k[2] : k[1]; k[2] = mine ? k[3] : k[2]; k[3] = mine ? 0u : k[3];
        res = (fr == rd) ? m : res;
    }
    return res;
}
__device__ const unsigned char CAND_AB[64] = {
    0x00, 0x01, 0x02, 0x03, 0x04, 0x05, 0x06, 0x07, 0x08, 0x09, 0x0a, 0x0b, 0x0c, 0x0d, 0x0e, 0x0f,
    0x10, 0x11, 0x12, 0x13, 0x14, 0x15, 0x16, 0x17, 0x20, 0x21, 0x22, 0x23, 0x24, 0x30, 0x31, 0x32,
    0x33, 0x40, 0x41, 0x42, 0x50, 0x51, 0x60, 0x61, 0x70, 0x71, 0x80, 0x90, 0xa0, 0xb0, 0xc0, 0xd0,
    0xe0, 0xf0, 0xff, 0xff, 0xff, 0xff, 0xff, 0xff, 0xff, 0xff, 0xff, 0xff, 0xff, 0xff, 0xff, 0xff};
__device__ __forceinline__ void p10_peer_route(const Ctx& C) {
    unsigned char* ws = C.ws; const int lane = C.lane, g = lane >> 4, fr = lane & 15;
    const bf16_t* qp = (const bf16_t*)C.dout; const bf16_t* keys = (const bf16_t*)(ws + WS_KEYS);
    int* experts = (int*)(ws + WS_EXPERTS); float* pgates = (float*)(ws + WS_PGATES);
    const unsigned cand4 = *(const unsigned*)(CAND_AB + 4 * fr);
    LAS unsigned char* KL = C.lds;
#pragma unroll
    for (int pp = 0; pp < 8; ++pp) { const int p = C.wave + 8 * pp; const int row = 4 * p + g; const int c = fr ^ (2 * (row & 7));
        __builtin_amdgcn_global_load_lds((const unsigned*)((const char*)keys + row * 256 + 16 * c), (LAS unsigned*)(KL + 1024 * p), 16, 0, 0); }
    asm volatile("s_waitcnt vmcnt(0)" ::: "memory");
    __syncthreads();
    for (int task = C.gw; task < T / 2; task += C.ngw) {
        const int t0 = task * 2;
        unsigned sel[2][4];
#pragma unroll
        for (int p = 0; p < 2; ++p) {
            bf16x8 A[4];
#pragma unroll
            for (int kk = 0; kk < 4; ++kk) A[kk] = *(const bf16x8*)(qp + (size_t)(t0 + (fr >> 3)) * 2048 + (fr & 7) * 256 + p * 128 + 32 * kk + 8 * g);
            f32x4 acc[8];
#pragma unroll
            for (int i = 0; i < 8; ++i) { if ((i & 1) == 0) __builtin_amdgcn_sched_barrier(0); acc[i] = (f32x4){0.f, 0.f, 0.f, 0.f};
#pragma unroll
                for (int kk = 0; kk < 4; ++kk) { const int row = p * 128 + 16 * i + fr; const bf16x8 Bk = *(const LAS bf16x8*)(KL + row * 256 + 16 * ((4 * kk + g) ^ (2 * (row & 7))));
                    acc[i] = __builtin_amdgcn_mfma_f32_16x16x32_bf16(A[kk], Bk, acc[i], 0, 0, 0); } }
#pragma unroll
            for (int r = 0; r < 4; ++r) { __builtin_amdgcn_sched_barrier(0); unsigned k[8];
#pragma unroll
                for (int i = 0; i < 8; ++i) k[i] = (f2key(acc[i][r]) & 0xffffff80u) | (unsigned)(16 * i + fr);
                sel[p][r] = pop16_of8(k, fr); }
        }
#pragma unroll
        for (int r = 0; r < 4; ++r) {
            __builtin_amdgcn_sched_barrier(0);
            const float s1 = key2f(sel[0][r] & 0xffffff80u), s2 = key2f(sel[1][r] & 0xffffff80u);
            unsigned k[4];
#pragma unroll
            for (int j = 0; j < 4; ++j) {
                const unsigned ab = (cand4 >> (8 * j)) & 0xffu; const unsigned msk = ab == 0xffu ? 0u : 0xffffffffu;
                const float va = __builtin_bit_cast(float, __builtin_amdgcn_ds_bpermute((int)(4u * (16u * g + (ab >> 4))), __builtin_bit_cast(int, s1)));
                const float vb = __builtin_bit_cast(float, __builtin_amdgcn_ds_bpermute((int)(4u * (16u * g + (ab & 15u))), __builtin_bit_cast(int, s2)));
                k[j] = ((f2key(va + vb) & 0xffffff00u) | ab) & msk;
            }
            const unsigned top = pop16_of4(k, fr);
            const int a = (int)((top >> 4) & 15u), b = (int)(top & 15u);
            const int i1 = __builtin_amdgcn_ds_bpermute(4 * (16 * g + a), (int)(sel[0][r] & 0x7fu));
            const int i2 = __builtin_amdgcn_ds_bpermute(4 * (16 * g + b), (int)(sel[1][r] & 0x7fu));
            const float sc = key2f(top & 0xffffff00u);
            const float mx = key2f(row_max_u(top) & 0xffffff00u);
            const float ev = __expf(sc - mx); const float sm = row_sum_f(ev);
            const int row = 4 * g + r; const size_t o = (size_t)(t0 + (row >> 3)) * 128 + (row & 7) * 16 + fr;
            experts[o] = i1 * 128 + i2; pgates[o] = ev / sm;
        }
    }
}
#undef CE_DESC

__device__ __forceinline__ float gelu_erf(float x) { return 0.5f * x * (1.0f + erff(x * 0.7071067811865476f)); }
typedef __bf16 bf2_t __attribute__((ext_vector_type(2)));
__device__ __forceinline__ unsigned fp8x2_to_bf16x2(unsigned w, bool hi) { return hi ? __builtin_bit_cast(unsigned, __builtin_amdgcn_cvt_scalef32_pk_bf16_fp8(w, 1.0f, true)) : __builtin_bit_cast(unsigned, __builtin_amdgcn_cvt_scalef32_pk_bf16_fp8(w, 1.0f, false)); }
__device__ __forceinline__ void p11_peer_experts(const Ctx& C) {
    unsigned char* ws = C.ws; const int lane = C.lane, g = lane >> 4, fr = lane & 15;
    const bf16_t* x1b = (const bf16_t*)(ws + WS_X1B); const float* x1 = (const float*)(ws + WS_X1);
    const unsigned char* ub = ws + WS_UB; const unsigned char* vb = ws + WS_VB;
    const int* experts = (const int*)(ws + WS_EXPERTS); const float* pgates = (const float*)(ws + WS_PGATES);
    float* out = (float*)C.dout; const float* gam = C.in[32]; const float* bet = C.in[33];
    LAS unsigned char* my = C.lds + C.wave * 4096;
    LAS float* cf = (LAS float*)(my + 2048); LAS int* eidl = (LAS int*)(my + 2560);
    for (int t = C.gw; t < T; t += C.ngw) {
        { const u32x4 a = *(const u32x4*)(x1b + (size_t)t * 1024 + 16 * lane), b = *(const u32x4*)(x1b + (size_t)t * 1024 + 16 * lane + 8);
          *(LAS u32x4*)(my + 32 * lane) = a; *(LAS u32x4*)(my + 32 * lane + 16) = b; }
        { const int e0 = experts[(size_t)t * 128 + lane], e1 = experts[(size_t)t * 128 + 64 + lane]; eidl[lane] = e0; eidl[64 + lane] = e1; }
        asm volatile("s_waitcnt lgkmcnt(0)" ::: "memory");
#pragma unroll 1
        for (int i = 0; i < 8; ++i) {
            const int e = eidl[16 * i + fr]; const unsigned char* urow = ub + (size_t)e * 1024 + 16 * g;
            f32x4 acc = (f32x4){0.f, 0.f, 0.f, 0.f};
#pragma unroll 8
            for (int m = 0; m < 16; ++m) {
                const u32x4 raw = *(const u32x4*)(urow + 64 * m);
                u32x4 a0, a1; a0.x = fp8x2_to_bf16x2(raw.x, false); a0.y = fp8x2_to_bf16x2(raw.x, true); a0.z = fp8x2_to_bf16x2(raw.y, false); a0.w = fp8x2_to_bf16x2(raw.y, true);
                a1.x = fp8x2_to_bf16x2(raw.z, false); a1.y = fp8x2_to_bf16x2(raw.z, true); a1.z = fp8x2_to_bf16x2(raw.w, false); a1.w = fp8x2_to_bf16x2(raw.w, true);
                const bf16x8 b0 = *(const LAS bf16x8*)(my + 2 * (64 * m + 16 * g)), b1 = *(const LAS bf16x8*)(my + 2 * (64 * m + 16 * g + 8));
                acc = __builtin_amdgcn_mfma_f32_16x16x32_bf16(__builtin_bit_cast(bf16x8, a0), b0, acc, 0, 0, 0);
                acc = __builtin_amdgcn_mfma_f32_16x16x32_bf16(__builtin_bit_cast(bf16x8, a1), b1, acc, 0, 0, 0);
            }
            const f32x4 pg = *(const f32x4*)(pgates + (size_t)t * 128 + 16 * i + 4 * g);
            constexpr float us = 1.0f / PEER_U_SCALE, vs = 1.0f / PEER_V_SCALE;
            if (fr == 0) { *(LAS f32x4*)(cf + 16 * i + 4 * g) = (f32x4){vs * pg.x * gelu_erf(acc[0] * us), vs * pg.y * gelu_erf(acc[1] * us), vs * pg.z * gelu_erf(acc[2] * us), vs * pg.w * gelu_erf(acc[3] * us)}; }
        }
        asm volatile("s_waitcnt lgkmcnt(0)" ::: "memory");
        float o[16];
#pragma unroll
        for (int j = 0; j < 16; ++j) o[j] = 0.f;
#pragma unroll 8
        for (int k = 0; k < 128; ++k) {
            const int e = __builtin_amdgcn_readfirstlane(eidl[k]); const float c = cf[k];
            const u32x4 raw = *(const u32x4*)(vb + (size_t)e * 1024 + 16 * lane);
            const unsigned rw[4] = {raw.x, raw.y, raw.z, raw.w};
#pragma unroll
            for (int j = 0; j < 4; ++j) { const f32x2 lo = __builtin_amdgcn_cvt_pk_f32_fp8((int)rw[j], false), hi = __builtin_amdgcn_cvt_pk_f32_fp8((int)rw[j], true);
                o[4 * j] = fmaf(c, lo.x, o[4 * j]); o[4 * j + 1] = fmaf(c, lo.y, o[4 * j + 1]); o[4 * j + 2] = fmaf(c, hi.x, o[4 * j + 2]); o[4 * j + 3] = fmaf(c, hi.y, o[4 * j + 3]); }
        }
        float s = 0.f; const float* xp = x1 + (size_t)t * 1024 + 16 * lane;
#pragma unroll
        for (int q = 0; q < 4; ++q) { const f32x4 a = *(const f32x4*)(xp + 4 * q); o[4 * q] += ALPHA * a.x; o[4 * q + 1] += ALPHA * a.y; o[4 * q + 2] += ALPHA * a.z; o[4 * q + 3] += ALPHA * a.w; }
#pragma unroll
        for (int j = 0; j < 16; ++j) s += o[j];
        const float mean = wave_sum(s) * (1.0f / 1024.0f); float s2 = 0.f;
#pragma unroll
        for (int j = 0; j < 16; ++j) { o[j] -= mean; s2 += o[j] * o[j]; }
        const float rstd = rsqrtf(wave_sum(s2) * (1.0f / 1024.0f) + 1e-5f);
#pragma unroll
        for (int q = 0; q < 4; ++q) { const int c0 = 16 * lane + 4 * q; const f32x4 gm = *(const f32x4*)(gam + c0), bt = *(const f32x4*)(bet + c0);
            *(f32x4*)(out + (size_t)t * 1024 + c0) = (f32x4){o[4 * q] * rstd * gm.x + bt.x, o[4 * q + 1] * rstd * gm.y + bt.y, o[4 * q + 2] * rstd * gm.z + bt.z, o[4 * q + 3] * rstd * gm.w + bt.w}; }
    }
}

constexpr int LDS_BYTES = 147456;
constexpr int LDS_MISC = 131072 + 256;
constexpr int NPHASE = 14;
constexpr int CW_BAR = 4096;

__global__ void __launch_bounds__(NTHREADS, 2) hybrid_fwd(Args args) {
    extern __shared__ __attribute__((aligned(16))) unsigned char lds_raw[];
    Ctx C;
    C.lds = (LAS unsigned char*)lds_raw;
    C.tid = threadIdx.x; C.lane = C.tid & 63; C.wave = __builtin_amdgcn_readfirstlane(C.tid >> 6);
    C.G = gridDim.x; C.gw = blockIdx.x * NWAVES + C.wave; C.ngw = C.G * NWAVES; C.gt = blockIdx.x * NTHREADS + C.tid; C.ngt = C.G * NTHREADS;
    C.in = args.in; C.ws = args.ws; C.dout = (unsigned char*)args.out;
    unsigned char* ws = args.ws; const float* const* in = args.in;
    volatile LAS unsigned* MISC = (volatile LAS unsigned*)(C.lds + LDS_MISC);
    if (C.tid < 64) MISC[C.tid] = 0u;
    __syncthreads();
    XcdBarrier bar; bar.bar = (unsigned*)(ws + WS_CTL) + CW_BAR; bar.x = 0; bar.st = nullptr;
    if (MK_N_LAUNCHES == 1) bar = xcd_barrier_post((unsigned*)(ws + WS_CTL) + CW_BAR, MISC + 8);
    const int lo = args.ph_lo, hi = args.ph_hi;
#define IN(k) (lo <= (k) && (k) < hi)
#define SEAM(k) do { if (IN(k) && IN((k) + 1)) xcd_barrier(bar); } while (0)
#define REP(k) for (int rep_ = 0; rep_ < (((PROBE_MASK >> (k)) & 1) ? 2 : 1); ++rep_)
    bf16_t* xb = (bf16_t*)(C.dout + DO_XB);

    if (IN(0)) REP(0) { p0_prologue(C); } SEAM(0);
    if (IN(1)) REP(1) {
        { pg8::Gemm gm{xb, (const bf16_t*)(ws + WS_WIN), T, 2816, 1024}; pg8::StaticOrder S; S.init(T, 2816, C.G, (int)blockIdx.x);
          EpiP1 E{(float*)(ws + WS_CSMALL), (bf16_t*)(ws + WS_RCOLS), (bf16_t*)(ws + WS_MEMQ)}; pg8::gemm_phase(C.lds, gm, S, E); }
        {
          const int nfull = (T / 256) * 11 % C.G; const int c2 = ((int)blockIdx.x - nfull + C.G) % C.G;
          pg8::Gemm gm{(const bf16_t*)(ws + WS_MEMB), (const bf16_t*)(ws + WS_WMEMKV), 1024, 1024, 1024}; pg8::StaticOrder S; S.init(1024, 1024, C.G, c2);
          EpiMemKV E{(bf16_t*)(ws + WS_KMEM), (bf16_t*)(ws + WS_VMEMT)}; pg8::gemm_phase(C.lds, gm, S, E); }
    } SEAM(1);
    if (IN(2)) REP(2) { p2_prep(C); } SEAM(2);
    if (IN(3)) REP(3) {
        { pg8::Gemm gm{(const bf16_t*)(ws + WS_LORAA), (const bf16_t*)(ws + WS_WLORA), T, 1536, 256}; pg8::StaticOrder S; S.init(T, 1536, C.G, (int)blockIdx.x);
          EpiLora E{(bf16_t*)(ws + WS_RW_E), (bf16_t*)(ws + WS_RW_A), (bf16_t*)(ws + WS_RW_G), in[11], in[13]}; pg8::gemm_phase(C.lds, gm, S, E); }
        { pg8::Gemm gm{(const bf16_t*)(ws + WS_CQN), (const bf16_t*)(ws + WS_WQ), T, 1280, 256}; pg8::StaticOrder S; S.init(T, 1280, C.G, C.G - 1 - (int)blockIdx.x);
          EpiQ E{(bf16_t*)(ws + WS_QLAT), (bf16_t*)(ws + WS_QIDX)}; pg8::gemm_phase(C.lds, gm, S, E); }
    } SEAM(3);
    if (IN(4)) { REP(14) { p4_indexer(C); } REP(15) { p4_memattn(C); } __syncthreads(); REP(16) { p4_rwkv_pass1(C); } } SEAM(4);
    if (IN(5)) { p5_rwkv_carry(C); __syncthreads(); REP(5) { p5_dsa_attn(C, rep_); } } SEAM(5);
    if (IN(6)) REP(6) { p6_rwkv_pass3(C); p6_late_weights(C); } SEAM(6);
    if (IN(7)) REP(7) {
        pg8::Gemm gm{xb, (const bf16_t*)(ws + WS_WG), T, 3072, 1024}; pg8::StaticOrder S; S.init(T, 3072, C.G, (int)blockIdx.x);
        EpiGates E{(bf16_t*)(ws + WS_GATES)}; pg8::gemm_phase(C.lds, gm, S, E);
    } SEAM(7);
    if (IN(8)) REP(8) {
        float* mf = (float*)C.dout; const bf16_t* gt = (const bf16_t*)(ws + WS_GATES); bf16_t* mb = (bf16_t*)(ws + WS_MERGEDB);
        { pg8::Gemm gm{(const bf16_t*)(ws + WS_OLAT), (const bf16_t*)(ws + WS_WOV), T, 1024, 1024}; pg8::StaticOrder S; S.init(T, 1024, C.G, (int)blockIdx.x);
          EpiMerge<0> E{gt, mf, mb}; pg8::gemm_phase(C.lds, gm, S, E); }
        { pg8::Gemm gm{(const bf16_t*)(ws + WS_YRWKV), (const bf16_t*)(ws + WS_WBRR), T, 1024, 512}; pg8::StaticOrder S; S.init(T, 1024, C.G, (int)blockIdx.x);
          EpiMerge<1> E{gt, mf, mb}; pg8::gemm_phase(C.lds, gm, S, E); }
        { pg8::Gemm gm{(const bf16_t*)(ws + WS_YMEM), (const bf16_t*)(ws + WS_WBRM), T, 1024, 512}; pg8::StaticOrder S; S.init(T, 1024, C.G, (int)blockIdx.x);
          EpiMerge<2> E{gt, mf, mb}; pg8::gemm_phase(C.lds, gm, S, E); }
    } SEAM(8);
    if (IN(9)) REP(9) {
        pg8::Gemm gm{(const bf16_t*)(ws + WS_MERGEDB), (const bf16_t*)(ws + WS_WOUT), T, 1024, 1024}; pg8::StaticOrder S; S.init(T, 1024, C.G, (int)blockIdx.x);
        EpiWout E{G_(in[0]), (float*)C.dout}; pg8::gemm_phase(C.lds, gm, S, E);
    } SEAM(9);
    if (IN(10)) REP(10) { p8_ln1(C); } SEAM(10);
    if (IN(11)) REP(11) {
        pg8::Gemm gm{(const bf16_t*)(ws + WS_X1B), (const bf16_t*)(ws + WS_WPEER), T, 2048, 1024}; pg8::StaticOrder S; S.init(T, 2048, C.G, (int)blockIdx.x);
        EpiPeerQ E{(bf16_t*)C.dout}; pg8::gemm_phase(C.lds, gm, S, E);
    } SEAM(11);
    if (IN(12)) REP(12) { p10_peer_route(C); } SEAM(12);
    if (IN(13)) REP(13) { p11_peer_experts(C); }
#undef IN
#undef SEAM
}

extern "C" void kernel_launch(void* const* d_in, const int* in_sizes, int n_in, void* d_out, int out_size, void* d_ws, size_t ws_size, hipStream_t stream) {
    static int grid = 0;
    if (grid == 0) {
        if (n_in != 34 || out_size != T * D || ws_size < WS_END) { fprintf(stderr, "kernel_launch: unexpected problem (n_in %d out %d ws %zu)\n", n_in, out_size, ws_size); grid = -1; return; }
        int dev = 0, cus = 0, per_cu = 0;
        if (hipGetDevice(&dev) != hipSuccess || hipDeviceGetAttribute(&cus, hipDeviceAttributeMultiprocessorCount, dev) != hipSuccess) { grid = -1; return; }
        if (hipFuncSetAttribute((const void*)hybrid_fwd, hipFuncAttributeMaxDynamicSharedMemorySize, LDS_BYTES) != hipSuccess) { fprintf(stderr, "kernel_launch: hipFuncSetAttribute failed\n"); grid = -1; return; }
        if (hipOccupancyMaxActiveBlocksPerMultiprocessor(&per_cu, (const void*)hybrid_fwd, NTHREADS, LDS_BYTES) != hipSuccess || per_cu < 1) { fprintf(stderr, "kernel_launch: occupancy query says %d\n", per_cu); }
        (void)hipGetLastError();
        grid = cus;
    }
    if (grid < 0) return;
    (void)hipMemsetAsync((char*)d_ws + WS_CTL, 0, 1 * MiB, stream);
    Args a{};
    for (int i = 0; i < 34; ++i) a.in[i] = (const float*)d_in[i];
    a.out = (float*)d_out; a.ws = (unsigned char*)d_ws; a.li = 0; a.pad = 0;
    if (MK_N_LAUNCHES == 1) { a.ph_lo = 0; a.ph_hi = NPHASE; hipLaunchKernelGGL(hybrid_fwd, dim3(grid), dim3(NTHREADS), LDS_BYTES, stream, a); }
    else for (int p = 0; p < NPHASE; ++p) { a.ph_lo = p; a.ph_hi = p + 1; a.li = p; hipLaunchKernelGGL(hybrid_fwd, dim3(grid), dim3(NTHREADS), LDS_BYTES, stream, a); }
}
```

```cpp
#include <hip/hip_runtime.h>
#include <stdint.h>
#include <stdio.h>

#ifndef MK_N_LAUNCHES
#define MK_N_LAUNCHES 1
#endif

#ifndef PROBE_MASK
#define PROBE_MASK 0
#endif
#define LAS __attribute__((address_space(3)))
typedef unsigned short bf16_t;
typedef const __attribute__((address_space(1))) float* gfp;
#define G_(p) ((gfp)(p))
typedef short bf16x8 __attribute__((ext_vector_type(8)));
typedef float f32x4 __attribute__((ext_vector_type(4)));
typedef float f32x2 __attribute__((ext_vector_type(2)));
typedef unsigned u32x4 __attribute__((ext_vector_type(4)));
typedef unsigned u32x2 __attribute__((ext_vector_type(2)));

constexpr int NB = 4, SEQ = 4096, T = NB * SEQ, D = 1024;
constexpr int IN_W = 5800;
constexpr int RW = 512;
constexpr int NWAVES = 8, NTHREADS = 512;
constexpr float ALPHA = 1.189207115002721f;
constexpr int RCH = 32, RL = SEQ / RCH;

constexpr size_t MiB = 1u << 20;
constexpr size_t WS_CTL = 0;
constexpr size_t WS_WIN = 1 * MiB, WS_WG = 7 * MiB, WS_WLORA = 13 * MiB, WS_WQ = 14 * MiB, WS_WMEMKV = 15 * MiB, WS_WOV = 17 * MiB,
                 WS_WBRR = 19 * MiB, WS_WBRM = 20 * MiB, WS_WOUT = 21 * MiB, WS_WPEER = 23 * MiB, WS_KEYS = 27 * MiB;
constexpr size_t WS_CSMALL = 29 * MiB, WS_QLAT = 29 * MiB, WS_MERGEDB = 29 * MiB, WS_UB = 29 * MiB;
constexpr size_t WS_RCOLS = 61 * MiB, WS_QIDX = 61 * MiB, WS_YM = 69 * MiB, WS_OLAT = 101 * MiB, WS_VB = 61 * MiB, WS_EXPERTS = 93 * MiB, WS_PGATES = 101 * MiB;
constexpr size_t WS_MEMQ = 117 * MiB;
constexpr size_t WS_RW_R = 133 * MiB, WS_RW_K = 149 * MiB, WS_RW_V = 165 * MiB, WS_RW_A = 181 * MiB, WS_RW_E = 197 * MiB, WS_RW_G = 213 * MiB;
constexpr size_t WS_GATES = 133 * MiB, WS_X1B = 133 * MiB, WS_X1 = 165 * MiB;
constexpr size_t WS_CQN = 229 * MiB, WS_KVL = 237 * MiB, WS_KIDX = 241 * MiB, WS_WIDX = 242 * MiB, WS_LORAA = 243 * MiB, WS_IDX = 243 * MiB,
                 WS_KMEM = 251 * MiB, WS_VMEMT = 252 * MiB, WS_MEMB = 253 * MiB, WS_END = 256 * MiB;
constexpr size_t DO_XB = 0, DO_PQ = 32 * MiB;
constexpr size_t WS_XB2 = 29 * MiB;
constexpr int CW_DSAQ = 64;

typedef __bf16 bf2_hw __attribute__((ext_vector_type(2)));
__device__ __forceinline__ unsigned f2bf(float f) { return (unsigned)__builtin_bit_cast(unsigned short, (__bf16)f); }
__device__ __forceinline__ unsigned pk2(float lo, float hi) { bf2_hw r; r.x = (__bf16)lo; r.y = (__bf16)hi; return __builtin_bit_cast(unsigned, r); }
__device__ __forceinline__ float bflo(unsigned w) { return __uint_as_float(w << 16); }
__device__ __forceinline__ float bfhi(unsigned w) { return __uint_as_float(w & 0xffff0000u); }
__device__ __forceinline__ float bf1(bf16_t h) { return __uint_as_float(((unsigned)h) << 16); }
template <int CTRL, int RM = 0xF> __device__ __forceinline__ float dpp_f(float v) { return __builtin_bit_cast(float, __builtin_amdgcn_update_dpp(0, __builtin_bit_cast(int, v), CTRL, RM, 0xF, false)); }
template <int CTRL> __device__ __forceinline__ unsigned dpp_u(unsigned v) { return (unsigned)__builtin_amdgcn_update_dpp(0, (int)v, CTRL, 0xF, 0xF, false); }
__device__ __forceinline__ float wave_sum(float v) {
    v += dpp_f<0x111>(v); v += dpp_f<0x112>(v); v += dpp_f<0x114>(v); v += dpp_f<0x118>(v);
    v += dpp_f<0x142, 0xA>(v); v += dpp_f<0x143, 0xC>(v);
    return __builtin_bit_cast(float, __builtin_amdgcn_readlane(__builtin_bit_cast(int, v), 63));
}
__device__ __forceinline__ unsigned row_max_u(unsigned x) {
    unsigned y = dpp_u<0x128>(x); x = x > y ? x : y; y = dpp_u<0x124>(x); x = x > y ? x : y; y = dpp_u<0x122>(x); x = x > y ? x : y; y = dpp_u<0x121>(x); x = x > y ? x : y; return x; }
__device__ __forceinline__ float row_sum_f(float x) { x += dpp_f<0x128>(x); x += dpp_f<0x124>(x); x += dpp_f<0x122>(x); x += dpp_f<0x121>(x); return x; }
__device__ __forceinline__ float key2f(unsigned k) { const unsigned b = (k & 0x80000000u) ? (k & 0x7fffffffu) : ~k; return __uint_as_float(b); }
__device__ __forceinline__ float sigmoidf_(float x) { return 1.0f / (1.0f + __expf(-x)); }
__device__ __forceinline__ unsigned f2key(float f) { unsigned b = __float_as_uint(f); if (f == 0.0f) b = 0u; return (b & 0x80000000u) ? ~b : (b | 0x80000000u); }
__device__ __forceinline__ u32x4 pack8(const float* v) { u32x4 w; w.x = pk2(v[0], v[1]); w.y = pk2(v[2], v[3]); w.z = pk2(v[4], v[5]); w.w = pk2(v[6], v[7]); return w; }
__device__ __forceinline__ void unpack8(u32x4 w, float* v) { v[0] = bflo(w.x); v[1] = bfhi(w.x); v[2] = bflo(w.y); v[3] = bfhi(w.y); v[4] = bflo(w.z); v[5] = bfhi(w.z); v[6] = bflo(w.w); v[7] = bfhi(w.w); }

#define XB_TMO      128
#define XB_XCNT(j)  (256  + 64 * (j))
#define XB_XSUB(j)  (1280 + 64 * (j))
#define XB_XGEN(j)  (2304 + 64 * (j))
#define XB_TOP      3328
#define XB_TOPGEN   3392
#define XCD_BAR_WORDS 3456
#define XB_SPIN_CAP (1u << 18)

__device__ __forceinline__ unsigned xb_ld(unsigned* p)              { return __hip_atomic_load(p, __ATOMIC_RELAXED, __HIP_MEMORY_SCOPE_AGENT); }
__device__ __forceinline__ unsigned xb_add(unsigned* p, unsigned v) { return __hip_atomic_fetch_add(p, v, __ATOMIC_RELAXED, __HIP_MEMORY_SCOPE_AGENT); }
__device__ __forceinline__ unsigned xb_xcc_id() { return (unsigned)__builtin_amdgcn_s_getreg((3 << 11) | 20) & 0xFu; }
#define XB_SPIN(cond, bar) do { unsigned _sp = 0; while (cond) { __builtin_amdgcn_s_sleep(1); \
    if ((++_sp & 255u) == 0u) { if (xb_ld(&(bar)[XB_TMO])) break; if (_sp > XB_SPIN_CAP) { atomicAdd(&(bar)[XB_TMO], 1u); break; } } } } while (0)

struct XcdBarrier {
    unsigned* bar; unsigned x;
    volatile LAS unsigned* st;
};
__device__ __forceinline__ XcdBarrier xcd_barrier_post(unsigned* bar, volatile LAS unsigned* st) {
    XcdBarrier b; b.bar = bar; b.x = xb_xcc_id(); b.st = st;
    if (threadIdx.x == 0) (void)xb_add(&bar[XB_XCNT(b.x)], 1u);
    return b;
}
__device__ __forceinline__ void xcd_barrier_complete(unsigned* bar, unsigned x, unsigned& nloc, unsigned& nx) {
    const unsigned G = gridDim.x * gridDim.y * gridDim.z;
    unsigned sum, cnt, mine, sp = 0u;
    for (;;) {
        sum = 0u; cnt = 0u; mine = 0u;
#pragma unroll
        for (unsigned j = 0; j < 16; ++j) { const unsigned c = xb_ld(&bar[XB_XCNT(j)]); sum += c; cnt += (c > 0u) ? 1u : 0u; mine = (j == x) ? c : mine; }
        if (sum == G) break;
        __builtin_amdgcn_s_sleep(1);
        if ((++sp & 255u) == 0u) { if (xb_ld(&bar[XB_TMO])) break; if (sp > XB_SPIN_CAP) { atomicAdd(&bar[XB_TMO], 1u); break; } }
    }
    nloc = mine > 0u ? mine : 1u; nx = cnt > 0u ? cnt : 1u;
}
__device__ __forceinline__ void xcd_barrier(const XcdBarrier& b) {
    asm volatile("s_waitcnt vmcnt(0)" ::: "memory");
    __syncthreads();
    if (threadIdx.x == 0) {
        unsigned* bar = b.bar;
        __builtin_amdgcn_s_waitcnt(0);
        unsigned nloc = b.st[0], nx = b.st[1];
        if (nloc == 0u) { xcd_barrier_complete(bar, b.x, nloc, nx); b.st[0] = nloc; b.st[1] = nx; }
        const unsigned old = xb_add(&bar[XB_XSUB(b.x)], 1u);
        const unsigned gen = old / nloc;
        if (old + 1u == (gen + 1u) * nloc) {
            __builtin_amdgcn_fence(__ATOMIC_RELEASE, "agent");
            asm volatile("s_waitcnt vmcnt(0)" ::: "memory");
            const unsigned og = xb_add(&bar[XB_TOP], 1u);
            const unsigned tg = og / nx;
            if (og + 1u == (tg + 1u) * nx) xb_add(&bar[XB_TOPGEN], 1u);
            else XB_SPIN(xb_ld(&bar[XB_TOPGEN]) == tg, bar);
            __builtin_amdgcn_fence(__ATOMIC_ACQUIRE, "agent");
            xb_add(&bar[XB_XGEN(b.x)], 1u);
            asm volatile("s_waitcnt vmcnt(0)" ::: "memory");
        } else {
            XB_SPIN(xb_ld(&bar[XB_XGEN(b.x)]) == gen, bar);
            __builtin_amdgcn_fence(__ATOMIC_ACQUIRE, "agent");
            asm volatile("s_waitcnt vmcnt(0)" ::: "memory");
        }
    }
    __syncthreads();
}

namespace pg8 {
constexpr int BM = 256, BK = 64, HALF = 128, HTB = HALF * BK * 2, STAGE_BYTES = 8 * HTB, NXCD = 8, WGM = 8;
__device__ __forceinline__ int lds_byte(int r, int c) { const int st = (r >> 4) * 2 + (c >> 5), rr = r & 15, cc = c & 31, ob = rr * 64 + cc * 2; return st * 1024 + (ob ^ (((ob >> 9) & 1) << 5)); }
__device__ __forceinline__ void stage_rc(int b, int& R, int& C) { const int st = b / 1024, sb = b % 1024, swz = sb ^ (((sb >> 9) & 1) << 5); R = (st >> 1) * 16 + swz / 64; C = (st & 1) * 32 + (swz % 64) / 2; }
__device__ __forceinline__ int perm32(int rho) { const int n = rho >> 4, i = rho & 15; return 8 * (i >> 2) + 4 * n + (i & 3); }
struct Unit { int pm, pn; };
struct Gemm { const bf16_t* A; const bf16_t* Bt; int M, N, K; };
struct StaticOrder {
    int nM, nN, nwg, G, c;
    __device__ void init(int M, int N, int G_, int c_) { nM = M / BM; nN = N / BM; nwg = nM * nN; G = G_; c = c_; }
    __device__ bool next(int i, Unit& u) const {
        const long L = (long)i * G + c; if (L >= nwg) return false;
        int wgid = (int)L; { const int q = nwg / NXCD, r = nwg % NXCD, xcd = wgid % NXCD, off = wgid / NXCD; wgid = (xcd < r ? xcd * (q + 1) : r * (q + 1) + (xcd - r) * q) + off; }
        const int nig = WGM * nN, gid = wgid / nig, fm = gid * WGM, gsz = (nM - fm) < WGM ? (nM - fm) : WGM;
        u.pm = fm + ((wgid % nig) % gsz); u.pn = (wgid % nig) / gsz; return true;
    }
};
template <class Epi>
__device__ __forceinline__ void gemm_phase(LAS unsigned char* lds, const Gemm g, const StaticOrder& S, const Epi& E) {
    const int tid = threadIdx.x, wid = __builtin_amdgcn_readfirstlane(tid >> 6), lane = tid & 63, wr = wid >> 2, wc = wid & 3, fr = lane & 15, fq = lane >> 4;
    const int K = g.K, nt = K / BK;
    unsigned voffA[2], voffB[2];
#pragma unroll
    for (int i = 0; i < 2; ++i) { int R, C; stage_rc(tid * 16 + i * 8192, R, C); const int Rb = (R & ~31) + perm32(R & 31);
        voffA[i] = (unsigned)(R * K + C) * 2u; voffB[i] = (unsigned)(Rb * K + C) * 2u; }
    const size_t kstep = (size_t)(BK * 2);
    const size_t hstep = (size_t)HALF * K * 2;
    const size_t tstep = 2 * hstep;
    const unsigned ldsw = (unsigned)wid * 1024u;
    const int aoff = lds_byte(wr * 64 + fr, fq * 8), boff = lds_byte(wc * 32 + fr, fq * 8);
#define PG8_SA(b, h) (((b) * 2 + (h)) * HTB)
#define PG8_SB(b, h) ((4 + (b) * 2 + (h)) * HTB)
#define PG8_STAGE(bufoff, gbase, voff) do { _Pragma("unroll") for (int _i = 0; _i < 2; ++_i) \
        __builtin_amdgcn_global_load_lds((const unsigned*)((const char*)(gbase) + (voff)[_i]), (LAS unsigned*)(lds + (bufoff) + ldsw + _i * 8192), 16, 0, 0); } while (0)
#define PG8_LDA(dst, b, h) do { _Pragma("unroll") for (int m = 0; m < 4; ++m) _Pragma("unroll") for (int k = 0; k < 2; ++k) dst[m][k] = *(const LAS bf16x8*)(lds + PG8_SA(b, h) + aoff + m * 2048 + k * 1024); } while (0)
#define PG8_LDB(dst, b, h) do { _Pragma("unroll") for (int n = 0; n < 2; ++n) _Pragma("unroll") for (int k = 0; k < 2; ++k) dst[n][k] = *(const LAS bf16x8*)(lds + PG8_SB(b, h) + boff + n * 2048 + k * 1024); } while (0)
#define PG8_MMA(ai, bj, At, Bt) do { __builtin_amdgcn_s_setprio(1); _Pragma("unroll") for (int m = 0; m < 4; ++m) _Pragma("unroll") for (int n = 0; n < 2; ++n) _Pragma("unroll") for (int k = 0; k < 2; ++k) \
        acc[ai][bj][m][n] = __builtin_amdgcn_mfma_f32_16x16x32_bf16(Bt[n][k], At[m][k], acc[ai][bj][m][n], 0, 0, 0); __builtin_amdgcn_s_setprio(0); } while (0)
#define PG8_WAIT_V(n) asm volatile("s_waitcnt vmcnt(" #n ")" ::: "memory")
#define PG8_WAIT_L(n) asm volatile("s_waitcnt lgkmcnt(" #n ")" ::: "memory")
#define PG8_BAR __builtin_amdgcn_s_barrier()
#define PG8_SCHED __builtin_amdgcn_sched_barrier(0)
    Unit cur, nxt; int ui = 0;
    if (!S.next(0, cur)) return;
    f32x4 acc[2][2][4][2];
#pragma unroll
    for (int a = 0; a < 2; ++a)
#pragma unroll
        for (int b = 0; b < 2; ++b)
#pragma unroll
            for (int m = 0; m < 4; ++m)
#pragma unroll
                for (int n = 0; n < 2; ++n) acc[a][b][m][n] = (f32x4){0.f, 0.f, 0.f, 0.f};
    bf16x8 At[4][2], B0[2][2], B1[2][2];
    const char* cA = (const char*)g.A + (size_t)cur.pm * tstep; const char* cB = (const char*)g.Bt + (size_t)cur.pn * tstep;
    PG8_STAGE(PG8_SB(0, 0), cB, voffB); PG8_STAGE(PG8_SA(0, 0), cA, voffA); PG8_STAGE(PG8_SB(0, 1), cB + hstep, voffB); PG8_STAGE(PG8_SA(0, 1), cA + hstep, voffA);
    if (wr == 1) PG8_BAR;
    PG8_WAIT_V(4); PG8_BAR;
    PG8_STAGE(PG8_SB(1, 0), cB + kstep, voffB); PG8_STAGE(PG8_SA(1, 0), cA + kstep, voffA); PG8_STAGE(PG8_SB(1, 1), cB + hstep + kstep, voffB);
    PG8_WAIT_V(6); PG8_BAR;
    for (;;) {
        const bool has_next = S.next(ui + 1, nxt);
        const char* nA = has_next ? (const char*)g.A + (size_t)nxt.pm * tstep : cA; const char* nB = has_next ? (const char*)g.Bt + (size_t)nxt.pn * tstep : cB;
#pragma unroll 1
        for (int t = 0; t < nt; t += 2) {
            const bool last = (t == nt - 2);
            const char* a1 = cA + (size_t)(t + 1) * kstep;
            const char* a2 = last ? nA : cA + (size_t)(t + 2) * kstep; const char* b2 = last ? nB : cB + (size_t)(t + 2) * kstep;
            const char* a3 = a2 + kstep; const char* b3 = b2 + kstep;
            PG8_LDB(B0, 0, 0); PG8_SCHED; PG8_LDA(At, 0, 0); PG8_STAGE(PG8_SA(1, 1), a1 + hstep, voffA);
            PG8_WAIT_L(8); PG8_BAR; PG8_WAIT_L(0); PG8_MMA(0, 0, At, B0); PG8_BAR; PG8_SCHED;
            PG8_LDB(B1, 0, 1); PG8_STAGE(PG8_SB(0, 0), b2, voffB);
            PG8_BAR; PG8_WAIT_L(0); PG8_MMA(0, 1, At, B1); PG8_BAR;
            PG8_LDA(At, 0, 1); PG8_STAGE(PG8_SA(0, 0), a2, voffA);
            PG8_BAR; PG8_WAIT_L(0); PG8_MMA(1, 0, At, B0); PG8_BAR; PG8_SCHED;
            PG8_STAGE(PG8_SB(0, 1), b2 + hstep, voffB);
            PG8_WAIT_V(6); PG8_BAR; PG8_MMA(1, 1, At, B1); PG8_BAR;
            PG8_LDB(B0, 1, 0); PG8_SCHED; PG8_LDA(At, 1, 0); PG8_STAGE(PG8_SA(0, 1), a2 + hstep, voffA);
            PG8_WAIT_L(8); PG8_BAR; PG8_WAIT_L(0); PG8_MMA(0, 0, At, B0); PG8_BAR; PG8_SCHED;
            PG8_LDB(B1, 1, 1); PG8_STAGE(PG8_SB(1, 0), b3, voffB);
            PG8_BAR; PG8_WAIT_L(0); PG8_MMA(0, 1, At, B1); PG8_BAR;
            PG8_LDA(At, 1, 1); PG8_STAGE(PG8_SA(1, 0), a3, voffA);
            PG8_BAR; PG8_WAIT_L(0); PG8_MMA(1, 0, At, B0); PG8_BAR; PG8_SCHED;
            PG8_STAGE(PG8_SB(1, 1), b3 + hstep, voffB);
            PG8_WAIT_V(6); PG8_BAR; PG8_MMA(1, 1, At, B1); PG8_BAR;
        }
        {
            const int row0 = cur.pm * BM + wr * 64 + fr, col0 = cur.pn * BM + wc * 32 + 8 * fq;
#pragma unroll
            for (int ai = 0; ai < 2; ++ai)
#pragma unroll
                for (int m = 0; m < 4; ++m)
#pragma unroll
                    for (int bj = 0; bj < 2; ++bj) { E(row0 + ai * HALF + m * 16, col0 + bj * HALF, cur.pn, acc[ai][bj][m][0], acc[ai][bj][m][1]); if (Epi::SERIAL) __builtin_amdgcn_sched_barrier(0); }
        }
        if (!has_next) break;
#pragma unroll
        for (int a = 0; a < 2; ++a)
#pragma unroll
            for (int b = 0; b < 2; ++b)
#pragma unroll
                for (int m = 0; m < 4; ++m)
#pragma unroll
                    for (int n = 0; n < 2; ++n) acc[a][b][m][n] = (f32x4){0.f, 0.f, 0.f, 0.f};
        cur = nxt; cA = nA; cB = nB; ++ui;
    }
    PG8_WAIT_V(0);
    if (wr == 0) PG8_BAR;
    PG8_BAR;
#undef PG8_SA
#undef PG8_SB
#undef PG8_STAGE
#undef PG8_LDA
#undef PG8_LDB
#undef PG8_MMA
#undef PG8_WAIT_V
#undef PG8_WAIT_L
#undef PG8_BAR
#undef PG8_SCHED
}
struct GemmM { const bf16_t* A0; const bf16_t* A1; const bf16_t* Bt; int M, N; };
template <class Hook>
__device__ __forceinline__ void gemm_phase_merge(LAS unsigned char* lds, const GemmM g, const StaticOrder& S, const Hook& H) {
    const int tid = threadIdx.x, wid = __builtin_amdgcn_readfirstlane(tid >> 6), lane = tid & 63, wr = wid >> 2, wc = wid & 3, fr = lane & 15, fq = lane >> 4;
    constexpr int K = 2048, LDA = 1024, nt = K / BK, KS = 16;
    unsigned voffA[2], voffB[2];
#pragma unroll
    for (int i = 0; i < 2; ++i) { int R, C; stage_rc(tid * 16 + i * 8192, R, C); const int Rb = (R & ~31) + perm32(R & 31);
        voffA[i] = (unsigned)(R * LDA + C) * 2u; voffB[i] = (unsigned)(Rb * K + C) * 2u; }
    const size_t kstep = (size_t)(BK * 2);
    const size_t hstepA = (size_t)HALF * LDA * 2, tstepA = 2 * hstepA, hstepB = (size_t)HALF * K * 2, tstepB = 2 * hstepB;
    const unsigned ldsw = (unsigned)wid * 1024u;
    const int aoff = lds_byte(wr * 64 + fr, fq * 8), boff = lds_byte(wc * 32 + fr, fq * 8);
#define PG8_SA(b, h) (((b) * 2 + (h)) * HTB)
#define PG8_SB(b, h) ((4 + (b) * 2 + (h)) * HTB)
#define PG8_STAGE(bufoff, gbase, voff) do { _Pragma("unroll") for (int _i = 0; _i < 2; ++_i) \
        __builtin_amdgcn_global_load_lds((const unsigned*)((const char*)(gbase) + (voff)[_i]), (LAS unsigned*)(lds + (bufoff) + ldsw + _i * 8192), 16, 0, 0); } while (0)
#define PG8_LDA(dst, b, h) do { _Pragma("unroll") for (int m = 0; m < 4; ++m) _Pragma("unroll") for (int k = 0; k < 2; ++k) dst[m][k] = *(const LAS bf16x8*)(lds + PG8_SA(b, h) + aoff + m * 2048 + k * 1024); } while (0)
#define PG8_LDB(dst, b, h) do { _Pragma("unroll") for (int n = 0; n < 2; ++n) _Pragma("unroll") for (int k = 0; k < 2; ++k) dst[n][k] = *(const LAS bf16x8*)(lds + PG8_SB(b, h) + boff + n * 2048 + k * 1024); } while (0)
#define PG8_MMA(ai, bj, At, Bt) do { __builtin_amdgcn_s_setprio(1); _Pragma("unroll") for (int m = 0; m < 4; ++m) _Pragma("unroll") for (int n = 0; n < 2; ++n) _Pragma("unroll") for (int k = 0; k < 2; ++k) \
        acc[ai][bj][m][n] = __builtin_amdgcn_mfma_f32_16x16x32_bf16(Bt[n][k], At[m][k], acc[ai][bj][m][n], 0, 0, 0); __builtin_amdgcn_s_setprio(0); } while (0)
#define PG8_WAIT_V(n) asm volatile("s_waitcnt vmcnt(" #n ")" ::: "memory")
#define PG8_WAIT_L(n) asm volatile("s_waitcnt lgkmcnt(" #n ")" ::: "memory")
#define PG8_BAR __builtin_amdgcn_s_barrier()
#define PG8_SCHED __builtin_amdgcn_sched_barrier(0)
#define PG8_AT(b0, b1, t) ((t) < KS ? (b0) + (size_t)(t) * kstep : (b1) + (size_t)((t) - KS) * kstep)
    Unit cur, nxt; int ui = 0;
    if (!S.next(0, cur)) return;
    f32x4 acc[2][2][4][2];
#pragma unroll
    for (int a = 0; a < 2; ++a)
#pragma unroll
        for (int b = 0; b < 2; ++b)
#pragma unroll
            for (int m = 0; m < 4; ++m)
#pragma unroll
                for (int n = 0; n < 2; ++n) acc[a][b][m][n] = (f32x4){0.f, 0.f, 0.f, 0.f};
    bf16x8 At[4][2], B0[2][2], B1[2][2];
    const char* cA0 = (const char*)g.A0 + (size_t)cur.pm * tstepA; const char* cA1 = (const char*)g.A1 + (size_t)cur.pm * tstepA; const char* cB = (const char*)g.Bt + (size_t)cur.pn * tstepB;
    PG8_STAGE(PG8_SB(0, 0), cB, voffB); PG8_STAGE(PG8_SA(0, 0), cA0, voffA); PG8_STAGE(PG8_SB(0, 1), cB + hstepB, voffB); PG8_STAGE(PG8_SA(0, 1), cA0 + hstepA, voffA);
    if (wr == 1) PG8_BAR;
    PG8_WAIT_V(4); PG8_BAR;
    PG8_STAGE(PG8_SB(1, 0), cB + kstep, voffB); PG8_STAGE(PG8_SA(1, 0), cA0 + kstep, voffA); PG8_STAGE(PG8_SB(1, 1), cB + hstepB + kstep, voffB);
    PG8_WAIT_V(6); PG8_BAR;
    for (;;) {
        const bool has_next = S.next(ui + 1, nxt);
        const char* nA0 = has_next ? (const char*)g.A0 + (size_t)nxt.pm * tstepA : cA0; const char* nA1 = has_next ? (const char*)g.A1 + (size_t)nxt.pm * tstepA : cA1;
        const char* nB = has_next ? (const char*)g.Bt + (size_t)nxt.pn * tstepB : cB;
#pragma unroll 1
        for (int t = 0; t < nt; t += 2) {
            const bool last = (t == nt - 2);
            if (t == 16 || t == 24) H.rescale(acc, cur, t == 24 ? 1 : 0, wr, wc, fr, fq);
            const char* a1 = PG8_AT(cA0, cA1, t + 1);
            const char* a2 = last ? nA0 : PG8_AT(cA0, cA1, t + 2); const char* b2 = last ? nB : cB + (size_t)(t + 2) * kstep;
            const char* a3 = last ? nA0 + kstep : PG8_AT(cA0, cA1, t + 3); const char* b3 = b2 + kstep;
            PG8_LDB(B0, 0, 0); PG8_SCHED; PG8_LDA(At, 0, 0); PG8_STAGE(PG8_SA(1, 1), a1 + hstepA, voffA);
            PG8_WAIT_L(8); PG8_BAR; PG8_WAIT_L(0); PG8_MMA(0, 0, At, B0); PG8_BAR; PG8_SCHED;
            PG8_LDB(B1, 0, 1); PG8_STAGE(PG8_SB(0, 0), b2, voffB);
            PG8_BAR; PG8_WAIT_L(0); PG8_MMA(0, 1, At, B1); PG8_BAR;
            PG8_LDA(At, 0, 1); PG8_STAGE(PG8_SA(0, 0), a2, voffA);
            PG8_BAR; PG8_WAIT_L(0); PG8_MMA(1, 0, At, B0); PG8_BAR; PG8_SCHED;
            PG8_STAGE(PG8_SB(0, 1), b2 + hstepB, voffB);
            PG8_WAIT_V(6); PG8_BAR; PG8_MMA(1, 1, At, B1); PG8_BAR;
            PG8_LDB(B0, 1, 0); PG8_SCHED; PG8_LDA(At, 1, 0); PG8_STAGE(PG8_SA(0, 1), a2 + hstepA, voffA);
            PG8_WAIT_L(8); PG8_BAR; PG8_WAIT_L(0); PG8_MMA(0, 0, At, B0); PG8_BAR; PG8_SCHED;
            PG8_LDB(B1, 1, 1); PG8_STAGE(PG8_SB(1, 0), b3, voffB);
            PG8_BAR; PG8_WAIT_L(0); PG8_MMA(0, 1, At, B1); PG8_BAR;
            PG8_LDA(At, 1, 1); PG8_STAGE(PG8_SA(1, 0), a3, voffA);
            PG8_BAR; PG8_WAIT_L(0); PG8_MMA(1, 0, At, B0); PG8_BAR; PG8_SCHED;
            PG8_STAGE(PG8_SB(1, 1), b3 + hstepB, voffB);
            PG8_WAIT_V(6); PG8_BAR; PG8_MMA(1, 1, At, B1); PG8_BAR;
        }
        H.finish(acc, cur, wr, wc, fr, fq);
        if (!has_next) break;
#pragma unroll
        for (int a = 0; a < 2; ++a)
#pragma unroll
            for (int b = 0; b < 2; ++b)
#pragma unroll
                for (int m = 0; m < 4; ++m)
#pragma unroll
                    for (int n = 0; n < 2; ++n) acc[a][b][m][n] = (f32x4){0.f, 0.f, 0.f, 0.f};
        cur = nxt; cA0 = nA0; cA1 = nA1; cB = nB; ++ui;
    }
    PG8_WAIT_V(0);
    if (wr == 0) PG8_BAR;
    PG8_BAR;
#undef PG8_SA
#undef PG8_SB
#undef PG8_STAGE
#undef PG8_LDA
#undef PG8_LDB
#undef PG8_MMA
#undef PG8_WAIT_V
#undef PG8_WAIT_L
#undef PG8_BAR
#undef PG8_SCHED
#undef PG8_AT
}
}

struct Args { const float* in[34]; float* out; unsigned char* ws; int ph_lo, ph_hi, li, pad; };

struct Ctx {
    LAS unsigned char* lds;
    int tid, lane, wave, gw, ngw, gt, ngt, G;
    const float* const* in; unsigned char* ws; unsigned char* dout;
};

__device__ __forceinline__ void st8_bf16(bf16_t* p, f32x4 a, f32x4 b) { u32x4 w; w.x = pk2(a.x, a.y); w.y = pk2(a.z, a.w); w.z = pk2(b.x, b.y); w.w = pk2(b.z, b.w); *(u32x4*)p = w; }
struct EpiP1 { static constexpr bool SERIAL = false;
    float* cs; bf16_t* rc; bf16_t* mq;
    __device__ __forceinline__ void operator()(int row, int col, int pn, f32x4 a, f32x4 b) const {
        if (pn < 2) { float* p = cs + (size_t)row * 512 + col; *(f32x4*)p = a; *(f32x4*)(p + 4) = b; }
        else if (pn < 9) st8_bf16(rc + (size_t)row * 1792 + (col - 512), a, b);
        else st8_bf16(mq + (size_t)row * 512 + (col - 2304), a, b);
    }
};
struct EpiMemKV { static constexpr bool SERIAL = false;
    bf16_t* km; bf16_t* vt;
    __device__ __forceinline__ void operator()(int row, int col, int pn, f32x4 a, f32x4 b) const {
        const int bb = row >> 8, m = row & 255;
        if (col < 512) { const int h = col >> 7, d = col & 127; st8_bf16(km + ((size_t)((bb * 4 + h) * 256 + m)) * 128 + d, a, b); }
        else { const int c2 = col - 512, h = c2 >> 7, d = c2 & 127; bf16_t* p = vt + ((size_t)((bb * 4 + h) * 128 + d)) * 256 + m;
            p[0] = (bf16_t)f2bf(a.x); p[256] = (bf16_t)f2bf(a.y); p[512] = (bf16_t)f2bf(a.z); p[768] = (bf16_t)f2bf(a.w);
            p[1024] = (bf16_t)f2bf(b.x); p[1280] = (bf16_t)f2bf(b.y); p[1536] = (bf16_t)f2bf(b.z); p[1792] = (bf16_t)f2bf(b.w); }
    }
};
struct EpiLora { static constexpr bool SERIAL = true;
    bf16_t* e; bf16_t* a; bf16_t* g; const float* w0; const float* a0;
    __device__ __forceinline__ void operator()(int row, int col, int pn, f32x4 x, f32x4 y) const {
        float v[8] = {x.x, x.y, x.z, x.w, y.x, y.y, y.z, y.w};
        if (pn < 4) { const int c = col & 511; const float* bp = (pn < 2 ? w0 : a0) + c; const f32x4 b0 = *(const f32x4*)bp, b1 = *(const f32x4*)(bp + 4);
            const float bb[8] = {b0.x, b0.y, b0.z, b0.w, b1.x, b1.y, b1.z, b1.w}; const float sc = pn < 2 ? 0.6065306597126334f : 1.0f;
#pragma unroll
            for (int j = 0; j < 8; ++j) v[j] = sc * sigmoidf_(v[j] + bb[j]);
            *(u32x4*)((pn < 2 ? e : a) + (size_t)row * 512 + c) = pack8(v);
        } else *(u32x4*)(g + (size_t)row * 512 + (col - 1024)) = pack8(v);
    }
};
struct EpiQ { static constexpr bool SERIAL = false;
    bf16_t* ql; bf16_t* qi;
    __device__ __forceinline__ void operator()(int row, int col, int pn, f32x4 a, f32x4 b) const {
        if (pn < 4) st8_bf16(ql + (size_t)row * 1024 + col, a, b); else st8_bf16(qi + (size_t)row * 256 + (col - 1024), a, b);
    }
};
struct EpiGates { static constexpr bool SERIAL = true;
    bf16_t* o;
    __device__ __forceinline__ void operator()(int row, int col, int pn, f32x4 a, f32x4 b) const {
        float v[8] = {a.x, a.y, a.z, a.w, b.x, b.y, b.z, b.w};
#pragma unroll
        for (int j = 0; j < 8; ++j) v[j] = sigmoidf_(v[j]);
        *(u32x4*)(o + (size_t)row * 3072 + col) = pack8(v);
    }
};
struct MergeHook {
    const bf16_t* gates; bf16_t* mb;
    __device__ __forceinline__ void rescale(f32x4 (&acc)[2][2][4][2], const pg8::Unit& u, int idx, int wr, int wc, int fr, int fq) const {
        asm volatile("" : "+v"(fr), "+v"(fq));
        const int row0 = u.pm * 256 + wr * 64 + fr, col0 = u.pn * 256 + wc * 32 + 8 * fq;
#pragma unroll
        for (int ai = 0; ai < 2; ++ai)
#pragma unroll
            for (int mh = 0; mh < 2; ++mh) {
                u32x4 pa[2][2], pb[2][2];
#pragma unroll
                for (int mm = 0; mm < 2; ++mm)
#pragma unroll
                    for (int bj = 0; bj < 2; ++bj) { const bf16_t* gp = gates + (size_t)(row0 + ai * 128 + (2 * mh + mm) * 16) * 3072 + idx * 1024 + col0 + bj * 128; pa[mm][bj] = *(const u32x4*)gp; pb[mm][bj] = *(const u32x4*)(gp + 1024); }
                __builtin_amdgcn_sched_barrier(0);
#pragma unroll
                for (int mm = 0; mm < 2; ++mm)
#pragma unroll
                    for (int bj = 0; bj < 2; ++bj) { float a[8], b[8]; unpack8(pa[mm][bj], a); unpack8(pb[mm][bj], b); const int m = 2 * mh + mm;
#pragma unroll
                        for (int j = 0; j < 4; ++j) { acc[ai][bj][m][0][j] *= a[j] * __builtin_amdgcn_rcpf(b[j]); acc[ai][bj][m][1][j] *= a[4 + j] * __builtin_amdgcn_rcpf(b[4 + j]); } }
                __builtin_amdgcn_sched_barrier(0);
            }
    }
    __device__ __forceinline__ void finish(f32x4 (&acc)[2][2][4][2], const pg8::Unit& u, int wr, int wc, int fr, int fq) const {
        asm volatile("" : "+v"(fr), "+v"(fq));
        const int row0 = u.pm * 256 + wr * 64 + fr, col0 = u.pn * 256 + wc * 32 + 8 * fq;
#pragma unroll
        for (int ai = 0; ai < 2; ++ai)
#pragma unroll
            for (int m = 0; m < 4; ++m)
#pragma unroll
                for (int bj = 0; bj < 2; ++bj) { const int row = row0 + ai * 128 + m * 16, col = col0 + bj * 128;
                    float gv[8]; unpack8(*(const u32x4*)(gates + (size_t)row * 3072 + 2048 + col), gv);
                    const f32x4 x = acc[ai][bj][m][0], y = acc[ai][bj][m][1];
                    float v[8] = {x[0] * gv[0], x[1] * gv[1], x[2] * gv[2], x[3] * gv[3], y[0] * gv[4], y[1] * gv[5], y[2] * gv[6], y[3] * gv[7]};
                    *(u32x4*)(mb + (size_t)row * 1024 + col) = pack8(v); }
    }
};
struct EpiWout { static constexpr bool SERIAL = false;
    gfp x; bf16_t* pre;
    __device__ __forceinline__ void operator()(int row, int col, int pn, f32x4 a, f32x4 b) const {
        gfp xp = x + (size_t)row * 1024 + col; typedef const __attribute__((address_space(1))) f32x4* g4p;
        st8_bf16(pre + (size_t)row * 1024 + col, *(g4p)xp * ALPHA + a, *(g4p)(xp + 4) * ALPHA + b);
    }
};
struct EpiPeerQ { static constexpr bool SERIAL = false; bf16_t* o; __device__ __forceinline__ void operator()(int row, int col, int pn, f32x4 a, f32x4 b) const { st8_bf16(o + (size_t)row * 2048 + col, a, b); } };

template <int N, int K, class F> __device__ __forceinline__ void build_bt(bf16_t* dst, const F& f, int gt, int ngt) {
    constexpr int items = N * (K / 8);
    for (int i = gt; i < items; i += ngt) { const int n = i % N, k0 = (i / N) * 8; float v[8];
#pragma unroll
        for (int j = 0; j < 8; ++j) v[j] = f(n, k0 + j);
        *(u32x4*)(dst + (size_t)n * K + k0) = pack8(v); }
}
template <int N, int K, class F> __device__ __forceinline__ void build_bt_ld(bf16_t* dst, int ld, const F& f, int gt, int ngt) {
    constexpr int items = N * (K / 8);
    for (int i = gt; i < items; i += ngt) { const int n = i % N, k0 = (i / N) * 8; float v[8];
#pragma unroll
        for (int j = 0; j < 8; ++j) v[j] = f(n, k0 + j);
        *(u32x4*)(dst + (size_t)n * ld + k0) = pack8(v); }
}
struct FWin { gfp w; __device__ __forceinline__ float operator()(int n, int k) const { if (n < 424) return w[(size_t)k * IN_W + n]; if (n < 512) return 0.f; return w[(size_t)k * IN_W + n - 88]; } };
struct FWg { gfp w; __device__ __forceinline__ float operator()(int n, int k) const { return w[(size_t)k * IN_W + 2728 + n]; } };
struct FLora { gfp w2, a2, g2; __device__ __forceinline__ float operator()(int n, int k) const {
    if (n < 512) return k < 64 ? w2[k * 512 + n] : 0.f;
    if (n < 1024) return (k >= 64 && k < 128) ? a2[(k - 64) * 512 + n - 512] : 0.f;
    return k >= 128 ? g2[(k - 128) * 512 + n - 1024] : 0.f; } };
struct FWq { const float *uq, *uk, *iq; __device__ __forceinline__ float operator()(int n, int k) const {
    if (n >= 1024) return iq[k * 256 + n - 1024];
    const int h = n >> 7, c = n & 127; const float* a = uq + (size_t)k * 512 + h * 64; const float* b = uk + (size_t)(c * 8 + h) * 64; float s = 0.f;
#pragma unroll 8
    for (int d = 0; d < 64; ++d) s = fmaf(a[d], b[d], s);
    return s * 0.125f; } };
struct FWov { const float *uv, *br; __device__ __forceinline__ float operator()(int n, int k) const {
    const int h = k >> 7, c = k & 127; const float* a = uv + (size_t)(c * 8 + h) * 64; const float* b = br + (size_t)(h * 64) * 1024 + n; float s = 0.f;
#pragma unroll 8
    for (int d = 0; d < 64; ++d) s = fmaf(a[d], b[(size_t)d * 1024], s);
    return s; } };
struct FT { gfp w; int ld; __device__ __forceinline__ float operator()(int n, int k) const { return w[(size_t)k * ld + n]; } };

__device__ __forceinline__ void cvt_rows(gfp src, bf16_t* dst, size_t n8, int gt, int ngt) {
    for (size_t i = gt; i < n8; i += ngt) { const f32x4 a = *(const __attribute__((address_space(1))) f32x4*)(src + i * 8), b = *(const __attribute__((address_space(1))) f32x4*)(src + i * 8 + 4); st8_bf16(dst + i * 8, a, b); }
}
constexpr float PEER_U_SCALE = 64.0f, PEER_V_SCALE = 8.0f;
__device__ __forceinline__ void cvt_rows_fp8(gfp src, unsigned char* dst, size_t n16, float scale, int gt, int ngt) {
    for (size_t i = gt; i < n16; i += ngt) { typedef const __attribute__((address_space(1))) f32x4* g4p; gfp p = src + i * 16; u32x4 w;
        const f32x4 a = *(g4p)p * scale, b = *(g4p)(p + 4) * scale, c = *(g4p)(p + 8) * scale, d = *(g4p)(p + 12) * scale;
        int t = 0; t = __builtin_amdgcn_cvt_pk_fp8_f32(a.x, a.y, t, false); t = __builtin_amdgcn_cvt_pk_fp8_f32(a.z, a.w, t, true); w.x = (unsigned)t;
        t = 0; t = __builtin_amdgcn_cvt_pk_fp8_f32(b.x, b.y, t, false); t = __builtin_amdgcn_cvt_pk_fp8_f32(b.z, b.w, t, true); w.y = (unsigned)t;
        t = 0; t = __builtin_amdgcn_cvt_pk_fp8_f32(c.x, c.y, t, false); t = __builtin_amdgcn_cvt_pk_fp8_f32(c.z, c.w, t, true); w.z = (unsigned)t;
        t = 0; t = __builtin_amdgcn_cvt_pk_fp8_f32(d.x, d.y, t, false); t = __builtin_amdgcn_cvt_pk_fp8_f32(d.z, d.w, t, true); w.w = (unsigned)t;
        *(u32x4*)(dst + i * 16) = w; }
}
__device__ __forceinline__ void p0_prologue(const Ctx& C) {
    const float* const* in = C.in; unsigned char* ws = C.ws;
    cvt_rows(G_(in[0]), (bf16_t*)(C.dout + DO_XB), (size_t)T * D / 8, C.gt, C.ngt);
    cvt_rows(G_(in[1]), (bf16_t*)(ws + WS_MEMB), (size_t)1024 * 1024 / 8, C.gt, C.ngt);
    cvt_rows(G_(in[29]), (bf16_t*)(ws + WS_KEYS), (size_t)2 * 128 * 128 / 8, C.gt, C.ngt);
    build_bt<2816, 1024>((bf16_t*)(ws + WS_WIN), FWin{G_(in[3])}, C.gt, C.ngt);
    build_bt<1536, 256>((bf16_t*)(ws + WS_WLORA), FLora{G_(in[12]), G_(in[14]), G_(in[15])}, C.gt, C.ngt);
    {
        bf16_t* dst = (bf16_t*)(ws + WS_WQ); const float* uq = in[6]; const float* uk = in[7];
        for (int item = C.gw; item < 4096; item += C.ngw) { const int n = item >> 2, k = (item & 3) * 64 + C.lane, h = n >> 7, c = n & 127;
            const float* a = uq + (size_t)k * 512 + h * 64; const float* bq = uk + (size_t)(c * 8 + h) * 64; float s = 0.f;
#pragma unroll
            for (int d4 = 0; d4 < 16; ++d4) { const f32x4 av = *(const f32x4*)(a + 4 * d4), bv = *(const f32x4*)(bq + 4 * d4); s += av.x * bv.x + av.y * bv.y + av.z * bv.z + av.w * bv.w; }
            dst[(size_t)n * 256 + k] = (bf16_t)f2bf(s * 0.125f); }
        build_bt<256, 256>(dst + 1024 * 256, FT{G_(in[9]), 256}, C.gt, C.ngt);
    }
    build_bt<1024, 1024>((bf16_t*)(ws + WS_WMEMKV), FT{G_(in[21]), 1024}, C.gt, C.ngt);
}
__device__ __forceinline__ void p6_late_weights(const Ctx& C) {
    const float* const* in = C.in; unsigned char* ws = C.ws;
    build_bt<3072, 1024>((bf16_t*)(ws + WS_WG), FWg{G_(in[3])}, C.gt, C.ngt);
    {
        bf16_t* dst = (bf16_t*)(ws + WS_WOV); const float* uv = in[8]; const float* br = in[22];
        for (int i = C.gt; i < 1024 * 128; i += C.ngt) { const int n = i & 1023, k0 = (i >> 10) * 8, h = k0 >> 7, c0 = k0 & 127; float acc[8];
#pragma unroll
            for (int j = 0; j < 8; ++j) acc[j] = 0.f;
            for (int d4 = 0; d4 < 16; ++d4) {
                float b[4];
#pragma unroll
                for (int q = 0; q < 4; ++q) b[q] = br[(size_t)(h * 64 + 4 * d4 + q) * 1024 + n];
#pragma unroll
                for (int j = 0; j < 8; ++j) { const f32x4 a = *(const f32x4*)(uv + (size_t)((c0 + j) * 8 + h) * 64 + 4 * d4); acc[j] += a.x * b[0] + a.y * b[1] + a.z * b[2] + a.w * b[3]; }
            }
            *(u32x4*)(dst + (size_t)n * 2048 + k0) = pack8(acc); }
    }
    build_bt_ld<1024, 512>((bf16_t*)(ws + WS_WOV) + 1024, 2048, FT{G_(in[23]), 1024}, C.gt, C.ngt);
    build_bt_ld<1024, 512>((bf16_t*)(ws + WS_WOV) + 1536, 2048, FT{G_(in[24]), 1024}, C.gt, C.ngt);
    build_bt<1024, 1024>((bf16_t*)(ws + WS_WOUT), FT{G_(in[25]), 1024}, C.gt, C.ngt);
    build_bt<2048, 1024>((bf16_t*)(ws + WS_WPEER), FT{G_(in[28]), 2048}, C.gt, C.ngt);
}

__device__ __forceinline__ void p2_prep(const Ctx& C) {
    const float* const* in = C.in; unsigned char* ws = C.ws; const int lane = C.lane;
    const float* csmall = (const float*)(ws + WS_CSMALL); const bf16_t* rcols = (const bf16_t*)(ws + WS_RCOLS);
    bf16_t* cqn = (bf16_t*)(ws + WS_CQN); bf16_t* kvl = (bf16_t*)(ws + WS_KVL); bf16_t* kidx = (bf16_t*)(ws + WS_KIDX); float* widx = (float*)(ws + WS_WIDX);
    bf16_t* rr = (bf16_t*)(ws + WS_RW_R); bf16_t* rk = (bf16_t*)(ws + WS_RW_K); bf16_t* rv = (bf16_t*)(ws + WS_RW_V); bf16_t* la = (bf16_t*)(ws + WS_LORAA);
    const float* mu = in[10];
    const f32x4 gq = *(const f32x4*)(in[4] + 4 * lane); const f32x2 gk = *(const f32x2*)(in[5] + 2 * lane);
    for (int t = C.gw; t < T; t += C.ngw) {
        const float* cs = csmall + (size_t)t * 512;
        {
            const f32x4 q = *(const f32x4*)(cs + 4 * lane);
            const float ss = wave_sum(q.x * q.x + q.y * q.y + q.z * q.z + q.w * q.w);
            const float rs = rsqrtf(ss * (1.0f / 256.0f) + 1e-6f);
            u32x2 w; w.x = pk2(q.x * rs * gq.x, q.y * rs * gq.y); w.y = pk2(q.z * rs * gq.z, q.w * rs * gq.w);
            *(u32x2*)(cqn + (size_t)t * 256 + 4 * lane) = w;
        }
        {
            const f32x2 k = *(const f32x2*)(cs + 256 + 2 * lane);
            const float ss = wave_sum(k.x * k.x + k.y * k.y);
            const float rs = rsqrtf(ss * (1.0f / 128.0f) + 1e-6f);
            *(unsigned*)(kvl + (size_t)t * 128 + 2 * lane) = pk2(k.x * rs * gk.x, k.y * rs * gk.y);
        }
        if (lane < 16) { const f32x2 k = *(const f32x2*)(cs + 384 + 2 * lane); *(unsigned*)(kidx + (size_t)t * 32 + 2 * lane) = pk2(k.x, k.y); }
        if (lane < 8) widx[(size_t)t * 8 + lane] = cs[416 + lane] * 0.0625f;
        const bf16_t* rc = rcols + (size_t)t * 1792; const bool hp = (t & (SEQ - 1)) != 0; const bf16_t* rp = hp ? rc - 1792 : rc;
#pragma unroll
        for (int seg = 0; seg < 3; ++seg) {
            float c[8], p[8], o[8];
            unpack8(*(const u32x4*)(rc + seg * 512 + 8 * lane), c); unpack8(*(const u32x4*)(rp + seg * 512 + 8 * lane), p);
            const f32x4 m0 = *(const f32x4*)(mu + seg * 512 + 8 * lane), m1 = *(const f32x4*)(mu + seg * 512 + 8 * lane + 4);
            const float mm[8] = {m0.x, m0.y, m0.z, m0.w, m1.x, m1.y, m1.z, m1.w};
#pragma unroll
            for (int j = 0; j < 8; ++j) { const float pv = hp ? p[j] : 0.f; o[j] = c[j] + (pv - c[j]) * mm[j]; }
            bf16_t* dst = (seg == 0 ? rr : (seg == 1 ? rk : rv)) + (size_t)t * 512 + 8 * lane;
            *(u32x4*)dst = pack8(o);
        }
        {
            const float cw = bf1(rc[1536 + lane]), pw = hp ? bf1(rp[1536 + lane]) : 0.f; const float wl = cw + (pw - cw) * mu[1536 + lane];
            const float ca = bf1(rc[1600 + lane]), pa = hp ? bf1(rp[1600 + lane]) : 0.f; const float al = ca + (pa - ca) * mu[1600 + lane];
            const unsigned cgw = *(const unsigned*)(rc + 1664 + 2 * lane), pgw = *(const unsigned*)(rp + 1664 + 2 * lane);
            const float cg0 = bflo(cgw), cg1 = bfhi(cgw), pg0 = hp ? bflo(pgw) : 0.f, pg1 = hp ? bfhi(pgw) : 0.f;
            const float g0 = cg0 + (pg0 - cg0) * mu[1664 + 2 * lane], g1 = cg1 + (pg1 - cg1) * mu[1664 + 2 * lane + 1];
            bf16_t* l = la + (size_t)t * 256;
            l[lane] = (bf16_t)f2bf(tanhf(wl)); l[64 + lane] = (bf16_t)f2bf(al);
            *(unsigned*)(l + 128 + 2 * lane) = pk2(sigmoidf_(g0), sigmoidf_(g1));
        }
    }
}

template <int NV> __device__ __forceinline__ unsigned kth_largest(const unsigned (&u)[NV], int k) {
    unsigned Tk = 0u;
    for (int bit = 31; bit >= 0; --bit) {
        const unsigned cand = Tk | (1u << bit); int cnt = 0;
#pragma unroll
        for (int j = 0; j < NV; ++j) cnt += __popcll(__ballot(u[j] >= cand));
        if (cnt >= k) Tk = cand;
    }
    return Tk;
}

__device__ __forceinline__ unsigned wave_max_u(unsigned x) {
    unsigned y;
    y = dpp_u<0x111>(x); x = x > y ? x : y; y = dpp_u<0x112>(x); x = x > y ? x : y; y = dpp_u<0x114>(x); x = x > y ? x : y; y = dpp_u<0x118>(x); x = x > y ? x : y;
    y = (unsigned)__builtin_amdgcn_update_dpp(0, (int)x, 0x142, 0xA, 0xF, false); x = x > y ? x : y;
    y = (unsigned)__builtin_amdgcn_update_dpp(0, (int)x, 0x143, 0xC, 0xF, false); x = x > y ? x : y;
    return (unsigned)__builtin_amdgcn_readlane((int)x, 63);
}
__device__ __forceinline__ int wave_sum_i(int x) {
    x += __builtin_amdgcn_update_dpp(0, x, 0x111, 0xF, 0xF, false); x += __builtin_amdgcn_update_dpp(0, x, 0x112, 0xF, 0xF, false);
    x += __builtin_amdgcn_update_dpp(0, x, 0x114, 0xF, 0xF, false); x += __builtin_amdgcn_update_dpp(0, x, 0x118, 0xF, 0xF, false);
    x += __builtin_amdgcn_update_dpp(0, x, 0x142, 0xA, 0xF, false); x += __builtin_amdgcn_update_dpp(0, x, 0x143, 0xC, 0xF, false);
    return __builtin_amdgcn_readlane(x, 63);
}
__device__ __forceinline__ float wave_max_f(float x) {
    const int ninf = (int)0xff800000u; float y;
    y = __builtin_bit_cast(float, __builtin_amdgcn_update_dpp(ninf, __builtin_bit_cast(int, x), 0x111, 0xF, 0xF, false)); x = fmaxf(x, y);
    y = __builtin_bit_cast(float, __builtin_amdgcn_update_dpp(ninf, __builtin_bit_cast(int, x), 0x112, 0xF, 0xF, false)); x = fmaxf(x, y);
    y = __builtin_bit_cast(float, __builtin_amdgcn_update_dpp(ninf, __builtin_bit_cast(int, x), 0x114, 0xF, 0xF, false)); x = fmaxf(x, y);
    y = __builtin_bit_cast(float, __builtin_amdgcn_update_dpp(ninf, __builtin_bit_cast(int, x), 0x118, 0xF, 0xF, false)); x = fmaxf(x, y);
    y = __builtin_bit_cast(float, __builtin_amdgcn_update_dpp(ninf, __builtin_bit_cast(int, x), 0x142, 0xA, 0xF, false)); x = fmaxf(x, y);
    y = __builtin_bit_cast(float, __builtin_amdgcn_update_dpp(ninf, __builtin_bit_cast(int, x), 0x143, 0xC, 0xF, false)); x = fmaxf(x, y);
    return __builtin_bit_cast(float, __builtin_amdgcn_readlane(__builtin_bit_cast(int, x), 63));
}
__device__ __forceinline__ int wave_scan_i(int x) {
    x += __builtin_amdgcn_update_dpp(0, x, 0x111, 0xF, 0xF, false); x += __builtin_amdgcn_update_dpp(0, x, 0x112, 0xF, 0xF, false);
    x += __builtin_amdgcn_update_dpp(0, x, 0x114, 0xF, 0xF, false); x += __builtin_amdgcn_update_dpp(0, x, 0x118, 0xF, 0xF, false);
    x += __builtin_amdgcn_update_dpp(0, x, 0x142, 0xA, 0xF, false); x += __builtin_amdgcn_update_dpp(0, x, 0x143, 0xC, 0xF, false);
    return x;
}
__device__ __forceinline__ int hist_find(u32x4 h, int K, int lane, int& chi, int& cnt) {
    const int ls = (int)(h.x + h.y + h.z + h.w); const int inc = wave_scan_i(ls); const int tot = __builtin_amdgcn_readlane(inc, 63);
    const int a3 = tot - inc, a2 = a3 + (int)h.w, a1 = a2 + (int)h.z, a0 = a1 + (int)h.y;
    int myb = -1, mya = 0, myc = 0;
    if (a3 < K && K <= a3 + (int)h.w) { myb = 3; mya = a3; myc = (int)h.w; }
    if (a2 < K && K <= a2 + (int)h.z) { myb = 2; mya = a2; myc = (int)h.z; }
    if (a1 < K && K <= a1 + (int)h.y) { myb = 1; mya = a1; myc = (int)h.y; }
    if (a0 < K && K <= a0 + (int)h.x) { myb = 0; mya = a0; myc = (int)h.x; }
    const unsigned long long m = __ballot(myb >= 0); const int src = m ? (int)__builtin_ctzll(m) : 0;
    chi = __builtin_amdgcn_readlane(mya, src); cnt = __builtin_amdgcn_readlane(myc, src);
    return 4 * src + __builtin_amdgcn_readlane(myb, src);
}
constexpr int LDS_HIST = 131072 + 4096;
__device__ __forceinline__ void p4_indexer(const Ctx& C) {
    unsigned char* ws = C.ws; const int lane = C.lane, wave = C.wave, g = lane >> 4, fr = lane & 15;
    const bf16_t* qidx = (const bf16_t*)(ws + WS_QIDX); const bf16_t* kidx = (const bf16_t*)(ws + WS_KIDX); const float* widx = (const float*)(ws + WS_WIDX);
    bf16_t* idxo = (bf16_t*)(ws + WS_IDX);
    constexpr int SCB = 8192 + 16;
    LAS unsigned char* SC = C.lds;
    LAS unsigned* H = (LAS unsigned*)(C.lds + LDS_HIST + wave * 1024);
    for (int u = blockIdx.x; u < 1024; u += C.G) {
        const int i4 = u >> 8, cc = u & 255, b = cc & 3, j = cc >> 2, qb = (i4 & 1) ? 64 * i4 + 63 - j : 64 * i4 + j;
        const int t0 = qb * 16, ntile = (t0 + 16 + 15) >> 4; const size_t tb = (size_t)b * SEQ; const size_t qrow = tb + t0 + fr;
        bf16x8 Bq[8];
#pragma unroll
        for (int h = 0; h < 8; ++h) Bq[h] = *(const bf16x8*)(qidx + qrow * 256 + h * 32 + 8 * g);
        const f32x4 w0 = *(const f32x4*)(widx + qrow * 8), w1 = *(const f32x4*)(widx + qrow * 8 + 4);
        const float wq[8] = {w0.x, w0.y, w0.z, w0.w, w1.x, w1.y, w1.z, w1.w};
        bf16x8 An[4];
#pragma unroll
        for (int q = 0; q < 4; ++q) { int i = wave + q * NWAVES; i = i < ntile ? i : ntile - 1; An[q] = *(const bf16x8*)(kidx + (tb + 16 * i + fr) * 32 + 8 * g); }
        for (int i0 = wave; i0 < ntile; i0 += 4 * NWAVES) {
            bf16x8 A[4];
#pragma unroll
            for (int q = 0; q < 4; ++q) A[q] = An[q];
#pragma unroll
            for (int q = 0; q < 4; ++q) { int i = i0 + 4 * NWAVES + q * NWAVES; i = i < ntile ? i : ntile - 1; An[q] = *(const bf16x8*)(kidx + (tb + 16 * i + fr) * 32 + 8 * g); }
#pragma unroll
            for (int q = 0; q < 4; ++q) {
                const int i = i0 + q * NWAVES;
                if (i < ntile) {
                    f32x4 sc = (f32x4){0.f, 0.f, 0.f, 0.f};
#pragma unroll
                    for (int h = 0; h < 8; ++h) { const f32x4 d = __builtin_amdgcn_mfma_f32_16x16x32_bf16(A[q], Bq[h], (f32x4){0.f, 0.f, 0.f, 0.f}, 0, 0, 0);
#pragma unroll
                        for (int r = 0; r < 4; ++r) sc[r] = fmaf(wq[h], fmaxf(d[r], 0.f), sc[r]); }
                    const int tq = t0 + fr, s0 = 16 * i + 4 * g; unsigned kq[4];
#pragma unroll
                    for (int r = 0; r < 4; ++r) { const unsigned hb = (unsigned)__builtin_bit_cast(unsigned short, (_Float16)sc[r]); const unsigned ky = (hb & 0x8000u) ? (~hb & 0xffffu) : (hb | 0x8000u); kq[r] = (s0 + r <= tq) ? ky : 0u; }
                    u32x2 w; w.x = kq[0] | (kq[1] << 16); w.y = kq[2] | (kq[3] << 16);
                    *(LAS u32x2*)(SC + fr * SCB + 2 * s0) = w;
                }
            }
        }
        __syncthreads();
#pragma unroll 1
        for (int rr = 0; rr < 2; ++rr) {
            const int row = wave + 8 * rr, tq = t0 + row; bf16_t* out = idxo + (tb + tq) * 256;
            if (tq < 256) {
#pragma unroll
                for (int jj = 0; jj < 4; ++jj) { const int s = jj * 64 + lane; if (s <= tq) out[s] = (bf16_t)s; }
            } else {
                unsigned kp[32];
#pragma unroll
                for (int d = 0; d < 32; ++d) { const int s2 = 2 * (64 * d + lane); unsigned w = *(const LAS unsigned*)(SC + row * SCB + 2 * s2); if (s2 > tq) w = 0u; kp[d] = w; }
                *(LAS u32x4*)(H + 4 * lane) = (u32x4){0u, 0u, 0u, 0u};
#pragma unroll
                for (int d = 0; d < 32; ++d) { const unsigned a = kp[d] & 0xffffu, bq_ = kp[d] >> 16;
                    if (a) __hip_atomic_fetch_add(H + (a >> 8), 1u, __ATOMIC_RELAXED, __HIP_MEMORY_SCOPE_WORKGROUP);
                    if (bq_) __hip_atomic_fetch_add(H + (bq_ >> 8), 1u, __ATOMIC_RELAXED, __HIP_MEMORY_SCOPE_WORKGROUP); }
                asm volatile("s_waitcnt lgkmcnt(0)" ::: "memory");
                int chi1, cnt1; const int b1 = hist_find(*(const LAS u32x4*)(H + 4 * lane), 256, lane, chi1, cnt1);
                asm volatile("s_waitcnt lgkmcnt(0)" ::: "memory");
                *(LAS u32x4*)(H + 4 * lane) = (u32x4){0u, 0u, 0u, 0u};
#pragma unroll
                for (int d = 0; d < 32; ++d) { const unsigned a = kp[d] & 0xffffu, bq_ = kp[d] >> 16;
                    if ((int)(a >> 8) == b1 && a) __hip_atomic_fetch_add(H + (a & 255u), 1u, __ATOMIC_RELAXED, __HIP_MEMORY_SCOPE_WORKGROUP);
                    if ((int)(bq_ >> 8) == b1 && bq_) __hip_atomic_fetch_add(H + (bq_ & 255u), 1u, __ATOMIC_RELAXED, __HIP_MEMORY_SCOPE_WORKGROUP); }
                asm volatile("s_waitcnt lgkmcnt(0)" ::: "memory");
                int chi2, cnt2; const int b2 = hist_find(*(const LAS u32x4*)(H + 4 * lane), 256 - chi1, lane, chi2, cnt2);
                const unsigned T16 = (unsigned)(b1 * 256 + b2); const int need = 256 - chi1 - chi2;
                const bool allties = (need == cnt2); const unsigned thr = allties ? T16 : T16 + 1u;
                unsigned mlo = 0u, mhi = 0u;
#pragma unroll
                for (int d = 0; d < 16; ++d) { const unsigned a = kp[d] & 0xffffu, bq_ = kp[d] >> 16; mlo |= (a >= thr ? 1u : 0u) << (2 * d); mlo |= (bq_ >= thr ? 1u : 0u) << (2 * d + 1); }
#pragma unroll
                for (int d = 16; d < 32; ++d) { const unsigned a = kp[d] & 0xffffu, bq_ = kp[d] >> 16; mhi |= (a >= thr ? 1u : 0u) << (2 * (d - 16)); mhi |= (bq_ >= thr ? 1u : 0u) << (2 * (d - 16) + 1); }
                LAS bf16_t* stage = (LAS bf16_t*)(SC + row * SCB);
                const int mycnt = __popc(mlo) + __popc(mhi); int base = wave_scan_i(mycnt) - mycnt;
                while (mlo) { const int bp = __builtin_ctz(mlo); stage[base++] = (bf16_t)(2 * (64 * (bp >> 1) + lane) + (bp & 1)); mlo &= mlo - 1u; }
                while (mhi) { const int bp = __builtin_ctz(mhi); stage[base++] = (bf16_t)(2 * (64 * ((bp >> 1) + 16) + lane) + (bp & 1)); mhi &= mhi - 1u; }
                if (!allties) {
                    int eqb = 0; const int pos0 = 256 - need;
#pragma unroll 4
                    for (int d = 0; d < 32; ++d) {
                        const bool eq0 = ((kp[d] & 0xffffu) == T16), eq1 = ((kp[d] >> 16) == T16);
                        const unsigned long long m0 = __ballot(eq0), m1 = __ballot(eq1);
                        const int below = (int)__builtin_amdgcn_mbcnt_hi((unsigned)(m0 >> 32), __builtin_amdgcn_mbcnt_lo((unsigned)m0, 0u)) + (int)__builtin_amdgcn_mbcnt_hi((unsigned)(m1 >> 32), __builtin_amdgcn_mbcnt_lo((unsigned)m1, 0u));
                        const int r0 = eqb + below, r1 = r0 + (eq0 ? 1 : 0);
                        if (eq0 && r0 < need) stage[pos0 + r0] = (bf16_t)(2 * (64 * d + lane));
                        if (eq1 && r1 < need) stage[pos0 + r1] = (bf16_t)(2 * (64 * d + lane) + 1);
                        eqb += __popcll(m0) + __popcll(m1);
                    }
                }
                asm volatile("s_waitcnt lgkmcnt(0)" ::: "memory");
                *(u32x2*)(out + 4 * lane) = *(const LAS u32x2*)(stage + 4 * lane);
            }
        }
        __syncthreads();
    }
}

__device__ __forceinline__ void p4_memattn(const Ctx& C) {
    unsigned char* ws = C.ws; const int lane = C.lane, wave = C.wave, g = lane >> 4, fr = lane & 15;
    const bf16_t* memq = (const bf16_t*)(ws + WS_MEMQ); const bf16_t* kmem = (const bf16_t*)(ws + WS_KMEM); const bf16_t* vmt = (const bf16_t*)(ws + WS_VMEMT);
    bf16_t* ymem = (bf16_t*)(ws + WS_YM) + 512;
    LAS unsigned char* KL = C.lds; LAS unsigned char* VL = C.lds + 65536;
    for (int su = blockIdx.x; su < 256; su += C.G) {
        const int bh = su >> 4, j = su & 15, b = bh >> 2, h = bh & 3;
        const char* kb = (const char*)(kmem + (size_t)(bh * 256) * 128); const char* vb = (const char*)(vmt + (size_t)(bh * 128) * 256);
#pragma unroll
        for (int pp = 0; pp < 8; ++pp) { const int p = wave + 8 * pp;
            { const int row = 4 * p + g; const int c = fr ^ (2 * (row & 7)); __builtin_amdgcn_global_load_lds((const unsigned*)(kb + row * 256 + 16 * c), (LAS unsigned*)(KL + 1024 * p), 16, 0, 0); }
            { const int row = 2 * p + (lane >> 5); const int c = (lane & 31) ^ (row & 15); __builtin_amdgcn_global_load_lds((const unsigned*)(vb + row * 512 + 16 * c), (LAS unsigned*)(VL + 1024 * p), 16, 0, 0); } }
        asm volatile("s_waitcnt vmcnt(0)" ::: "memory");
        __syncthreads();
#pragma unroll 1
        for (int u = 0; u < 2; ++u) {
            const int t0 = b * SEQ + (2 * j + u) * 128 + wave * 16;
            bf16x8 Bq[4];
#pragma unroll
            for (int kk = 0; kk < 4; ++kk) Bq[kk] = *(const bf16x8*)(memq + (size_t)(t0 + fr) * 512 + h * 128 + 32 * kk + 8 * g);
            f32x4 sc[16];
#pragma unroll
            for (int i = 0; i < 16; ++i) { if ((i & 1) == 0) __builtin_amdgcn_sched_barrier(0); f32x4 a = (f32x4){0.f, 0.f, 0.f, 0.f}; const int row = 16 * i + fr;
#pragma unroll
                for (int kk = 0; kk < 4; ++kk) { const bf16x8 A = *(const LAS bf16x8*)(KL + row * 256 + 16 * ((4 * kk + g) ^ (2 * (row & 7)))); a = __builtin_amdgcn_mfma_f32_16x16x32_bf16(A, Bq[kk], a, 0, 0, 0); }
                sc[i] = a; }
            const float scale = 0.08838834764831845f;
            float mx = -3.0e38f;
#pragma unroll
            for (int i = 0; i < 16; ++i)
#pragma unroll
                for (int r = 0; r < 4; ++r) { sc[i][r] *= scale; mx = fmaxf(mx, sc[i][r]); }
            mx = fmaxf(mx, __shfl_xor(mx, 16)); mx = fmaxf(mx, __shfl_xor(mx, 32));
            float sum = 0.f;
#pragma unroll
            for (int i = 0; i < 16; ++i)
#pragma unroll
                for (int r = 0; r < 4; ++r) { sc[i][r] = __expf(sc[i][r] - mx); sum += sc[i][r]; }
            sum += __shfl_xor(sum, 16); sum += __shfl_xor(sum, 32);
            const float inv = 1.0f / sum;
            bf16x8 Pb[8];
#pragma unroll
            for (int ks = 0; ks < 8; ++ks) { u32x4 w; w.x = pk2(sc[2 * ks][0] * inv, sc[2 * ks][1] * inv); w.y = pk2(sc[2 * ks][2] * inv, sc[2 * ks][3] * inv);
                w.z = pk2(sc[2 * ks + 1][0] * inv, sc[2 * ks + 1][1] * inv); w.w = pk2(sc[2 * ks + 1][2] * inv, sc[2 * ks + 1][3] * inv); Pb[ks] = __builtin_bit_cast(bf16x8, w); }
#pragma unroll
            for (int dt = 0; dt < 8; ++dt) {
                __builtin_amdgcn_sched_barrier(0);
                f32x4 o = (f32x4){0.f, 0.f, 0.f, 0.f}; const int row = 16 * dt + fr;
#pragma unroll
                for (int ks = 0; ks < 8; ++ks) { const int ch = 4 * ks + (g >> 1);
                    const u32x2 lo = *(const LAS u32x2*)(VL + row * 512 + 16 * (ch ^ (row & 15)) + 8 * (g & 1)), hi = *(const LAS u32x2*)(VL + row * 512 + 16 * ((ch + 2) ^ (row & 15)) + 8 * (g & 1));
                    u32x4 w; w.x = lo.x; w.y = lo.y; w.z = hi.x; w.w = hi.y;
                    o = __builtin_amdgcn_mfma_f32_16x16x32_bf16(__builtin_bit_cast(bf16x8, w), Pb[ks], o, 0, 0, 0); }
                u32x2 w; w.x = pk2(o[0], o[1]); w.y = pk2(o[2], o[3]);
                *(u32x2*)(ymem + (size_t)(t0 + fr) * 1024 + h * 128 + 16 * dt + 4 * g) = w;
            }
        }
        __syncthreads();
    }
}

constexpr int LDS_RELB = 131072 + 1024;
constexpr int LDS_LUT = LDS_RELB + 1024;
__device__ __forceinline__ void tr_read8(const unsigned (&a)[8], u32x2 (&d)[8]) {
    asm volatile("ds_read_b64_tr_b16 %0, %8\n\tds_read_b64_tr_b16 %1, %9\n\tds_read_b64_tr_b16 %2, %10\n\tds_read_b64_tr_b16 %3, %11\n\t"
                 "ds_read_b64_tr_b16 %4, %12\n\tds_read_b64_tr_b16 %5, %13\n\tds_read_b64_tr_b16 %6, %14\n\tds_read_b64_tr_b16 %7, %15\n\ts_waitcnt lgkmcnt(0)"
                 : "=&v"(d[0]), "=&v"(d[1]), "=&v"(d[2]), "=&v"(d[3]), "=&v"(d[4]), "=&v"(d[5]), "=&v"(d[6]), "=&v"(d[7])
                 : "v"(a[0]), "v"(a[1]), "v"(a[2]), "v"(a[3]), "v"(a[4]), "v"(a[5]), "v"(a[6]), "v"(a[7]) : "memory");
}
constexpr int LDS_DSAX = 131072 + 4096;
__device__ __forceinline__ void p5_dsa_attn(const Ctx& C, int qsel) {
    unsigned char* ws = C.ws; const int lane = C.lane, wave = C.wave, g = lane >> 4, fr = lane & 15;
    const bf16_t* qlat = (const bf16_t*)(ws + WS_QLAT); const bf16_t* kvl = (const bf16_t*)(ws + WS_KVL); const bf16_t* idxb = (const bf16_t*)(ws + WS_IDX);
    bf16_t* olat = (bf16_t*)(ws + WS_OLAT);
    LAS int* lut = (LAS int*)(C.lds + LDS_LUT);
    if (C.tid < 128) { const int n = C.tid; int bk = n; if (n >= 16) { bk = 16 + (int)(logf((float)n * (1.0f / 16.0f)) / 2.0794415416798357f * 16.0f); bk = bk > 31 ? 31 : bk; } lut[n] = bk; }
    __syncthreads();
    LAS unsigned char* my = C.lds + wave * 16384; const unsigned mybase = (unsigned)(uintptr_t)my;
    LAS bf16_t* IDXL = (LAS bf16_t*)(C.lds + LDS_DSAX + wave * 1024); LAS bf16_t* BKL = IDXL + 256;
    unsigned* qctr = (unsigned*)(ws + WS_CTL) + CW_DSAQ + 64 * qsel;
    const int qq = fr >> 2, p2 = fr & 3;
    bf16x8 Bbias;
    { float bv[8];
#pragma unroll
      for (int j = 0; j < 8; ++j) bv[j] = C.in[2][(8 * g + j) * 8 + (fr & 7)];
      Bbias = __builtin_bit_cast(bf16x8, pack8(bv)); }
    unsigned qkoff[2][4];
#pragma unroll
    for (int i = 0; i < 2; ++i) { const int ph = 4 * (fr & 7) + 2 * i + (fr >> 3);
#pragma unroll
        for (int kk = 0; kk < 4; ++kk) qkoff[i][kk] = (unsigned)(ph * 256 + 16 * ((4 * kk + g) ^ (2 * (ph & 7)))); }
    const int ph0 = 4 * (4 * (g & 1) + qq) + (g >> 1), ph1 = ph0 + 2;
    for (;;) {
      int q0 = 0; if (lane == 0) q0 = (int)__hip_atomic_fetch_add(qctr, 4u, __ATOMIC_RELAXED, __HIP_MEMORY_SCOPE_AGENT);
      q0 = __builtin_amdgcn_readfirstlane(q0); if (q0 >= T) break;
      for (int q = q0; q < q0 + 4; ++q) {
        const int b = q >> 12, s = q & (SEQ - 1); const int nvalid = s + 1 < 256 ? s + 1 : 256;
        const char* kvb = (const char*)(kvl + (size_t)b * SEQ * 128);
        {
            const u32x2 w = *(const u32x2*)(idxb + (size_t)q * 256 + 4 * lane); int ix[4] = {(int)(w.x & 0xffffu), (int)(w.x >> 16), (int)(w.y & 0xffffu), (int)(w.y >> 16)}; unsigned bk[4];
#pragma unroll
            for (int j = 0; j < 4; ++j) { if (4 * lane + j >= nvalid) ix[j] = 0; const int dist = s - ix[j]; bk[j] = (unsigned)(dist >= 128 ? 31 : lut[dist < 0 ? 0 : dist]); }
            u32x2 wi; wi.x = (unsigned)ix[0] | ((unsigned)ix[1] << 16); wi.y = (unsigned)ix[2] | ((unsigned)ix[3] << 16); *(LAS u32x2*)(IDXL + 4 * lane) = wi;
            u32x2 wb; wb.x = bk[0] | (bk[1] << 16); wb.y = bk[2] | (bk[3] << 16); *(LAS u32x2*)(BKL + 4 * lane) = wb;
        }
        bf16x8 Bq[4];
#pragma unroll
        for (int kk = 0; kk < 4; ++kk) Bq[kk] = *(const bf16x8*)(qlat + (size_t)q * 1024 + (fr & 7) * 128 + 32 * kk + 8 * g);
        float m_ref = 0.f, l_part = 0.f;
        f32x4 O[8];
#pragma unroll
        for (int cc = 0; cc < 8; ++cc) O[cc] = (f32x4){0.f, 0.f, 0.f, 0.f};
        const int nsub = (nvalid + 31) >> 5;
        asm volatile("s_waitcnt vmcnt(0) lgkmcnt(0)" ::: "memory");
        {
            const u32x4 rw = *(const LAS u32x4*)(IDXL + 8 * g); const unsigned rws[4] = {rw.x, rw.y, rw.z, rw.w};
#pragma unroll
            for (int p = 0; p < 8; ++p) { const int srow = (int)((rws[p >> 1] >> (16 * (p & 1))) & 0xffffu); const int c = fr ^ (2 * ((4 * p + g) & 7));
                __builtin_amdgcn_global_load_lds((const unsigned*)(kvb + (size_t)srow * 256 + 16 * c), (LAS unsigned*)(my + 1024 * p), 16, 0, 0); }
        }
#pragma unroll
        for (int sc_ = 0; sc_ < 8; ++sc_) {
          if (sc_ < nsub) {
            LAS unsigned char* cur = my + (sc_ & 1) * 8192; const unsigned curb = mybase + (sc_ & 1) * 8192;
            if (sc_ + 1 < nsub) {
                LAS unsigned char* nb = my + ((sc_ + 1) & 1) * 8192;
                const u32x4 rw = *(const LAS u32x4*)(IDXL + 32 * (sc_ + 1) + 8 * g); const unsigned rws[4] = {rw.x, rw.y, rw.z, rw.w};
#pragma unroll
                for (int p = 0; p < 8; ++p) { const int srow = (int)((rws[p >> 1] >> (16 * (p & 1))) & 0xffffu); const int c = fr ^ (2 * ((4 * p + g) & 7));
                    __builtin_amdgcn_global_load_lds((const unsigned*)(kvb + (size_t)srow * 256 + 16 * c), (LAS unsigned*)(nb + 1024 * p), 16, 0, 0); }
                asm volatile("s_waitcnt vmcnt(8)" ::: "memory");
            } else asm volatile("s_waitcnt vmcnt(0)" ::: "memory");
            f32x4 sc[2];
#pragma unroll
            for (int i = 0; i < 2; ++i) {
                const int pos = (int)BKL[32 * sc_ + 16 * i + fr] - 8 * g;
                u32x4 oh; oh.x = (pos == 0 ? 0x3F80u : 0u) | (pos == 1 ? 0x3F800000u : 0u); oh.y = (pos == 2 ? 0x3F80u : 0u) | (pos == 3 ? 0x3F800000u : 0u);
                oh.z = (pos == 4 ? 0x3F80u : 0u) | (pos == 5 ? 0x3F800000u : 0u); oh.w = (pos == 6 ? 0x3F80u : 0u) | (pos == 7 ? 0x3F800000u : 0u);
                f32x4 a = __builtin_amdgcn_mfma_f32_16x16x32_bf16(__builtin_bit_cast(bf16x8, oh), Bbias, (f32x4){0.f, 0.f, 0.f, 0.f}, 0, 0, 0);
#pragma unroll
                for (int kk = 0; kk < 4; ++kk) a = __builtin_amdgcn_mfma_f32_16x16x32_bf16(*(const LAS bf16x8*)(cur + qkoff[i][kk]), Bq[kk], a, 0, 0, 0);
                sc[i] = a; }
            if (nvalid < 256) {
#pragma unroll
                for (int i = 0; i < 2; ++i)
#pragma unroll
                    for (int r = 0; r < 4; ++r) if (sc_ * 32 + 16 * i + 4 * g + r >= nvalid) sc[i][r] = -INFINITY;
            }
            if (sc_ == 0) { float mx = fmaxf(fmaxf(fmaxf(sc[0][0], sc[0][1]), fmaxf(sc[0][2], sc[0][3])), fmaxf(fmaxf(sc[1][0], sc[1][1]), fmaxf(sc[1][2], sc[1][3])));
                mx = fmaxf(mx, __shfl_xor(mx, 16)); mx = fmaxf(mx, __shfl_xor(mx, 32)); m_ref = mx; }
#pragma unroll
            for (int i = 0; i < 2; ++i)
#pragma unroll
                for (int r = 0; r < 4; ++r) { sc[i][r] = __expf(sc[i][r] - m_ref); l_part += sc[i][r]; }
            u32x4 w; w.x = pk2(sc[0][0], sc[0][1]); w.y = pk2(sc[0][2], sc[0][3]); w.z = pk2(sc[1][0], sc[1][1]); w.w = pk2(sc[1][2], sc[1][3]);
            const bf16x8 Pa = __builtin_bit_cast(bf16x8, w);
#pragma unroll
            for (int hf = 0; hf < 2; ++hf) {
                unsigned ad[8]; u32x2 dd[8];
#pragma unroll
                for (int c4 = 0; c4 < 4; ++c4) { const int chk = 2 * (4 * hf + c4) + (p2 >> 1);
                    ad[2 * c4] = curb + ph0 * 256 + 16 * (chk ^ (2 * (ph0 & 7))) + 8 * (p2 & 1); ad[2 * c4 + 1] = curb + ph1 * 256 + 16 * (chk ^ (2 * (ph1 & 7))) + 8 * (p2 & 1); }
                tr_read8(ad, dd);
#pragma unroll
                for (int c4 = 0; c4 < 4; ++c4) { u32x4 bw; bw.x = dd[2 * c4].x; bw.y = dd[2 * c4].y; bw.z = dd[2 * c4 + 1].x; bw.w = dd[2 * c4 + 1].y;
                    O[4 * hf + c4] = __builtin_amdgcn_mfma_f32_16x16x32_bf16(Pa, __builtin_bit_cast(bf16x8, bw), O[4 * hf + c4], 0, 0, 0); }
            }
            asm volatile("" ::: "memory");
          }
        }
        float l_run = l_part; l_run += __shfl_xor(l_run, 16); l_run += __shfl_xor(l_run, 32);
        const float inv = 1.0f / l_run; float ir[4];
#pragma unroll
        for (int r = 0; r < 4; ++r) ir[r] = __shfl(inv, 4 * g + r);
        if (g < 2) {
#pragma unroll
            for (int cc = 0; cc < 8; ++cc)
#pragma unroll
                for (int r = 0; r < 4; ++r) olat[(size_t)q * 1024 + (4 * g + r) * 128 + 16 * cc + fr] = (bf16_t)f2bf(O[cc][r] * ir[r]);
        }
      }
    }
}

constexpr int RWM_LDS = 15872;
__device__ __forceinline__ bf16x8 frag_pack(f32x4 lo, f32x4 hi) { u32x4 w; w.x = pk2(lo.x, lo.y); w.y = pk2(lo.z, lo.w); w.z = pk2(hi.x, hi.y); w.w = pk2(hi.z, hi.w); return __builtin_bit_cast(bf16x8, w); }
__device__ __forceinline__ bf16x8 frag_pack_lo(f32x4 lo) { u32x4 w; w.x = pk2(lo.x, lo.y); w.y = pk2(lo.z, lo.w); w.z = 0u; w.w = 0u; return __builtin_bit_cast(bf16x8, w); }
struct RwIn { u32x4 e[2], k[2], a[2]; };
template <int MODE> __device__ __forceinline__ void rwm_fetch(RwIn& w, const bf16_t* pe, const bf16_t* pk, const bf16_t* pa, const bf16_t* pr, const bf16_t* pv, const bf16_t* pg, size_t t0, int h, int g, int fr) {
    const size_t rowoff = (t0 + fr) * 512 + h * 64;
#pragma unroll
    for (int k2 = 0; k2 < 2; ++k2) { const int c0 = 32 * k2 + 8 * g; w.e[k2] = *(const u32x4*)(pe + rowoff + c0); w.k[k2] = *(const u32x4*)(pk + rowoff + c0); w.a[k2] = *(const u32x4*)(pa + rowoff + c0);
        }
}
__device__ __forceinline__ void tr_read4(const unsigned (&a)[4], u32x2 (&d)[4]) {
    asm volatile("ds_read_b64_tr_b16 %0, %4\n\tds_read_b64_tr_b16 %1, %5\n\tds_read_b64_tr_b16 %2, %6\n\tds_read_b64_tr_b16 %3, %7\n\ts_waitcnt lgkmcnt(0)"
                 : "=&v"(d[0]), "=&v"(d[1]), "=&v"(d[2]), "=&v"(d[3]) : "v"(a[0]), "v"(a[1]), "v"(a[2]), "v"(a[3]) : "memory");
}
template <int O0, int O1, int O2, int O3> __device__ __forceinline__ void tr_read4_off(unsigned base, u32x2 (&d)[4]) {
    asm volatile("ds_read_b64_tr_b16 %0, %4 offset:%5\n\tds_read_b64_tr_b16 %1, %4 offset:%6\n\tds_read_b64_tr_b16 %2, %4 offset:%7\n\tds_read_b64_tr_b16 %3, %4 offset:%8\n\ts_waitcnt lgkmcnt(0)"
                 : "=&v"(d[0]), "=&v"(d[1]), "=&v"(d[2]), "=&v"(d[3]) : "v"(base), "i"(O0), "i"(O1), "i"(O2), "i"(O3) : "memory");
}
__device__ __forceinline__ bf16x8 frag_lo_raw(u32x2 lo) { u32x4 w; w.x = lo.x; w.y = lo.y; w.z = 0u; w.w = 0u; return __builtin_bit_cast(bf16x8, w); }
__device__ __forceinline__ bf16x8 frag_pack_raw(f32x4 lo, u32x2 hi) { u32x4 w; w.x = pk2(lo.x, lo.y); w.y = pk2(lo.z, lo.w); w.z = hi.x; w.w = hi.y; return __builtin_bit_cast(bf16x8, w); }
template <int MODE> __device__ __forceinline__ void rwm_task(const Ctx& C, int bh, int ch) {
    unsigned char* ws = C.ws; const int lane = C.lane, g = lane >> 4, fr = lane & 15; const int b = bh >> 3, h = bh & 7;
    const bf16_t* pr = (const bf16_t*)(ws + WS_RW_R); const bf16_t* pk = (const bf16_t*)(ws + WS_RW_K); const bf16_t* pv = (const bf16_t*)(ws + WS_RW_V);
    const bf16_t* pa = (const bf16_t*)(ws + WS_RW_A); const bf16_t* pe = (const bf16_t*)(ws + WS_RW_E); const bf16_t* pg = (const bf16_t*)(ws + WS_RW_G);
    bf16_t* yo = (bf16_t*)(ws + WS_YM);
    float* PQ = (float*)(C.dout + DO_PQ);
    LAS unsigned char* my = C.lds + C.wave * RWM_LDS; const unsigned myb = (unsigned)(uintptr_t)my;
    LAS unsigned char* SI = my; LAS unsigned char* BI = my + 9216; LAS unsigned char* KI = my + 11264; LAS float* CL = (LAS float*)(my + 13312); LAS unsigned char* VI = my + 13824;
    const gfp in16 = (gfp)C.in[16], in17 = (gfp)C.in[17], in18 = (gfp)C.in[18], in19 = (gfp)C.in[19], in20 = (gfp)C.in[20];
    const size_t tok0 = (size_t)b * SEQ + (size_t)ch * RL;
    const f32x4 Z4 = (f32x4){0.f, 0.f, 0.f, 0.f};
    const float* sbase = PQ + ((size_t)((bh * RCH + (ch > 0 ? ch - 1 : 0)) * 2)) * 4096 + fr * 64 + 4 * g;
    int gv = g; asm volatile("" : "+v"(gv));
    f32x4 S[4][4];
#pragma unroll
    for (int vt = 0; vt < 4; ++vt)
#pragma unroll
        for (int kt = 0; kt < 4; ++kt) {
            if (MODE == 1) { f32x4 x;
#pragma unroll
                for (int r = 0; r < 4; ++r) x[r] = (vt == kt && 4 * gv + r == fr) ? 1.f : 0.f;
                S[vt][kt] = x; }
            else if (MODE == 2 && ch > 0) { gfp sp = (gfp)(sbase + 1024 * vt); asm volatile("" : "+v"(sp));
                S[vt][kt] = *(const __attribute__((address_space(1))) f32x4*)(sp + 16 * kt); }
            else S[vt][kt] = Z4; }
    const bool strict[4] = {4 * g + 0 < fr, 4 * g + 1 < fr, 4 * g + 2 < fr, 4 * g + 3 < fr};
    const bool incl[4] = {4 * g + 0 <= fr, 4 * g + 1 <= fr, 4 * g + 2 <= fr, 4 * g + 3 <= fr};
    const int qq = fr >> 2, p2 = fr & 3; const unsigned trb = myb + (unsigned)((4 * g + qq) * 128 + 8 * p2);
    RwIn nxt; rwm_fetch<MODE>(nxt, pe, pk, pa, pr, pv, pg, tok0, h, g, fr);
#pragma unroll 1
    for (int sub = 0; sub < RL / 16; ++sub) {
        const size_t t0 = tok0 + (size_t)sub * 16;
        int frl = fr, gl_ = g; asm volatile("" : "+v"(frl), "+v"(gl_));
        u32x4 gq[2], rq[2], vq[2];
        { const size_t ro0 = (t0 + frl) * 512 + h * 64 + 8 * gl_;
          if (MODE == 2) { gq[0] = *(const u32x4*)(pg + ro0); gq[1] = *(const u32x4*)(pg + ro0 + 32); rq[0] = *(const u32x4*)(pr + ro0); rq[1] = *(const u32x4*)(pr + ro0 + 32); }
          if (MODE != 1) { vq[0] = *(const u32x4*)(pv + ro0); vq[1] = *(const u32x4*)(pv + ro0 + 32); } }
        const RwIn cur = nxt; rwm_fetch<MODE>(nxt, pe, pk, pa, pr, pv, pg, tok0 + (size_t)(sub + 1 < RL / 16 ? sub + 1 : sub) * 16, h, gl_, frl);
#pragma unroll
        for (int vt = 0; vt < 4; ++vt)
#pragma unroll
            for (int kt = 0; kt < 4; ++kt)
                { u32x2 w; w.x = pk2(S[vt][kt][0], S[vt][kt][1]); w.y = pk2(S[vt][kt][2], S[vt][kt][3]); *(LAS u32x2*)(SI + fr * 144 + 8 * g + vt * 2304 + 32 * kt) = w; }
        bf16x8 kap[2], rtl[2]; float bcoef = 0.f;
        {
            float ssq = 0.f, bsum = 0.f;
#pragma unroll
            for (int k2 = 0; k2 < 2; ++k2) { const int c0 = 32 * k2 + 8 * g; float kv[8]; unpack8(cur.k[k2], kv);
                const f32x4 kk0 = *(const __attribute__((address_space(1))) f32x4*)(in16 + h * 64 + c0), kk1 = *(const __attribute__((address_space(1))) f32x4*)(in16 + h * 64 + c0 + 4); const float kkc[8] = {kk0.x, kk0.y, kk0.z, kk0.w, kk1.x, kk1.y, kk1.z, kk1.w};
#pragma unroll
                for (int j = 0; j < 8; ++j) { const float x = kv[j] * kkc[j]; ssq += x * x; } }
            ssq += __shfl_xor(ssq, 16); ssq += __shfl_xor(ssq, 32);
            const float rn = __builtin_amdgcn_rsqf(fmaxf(ssq, 1e-24f));
#pragma unroll
            for (int k2 = 0; k2 < 2; ++k2) { const int c0 = 32 * k2 + 8 * g; float ev[8], kv[8], aa[8], rv[8];
                __builtin_amdgcn_sched_barrier(0);
                unpack8(cur.e[k2], ev); unpack8(cur.k[k2], kv); unpack8(cur.a[k2], aa);
                if (MODE == 2) unpack8(rq[k2], rv);
                const f32x4 ka0 = *(const __attribute__((address_space(1))) f32x4*)(in17 + h * 64 + c0), ka1 = *(const __attribute__((address_space(1))) f32x4*)(in17 + h * 64 + c0 + 4); const float kac[8] = {ka0.x, ka0.y, ka0.z, ka0.w, ka1.x, ka1.y, ka1.z, ka1.w};
                const f32x4 kk0 = *(const __attribute__((address_space(1))) f32x4*)(in16 + h * 64 + c0), kk1 = *(const __attribute__((address_space(1))) f32x4*)(in16 + h * 64 + c0 + 4); const float kkc[8] = {kk0.x, kk0.y, kk0.z, kk0.w, kk1.x, kk1.y, kk1.z, kk1.w};
                float rkc[8];
                if (MODE == 2) { const f32x4 r0 = *(const __attribute__((address_space(1))) f32x4*)(in18 + h * 64 + c0), r1 = *(const __attribute__((address_space(1))) f32x4*)(in18 + h * 64 + c0 + 4); rkc[0] = r0.x; rkc[1] = r0.y; rkc[2] = r0.z; rkc[3] = r0.w; rkc[4] = r1.x; rkc[5] = r1.y; rkc[6] = r1.z; rkc[7] = r1.w; }
                float kt_[8], bt_[8], kxt_[8], rt_[8];
#pragma unroll
                for (int j = 0; j < 8; ++j) {
                    float c = ev[j]; c += dpp_f<0x111>(c); c += dpp_f<0x112>(c); c += dpp_f<0x114>(c); c += dpp_f<0x118>(c);
                    const float kx = kv[j] * (1.0f + (aa[j] - 1.0f) * kac[j]); const float kk = kv[j] * kkc[j] * rn;
                    const float e2 = __expf(c), e3 = __builtin_amdgcn_rcpf(e2), e1 = e3 * __expf(ev[j]);
                    kt_[j] = kk * e1; bt_[j] = kk * aa[j] * e2; kxt_[j] = kx * e2;
                    if (MODE == 2) { rt_[j] = rv[j] * e3; bsum += rv[j] * kx * rkc[j]; } else rt_[j] = 0.f;
                    if (fr == 15) CL[c0 + j] = e3;
                }
                kap[k2] = __builtin_bit_cast(bf16x8, pack8(kt_)); if (MODE == 2) rtl[k2] = __builtin_bit_cast(bf16x8, pack8(rt_));
                *(LAS u32x4*)(BI + fr * 128 + 64 * k2 + 16 * g) = pack8(bt_); *(LAS u32x4*)(KI + fr * 128 + 64 * k2 + 16 * g) = pack8(kxt_);
            }
            if (MODE == 2) { bsum += __shfl_xor(bsum, 16); bsum += __shfl_xor(bsum, 32); bcoef = bsum; }
        }
        bf16x8 bet[2], kxf[2];
#pragma unroll
        for (int k2 = 0; k2 < 2; ++k2) { bet[k2] = *(const LAS bf16x8*)(BI + fr * 128 + 64 * k2 + 16 * g); kxf[k2] = *(const LAS bf16x8*)(KI + fr * 128 + 64 * k2 + 16 * g); }
        u32x2 VT[4];
        if (MODE != 1) {
#pragma unroll
            for (int k2 = 0; k2 < 2; ++k2) *(LAS u32x4*)(VI + fr * 128 + 64 * k2 + 16 * g) = vq[k2];
            tr_read4_off<13824, 13824 + 32, 13824 + 64, 13824 + 96>(trb, VT);
        } else {
#pragma unroll
            for (int vt = 0; vt < 4; ++vt) { VT[vt].x = 0u; VT[vt].y = 0u; }
        }
        f32x4 AT = Z4, BmT = Z4, C1T = Z4, C2T = Z4;
#pragma unroll
        for (int k2 = 0; k2 < 2; ++k2) { AT = __builtin_amdgcn_mfma_f32_16x16x32_bf16(bet[k2], kap[k2], AT, 0, 0, 0);
            if (MODE != 1) BmT = __builtin_amdgcn_mfma_f32_16x16x32_bf16(kxf[k2], kap[k2], BmT, 0, 0, 0);
            if (MODE == 2) { C1T = __builtin_amdgcn_mfma_f32_16x16x32_bf16(bet[k2], rtl[k2], C1T, 0, 0, 0); C2T = __builtin_amdgcn_mfma_f32_16x16x32_bf16(kxf[k2], rtl[k2], C2T, 0, 0, 0); } }
#pragma unroll
        for (int r = 0; r < 4; ++r) { AT[r] = strict[r] ? AT[r] : 0.f; BmT[r] = strict[r] ? BmT[r] : 0.f; C1T[r] = incl[r] ? C1T[r] : 0.f; C2T[r] = incl[r] ? C2T[r] : 0.f; }
        float tr[16];
        int frv = fr; asm volatile("" : "+v"(frv));
#pragma unroll
        for (int c = 15; c >= 0; --c) { float s = (c == frv) ? 1.f : 0.f;
#pragma unroll
            for (int j = c + 1; j < 16; ++j) { const float ajc = __builtin_bit_cast(float, __builtin_amdgcn_readlane(__builtin_bit_cast(int, AT[c & 3]), j + 16 * (c >> 2))); s = fmaf(-tr[j], ajc, s); }
            tr[c] = s; }
        f32x4 Tq;
#pragma unroll
        for (int jj = 0; jj < 4; ++jj) Tq[jj] = g == 0 ? tr[jj] : (g == 1 ? tr[4 + jj] : (g == 2 ? tr[8 + jj] : tr[12 + jj]));
        const bf16x8 Tf = frag_pack_lo(Tq), Bmf = frag_pack_lo(BmT), Cf = frag_pack(C1T, C2T);
        f32x4 Zt[4], Yt[4];
#pragma unroll
        for (int vt = 0; vt < 4; ++vt) {
            const int v = 16 * vt + fr;
            const bf16x8 s0 = *(const LAS bf16x8*)(SI + v * 144 + 16 * g), s1 = *(const LAS bf16x8*)(SI + v * 144 + 64 + 16 * g);
            f32x4 rhs = __builtin_amdgcn_mfma_f32_16x16x32_bf16(kap[0], s0, Z4, 0, 0, 0); rhs = __builtin_amdgcn_mfma_f32_16x16x32_bf16(kap[1], s1, rhs, 0, 0, 0);
            if (MODE != 1) rhs = __builtin_amdgcn_mfma_f32_16x16x32_bf16(Bmf, frag_lo_raw(VT[vt]), rhs, 0, 0, 0);
            f32x4 z = __builtin_amdgcn_mfma_f32_16x16x32_bf16(Tf, frag_pack_lo(rhs), Z4, 0, 0, 0);
            Zt[vt] = -z;
            if (MODE == 2) { f32x4 y = __builtin_amdgcn_mfma_f32_16x16x32_bf16(rtl[0], s0, Z4, 0, 0, 0); y = __builtin_amdgcn_mfma_f32_16x16x32_bf16(rtl[1], s1, y, 0, 0, 0);
                Yt[vt] = __builtin_amdgcn_mfma_f32_16x16x32_bf16(Cf, frag_pack_raw(Zt[vt], VT[vt]), y, 0, 0, 0); }
        }
        if (MODE == 2) {
            u32x2 GT[4];
            {
#pragma unroll
                for (int k2 = 0; k2 < 2; ++k2) *(LAS u32x4*)(VI + fr * 128 + 64 * k2 + 16 * g) = gq[k2];
                tr_read4_off<13824, 13824 + 32, 13824 + 64, 13824 + 96>(trb, GT);
            }
#pragma unroll
            for (int r = 0; r < 4; ++r) {
                const float mean = row_sum_f(Yt[0][r] + Yt[1][r] + Yt[2][r] + Yt[3][r]) * (1.0f / 64.0f);
                const float d0 = Yt[0][r] - mean, d1 = Yt[1][r] - mean, d2 = Yt[2][r] - mean, d3 = Yt[3][r] - mean;
                const float rstd = rsqrtf(row_sum_f(d0 * d0 + d1 * d1 + d2 * d2 + d3 * d3) * (1.0f / 64.0f) + 64e-5f);
                const float bc = __shfl(bcoef, 4 * g + r); const float dd_[4] = {d0, d1, d2, d3}; const size_t ro = (t0 + 4 * gl_ + r) * 1024 + h * 64 + frl;
#pragma unroll
                for (int vt = 0; vt < 4; ++vt) { const unsigned gw2 = r < 2 ? GT[vt].x : GT[vt].y, vw2 = r < 2 ? VT[vt].x : VT[vt].y; const float gate = (r & 1) ? bfhi(gw2) : bflo(gw2), vval = (r & 1) ? bfhi(vw2) : bflo(vw2);
                    yo[ro + 16 * vt] = (bf16_t)f2bf((dd_[vt] * rstd * in19[h * 64 + 16 * vt + frl] + in20[h * 64 + 16 * vt + frl] + bc * vval) * gate); }
            }
        }
        {
            u32x2 db[4], dk[4], dd[8];
            tr_read4_off<9216, 9216 + 32, 9216 + 64, 9216 + 96>(trb, db); tr_read4_off<11264, 11264 + 32, 11264 + 64, 11264 + 96>(trb, dk);
#pragma unroll
            for (int kt = 0; kt < 4; ++kt) { dd[2 * kt] = db[kt]; dd[2 * kt + 1] = dk[kt]; }
            f32x4 gl[4];
#pragma unroll
            for (int kt = 0; kt < 4; ++kt) gl[kt] = *(const LAS f32x4*)(CL + 16 * kt + 4 * g);
#pragma unroll
            for (int vt = 0; vt < 4; ++vt) { const bf16x8 Af = frag_pack_raw(Zt[vt], VT[vt]);
#pragma unroll
                for (int kt = 0; kt < 4; ++kt) { u32x4 bw; bw.x = dd[2 * kt].x; bw.y = dd[2 * kt].y; bw.z = dd[2 * kt + 1].x; bw.w = dd[2 * kt + 1].y;
                    S[vt][kt] = __builtin_amdgcn_mfma_f32_16x16x32_bf16(__builtin_bit_cast(bf16x8, bw), Af, S[vt][kt], 0, 0, 0) * gl[kt]; } }
        }
    }
    if (MODE != 2) { float* dst = PQ + ((size_t)((bh * RCH + ch) * 2 + MODE)) * 4096 + fr * 64 + 4 * g;
#pragma unroll
        for (int vt = 0; vt < 4; ++vt)
#pragma unroll
            for (int kt = 0; kt < 4; ++kt) *(f32x4*)(dst + vt * 1024 + 16 * kt) = S[vt][kt]; }
}
__device__ __forceinline__ void p4_rwkv_pass1(const Ctx& C) {
    for (int task = C.gw; task < 32 * (RCH - 1) * 2; task += C.ngw) { const int mode = task & 1, rr = task >> 1, ch = rr % (RCH - 1), bh = rr / (RCH - 1);
        if (mode == 0) rwm_task<0>(C, bh, ch); else rwm_task<1>(C, bh, ch); }
}
__device__ __forceinline__ void p6_rwkv_pass3(const Ctx& C) {
    for (int task = (int)blockIdx.x + C.G * C.wave; task < 32 * RCH; task += C.G * NWAVES) rwm_task<2>(C, task / RCH, task % RCH);
}
__device__ __forceinline__ void p5_rwkv_carry(const Ctx& C) {
    float* PQ = (float*)(C.dout + DO_PQ); const int lane = C.lane, wave = C.wave, tid = C.tid;
    LAS float* ST = (LAS float*)C.lds;
    LAS float* PL = (LAS float*)(C.lds + 32768);
    for (int bh = blockIdx.x; bh < 32; bh += C.G) {
        for (int i = tid; i < 4096; i += NTHREADS) ST[i] = 0.f;
        const float* base = PQ + (size_t)(bh * RCH) * 2 * 4096;
        f32x4 pa = *(const f32x4*)(base + 4096 + tid * 8), pb = *(const f32x4*)(base + 4096 + tid * 8 + 4);
        f32x4 q0 = *(const f32x4*)(base + lane * 64 + 8 * wave), q1 = *(const f32x4*)(base + lane * 64 + 8 * wave + 4);
        __syncthreads();
        for (int ch = 0; ch < RCH - 1; ++ch) {
            LAS float* cur = ST + (ch & 1) * 4096; LAS float* nxt = ST + ((ch + 1) & 1) * 4096;
            float* Q = PQ + ((size_t)((bh * RCH + ch) * 2)) * 4096;
            *(LAS f32x4*)(PL + tid * 8) = pa; *(LAS f32x4*)(PL + tid * 8 + 4) = pb;
            float acc[8] = {q0.x, q0.y, q0.z, q0.w, q1.x, q1.y, q1.z, q1.w};
            __syncthreads();
            const int cn = ch + 1 < RCH - 1 ? ch + 1 : ch; const float* nb = PQ + ((size_t)((bh * RCH + cn) * 2)) * 4096;
            pa = *(const f32x4*)(nb + 4096 + tid * 8); pb = *(const f32x4*)(nb + 4096 + tid * 8 + 4);
            q0 = *(const f32x4*)(nb + lane * 64 + 8 * wave); q1 = *(const f32x4*)(nb + lane * 64 + 8 * wave + 4);
#pragma unroll 8
            for (int j = 0; j < 64; ++j) { const float sj = cur[j * 64 + lane]; const f32x4 p0 = *(const LAS f32x4*)(PL + j * 64 + 8 * wave), p1 = *(const LAS f32x4*)(PL + j * 64 + 8 * wave + 4);
                acc[0] = fmaf(sj, p0.x, acc[0]); acc[1] = fmaf(sj, p0.y, acc[1]); acc[2] = fmaf(sj, p0.z, acc[2]); acc[3] = fmaf(sj, p0.w, acc[3]);
                acc[4] = fmaf(sj, p1.x, acc[4]); acc[5] = fmaf(sj, p1.y, acc[5]); acc[6] = fmaf(sj, p1.z, acc[6]); acc[7] = fmaf(sj, p1.w, acc[7]); }
            *(f32x4*)(Q + lane * 64 + 8 * wave) = (f32x4){acc[0], acc[1], acc[2], acc[3]}; *(f32x4*)(Q + lane * 64 + 8 * wave + 4) = (f32x4){acc[4], acc[5], acc[6], acc[7]};
#pragma unroll
            for (int kk = 0; kk < 8; ++kk) nxt[(8 * wave + kk) * 64 + lane] = acc[kk];
            __syncthreads();
        }
    }
}

__device__ __forceinline__ void p8_ln1(const Ctx& C) {
    const bf16_t* pre = (const bf16_t*)C.dout; bf16_t* x1b = (bf16_t*)(C.ws + WS_X1B); const int lane = C.lane;
    const float* gam = C.in[26]; const float* bet = C.in[27];
    for (int t = C.gw; t < T; t += C.ngw) {
        const bf16_t* p = pre + (size_t)t * 1024 + 16 * lane; float v[16];
        unpack8(*(const u32x4*)p, v); unpack8(*(const u32x4*)(p + 8), v + 8);
        float s = 0.f;
#pragma unroll
        for (int j = 0; j < 16; ++j) s += v[j];
        const float mean = wave_sum(s) * (1.0f / 1024.0f); float s2 = 0.f;
#pragma unroll
        for (int j = 0; j < 16; ++j) { v[j] -= mean; s2 += v[j] * v[j]; }
        const float rstd = rsqrtf(wave_sum(s2) * (1.0f / 1024.0f) + 1e-5f);
        float o[16];
#pragma unroll
        for (int q = 0; q < 4; ++q) { const f32x4 gm = *(const f32x4*)(gam + 16 * lane + 4 * q), bt = *(const f32x4*)(bet + 16 * lane + 4 * q);
            o[4 * q] = v[4 * q] * rstd * gm.x + bt.x; o[4 * q + 1] = v[4 * q + 1] * rstd * gm.y + bt.y; o[4 * q + 2] = v[4 * q + 2] * rstd * gm.z + bt.z; o[4 * q + 3] = v[4 * q + 3] * rstd * gm.w + bt.w; }
        *(u32x4*)(x1b + (size_t)t * 1024 + 16 * lane) = pack8(o); *(u32x4*)(x1b + (size_t)t * 1024 + 16 * lane + 8) = pack8(o + 8);
    }
    cvt_rows_fp8(G_(C.in[30]), C.ws + WS_UB, (size_t)16384 * 1024 / 16, PEER_U_SCALE, C.gt, C.ngt);
    cvt_rows_fp8(G_(C.in[31]), C.ws + WS_VB, (size_t)16384 * 1024 / 16, PEER_V_SCALE, C.gt, C.ngt);
}

#define CE_DESC(a, b) do { const unsigned hi_ = k[a] > k[b] ? k[a] : k[b], lo_ = k[a] > k[b] ? k[b] : k[a]; k[a] = hi_; k[b] = lo_; } while (0)
__device__ __forceinline__ unsigned pop16_of8(unsigned (&k)[8], int fr) {
    CE_DESC(0, 1); CE_DESC(2, 3); CE_DESC(4, 5); CE_DESC(6, 7); CE_DESC(0, 2); CE_DESC(1, 3); CE_DESC(4, 6); CE_DESC(5, 7); CE_DESC(1, 2); CE_DESC(5, 6);
    CE_DESC(0, 4); CE_DESC(1, 5); CE_DESC(2, 6); CE_DESC(3, 7); CE_DESC(2, 4); CE_DESC(3, 5); CE_DESC(1, 2); CE_DESC(3, 4); CE_DESC(5, 6);
    unsigned res = 0u;
#pragma unroll
    for (int rd = 0; rd < 16; ++rd) {
        const unsigned m = row_max_u(k[0]); const bool mine = (k[0] == m);
#pragma unroll
        for (int j = 0; j < 7; ++j) k[j] = mine ? k[j + 1] : k[j];
        k[7] = mine ? 0u : k[7];
        res = (fr == rd) ? m : res;
    }
    return res;
}
__device__ __forceinline__ unsigned pop16_of4(unsigned (&k)[4], int fr) {
    CE_DESC(0, 1); CE_DESC(2, 3); CE_DESC(0, 2); CE_DESC(1, 3); CE_DESC(1, 2);
    unsigned res = 0u;
#pragma unroll
    for (int rd = 0; rd < 16; ++rd) {
        const unsigned m = row_max_u(k[0]); const bool mine = (k[0] == m);
        k[0] = mine ? k[1] : k[0]; k[1] = mine ? k[2] : k[1]; k[2] = mine ? k[3] : k[2]; k[3] = mine ? 0u : k[3];
        res = (fr == rd) ? m : res;
    }
    return res;
}
__device__ const unsigned char CAND_AB[64] = {
    0x00, 0x01, 0x02, 0x03, 0x04, 0x05, 0x06, 0x07, 0x08, 0x09, 0x0a, 0x0b, 0x0c, 0x0d, 0x0e, 0x0f,
    0x10, 0x11, 0x12, 0x13, 0x14, 0x15, 0x16, 0x17, 0x20, 0x21, 0x22, 0x23, 0x24, 0x30, 0x31, 0x32,
    0x33, 0x40, 0x41, 0x42, 0x50, 0x51, 0x60, 0x61, 0x70, 0x71, 0x80, 0x90, 0xa0, 0xb0, 0xc0, 0xd0,
    0xe0, 0xf0, 0xff, 0xff, 0xff, 0xff, 0xff, 0xff, 0xff, 0xff, 0xff, 0xff, 0xff, 0xff, 0xff, 0xff};
__device__ __forceinline__ void p10_peer_route(const Ctx& C) {
    unsigned char* ws = C.ws; const int lane = C.lane, g = lane >> 4, fr = lane & 15;
    const bf16_t* qp = (const bf16_t*)C.dout; const bf16_t* keys = (const bf16_t*)(ws + WS_KEYS);
    int* experts = (int*)(ws + WS_EXPERTS); float* pgates = (float*)(ws + WS_PGATES);
    const unsigned cand4 = *(const unsigned*)(CAND_AB + 4 * fr);
    LAS unsigned char* KL = C.lds;
#pragma unroll
    for (int pp = 0; pp < 8; ++pp) { const int p = C.wave + 8 * pp; const int row = 4 * p + g; const int c = fr ^ (2 * (row & 7));
        __builtin_amdgcn_global_load_lds((const unsigned*)((const char*)keys + row * 256 + 16 * c), (LAS unsigned*)(KL + 1024 * p), 16, 0, 0); }
    asm volatile("s_waitcnt vmcnt(0)" ::: "memory");
    __syncthreads();
    for (int task = C.gw; task < T / 2; task += C.ngw) {
        const int t0 = task * 2;
        unsigned sel[2][4];
#pragma unroll
        for (int p = 0; p < 2; ++p) {
            bf16x8 A[4];
#pragma unroll
            for (int kk = 0; kk < 4; ++kk) A[kk] = *(const bf16x8*)(qp + (size_t)(t0 + (fr >> 3)) * 2048 + (fr & 7) * 256 + p * 128 + 32 * kk + 8 * g);
            f32x4 acc[8];
#pragma unroll
            for (int i = 0; i < 8; ++i) { if ((i & 1) == 0) __builtin_amdgcn_sched_barrier(0); acc[i] = (f32x4){0.f, 0.f, 0.f, 0.f};
#pragma unroll
                for (int kk = 0; kk < 4; ++kk) { const int row = p * 128 + 16 * i + fr; const bf16x8 Bk = *(const LAS bf16x8*)(KL + row * 256 + 16 * ((4 * kk + g) ^ (2 * (row & 7))));
                    acc[i] = __builtin_amdgcn_mfma_f32_16x16x32_bf16(A[kk], Bk, acc[i], 0, 0, 0); } }
#pragma unroll
            for (int r = 0; r < 4; ++r) { __builtin_amdgcn_sched_barrier(0); unsigned k[8];
#pragma unroll
                for (int i = 0; i < 8; ++i) k[i] = (f2key(acc[i][r]) & 0xffffff80u) | (unsigned)(16 * i + fr);
                sel[p][r] = pop16_of8(k, fr); }
        }
#pragma unroll
        for (int r = 0; r < 4; ++r) {
            __builtin_amdgcn_sched_barrier(0);
            const float s1 = key2f(sel[0][r] & 0xffffff80u), s2 = key2f(sel[1][r] & 0xffffff80u);
            unsigned k[4];
#pragma unroll
            for (int j = 0; j < 4; ++j) {
                const unsigned ab = (cand4 >> (8 * j)) & 0xffu; const unsigned msk = ab == 0xffu ? 0u : 0xffffffffu;
                const float va = __builtin_bit_cast(float, __builtin_amdgcn_ds_bpermute((int)(4u * (16u * g + (ab >> 4))), __builtin_bit_cast(int, s1)));
                const float vb = __builtin_bit_cast(float, __builtin_amdgcn_ds_bpermute((int)(4u * (16u * g + (ab & 15u))), __builtin_bit_cast(int, s2)));
                k[j] = ((f2key(va + vb) & 0xffffff00u) | ab) & msk;
            }
            const unsigned top = pop16_of4(k, fr);
            const int a = (int)((top >> 4) & 15u), b = (int)(top & 15u);
            const int i1 = __builtin_amdgcn_ds_bpermute(4 * (16 * g + a), (int)(sel[0][r] & 0x7fu));
            const int i2 = __builtin_amdgcn_ds_bpermute(4 * (16 * g + b), (int)(sel[1][r] & 0x7fu));
            const float sc = key2f(top & 0xffffff00u);
            const float mx = key2f(row_max_u(top) & 0xffffff00u);
            const float ev = __expf(sc - mx); const float sm = row_sum_f(ev);
            const int row = 4 * g + r; const size_t o = (size_t)(t0 + (row >> 3)) * 128 + (row & 7) * 16 + fr;
            experts[o] = i1 * 128 + i2; pgates[o] = ev / sm;
        }
    }
}
#undef CE_DESC

__device__ __forceinline__ float gelu_erf(float x) { return 0.5f * x * (1.0f + erff(x * 0.7071067811865476f)); }
typedef __bf16 bf2_t __attribute__((ext_vector_type(2)));
__device__ __forceinline__ unsigned fp8x2_to_bf16x2(unsigned w, bool hi) { return hi ? __builtin_bit_cast(unsigned, __builtin_amdgcn_cvt_scalef32_pk_bf16_fp8(w, 1.0f, true)) : __builtin_bit_cast(unsigned, __builtin_amdgcn_cvt_scalef32_pk_bf16_fp8(w, 1.0f, false)); }
__device__ __forceinline__ void p11_peer_experts(const Ctx& C) {
    unsigned char* ws = C.ws; const int lane = C.lane, g = lane >> 4, fr = lane & 15;
    const bf16_t* x1b = (const bf16_t*)(ws + WS_X1B);
    const unsigned char* ub = ws + WS_UB; const unsigned char* vb = ws + WS_VB;
    const int* experts = (const int*)(ws + WS_EXPERTS); const float* pgates = (const float*)(ws + WS_PGATES);
    float* out = (float*)C.dout; const float* gam = C.in[32]; const float* bet = C.in[33];
    LAS unsigned char* my = C.lds + C.wave * 4096;
    LAS float* cf = (LAS float*)(my + 2048); LAS int* eidl = (LAS int*)(my + 2560);
    for (int t = C.gw; t < T; t += C.ngw) {
        { const u32x4 a = *(const u32x4*)(x1b + (size_t)t * 1024 + 16 * lane), b = *(const u32x4*)(x1b + (size_t)t * 1024 + 16 * lane + 8);
          *(LAS u32x4*)(my + 32 * lane) = a; *(LAS u32x4*)(my + 32 * lane + 16) = b; }
        { const int e0 = experts[(size_t)t * 128 + lane], e1 = experts[(size_t)t * 128 + 64 + lane]; eidl[lane] = e0; eidl[64 + lane] = e1; }
        asm volatile("s_waitcnt lgkmcnt(0)" ::: "memory");
#pragma unroll 1
        for (int i = 0; i < 8; ++i) {
            const int e = eidl[16 * i + fr]; const unsigned char* urow = ub + (size_t)e * 1024 + 16 * g;
            f32x4 acc = (f32x4){0.f, 0.f, 0.f, 0.f};
#pragma unroll 4
            for (int m = 0; m < 16; ++m) {
                const u32x4 raw = *(const u32x4*)(urow + 64 * m);
                u32x4 a0, a1; a0.x = fp8x2_to_bf16x2(raw.x, false); a0.y = fp8x2_to_bf16x2(raw.x, true); a0.z = fp8x2_to_bf16x2(raw.y, false); a0.w = fp8x2_to_bf16x2(raw.y, true);
                a1.x = fp8x2_to_bf16x2(raw.z, false); a1.y = fp8x2_to_bf16x2(raw.z, true); a1.z = fp8x2_to_bf16x2(raw.w, false); a1.w = fp8x2_to_bf16x2(raw.w, true);
                const bf16x8 b0 = *(const LAS bf16x8*)(my + 2 * (64 * m + 16 * g)), b1 = *(const LAS bf16x8*)(my + 2 * (64 * m + 16 * g + 8));
                acc = __builtin_amdgcn_mfma_f32_16x16x32_bf16(__builtin_bit_cast(bf16x8, a0), b0, acc, 0, 0, 0);
                acc = __builtin_amdgcn_mfma_f32_16x16x32_bf16(__builtin_bit_cast(bf16x8, a1), b1, acc, 0, 0, 0);
            }
            const f32x4 pg = *(const f32x4*)(pgates + (size_t)t * 128 + 16 * i + 4 * g);
            constexpr float us = 1.0f / PEER_U_SCALE, vs = 1.0f / PEER_V_SCALE;
            if (fr == 0) { *(LAS f32x4*)(cf + 16 * i + 4 * g) = (f32x4){vs * pg.x * gelu_erf(acc[0] * us), vs * pg.y * gelu_erf(acc[1] * us), vs * pg.z * gelu_erf(acc[2] * us), vs * pg.w * gelu_erf(acc[3] * us)}; }
        }
        asm volatile("s_waitcnt lgkmcnt(0)" ::: "memory");
        float o[16];
#pragma unroll
        for (int j = 0; j < 16; ++j) o[j] = 0.f;
#pragma unroll 8
        for (int k = 0; k < 128; ++k) {
            const int e = __builtin_amdgcn_readfirstlane(eidl[k]); const float c = cf[k];
            const u32x4 raw = *(const u32x4*)(vb + (size_t)e * 1024 + 16 * lane);
            const unsigned rw[4] = {raw.x, raw.y, raw.z, raw.w};
#pragma unroll
            for (int j = 0; j < 4; ++j) { const f32x2 lo = __builtin_amdgcn_cvt_pk_f32_fp8((int)rw[j], false), hi = __builtin_amdgcn_cvt_pk_f32_fp8((int)rw[j], true);
                o[4 * j] = fmaf(c, lo.x, o[4 * j]); o[4 * j + 1] = fmaf(c, lo.y, o[4 * j + 1]); o[4 * j + 2] = fmaf(c, hi.x, o[4 * j + 2]); o[4 * j + 3] = fmaf(c, hi.y, o[4 * j + 3]); }
        }
        float s = 0.f;
        { float xr[16]; unpack8(*(const u32x4*)(x1b + (size_t)t * 1024 + 16 * lane), xr); unpack8(*(const u32x4*)(x1b + (size_t)t * 1024 + 16 * lane + 8), xr + 8);
#pragma unroll
          for (int j = 0; j < 16; ++j) o[j] += ALPHA * xr[j]; }
#pragma unroll
        for (int j = 0; j < 16; ++j) s += o[j];
        const float mean = wave_sum(s) * (1.0f / 1024.0f); float s2 = 0.f;
#pragma unroll
        for (int j = 0; j < 16; ++j) { o[j] -= mean; s2 += o[j] * o[j]; }
        const float rstd = rsqrtf(wave_sum(s2) * (1.0f / 1024.0f) + 1e-5f);
#pragma unroll
        for (int q = 0; q < 4; ++q) { const int c0 = 16 * lane + 4 * q; const f32x4 gm = *(const f32x4*)(gam + c0), bt = *(const f32x4*)(bet + c0);
            *(f32x4*)(out + (size_t)t * 1024 + c0) = (f32x4){o[4 * q] * rstd * gm.x + bt.x, o[4 * q + 1] * rstd * gm.y + bt.y, o[4 * q + 2] * rstd * gm.z + bt.z, o[4 * q + 3] * rstd * gm.w + bt.w}; }
    }
}

constexpr int LDS_BYTES = 147456;
constexpr int LDS_MISC = 131072 + 256;
constexpr int NPHASE = 14;
constexpr int CW_BAR = 4096;

__global__ void __launch_bounds__(NTHREADS, 2) hybrid_fwd(Args args) {
    extern __shared__ __attribute__((aligned(16))) unsigned char lds_raw[];
    Ctx C;
    C.lds = (LAS unsigned char*)lds_raw;
    C.tid = threadIdx.x; C.lane = C.tid & 63; C.wave = __builtin_amdgcn_readfirstlane(C.tid >> 6);
    C.G = gridDim.x; C.gw = blockIdx.x * NWAVES + C.wave; C.ngw = C.G * NWAVES; C.gt = blockIdx.x * NTHREADS + C.tid; C.ngt = C.G * NTHREADS;
    C.in = args.in; C.ws = args.ws; C.dout = (unsigned char*)args.out;
    unsigned char* ws = args.ws; const float* const* in = args.in;
    volatile LAS unsigned* MISC = (volatile LAS unsigned*)(C.lds + LDS_MISC);
    if (C.tid < 64) MISC[C.tid] = 0u;
    __syncthreads();
    XcdBarrier bar; bar.bar = (unsigned*)(ws + WS_CTL) + CW_BAR; bar.x = 0; bar.st = nullptr;
    if (MK_N_LAUNCHES == 1) bar = xcd_barrier_post((unsigned*)(ws + WS_CTL) + CW_BAR, MISC + 8);
    const int lo = args.ph_lo, hi = args.ph_hi;
#define IN(k) (lo <= (k) && (k) < hi)
#define SEAM(k) do { if (IN(k) && IN((k) + 1)) xcd_barrier(bar); } while (0)
#define REP(k) for (int rep_ = 0; rep_ < (((PROBE_MASK >> (k)) & 1) ? 2 : 1); ++rep_)
    bf16_t* xb = (bf16_t*)(C.dout + DO_XB);

    if (IN(0)) REP(0) { p0_prologue(C); } SEAM(0);
    if (IN(1)) REP(1) {
        { pg8::Gemm gm{xb, (const bf16_t*)(ws + WS_WIN), T, 2816, 1024}; pg8::StaticOrder S; S.init(T, 2816, C.G, (int)blockIdx.x);
          EpiP1 E{(float*)(ws + WS_CSMALL), (bf16_t*)(ws + WS_RCOLS), (bf16_t*)(ws + WS_MEMQ)}; pg8::gemm_phase(C.lds, gm, S, E); }
        {
          const int nfull = (T / 256) * 11 % C.G; const int c2 = ((int)blockIdx.x - nfull + C.G) % C.G;
          pg8::Gemm gm{(const bf16_t*)(ws + WS_MEMB), (const bf16_t*)(ws + WS_WMEMKV), 1024, 1024, 1024}; pg8::StaticOrder S; S.init(1024, 1024, C.G, c2);
          EpiMemKV E{(bf16_t*)(ws + WS_KMEM), (bf16_t*)(ws + WS_VMEMT)}; pg8::gemm_phase(C.lds, gm, S, E); }
    } SEAM(1);
    if (IN(2)) REP(2) { p2_prep(C); } SEAM(2);
    if (IN(3)) REP(3) {
        { pg8::Gemm gm{(const bf16_t*)(ws + WS_LORAA), (const bf16_t*)(ws + WS_WLORA), T, 1536, 256}; pg8::StaticOrder S; S.init(T, 1536, C.G, (int)blockIdx.x);
          EpiLora E{(bf16_t*)(ws + WS_RW_E), (bf16_t*)(ws + WS_RW_A), (bf16_t*)(ws + WS_RW_G), in[11], in[13]}; pg8::gemm_phase(C.lds, gm, S, E); }
        { pg8::Gemm gm{(const bf16_t*)(ws + WS_CQN), (const bf16_t*)(ws + WS_WQ), T, 1280, 256}; pg8::StaticOrder S; S.init(T, 1280, C.G, C.G - 1 - (int)blockIdx.x);
          EpiQ E{(bf16_t*)(ws + WS_QLAT), (bf16_t*)(ws + WS_QIDX)}; pg8::gemm_phase(C.lds, gm, S, E); }
    } SEAM(3);
    if (IN(4)) { REP(14) { p4_indexer(C); } REP(15) { p4_memattn(C); } __syncthreads(); REP(16) { p4_rwkv_pass1(C); } } SEAM(4);
    if (IN(5)) { p5_rwkv_carry(C); __syncthreads(); REP(5) { p5_dsa_attn(C, rep_); } } SEAM(5);
    if (IN(6)) REP(6) { p6_rwkv_pass3(C); p6_late_weights(C); } SEAM(6);
    if (IN(7)) REP(7) {
        pg8::Gemm gm{xb, (const bf16_t*)(ws + WS_WG), T, 3072, 1024}; pg8::StaticOrder S; S.init(T, 3072, C.G, (int)blockIdx.x);
        EpiGates E{(bf16_t*)(ws + WS_GATES)}; pg8::gemm_phase(C.lds, gm, S, E);
    } SEAM(7);
    if (IN(8)) REP(8) {
        pg8::GemmM gm{(const bf16_t*)(ws + WS_OLAT), (const bf16_t*)(ws + WS_YM), (const bf16_t*)(ws + WS_WOV), T, 1024}; pg8::StaticOrder S; S.init(T, 1024, C.G, (int)blockIdx.x);
        MergeHook H{(const bf16_t*)(ws + WS_GATES), (bf16_t*)(ws + WS_MERGEDB)}; pg8::gemm_phase_merge(C.lds, gm, S, H);
    } SEAM(8);
    if (IN(9)) REP(9) {
        pg8::Gemm gm{(const bf16_t*)(ws + WS_MERGEDB), (const bf16_t*)(ws + WS_WOUT), T, 1024, 1024}; pg8::StaticOrder S; S.init(T, 1024, C.G, (int)blockIdx.x);
        EpiWout E{G_(in[0]), (bf16_t*)C.dout}; pg8::gemm_phase(C.lds, gm, S, E);
    } SEAM(9);
    if (IN(10)) REP(10) { p8_ln1(C); } SEAM(10);
    if (IN(11)) REP(11) {
        pg8::Gemm gm{(const bf16_t*)(ws + WS_X1B), (const bf16_t*)(ws + WS_WPEER), T, 2048, 1024}; pg8::StaticOrder S; S.init(T, 2048, C.G, (int)blockIdx.x);
        EpiPeerQ E{(bf16_t*)C.dout}; pg8::gemm_phase(C.lds, gm, S, E);
    } SEAM(11);
    if (IN(12)) REP(12) { p10_peer_route(C); } SEAM(12);
    if (IN(13)) REP(13) { p11_peer_experts(C); }
#undef IN
#undef SEAM
}

extern "C" void kernel_launch(void* const* d_in, const int* in_sizes, int n_in, void* d_out, int out_size, void* d_ws, size_t ws_size, hipStream_t stream) {
    static int grid = 0;
    if (grid == 0) {
        if (n_in != 34 || out_size != T * D || ws_size < WS_END) { fprintf(stderr, "kernel_launch: unexpected problem (n_in %d out %d ws %zu)\n", n_in, out_size, ws_size); grid = -1; return; }
        int dev = 0, cus = 0, per_cu = 0;
        if (hipGetDevice(&dev) != hipSuccess || hipDeviceGetAttribute(&cus, hipDeviceAttributeMultiprocessorCount, dev) != hipSuccess) { grid = -1; return; }
        if (hipFuncSetAttribute((const void*)hybrid_fwd, hipFuncAttributeMaxDynamicSharedMemorySize, LDS_BYTES) != hipSuccess) { fprintf(stderr, "kernel_launch: hipFuncSetAttribute failed\n"); grid = -1; return; }
        if (hipOccupancyMaxActiveBlocksPerMultiprocessor(&per_cu, (const void*)hybrid_fwd, NTHREADS, LDS_BYTES) != hipSuccess || per_cu < 1) { fprintf(stderr, "kernel_launch: occupancy query says %d\n", per_cu); }
        (void)hipGetLastError();
        grid = cus;
    }
    if (grid < 0) return;
    (void)hipMemsetAsync((char*)d_ws + WS_CTL, 0, 1 * MiB, stream);
    Args a{};
    for (int i = 0; i < 34; ++i) a.in[i] = (const float*)d_in[i];
    a.out = (float*)d_out; a.ws = (unsigned char*)d_ws; a.li = 0; a.pad = 0;
    if (MK_N_LAUNCHES == 1) { a.ph_lo = 0; a.ph_hi = NPHASE; hipLaunchKernelGGL(hybrid_fwd, dim3(grid), dim3(NTHREADS), LDS_BYTES, stream, a); }
    else for (int p = 0; p < NPHASE; ++p) { a.ph_lo = p; a.ph_hi = p + 1; a.li = p; hipLaunchKernelGGL(hybrid_fwd, dim3(grid), dim3(NTHREADS), LDS_BYTES, stream, a); }
}
```

```cpp
#include <hip/hip_runtime.h>
#include <stdint.h>
#include <stdio.h>

#ifndef MK_N_LAUNCHES
#define MK_N_LAUNCHES 1
#endif

#ifndef PROBE_MASK
#define PROBE_MASK 0
#endif
#define LAS __attribute__((address_space(3)))
typedef unsigned short bf16_t;
typedef const __attribute__((address_space(1))) float* gfp;
#define G_(p) ((gfp)(p))
typedef short bf16x8 __attribute__((ext_vector_type(8)));
typedef float f32x4 __attribute__((ext_vector_type(4)));
typedef float f32x2 __attribute__((ext_vector_type(2)));
typedef unsigned u32x4 __attribute__((ext_vector_type(4)));
typedef unsigned u32x2 __attribute__((ext_vector_type(2)));

constexpr int NB = 4, SEQ = 4096, T = NB * SEQ, D = 1024;
constexpr int IN_W = 5800;
constexpr int RW = 512;
constexpr int NWAVES = 8, NTHREADS = 512;
constexpr float ALPHA = 1.189207115002721f;
constexpr int RCH = 32, RL = SEQ / RCH;

constexpr size_t MiB = 1u << 20;
constexpr size_t WS_CTL = 0;
constexpr size_t WS_WIN = 1 * MiB, WS_WG = 7 * MiB, WS_WLORA = 13 * MiB, WS_WQ = 14 * MiB, WS_WMEMKV = 15 * MiB, WS_WOV = 17 * MiB,
                 WS_WBRR = 19 * MiB, WS_WBRM = 20 * MiB, WS_WOUT = 21 * MiB, WS_WPEER = 23 * MiB, WS_KEYS = 27 * MiB;
constexpr size_t WS_CSMALL = 29 * MiB, WS_QLAT = 29 * MiB, WS_MERGEDB = 29 * MiB, WS_UB = 29 * MiB;
constexpr size_t WS_RCOLS = 61 * MiB, WS_QIDX = 61 * MiB, WS_YM = 69 * MiB, WS_OLAT = 101 * MiB, WS_VB = 45 * MiB, WS_EXPERTS = 93 * MiB, WS_PGATES = 101 * MiB;
constexpr size_t WS_MEMQ = 117 * MiB;
constexpr size_t WS_RW_R = 133 * MiB, WS_RW_K = 149 * MiB, WS_RW_V = 165 * MiB, WS_RW_A = 181 * MiB, WS_RW_E = 197 * MiB, WS_RW_G = 213 * MiB;
constexpr size_t WS_GATES = 133 * MiB, WS_X1B = 133 * MiB, WS_X1 = 165 * MiB;
constexpr size_t WS_CQN = 229 * MiB, WS_KVL = 237 * MiB, WS_KIDX = 241 * MiB, WS_WIDX = 242 * MiB, WS_LORAA = 243 * MiB, WS_IDX = 243 * MiB,
                 WS_KMEM = 251 * MiB, WS_VMEMT = 252 * MiB, WS_MEMB = 253 * MiB, WS_END = 256 * MiB;
constexpr size_t DO_XB = 0, DO_PQ = 32 * MiB;
constexpr size_t WS_XB2 = 29 * MiB;
constexpr int CW_DSAQ = 64;

typedef __bf16 bf2_hw __attribute__((ext_vector_type(2)));
__device__ __forceinline__ unsigned f2bf(float f) { return (unsigned)__builtin_bit_cast(unsigned short, (__bf16)f); }
__device__ __forceinline__ unsigned pk2(float lo, float hi) { bf2_hw r; r.x = (__bf16)lo; r.y = (__bf16)hi; return __builtin_bit_cast(unsigned, r); }
__device__ __forceinline__ float bflo(unsigned w) { return __uint_as_float(w << 16); }
__device__ __forceinline__ float bfhi(unsigned w) { return __uint_as_float(w & 0xffff0000u); }
__device__ __forceinline__ float bf1(bf16_t h) { return __uint_as_float(((unsigned)h) << 16); }
template <int CTRL, int RM = 0xF> __device__ __forceinline__ float dpp_f(float v) { return __builtin_bit_cast(float, __builtin_amdgcn_update_dpp(0, __builtin_bit_cast(int, v), CTRL, RM, 0xF, false)); }
template <int CTRL> __device__ __forceinline__ unsigned dpp_u(unsigned v) { return (unsigned)__builtin_amdgcn_update_dpp(0, (int)v, CTRL, 0xF, 0xF, false); }
__device__ __forceinline__ float wave_sum(float v) {
    v += dpp_f<0x111>(v); v += dpp_f<0x112>(v); v += dpp_f<0x114>(v); v += dpp_f<0x118>(v);
    v += dpp_f<0x142, 0xA>(v); v += dpp_f<0x143, 0xC>(v);
    return __builtin_bit_cast(float, __builtin_amdgcn_readlane(__builtin_bit_cast(int, v), 63));
}
__device__ __forceinline__ unsigned row_max_u(unsigned x) {
    unsigned y = dpp_u<0x128>(x); x = x > y ? x : y; y = dpp_u<0x124>(x); x = x > y ? x : y; y = dpp_u<0x122>(x); x = x > y ? x : y; y = dpp_u<0x121>(x); x = x > y ? x : y; return x; }
__device__ __forceinline__ float row_sum_f(float x) { x += dpp_f<0x128>(x); x += dpp_f<0x124>(x); x += dpp_f<0x122>(x); x += dpp_f<0x121>(x); return x; }
__device__ __forceinline__ float key2f(unsigned k) { const unsigned b = (k & 0x80000000u) ? (k & 0x7fffffffu) : ~k; return __uint_as_float(b); }
__device__ __forceinline__ float sigmoidf_(float x) { return 1.0f / (1.0f + __expf(-x)); }
__device__ __forceinline__ unsigned f2key(float f) { unsigned b = __float_as_uint(f); if (f == 0.0f) b = 0u; return (b & 0x80000000u) ? ~b : (b | 0x80000000u); }
__device__ __forceinline__ u32x4 pack8(const float* v) { u32x4 w; w.x = pk2(v[0], v[1]); w.y = pk2(v[2], v[3]); w.z = pk2(v[4], v[5]); w.w = pk2(v[6], v[7]); return w; }
__device__ __forceinline__ void unpack8(u32x4 w, float* v) { v[0] = bflo(w.x); v[1] = bfhi(w.x); v[2] = bflo(w.y); v[3] = bfhi(w.y); v[4] = bflo(w.z); v[5] = bfhi(w.z); v[6] = bflo(w.w); v[7] = bfhi(w.w); }

#define XB_TMO      128
#define XB_XCNT(j)  (256  + 64 * (j))
#define XB_XSUB(j)  (1280 + 64 * (j))
#define XB_XGEN(j)  (2304 + 64 * (j))
#define XB_TOP      3328
#define XB_TOPGEN   3392
#define XCD_BAR_WORDS 3456
#define XB_SPIN_CAP (1u << 18)

__device__ __forceinline__ unsigned xb_ld(unsigned* p)              { return __hip_atomic_load(p, __ATOMIC_RELAXED, __HIP_MEMORY_SCOPE_AGENT); }
__device__ __forceinline__ unsigned xb_add(unsigned* p, unsigned v) { return __hip_atomic_fetch_add(p, v, __ATOMIC_RELAXED, __HIP_MEMORY_SCOPE_AGENT); }
__device__ __forceinline__ unsigned xb_xcc_id() { return (unsigned)__builtin_amdgcn_s_getreg((3 << 11) | 20) & 0xFu; }
#define XB_SPIN(cond, bar) do { unsigned _sp = 0; while (cond) { __builtin_amdgcn_s_sleep(1); \
    if ((++_sp & 255u) == 0u) { if (xb_ld(&(bar)[XB_TMO])) break; if (_sp > XB_SPIN_CAP) { atomicAdd(&(bar)[XB_TMO], 1u); break; } } } } while (0)

struct XcdBarrier {
    unsigned* bar; unsigned x;
    volatile LAS unsigned* st;
};
__device__ __forceinline__ XcdBarrier xcd_barrier_post(unsigned* bar, volatile LAS unsigned* st) {
    XcdBarrier b; b.bar = bar; b.x = xb_xcc_id(); b.st = st;
    if (threadIdx.x == 0) (void)xb_add(&bar[XB_XCNT(b.x)], 1u);
    return b;
}
__device__ __forceinline__ void xcd_barrier_complete(unsigned* bar, unsigned x, unsigned& nloc, unsigned& nx) {
    const unsigned G = gridDim.x * gridDim.y * gridDim.z;
    unsigned sum, cnt, mine, sp = 0u;
    for (;;) {
        sum = 0u; cnt = 0u; mine = 0u;
#pragma unroll
        for (unsigned j = 0; j < 16; ++j) { const unsigned c = xb_ld(&bar[XB_XCNT(j)]); sum += c; cnt += (c > 0u) ? 1u : 0u; mine = (j == x) ? c : mine; }
        if (sum == G) break;
        __builtin_amdgcn_s_sleep(1);
        if ((++sp & 255u) == 0u) { if (xb_ld(&bar[XB_TMO])) break; if (sp > XB_SPIN_CAP) { atomicAdd(&bar[XB_TMO], 1u); break; } }
    }
    nloc = mine > 0u ? mine : 1u; nx = cnt > 0u ? cnt : 1u;
}
__device__ __forceinline__ void xcd_barrier(const XcdBarrier& b) {
    asm volatile("s_waitcnt vmcnt(0)" ::: "memory");
    __syncthreads();
    if (threadIdx.x == 0) {
        unsigned* bar = b.bar;
        __builtin_amdgcn_s_waitcnt(0);
        unsigned nloc = b.st[0], nx = b.st[1];
        if (nloc == 0u) { xcd_barrier_complete(bar, b.x, nloc, nx); b.st[0] = nloc; b.st[1] = nx; }
        const unsigned old = xb_add(&bar[XB_XSUB(b.x)], 1u);
        const unsigned gen = old / nloc;
        if (old + 1u == (gen + 1u) * nloc) {
            __builtin_amdgcn_fence(__ATOMIC_RELEASE, "agent");
            asm volatile("s_waitcnt vmcnt(0)" ::: "memory");
            const unsigned og = xb_add(&bar[XB_TOP], 1u);
            const unsigned tg = og / nx;
            if (og + 1u == (tg + 1u) * nx) xb_add(&bar[XB_TOPGEN], 1u);
            else XB_SPIN(xb_ld(&bar[XB_TOPGEN]) == tg, bar);
            __builtin_amdgcn_fence(__ATOMIC_ACQUIRE, "agent");
            xb_add(&bar[XB_XGEN(b.x)], 1u);
            asm volatile("s_waitcnt vmcnt(0)" ::: "memory");
        } else {
            XB_SPIN(xb_ld(&bar[XB_XGEN(b.x)]) == gen, bar);
            __builtin_amdgcn_fence(__ATOMIC_ACQUIRE, "agent");
            asm volatile("s_waitcnt vmcnt(0)" ::: "memory");
        }
    }
    __syncthreads();
}

namespace pg8 {
constexpr int BM = 256, BK = 64, HALF = 128, HTB = HALF * BK * 2, STAGE_BYTES = 8 * HTB, NXCD = 8, WGM = 8;
__device__ __forceinline__ int lds_byte(int r, int c) { const int st = (r >> 4) * 2 + (c >> 5), rr = r & 15, cc = c & 31, ob = rr * 64 + cc * 2; return st * 1024 + (ob ^ (((ob >> 9) & 1) << 5)); }
__device__ __forceinline__ void stage_rc(int b, int& R, int& C) { const int st = b / 1024, sb = b % 1024, swz = sb ^ (((sb >> 9) & 1) << 5); R = (st >> 1) * 16 + swz / 64; C = (st & 1) * 32 + (swz % 64) / 2; }
__device__ __forceinline__ int perm32(int rho) { const int n = rho >> 4, i = rho & 15; return 8 * (i >> 2) + 4 * n + (i & 3); }
struct Unit { int pm, pn; };
struct Gemm { const bf16_t* A; const bf16_t* Bt; int M, N, K; };
struct StaticOrder {
    int nM, nN, nwg, G, c;
    __device__ void init(int M, int N, int G_, int c_) { nM = M / BM; nN = N / BM; nwg = nM * nN; G = G_; c = c_; }
    __device__ bool next(int i, Unit& u) const {
        const long L = (long)i * G + c; if (L >= nwg) return false;
        int wgid = (int)L; { const int q = nwg / NXCD, r = nwg % NXCD, xcd = wgid % NXCD, off = wgid / NXCD; wgid = (xcd < r ? xcd * (q + 1) : r * (q + 1) + (xcd - r) * q) + off; }
        const int nig = WGM * nN, gid = wgid / nig, fm = gid * WGM, gsz = (nM - fm) < WGM ? (nM - fm) : WGM;
        u.pm = fm + ((wgid % nig) % gsz); u.pn = (wgid % nig) / gsz; return true;
    }
};
template <class Epi>
__device__ __forceinline__ void gemm_phase(LAS unsigned char* lds, const Gemm g, const StaticOrder& S, const Epi& E) {
    const int tid = threadIdx.x, wid = __builtin_amdgcn_readfirstlane(tid >> 6), lane = tid & 63, wr = wid >> 2, wc = wid & 3, fr = lane & 15, fq = lane >> 4;
    const int K = g.K, nt = K / BK;
    unsigned voffA[2], voffB[2];
#pragma unroll
    for (int i = 0; i < 2; ++i) { int R, C; stage_rc(tid * 16 + i * 8192, R, C); const int Rb = (R & ~31) + perm32(R & 31);
        voffA[i] = (unsigned)(R * K + C) * 2u; voffB[i] = (unsigned)(Rb * K + C) * 2u; }
    const size_t kstep = (size_t)(BK * 2);
    const size_t hstep = (size_t)HALF * K * 2;
    const size_t tstep = 2 * hstep;
    const unsigned ldsw = (unsigned)wid * 1024u;
    const int aoff = lds_byte(wr * 64 + fr, fq * 8), boff = lds_byte(wc * 32 + fr, fq * 8);
#define PG8_SA(b, h) (((b) * 2 + (h)) * HTB)
#define PG8_SB(b, h) ((4 + (b) * 2 + (h)) * HTB)
#define PG8_STAGE(bufoff, gbase, voff) do { _Pragma("unroll") for (int _i = 0; _i < 2; ++_i) \
        __builtin_amdgcn_global_load_lds((const unsigned*)((const char*)(gbase) + (voff)[_i]), (LAS unsigned*)(lds + (bufoff) + ldsw + _i * 8192), 16, 0, 0); } while (0)
#define PG8_LDA(dst, b, h) do { _Pragma("unroll") for (int m = 0; m < 4; ++m) _Pragma("unroll") for (int k = 0; k < 2; ++k) dst[m][k] = *(const LAS bf16x8*)(lds + PG8_SA(b, h) + aoff + m * 2048 + k * 1024); } while (0)
#define PG8_LDB(dst, b, h) do { _Pragma("unroll") for (int n = 0; n < 2; ++n) _Pragma("unroll") for (int k = 0; k < 2; ++k) dst[n][k] = *(const LAS bf16x8*)(lds + PG8_SB(b, h) + boff + n * 2048 + k * 1024); } while (0)
#define PG8_MMA(ai, bj, At, Bt) do { __builtin_amdgcn_s_setprio(1); _Pragma("unroll") for (int m = 0; m < 4; ++m) _Pragma("unroll") for (int n = 0; n < 2; ++n) _Pragma("unroll") for (int k = 0; k < 2; ++k) \
        acc[ai][bj][m][n] = __builtin_amdgcn_mfma_f32_16x16x32_bf16(Bt[n][k], At[m][k], acc[ai][bj][m][n], 0, 0, 0); __builtin_amdgcn_s_setprio(0); } while (0)
#define PG8_WAIT_V(n) asm volatile("s_waitcnt vmcnt(" #n ")" ::: "memory")
#define PG8_WAIT_L(n) asm volatile("s_waitcnt lgkmcnt(" #n ")" ::: "memory")
#define PG8_BAR __builtin_amdgcn_s_barrier()
#define PG8_SCHED __builtin_amdgcn_sched_barrier(0)
    Unit cur, nxt; int ui = 0;
    if (!S.next(0, cur)) return;
    f32x4 acc[2][2][4][2];
#pragma unroll
    for (int a = 0; a < 2; ++a)
#pragma unroll
        for (int b = 0; b < 2; ++b)
#pragma unroll
            for (int m = 0; m < 4; ++m)
#pragma unroll
                for (int n = 0; n < 2; ++n) acc[a][b][m][n] = (f32x4){0.f, 0.f, 0.f, 0.f};
    bf16x8 At[4][2], B0[2][2], B1[2][2];
    const char* cA = (const char*)g.A + (size_t)cur.pm * tstep; const char* cB = (const char*)g.Bt + (size_t)cur.pn * tstep;
    PG8_STAGE(PG8_SB(0, 0), cB, voffB); PG8_STAGE(PG8_SA(0, 0), cA, voffA); PG8_STAGE(PG8_SB(0, 1), cB + hstep, voffB); PG8_STAGE(PG8_SA(0, 1), cA + hstep, voffA);
    if (wr == 1) PG8_BAR;
    PG8_WAIT_V(4); PG8_BAR;
    PG8_STAGE(PG8_SB(1, 0), cB + kstep, voffB); PG8_STAGE(PG8_SA(1, 0), cA + kstep, voffA); PG8_STAGE(PG8_SB(1, 1), cB + hstep + kstep, voffB);
    PG8_WAIT_V(6); PG8_BAR;
    for (;;) {
        const bool has_next = S.next(ui + 1, nxt);
        const char* nA = has_next ? (const char*)g.A + (size_t)nxt.pm * tstep : cA; const char* nB = has_next ? (const char*)g.Bt + (size_t)nxt.pn * tstep : cB;
#pragma unroll 1
        for (int t = 0; t < nt; t += 2) {
            const bool last = (t == nt - 2);
            const char* a1 = cA + (size_t)(t + 1) * kstep;
            const char* a2 = last ? nA : cA + (size_t)(t + 2) * kstep; const char* b2 = last ? nB : cB + (size_t)(t + 2) * kstep;
            const char* a3 = a2 + kstep; const char* b3 = b2 + kstep;
            PG8_LDB(B0, 0, 0); PG8_SCHED; PG8_LDA(At, 0, 0); PG8_STAGE(PG8_SA(1, 1), a1 + hstep, voffA);
            PG8_WAIT_L(8); PG8_BAR; PG8_WAIT_L(0); PG8_MMA(0, 0, At, B0); PG8_BAR; PG8_SCHED;
            PG8_LDB(B1, 0, 1); PG8_STAGE(PG8_SB(0, 0), b2, voffB);
            PG8_BAR; PG8_WAIT_L(0); PG8_MMA(0, 1, At, B1); PG8_BAR;
            PG8_LDA(At, 0, 1); PG8_STAGE(PG8_SA(0, 0), a2, voffA);
            PG8_BAR; PG8_WAIT_L(0); PG8_MMA(1, 0, At, B0); PG8_BAR; PG8_SCHED;
            PG8_STAGE(PG8_SB(0, 1), b2 + hstep, voffB);
            PG8_WAIT_V(6); PG8_BAR; PG8_MMA(1, 1, At, B1); PG8_BAR;
            PG8_LDB(B0, 1, 0); PG8_SCHED; PG8_LDA(At, 1, 0); PG8_STAGE(PG8_SA(0, 1), a2 + hstep, voffA);
            PG8_WAIT_L(8); PG8_BAR; PG8_WAIT_L(0); PG8_MMA(0, 0, At, B0); PG8_BAR; PG8_SCHED;
            PG8_LDB(B1, 1, 1); PG8_STAGE(PG8_SB(1, 0), b3, voffB);
            PG8_BAR; PG8_WAIT_L(0); PG8_MMA(0, 1, At, B1); PG8_BAR;
            PG8_LDA(At, 1, 1); PG8_STAGE(PG8_SA(1, 0), a3, voffA);
            PG8_BAR; PG8_WAIT_L(0); PG8_MMA(1, 0, At, B0); PG8_BAR; PG8_SCHED;
            PG8_STAGE(PG8_SB(1, 1), b3 + hstep, voffB);
            PG8_WAIT_V(6); PG8_BAR; PG8_MMA(1, 1, At, B1); PG8_BAR;
        }
        {
            const int row0 = cur.pm * BM + wr * 64 + fr, col0 = cur.pn * BM + wc * 32 + 8 * fq;
#pragma unroll
            for (int ai = 0; ai < 2; ++ai)
#pragma unroll
                for (int m = 0; m < 4; ++m)
#pragma unroll
                    for (int bj = 0; bj < 2; ++bj) { E(row0 + ai * HALF + m * 16, col0 + bj * HALF, cur.pn, acc[ai][bj][m][0], acc[ai][bj][m][1]); if (Epi::SERIAL) __builtin_amdgcn_sched_barrier(0); }
        }
        if (!has_next) break;
#pragma unroll
        for (int a = 0; a < 2; ++a)
#pragma unroll
            for (int b = 0; b < 2; ++b)
#pragma unroll
                for (int m = 0; m < 4; ++m)
#pragma unroll
                    for (int n = 0; n < 2; ++n) acc[a][b][m][n] = (f32x4){0.f, 0.f, 0.f, 0.f};
        cur = nxt; cA = nA; cB = nB; ++ui;
    }
    PG8_WAIT_V(0);
    if (wr == 0) PG8_BAR;
    PG8_BAR;
#undef PG8_SA
#undef PG8_SB
#undef PG8_STAGE
#undef PG8_LDA
#undef PG8_LDB
#undef PG8_MMA
#undef PG8_WAIT_V
#undef PG8_WAIT_L
#undef PG8_BAR
#undef PG8_SCHED
}
struct GemmM { const bf16_t* A0; const bf16_t* A1; const bf16_t* Bt; int M, N; };
template <class Hook>
__device__ __forceinline__ void gemm_phase_merge(LAS unsigned char* lds, const GemmM g, const StaticOrder& S, const Hook& H) {
    const int tid = threadIdx.x, wid = __builtin_amdgcn_readfirstlane(tid >> 6), lane = tid & 63, wr = wid >> 2, wc = wid & 3, fr = lane & 15, fq = lane >> 4;
    constexpr int K = 2048, LDA = 1024, nt = K / BK, KS = 16;
    unsigned voffA[2], voffB[2];
#pragma unroll
    for (int i = 0; i < 2; ++i) { int R, C; stage_rc(tid * 16 + i * 8192, R, C); const int Rb = (R & ~31) + perm32(R & 31);
        voffA[i] = (unsigned)(R * LDA + C) * 2u; voffB[i] = (unsigned)(Rb * K + C) * 2u; }
    const size_t kstep = (size_t)(BK * 2);
    const size_t hstepA = (size_t)HALF * LDA * 2, tstepA = 2 * hstepA, hstepB = (size_t)HALF * K * 2, tstepB = 2 * hstepB;
    const unsigned ldsw = (unsigned)wid * 1024u;
    const int aoff = lds_byte(wr * 64 + fr, fq * 8), boff = lds_byte(wc * 32 + fr, fq * 8);
#define PG8_SA(b, h) (((b) * 2 + (h)) * HTB)
#define PG8_SB(b, h) ((4 + (b) * 2 + (h)) * HTB)
#define PG8_STAGE(bufoff, gbase, voff) do { _Pragma("unroll") for (int _i = 0; _i < 2; ++_i) \
        __builtin_amdgcn_global_load_lds((const unsigned*)((const char*)(gbase) + (voff)[_i]), (LAS unsigned*)(lds + (bufoff) + ldsw + _i * 8192), 16, 0, 0); } while (0)
#define PG8_LDA(dst, b, h) do { _Pragma("unroll") for (int m = 0; m < 4; ++m) _Pragma("unroll") for (int k = 0; k < 2; ++k) dst[m][k] = *(const LAS bf16x8*)(lds + PG8_SA(b, h) + aoff + m * 2048 + k * 1024); } while (0)
#define PG8_LDB(dst, b, h) do { _Pragma("unroll") for (int n = 0; n < 2; ++n) _Pragma("unroll") for (int k = 0; k < 2; ++k) dst[n][k] = *(const LAS bf16x8*)(lds + PG8_SB(b, h) + boff + n * 2048 + k * 1024); } while (0)
#define PG8_MMA(ai, bj, At, Bt) do { __builtin_amdgcn_s_setprio(1); _Pragma("unroll") for (int m = 0; m < 4; ++m) _Pragma("unroll") for (int n = 0; n < 2; ++n) _Pragma("unroll") for (int k = 0; k < 2; ++k) \
        acc[ai][bj][m][n] = __builtin_amdgcn_mfma_f32_16x16x32_bf16(Bt[n][k], At[m][k], acc[ai][bj][m][n], 0, 0, 0); __builtin_amdgcn_s_setprio(0); } while (0)
#define PG8_WAIT_V(n) asm volatile("s_waitcnt vmcnt(" #n ")" ::: "memory")
#define PG8_WAIT_L(n) asm volatile("s_waitcnt lgkmcnt(" #n ")" ::: "memory")
#define PG8_BAR __builtin_amdgcn_s_barrier()
#define PG8_SCHED __builtin_amdgcn_sched_barrier(0)
#define PG8_AT(b0, b1, t) ((t) < KS ? (b0) + (size_t)(t) * kstep : (b1) + (size_t)((t) - KS) * kstep)
    Unit cur, nxt; int ui = 0;
    if (!S.next(0, cur)) return;
    f32x4 acc[2][2][4][2];
#pragma unroll
    for (int a = 0; a < 2; ++a)
#pragma unroll
        for (int b = 0; b < 2; ++b)
#pragma unroll
            for (int m = 0; m < 4; ++m)
#pragma unroll
                for (int n = 0; n < 2; ++n) acc[a][b][m][n] = (f32x4){0.f, 0.f, 0.f, 0.f};
    bf16x8 At[4][2], B0[2][2], B1[2][2];
    const char* cA0 = (const char*)g.A0 + (size_t)cur.pm * tstepA; const char* cA1 = (const char*)g.A1 + (size_t)cur.pm * tstepA; const char* cB = (const char*)g.Bt + (size_t)cur.pn * tstepB;
    PG8_STAGE(PG8_SB(0, 0), cB, voffB); PG8_STAGE(PG8_SA(0, 0), cA0, voffA); PG8_STAGE(PG8_SB(0, 1), cB + hstepB, voffB); PG8_STAGE(PG8_SA(0, 1), cA0 + hstepA, voffA);
    if (wr == 1) PG8_BAR;
    PG8_WAIT_V(4); PG8_BAR;
    PG8_STAGE(PG8_SB(1, 0), cB + kstep, voffB); PG8_STAGE(PG8_SA(1, 0), cA0 + kstep, voffA); PG8_STAGE(PG8_SB(1, 1), cB + hstepB + kstep, voffB);
    PG8_WAIT_V(6); PG8_BAR;
    for (;;) {
        const bool has_next = S.next(ui + 1, nxt);
        const char* nA0 = has_next ? (const char*)g.A0 + (size_t)nxt.pm * tstepA : cA0; const char* nA1 = has_next ? (const char*)g.A1 + (size_t)nxt.pm * tstepA : cA1;
        const char* nB = has_next ? (const char*)g.Bt + (size_t)nxt.pn * tstepB : cB;
#pragma unroll 1
        for (int t = 0; t < nt; t += 2) {
            const bool last = (t == nt - 2);
            if (t == 16 || t == 24) H.rescale(acc, cur, t == 24 ? 1 : 0, wr, wc, fr, fq);
            const char* a1 = PG8_AT(cA0, cA1, t + 1);
            const char* a2 = last ? nA0 : PG8_AT(cA0, cA1, t + 2); const char* b2 = last ? nB : cB + (size_t)(t + 2) * kstep;
            const char* a3 = last ? nA0 + kstep : PG8_AT(cA0, cA1, t + 3); const char* b3 = b2 + kstep;
            PG8_LDB(B0, 0, 0); PG8_SCHED; PG8_LDA(At, 0, 0); PG8_STAGE(PG8_SA(1, 1), a1 + hstepA, voffA);
            PG8_WAIT_L(8); PG8_BAR; PG8_WAIT_L(0); PG8_MMA(0, 0, At, B0); PG8_BAR; PG8_SCHED;
            PG8_LDB(B1, 0, 1); PG8_STAGE(PG8_SB(0, 0), b2, voffB);
            PG8_BAR; PG8_WAIT_L(0); PG8_MMA(0, 1, At, B1); PG8_BAR;
            PG8_LDA(At, 0, 1); PG8_STAGE(PG8_SA(0, 0), a2, voffA);
            PG8_BAR; PG8_WAIT_L(0); PG8_MMA(1, 0, At, B0); PG8_BAR; PG8_SCHED;
            PG8_STAGE(PG8_SB(0, 1), b2 + hstepB, voffB);
            PG8_WAIT_V(6); PG8_BAR; PG8_MMA(1, 1, At, B1); PG8_BAR;
            PG8_LDB(B0, 1, 0); PG8_SCHED; PG8_LDA(At, 1, 0); PG8_STAGE(PG8_SA(0, 1), a2 + hstepA, voffA);
            PG8_WAIT_L(8); PG8_BAR; PG8_WAIT_L(0); PG8_MMA(0, 0, At, B0); PG8_BAR; PG8_SCHED;
            PG8_LDB(B1, 1, 1); PG8_STAGE(PG8_SB(1, 0), b3, voffB);
            PG8_BAR; PG8_WAIT_L(0); PG8_MMA(0, 1, At, B1); PG8_BAR;
            PG8_LDA(At, 1, 1); PG8_STAGE(PG8_SA(1, 0), a3, voffA);
            PG8_BAR; PG8_WAIT_L(0); PG8_MMA(1, 0, At, B0); PG8_BAR; PG8_SCHED;
            PG8_STAGE(PG8_SB(1, 1), b3 + hstepB, voffB);
            PG8_WAIT_V(6); PG8_BAR; PG8_MMA(1, 1, At, B1); PG8_BAR;
        }
        H.finish(acc, cur, wr, wc, fr, fq);
        if (!has_next) break;
#pragma unroll
        for (int a = 0; a < 2; ++a)
#pragma unroll
            for (int b = 0; b < 2; ++b)
#pragma unroll
                for (int m = 0; m < 4; ++m)
#pragma unroll
                    for (int n = 0; n < 2; ++n) acc[a][b][m][n] = (f32x4){0.f, 0.f, 0.f, 0.f};
        cur = nxt; cA0 = nA0; cA1 = nA1; cB = nB; ++ui;
    }
    PG8_WAIT_V(0);
    if (wr == 0) PG8_BAR;
    PG8_BAR;
#undef PG8_SA
#undef PG8_SB
#undef PG8_STAGE
#undef PG8_LDA
#undef PG8_LDB
#undef PG8_MMA
#undef PG8_WAIT_V
#undef PG8_WAIT_L
#undef PG8_BAR
#undef PG8_SCHED
#undef PG8_AT
}
}

struct Args { const float* in[34]; float* out; unsigned char* ws; int ph_lo, ph_hi, li, pad; };

struct Ctx {
    LAS unsigned char* lds;
    int tid, lane, wave, gw, ngw, gt, ngt, G;
    const float* const* in; unsigned char* ws; unsigned char* dout;
};

__device__ __forceinline__ void st8_bf16(bf16_t* p, f32x4 a, f32x4 b) { u32x4 w; w.x = pk2(a.x, a.y); w.y = pk2(a.z, a.w); w.z = pk2(b.x, b.y); w.w = pk2(b.z, b.w); *(u32x4*)p = w; }
struct EpiP1 { static constexpr bool SERIAL = false;
    float* cs; bf16_t* rc; bf16_t* mq;
    __device__ __forceinline__ void operator()(int row, int col, int pn, f32x4 a, f32x4 b) const {
        if (pn < 2) { float* p = cs + (size_t)row * 512 + col; *(f32x4*)p = a; *(f32x4*)(p + 4) = b; }
        else if (pn < 9) st8_bf16(rc + (size_t)row * 1792 + (col - 512), a, b);
        else st8_bf16(mq + (size_t)row * 512 + (col - 2304), a, b);
    }
};
struct EpiMemKV { static constexpr bool SERIAL = false;
    bf16_t* km; bf16_t* vt;
    __device__ __forceinline__ void operator()(int row, int col, int pn, f32x4 a, f32x4 b) const {
        const int bb = row >> 8, m = row & 255;
        if (col < 512) { const int h = col >> 7, d = col & 127; st8_bf16(km + ((size_t)((bb * 4 + h) * 256 + m)) * 128 + d, a, b); }
        else { const int c2 = col - 512, h = c2 >> 7, d = c2 & 127; bf16_t* p = vt + ((size_t)((bb * 4 + h) * 128 + d)) * 256 + m;
            p[0] = (bf16_t)f2bf(a.x); p[256] = (bf16_t)f2bf(a.y); p[512] = (bf16_t)f2bf(a.z); p[768] = (bf16_t)f2bf(a.w);
            p[1024] = (bf16_t)f2bf(b.x); p[1280] = (bf16_t)f2bf(b.y); p[1536] = (bf16_t)f2bf(b.z); p[1792] = (bf16_t)f2bf(b.w); }
    }
};
struct EpiLora { static constexpr bool SERIAL = true;
    bf16_t* e; bf16_t* a; bf16_t* g; const float* w0; const float* a0;
    __device__ __forceinline__ void operator()(int row, int col, int pn, f32x4 x, f32x4 y) const {
        float v[8] = {x.x, x.y, x.z, x.w, y.x, y.y, y.z, y.w};
        if (pn < 4) { const int c = col & 511; const float* bp = (pn < 2 ? w0 : a0) + c; const f32x4 b0 = *(const f32x4*)bp, b1 = *(const f32x4*)(bp + 4);
            const float bb[8] = {b0.x, b0.y, b0.z, b0.w, b1.x, b1.y, b1.z, b1.w}; const float sc = pn < 2 ? 0.6065306597126334f : 1.0f;
#pragma unroll
            for (int j = 0; j < 8; ++j) v[j] = sc * sigmoidf_(v[j] + bb[j]);
            *(u32x4*)((pn < 2 ? e : a) + (size_t)row * 512 + c) = pack8(v);
        } else *(u32x4*)(g + (size_t)row * 512 + (col - 1024)) = pack8(v);
    }
};
struct EpiQ { static constexpr bool SERIAL = false;
    bf16_t* ql; bf16_t* qi;
    __device__ __forceinline__ void operator()(int row, int col, int pn, f32x4 a, f32x4 b) const {
        if (pn < 4) st8_bf16(ql + (size_t)row * 1024 + col, a, b); else st8_bf16(qi + (size_t)row * 256 + (col - 1024), a, b);
    }
};
struct EpiGates { static constexpr bool SERIAL = true;
    bf16_t* o;
    __device__ __forceinline__ void operator()(int row, int col, int pn, f32x4 a, f32x4 b) const {
        float v[8] = {a.x, a.y, a.z, a.w, b.x, b.y, b.z, b.w};
#pragma unroll
        for (int j = 0; j < 8; ++j) v[j] = sigmoidf_(v[j]);
        *(u32x4*)(o + (size_t)row * 3072 + col) = pack8(v);
    }
};
struct MergeHook {
    const bf16_t* gates; bf16_t* mb;
    __device__ __forceinline__ void rescale(f32x4 (&acc)[2][2][4][2], const pg8::Unit& u, int idx, int wr, int wc, int fr, int fq) const {
        asm volatile("" : "+v"(fr), "+v"(fq));
        const int row0 = u.pm * 256 + wr * 64 + fr, col0 = u.pn * 256 + wc * 32 + 8 * fq;
#pragma unroll
        for (int ai = 0; ai < 2; ++ai)
#pragma unroll
            for (int mh = 0; mh < 2; ++mh) {
                u32x4 pa[2][2], pb[2][2];
#pragma unroll
                for (int mm = 0; mm < 2; ++mm)
#pragma unroll
                    for (int bj = 0; bj < 2; ++bj) { const bf16_t* gp = gates + (size_t)(row0 + ai * 128 + (2 * mh + mm) * 16) * 3072 + idx * 1024 + col0 + bj * 128; pa[mm][bj] = *(const u32x4*)gp; pb[mm][bj] = *(const u32x4*)(gp + 1024); }
                __builtin_amdgcn_sched_barrier(0);
#pragma unroll
                for (int mm = 0; mm < 2; ++mm)
#pragma unroll
                    for (int bj = 0; bj < 2; ++bj) { float a[8], b[8]; unpack8(pa[mm][bj], a); unpack8(pb[mm][bj], b); const int m = 2 * mh + mm;
#pragma unroll
                        for (int j = 0; j < 4; ++j) { acc[ai][bj][m][0][j] *= a[j] * __builtin_amdgcn_rcpf(b[j]); acc[ai][bj][m][1][j] *= a[4 + j] * __builtin_amdgcn_rcpf(b[4 + j]); } }
                __builtin_amdgcn_sched_barrier(0);
            }
    }
    __device__ __forceinline__ void finish(f32x4 (&acc)[2][2][4][2], const pg8::Unit& u, int wr, int wc, int fr, int fq) const {
        asm volatile("" : "+v"(fr), "+v"(fq));
        const int row0 = u.pm * 256 + wr * 64 + fr, col0 = u.pn * 256 + wc * 32 + 8 * fq;
#pragma unroll
        for (int ai = 0; ai < 2; ++ai)
#pragma unroll
            for (int m = 0; m < 4; ++m)
#pragma unroll
                for (int bj = 0; bj < 2; ++bj) { const int row = row0 + ai * 128 + m * 16, col = col0 + bj * 128;
                    float gv[8]; unpack8(*(const u32x4*)(gates + (size_t)row * 3072 + 2048 + col), gv);
                    const f32x4 x = acc[ai][bj][m][0], y = acc[ai][bj][m][1];
                    float v[8] = {x[0] * gv[0], x[1] * gv[1], x[2] * gv[2], x[3] * gv[3], y[0] * gv[4], y[1] * gv[5], y[2] * gv[6], y[3] * gv[7]};
                    *(u32x4*)(mb + (size_t)row * 1024 + col) = pack8(v); }
    }
};
struct EpiWout { static constexpr bool SERIAL = false;
    gfp x; bf16_t* pre;
    __device__ __forceinline__ void operator()(int row, int col, int pn, f32x4 a, f32x4 b) const {
        gfp xp = x + (size_t)row * 1024 + col; typedef const __attribute__((address_space(1))) f32x4* g4p;
        st8_bf16(pre + (size_t)row * 1024 + col, *(g4p)xp * ALPHA + a, *(g4p)(xp + 4) * ALPHA + b);
    }
};
struct EpiPeerQ { static constexpr bool SERIAL = false; bf16_t* o; __device__ __forceinline__ void operator()(int row, int col, int pn, f32x4 a, f32x4 b) const { st8_bf16(o + (size_t)row * 2048 + col, a, b); } };

template <int N, int K, class F> __device__ __forceinline__ void build_bt(bf16_t* dst, const F& f, int gt, int ngt) {
    constexpr int items = N * (K / 8);
    for (int i = gt; i < items; i += ngt) { const int n = i % N, k0 = (i / N) * 8; float v[8];
#pragma unroll
        for (int j = 0; j < 8; ++j) v[j] = f(n, k0 + j);
        *(u32x4*)(dst + (size_t)n * K + k0) = pack8(v); }
}
template <int N, int K, class F> __device__ __forceinline__ void build_bt_ld(bf16_t* dst, int ld, const F& f, int gt, int ngt) {
    constexpr int items = N * (K / 8);
    for (int i = gt; i < items; i += ngt) { const int n = i % N, k0 = (i / N) * 8; float v[8];
#pragma unroll
        for (int j = 0; j < 8; ++j) v[j] = f(n, k0 + j);
        *(u32x4*)(dst + (size_t)n * ld + k0) = pack8(v); }
}
struct FWin { gfp w; __device__ __forceinline__ float operator()(int n, int k) const { if (n < 424) return w[(size_t)k * IN_W + n]; if (n < 512) return 0.f; return w[(size_t)k * IN_W + n - 88]; } };
struct FWg { gfp w; __device__ __forceinline__ float operator()(int n, int k) const { return w[(size_t)k * IN_W + 2728 + n]; } };
struct FLora { gfp w2, a2, g2; __device__ __forceinline__ float operator()(int n, int k) const {
    if (n < 512) return k < 64 ? w2[k * 512 + n] : 0.f;
    if (n < 1024) return (k >= 64 && k < 128) ? a2[(k - 64) * 512 + n - 512] : 0.f;
    return k >= 128 ? g2[(k - 128) * 512 + n - 1024] : 0.f; } };
struct FWq { const float *uq, *uk, *iq; __device__ __forceinline__ float operator()(int n, int k) const {
    if (n >= 1024) return iq[k * 256 + n - 1024];
    const int h = n >> 7, c = n & 127; const float* a = uq + (size_t)k * 512 + h * 64; const float* b = uk + (size_t)(c * 8 + h) * 64; float s = 0.f;
#pragma unroll 8
    for (int d = 0; d < 64; ++d) s = fmaf(a[d], b[d], s);
    return s * 0.125f; } };
struct FWov { const float *uv, *br; __device__ __forceinline__ float operator()(int n, int k) const {
    const int h = k >> 7, c = k & 127; const float* a = uv + (size_t)(c * 8 + h) * 64; const float* b = br + (size_t)(h * 64) * 1024 + n; float s = 0.f;
#pragma unroll 8
    for (int d = 0; d < 64; ++d) s = fmaf(a[d], b[(size_t)d * 1024], s);
    return s; } };
struct FT { gfp w; int ld; __device__ __forceinline__ float operator()(int n, int k) const { return w[(size_t)k * ld + n]; } };

__device__ __forceinline__ void cvt_rows(gfp src, bf16_t* dst, size_t n8, int gt, int ngt) {
    for (size_t i = gt; i < n8; i += ngt) { const f32x4 a = *(const __attribute__((address_space(1))) f32x4*)(src + i * 8), b = *(const __attribute__((address_space(1))) f32x4*)(src + i * 8 + 4); st8_bf16(dst + i * 8, a, b); }
}
constexpr float PEER_U_SCALE = 64.0f, PEER_V_SCALE = 8.0f;
template <bool SLICED = false>
__device__ __forceinline__ void cvt_rows_fp8(gfp src, unsigned char* dst, size_t n16, float scale, int gt, int ngt) {
    for (size_t i = gt; i < n16; i += ngt) { typedef const __attribute__((address_space(1))) f32x4* g4p; gfp p = src + i * 16; u32x4 w;
        const f32x4 a = *(g4p)p * scale, b = *(g4p)(p + 4) * scale, c = *(g4p)(p + 8) * scale, d = *(g4p)(p + 12) * scale;
        int t = 0; t = __builtin_amdgcn_cvt_pk_fp8_f32(a.x, a.y, t, false); t = __builtin_amdgcn_cvt_pk_fp8_f32(a.z, a.w, t, true); w.x = (unsigned)t;
        t = 0; t = __builtin_amdgcn_cvt_pk_fp8_f32(b.x, b.y, t, false); t = __builtin_amdgcn_cvt_pk_fp8_f32(b.z, b.w, t, true); w.y = (unsigned)t;
        t = 0; t = __builtin_amdgcn_cvt_pk_fp8_f32(c.x, c.y, t, false); t = __builtin_amdgcn_cvt_pk_fp8_f32(c.z, c.w, t, true); w.z = (unsigned)t;
        t = 0; t = __builtin_amdgcn_cvt_pk_fp8_f32(d.x, d.y, t, false); t = __builtin_amdgcn_cvt_pk_fp8_f32(d.z, d.w, t, true); w.w = (unsigned)t;
        if (SLICED) *(u32x4*)(dst + (((i >> 3) & 7) << 21) + ((i >> 6) << 7) + ((i & 7) << 4)) = w; else *(u32x4*)(dst + i * 16) = w; }
}
__device__ __forceinline__ void p0_prologue(const Ctx& C) {
    const float* const* in = C.in; unsigned char* ws = C.ws;
    cvt_rows(G_(in[0]), (bf16_t*)(C.dout + DO_XB), (size_t)T * D / 8, C.gt, C.ngt);
    cvt_rows(G_(in[1]), (bf16_t*)(ws + WS_MEMB), (size_t)1024 * 1024 / 8, C.gt, C.ngt);
    cvt_rows(G_(in[29]), (bf16_t*)(ws + WS_KEYS), (size_t)2 * 128 * 128 / 8, C.gt, C.ngt);
    build_bt<2816, 1024>((bf16_t*)(ws + WS_WIN), FWin{G_(in[3])}, C.gt, C.ngt);
    build_bt<1536, 256>((bf16_t*)(ws + WS_WLORA), FLora{G_(in[12]), G_(in[14]), G_(in[15])}, C.gt, C.ngt);
    {
        bf16_t* dst = (bf16_t*)(ws + WS_WQ); const float* uq = in[6]; const float* uk = in[7];
        for (int item = C.gw; item < 4096; item += C.ngw) { const int n = item >> 2, k = (item & 3) * 64 + C.lane, h = n >> 7, c = n & 127;
            const float* a = uq + (size_t)k * 512 + h * 64; const float* bq = uk + (size_t)(c * 8 + h) * 64; float s = 0.f;
#pragma unroll
            for (int d4 = 0; d4 < 16; ++d4) { const f32x4 av = *(const f32x4*)(a + 4 * d4), bv = *(const f32x4*)(bq + 4 * d4); s += av.x * bv.x + av.y * bv.y + av.z * bv.z + av.w * bv.w; }
            dst[(size_t)n * 256 + k] = (bf16_t)f2bf(s * 0.125f); }
        build_bt<256, 256>(dst + 1024 * 256, FT{G_(in[9]), 256}, C.gt, C.ngt);
    }
    build_bt<1024, 1024>((bf16_t*)(ws + WS_WMEMKV), FT{G_(in[21]), 1024}, C.gt, C.ngt);
}
__device__ __forceinline__ void p6_late_weights(const Ctx& C0) {
    const int busy = (32 * RCH + C0.G - 1) / C0.G; Ctx C = C0;
    if (busy < NWAVES) { if (C0.wave < busy) return; C.gt = (int)blockIdx.x * (NWAVES - busy) * 64 + (C0.wave - busy) * 64 + C0.lane; C.ngt = C0.G * (NWAVES - busy) * 64; C.gw = C.gt >> 6; C.ngw = C.ngt >> 6; }
    const float* const* in = C.in; unsigned char* ws = C.ws;
    build_bt<3072, 1024>((bf16_t*)(ws + WS_WG), FWg{G_(in[3])}, C.gt, C.ngt);
    {
        bf16_t* dst = (bf16_t*)(ws + WS_WOV); const float* uv = in[8]; const float* br = in[22];
        for (int i = C.gt; i < 1024 * 128; i += C.ngt) { const int n = i & 1023, k0 = (i >> 10) * 8, h = k0 >> 7, c0 = k0 & 127; float acc[8];
#pragma unroll
            for (int j = 0; j < 8; ++j) acc[j] = 0.f;
            for (int d4 = 0; d4 < 16; ++d4) {
                float b[4];
#pragma unroll
                for (int q = 0; q < 4; ++q) b[q] = br[(size_t)(h * 64 + 4 * d4 + q) * 1024 + n];
#pragma unroll
                for (int j = 0; j < 8; ++j) { const f32x4 a = *(const f32x4*)(uv + (size_t)((c0 + j) * 8 + h) * 64 + 4 * d4); acc[j] += a.x * b[0] + a.y * b[1] + a.z * b[2] + a.w * b[3]; }
            }
            *(u32x4*)(dst + (size_t)n * 2048 + k0) = pack8(acc); }
    }
    build_bt_ld<1024, 512>((bf16_t*)(ws + WS_WOV) + 1024, 2048, FT{G_(in[23]), 1024}, C.gt, C.ngt);
    build_bt_ld<1024, 512>((bf16_t*)(ws + WS_WOV) + 1536, 2048, FT{G_(in[24]), 1024}, C.gt, C.ngt);
    build_bt<1024, 1024>((bf16_t*)(ws + WS_WOUT), FT{G_(in[25]), 1024}, C.gt, C.ngt);
    build_bt<2048, 1024>((bf16_t*)(ws + WS_WPEER), FT{G_(in[28]), 2048}, C.gt, C.ngt);
    cvt_rows_fp8(G_(in[30]), ws + WS_UB, (size_t)16384 * 1024 / 16, PEER_U_SCALE, C.gt, C.ngt);
}

__device__ __forceinline__ void p2_prep(const Ctx& C) {
    const float* const* in = C.in; unsigned char* ws = C.ws; const int lane = C.lane;
    const float* csmall = (const float*)(ws + WS_CSMALL); const bf16_t* rcols = (const bf16_t*)(ws + WS_RCOLS);
    bf16_t* cqn = (bf16_t*)(ws + WS_CQN); bf16_t* kvl = (bf16_t*)(ws + WS_KVL); bf16_t* kidx = (bf16_t*)(ws + WS_KIDX); float* widx = (float*)(ws + WS_WIDX);
    bf16_t* rr = (bf16_t*)(ws + WS_RW_R); bf16_t* rk = (bf16_t*)(ws + WS_RW_K); bf16_t* rv = (bf16_t*)(ws + WS_RW_V); bf16_t* la = (bf16_t*)(ws + WS_LORAA);
    const float* mu = in[10];
    const f32x4 gq = *(const f32x4*)(in[4] + 4 * lane); const f32x2 gk = *(const f32x2*)(in[5] + 2 * lane);
    for (int t = C.gw; t < T; t += C.ngw) {
        const float* cs = csmall + (size_t)t * 512;
        {
            const f32x4 q = *(const f32x4*)(cs + 4 * lane);
            const float ss = wave_sum(q.x * q.x + q.y * q.y + q.z * q.z + q.w * q.w);
            const float rs = rsqrtf(ss * (1.0f / 256.0f) + 1e-6f);
            u32x2 w; w.x = pk2(q.x * rs * gq.x, q.y * rs * gq.y); w.y = pk2(q.z * rs * gq.z, q.w * rs * gq.w);
            *(u32x2*)(cqn + (size_t)t * 256 + 4 * lane) = w;
        }
        {
            const f32x2 k = *(const f32x2*)(cs + 256 + 2 * lane);
            const float ss = wave_sum(k.x * k.x + k.y * k.y);
            const float rs = rsqrtf(ss * (1.0f / 128.0f) + 1e-6f);
            *(unsigned*)(kvl + (size_t)t * 128 + 2 * lane) = pk2(k.x * rs * gk.x, k.y * rs * gk.y);
        }
        if (lane < 16) { const f32x2 k = *(const f32x2*)(cs + 384 + 2 * lane); *(unsigned*)(kidx + (size_t)t * 32 + 2 * lane) = pk2(k.x, k.y); }
        if (lane < 8) widx[(size_t)t * 8 + lane] = cs[416 + lane] * 0.0625f;
        const bf16_t* rc = rcols + (size_t)t * 1792; const bool hp = (t & (SEQ - 1)) != 0; const bf16_t* rp = hp ? rc - 1792 : rc;
#pragma unroll
        for (int seg = 0; seg < 3; ++seg) {
            float c[8], p[8], o[8];
            unpack8(*(const u32x4*)(rc + seg * 512 + 8 * lane), c); unpack8(*(const u32x4*)(rp + seg * 512 + 8 * lane), p);
            const f32x4 m0 = *(const f32x4*)(mu + seg * 512 + 8 * lane), m1 = *(const f32x4*)(mu + seg * 512 + 8 * lane + 4);
            const float mm[8] = {m0.x, m0.y, m0.z, m0.w, m1.x, m1.y, m1.z, m1.w};
#pragma unroll
            for (int j = 0; j < 8; ++j) { const float pv = hp ? p[j] : 0.f; o[j] = c[j] + (pv - c[j]) * mm[j]; }
            bf16_t* dst = (seg == 0 ? rr : (seg == 1 ? rk : rv)) + (size_t)t * 512 + 8 * lane;
            *(u32x4*)dst = pack8(o);
        }
        {
            const float cw = bf1(rc[1536 + lane]), pw = hp ? bf1(rp[1536 + lane]) : 0.f; const float wl = cw + (pw - cw) * mu[1536 + lane];
            const float ca = bf1(rc[1600 + lane]), pa = hp ? bf1(rp[1600 + lane]) : 0.f; const float al = ca + (pa - ca) * mu[1600 + lane];
            const unsigned cgw = *(const unsigned*)(rc + 1664 + 2 * lane), pgw = *(const unsigned*)(rp + 1664 + 2 * lane);
            const float cg0 = bflo(cgw), cg1 = bfhi(cgw), pg0 = hp ? bflo(pgw) : 0.f, pg1 = hp ? bfhi(pgw) : 0.f;
            const float g0 = cg0 + (pg0 - cg0) * mu[1664 + 2 * lane], g1 = cg1 + (pg1 - cg1) * mu[1664 + 2 * lane + 1];
            bf16_t* l = la + (size_t)t * 256;
            l[lane] = (bf16_t)f2bf(tanhf(wl)); l[64 + lane] = (bf16_t)f2bf(al);
            *(unsigned*)(l + 128 + 2 * lane) = pk2(sigmoidf_(g0), sigmoidf_(g1));
        }
    }
}

template <int NV> __device__ __forceinline__ unsigned kth_largest(const unsigned (&u)[NV], int k) {
    unsigned Tk = 0u;
    for (int bit = 31; bit >= 0; --bit) {
        const unsigned cand = Tk | (1u << bit); int cnt = 0;
#pragma unroll
        for (int j = 0; j < NV; ++j) cnt += __popcll(__ballot(u[j] >= cand));
        if (cnt >= k) Tk = cand;
    }
    return Tk;
}

__device__ __forceinline__ unsigned wave_max_u(unsigned x) {
    unsigned y;
    y = dpp_u<0x111>(x); x = x > y ? x : y; y = dpp_u<0x112>(x); x = x > y ? x : y; y = dpp_u<0x114>(x); x = x > y ? x : y; y = dpp_u<0x118>(x); x = x > y ? x : y;
    y = (unsigned)__builtin_amdgcn_update_dpp(0, (int)x, 0x142, 0xA, 0xF, false); x = x > y ? x : y;
    y = (unsigned)__builtin_amdgcn_update_dpp(0, (int)x, 0x143, 0xC, 0xF, false); x = x > y ? x : y;
    return (unsigned)__builtin_amdgcn_readlane((int)x, 63);
}
__device__ __forceinline__ int wave_sum_i(int x) {
    x += __builtin_amdgcn_update_dpp(0, x, 0x111, 0xF, 0xF, false); x += __builtin_amdgcn_update_dpp(0, x, 0x112, 0xF, 0xF, false);
    x += __builtin_amdgcn_update_dpp(0, x, 0x114, 0xF, 0xF, false); x += __builtin_amdgcn_update_dpp(0, x, 0x118, 0xF, 0xF, false);
    x += __builtin_amdgcn_update_dpp(0, x, 0x142, 0xA, 0xF, false); x += __builtin_amdgcn_update_dpp(0, x, 0x143, 0xC, 0xF, false);
    return __builtin_amdgcn_readlane(x, 63);
}
__device__ __forceinline__ float wave_max_f(float x) {
    const int ninf = (int)0xff800000u; float y;
    y = __builtin_bit_cast(float, __builtin_amdgcn_update_dpp(ninf, __builtin_bit_cast(int, x), 0x111, 0xF, 0xF, false)); x = fmaxf(x, y);
    y = __builtin_bit_cast(float, __builtin_amdgcn_update_dpp(ninf, __builtin_bit_cast(int, x), 0x112, 0xF, 0xF, false)); x = fmaxf(x, y);
    y = __builtin_bit_cast(float, __builtin_amdgcn_update_dpp(ninf, __builtin_bit_cast(int, x), 0x114, 0xF, 0xF, false)); x = fmaxf(x, y);
    y = __builtin_bit_cast(float, __builtin_amdgcn_update_dpp(ninf, __builtin_bit_cast(int, x), 0x118, 0xF, 0xF, false)); x = fmaxf(x, y);
    y = __builtin_bit_cast(float, __builtin_amdgcn_update_dpp(ninf, __builtin_bit_cast(int, x), 0x142, 0xA, 0xF, false)); x = fmaxf(x, y);
    y = __builtin_bit_cast(float, __builtin_amdgcn_update_dpp(ninf, __builtin_bit_cast(int, x), 0x143, 0xC, 0xF, false)); x = fmaxf(x, y);
    return __builtin_bit_cast(float, __builtin_amdgcn_readlane(__builtin_bit_cast(int, x), 63));
}
__device__ __forceinline__ int wave_scan_i(int x) {
    x += __builtin_amdgcn_update_dpp(0, x, 0x111, 0xF, 0xF, false); x += __builtin_amdgcn_update_dpp(0, x, 0x112, 0xF, 0xF, false);
    x += __builtin_amdgcn_update_dpp(0, x, 0x114, 0xF, 0xF, false); x += __builtin_amdgcn_update_dpp(0, x, 0x118, 0xF, 0xF, false);
    x += __builtin_amdgcn_update_dpp(0, x, 0x142, 0xA, 0xF, false); x += __builtin_amdgcn_update_dpp(0, x, 0x143, 0xC, 0xF, false);
    return x;
}
__device__ __forceinline__ int hist_find(u32x4 h, int K, int lane, int& chi, int& cnt) {
    const int ls = (int)(h.x + h.y + h.z + h.w); const int inc = wave_scan_i(ls); const int tot = __builtin_amdgcn_readlane(inc, 63);
    const int a3 = tot - inc, a2 = a3 + (int)h.w, a1 = a2 + (int)h.z, a0 = a1 + (int)h.y;
    int myb = -1, mya = 0, myc = 0;
    if (a3 < K && K <= a3 + (int)h.w) { myb = 3; mya = a3; myc = (int)h.w; }
    if (a2 < K && K <= a2 + (int)h.z) { myb = 2; mya = a2; myc = (int)h.z; }
    if (a1 < K && K <= a1 + (int)h.y) { myb = 1; mya = a1; myc = (int)h.y; }
    if (a0 < K && K <= a0 + (int)h.x) { myb = 0; mya = a0; myc = (int)h.x; }
    const unsigned long long m = __ballot(myb >= 0); const int src = m ? (int)__builtin_ctzll(m) : 0;
    chi = __builtin_amdgcn_readlane(mya, src); cnt = __builtin_amdgcn_readlane(myc, src);
    return 4 * src + __builtin_amdgcn_readlane(myb, src);
}
constexpr int LDS_HIST = 131072 + 4096;
__device__ __forceinline__ void p4_indexer(const Ctx& C) {
    unsigned char* ws = C.ws; const int lane = C.lane, wave = C.wave, g = lane >> 4, fr = lane & 15;
    const bf16_t* qidx = (const bf16_t*)(ws + WS_QIDX); const bf16_t* kidx = (const bf16_t*)(ws + WS_KIDX); const float* widx = (const float*)(ws + WS_WIDX);
    bf16_t* idxo = (bf16_t*)(ws + WS_IDX);
    constexpr int SCB = 8192 + 16;
    LAS unsigned char* SC = C.lds;
    LAS unsigned* H = (LAS unsigned*)(C.lds + LDS_HIST + wave * 1024);
    for (int u = blockIdx.x; u < 1024; u += C.G) {
        const int i4 = u >> 8, cc = u & 255, b = cc & 3, j = cc >> 2, qb = (i4 & 1) ? 64 * i4 + 63 - j : 64 * i4 + j;
        const int t0 = qb * 16, ntile = (t0 + 16 + 15) >> 4; const size_t tb = (size_t)b * SEQ; const size_t qrow = tb + t0 + fr;
        bf16x8 Bq[8];
#pragma unroll
        for (int h = 0; h < 8; ++h) Bq[h] = *(const bf16x8*)(qidx + qrow * 256 + h * 32 + 8 * g);
        const f32x4 w0 = *(const f32x4*)(widx + qrow * 8), w1 = *(const f32x4*)(widx + qrow * 8 + 4);
        const float wq[8] = {w0.x, w0.y, w0.z, w0.w, w1.x, w1.y, w1.z, w1.w};
        bf16x8 An[4];
#pragma unroll
        for (int q = 0; q < 4; ++q) { int i = wave + q * NWAVES; i = i < ntile ? i : ntile - 1; An[q] = *(const bf16x8*)(kidx + (tb + 16 * i + fr) * 32 + 8 * g); }
        for (int i0 = wave; i0 < ntile; i0 += 4 * NWAVES) {
            bf16x8 A[4];
#pragma unroll
            for (int q = 0; q < 4; ++q) A[q] = An[q];
#pragma unroll
            for (int q = 0; q < 4; ++q) { int i = i0 + 4 * NWAVES + q * NWAVES; i = i < ntile ? i : ntile - 1; An[q] = *(const bf16x8*)(kidx + (tb + 16 * i + fr) * 32 + 8 * g); }
#pragma unroll
            for (int q = 0; q < 4; ++q) {
                const int i = i0 + q * NWAVES;
                if (i < ntile) {
                    f32x4 sc = (f32x4){0.f, 0.f, 0.f, 0.f};
#pragma unroll
                    for (int h = 0; h < 8; ++h) { const f32x4 d = __builtin_amdgcn_mfma_f32_16x16x32_bf16(A[q], Bq[h], (f32x4){0.f, 0.f, 0.f, 0.f}, 0, 0, 0);
#pragma unroll
                        for (int r = 0; r < 4; ++r) sc[r] = fmaf(wq[h], fmaxf(d[r], 0.f), sc[r]); }
                    const int tq = t0 + fr, s0 = 16 * i + 4 * g; unsigned kq[4];
#pragma unroll
                    for (int r = 0; r < 4; ++r) { const unsigned hb = (unsigned)__builtin_bit_cast(unsigned short, (_Float16)sc[r]); const unsigned ky = (hb & 0x8000u) ? (~hb & 0xffffu) : (hb | 0x8000u); kq[r] = (s0 + r <= tq) ? ky : 0u; }
                    u32x2 w; w.x = kq[0] | (kq[1] << 16); w.y = kq[2] | (kq[3] << 16);
                    *(LAS u32x2*)(SC + fr * SCB + 2 * s0) = w;
                }
            }
        }
        __syncthreads();
#pragma unroll 1
        for (int rr = 0; rr < 2; ++rr) {
            const int row = wave + 8 * rr, tq = t0 + row; bf16_t* out = idxo + (tb + tq) * 256;
            if (tq < 256) {
#pragma unroll
                for (int jj = 0; jj < 4; ++jj) { const int s = jj * 64 + lane; if (s <= tq) out[s] = (bf16_t)s; }
            } else {
                unsigned kp[32];
#pragma unroll
                for (int d = 0; d < 32; ++d) { const int s2 = 2 * (64 * d + lane); unsigned w = *(const LAS unsigned*)(SC + row * SCB + 2 * s2); if (s2 > tq) w = 0u; kp[d] = w; }
                *(LAS u32x4*)(H + 4 * lane) = (u32x4){0u, 0u, 0u, 0u};
#pragma unroll
                for (int d = 0; d < 32; ++d) { const unsigned a = kp[d] & 0xffffu, bq_ = kp[d] >> 16;
                    if (a) __hip_atomic_fetch_add(H + (a >> 8), 1u, __ATOMIC_RELAXED, __HIP_MEMORY_SCOPE_WORKGROUP);
                    if (bq_) __hip_atomic_fetch_add(H + (bq_ >> 8), 1u, __ATOMIC_RELAXED, __HIP_MEMORY_SCOPE_WORKGROUP); }
                asm volatile("s_waitcnt lgkmcnt(0)" ::: "memory");
                int chi1, cnt1; const int b1 = hist_find(*(const LAS u32x4*)(H + 4 * lane), 256, lane, chi1, cnt1);
                asm volatile("s_waitcnt lgkmcnt(0)" ::: "memory");
                *(LAS u32x4*)(H + 4 * lane) = (u32x4){0u, 0u, 0u, 0u};
#pragma unroll
                for (int d = 0; d < 32; ++d) { const unsigned a = kp[d] & 0xffffu, bq_ = kp[d] >> 16;
                    if ((int)(a >> 8) == b1 && a) __hip_atomic_fetch_add(H + (a & 255u), 1u, __ATOMIC_RELAXED, __HIP_MEMORY_SCOPE_WORKGROUP);
                    if ((int)(bq_ >> 8) == b1 && bq_) __hip_atomic_fetch_add(H + (bq_ & 255u), 1u, __ATOMIC_RELAXED, __HIP_MEMORY_SCOPE_WORKGROUP); }
                asm volatile("s_waitcnt lgkmcnt(0)" ::: "memory");
                int chi2, cnt2; const int b2 = hist_find(*(const LAS u32x4*)(H + 4 * lane), 256 - chi1, lane, chi2, cnt2);
                const unsigned T16 = (unsigned)(b1 * 256 + b2); const int need = 256 - chi1 - chi2;
                const bool allties = (need == cnt2); const unsigned thr = allties ? T16 : T16 + 1u;
                unsigned mlo = 0u, mhi = 0u;
#pragma unroll
                for (int d = 0; d < 16; ++d) { const unsigned a = kp[d] & 0xffffu, bq_ = kp[d] >> 16; mlo |= (a >= thr ? 1u : 0u) << (2 * d); mlo |= (bq_ >= thr ? 1u : 0u) << (2 * d + 1); }
#pragma unroll
                for (int d = 16; d < 32; ++d) { const unsigned a = kp[d] & 0xffffu, bq_ = kp[d] >> 16; mhi |= (a >= thr ? 1u : 0u) << (2 * (d - 16)); mhi |= (bq_ >= thr ? 1u : 0u) << (2 * (d - 16) + 1); }
                LAS bf16_t* stage = (LAS bf16_t*)(SC + row * SCB);
                const int mycnt = __popc(mlo) + __popc(mhi); int base = wave_scan_i(mycnt) - mycnt;
                while (mlo) { const int bp = __builtin_ctz(mlo); stage[base++] = (bf16_t)(2 * (64 * (bp >> 1) + lane) + (bp & 1)); mlo &= mlo - 1u; }
                while (mhi) { const int bp = __builtin_ctz(mhi); stage[base++] = (bf16_t)(2 * (64 * ((bp >> 1) + 16) + lane) + (bp & 1)); mhi &= mhi - 1u; }
                if (!allties) {
                    int eqb = 0; const int pos0 = 256 - need;
#pragma unroll 4
                    for (int d = 0; d < 32; ++d) {
                        const bool eq0 = ((kp[d] & 0xffffu) == T16), eq1 = ((kp[d] >> 16) == T16);
                        const unsigned long long m0 = __ballot(eq0), m1 = __ballot(eq1);
                        const int below = (int)__builtin_amdgcn_mbcnt_hi((unsigned)(m0 >> 32), __builtin_amdgcn_mbcnt_lo((unsigned)m0, 0u)) + (int)__builtin_amdgcn_mbcnt_hi((unsigned)(m1 >> 32), __builtin_amdgcn_mbcnt_lo((unsigned)m1, 0u));
                        const int r0 = eqb + below, r1 = r0 + (eq0 ? 1 : 0);
                        if (eq0 && r0 < need) stage[pos0 + r0] = (bf16_t)(2 * (64 * d + lane));
                        if (eq1 && r1 < need) stage[pos0 + r1] = (bf16_t)(2 * (64 * d + lane) + 1);
                        eqb += __popcll(m0) + __popcll(m1);
                    }
                }
                asm volatile("s_waitcnt lgkmcnt(0)" ::: "memory");
                *(u32x2*)(out + 4 * lane) = *(const LAS u32x2*)(stage + 4 * lane);
            }
        }
        __syncthreads();
    }
}

__device__ __forceinline__ void p4_memattn(const Ctx& C) {
    unsigned char* ws = C.ws; const int lane = C.lane, wave = C.wave, g = lane >> 4, fr = lane & 15;
    const bf16_t* memq = (const bf16_t*)(ws + WS_MEMQ); const bf16_t* kmem = (const bf16_t*)(ws + WS_KMEM); const bf16_t* vmt = (const bf16_t*)(ws + WS_VMEMT);
    bf16_t* ymem = (bf16_t*)(ws + WS_YM) + 512;
    LAS unsigned char* KL = C.lds; LAS unsigned char* VL = C.lds + 65536;
    for (int su = blockIdx.x; su < 256; su += C.G) {
        const int bh = su >> 4, j = su & 15, b = bh >> 2, h = bh & 3;
        const char* kb = (const char*)(kmem + (size_t)(bh * 256) * 128); const char* vb = (const char*)(vmt + (size_t)(bh * 128) * 256);
#pragma unroll
        for (int pp = 0; pp < 8; ++pp) { const int p = wave + 8 * pp;
            { const int row = 4 * p + g; const int c = fr ^ (2 * (row & 7)); __builtin_amdgcn_global_load_lds((const unsigned*)(kb + row * 256 + 16 * c), (LAS unsigned*)(KL + 1024 * p), 16, 0, 0); }
            { const int row = 2 * p + (lane >> 5); const int c = (lane & 31) ^ (row & 15); __builtin_amdgcn_global_load_lds((const unsigned*)(vb + row * 512 + 16 * c), (LAS unsigned*)(VL + 1024 * p), 16, 0, 0); } }
        asm volatile("s_waitcnt vmcnt(0)" ::: "memory");
        __syncthreads();
#pragma unroll 1
        for (int u = 0; u < 2; ++u) {
            const int t0 = b * SEQ + (2 * j + u) * 128 + wave * 16;
            bf16x8 Bq[4];
#pragma unroll
            for (int kk = 0; kk < 4; ++kk) Bq[kk] = *(const bf16x8*)(memq + (size_t)(t0 + fr) * 512 + h * 128 + 32 * kk + 8 * g);
            f32x4 sc[16];
#pragma unroll
            for (int i = 0; i < 16; ++i) { if ((i & 1) == 0) __builtin_amdgcn_sched_barrier(0); f32x4 a = (f32x4){0.f, 0.f, 0.f, 0.f}; const int row = 16 * i + fr;
#pragma unroll
                for (int kk = 0; kk < 4; ++kk) { const bf16x8 A = *(const LAS bf16x8*)(KL + row * 256 + 16 * ((4 * kk + g) ^ (2 * (row & 7)))); a = __builtin_amdgcn_mfma_f32_16x16x32_bf16(A, Bq[kk], a, 0, 0, 0); }
                sc[i] = a; }
            const float scale = 0.08838834764831845f;
            float mx = -3.0e38f;
#pragma unroll
            for (int i = 0; i < 16; ++i)
#pragma unroll
                for (int r = 0; r < 4; ++r) { sc[i][r] *= scale; mx = fmaxf(mx, sc[i][r]); }
            mx = fmaxf(mx, __shfl_xor(mx, 16)); mx = fmaxf(mx, __shfl_xor(mx, 32));
            float sum = 0.f;
#pragma unroll
            for (int i = 0; i < 16; ++i)
#pragma unroll
                for (int r = 0; r < 4; ++r) { sc[i][r] = __expf(sc[i][r] - mx); sum += sc[i][r]; }
            sum += __shfl_xor(sum, 16); sum += __shfl_xor(sum, 32);
            const float inv = 1.0f / sum;
            bf16x8 Pb[8];
#pragma unroll
            for (int ks = 0; ks < 8; ++ks) { u32x4 w; w.x = pk2(sc[2 * ks][0] * inv, sc[2 * ks][1] * inv); w.y = pk2(sc[2 * ks][2] * inv, sc[2 * ks][3] * inv);
                w.z = pk2(sc[2 * ks + 1][0] * inv, sc[2 * ks + 1][1] * inv); w.w = pk2(sc[2 * ks + 1][2] * inv, sc[2 * ks + 1][3] * inv); Pb[ks] = __builtin_bit_cast(bf16x8, w); }
#pragma unroll
            for (int dt = 0; dt < 8; ++dt) {
                __builtin_amdgcn_sched_barrier(0);
                f32x4 o = (f32x4){0.f, 0.f, 0.f, 0.f}; const int row = 16 * dt + fr;
#pragma unroll
                for (int ks = 0; ks < 8; ++ks) { const int ch = 4 * ks + (g >> 1);
                    const u32x2 lo = *(const LAS u32x2*)(VL + row * 512 + 16 * (ch ^ (row & 15)) + 8 * (g & 1)), hi = *(const LAS u32x2*)(VL + row * 512 + 16 * ((ch + 2) ^ (row & 15)) + 8 * (g & 1));
                    u32x4 w; w.x = lo.x; w.y = lo.y; w.z = hi.x; w.w = hi.y;
                    o = __builtin_amdgcn_mfma_f32_16x16x32_bf16(__builtin_bit_cast(bf16x8, w), Pb[ks], o, 0, 0, 0); }
                u32x2 w; w.x = pk2(o[0], o[1]); w.y = pk2(o[2], o[3]);
                *(u32x2*)(ymem + (size_t)(t0 + fr) * 1024 + h * 128 + 16 * dt + 4 * g) = w;
            }
        }
        __syncthreads();
    }
}

constexpr int LDS_RELB = 131072 + 1024;
constexpr int LDS_LUT = LDS_RELB + 1024;
__device__ __forceinline__ void tr_read8(const unsigned (&a)[8], u32x2 (&d)[8]) {
    asm volatile("ds_read_b64_tr_b16 %0, %8\n\tds_read_b64_tr_b16 %1, %9\n\tds_read_b64_tr_b16 %2, %10\n\tds_read_b64_tr_b16 %3, %11\n\t"
                 "ds_read_b64_tr_b16 %4, %12\n\tds_read_b64_tr_b16 %5, %13\n\tds_read_b64_tr_b16 %6, %14\n\tds_read_b64_tr_b16 %7, %15\n\ts_waitcnt lgkmcnt(0)"
                 : "=&v"(d[0]), "=&v"(d[1]), "=&v"(d[2]), "=&v"(d[3]), "=&v"(d[4]), "=&v"(d[5]), "=&v"(d[6]), "=&v"(d[7])
                 : "v"(a[0]), "v"(a[1]), "v"(a[2]), "v"(a[3]), "v"(a[4]), "v"(a[5]), "v"(a[6]), "v"(a[7]) : "memory");
}
constexpr int LDS_DSAX = 131072 + 4096;
__device__ __forceinline__ void p5_dsa_attn(const Ctx& C, int qsel) {
    unsigned char* ws = C.ws; const int lane = C.lane, wave = C.wave, g = lane >> 4, fr = lane & 15;
    const bf16_t* qlat = (const bf16_t*)(ws + WS_QLAT); const bf16_t* kvl = (const bf16_t*)(ws + WS_KVL); const bf16_t* idxb = (const bf16_t*)(ws + WS_IDX);
    bf16_t* olat = (bf16_t*)(ws + WS_OLAT);
    LAS int* lut = (LAS int*)(C.lds + LDS_LUT);
    if (C.tid < 128) { const int n = C.tid; int bk = n; if (n >= 16) { bk = 16 + (int)(logf((float)n * (1.0f / 16.0f)) / 2.0794415416798357f * 16.0f); bk = bk > 31 ? 31 : bk; } lut[n] = bk; }
    __syncthreads();
    LAS unsigned char* my = C.lds + wave * 16384; const unsigned mybase = (unsigned)(uintptr_t)my;
    LAS bf16_t* IDXL = (LAS bf16_t*)(C.lds + LDS_DSAX + wave * 1024); LAS bf16_t* BKL = IDXL + 256;
    unsigned* qctr = (unsigned*)(ws + WS_CTL) + CW_DSAQ + 64 * qsel;
    const int qq = fr >> 2, p2 = fr & 3;
    bf16x8 Bbias;
    { float bv[8];
#pragma unroll
      for (int j = 0; j < 8; ++j) bv[j] = C.in[2][(8 * g + j) * 8 + (fr & 7)];
      Bbias = __builtin_bit_cast(bf16x8, pack8(bv)); }
    unsigned qkoff[2][4];
#pragma unroll
    for (int i = 0; i < 2; ++i) { const int ph = 4 * (fr & 7) + 2 * i + (fr >> 3);
#pragma unroll
        for (int kk = 0; kk < 4; ++kk) qkoff[i][kk] = (unsigned)(ph * 256 + 16 * ((4 * kk + g) ^ (2 * (ph & 7)))); }
    const int ph0 = 4 * (4 * (g & 1) + qq) + (g >> 1), ph1 = ph0 + 2;
    auto fetch_batch = [&]() -> int { int q0 = 0; if (lane == 0) q0 = (int)__hip_atomic_fetch_add(qctr, 4u, __ATOMIC_RELAXED, __HIP_MEMORY_SCOPE_AGENT); return __builtin_amdgcn_readfirstlane(q0); };
    int q = fetch_batch();
    u32x2 ixw = (u32x2){0u, 0u}; bf16x8 Bq[4];
    if (q < T) { ixw = *(const u32x2*)(idxb + (size_t)q * 256 + 4 * lane);
#pragma unroll
        for (int kk = 0; kk < 4; ++kk) Bq[kk] = *(const bf16x8*)(qlat + (size_t)q * 1024 + (fr & 7) * 128 + 32 * kk + 8 * g); }
    bool staged = false;
    while (q < T) {
        const int b = q >> 12, s = q & (SEQ - 1); const int nvalid = s + 1 < 256 ? s + 1 : 256;
        const char* kvb = (const char*)(kvl + (size_t)b * SEQ * 128);
        const int nsub = (nvalid + 31) >> 5;
#define DSA_STAGE(IXW, SS, NV, KVB) do { \
            int ix_[4] = {(int)((IXW).x & 0xffffu), (int)((IXW).x >> 16), (int)((IXW).y & 0xffffu), (int)((IXW).y >> 16)}; unsigned bk_[4]; \
            _Pragma("unroll") for (int j_ = 0; j_ < 4; ++j_) { if (4 * lane + j_ >= (NV)) ix_[j_] = 0; const int dist_ = (SS) - ix_[j_]; bk_[j_] = (unsigned)(dist_ >= 128 ? 31 : lut[dist_ < 0 ? 0 : dist_]); } \
            u32x2 wi_; wi_.x = (unsigned)ix_[0] | ((unsigned)ix_[1] << 16); wi_.y = (unsigned)ix_[2] | ((unsigned)ix_[3] << 16); *(LAS u32x2*)(IDXL + 4 * lane) = wi_; \
            u32x2 wb_; wb_.x = bk_[0] | (bk_[1] << 16); wb_.y = bk_[2] | (bk_[3] << 16); *(LAS u32x2*)(BKL + 4 * lane) = wb_; \
            asm volatile("s_waitcnt lgkmcnt(0)" ::: "memory"); \
            const u32x4 rw_ = *(const LAS u32x4*)(IDXL + 8 * g); const unsigned rws_[4] = {rw_.x, rw_.y, rw_.z, rw_.w}; \
            _Pragma("unroll") for (int p_ = 0; p_ < 8; ++p_) { const int srow_ = (int)((rws_[p_ >> 1] >> (16 * (p_ & 1))) & 0xffffu); const int c_ = fr ^ (2 * ((4 * p_ + g) & 7)); \
                __builtin_amdgcn_global_load_lds((const unsigned*)((KVB) + (size_t)srow_ * 256 + 16 * c_), (LAS unsigned*)(my + 1024 * p_), 16, 0, 0); } } while (0)
        if (!staged) { asm volatile("s_waitcnt vmcnt(0)" ::: "memory"); DSA_STAGE(ixw, s, nvalid, kvb); }
        int qn = ((q & 3) != 3) ? q + 1 : fetch_batch();
        u32x2 ixn = (u32x2){0u, 0u}; bf16x8 Bqn[4];
        if (qn < T) { ixn = *(const u32x2*)(idxb + (size_t)qn * 256 + 4 * lane);
#pragma unroll
            for (int kk = 0; kk < 4; ++kk) Bqn[kk] = *(const bf16x8*)(qlat + (size_t)qn * 1024 + (fr & 7) * 128 + 32 * kk + 8 * g); }
        else {
#pragma unroll
            for (int kk = 0; kk < 4; ++kk) Bqn[kk] = Bq[kk]; }
        float m_ref = 0.f, l_part = 0.f;
        f32x4 O[8];
#pragma unroll
        for (int cc = 0; cc < 8; ++cc) O[cc] = (f32x4){0.f, 0.f, 0.f, 0.f};
#pragma unroll
        for (int sc_ = 0; sc_ < 8; ++sc_) {
          if (sc_ < nsub) {
            LAS unsigned char* cur = my + (sc_ & 1) * 8192; const unsigned curb = mybase + (sc_ & 1) * 8192;
            if (sc_ + 1 < nsub) {
                LAS unsigned char* nb = my + ((sc_ + 1) & 1) * 8192;
                const u32x4 rw = *(const LAS u32x4*)(IDXL + 32 * (sc_ + 1) + 8 * g); const unsigned rws[4] = {rw.x, rw.y, rw.z, rw.w};
#pragma unroll
                for (int p = 0; p < 8; ++p) { const int srow = (int)((rws[p >> 1] >> (16 * (p & 1))) & 0xffffu); const int c = fr ^ (2 * ((4 * p + g) & 7));
                    __builtin_amdgcn_global_load_lds((const unsigned*)(kvb + (size_t)srow * 256 + 16 * c), (LAS unsigned*)(nb + 1024 * p), 16, 0, 0); }
                asm volatile("s_waitcnt vmcnt(8)" ::: "memory");
            } else asm volatile("s_waitcnt vmcnt(0)" ::: "memory");
            f32x4 sc[2];
#pragma unroll
            for (int i = 0; i < 2; ++i) {
                const int pos = (int)BKL[32 * sc_ + 16 * i + fr] - 8 * g;
                u32x4 oh; oh.x = (pos == 0 ? 0x3F80u : 0u) | (pos == 1 ? 0x3F800000u : 0u); oh.y = (pos == 2 ? 0x3F80u : 0u) | (pos == 3 ? 0x3F800000u : 0u);
                oh.z = (pos == 4 ? 0x3F80u : 0u) | (pos == 5 ? 0x3F800000u : 0u); oh.w = (pos == 6 ? 0x3F80u : 0u) | (pos == 7 ? 0x3F800000u : 0u);
                f32x4 a = __builtin_amdgcn_mfma_f32_16x16x32_bf16(__builtin_bit_cast(bf16x8, oh), Bbias, (f32x4){0.f, 0.f, 0.f, 0.f}, 0, 0, 0);
#pragma unroll
                for (int kk = 0; kk < 4; ++kk) a = __builtin_amdgcn_mfma_f32_16x16x32_bf16(*(const LAS bf16x8*)(cur + qkoff[i][kk]), Bq[kk], a, 0, 0, 0);
                sc[i] = a; }
            if (nvalid < 256) {
#pragma unroll
                for (int i = 0; i < 2; ++i)
#pragma unroll
                    for (int r = 0; r < 4; ++r) if (sc_ * 32 + 16 * i + 4 * g + r >= nvalid) sc[i][r] = -INFINITY;
            }
            if (sc_ == 0) { float mx = fmaxf(fmaxf(fmaxf(sc[0][0], sc[0][1]), fmaxf(sc[0][2], sc[0][3])), fmaxf(fmaxf(sc[1][0], sc[1][1]), fmaxf(sc[1][2], sc[1][3])));
                mx = fmaxf(mx, __shfl_xor(mx, 16)); mx = fmaxf(mx, __shfl_xor(mx, 32)); m_ref = mx; }
#pragma unroll
            for (int i = 0; i < 2; ++i)
#pragma unroll
                for (int r = 0; r < 4; ++r) { sc[i][r] = __expf(sc[i][r] - m_ref); l_part += sc[i][r]; }
            u32x4 w; w.x = pk2(sc[0][0], sc[0][1]); w.y = pk2(sc[0][2], sc[0][3]); w.z = pk2(sc[1][0], sc[1][1]); w.w = pk2(sc[1][2], sc[1][3]);
            const bf16x8 Pa = __builtin_bit_cast(bf16x8, w);
#pragma unroll
            for (int hf = 0; hf < 2; ++hf) {
                unsigned ad[8]; u32x2 dd[8];
#pragma unroll
                for (int c4 = 0; c4 < 4; ++c4) { const int chk = 2 * (4 * hf + c4) + (p2 >> 1);
                    ad[2 * c4] = curb + ph0 * 256 + 16 * (chk ^ (2 * (ph0 & 7))) + 8 * (p2 & 1); ad[2 * c4 + 1] = curb + ph1 * 256 + 16 * (chk ^ (2 * (ph1 & 7))) + 8 * (p2 & 1); }
                tr_read8(ad, dd);
#pragma unroll
                for (int c4 = 0; c4 < 4; ++c4) { u32x4 bw; bw.x = dd[2 * c4].x; bw.y = dd[2 * c4].y; bw.z = dd[2 * c4 + 1].x; bw.w = dd[2 * c4 + 1].y;
                    O[4 * hf + c4] = __builtin_amdgcn_mfma_f32_16x16x32_bf16(Pa, __builtin_bit_cast(bf16x8, bw), O[4 * hf + c4], 0, 0, 0); }
            }
            asm volatile("" ::: "memory");
          }
        }
        staged = false;
        if (qn < T) { const int bn = qn >> 12, sn = qn & (SEQ - 1); const int nvn = sn + 1 < 256 ? sn + 1 : 256; const char* kvbn = (const char*)(kvl + (size_t)bn * SEQ * 128);
            DSA_STAGE(ixn, sn, nvn, kvbn); staged = true; }
        float l_run = l_part; l_run += __shfl_xor(l_run, 16); l_run += __shfl_xor(l_run, 32);
        const float inv = 1.0f / l_run; float ir[4];
#pragma unroll
        for (int r = 0; r < 4; ++r) ir[r] = __shfl(inv, 4 * g + r);
        if (g < 2) {
#pragma unroll
            for (int cc = 0; cc < 8; ++cc)
#pragma unroll
                for (int r = 0; r < 4; ++r) olat[(size_t)q * 1024 + (4 * g + r) * 128 + 16 * cc + fr] = (bf16_t)f2bf(O[cc][r] * ir[r]);
        }
        q = qn; ixw = ixn;
#pragma unroll
        for (int kk = 0; kk < 4; ++kk) Bq[kk] = Bqn[kk];
    }
#undef DSA_STAGE
}

constexpr int RWM_LDS = 15872;
__device__ __forceinline__ bf16x8 frag_pack(f32x4 lo, f32x4 hi) { u32x4 w; w.x = pk2(lo.x, lo.y); w.y = pk2(lo.z, lo.w); w.z = pk2(hi.x, hi.y); w.w = pk2(hi.z, hi.w); return __builtin_bit_cast(bf16x8, w); }
__device__ __forceinline__ bf16x8 frag_pack_lo(f32x4 lo) { u32x4 w; w.x = pk2(lo.x, lo.y); w.y = pk2(lo.z, lo.w); w.z = 0u; w.w = 0u; return __builtin_bit_cast(bf16x8, w); }
struct RwIn { u32x4 e[2], k[2], a[2]; };
template <int MODE> __device__ __forceinline__ void rwm_fetch(RwIn& w, const bf16_t* pe, const bf16_t* pk, const bf16_t* pa, const bf16_t* pr, const bf16_t* pv, const bf16_t* pg, size_t t0, int h, int g, int fr) {
    const size_t rowoff = (t0 + fr) * 512 + h * 64;
#pragma unroll
    for (int k2 = 0; k2 < 2; ++k2) { const int c0 = 32 * k2 + 8 * g; w.e[k2] = *(const u32x4*)(pe + rowoff + c0); w.k[k2] = *(const u32x4*)(pk + rowoff + c0); w.a[k2] = *(const u32x4*)(pa + rowoff + c0);
        }
}
__device__ __forceinline__ void tr_read4(const unsigned (&a)[4], u32x2 (&d)[4]) {
    asm volatile("ds_read_b64_tr_b16 %0, %4\n\tds_read_b64_tr_b16 %1, %5\n\tds_read_b64_tr_b16 %2, %6\n\tds_read_b64_tr_b16 %3, %7\n\ts_waitcnt lgkmcnt(0)"
                 : "=&v"(d[0]), "=&v"(d[1]), "=&v"(d[2]), "=&v"(d[3]) : "v"(a[0]), "v"(a[1]), "v"(a[2]), "v"(a[3]) : "memory");
}
template <int O0, int O1, int O2, int O3> __device__ __forceinline__ void tr_read4_off(unsigned base, u32x2 (&d)[4]) {
    asm volatile("ds_read_b64_tr_b16 %0, %4 offset:%5\n\tds_read_b64_tr_b16 %1, %4 offset:%6\n\tds_read_b64_tr_b16 %2, %4 offset:%7\n\tds_read_b64_tr_b16 %3, %4 offset:%8\n\ts_waitcnt lgkmcnt(0)"
                 : "=&v"(d[0]), "=&v"(d[1]), "=&v"(d[2]), "=&v"(d[3]) : "v"(base), "i"(O0), "i"(O1), "i"(O2), "i"(O3) : "memory");
}
__device__ __forceinline__ bf16x8 frag_lo_raw(u32x2 lo) { u32x4 w; w.x = lo.x; w.y = lo.y; w.z = 0u; w.w = 0u; return __builtin_bit_cast(bf16x8, w); }
__device__ __forceinline__ bf16x8 frag_pack_raw(f32x4 lo, u32x2 hi) { u32x4 w; w.x = pk2(lo.x, lo.y); w.y = pk2(lo.z, lo.w); w.z = hi.x; w.w = hi.y; return __builtin_bit_cast(bf16x8, w); }
template <int MODE> __device__ __forceinline__ void rwm_task(const Ctx& C, int bh, int ch) {
    unsigned char* ws = C.ws; const int lane = C.lane, g = lane >> 4, fr = lane & 15; const int b = bh >> 3, h = bh & 7;
    const bf16_t* pr = (const bf16_t*)(ws + WS_RW_R); const bf16_t* pk = (const bf16_t*)(ws + WS_RW_K); const bf16_t* pv = (const bf16_t*)(ws + WS_RW_V);
    const bf16_t* pa = (const bf16_t*)(ws + WS_RW_A); const bf16_t* pe = (const bf16_t*)(ws + WS_RW_E); const bf16_t* pg = (const bf16_t*)(ws + WS_RW_G);
    bf16_t* yo = (bf16_t*)(ws + WS_YM);
    float* PQ = (float*)(C.dout + DO_PQ);
    LAS unsigned char* my = C.lds + C.wave * RWM_LDS; const unsigned myb = (unsigned)(uintptr_t)my;
    LAS unsigned char* SI = my; LAS unsigned char* BI = my + 9216; LAS unsigned char* KI = my + 11264; LAS float* CL = (LAS float*)(my + 13312); LAS unsigned char* VI = my + 13824;
    const gfp in16 = (gfp)C.in[16], in17 = (gfp)C.in[17], in18 = (gfp)C.in[18], in19 = (gfp)C.in[19], in20 = (gfp)C.in[20];
    const size_t tok0 = (size_t)b * SEQ + (size_t)ch * RL;
    const f32x4 Z4 = (f32x4){0.f, 0.f, 0.f, 0.f};
    const float* sbase = PQ + ((size_t)((bh * RCH + (ch > 0 ? ch - 1 : 0)) * 2)) * 4096 + fr * 64 + 4 * g;
    int gv = g; asm volatile("" : "+v"(gv));
    f32x4 S[4][4];
#pragma unroll
    for (int vt = 0; vt < 4; ++vt)
#pragma unroll
        for (int kt = 0; kt < 4; ++kt) {
            if (MODE == 1) { f32x4 x;
#pragma unroll
                for (int r = 0; r < 4; ++r) x[r] = (vt == kt && 4 * gv + r == fr) ? 1.f : 0.f;
                S[vt][kt] = x; }
            else if (MODE == 2 && ch > 0) { gfp sp = (gfp)(sbase + 1024 * vt); asm volatile("" : "+v"(sp));
                S[vt][kt] = *(const __attribute__((address_space(1))) f32x4*)(sp + 16 * kt); }
            else S[vt][kt] = Z4; }
    const bool strict[4] = {4 * g + 0 < fr, 4 * g + 1 < fr, 4 * g + 2 < fr, 4 * g + 3 < fr};
    const bool incl[4] = {4 * g + 0 <= fr, 4 * g + 1 <= fr, 4 * g + 2 <= fr, 4 * g + 3 <= fr};
    const int qq = fr >> 2, p2 = fr & 3; const unsigned trb = myb + (unsigned)((4 * g + qq) * 128 + 8 * p2);
    RwIn nxt; rwm_fetch<MODE>(nxt, pe, pk, pa, pr, pv, pg, tok0, h, g, fr);
#pragma unroll 1
    for (int sub = 0; sub < RL / 16; ++sub) {
        const size_t t0 = tok0 + (size_t)sub * 16;
        int frl = fr, gl_ = g; asm volatile("" : "+v"(frl), "+v"(gl_));
        u32x4 gq[2], rq[2], vq[2];
        { const size_t ro0 = (t0 + frl) * 512 + h * 64 + 8 * gl_;
          if (MODE == 2) { gq[0] = *(const u32x4*)(pg + ro0); gq[1] = *(const u32x4*)(pg + ro0 + 32); rq[0] = *(const u32x4*)(pr + ro0); rq[1] = *(const u32x4*)(pr + ro0 + 32); }
          if (MODE != 1) { vq[0] = *(const u32x4*)(pv + ro0); vq[1] = *(const u32x4*)(pv + ro0 + 32); } }
        const RwIn cur = nxt; rwm_fetch<MODE>(nxt, pe, pk, pa, pr, pv, pg, tok0 + (size_t)(sub + 1 < RL / 16 ? sub + 1 : sub) * 16, h, gl_, frl);
#pragma unroll
        for (int vt = 0; vt < 4; ++vt)
#pragma unroll
            for (int kt = 0; kt < 4; ++kt)
                { u32x2 w; w.x = pk2(S[vt][kt][0], S[vt][kt][1]); w.y = pk2(S[vt][kt][2], S[vt][kt][3]); *(LAS u32x2*)(SI + fr * 144 + 8 * g + vt * 2304 + 32 * kt) = w; }
        bf16x8 kap[2], rtl[2]; float bcoef = 0.f;
        {
            float ssq = 0.f, bsum = 0.f;
#pragma unroll
            for (int k2 = 0; k2 < 2; ++k2) { const int c0 = 32 * k2 + 8 * g; float kv[8]; unpack8(cur.k[k2], kv);
                const f32x4 kk0 = *(const __attribute__((address_space(1))) f32x4*)(in16 + h * 64 + c0), kk1 = *(const __attribute__((address_space(1))) f32x4*)(in16 + h * 64 + c0 + 4); const float kkc[8] = {kk0.x, kk0.y, kk0.z, kk0.w, kk1.x, kk1.y, kk1.z, kk1.w};
#pragma unroll
                for (int j = 0; j < 8; ++j) { const float x = kv[j] * kkc[j]; ssq += x * x; } }
            ssq += __shfl_xor(ssq, 16); ssq += __shfl_xor(ssq, 32);
            const float rn = __builtin_amdgcn_rsqf(fmaxf(ssq, 1e-24f));
#pragma unroll
            for (int k2 = 0; k2 < 2; ++k2) { const int c0 = 32 * k2 + 8 * g; float ev[8], kv[8], aa[8], rv[8];
                __builtin_amdgcn_sched_barrier(0);
                unpack8(cur.e[k2], ev); unpack8(cur.k[k2], kv); unpack8(cur.a[k2], aa);
                if (MODE == 2) unpack8(rq[k2], rv);
                const f32x4 ka0 = *(const __attribute__((address_space(1))) f32x4*)(in17 + h * 64 + c0), ka1 = *(const __attribute__((address_space(1))) f32x4*)(in17 + h * 64 + c0 + 4); const float kac[8] = {ka0.x, ka0.y, ka0.z, ka0.w, ka1.x, ka1.y, ka1.z, ka1.w};
                const f32x4 kk0 = *(const __attribute__((address_space(1))) f32x4*)(in16 + h * 64 + c0), kk1 = *(const __attribute__((address_space(1))) f32x4*)(in16 + h * 64 + c0 + 4); const float kkc[8] = {kk0.x, kk0.y, kk0.z, kk0.w, kk1.x, kk1.y, kk1.z, kk1.w};
                float rkc[8];
                if (MODE == 2) { const f32x4 r0 = *(const __attribute__((address_space(1))) f32x4*)(in18 + h * 64 + c0), r1 = *(const __attribute__((address_space(1))) f32x4*)(in18 + h * 64 + c0 + 4); rkc[0] = r0.x; rkc[1] = r0.y; rkc[2] = r0.z; rkc[3] = r0.w; rkc[4] = r1.x; rkc[5] = r1.y; rkc[6] = r1.z; rkc[7] = r1.w; }
                float kt_[8], bt_[8], kxt_[8], rt_[8];
#pragma unroll
                for (int j = 0; j < 8; ++j) {
                    float c = ev[j]; c += dpp_f<0x111>(c); c += dpp_f<0x112>(c); c += dpp_f<0x114>(c); c += dpp_f<0x118>(c);
                    const float kx = kv[j] * (1.0f + (aa[j] - 1.0f) * kac[j]); const float kk = kv[j] * kkc[j] * rn;
                    const float e2 = __expf(c), e3 = __builtin_amdgcn_rcpf(e2), e1 = e3 * __expf(ev[j]);
                    kt_[j] = kk * e1; bt_[j] = kk * aa[j] * e2; kxt_[j] = kx * e2;
                    if (MODE == 2) { rt_[j] = rv[j] * e3; bsum += rv[j] * kx * rkc[j]; } else rt_[j] = 0.f;
                    if (fr == 15) CL[c0 + j] = e3;
                }
                kap[k2] = __builtin_bit_cast(bf16x8, pack8(kt_)); if (MODE == 2) rtl[k2] = __builtin_bit_cast(bf16x8, pack8(rt_));
                *(LAS u32x4*)(BI + fr * 128 + 64 * k2 + 16 * g) = pack8(bt_); *(LAS u32x4*)(KI + fr * 128 + 64 * k2 + 16 * g) = pack8(kxt_);
            }
            if (MODE == 2) { bsum += __shfl_xor(bsum, 16); bsum += __shfl_xor(bsum, 32); bcoef = bsum; }
        }
        bf16x8 bet[2], kxf[2];
#pragma unroll
        for (int k2 = 0; k2 < 2; ++k2) { bet[k2] = *(const LAS bf16x8*)(BI + fr * 128 + 64 * k2 + 16 * g); kxf[k2] = *(const LAS bf16x8*)(KI + fr * 128 + 64 * k2 + 16 * g); }
        u32x2 VT[4];
        if (MODE != 1) {
#pragma unroll
            for (int k2 = 0; k2 < 2; ++k2) *(LAS u32x4*)(VI + fr * 128 + 64 * k2 + 16 * g) = vq[k2];
            tr_read4_off<13824, 13824 + 32, 13824 + 64, 13824 + 96>(trb, VT);
        } else {
#pragma unroll
            for (int vt = 0; vt < 4; ++vt) { VT[vt].x = 0u; VT[vt].y = 0u; }
        }
        f32x4 AT = Z4, BmT = Z4, C1T = Z4, C2T = Z4;
#pragma unroll
        for (int k2 = 0; k2 < 2; ++k2) { AT = __builtin_amdgcn_mfma_f32_16x16x32_bf16(bet[k2], kap[k2], AT, 0, 0, 0);
            if (MODE != 1) BmT = __builtin_amdgcn_mfma_f32_16x16x32_bf16(kxf[k2], kap[k2], BmT, 0, 0, 0);
            if (MODE == 2) { C1T = __builtin_amdgcn_mfma_f32_16x16x32_bf16(bet[k2], rtl[k2], C1T, 0, 0, 0); C2T = __builtin_amdgcn_mfma_f32_16x16x32_bf16(kxf[k2], rtl[k2], C2T, 0, 0, 0); } }
#pragma unroll
        for (int r = 0; r < 4; ++r) { AT[r] = strict[r] ? AT[r] : 0.f; BmT[r] = strict[r] ? BmT[r] : 0.f; C1T[r] = incl[r] ? C1T[r] : 0.f; C2T[r] = incl[r] ? C2T[r] : 0.f; }
        float tr[16];
        int frv = fr; asm volatile("" : "+v"(frv));
#pragma unroll
        for (int c = 15; c >= 0; --c) { float s = (c == frv) ? 1.f : 0.f;
#pragma unroll
            for (int j = c + 1; j < 16; ++j) { const float ajc = __builtin_bit_cast(float, __builtin_amdgcn_readlane(__builtin_bit_cast(int, AT[c & 3]), j + 16 * (c >> 2))); s = fmaf(-tr[j], ajc, s); }
            tr[c] = s; }
        f32x4 Tq;
#pragma unroll
        for (int jj = 0; jj < 4; ++jj) Tq[jj] = g == 0 ? tr[jj] : (g == 1 ? tr[4 + jj] : (g == 2 ? tr[8 + jj] : tr[12 + jj]));
        const bf16x8 Tf = frag_pack_lo(Tq), Bmf = frag_pack_lo(BmT), Cf = frag_pack(C1T, C2T);
        f32x4 Zt[4], Yt[4];
#pragma unroll
        for (int vt = 0; vt < 4; ++vt) {
            const int v = 16 * vt + fr;
            const bf16x8 s0 = *(const LAS bf16x8*)(SI + v * 144 + 16 * g), s1 = *(const LAS bf16x8*)(SI + v * 144 + 64 + 16 * g);
            f32x4 rhs = __builtin_amdgcn_mfma_f32_16x16x32_bf16(kap[0], s0, Z4, 0, 0, 0); rhs = __builtin_amdgcn_mfma_f32_16x16x32_bf16(kap[1], s1, rhs, 0, 0, 0);
            if (MODE != 1) rhs = __builtin_amdgcn_mfma_f32_16x16x32_bf16(Bmf, frag_lo_raw(VT[vt]), rhs, 0, 0, 0);
            f32x4 z = __builtin_amdgcn_mfma_f32_16x16x32_bf16(Tf, frag_pack_lo(rhs), Z4, 0, 0, 0);
            Zt[vt] = -z;
            if (MODE == 2) { f32x4 y = __builtin_amdgcn_mfma_f32_16x16x32_bf16(rtl[0], s0, Z4, 0, 0, 0); y = __builtin_amdgcn_mfma_f32_16x16x32_bf16(rtl[1], s1, y, 0, 0, 0);
                Yt[vt] = __builtin_amdgcn_mfma_f32_16x16x32_bf16(Cf, frag_pack_raw(Zt[vt], VT[vt]), y, 0, 0, 0); }
        }
        if (MODE == 2) {
            u32x2 GT[4];
            {
#pragma unroll
                for (int k2 = 0; k2 < 2; ++k2) *(LAS u32x4*)(VI + fr * 128 + 64 * k2 + 16 * g) = gq[k2];
                tr_read4_off<13824, 13824 + 32, 13824 + 64, 13824 + 96>(trb, GT);
            }
#pragma unroll
            for (int r = 0; r < 4; ++r) {
                const float mean = row_sum_f(Yt[0][r] + Yt[1][r] + Yt[2][r] + Yt[3][r]) * (1.0f / 64.0f);
                const float d0 = Yt[0][r] - mean, d1 = Yt[1][r] - mean, d2 = Yt[2][r] - mean, d3 = Yt[3][r] - mean;
                const float rstd = rsqrtf(row_sum_f(d0 * d0 + d1 * d1 + d2 * d2 + d3 * d3) * (1.0f / 64.0f) + 64e-5f);
                const float bc = __shfl(bcoef, 4 * g + r); const float dd_[4] = {d0, d1, d2, d3}; const size_t ro = (t0 + 4 * gl_ + r) * 1024 + h * 64 + frl;
#pragma unroll
                for (int vt = 0; vt < 4; ++vt) { const unsigned gw2 = r < 2 ? GT[vt].x : GT[vt].y, vw2 = r < 2 ? VT[vt].x : VT[vt].y; const float gate = (r & 1) ? bfhi(gw2) : bflo(gw2), vval = (r & 1) ? bfhi(vw2) : bflo(vw2);
                    yo[ro + 16 * vt] = (bf16_t)f2bf((dd_[vt] * rstd * in19[h * 64 + 16 * vt + frl] + in20[h * 64 + 16 * vt + frl] + bc * vval) * gate); }
            }
        }
        {
            u32x2 db[4], dk[4], dd[8];
            tr_read4_off<9216, 9216 + 32, 9216 + 64, 9216 + 96>(trb, db); tr_read4_off<11264, 11264 + 32, 11264 + 64, 11264 + 96>(trb, dk);
#pragma unroll
            for (int kt = 0; kt < 4; ++kt) { dd[2 * kt] = db[kt]; dd[2 * kt + 1] = dk[kt]; }
            f32x4 gl[4];
#pragma unroll
            for (int kt = 0; kt < 4; ++kt) gl[kt] = *(const LAS f32x4*)(CL + 16 * kt + 4 * g);
#pragma unroll
            for (int vt = 0; vt < 4; ++vt) { const bf16x8 Af = frag_pack_raw(Zt[vt], VT[vt]);
#pragma unroll
                for (int kt = 0; kt < 4; ++kt) { u32x4 bw; bw.x = dd[2 * kt].x; bw.y = dd[2 * kt].y; bw.z = dd[2 * kt + 1].x; bw.w = dd[2 * kt + 1].y;
                    S[vt][kt] = __builtin_amdgcn_mfma_f32_16x16x32_bf16(__builtin_bit_cast(bf16x8, bw), Af, S[vt][kt], 0, 0, 0) * gl[kt]; } }
        }
    }
    if (MODE != 2) { float* dst = PQ + ((size_t)((bh * RCH + ch) * 2 + MODE)) * 4096 + fr * 64 + 4 * g;
#pragma unroll
        for (int vt = 0; vt < 4; ++vt)
#pragma unroll
            for (int kt = 0; kt < 4; ++kt) *(f32x4*)(dst + vt * 1024 + 16 * kt) = S[vt][kt]; }
}
__device__ __forceinline__ void p4_rwkv_pass1(const Ctx& C) {
    for (int task = C.gw; task < 32 * (RCH - 1) * 2; task += C.ngw) { const int mode = task & 1, rr = task >> 1, ch = rr % (RCH - 1), bh = rr / (RCH - 1);
        if (mode == 0) rwm_task<0>(C, bh, ch); else rwm_task<1>(C, bh, ch); }
}
__device__ __forceinline__ void p6_rwkv_pass3(const Ctx& C) {
    for (int task = (int)blockIdx.x + C.G * C.wave; task < 32 * RCH; task += C.G * NWAVES) rwm_task<2>(C, task / RCH, task % RCH);
}
__device__ __forceinline__ void p5_rwkv_carry(const Ctx& C) {
    float* PQ = (float*)(C.dout + DO_PQ); const int lane = C.lane, wave = C.wave, tid = C.tid;
    LAS float* ST = (LAS float*)C.lds;
    LAS float* PL = (LAS float*)(C.lds + 32768);
    for (int bh = blockIdx.x; bh < 32; bh += C.G) {
        for (int i = tid; i < 4096; i += NTHREADS) ST[i] = 0.f;
        const float* base = PQ + (size_t)(bh * RCH) * 2 * 4096;
        f32x4 pa = *(const f32x4*)(base + 4096 + tid * 8), pb = *(const f32x4*)(base + 4096 + tid * 8 + 4);
        f32x4 q0 = *(const f32x4*)(base + lane * 64 + 8 * wave), q1 = *(const f32x4*)(base + lane * 64 + 8 * wave + 4);
        __syncthreads();
        for (int ch = 0; ch < RCH - 1; ++ch) {
            LAS float* cur = ST + (ch & 1) * 4096; LAS float* nxt = ST + ((ch + 1) & 1) * 4096;
            float* Q = PQ + ((size_t)((bh * RCH + ch) * 2)) * 4096;
            *(LAS f32x4*)(PL + tid * 8) = pa; *(LAS f32x4*)(PL + tid * 8 + 4) = pb;
            float acc[8] = {q0.x, q0.y, q0.z, q0.w, q1.x, q1.y, q1.z, q1.w};
            __syncthreads();
            const int cn = ch + 1 < RCH - 1 ? ch + 1 : ch; const float* nb = PQ + ((size_t)((bh * RCH + cn) * 2)) * 4096;
            pa = *(const f32x4*)(nb + 4096 + tid * 8); pb = *(const f32x4*)(nb + 4096 + tid * 8 + 4);
            q0 = *(const f32x4*)(nb + lane * 64 + 8 * wave); q1 = *(const f32x4*)(nb + lane * 64 + 8 * wave + 4);
#pragma unroll 8
            for (int j = 0; j < 64; ++j) { const float sj = cur[j * 64 + lane]; const f32x4 p0 = *(const LAS f32x4*)(PL + j * 64 + 8 * wave), p1 = *(const LAS f32x4*)(PL + j * 64 + 8 * wave + 4);
                acc[0] = fmaf(sj, p0.x, acc[0]); acc[1] = fmaf(sj, p0.y, acc[1]); acc[2] = fmaf(sj, p0.z, acc[2]); acc[3] = fmaf(sj, p0.w, acc[3]);
                acc[4] = fmaf(sj, p1.x, acc[4]); acc[5] = fmaf(sj, p1.y, acc[5]); acc[6] = fmaf(sj, p1.z, acc[6]); acc[7] = fmaf(sj, p1.w, acc[7]); }
            *(f32x4*)(Q + lane * 64 + 8 * wave) = (f32x4){acc[0], acc[1], acc[2], acc[3]}; *(f32x4*)(Q + lane * 64 + 8 * wave + 4) = (f32x4){acc[4], acc[5], acc[6], acc[7]};
#pragma unroll
            for (int kk = 0; kk < 8; ++kk) nxt[(8 * wave + kk) * 64 + lane] = acc[kk];
            __syncthreads();
        }
    }
}

__device__ __forceinline__ void p8_ln1(const Ctx& C) {
    const bf16_t* pre = (const bf16_t*)(C.dout + 32 * MiB); bf16_t* x1b = (bf16_t*)(C.ws + WS_X1B); const int lane = C.lane;
    const float* gam = C.in[26]; const float* bet = C.in[27];
    for (int t = C.gw; t < T; t += C.ngw) {
        const bf16_t* p = pre + (size_t)t * 1024 + 16 * lane; float v[16];
        unpack8(*(const u32x4*)p, v); unpack8(*(const u32x4*)(p + 8), v + 8);
        float s = 0.f;
#pragma unroll
        for (int j = 0; j < 16; ++j) s += v[j];
        const float mean = wave_sum(s) * (1.0f / 1024.0f); float s2 = 0.f;
#pragma unroll
        for (int j = 0; j < 16; ++j) { v[j] -= mean; s2 += v[j] * v[j]; }
        const float rstd = rsqrtf(wave_sum(s2) * (1.0f / 1024.0f) + 1e-5f);
        float o[16];
#pragma unroll
        for (int q = 0; q < 4; ++q) { const f32x4 gm = *(const f32x4*)(gam + 16 * lane + 4 * q), bt = *(const f32x4*)(bet + 16 * lane + 4 * q);
            o[4 * q] = v[4 * q] * rstd * gm.x + bt.x; o[4 * q + 1] = v[4 * q + 1] * rstd * gm.y + bt.y; o[4 * q + 2] = v[4 * q + 2] * rstd * gm.z + bt.z; o[4 * q + 3] = v[4 * q + 3] * rstd * gm.w + bt.w; }
        *(u32x4*)(x1b + (size_t)t * 1024 + 16 * lane) = pack8(o); *(u32x4*)(x1b + (size_t)t * 1024 + 16 * lane + 8) = pack8(o + 8);
    }
    cvt_rows_fp8<true>(G_(C.in[31]), C.ws + WS_VB, (size_t)16384 * 1024 / 16, PEER_V_SCALE, C.gt, C.ngt);
}

#define CE_DESC(a, b) do { const unsigned hi_ = k[a] > k[b] ? k[a] : k[b], lo_ = k[a] > k[b] ? k[b] : k[a]; k[a] = hi_; k[b] = lo_; } while (0)
__device__ __forceinline__ unsigned pop16_of8(unsigned (&k)[8], int fr) {
    CE_DESC(0, 1); CE_DESC(2, 3); CE_DESC(4, 5); CE_DESC(6, 7); CE_DESC(0, 2); CE_DESC(1, 3); CE_DESC(4, 6); CE_DESC(5, 7); CE_DESC(1, 2); CE_DESC(5, 6);
    CE_DESC(0, 4); CE_DESC(1, 5); CE_DESC(2, 6); CE_DESC(3, 7); CE_DESC(2, 4); CE_DESC(3, 5); CE_DESC(1, 2); CE_DESC(3, 4); CE_DESC(5, 6);
    unsigned res = 0u;
#pragma unroll
    for (int rd = 0; rd < 16; ++rd) {
        const unsigned m = row_max_u(k[0]); const bool mine = (k[0] == m);
#pragma unroll
        for (int j = 0; j < 7; ++j) k[j] = mine ? k[j + 1] : k[j];
        k[7] = mine ? 0u : k[7];
        res = (fr == rd) ? m : res;
    }
    return res;
}
__device__ __forceinline__ unsigned pop16_of4(unsigned (&k)[4], int fr) {
    CE_DESC(0, 1); CE_DESC(2, 3); CE_DESC(0, 2); CE_DESC(1, 3); CE_DESC(1, 2);
    unsigned res = 0u;
#pragma unroll
    for (int rd = 0; rd < 16; ++rd) {
        const unsigned m = row_max_u(k[0]); const bool mine = (k[0] == m);
        k[0] = mine ? k[1] : k[0]; k[1] = mine ? k[2] : k[1]; k[2] = mine ? k[3] : k[2]; k[3] = mine ? 0u : k[3];
        res = (fr == rd) ? m : res;
    }
    return res;
}
__device__ const unsigned char CAND_AB[64] = {
    0x00, 0x01, 0x02, 0x03, 0x04, 0x05, 0x06, 0x07, 0x08, 0x09, 0x0a, 0x0b, 0x0c, 0x0d, 0x0e, 0x0f,
    0x10, 0x11, 0x12, 0x13, 0x14, 0x15, 0x16, 0x17, 0x20, 0x21, 0x22, 0x23, 0x24, 0x30, 0x31, 0x32,
    0x33, 0x40, 0x41, 0x42, 0x50, 0x51, 0x60, 0x61, 0x70, 0x71, 0x80, 0x90, 0xa0, 0xb0, 0xc0, 0xd0,
    0xe0, 0xf0, 0xff, 0xff, 0xff, 0xff, 0xff, 0xff, 0xff, 0xff, 0xff, 0xff, 0xff, 0xff, 0xff, 0xff};
__device__ __forceinline__ void p10_peer_route(const Ctx& C) {
    unsigned char* ws = C.ws; const int lane = C.lane, g = lane >> 4, fr = lane & 15;
    const bf16_t* qp = (const bf16_t*)C.dout; const bf16_t* keys = (const bf16_t*)(ws + WS_KEYS);
    int* experts = (int*)(ws + WS_EXPERTS); float* pgates = (float*)(ws + WS_PGATES);
    const unsigned cand4 = *(const unsigned*)(CAND_AB + 4 * fr);
    LAS unsigned char* KL = C.lds;
#pragma unroll
    for (int pp = 0; pp < 8; ++pp) { const int p = C.wave + 8 * pp; const int row = 4 * p + g; const int c = fr ^ (2 * (row & 7));
        __builtin_amdgcn_global_load_lds((const unsigned*)((const char*)keys + row * 256 + 16 * c), (LAS unsigned*)(KL + 1024 * p), 16, 0, 0); }
    asm volatile("s_waitcnt vmcnt(0)" ::: "memory");
    __syncthreads();
    for (int task = C.gw; task < T / 2; task += C.ngw) {
        const int t0 = task * 2;
        unsigned sel[2][4];
#pragma unroll
        for (int p = 0; p < 2; ++p) {
            bf16x8 A[4];
#pragma unroll
            for (int kk = 0; kk < 4; ++kk) A[kk] = *(const bf16x8*)(qp + (size_t)(t0 + (fr >> 3)) * 2048 + (fr & 7) * 256 + p * 128 + 32 * kk + 8 * g);
            f32x4 acc[8];
#pragma unroll
            for (int i = 0; i < 8; ++i) { if ((i & 1) == 0) __builtin_amdgcn_sched_barrier(0); acc[i] = (f32x4){0.f, 0.f, 0.f, 0.f};
#pragma unroll
                for (int kk = 0; kk < 4; ++kk) { const int row = p * 128 + 16 * i + fr; const bf16x8 Bk = *(const LAS bf16x8*)(KL + row * 256 + 16 * ((4 * kk + g) ^ (2 * (row & 7))));
                    acc[i] = __builtin_amdgcn_mfma_f32_16x16x32_bf16(A[kk], Bk, acc[i], 0, 0, 0); } }
#pragma unroll
            for (int r = 0; r < 4; ++r) { __builtin_amdgcn_sched_barrier(0); unsigned k[8];
#pragma unroll
                for (int i = 0; i < 8; ++i) k[i] = (f2key(acc[i][r]) & 0xffffff80u) | (unsigned)(16 * i + fr);
                sel[p][r] = pop16_of8(k, fr); }
        }
#pragma unroll
        for (int r = 0; r < 4; ++r) {
            __builtin_amdgcn_sched_barrier(0);
            const float s1 = key2f(sel[0][r] & 0xffffff80u), s2 = key2f(sel[1][r] & 0xffffff80u);
            unsigned k[4];
#pragma unroll
            for (int j = 0; j < 4; ++j) {
                const unsigned ab = (cand4 >> (8 * j)) & 0xffu; const unsigned msk = ab == 0xffu ? 0u : 0xffffffffu;
                const float va = __builtin_bit_cast(float, __builtin_amdgcn_ds_bpermute((int)(4u * (16u * g + (ab >> 4))), __builtin_bit_cast(int, s1)));
                const float vb = __builtin_bit_cast(float, __builtin_amdgcn_ds_bpermute((int)(4u * (16u * g + (ab & 15u))), __builtin_bit_cast(int, s2)));
                k[j] = ((f2key(va + vb) & 0xffffff00u) | ab) & msk;
            }
            const unsigned top = pop16_of4(k, fr);
            const int a = (int)((top >> 4) & 15u), b = (int)(top & 15u);
            const int i1 = __builtin_amdgcn_ds_bpermute(4 * (16 * g + a), (int)(sel[0][r] & 0x7fu));
            const int i2 = __builtin_amdgcn_ds_bpermute(4 * (16 * g + b), (int)(sel[1][r] & 0x7fu));
            const float sc = key2f(top & 0xffffff00u);
            const float mx = key2f(row_max_u(top) & 0xffffff00u);
            const float ev = __expf(sc - mx); const float sm = row_sum_f(ev);
            const int row = 4 * g + r; const size_t o = (size_t)(t0 + (row >> 3)) * 128 + (row & 7) * 16 + fr;
            experts[o] = i1 * 128 + i2; pgates[o] = ev / sm;
        }
    }
}
#undef CE_DESC

__device__ __forceinline__ float gelu_erf(float x) { return 0.5f * x * (1.0f + erff(x * 0.7071067811865476f)); }
typedef __bf16 bf2_t __attribute__((ext_vector_type(2)));
__device__ __forceinline__ unsigned fp8x2_to_bf16x2(unsigned w, bool hi) { return hi ? __builtin_bit_cast(unsigned, __builtin_amdgcn_cvt_scalef32_pk_bf16_fp8(w, 1.0f, true)) : __builtin_bit_cast(unsigned, __builtin_amdgcn_cvt_scalef32_pk_bf16_fp8(w, 1.0f, false)); }
constexpr size_t WS_EC = 101 * MiB + 8 * MiB;
constexpr size_t WS_Y2 = 61 * MiB;
constexpr size_t WS_STAT = 125 * MiB;
constexpr int CW_PV = 512;
typedef _Float16 f16x2_t __attribute__((ext_vector_type(2)));
__device__ __forceinline__ unsigned h2splat(float v) { const _Float16 h = (_Float16)v; return __builtin_bit_cast(unsigned, (f16x2_t){h, h}); }
__device__ __forceinline__ void p11_peer_u(const Ctx& C) {
    unsigned char* ws = C.ws; const int lane = C.lane, g = lane >> 4, fr = lane & 15;
    const bf16_t* x1b = (const bf16_t*)(ws + WS_X1B); const unsigned char* ub = ws + WS_UB;
    const int* experts = (const int*)(ws + WS_EXPERTS); const float* pgates = (const float*)(ws + WS_PGATES); unsigned char* ecb = ws + WS_EC;
    LAS unsigned char* my = C.lds + C.wave * 4096;
    LAS int* eidl = (LAS int*)(my + 2560);
    for (int t = C.gw; t < T; t += C.ngw) {
        { const u32x4 a = *(const u32x4*)(x1b + (size_t)t * 1024 + 16 * lane), b = *(const u32x4*)(x1b + (size_t)t * 1024 + 16 * lane + 8);
          *(LAS u32x4*)(my + 32 * lane) = a; *(LAS u32x4*)(my + 32 * lane + 16) = b; }
        { const int e0 = experts[(size_t)t * 128 + lane], e1 = experts[(size_t)t * 128 + 64 + lane]; eidl[lane] = e0; eidl[64 + lane] = e1; }
        asm volatile("s_waitcnt lgkmcnt(0)" ::: "memory");
#pragma unroll 1
        for (int i = 0; i < 8; ++i) {
            const int e = eidl[16 * i + fr]; const unsigned char* urow = ub + (size_t)e * 1024 + 16 * g;
            f32x4 acc = (f32x4){0.f, 0.f, 0.f, 0.f};
#pragma unroll 4
            for (int m = 0; m < 16; ++m) {
                const u32x4 raw = *(const u32x4*)(urow + 64 * m);
                u32x4 a0, a1; a0.x = fp8x2_to_bf16x2(raw.x, false); a0.y = fp8x2_to_bf16x2(raw.x, true); a0.z = fp8x2_to_bf16x2(raw.y, false); a0.w = fp8x2_to_bf16x2(raw.y, true);
                a1.x = fp8x2_to_bf16x2(raw.z, false); a1.y = fp8x2_to_bf16x2(raw.z, true); a1.z = fp8x2_to_bf16x2(raw.w, false); a1.w = fp8x2_to_bf16x2(raw.w, true);
                const bf16x8 b0 = *(const LAS bf16x8*)(my + 2 * (64 * m + 16 * g)), b1 = *(const LAS bf16x8*)(my + 2 * (64 * m + 16 * g + 8));
                acc = __builtin_amdgcn_mfma_f32_16x16x32_bf16(__builtin_bit_cast(bf16x8, a0), b0, acc, 0, 0, 0);
                acc = __builtin_amdgcn_mfma_f32_16x16x32_bf16(__builtin_bit_cast(bf16x8, a1), b1, acc, 0, 0, 0);
            }
            const f32x4 pg = *(const f32x4*)(pgates + (size_t)t * 128 + 16 * i + 4 * g);
            constexpr float us = 1.0f / PEER_U_SCALE, vs = 64.0f / PEER_V_SCALE;
            if (fr == 0) { const int k0 = 16 * i + 4 * g; u32x4 w0, w1;
                w0.x = (unsigned)eidl[k0]; w0.y = h2splat(vs * pg.x * gelu_erf(acc[0] * us)); w0.z = (unsigned)eidl[k0 + 1]; w0.w = h2splat(vs * pg.y * gelu_erf(acc[1] * us));
                w1.x = (unsigned)eidl[k0 + 2]; w1.y = h2splat(vs * pg.z * gelu_erf(acc[2] * us)); w1.z = (unsigned)eidl[k0 + 3]; w1.w = h2splat(vs * pg.w * gelu_erf(acc[3] * us));
                *(u32x4*)(ecb + ((size_t)t * 128 + k0) * 8) = w0; *(u32x4*)(ecb + ((size_t)t * 128 + k0) * 8 + 16) = w1; }
        }
    }
}
constexpr int PV_NT = 4;
struct PvRows { u32x4 r[16]; unsigned c[16]; unsigned xr; };
__device__ __forceinline__ void pv_load(PvRows& R, LAS const unsigned char* ecl, const unsigned char* vbx, const bf16_t* xp) {
#pragma unroll
    for (int j = 0; j < 16; ++j) { const u32x2 ec = *(LAS const u32x2*)(ecl + 64 * j); R.r[j] = *(const u32x4*)(vbx + (size_t)ec.x * 128); R.c[j] = ec.y; }
    R.xr = *(const unsigned*)xp;
}
__device__ __forceinline__ void pv_compute(const PvRows& R, bf16_t* yp, float* stp, int lane) {
    f16x2_t o2[8];
#pragma unroll
    for (int j = 0; j < 8; ++j) o2[j] = (f16x2_t){(_Float16)0.f, (_Float16)0.f};
#pragma unroll
    for (int j = 0; j < 16; ++j) {
        const f16x2_t cc = __builtin_bit_cast(f16x2_t, R.c[j]); const unsigned rw[4] = {R.r[j].x, R.r[j].y, R.r[j].z, R.r[j].w};
#pragma unroll
        for (int q = 0; q < 4; ++q) { const f16x2_t lo = __builtin_amdgcn_cvt_scalef32_pk_f16_fp8(rw[q], 1.0f, false), hi = __builtin_amdgcn_cvt_scalef32_pk_f16_fp8(rw[q], 1.0f, true);
            o2[2 * q] = __builtin_elementwise_fma(cc, lo, o2[2 * q]); o2[2 * q + 1] = __builtin_elementwise_fma(cc, hi, o2[2 * q + 1]); }
    }
    float o[16];
#pragma unroll
    for (int j = 0; j < 8; ++j) { o[2 * j] = (float)o2[j].x; o[2 * j + 1] = (float)o2[j].y; }
    float p[8];
#pragma unroll
    for (int d = 0; d < 8; ++d) { const auto s = __builtin_amdgcn_permlane32_swap(__float_as_uint(o[d]), __float_as_uint(o[d + 8]), false, false); p[d] = __uint_as_float(s[0]) + __uint_as_float(s[1]); }
    float q4[4];
#pragma unroll
    for (int d = 0; d < 4; ++d) { const auto s = __builtin_amdgcn_permlane16_swap(__float_as_uint(p[d]), __float_as_uint(p[d + 4]), false, false); q4[d] = __uint_as_float(s[0]) + __uint_as_float(s[1]); }
#pragma unroll
    for (int d = 0; d < 4; ++d) q4[d] += __uint_as_float((unsigned)__builtin_amdgcn_update_dpp(0, (int)__float_as_uint(q4[d]), 0x128, 0xf, 0xf, false));
    const bool b3 = (lane & 8) != 0;
    const float y0 = fmaf(b3 ? q4[2] : q4[0], 1.0f / 64.0f, ALPHA * bflo(R.xr)), y1 = fmaf(b3 ? q4[3] : q4[1], 1.0f / 64.0f, ALPHA * bfhi(R.xr));
    *(unsigned*)yp = pk2(y0, y1);
    const float s1 = wave_sum(y0 + y1), s2 = wave_sum(y0 * y0 + y1 * y1);
    if (lane == 0) *(f32x2*)stp = (f32x2){s1, s2};
}
__device__ __forceinline__ void p11_peer_v(const Ctx& C, int rep_) {
    unsigned char* ws = C.ws; const int lane = C.lane, rg = lane >> 3, ck = lane & 7;
    const bf16_t* x1b = (const bf16_t*)(ws + WS_X1B); const unsigned char* vb = ws + WS_VB; const unsigned char* ecb = ws + WS_EC;
    bf16_t* y2 = (bf16_t*)(ws + WS_Y2); float* stat = (float*)(ws + WS_STAT); unsigned* qv = (unsigned*)(ws + WS_CTL) + CW_PV + 32 * rep_;
    LAS unsigned char* my = C.lds + C.wave * 4096;
    const int colo = 16 * ck + 4 * (lane >> 4) + ((lane & 8) ? 2 : 0);
    const int x0 = (int)(xb_xcc_id() & 7u);
    for (int xo = 0; xo < 8; ++xo) {
        const int x = (x0 + xo) & 7;
        if (xo) { unsigned hd = 0; if (lane == 0) hd = __hip_atomic_load(qv + 64 * x, __ATOMIC_RELAXED, __HIP_MEMORY_SCOPE_AGENT); if ((int)__builtin_amdgcn_readfirstlane(hd) >= T) continue; }
        const unsigned char* vbx = vb + ((size_t)x << 21) + 16 * ck; const int cx = 128 * x + colo;
        int tc, tn;
        { int a = 0; if (lane == 0) a = (int)__hip_atomic_fetch_add(qv + 64 * x, (unsigned)(2 * PV_NT), __ATOMIC_RELAXED, __HIP_MEMORY_SCOPE_AGENT); tc = __builtin_amdgcn_readfirstlane(a); tn = tc + PV_NT; }
        u32x4 s[PV_NT];
        if (tc < T) {
#pragma unroll
            for (int q = 0; q < PV_NT; ++q) s[q] = *(const u32x4*)(ecb + (size_t)(tc + q) * 1024 + 16 * lane);
        }
        while (tc < T) {
#pragma unroll
            for (int q = 0; q < PV_NT; ++q) *(LAS u32x4*)(my + 1024 * q + 16 * lane) = s[q];
            int a = 0; if (lane == 0) a = (int)__hip_atomic_fetch_add(qv + 64 * x, (unsigned)PV_NT, __ATOMIC_RELAXED, __HIP_MEMORY_SCOPE_AGENT);
            { const int tl = tn < T ? tn : T - PV_NT;
#pragma unroll
              for (int q = 0; q < PV_NT; ++q) s[q] = *(const u32x4*)(ecb + (size_t)(tl + q) * 1024 + 16 * lane); }
            PvRows Ra, Rb;
            pv_load(Ra, my + 8 * rg, vbx, x1b + (size_t)tc * 1024 + cx);
            __builtin_amdgcn_sched_barrier(0);
#pragma unroll
            for (int tt = 0; tt < PV_NT; tt += 2) {
                pv_load(Rb, my + 1024 * (tt + 1) + 8 * rg, vbx, x1b + (size_t)(tc + tt + 1) * 1024 + cx);
                __builtin_amdgcn_sched_barrier(0);
                pv_compute(Ra, y2 + (size_t)(tc + tt) * 1024 + cx, stat + ((size_t)(tc + tt) * 8 + x) * 2, lane);
                __builtin_amdgcn_sched_barrier(0);
                if (tt + 2 < PV_NT) pv_load(Ra, my + 1024 * (tt + 2) + 8 * rg, vbx, x1b + (size_t)(tc + tt + 2) * 1024 + cx);
                __builtin_amdgcn_sched_barrier(0);
                pv_compute(Rb, y2 + (size_t)(tc + tt + 1) * 1024 + cx, stat + ((size_t)(tc + tt + 1) * 8 + x) * 2, lane);
                __builtin_amdgcn_sched_barrier(0);
            }
            tc = tn; tn = __builtin_amdgcn_readfirstlane(a);
        }
    }
}
__device__ __forceinline__ void p11_peer_ln2(const Ctx& C) {
    unsigned char* ws = C.ws; const int lane = C.lane; const bf16_t* y2 = (const bf16_t*)(ws + WS_Y2); const float* stat = (const float*)(ws + WS_STAT);
    float* out = (float*)C.dout; const float* gam = C.in[32]; const float* bet = C.in[33];
    for (int t = C.gw; t < T; t += C.ngw) {
        float s1 = 0.f, s2 = 0.f;
        if (lane < 8) { const f32x2 v = *(const f32x2*)(stat + ((size_t)t * 8 + lane) * 2); s1 = v.x; s2 = v.y; }
        s1 = wave_sum(s1); s2 = wave_sum(s2);
        const float mean = s1 * (1.0f / 1024.0f); const float var = fmaxf(s2 * (1.0f / 1024.0f) - mean * mean, 0.f); const float rstd = rsqrtf(var + 1e-5f);
        float o[16]; const bf16_t* yp = y2 + (size_t)t * 1024 + 16 * lane; unpack8(*(const u32x4*)yp, o); unpack8(*(const u32x4*)(yp + 8), o + 8);
#pragma unroll
        for (int q = 0; q < 4; ++q) { const int c0 = 16 * lane + 4 * q; const f32x4 gm = *(const f32x4*)(gam + c0), bt = *(const f32x4*)(bet + c0);
            *(f32x4*)(out + (size_t)t * 1024 + c0) = (f32x4){(o[4 * q] - mean) * rstd * gm.x + bt.x, (o[4 * q + 1] - mean) * rstd * gm.y + bt.y, (o[4 * q + 2] - mean) * rstd * gm.z + bt.z, (o[4 * q + 3] - mean) * rstd * gm.w + bt.w}; }
    }
}

constexpr int LDS_BYTES = 147456;
constexpr int LDS_MISC = 131072 + 256;
constexpr int NPHASE = 16;
constexpr int CW_BAR = 4096;

__global__ void __launch_bounds__(NTHREADS, 2) hybrid_fwd(Args args) {
    extern __shared__ __attribute__((aligned(16))) unsigned char lds_raw[];
    Ctx C;
    C.lds = (LAS unsigned char*)lds_raw;
    C.tid = threadIdx.x; C.lane = C.tid & 63; C.wave = __builtin_amdgcn_readfirstlane(C.tid >> 6);
    C.G = gridDim.x; C.gw = blockIdx.x * NWAVES + C.wave; C.ngw = C.G * NWAVES; C.gt = blockIdx.x * NTHREADS + C.tid; C.ngt = C.G * NTHREADS;
    C.in = args.in; C.ws = args.ws; C.dout = (unsigned char*)args.out;
    unsigned char* ws = args.ws; const float* const* in = args.in;
    volatile LAS unsigned* MISC = (volatile LAS unsigned*)(C.lds + LDS_MISC);
    if (C.tid < 64) MISC[C.tid] = 0u;
    __syncthreads();
    XcdBarrier bar; bar.bar = (unsigned*)(ws + WS_CTL) + CW_BAR; bar.x = 0; bar.st = nullptr;
    if (MK_N_LAUNCHES == 1) bar = xcd_barrier_post((unsigned*)(ws + WS_CTL) + CW_BAR, MISC + 8);
    const int lo = args.ph_lo, hi = args.ph_hi;
#define IN(k) (lo <= (k) && (k) < hi)
#define SEAM(k) do { if (IN(k) && IN((k) + 1)) xcd_barrier(bar); } while (0)
#define REP(k) for (int rep_ = 0; rep_ < (((PROBE_MASK >> (k)) & 1) ? 2 : 1); ++rep_)
    bf16_t* xb = (bf16_t*)(C.dout + DO_XB);

    if (IN(0)) REP(0) { p0_prologue(C); } SEAM(0);
    if (IN(1)) REP(1) {
        { pg8::Gemm gm{xb, (const bf16_t*)(ws + WS_WIN), T, 2816, 1024}; pg8::StaticOrder S; S.init(T, 2816, C.G, (int)blockIdx.x);
          EpiP1 E{(float*)(ws + WS_CSMALL), (bf16_t*)(ws + WS_RCOLS), (bf16_t*)(ws + WS_MEMQ)}; pg8::gemm_phase(C.lds, gm, S, E); }
        {
          const int nfull = (T / 256) * 11 % C.G; const int c2 = ((int)blockIdx.x - nfull + C.G) % C.G;
          pg8::Gemm gm{(const bf16_t*)(ws + WS_MEMB), (const bf16_t*)(ws + WS_WMEMKV), 1024, 1024, 1024}; pg8::StaticOrder S; S.init(1024, 1024, C.G, c2);
          EpiMemKV E{(bf16_t*)(ws + WS_KMEM), (bf16_t*)(ws + WS_VMEMT)}; pg8::gemm_phase(C.lds, gm, S, E); }
    } SEAM(1);
    if (IN(2)) REP(2) { p2_prep(C); } SEAM(2);
    if (IN(3)) REP(3) {
        { pg8::Gemm gm{(const bf16_t*)(ws + WS_LORAA), (const bf16_t*)(ws + WS_WLORA), T, 1536, 256}; pg8::StaticOrder S; S.init(T, 1536, C.G, (int)blockIdx.x);
          EpiLora E{(bf16_t*)(ws + WS_RW_E), (bf16_t*)(ws + WS_RW_A), (bf16_t*)(ws + WS_RW_G), in[11], in[13]}; pg8::gemm_phase(C.lds, gm, S, E); }
        { pg8::Gemm gm{(const bf16_t*)(ws + WS_CQN), (const bf16_t*)(ws + WS_WQ), T, 1280, 256}; pg8::StaticOrder S; S.init(T, 1280, C.G, C.G - 1 - (int)blockIdx.x);
          EpiQ E{(bf16_t*)(ws + WS_QLAT), (bf16_t*)(ws + WS_QIDX)}; pg8::gemm_phase(C.lds, gm, S, E); }
    } SEAM(3);
    if (IN(4)) { REP(17) { p4_indexer(C); } REP(18) { p4_memattn(C); } __syncthreads(); REP(19) { p4_rwkv_pass1(C); } } SEAM(4);
    if (IN(5)) { p5_rwkv_carry(C); __syncthreads(); REP(5) { p5_dsa_attn(C, rep_); } } SEAM(5);
    if (IN(6)) REP(6) { p6_rwkv_pass3(C); p6_late_weights(C); } SEAM(6);
    if (IN(7)) REP(7) {
        pg8::Gemm gm{xb, (const bf16_t*)(ws + WS_WG), T, 3072, 1024}; pg8::StaticOrder S; S.init(T, 3072, C.G, (int)blockIdx.x);
        EpiGates E{(bf16_t*)(ws + WS_GATES)}; pg8::gemm_phase(C.lds, gm, S, E);
    } SEAM(7);
    if (IN(8)) REP(8) {
        pg8::GemmM gm{(const bf16_t*)(ws + WS_OLAT), (const bf16_t*)(ws + WS_YM), (const bf16_t*)(ws + WS_WOV), T, 1024}; pg8::StaticOrder S; S.init(T, 1024, C.G, (int)blockIdx.x);
        MergeHook H{(const bf16_t*)(ws + WS_GATES), (bf16_t*)C.dout}; pg8::gemm_phase_merge(C.lds, gm, S, H);
    } SEAM(8);
    if (IN(9)) REP(9) {
        pg8::Gemm gm{(const bf16_t*)C.dout, (const bf16_t*)(ws + WS_WOUT), T, 1024, 1024}; pg8::StaticOrder S; S.init(T, 1024, C.G, (int)blockIdx.x);
        EpiWout E{G_(in[0]), (bf16_t*)(C.dout + 32 * MiB)}; pg8::gemm_phase(C.lds, gm, S, E);
    } SEAM(9);
    if (IN(10)) REP(10) { p8_ln1(C); } SEAM(10);
    if (IN(11)) REP(11) {
        pg8::Gemm gm{(const bf16_t*)(ws + WS_X1B), (const bf16_t*)(ws + WS_WPEER), T, 2048, 1024}; pg8::StaticOrder S; S.init(T, 2048, C.G, (int)blockIdx.x);
        EpiPeerQ E{(bf16_t*)C.dout}; pg8::gemm_phase(C.lds, gm, S, E);
    } SEAM(11);
    if (IN(12)) REP(12) { p10_peer_route(C); } SEAM(12);
    if (IN(13)) REP(13) { p11_peer_u(C); } SEAM(13);
    if (IN(14)) REP(14) { p11_peer_v(C, rep_); } SEAM(14);
    if (IN(15)) { p11_peer_ln2(C); }
#undef IN
#undef SEAM
}

extern "C" void kernel_launch(void* const* d_in, const int* in_sizes, int n_in, void* d_out, int out_size, void* d_ws, size_t ws_size, hipStream_t stream) {
    static int grid = 0;
    if (grid == 0) {
        if (n_in != 34 || out_size != T * D || ws_size < WS_END) { fprintf(stderr, "kernel_launch: unexpected problem (n_in %d out %d ws %zu)\n", n_in, out_size, ws_size); grid = -1; return; }
        int dev = 0, cus = 0, per_cu = 0;
        if (hipGetDevice(&dev) != hipSuccess || hipDeviceGetAttribute(&cus, hipDeviceAttributeMultiprocessorCount, dev) != hipSuccess) { grid = -1; return; }
        if (hipFuncSetAttribute((const void*)hybrid_fwd, hipFuncAttributeMaxDynamicSharedMemorySize, LDS_BYTES) != hipSuccess) { fprintf(stderr, "kernel_launch: hipFuncSetAttribute failed\n"); grid = -1; return; }
        if (hipOccupancyMaxActiveBlocksPerMultiprocessor(&per_cu, (const void*)hybrid_fwd, NTHREADS, LDS_BYTES) != hipSuccess || per_cu < 1) { fprintf(stderr, "kernel_launch: occupancy query says %d\n", per_cu); }
        (void)hipGetLastError();
        grid = cus;
    }
    if (grid < 0) return;
    (void)hipMemsetAsync((char*)d_ws + WS_CTL, 0, 1 * MiB, stream);
    Args a{};
    for (int i = 0; i < 34; ++i) a.in[i] = (const float*)d_in[i];
    a.out = (float*)d_out; a.ws = (unsigned char*)d_ws; a.li = 0; a.pad = 0;
    if (MK_N_LAUNCHES == 1) { a.ph_lo = 0; a.ph_hi = NPHASE; hipLaunchKernelGGL(hybrid_fwd, dim3(grid), dim3(NTHREADS), LDS_BYTES, stream, a); }
    else for (int p = 0; p < NPHASE; ++p) { a.ph_lo = p; a.ph_hi = p + 1; a.li = p; hipLaunchKernelGGL(hybrid_fwd, dim3(grid), dim3(NTHREADS), LDS_BYTES, stream, a); }
}
```

```cpp
#include <hip/hip_runtime.h>
#include <stdint.h>
#include <stdio.h>

#ifndef MK_N_LAUNCHES
#define MK_N_LAUNCHES 1
#endif

#ifndef PROBE_MASK
#define PROBE_MASK 0
#endif
#define LAS __attribute__((address_space(3)))
typedef unsigned short bf16_t;
typedef const __attribute__((address_space(1))) float* gfp;
#define G_(p) ((gfp)(p))
typedef short bf16x8 __attribute__((ext_vector_type(8)));
typedef float f32x4 __attribute__((ext_vector_type(4)));
typedef float f32x2 __attribute__((ext_vector_type(2)));
typedef unsigned u32x4 __attribute__((ext_vector_type(4)));
typedef unsigned u32x2 __attribute__((ext_vector_type(2)));

constexpr int NB = 4, SEQ = 4096, T = NB * SEQ, D = 1024;
constexpr int IN_W = 5800;
constexpr int RW = 512;
constexpr int NWAVES = 8, NTHREADS = 512;
constexpr float ALPHA = 1.189207115002721f;
constexpr int RCH = 32, RL = SEQ / RCH;

constexpr size_t MiB = 1u << 20;
constexpr size_t WS_CTL = 0;
constexpr size_t WS_WIN = 1 * MiB, WS_WG = 7 * MiB, WS_WLORA = 13 * MiB, WS_WQ = 14 * MiB, WS_WMEMKV = 15 * MiB, WS_WOV = 17 * MiB,
                 WS_WBRR = 19 * MiB, WS_WBRM = 20 * MiB, WS_WOUT = 21 * MiB, WS_WPEER = 23 * MiB, WS_KEYS = 27 * MiB;
constexpr size_t WS_CSMALL = 29 * MiB, WS_QLAT = 29 * MiB, WS_MERGEDB = 29 * MiB, WS_UB = 29 * MiB;
constexpr size_t WS_RCOLS = 61 * MiB, WS_QIDX = 61 * MiB, WS_YM = 69 * MiB, WS_OLAT = 101 * MiB, WS_VB = 45 * MiB, WS_EXPERTS = 93 * MiB, WS_PGATES = 101 * MiB;
constexpr size_t WS_MEMQ = 117 * MiB;
constexpr size_t WS_RW_R = 133 * MiB, WS_RW_K = 149 * MiB, WS_RW_V = 165 * MiB, WS_RW_A = 181 * MiB, WS_RW_E = 197 * MiB, WS_RW_G = 213 * MiB;
constexpr size_t WS_GATES = 133 * MiB, WS_X1B = 133 * MiB, WS_X1 = 165 * MiB;
constexpr size_t WS_CQN = 229 * MiB, WS_KVL = 237 * MiB, WS_KIDX = 241 * MiB, WS_WIDX = 242 * MiB, WS_LORAA = 243 * MiB, WS_IDX = 243 * MiB,
                 WS_KMEM = 251 * MiB, WS_VMEMT = 252 * MiB, WS_MEMB = 253 * MiB, WS_END = 256 * MiB;
constexpr size_t DO_XB = 0, DO_PQ = 32 * MiB;
constexpr size_t WS_XB2 = 29 * MiB;
constexpr int CW_DSAQ = 64;

typedef __bf16 bf2_hw __attribute__((ext_vector_type(2)));
__device__ __forceinline__ unsigned f2bf(float f) { return (unsigned)__builtin_bit_cast(unsigned short, (__bf16)f); }
__device__ __forceinline__ unsigned pk2(float lo, float hi) { bf2_hw r; r.x = (__bf16)lo; r.y = (__bf16)hi; return __builtin_bit_cast(unsigned, r); }
__device__ __forceinline__ float bflo(unsigned w) { return __uint_as_float(w << 16); }
__device__ __forceinline__ float bfhi(unsigned w) { return __uint_as_float(w & 0xffff0000u); }
__device__ __forceinline__ float bf1(bf16_t h) { return __uint_as_float(((unsigned)h) << 16); }
template <int CTRL, int RM = 0xF> __device__ __forceinline__ float dpp_f(float v) { return __builtin_bit_cast(float, __builtin_amdgcn_update_dpp(0, __builtin_bit_cast(int, v), CTRL, RM, 0xF, false)); }
template <int CTRL> __device__ __forceinline__ unsigned dpp_u(unsigned v) { return (unsigned)__builtin_amdgcn_update_dpp(0, (int)v, CTRL, 0xF, 0xF, false); }
__device__ __forceinline__ float wave_sum(float v) {
    v += dpp_f<0x111>(v); v += dpp_f<0x112>(v); v += dpp_f<0x114>(v); v += dpp_f<0x118>(v);
    v += dpp_f<0x142, 0xA>(v); v += dpp_f<0x143, 0xC>(v);
    return __builtin_bit_cast(float, __builtin_amdgcn_readlane(__builtin_bit_cast(int, v), 63));
}
__device__ __forceinline__ unsigned row_max_u(unsigned x) {
    unsigned y = dpp_u<0x128>(x); x = x > y ? x : y; y = dpp_u<0x124>(x); x = x > y ? x : y; y = dpp_u<0x122>(x); x = x > y ? x : y; y = dpp_u<0x121>(x); x = x > y ? x : y; return x; }
__device__ __forceinline__ float row_sum_f(float x) { x += dpp_f<0x128>(x); x += dpp_f<0x124>(x); x += dpp_f<0x122>(x); x += dpp_f<0x121>(x); return x; }
__device__ __forceinline__ float key2f(unsigned k) { const unsigned b = (k & 0x80000000u) ? (k & 0x7fffffffu) : ~k; return __uint_as_float(b); }
__device__ __forceinline__ float sigmoidf_(float x) { return 1.0f / (1.0f + __expf(-x)); }
__device__ __forceinline__ unsigned f2key(float f) { unsigned b = __float_as_uint(f); if (f == 0.0f) b = 0u; return (b & 0x80000000u) ? ~b : (b | 0x80000000u); }
__device__ __forceinline__ u32x4 pack8(const float* v) { u32x4 w; w.x = pk2(v[0], v[1]); w.y = pk2(v[2], v[3]); w.z = pk2(v[4], v[5]); w.w = pk2(v[6], v[7]); return w; }
__device__ __forceinline__ void unpack8(u32x4 w, float* v) { v[0] = bflo(w.x); v[1] = bfhi(w.x); v[2] = bflo(w.y); v[3] = bfhi(w.y); v[4] = bflo(w.z); v[5] = bfhi(w.z); v[6] = bflo(w.w); v[7] = bfhi(w.w); }

#define XB_TMO      128
#define XB_XCNT(j)  (256  + 64 * (j))
#define XB_XSUB(j)  (1280 + 64 * (j))
#define XB_XGEN(j)  (2304 + 64 * (j))
#define XB_TOP      3328
#define XB_TOPGEN   3392
#define XCD_BAR_WORDS 3456
#define XB_SPIN_CAP (1u << 18)

__device__ __forceinline__ unsigned xb_ld(unsigned* p)              { return __hip_atomic_load(p, __ATOMIC_RELAXED, __HIP_MEMORY_SCOPE_AGENT); }
__device__ __forceinline__ unsigned xb_add(unsigned* p, unsigned v) { return __hip_atomic_fetch_add(p, v, __ATOMIC_RELAXED, __HIP_MEMORY_SCOPE_AGENT); }
__device__ __forceinline__ unsigned xb_xcc_id() { return (unsigned)__builtin_amdgcn_s_getreg((3 << 11) | 20) & 0xFu; }
#define XB_SPIN(cond, bar) do { unsigned _sp = 0; while (cond) { __builtin_amdgcn_s_sleep(1); \
    if ((++_sp & 255u) == 0u) { if (xb_ld(&(bar)[XB_TMO])) break; if (_sp > XB_SPIN_CAP) { atomicAdd(&(bar)[XB_TMO], 1u); break; } } } } while (0)

struct XcdBarrier {
    unsigned* bar; unsigned x;
    volatile LAS unsigned* st;
};
__device__ __forceinline__ XcdBarrier xcd_barrier_post(unsigned* bar, volatile LAS unsigned* st) {
    XcdBarrier b; b.bar = bar; b.x = xb_xcc_id(); b.st = st;
    if (threadIdx.x == 0) (void)xb_add(&bar[XB_XCNT(b.x)], 1u);
    return b;
}
__device__ __forceinline__ void xcd_barrier_complete(unsigned* bar, unsigned x, unsigned& nloc, unsigned& nx) {
    const unsigned G = gridDim.x * gridDim.y * gridDim.z;
    unsigned sum, cnt, mine, sp = 0u;
    for (;;) {
        sum = 0u; cnt = 0u; mine = 0u;
#pragma unroll
        for (unsigned j = 0; j < 16; ++j) { const unsigned c = xb_ld(&bar[XB_XCNT(j)]); sum += c; cnt += (c > 0u) ? 1u : 0u; mine = (j == x) ? c : mine; }
        if (sum == G) break;
        __builtin_amdgcn_s_sleep(1);
        if ((++sp & 255u) == 0u) { if (xb_ld(&bar[XB_TMO])) break; if (sp > XB_SPIN_CAP) { atomicAdd(&bar[XB_TMO], 1u); break; } }
    }
    nloc = mine > 0u ? mine : 1u; nx = cnt > 0u ? cnt : 1u;
}
__device__ __forceinline__ void xcd_barrier(const XcdBarrier& b) {
    asm volatile("s_waitcnt vmcnt(0)" ::: "memory");
    __syncthreads();
    if (threadIdx.x == 0) {
        unsigned* bar = b.bar;
        __builtin_amdgcn_s_waitcnt(0);
        unsigned nloc = b.st[0], nx = b.st[1];
        if (nloc == 0u) { xcd_barrier_complete(bar, b.x, nloc, nx); b.st[0] = nloc; b.st[1] = nx; }
        const unsigned old = xb_add(&bar[XB_XSUB(b.x)], 1u);
        const unsigned gen = old / nloc;
        if (old + 1u == (gen + 1u) * nloc) {
            __builtin_amdgcn_fence(__ATOMIC_RELEASE, "agent");
            asm volatile("s_waitcnt vmcnt(0)" ::: "memory");
            const unsigned og = xb_add(&bar[XB_TOP], 1u);
            const unsigned tg = og / nx;
            if (og + 1u == (tg + 1u) * nx) xb_add(&bar[XB_TOPGEN], 1u);
            else XB_SPIN(xb_ld(&bar[XB_TOPGEN]) == tg, bar);
            __builtin_amdgcn_fence(__ATOMIC_ACQUIRE, "agent");
            xb_add(&bar[XB_XGEN(b.x)], 1u);
            asm volatile("s_waitcnt vmcnt(0)" ::: "memory");
        } else {
            XB_SPIN(xb_ld(&bar[XB_XGEN(b.x)]) == gen, bar);
            __builtin_amdgcn_fence(__ATOMIC_ACQUIRE, "agent");
            asm volatile("s_waitcnt vmcnt(0)" ::: "memory");
        }
    }
    __syncthreads();
}

namespace pg8 {
constexpr int BM = 256, BK = 64, HALF = 128, HTB = HALF * BK * 2, STAGE_BYTES = 8 * HTB, NXCD = 8, WGM = 8;
__device__ __forceinline__ int lds_byte(int r, int c) { const int st = (r >> 4) * 2 + (c >> 5), rr = r & 15, cc = c & 31, ob = rr * 64 + cc * 2; return st * 1024 + (ob ^ (((ob >> 9) & 1) << 5)); }
__device__ __forceinline__ void stage_rc(int b, int& R, int& C) { const int st = b / 1024, sb = b % 1024, swz = sb ^ (((sb >> 9) & 1) << 5); R = (st >> 1) * 16 + swz / 64; C = (st & 1) * 32 + (swz % 64) / 2; }
__device__ __forceinline__ int perm32(int rho) { const int n = rho >> 4, i = rho & 15; return 8 * (i >> 2) + 4 * n + (i & 3); }
struct Unit { int pm, pn; };
struct Gemm { const bf16_t* A; const bf16_t* Bt; int M, N, K; };
struct StaticOrder {
    int nM, nN, nwg, G, c;
    __device__ void init(int M, int N, int G_, int c_) { nM = M / BM; nN = N / BM; nwg = nM * nN; G = G_; c = c_; }
    __device__ bool next(int i, Unit& u) const {
        const long L = (long)i * G + c; if (L >= nwg) return false;
        int wgid = (int)L; { const int q = nwg / NXCD, r = nwg % NXCD, xcd = wgid % NXCD, off = wgid / NXCD; wgid = (xcd < r ? xcd * (q + 1) : r * (q + 1) + (xcd - r) * q) + off; }
        const int nig = WGM * nN, gid = wgid / nig, fm = gid * WGM, gsz = (nM - fm) < WGM ? (nM - fm) : WGM;
        u.pm = fm + ((wgid % nig) % gsz); u.pn = (wgid % nig) / gsz; return true;
    }
};
template <class Epi>
__device__ __forceinline__ void gemm_phase(LAS unsigned char* lds, const Gemm g, const StaticOrder& S, const Epi& E) {
    const int tid = threadIdx.x, wid = __builtin_amdgcn_readfirstlane(tid >> 6), lane = tid & 63, wr = wid >> 2, wc = wid & 3, fr = lane & 15, fq = lane >> 4;
    const int K = g.K, nt = K / BK;
    unsigned voffA[2], voffB[2];
#pragma unroll
    for (int i = 0; i < 2; ++i) { int R, C; stage_rc(tid * 16 + i * 8192, R, C); const int Rb = (R & ~31) + perm32(R & 31);
        voffA[i] = (unsigned)(R * K + C) * 2u; voffB[i] = (unsigned)(Rb * K + C) * 2u; }
    const size_t kstep = (size_t)(BK * 2);
    const size_t hstep = (size_t)HALF * K * 2;
    const size_t tstep = 2 * hstep;
    const unsigned ldsw = (unsigned)wid * 1024u;
    const int aoff = lds_byte(wr * 64 + fr, fq * 8), boff = lds_byte(wc * 32 + fr, fq * 8);
#define PG8_SA(b, h) (((b) * 2 + (h)) * HTB)
#define PG8_SB(b, h) ((4 + (b) * 2 + (h)) * HTB)
#define PG8_STAGE(bufoff, gbase, voff) do { _Pragma("unroll") for (int _i = 0; _i < 2; ++_i) \
        __builtin_amdgcn_global_load_lds((const unsigned*)((const char*)(gbase) + (voff)[_i]), (LAS unsigned*)(lds + (bufoff) + ldsw + _i * 8192), 16, 0, 0); } while (0)
#define PG8_LDA(dst, b, h) do { _Pragma("unroll") for (int m = 0; m < 4; ++m) _Pragma("unroll") for (int k = 0; k < 2; ++k) dst[m][k] = *(const LAS bf16x8*)(lds + PG8_SA(b, h) + aoff + m * 2048 + k * 1024); } while (0)
#define PG8_LDB(dst, b, h) do { _Pragma("unroll") for (int n = 0; n < 2; ++n) _Pragma("unroll") for (int k = 0; k < 2; ++k) dst[n][k] = *(const LAS bf16x8*)(lds + PG8_SB(b, h) + boff + n * 2048 + k * 1024); } while (0)
#define PG8_MMA(ai, bj, At, Bt) do { __builtin_amdgcn_s_setprio(1); _Pragma("unroll") for (int m = 0; m < 4; ++m) _Pragma("unroll") for (int n = 0; n < 2; ++n) _Pragma("unroll") for (int k = 0; k < 2; ++k) \
        acc[ai][bj][m][n] = __builtin_amdgcn_mfma_f32_16x16x32_bf16(Bt[n][k], At[m][k], acc[ai][bj][m][n], 0, 0, 0); __builtin_amdgcn_s_setprio(0); } while (0)
#define PG8_WAIT_V(n) asm volatile("s_waitcnt vmcnt(" #n ")" ::: "memory")
#define PG8_WAIT_L(n) asm volatile("s_waitcnt lgkmcnt(" #n ")" ::: "memory")
#define PG8_BAR __builtin_amdgcn_s_barrier()
#define PG8_SCHED __builtin_amdgcn_sched_barrier(0)
    Unit cur, nxt; int ui = 0;
    if (!S.next(0, cur)) return;
    f32x4 acc[2][2][4][2];
#pragma unroll
    for (int a = 0; a < 2; ++a)
#pragma unroll
        for (int b = 0; b < 2; ++b)
#pragma unroll
            for (int m = 0; m < 4; ++m)
#pragma unroll
                for (int n = 0; n < 2; ++n) acc[a][b][m][n] = (f32x4){0.f, 0.f, 0.f, 0.f};
    bf16x8 At[4][2], B0[2][2], B1[2][2];
    const char* cA = (const char*)g.A + (size_t)cur.pm * tstep; const char* cB = (const char*)g.Bt + (size_t)cur.pn * tstep;
    PG8_STAGE(PG8_SB(0, 0), cB, voffB); PG8_STAGE(PG8_SA(0, 0), cA, voffA); PG8_STAGE(PG8_SB(0, 1), cB + hstep, voffB); PG8_STAGE(PG8_SA(0, 1), cA + hstep, voffA);
    if (wr == 1) PG8_BAR;
    PG8_WAIT_V(4); PG8_BAR;
    PG8_STAGE(PG8_SB(1, 0), cB + kstep, voffB); PG8_STAGE(PG8_SA(1, 0), cA + kstep, voffA); PG8_STAGE(PG8_SB(1, 1), cB + hstep + kstep, voffB);
    PG8_WAIT_V(6); PG8_BAR;
    for (;;) {
        const bool has_next = S.next(ui + 1, nxt);
        const char* nA = has_next ? (const char*)g.A + (size_t)nxt.pm * tstep : cA; const char* nB = has_next ? (const char*)g.Bt + (size_t)nxt.pn * tstep : cB;
#pragma unroll 1
        for (int t = 0; t < nt; t += 2) {
            const bool last = (t == nt - 2);
            const char* a1 = cA + (size_t)(t + 1) * kstep;
            const char* a2 = last ? nA : cA + (size_t)(t + 2) * kstep; const char* b2 = last ? nB : cB + (size_t)(t + 2) * kstep;
            const char* a3 = a2 + kstep; const char* b3 = b2 + kstep;
            PG8_LDB(B0, 0, 0); PG8_SCHED; PG8_LDA(At, 0, 0); PG8_STAGE(PG8_SA(1, 1), a1 + hstep, voffA);
            PG8_WAIT_L(8); PG8_BAR; PG8_WAIT_L(0); PG8_MMA(0, 0, At, B0); PG8_BAR; PG8_SCHED;
            PG8_LDB(B1, 0, 1); PG8_STAGE(PG8_SB(0, 0), b2, voffB);
            PG8_BAR; PG8_WAIT_L(0); PG8_MMA(0, 1, At, B1); PG8_BAR;
            PG8_LDA(At, 0, 1); PG8_STAGE(PG8_SA(0, 0), a2, voffA);
            PG8_BAR; PG8_WAIT_L(0); PG8_MMA(1, 0, At, B0); PG8_BAR; PG8_SCHED;
            PG8_STAGE(PG8_SB(0, 1), b2 + hstep, voffB);
            PG8_WAIT_V(6); PG8_BAR; PG8_MMA(1, 1, At, B1); PG8_BAR;
            PG8_LDB(B0, 1, 0); PG8_SCHED; PG8_LDA(At, 1, 0); PG8_STAGE(PG8_SA(0, 1), a2 + hstep, voffA);
            PG8_WAIT_L(8); PG8_BAR; PG8_WAIT_L(0); PG8_MMA(0, 0, At, B0); PG8_BAR; PG8_SCHED;
            PG8_LDB(B1, 1, 1); PG8_STAGE(PG8_SB(1, 0), b3, voffB);
            PG8_BAR; PG8_WAIT_L(0); PG8_MMA(0, 1, At, B1); PG8_BAR;
            PG8_LDA(At, 1, 1); PG8_STAGE(PG8_SA(1, 0), a3, voffA);
            PG8_BAR; PG8_WAIT_L(0); PG8_MMA(1, 0, At, B0); PG8_BAR; PG8_SCHED;
            PG8_STAGE(PG8_SB(1, 1), b3 + hstep, voffB);
            PG8_WAIT_V(6); PG8_BAR; PG8_MMA(1, 1, At, B1); PG8_BAR;
        }
        {
            const int row0 = cur.pm * BM + wr * 64 + fr, col0 = cur.pn * BM + wc * 32 + 8 * fq;
#pragma unroll
            for (int ai = 0; ai < 2; ++ai)
#pragma unroll
                for (int m = 0; m < 4; ++m)
#pragma unroll
                    for (int bj = 0; bj < 2; ++bj) { E(row0 + ai * HALF + m * 16, col0 + bj * HALF, cur.pn, acc[ai][bj][m][0], acc[ai][bj][m][1]); if (Epi::SERIAL) __builtin_amdgcn_sched_barrier(0); }
        }
        if (!has_next) break;
#pragma unroll
        for (int a = 0; a < 2; ++a)
#pragma unroll
            for (int b = 0; b < 2; ++b)
#pragma unroll
                for (int m = 0; m < 4; ++m)
#pragma unroll
                    for (int n = 0; n < 2; ++n) acc[a][b][m][n] = (f32x4){0.f, 0.f, 0.f, 0.f};
        cur = nxt; cA = nA; cB = nB; ++ui;
    }
    PG8_WAIT_V(0);
    if (wr == 0) PG8_BAR;
    PG8_BAR;
#undef PG8_SA
#undef PG8_SB
#undef PG8_STAGE
#undef PG8_LDA
#undef PG8_LDB
#undef PG8_MMA
#undef PG8_WAIT_V
#undef PG8_WAIT_L
#undef PG8_BAR
#undef PG8_SCHED
}
struct GemmM { const bf16_t* A0; const bf16_t* A1; const bf16_t* Bt; int M, N; };
template <class Hook>
__device__ __forceinline__ void gemm_phase_merge(LAS unsigned char* lds, const GemmM g, const StaticOrder& S, const Hook& H) {
    const int tid = threadIdx.x, wid = __builtin_amdgcn_readfirstlane(tid >> 6), lane = tid & 63, wr = wid >> 2, wc = wid & 3, fr = lane & 15, fq = lane >> 4;
    constexpr int K = 2048, LDA = 1024, nt = K / BK, KS = 16;
    unsigned voffA[2], voffB[2];
#pragma unroll
    for (int i = 0; i < 2; ++i) { int R, C; stage_rc(tid * 16 + i * 8192, R, C); const int Rb = (R & ~31) + perm32(R & 31);
        voffA[i] = (unsigned)(R * LDA + C) * 2u; voffB[i] = (unsigned)(Rb * K + C) * 2u; }
    const size_t kstep = (size_t)(BK * 2);
    const size_t hstepA = (size_t)HALF * LDA * 2, tstepA = 2 * hstepA, hstepB = (size_t)HALF * K * 2, tstepB = 2 * hstepB;
    const unsigned ldsw = (unsigned)wid * 1024u;
    const int aoff = lds_byte(wr * 64 + fr, fq * 8), boff = lds_byte(wc * 32 + fr, fq * 8);
#define PG8_SA(b, h) (((b) * 2 + (h)) * HTB)
#define PG8_SB(b, h) ((4 + (b) * 2 + (h)) * HTB)
#define PG8_STAGE(bufoff, gbase, voff) do { _Pragma("unroll") for (int _i = 0; _i < 2; ++_i) \
        __builtin_amdgcn_global_load_lds((const unsigned*)((const char*)(gbase) + (voff)[_i]), (LAS unsigned*)(lds + (bufoff) + ldsw + _i * 8192), 16, 0, 0); } while (0)
#define PG8_LDA(dst, b, h) do { _Pragma("unroll") for (int m = 0; m < 4; ++m) _Pragma("unroll") for (int k = 0; k < 2; ++k) dst[m][k] = *(const LAS bf16x8*)(lds + PG8_SA(b, h) + aoff + m * 2048 + k * 1024); } while (0)
#define PG8_LDB(dst, b, h) do { _Pragma("unroll") for (int n = 0; n < 2; ++n) _Pragma("unroll") for (int k = 0; k < 2; ++k) dst[n][k] = *(const LAS bf16x8*)(lds + PG8_SB(b, h) + boff + n * 2048 + k * 1024); } while (0)
#define PG8_MMA(ai, bj, At, Bt) do { __builtin_amdgcn_s_setprio(1); _Pragma("unroll") for (int m = 0; m < 4; ++m) _Pragma("unroll") for (int n = 0; n < 2; ++n) _Pragma("unroll") for (int k = 0; k < 2; ++k) \
        acc[ai][bj][m][n] = __builtin_amdgcn_mfma_f32_16x16x32_bf16(Bt[n][k], At[m][k], acc[ai][bj][m][n], 0, 0, 0); __builtin_amdgcn_s_setprio(0); } while (0)
#define PG8_WAIT_V(n) asm volatile("s_waitcnt vmcnt(" #n ")" ::: "memory")
#define PG8_WAIT_L(n) asm volatile("s_waitcnt lgkmcnt(" #n ")" ::: "memory")
#define PG8_BAR __builtin_amdgcn_s_barrier()
#define PG8_SCHED __builtin_amdgcn_sched_barrier(0)
#define PG8_AT(b0, b1, t) ((t) < KS ? (b0) + (size_t)(t) * kstep : (b1) + (size_t)((t) - KS) * kstep)
    Unit cur, nxt; int ui = 0;
    if (!S.next(0, cur)) return;
    f32x4 acc[2][2][4][2];
#pragma unroll
    for (int a = 0; a < 2; ++a)
#pragma unroll
        for (int b = 0; b < 2; ++b)
#pragma unroll
            for (int m = 0; m < 4; ++m)
#pragma unroll
                for (int n = 0; n < 2; ++n) acc[a][b][m][n] = (f32x4){0.f, 0.f, 0.f, 0.f};
    bf16x8 At[4][2], B0[2][2], B1[2][2];
    const char* cA0 = (const char*)g.A0 + (size_t)cur.pm * tstepA; const char* cA1 = (const char*)g.A1 + (size_t)cur.pm * tstepA; const char* cB = (const char*)g.Bt + (size_t)cur.pn * tstepB;
    PG8_STAGE(PG8_SB(0, 0), cB, voffB); PG8_STAGE(PG8_SA(0, 0), cA0, voffA); PG8_STAGE(PG8_SB(0, 1), cB + hstepB, voffB); PG8_STAGE(PG8_SA(0, 1), cA0 + hstepA, voffA);
    if (wr == 1) PG8_BAR;
    PG8_WAIT_V(4); PG8_BAR;
    PG8_STAGE(PG8_SB(1, 0), cB + kstep, voffB); PG8_STAGE(PG8_SA(1, 0), cA0 + kstep, voffA); PG8_STAGE(PG8_SB(1, 1), cB + hstepB + kstep, voffB);
    PG8_WAIT_V(6); PG8_BAR;
    for (;;) {
        const bool has_next = S.next(ui + 1, nxt);
        const char* nA0 = has_next ? (const char*)g.A0 + (size_t)nxt.pm * tstepA : cA0; const char* nA1 = has_next ? (const char*)g.A1 + (size_t)nxt.pm * tstepA : cA1;
        const char* nB = has_next ? (const char*)g.Bt + (size_t)nxt.pn * tstepB : cB;
#pragma unroll 1
        for (int t = 0; t < nt; t += 2) {
            const bool last = (t == nt - 2);
            if (t == 16 || t == 24) H.rescale(acc, cur, t == 24 ? 1 : 0, wr, wc, fr, fq);
            const char* a1 = PG8_AT(cA0, cA1, t + 1);
            const char* a2 = last ? nA0 : PG8_AT(cA0, cA1, t + 2); const char* b2 = last ? nB : cB + (size_t)(t + 2) * kstep;
            const char* a3 = last ? nA0 + kstep : PG8_AT(cA0, cA1, t + 3); const char* b3 = b2 + kstep;
            PG8_LDB(B0, 0, 0); PG8_SCHED; PG8_LDA(At, 0, 0); PG8_STAGE(PG8_SA(1, 1), a1 + hstepA, voffA);
            PG8_WAIT_L(8); PG8_BAR; PG8_WAIT_L(0); PG8_MMA(0, 0, At, B0); PG8_BAR; PG8_SCHED;
            PG8_LDB(B1, 0, 1); PG8_STAGE(PG8_SB(0, 0), b2, voffB);
            PG8_BAR; PG8_WAIT_L(0); PG8_MMA(0, 1, At, B1); PG8_BAR;
            PG8_LDA(At, 0, 1); PG8_STAGE(PG8_SA(0, 0), a2, voffA);
            PG8_BAR; PG8_WAIT_L(0); PG8_MMA(1, 0, At, B0); PG8_BAR; PG8_SCHED;
            PG8_STAGE(PG8_SB(0, 1), b2 + hstepB, voffB);
            PG8_WAIT_V(6); PG8_BAR; PG8_MMA(1, 1, At, B1); PG8_BAR;
            PG8_LDB(B0, 1, 0); PG8_SCHED; PG8_LDA(At, 1, 0); PG8_STAGE(PG8_SA(0, 1), a2 + hstepA, voffA);
            PG8_WAIT_L(8); PG8_BAR; PG8_WAIT_L(0); PG8_MMA(0, 0, At, B0); PG8_BAR; PG8_SCHED;
            PG8_LDB(B1, 1, 1); PG8_STAGE(PG8_SB(1, 0), b3, voffB);
            PG8_BAR; PG8_WAIT_L(0); PG8_MMA(0, 1, At, B1); PG8_BAR;
            PG8_LDA(At, 1, 1); PG8_STAGE(PG8_SA(1, 0), a3, voffA);
            PG8_BAR; PG8_WAIT_L(0); PG8_MMA(1, 0, At, B0); PG8_BAR; PG8_SCHED;
            PG8_STAGE(PG8_SB(1, 1), b3 + hstepB, voffB);
            PG8_WAIT_V(6); PG8_BAR; PG8_MMA(1, 1, At, B1); PG8_BAR;
        }
        H.finish(acc, cur, wr, wc, fr, fq);
        if (!has_next) break;
#pragma unroll
        for (int a = 0; a < 2; ++a)
#pragma unroll
            for (int b = 0; b < 2; ++b)
#pragma unroll
                for (int m = 0; m < 4; ++m)
#pragma unroll
                    for (int n = 0; n < 2; ++n) acc[a][b][m][n] = (f32x4){0.f, 0.f, 0.f, 0.f};
        cur = nxt; cA0 = nA0; cA1 = nA1; cB = nB; ++ui;
    }
    PG8_WAIT_V(0);
    if (wr == 0) PG8_BAR;
    PG8_BAR;
#undef PG8_SA
#undef PG8_SB
#undef PG8_STAGE
#undef PG8_LDA
#undef PG8_LDB
#undef PG8_MMA
#undef PG8_WAIT_V
#undef PG8_WAIT_L
#undef PG8_BAR
#undef PG8_SCHED
#undef PG8_AT
}
}

struct Args { const float* in[34]; float* out; unsigned char* ws; int ph_lo, ph_hi, li, pad; };

struct Ctx {
    LAS unsigned char* lds;
    int tid, lane, wave, gw, ngw, gt, ngt, G;
    const float* const* in; unsigned char* ws; unsigned char* dout;
};

__device__ __forceinline__ void st8_bf16(bf16_t* p, f32x4 a, f32x4 b) { u32x4 w; w.x = pk2(a.x, a.y); w.y = pk2(a.z, a.w); w.z = pk2(b.x, b.y); w.w = pk2(b.z, b.w); *(u32x4*)p = w; }
struct EpiP1 { static constexpr bool SERIAL = false;
    float* cs; bf16_t* rc; bf16_t* mq;
    __device__ __forceinline__ void operator()(int row, int col, int pn, f32x4 a, f32x4 b) const {
        if (pn < 2) { float* p = cs + (size_t)row * 512 + col; *(f32x4*)p = a; *(f32x4*)(p + 4) = b; }
        else if (pn < 9) st8_bf16(rc + (size_t)row * 1792 + (col - 512), a, b);
        else st8_bf16(mq + (size_t)row * 512 + (col - 2304), a, b);
    }
};
struct EpiMemKV { static constexpr bool SERIAL = false;
    bf16_t* km; bf16_t* vt;
    __device__ __forceinline__ void operator()(int row, int col, int pn, f32x4 a, f32x4 b) const {
        const int bb = row >> 8, m = row & 255;
        if (col < 512) { const int h = col >> 7, d = col & 127; st8_bf16(km + ((size_t)((bb * 4 + h) * 256 + m)) * 128 + d, a, b); }
        else { const int c2 = col - 512, h = c2 >> 7, d = c2 & 127; bf16_t* p = vt + ((size_t)((bb * 4 + h) * 128 + d)) * 256 + m;
            p[0] = (bf16_t)f2bf(a.x); p[256] = (bf16_t)f2bf(a.y); p[512] = (bf16_t)f2bf(a.z); p[768] = (bf16_t)f2bf(a.w);
            p[1024] = (bf16_t)f2bf(b.x); p[1280] = (bf16_t)f2bf(b.y); p[1536] = (bf16_t)f2bf(b.z); p[1792] = (bf16_t)f2bf(b.w); }
    }
};
struct EpiLora { static constexpr bool SERIAL = true;
    bf16_t* e; bf16_t* a; bf16_t* g; const float* w0; const float* a0;
    __device__ __forceinline__ void operator()(int row, int col, int pn, f32x4 x, f32x4 y) const {
        float v[8] = {x.x, x.y, x.z, x.w, y.x, y.y, y.z, y.w};
        if (pn < 4) { const int c = col & 511; const float* bp = (pn < 2 ? w0 : a0) + c; const f32x4 b0 = *(const f32x4*)bp, b1 = *(const f32x4*)(bp + 4);
            const float bb[8] = {b0.x, b0.y, b0.z, b0.w, b1.x, b1.y, b1.z, b1.w}; const float sc = pn < 2 ? 0.6065306597126334f : 1.0f;
#pragma unroll
            for (int j = 0; j < 8; ++j) v[j] = sc * sigmoidf_(v[j] + bb[j]);
            *(u32x4*)((pn < 2 ? e : a) + (size_t)row * 512 + c) = pack8(v);
        } else *(u32x4*)(g + (size_t)row * 512 + (col - 1024)) = pack8(v);
    }
};
struct EpiQ { static constexpr bool SERIAL = false;
    bf16_t* ql; bf16_t* qi;
    __device__ __forceinline__ void operator()(int row, int col, int pn, f32x4 a, f32x4 b) const {
        if (pn < 4) st8_bf16(ql + (size_t)row * 1024 + col, a, b); else st8_bf16(qi + (size_t)row * 256 + (col - 1024), a, b);
    }
};
struct EpiGates { static constexpr bool SERIAL = true;
    bf16_t* o;
    __device__ __forceinline__ void operator()(int row, int col, int pn, f32x4 a, f32x4 b) const {
        float v[8] = {a.x, a.y, a.z, a.w, b.x, b.y, b.z, b.w};
#pragma unroll
        for (int j = 0; j < 8; ++j) v[j] = sigmoidf_(v[j]);
        *(u32x4*)(o + (size_t)row * 3072 + col) = pack8(v);
    }
};
struct MergeHook {
    const bf16_t* gates; bf16_t* mb;
    __device__ __forceinline__ void rescale(f32x4 (&acc)[2][2][4][2], const pg8::Unit& u, int idx, int wr, int wc, int fr, int fq) const {
        asm volatile("" : "+v"(fr), "+v"(fq));
        const int row0 = u.pm * 256 + wr * 64 + fr, col0 = u.pn * 256 + wc * 32 + 8 * fq;
#pragma unroll
        for (int ai = 0; ai < 2; ++ai)
#pragma unroll
            for (int mh = 0; mh < 2; ++mh) {
                u32x4 pa[2][2], pb[2][2];
#pragma unroll
                for (int mm = 0; mm < 2; ++mm)
#pragma unroll
                    for (int bj = 0; bj < 2; ++bj) { const bf16_t* gp = gates + (size_t)(row0 + ai * 128 + (2 * mh + mm) * 16) * 3072 + idx * 1024 + col0 + bj * 128; pa[mm][bj] = *(const u32x4*)gp; pb[mm][bj] = *(const u32x4*)(gp + 1024); }
                __builtin_amdgcn_sched_barrier(0);
#pragma unroll
                for (int mm = 0; mm < 2; ++mm)
#pragma unroll
                    for (int bj = 0; bj < 2; ++bj) { float a[8], b[8]; unpack8(pa[mm][bj], a); unpack8(pb[mm][bj], b); const int m = 2 * mh + mm;
#pragma unroll
                        for (int j = 0; j < 4; ++j) { acc[ai][bj][m][0][j] *= a[j] * __builtin_amdgcn_rcpf(b[j]); acc[ai][bj][m][1][j] *= a[4 + j] * __builtin_amdgcn_rcpf(b[4 + j]); } }
                __builtin_amdgcn_sched_barrier(0);
            }
    }
    __device__ __forceinline__ void finish(f32x4 (&acc)[2][2][4][2], const pg8::Unit& u, int wr, int wc, int fr, int fq) const {
        asm volatile("" : "+v"(fr), "+v"(fq));
        const int row0 = u.pm * 256 + wr * 64 + fr, col0 = u.pn * 256 + wc * 32 + 8 * fq;
#pragma unroll
        for (int ai = 0; ai < 2; ++ai)
#pragma unroll
            for (int m = 0; m < 4; ++m)
#pragma unroll
                for (int bj = 0; bj < 2; ++bj) { const int row = row0 + ai * 128 + m * 16, col = col0 + bj * 128;
                    float gv[8]; unpack8(*(const u32x4*)(gates + (size_t)row * 3072 + 2048 + col), gv);
                    const f32x4 x = acc[ai][bj][m][0], y = acc[ai][bj][m][1];
                    float v[8] = {x[0] * gv[0], x[1] * gv[1], x[2] * gv[2], x[3] * gv[3], y[0] * gv[4], y[1] * gv[5], y[2] * gv[6], y[3] * gv[7]};
                    *(u32x4*)(mb + (size_t)row * 1024 + col) = pack8(v); }
    }
};
struct EpiWout { static constexpr bool SERIAL = false;
    gfp x; bf16_t* pre;
    __device__ __forceinline__ void operator()(int row, int col, int pn, f32x4 a, f32x4 b) const {
        gfp xp = x + (size_t)row * 1024 + col; typedef const __attribute__((address_space(1))) f32x4* g4p;
        st8_bf16(pre + (size_t)row * 1024 + col, *(g4p)xp * ALPHA + a, *(g4p)(xp + 4) * ALPHA + b);
    }
};
struct EpiPeerQ { static constexpr bool SERIAL = false; bf16_t* o; __device__ __forceinline__ void operator()(int row, int col, int pn, f32x4 a, f32x4 b) const { st8_bf16(o + (size_t)row * 2048 + col, a, b); } };

template <int N, int K, class F> __device__ __forceinline__ void build_bt(bf16_t* dst, const F& f, int gt, int ngt) {
    constexpr int items = N * (K / 8);
    for (int i = gt; i < items; i += ngt) { const int n = i % N, k0 = (i / N) * 8; float v[8];
#pragma unroll
        for (int j = 0; j < 8; ++j) v[j] = f(n, k0 + j);
        *(u32x4*)(dst + (size_t)n * K + k0) = pack8(v); }
}
template <int N, int K, class F> __device__ __forceinline__ void build_bt_ld(bf16_t* dst, int ld, const F& f, int gt, int ngt) {
    constexpr int items = N * (K / 8);
    for (int i = gt; i < items; i += ngt) { const int n = i % N, k0 = (i / N) * 8; float v[8];
#pragma unroll
        for (int j = 0; j < 8; ++j) v[j] = f(n, k0 + j);
        *(u32x4*)(dst + (size_t)n * ld + k0) = pack8(v); }
}
struct FWin { gfp w; __device__ __forceinline__ float operator()(int n, int k) const { if (n < 424) return w[(size_t)k * IN_W + n]; if (n < 512) return 0.f; return w[(size_t)k * IN_W + n - 88]; } };
struct FWg { gfp w; __device__ __forceinline__ float operator()(int n, int k) const { return w[(size_t)k * IN_W + 2728 + n]; } };
struct FLora { gfp w2, a2, g2; __device__ __forceinline__ float operator()(int n, int k) const {
    if (n < 512) return k < 64 ? w2[k * 512 + n] : 0.f;
    if (n < 1024) return (k >= 64 && k < 128) ? a2[(k - 64) * 512 + n - 512] : 0.f;
    return k >= 128 ? g2[(k - 128) * 512 + n - 1024] : 0.f; } };
struct FWq { const float *uq, *uk, *iq; __device__ __forceinline__ float operator()(int n, int k) const {
    if (n >= 1024) return iq[k * 256 + n - 1024];
    const int h = n >> 7, c = n & 127; const float* a = uq + (size_t)k * 512 + h * 64; const float* b = uk + (size_t)(c * 8 + h) * 64; float s = 0.f;
#pragma unroll 8
    for (int d = 0; d < 64; ++d) s = fmaf(a[d], b[d], s);
    return s * 0.125f; } };
struct FWov { const float *uv, *br; __device__ __forceinline__ float operator()(int n, int k) const {
    const int h = k >> 7, c = k & 127; const float* a = uv + (size_t)(c * 8 + h) * 64; const float* b = br + (size_t)(h * 64) * 1024 + n; float s = 0.f;
#pragma unroll 8
    for (int d = 0; d < 64; ++d) s = fmaf(a[d], b[(size_t)d * 1024], s);
    return s; } };
struct FT { gfp w; int ld; __device__ __forceinline__ float operator()(int n, int k) const { return w[(size_t)k * ld + n]; } };

__device__ __forceinline__ void cvt_rows(gfp src, bf16_t* dst, size_t n8, int gt, int ngt) {
    for (size_t i = gt; i < n8; i += ngt) { const f32x4 a = *(const __attribute__((address_space(1))) f32x4*)(src + i * 8), b = *(const __attribute__((address_space(1))) f32x4*)(src + i * 8 + 4); st8_bf16(dst + i * 8, a, b); }
}
constexpr float PEER_U_SCALE = 64.0f, PEER_V_SCALE = 8.0f;
template <bool SLICED = false>
__device__ __forceinline__ void cvt_rows_fp8(gfp src, unsigned char* dst, size_t n16, float scale, int gt, int ngt) {
    for (size_t i = gt; i < n16; i += ngt) { typedef const __attribute__((address_space(1))) f32x4* g4p; gfp p = src + i * 16; u32x4 w;
        const f32x4 a = *(g4p)p * scale, b = *(g4p)(p + 4) * scale, c = *(g4p)(p + 8) * scale, d = *(g4p)(p + 12) * scale;
        int t = 0; t = __builtin_amdgcn_cvt_pk_fp8_f32(a.x, a.y, t, false); t = __builtin_amdgcn_cvt_pk_fp8_f32(a.z, a.w, t, true); w.x = (unsigned)t;
        t = 0; t = __builtin_amdgcn_cvt_pk_fp8_f32(b.x, b.y, t, false); t = __builtin_amdgcn_cvt_pk_fp8_f32(b.z, b.w, t, true); w.y = (unsigned)t;
        t = 0; t = __builtin_amdgcn_cvt_pk_fp8_f32(c.x, c.y, t, false); t = __builtin_amdgcn_cvt_pk_fp8_f32(c.z, c.w, t, true); w.z = (unsigned)t;
        t = 0; t = __builtin_amdgcn_cvt_pk_fp8_f32(d.x, d.y, t, false); t = __builtin_amdgcn_cvt_pk_fp8_f32(d.z, d.w, t, true); w.w = (unsigned)t;
        if (SLICED) *(u32x4*)(dst + (((i >> 3) & 7) << 21) + ((i >> 6) << 7) + ((i & 7) << 4)) = w; else *(u32x4*)(dst + i * 16) = w; }
}
__device__ __forceinline__ void p0_prologue(const Ctx& C) {
    const float* const* in = C.in; unsigned char* ws = C.ws;
    cvt_rows(G_(in[0]), (bf16_t*)(C.dout + DO_XB), (size_t)T * D / 8, C.gt, C.ngt);
    cvt_rows(G_(in[1]), (bf16_t*)(ws + WS_MEMB), (size_t)1024 * 1024 / 8, C.gt, C.ngt);
    cvt_rows(G_(in[29]), (bf16_t*)(ws + WS_KEYS), (size_t)2 * 128 * 128 / 8, C.gt, C.ngt);
    build_bt<2816, 1024>((bf16_t*)(ws + WS_WIN), FWin{G_(in[3])}, C.gt, C.ngt);
    build_bt<1536, 256>((bf16_t*)(ws + WS_WLORA), FLora{G_(in[12]), G_(in[14]), G_(in[15])}, C.gt, C.ngt);
    {
        bf16_t* dst = (bf16_t*)(ws + WS_WQ); const float* uq = in[6]; const float* uk = in[7];
        for (int item = C.gw; item < 4096; item += C.ngw) { const int n = item >> 2, k = (item & 3) * 64 + C.lane, h = n >> 7, c = n & 127;
            const float* a = uq + (size_t)k * 512 + h * 64; const float* bq = uk + (size_t)(c * 8 + h) * 64; float s = 0.f;
#pragma unroll
            for (int d4 = 0; d4 < 16; ++d4) { const f32x4 av = *(const f32x4*)(a + 4 * d4), bv = *(const f32x4*)(bq + 4 * d4); s += av.x * bv.x + av.y * bv.y + av.z * bv.z + av.w * bv.w; }
            dst[(size_t)n * 256 + k] = (bf16_t)f2bf(s * 0.125f); }
        build_bt<256, 256>(dst + 1024 * 256, FT{G_(in[9]), 256}, C.gt, C.ngt);
    }
    build_bt<1024, 1024>((bf16_t*)(ws + WS_WMEMKV), FT{G_(in[21]), 1024}, C.gt, C.ngt);
}
__device__ __forceinline__ void p6_late_weights(const Ctx& C0) {
    const int busy = (32 * RCH + C0.G - 1) / C0.G; Ctx C = C0;
    if (busy < NWAVES) { if (C0.wave < busy) return; C.gt = (int)blockIdx.x * (NWAVES - busy) * 64 + (C0.wave - busy) * 64 + C0.lane; C.ngt = C0.G * (NWAVES - busy) * 64; C.gw = C.gt >> 6; C.ngw = C.ngt >> 6; }
    const float* const* in = C.in; unsigned char* ws = C.ws;
    build_bt<3072, 1024>((bf16_t*)(ws + WS_WG), FWg{G_(in[3])}, C.gt, C.ngt);
    {
        bf16_t* dst = (bf16_t*)(ws + WS_WOV); const float* uv = in[8]; const float* br = in[22];
        for (int i = C.gt; i < 1024 * 128; i += C.ngt) { const int n = i & 1023, k0 = (i >> 10) * 8, h = k0 >> 7, c0 = k0 & 127; float acc[8];
#pragma unroll
            for (int j = 0; j < 8; ++j) acc[j] = 0.f;
            for (int d4 = 0; d4 < 16; ++d4) {
                float b[4];
#pragma unroll
                for (int q = 0; q < 4; ++q) b[q] = br[(size_t)(h * 64 + 4 * d4 + q) * 1024 + n];
#pragma unroll
                for (int j = 0; j < 8; ++j) { const f32x4 a = *(const f32x4*)(uv + (size_t)((c0 + j) * 8 + h) * 64 + 4 * d4); acc[j] += a.x * b[0] + a.y * b[1] + a.z * b[2] + a.w * b[3]; }
            }
            *(u32x4*)(dst + (size_t)n * 2048 + k0) = pack8(acc); }
    }
    build_bt_ld<1024, 512>((bf16_t*)(ws + WS_WOV) + 1024, 2048, FT{G_(in[23]), 1024}, C.gt, C.ngt);
    build_bt_ld<1024, 512>((bf16_t*)(ws + WS_WOV) + 1536, 2048, FT{G_(in[24]), 1024}, C.gt, C.ngt);
    build_bt<1024, 1024>((bf16_t*)(ws + WS_WOUT), FT{G_(in[25]), 1024}, C.gt, C.ngt);
    build_bt<2048, 1024>((bf16_t*)(ws + WS_WPEER), FT{G_(in[28]), 2048}, C.gt, C.ngt);
    cvt_rows_fp8<true>(G_(in[30]), ws + WS_UB, (size_t)16384 * 1024 / 16, PEER_U_SCALE, C.gt, C.ngt);
}

__device__ __forceinline__ void p2_prep(const Ctx& C) {
    const float* const* in = C.in; unsigned char* ws = C.ws; const int lane = C.lane;
    const float* csmall = (const float*)(ws + WS_CSMALL); const bf16_t* rcols = (const bf16_t*)(ws + WS_RCOLS);
    bf16_t* cqn = (bf16_t*)(ws + WS_CQN); bf16_t* kvl = (bf16_t*)(ws + WS_KVL); bf16_t* kidx = (bf16_t*)(ws + WS_KIDX); float* widx = (float*)(ws + WS_WIDX);
    bf16_t* rr = (bf16_t*)(ws + WS_RW_R); bf16_t* rk = (bf16_t*)(ws + WS_RW_K); bf16_t* rv = (bf16_t*)(ws + WS_RW_V); bf16_t* la = (bf16_t*)(ws + WS_LORAA);
    const float* mu = in[10];
    const f32x4 gq = *(const f32x4*)(in[4] + 4 * lane); const f32x2 gk = *(const f32x2*)(in[5] + 2 * lane);
    for (int t = C.gw; t < T; t += C.ngw) {
        const float* cs = csmall + (size_t)t * 512;
        {
            const f32x4 q = *(const f32x4*)(cs + 4 * lane);
            const float ss = wave_sum(q.x * q.x + q.y * q.y + q.z * q.z + q.w * q.w);
            const float rs = rsqrtf(ss * (1.0f / 256.0f) + 1e-6f);
            u32x2 w; w.x = pk2(q.x * rs * gq.x, q.y * rs * gq.y); w.y = pk2(q.z * rs * gq.z, q.w * rs * gq.w);
            *(u32x2*)(cqn + (size_t)t * 256 + 4 * lane) = w;
        }
        {
            const f32x2 k = *(const f32x2*)(cs + 256 + 2 * lane);
            const float ss = wave_sum(k.x * k.x + k.y * k.y);
            const float rs = rsqrtf(ss * (1.0f / 128.0f) + 1e-6f);
            *(unsigned*)(kvl + (size_t)t * 128 + 2 * lane) = pk2(k.x * rs * gk.x, k.y * rs * gk.y);
        }
        if (lane < 16) { const f32x2 k = *(const f32x2*)(cs + 384 + 2 * lane); *(unsigned*)(kidx + (size_t)t * 32 + 2 * lane) = pk2(k.x, k.y); }
        if (lane < 8) widx[(size_t)t * 8 + lane] = cs[416 + lane] * 0.0625f;
        const bf16_t* rc = rcols + (size_t)t * 1792; const bool hp = (t & (SEQ - 1)) != 0; const bf16_t* rp = hp ? rc - 1792 : rc;
#pragma unroll
        for (int seg = 0; seg < 3; ++seg) {
            float c[8], p[8], o[8];
            unpack8(*(const u32x4*)(rc + seg * 512 + 8 * lane), c); unpack8(*(const u32x4*)(rp + seg * 512 + 8 * lane), p);
            const f32x4 m0 = *(const f32x4*)(mu + seg * 512 + 8 * lane), m1 = *(const f32x4*)(mu + seg * 512 + 8 * lane + 4);
            const float mm[8] = {m0.x, m0.y, m0.z, m0.w, m1.x, m1.y, m1.z, m1.w};
#pragma unroll
            for (int j = 0; j < 8; ++j) { const float pv = hp ? p[j] : 0.f; o[j] = c[j] + (pv - c[j]) * mm[j]; }
            bf16_t* dst = (seg == 0 ? rr : (seg == 1 ? rk : rv)) + (size_t)t * 512 + 8 * lane;
            *(u32x4*)dst = pack8(o);
        }
        {
            const float cw = bf1(rc[1536 + lane]), pw = hp ? bf1(rp[1536 + lane]) : 0.f; const float wl = cw + (pw - cw) * mu[1536 + lane];
            const float ca = bf1(rc[1600 + lane]), pa = hp ? bf1(rp[1600 + lane]) : 0.f; const float al = ca + (pa - ca) * mu[1600 + lane];
            const unsigned cgw = *(const unsigned*)(rc + 1664 + 2 * lane), pgw = *(const unsigned*)(rp + 1664 + 2 * lane);
            const float cg0 = bflo(cgw), cg1 = bfhi(cgw), pg0 = hp ? bflo(pgw) : 0.f, pg1 = hp ? bfhi(pgw) : 0.f;
            const float g0 = cg0 + (pg0 - cg0) * mu[1664 + 2 * lane], g1 = cg1 + (pg1 - cg1) * mu[1664 + 2 * lane + 1];
            bf16_t* l = la + (size_t)t * 256;
            l[lane] = (bf16_t)f2bf(tanhf(wl)); l[64 + lane] = (bf16_t)f2bf(al);
            *(unsigned*)(l + 128 + 2 * lane) = pk2(sigmoidf_(g0), sigmoidf_(g1));
        }
    }
}

template <int NV> __device__ __forceinline__ unsigned kth_largest(const unsigned (&u)[NV], int k) {
    unsigned Tk = 0u;
    for (int bit = 31; bit >= 0; --bit) {
        const unsigned cand = Tk | (1u << bit); int cnt = 0;
#pragma unroll
        for (int j = 0; j < NV; ++j) cnt += __popcll(__ballot(u[j] >= cand));
        if (cnt >= k) Tk = cand;
    }
    return Tk;
}

__device__ __forceinline__ unsigned wave_max_u(unsigned x) {
    unsigned y;
    y = dpp_u<0x111>(x); x = x > y ? x : y; y = dpp_u<0x112>(x); x = x > y ? x : y; y = dpp_u<0x114>(x); x = x > y ? x : y; y = dpp_u<0x118>(x); x = x > y ? x : y;
    y = (unsigned)__builtin_amdgcn_update_dpp(0, (int)x, 0x142, 0xA, 0xF, false); x = x > y ? x : y;
    y = (unsigned)__builtin_amdgcn_update_dpp(0, (int)x, 0x143, 0xC, 0xF, false); x = x > y ? x : y;
    return (unsigned)__builtin_amdgcn_readlane((int)x, 63);
}
__device__ __forceinline__ int wave_sum_i(int x) {
    x += __builtin_amdgcn_update_dpp(0, x, 0x111, 0xF, 0xF, false); x += __builtin_amdgcn_update_dpp(0, x, 0x112, 0xF, 0xF, false);
    x += __builtin_amdgcn_update_dpp(0, x, 0x114, 0xF, 0xF, false); x += __builtin_amdgcn_update_dpp(0, x, 0x118, 0xF, 0xF, false);
    x += __builtin_amdgcn_update_dpp(0, x, 0x142, 0xA, 0xF, false); x += __builtin_amdgcn_update_dpp(0, x, 0x143, 0xC, 0xF, false);
    return __builtin_amdgcn_readlane(x, 63);
}
__device__ __forceinline__ float wave_max_f(float x) {
    const int ninf = (int)0xff800000u; float y;
    y = __builtin_bit_cast(float, __builtin_amdgcn_update_dpp(ninf, __builtin_bit_cast(int, x), 0x111, 0xF, 0xF, false)); x = fmaxf(x, y);
    y = __builtin_bit_cast(float, __builtin_amdgcn_update_dpp(ninf, __builtin_bit_cast(int, x), 0x112, 0xF, 0xF, false)); x = fmaxf(x, y);
    y = __builtin_bit_cast(float, __builtin_amdgcn_update_dpp(ninf, __builtin_bit_cast(int, x), 0x114, 0xF, 0xF, false)); x = fmaxf(x, y);
    y = __builtin_bit_cast(float, __builtin_amdgcn_update_dpp(ninf, __builtin_bit_cast(int, x), 0x118, 0xF, 0xF, false)); x = fmaxf(x, y);
    y = __builtin_bit_cast(float, __builtin_amdgcn_update_dpp(ninf, __builtin_bit_cast(int, x), 0x142, 0xA, 0xF, false)); x = fmaxf(x, y);
    y = __builtin_bit_cast(float, __builtin_amdgcn_update_dpp(ninf, __builtin_bit_cast(int, x), 0x143, 0xC, 0xF, false)); x = fmaxf(x, y);
    return __builtin_bit_cast(float, __builtin_amdgcn_readlane(__builtin_bit_cast(int, x), 63));
}
__device__ __forceinline__ int wave_scan_i(int x) {
    x += __builtin_amdgcn_update_dpp(0, x, 0x111, 0xF, 0xF, false); x += __builtin_amdgcn_update_dpp(0, x, 0x112, 0xF, 0xF, false);
    x += __builtin_amdgcn_update_dpp(0, x, 0x114, 0xF, 0xF, false); x += __builtin_amdgcn_update_dpp(0, x, 0x118, 0xF, 0xF, false);
    x += __builtin_amdgcn_update_dpp(0, x, 0x142, 0xA, 0xF, false); x += __builtin_amdgcn_update_dpp(0, x, 0x143, 0xC, 0xF, false);
    return x;
}
__device__ __forceinline__ int hist_find(u32x4 h, int K, int lane, int& chi, int& cnt) {
    const int ls = (int)(h.x + h.y + h.z + h.w); const int inc = wave_scan_i(ls); const int tot = __builtin_amdgcn_readlane(inc, 63);
    const int a3 = tot - inc, a2 = a3 + (int)h.w, a1 = a2 + (int)h.z, a0 = a1 + (int)h.y;
    int myb = -1, mya = 0, myc = 0;
    if (a3 < K && K <= a3 + (int)h.w) { myb = 3; mya = a3; myc = (int)h.w; }
    if (a2 < K && K <= a2 + (int)h.z) { myb = 2; mya = a2; myc = (int)h.z; }
    if (a1 < K && K <= a1 + (int)h.y) { myb = 1; mya = a1; myc = (int)h.y; }
    if (a0 < K && K <= a0 + (int)h.x) { myb = 0; mya = a0; myc = (int)h.x; }
    const unsigned long long m = __ballot(myb >= 0); const int src = m ? (int)__builtin_ctzll(m) : 0;
    chi = __builtin_amdgcn_readlane(mya, src); cnt = __builtin_amdgcn_readlane(myc, src);
    return 4 * src + __builtin_amdgcn_readlane(myb, src);
}
constexpr int LDS_HIST = 131072 + 4096;
__device__ __forceinline__ void p4_indexer(const Ctx& C) {
    unsigned char* ws = C.ws; const int lane = C.lane, wave = C.wave, g = lane >> 4, fr = lane & 15;
    const bf16_t* qidx = (const bf16_t*)(ws + WS_QIDX); const bf16_t* kidx = (const bf16_t*)(ws + WS_KIDX); const float* widx = (const float*)(ws + WS_WIDX);
    bf16_t* idxo = (bf16_t*)(ws + WS_IDX);
    constexpr int SCB = 8192 + 16;
    LAS unsigned char* SC = C.lds;
    LAS unsigned* H = (LAS unsigned*)(C.lds + LDS_HIST + wave * 1024);
    for (int u = blockIdx.x; u < 1024; u += C.G) {
        const int i4 = u >> 8, cc = u & 255, b = cc & 3, j = cc >> 2, qb = (i4 & 1) ? 64 * i4 + 63 - j : 64 * i4 + j;
        const int t0 = qb * 16, ntile = (t0 + 16 + 15) >> 4; const size_t tb = (size_t)b * SEQ; const size_t qrow = tb + t0 + fr;
        bf16x8 Bq[8];
#pragma unroll
        for (int h = 0; h < 8; ++h) Bq[h] = *(const bf16x8*)(qidx + qrow * 256 + h * 32 + 8 * g);
        const f32x4 w0 = *(const f32x4*)(widx + qrow * 8), w1 = *(const f32x4*)(widx + qrow * 8 + 4);
        const float wq[8] = {w0.x, w0.y, w0.z, w0.w, w1.x, w1.y, w1.z, w1.w};
        bf16x8 An[4];
#pragma unroll
        for (int q = 0; q < 4; ++q) { int i = wave + q * NWAVES; i = i < ntile ? i : ntile - 1; An[q] = *(const bf16x8*)(kidx + (tb + 16 * i + fr) * 32 + 8 * g); }
        for (int i0 = wave; i0 < ntile; i0 += 4 * NWAVES) {
            bf16x8 A[4];
#pragma unroll
            for (int q = 0; q < 4; ++q) A[q] = An[q];
#pragma unroll
            for (int q = 0; q < 4; ++q) { int i = i0 + 4 * NWAVES + q * NWAVES; i = i < ntile ? i : ntile - 1; An[q] = *(const bf16x8*)(kidx + (tb + 16 * i + fr) * 32 + 8 * g); }
#pragma unroll
            for (int q = 0; q < 4; ++q) {
                const int i = i0 + q * NWAVES;
                if (i < ntile) {
                    f32x4 sc = (f32x4){0.f, 0.f, 0.f, 0.f};
#pragma unroll
                    for (int h = 0; h < 8; ++h) { const f32x4 d = __builtin_amdgcn_mfma_f32_16x16x32_bf16(A[q], Bq[h], (f32x4){0.f, 0.f, 0.f, 0.f}, 0, 0, 0);
#pragma unroll
                        for (int r = 0; r < 4; ++r) sc[r] = fmaf(wq[h], fmaxf(d[r], 0.f), sc[r]); }
                    const int tq = t0 + fr, s0 = 16 * i + 4 * g; unsigned kq[4];
#pragma unroll
                    for (int r = 0; r < 4; ++r) { const unsigned hb = (unsigned)__builtin_bit_cast(unsigned short, (_Float16)sc[r]); const unsigned ky = (hb & 0x8000u) ? (~hb & 0xffffu) : (hb | 0x8000u); kq[r] = (s0 + r <= tq) ? ky : 0u; }
                    u32x2 w; w.x = kq[0] | (kq[1] << 16); w.y = kq[2] | (kq[3] << 16);
                    *(LAS u32x2*)(SC + fr * SCB + 2 * s0) = w;
                }
            }
        }
        __syncthreads();
#pragma unroll 1
        for (int rr = 0; rr < 2; ++rr) {
            const int row = wave + 8 * rr, tq = t0 + row; bf16_t* out = idxo + (tb + tq) * 256;
            if (tq < 256) {
#pragma unroll
                for (int jj = 0; jj < 4; ++jj) { const int s = jj * 64 + lane; if (s <= tq) out[s] = (bf16_t)s; }
            } else {
                unsigned kp[32];
#pragma unroll
                for (int d = 0; d < 32; ++d) { const int s2 = 2 * (64 * d + lane); unsigned w = *(const LAS unsigned*)(SC + row * SCB + 2 * s2); if (s2 > tq) w = 0u; kp[d] = w; }
                *(LAS u32x4*)(H + 4 * lane) = (u32x4){0u, 0u, 0u, 0u};
#pragma unroll
                for (int d = 0; d < 32; ++d) { const unsigned a = kp[d] & 0xffffu, bq_ = kp[d] >> 16;
                    if (a) __hip_atomic_fetch_add(H + (a >> 8), 1u, __ATOMIC_RELAXED, __HIP_MEMORY_SCOPE_WORKGROUP);
                    if (bq_) __hip_atomic_fetch_add(H + (bq_ >> 8), 1u, __ATOMIC_RELAXED, __HIP_MEMORY_SCOPE_WORKGROUP); }
                asm volatile("s_waitcnt lgkmcnt(0)" ::: "memory");
                int chi1, cnt1; const int b1 = hist_find(*(const LAS u32x4*)(H + 4 * lane), 256, lane, chi1, cnt1);
                asm volatile("s_waitcnt lgkmcnt(0)" ::: "memory");
                *(LAS u32x4*)(H + 4 * lane) = (u32x4){0u, 0u, 0u, 0u};
#pragma unroll
                for (int d = 0; d < 32; ++d) { const unsigned a = kp[d] & 0xffffu, bq_ = kp[d] >> 16;
                    if ((int)(a >> 8) == b1 && a) __hip_atomic_fetch_add(H + (a & 255u), 1u, __ATOMIC_RELAXED, __HIP_MEMORY_SCOPE_WORKGROUP);
                    if ((int)(bq_ >> 8) == b1 && bq_) __hip_atomic_fetch_add(H + (bq_ & 255u), 1u, __ATOMIC_RELAXED, __HIP_MEMORY_SCOPE_WORKGROUP); }
                asm volatile("s_waitcnt lgkmcnt(0)" ::: "memory");
                int chi2, cnt2; const int b2 = hist_find(*(const LAS u32x4*)(H + 4 * lane), 256 - chi1, lane, chi2, cnt2);
                const unsigned T16 = (unsigned)(b1 * 256 + b2); const int need = 256 - chi1 - chi2;
                const bool allties = (need == cnt2); const unsigned thr = allties ? T16 : T16 + 1u;
                unsigned mlo = 0u, mhi = 0u;
#pragma unroll
                for (int d = 0; d < 16; ++d) { const unsigned a = kp[d] & 0xffffu, bq_ = kp[d] >> 16; mlo |= (a >= thr ? 1u : 0u) << (2 * d); mlo |= (bq_ >= thr ? 1u : 0u) << (2 * d + 1); }
#pragma unroll
                for (int d = 16; d < 32; ++d) { const unsigned a = kp[d] & 0xffffu, bq_ = kp[d] >> 16; mhi |= (a >= thr ? 1u : 0u) << (2 * (d - 16)); mhi |= (bq_ >= thr ? 1u : 0u) << (2 * (d - 16) + 1); }
                LAS bf16_t* stage = (LAS bf16_t*)(SC + row * SCB);
                const int mycnt = __popc(mlo) + __popc(mhi); int base = wave_scan_i(mycnt) - mycnt;
                while (mlo) { const int bp = __builtin_ctz(mlo); stage[base++] = (bf16_t)(2 * (64 * (bp >> 1) + lane) + (bp & 1)); mlo &= mlo - 1u; }
                while (mhi) { const int bp = __builtin_ctz(mhi); stage[base++] = (bf16_t)(2 * (64 * ((bp >> 1) + 16) + lane) + (bp & 1)); mhi &= mhi - 1u; }
                if (!allties) {
                    int eqb = 0; const int pos0 = 256 - need;
#pragma unroll 4
                    for (int d = 0; d < 32; ++d) {
                        const bool eq0 = ((kp[d] & 0xffffu) == T16), eq1 = ((kp[d] >> 16) == T16);
                        const unsigned long long m0 = __ballot(eq0), m1 = __ballot(eq1);
                        const int below = (int)__builtin_amdgcn_mbcnt_hi((unsigned)(m0 >> 32), __builtin_amdgcn_mbcnt_lo((unsigned)m0, 0u)) + (int)__builtin_amdgcn_mbcnt_hi((unsigned)(m1 >> 32), __builtin_amdgcn_mbcnt_lo((unsigned)m1, 0u));
                        const int r0 = eqb + below, r1 = r0 + (eq0 ? 1 : 0);
                        if (eq0 && r0 < need) stage[pos0 + r0] = (bf16_t)(2 * (64 * d + lane));
                        if (eq1 && r1 < need) stage[pos0 + r1] = (bf16_t)(2 * (64 * d + lane) + 1);
                        eqb += __popcll(m0) + __popcll(m1);
                    }
                }
                asm volatile("s_waitcnt lgkmcnt(0)" ::: "memory");
                *(u32x2*)(out + 4 * lane) = *(const LAS u32x2*)(stage + 4 * lane);
            }
        }
        __syncthreads();
    }
}

__device__ __forceinline__ void p4_memattn(const Ctx& C) {
    unsigned char* ws = C.ws; const int lane = C.lane, wave = C.wave, g = lane >> 4, fr = lane & 15;
    const bf16_t* memq = (const bf16_t*)(ws + WS_MEMQ); const bf16_t* kmem = (const bf16_t*)(ws + WS_KMEM); const bf16_t* vmt = (const bf16_t*)(ws + WS_VMEMT);
    bf16_t* ymem = (bf16_t*)(ws + WS_YM) + 512;
    LAS unsigned char* KL = C.lds; LAS unsigned char* VL = C.lds + 65536;
    for (int su = blockIdx.x; su < 256; su += C.G) {
        const int bh = su >> 4, j = su & 15, b = bh >> 2, h = bh & 3;
        const char* kb = (const char*)(kmem + (size_t)(bh * 256) * 128); const char* vb = (const char*)(vmt + (size_t)(bh * 128) * 256);
#pragma unroll
        for (int pp = 0; pp < 8; ++pp) { const int p = wave + 8 * pp;
            { const int row = 4 * p + g; const int c = fr ^ (2 * (row & 7)); __builtin_amdgcn_global_load_lds((const unsigned*)(kb + row * 256 + 16 * c), (LAS unsigned*)(KL + 1024 * p), 16, 0, 0); }
            { const int row = 2 * p + (lane >> 5); const int c = (lane & 31) ^ (row & 15); __builtin_amdgcn_global_load_lds((const unsigned*)(vb + row * 512 + 16 * c), (LAS unsigned*)(VL + 1024 * p), 16, 0, 0); } }
        asm volatile("s_waitcnt vmcnt(0)" ::: "memory");
        __syncthreads();
#pragma unroll 1
        for (int u = 0; u < 2; ++u) {
            const int t0 = b * SEQ + (2 * j + u) * 128 + wave * 16;
            bf16x8 Bq[4];
#pragma unroll
            for (int kk = 0; kk < 4; ++kk) Bq[kk] = *(const bf16x8*)(memq + (size_t)(t0 + fr) * 512 + h * 128 + 32 * kk + 8 * g);
            f32x4 sc[16];
#pragma unroll
            for (int i = 0; i < 16; ++i) { if ((i & 1) == 0) __builtin_amdgcn_sched_barrier(0); f32x4 a = (f32x4){0.f, 0.f, 0.f, 0.f}; const int row = 16 * i + fr;
#pragma unroll
                for (int kk = 0; kk < 4; ++kk) { const bf16x8 A = *(const LAS bf16x8*)(KL + row * 256 + 16 * ((4 * kk + g) ^ (2 * (row & 7)))); a = __builtin_amdgcn_mfma_f32_16x16x32_bf16(A, Bq[kk], a, 0, 0, 0); }
                sc[i] = a; }
            const float scale = 0.08838834764831845f;
            float mx = -3.0e38f;
#pragma unroll
            for (int i = 0; i < 16; ++i)
#pragma unroll
                for (int r = 0; r < 4; ++r) { sc[i][r] *= scale; mx = fmaxf(mx, sc[i][r]); }
            mx = fmaxf(mx, __shfl_xor(mx, 16)); mx = fmaxf(mx, __shfl_xor(mx, 32));
            float sum = 0.f;
#pragma unroll
            for (int i = 0; i < 16; ++i)
#pragma unroll
                for (int r = 0; r < 4; ++r) { sc[i][r] = __expf(sc[i][r] - mx); sum += sc[i][r]; }
            sum += __shfl_xor(sum, 16); sum += __shfl_xor(sum, 32);
            const float inv = 1.0f / sum;
            bf16x8 Pb[8];
#pragma unroll
            for (int ks = 0; ks < 8; ++ks) { u32x4 w; w.x = pk2(sc[2 * ks][0] * inv, sc[2 * ks][1] * inv); w.y = pk2(sc[2 * ks][2] * inv, sc[2 * ks][3] * inv);
                w.z = pk2(sc[2 * ks + 1][0] * inv, sc[2 * ks + 1][1] * inv); w.w = pk2(sc[2 * ks + 1][2] * inv, sc[2 * ks + 1][3] * inv); Pb[ks] = __builtin_bit_cast(bf16x8, w); }
#pragma unroll
            for (int dt = 0; dt < 8; ++dt) {
                __builtin_amdgcn_sched_barrier(0);
                f32x4 o = (f32x4){0.f, 0.f, 0.f, 0.f}; const int row = 16 * dt + fr;
#pragma unroll
                for (int ks = 0; ks < 8; ++ks) { const int ch = 4 * ks + (g >> 1);
                    const u32x2 lo = *(const LAS u32x2*)(VL + row * 512 + 16 * (ch ^ (row & 15)) + 8 * (g & 1)), hi = *(const LAS u32x2*)(VL + row * 512 + 16 * ((ch + 2) ^ (row & 15)) + 8 * (g & 1));
                    u32x4 w; w.x = lo.x; w.y = lo.y; w.z = hi.x; w.w = hi.y;
                    o = __builtin_amdgcn_mfma_f32_16x16x32_bf16(__builtin_bit_cast(bf16x8, w), Pb[ks], o, 0, 0, 0); }
                u32x2 w; w.x = pk2(o[0], o[1]); w.y = pk2(o[2], o[3]);
                *(u32x2*)(ymem + (size_t)(t0 + fr) * 1024 + h * 128 + 16 * dt + 4 * g) = w;
            }
        }
        __syncthreads();
    }
}

constexpr int LDS_RELB = 131072 + 1024;
constexpr int LDS_LUT = LDS_RELB + 1024;
__device__ __forceinline__ void tr_read8(const unsigned (&a)[8], u32x2 (&d)[8]) {
    asm volatile("ds_read_b64_tr_b16 %0, %8\n\tds_read_b64_tr_b16 %1, %9\n\tds_read_b64_tr_b16 %2, %10\n\tds_read_b64_tr_b16 %3, %11\n\t"
                 "ds_read_b64_tr_b16 %4, %12\n\tds_read_b64_tr_b16 %5, %13\n\tds_read_b64_tr_b16 %6, %14\n\tds_read_b64_tr_b16 %7, %15\n\ts_waitcnt lgkmcnt(0)"
                 : "=&v"(d[0]), "=&v"(d[1]), "=&v"(d[2]), "=&v"(d[3]), "=&v"(d[4]), "=&v"(d[5]), "=&v"(d[6]), "=&v"(d[7])
                 : "v"(a[0]), "v"(a[1]), "v"(a[2]), "v"(a[3]), "v"(a[4]), "v"(a[5]), "v"(a[6]), "v"(a[7]) : "memory");
}
constexpr int LDS_DSAX = 131072 + 4096;
__device__ __forceinline__ void p5_dsa_attn(const Ctx& C, int qsel) {
    unsigned char* ws = C.ws; const int lane = C.lane, wave = C.wave, g = lane >> 4, fr = lane & 15;
    const bf16_t* qlat = (const bf16_t*)(ws + WS_QLAT); const bf16_t* kvl = (const bf16_t*)(ws + WS_KVL); const bf16_t* idxb = (const bf16_t*)(ws + WS_IDX);
    bf16_t* olat = (bf16_t*)(ws + WS_OLAT);
    LAS int* lut = (LAS int*)(C.lds + LDS_LUT);
    if (C.tid < 128) { const int n = C.tid; int bk = n; if (n >= 16) { bk = 16 + (int)(logf((float)n * (1.0f / 16.0f)) / 2.0794415416798357f * 16.0f); bk = bk > 31 ? 31 : bk; } lut[n] = bk; }
    __syncthreads();
    LAS unsigned char* my = C.lds + wave * 16384; const unsigned mybase = (unsigned)(uintptr_t)my;
    LAS bf16_t* IDXL = (LAS bf16_t*)(C.lds + LDS_DSAX + wave * 1024); LAS bf16_t* BKL = IDXL + 256;
    unsigned* qctr = (unsigned*)(ws + WS_CTL) + CW_DSAQ + 64 * qsel;
    const int qq = fr >> 2, p2 = fr & 3;
    bf16x8 Bbias;
    { float bv[8];
#pragma unroll
      for (int j = 0; j < 8; ++j) bv[j] = C.in[2][(8 * g + j) * 8 + (fr & 7)];
      Bbias = __builtin_bit_cast(bf16x8, pack8(bv)); }
    unsigned qkoff[2][4];
#pragma unroll
    for (int i = 0; i < 2; ++i) { const int ph = 4 * (fr & 7) + 2 * i + (fr >> 3);
#pragma unroll
        for (int kk = 0; kk < 4; ++kk) qkoff[i][kk] = (unsigned)(ph * 256 + 16 * ((4 * kk + g) ^ (2 * (ph & 7)))); }
    const int ph0 = 4 * (4 * (g & 1) + qq) + (g >> 1), ph1 = ph0 + 2;
    auto fetch_batch = [&]() -> int { int q0 = 0; if (lane == 0) q0 = (int)__hip_atomic_fetch_add(qctr, 4u, __ATOMIC_RELAXED, __HIP_MEMORY_SCOPE_AGENT); return __builtin_amdgcn_readfirstlane(q0); };
    int q = fetch_batch();
    u32x2 ixw = (u32x2){0u, 0u}; bf16x8 Bq[4];
    if (q < T) { ixw = *(const u32x2*)(idxb + (size_t)q * 256 + 4 * lane);
#pragma unroll
        for (int kk = 0; kk < 4; ++kk) Bq[kk] = *(const bf16x8*)(qlat + (size_t)q * 1024 + (fr & 7) * 128 + 32 * kk + 8 * g); }
    bool staged = false;
    while (q < T) {
        const int b = q >> 12, s = q & (SEQ - 1); const int nvalid = s + 1 < 256 ? s + 1 : 256;
        const char* kvb = (const char*)(kvl + (size_t)b * SEQ * 128);
        const int nsub = (nvalid + 31) >> 5;
#define DSA_STAGE(IXW, SS, NV, KVB) do { \
            int ix_[4] = {(int)((IXW).x & 0xffffu), (int)((IXW).x >> 16), (int)((IXW).y & 0xffffu), (int)((IXW).y >> 16)}; unsigned bk_[4]; \
            _Pragma("unroll") for (int j_ = 0; j_ < 4; ++j_) { if (4 * lane + j_ >= (NV)) ix_[j_] = 0; const int dist_ = (SS) - ix_[j_]; bk_[j_] = (unsigned)(dist_ >= 128 ? 31 : lut[dist_ < 0 ? 0 : dist_]); } \
            u32x2 wi_; wi_.x = (unsigned)ix_[0] | ((unsigned)ix_[1] << 16); wi_.y = (unsigned)ix_[2] | ((unsigned)ix_[3] << 16); *(LAS u32x2*)(IDXL + 4 * lane) = wi_; \
            u32x2 wb_; wb_.x = bk_[0] | (bk_[1] << 16); wb_.y = bk_[2] | (bk_[3] << 16); *(LAS u32x2*)(BKL + 4 * lane) = wb_; \
            asm volatile("s_waitcnt lgkmcnt(0)" ::: "memory"); \
            const u32x4 rw_ = *(const LAS u32x4*)(IDXL + 8 * g); const unsigned rws_[4] = {rw_.x, rw_.y, rw_.z, rw_.w}; \
            _Pragma("unroll") for (int p_ = 0; p_ < 8; ++p_) { const int srow_ = (int)((rws_[p_ >> 1] >> (16 * (p_ & 1))) & 0xffffu); const int c_ = fr ^ (2 * ((4 * p_ + g) & 7)); \
                __builtin_amdgcn_global_load_lds((const unsigned*)((KVB) + (size_t)srow_ * 256 + 16 * c_), (LAS unsigned*)(my + 1024 * p_), 16, 0, 0); } } while (0)
        if (!staged) { asm volatile("s_waitcnt vmcnt(0)" ::: "memory"); DSA_STAGE(ixw, s, nvalid, kvb); }
        int qn = ((q & 3) != 3) ? q + 1 : fetch_batch();
        u32x2 ixn = (u32x2){0u, 0u}; bf16x8 Bqn[4];
        if (qn < T) { ixn = *(const u32x2*)(idxb + (size_t)qn * 256 + 4 * lane);
#pragma unroll
            for (int kk = 0; kk < 4; ++kk) Bqn[kk] = *(const bf16x8*)(qlat + (size_t)qn * 1024 + (fr & 7) * 128 + 32 * kk + 8 * g); }
        else {
#pragma unroll
            for (int kk = 0; kk < 4; ++kk) Bqn[kk] = Bq[kk]; }
        float m_ref = 0.f, l_part = 0.f;
        f32x4 O[8];
#pragma unroll
        for (int cc = 0; cc < 8; ++cc) O[cc] = (f32x4){0.f, 0.f, 0.f, 0.f};
#pragma unroll
        for (int sc_ = 0; sc_ < 8; ++sc_) {
          if (sc_ < nsub) {
            LAS unsigned char* cur = my + (sc_ & 1) * 8192; const unsigned curb = mybase + (sc_ & 1) * 8192;
            if (sc_ + 1 < nsub) {
                LAS unsigned char* nb = my + ((sc_ + 1) & 1) * 8192;
                const u32x4 rw = *(const LAS u32x4*)(IDXL + 32 * (sc_ + 1) + 8 * g); const unsigned rws[4] = {rw.x, rw.y, rw.z, rw.w};
#pragma unroll
                for (int p = 0; p < 8; ++p) { const int srow = (int)((rws[p >> 1] >> (16 * (p & 1))) & 0xffffu); const int c = fr ^ (2 * ((4 * p + g) & 7));
                    __builtin_amdgcn_global_load_lds((const unsigned*)(kvb + (size_t)srow * 256 + 16 * c), (LAS unsigned*)(nb + 1024 * p), 16, 0, 0); }
                asm volatile("s_waitcnt vmcnt(8)" ::: "memory");
            } else asm volatile("s_waitcnt vmcnt(0)" ::: "memory");
            f32x4 sc[2];
#pragma unroll
            for (int i = 0; i < 2; ++i) {
                const int pos = (int)BKL[32 * sc_ + 16 * i + fr] - 8 * g;
                u32x4 oh; oh.x = (pos == 0 ? 0x3F80u : 0u) | (pos == 1 ? 0x3F800000u : 0u); oh.y = (pos == 2 ? 0x3F80u : 0u) | (pos == 3 ? 0x3F800000u : 0u);
                oh.z = (pos == 4 ? 0x3F80u : 0u) | (pos == 5 ? 0x3F800000u : 0u); oh.w = (pos == 6 ? 0x3F80u : 0u) | (pos == 7 ? 0x3F800000u : 0u);
                f32x4 a = __builtin_amdgcn_mfma_f32_16x16x32_bf16(__builtin_bit_cast(bf16x8, oh), Bbias, (f32x4){0.f, 0.f, 0.f, 0.f}, 0, 0, 0);
#pragma unroll
                for (int kk = 0; kk < 4; ++kk) a = __builtin_amdgcn_mfma_f32_16x16x32_bf16(*(const LAS bf16x8*)(cur + qkoff[i][kk]), Bq[kk], a, 0, 0, 0);
                sc[i] = a; }
            if (nvalid < 256) {
#pragma unroll
                for (int i = 0; i < 2; ++i)
#pragma unroll
                    for (int r = 0; r < 4; ++r) if (sc_ * 32 + 16 * i + 4 * g + r >= nvalid) sc[i][r] = -INFINITY;
            }
            if (sc_ == 0) { float mx = fmaxf(fmaxf(fmaxf(sc[0][0], sc[0][1]), fmaxf(sc[0][2], sc[0][3])), fmaxf(fmaxf(sc[1][0], sc[1][1]), fmaxf(sc[1][2], sc[1][3])));
                mx = fmaxf(mx, __shfl_xor(mx, 16)); mx = fmaxf(mx, __shfl_xor(mx, 32)); m_ref = mx; }
#pragma unroll
            for (int i = 0; i < 2; ++i)
#pragma unroll
                for (int r = 0; r < 4; ++r) { sc[i][r] = __expf(sc[i][r] - m_ref); l_part += sc[i][r]; }
            u32x4 w; w.x = pk2(sc[0][0], sc[0][1]); w.y = pk2(sc[0][2], sc[0][3]); w.z = pk2(sc[1][0], sc[1][1]); w.w = pk2(sc[1][2], sc[1][3]);
            const bf16x8 Pa = __builtin_bit_cast(bf16x8, w);
#pragma unroll
            for (int hf = 0; hf < 2; ++hf) {
                unsigned ad[8]; u32x2 dd[8];
#pragma unroll
                for (int c4 = 0; c4 < 4; ++c4) { const int chk = 2 * (4 * hf + c4) + (p2 >> 1);
                    ad[2 * c4] = curb + ph0 * 256 + 16 * (chk ^ (2 * (ph0 & 7))) + 8 * (p2 & 1); ad[2 * c4 + 1] = curb + ph1 * 256 + 16 * (chk ^ (2 * (ph1 & 7))) + 8 * (p2 & 1); }
                tr_read8(ad, dd);
#pragma unroll
                for (int c4 = 0; c4 < 4; ++c4) { u32x4 bw; bw.x = dd[2 * c4].x; bw.y = dd[2 * c4].y; bw.z = dd[2 * c4 + 1].x; bw.w = dd[2 * c4 + 1].y;
                    O[4 * hf + c4] = __builtin_amdgcn_mfma_f32_16x16x32_bf16(Pa, __builtin_bit_cast(bf16x8, bw), O[4 * hf + c4], 0, 0, 0); }
            }
            asm volatile("" ::: "memory");
          }
        }
        staged = false;
        if (qn < T) { const int bn = qn >> 12, sn = qn & (SEQ - 1); const int nvn = sn + 1 < 256 ? sn + 1 : 256; const char* kvbn = (const char*)(kvl + (size_t)bn * SEQ * 128);
            DSA_STAGE(ixn, sn, nvn, kvbn); staged = true; }
        float l_run = l_part; l_run += __shfl_xor(l_run, 16); l_run += __shfl_xor(l_run, 32);
        const float inv = 1.0f / l_run; float ir[4];
#pragma unroll
        for (int r = 0; r < 4; ++r) ir[r] = __shfl(inv, 4 * g + r);
        if (g < 2) {
#pragma unroll
            for (int cc = 0; cc < 8; ++cc)
#pragma unroll
                for (int r = 0; r < 4; ++r) olat[(size_t)q * 1024 + (4 * g + r) * 128 + 16 * cc + fr] = (bf16_t)f2bf(O[cc][r] * ir[r]);
        }
        q = qn; ixw = ixn;
#pragma unroll
        for (int kk = 0; kk < 4; ++kk) Bq[kk] = Bqn[kk];
    }
#undef DSA_STAGE
}

constexpr int RWM_LDS = 15872;
__device__ __forceinline__ bf16x8 frag_pack(f32x4 lo, f32x4 hi) { u32x4 w; w.x = pk2(lo.x, lo.y); w.y = pk2(lo.z, lo.w); w.z = pk2(hi.x, hi.y); w.w = pk2(hi.z, hi.w); return __builtin_bit_cast(bf16x8, w); }
__device__ __forceinline__ bf16x8 frag_pack_lo(f32x4 lo) { u32x4 w; w.x = pk2(lo.x, lo.y); w.y = pk2(lo.z, lo.w); w.z = 0u; w.w = 0u; return __builtin_bit_cast(bf16x8, w); }
struct RwIn { u32x4 e[2], k[2], a[2]; };
template <int MODE> __device__ __forceinline__ void rwm_fetch(RwIn& w, const bf16_t* pe, const bf16_t* pk, const bf16_t* pa, const bf16_t* pr, const bf16_t* pv, const bf16_t* pg, size_t t0, int h, int g, int fr) {
    const size_t rowoff = (t0 + fr) * 512 + h * 64;
#pragma unroll
    for (int k2 = 0; k2 < 2; ++k2) { const int c0 = 32 * k2 + 8 * g; w.e[k2] = *(const u32x4*)(pe + rowoff + c0); w.k[k2] = *(const u32x4*)(pk + rowoff + c0); w.a[k2] = *(const u32x4*)(pa + rowoff + c0);
        }
}
__device__ __forceinline__ void tr_read4(const unsigned (&a)[4], u32x2 (&d)[4]) {
    asm volatile("ds_read_b64_tr_b16 %0, %4\n\tds_read_b64_tr_b16 %1, %5\n\tds_read_b64_tr_b16 %2, %6\n\tds_read_b64_tr_b16 %3, %7\n\ts_waitcnt lgkmcnt(0)"
                 : "=&v"(d[0]), "=&v"(d[1]), "=&v"(d[2]), "=&v"(d[3]) : "v"(a[0]), "v"(a[1]), "v"(a[2]), "v"(a[3]) : "memory");
}
template <int O0, int O1, int O2, int O3> __device__ __forceinline__ void tr_read4_off(unsigned base, u32x2 (&d)[4]) {
    asm volatile("ds_read_b64_tr_b16 %0, %4 offset:%5\n\tds_read_b64_tr_b16 %1, %4 offset:%6\n\tds_read_b64_tr_b16 %2, %4 offset:%7\n\tds_read_b64_tr_b16 %3, %4 offset:%8\n\ts_waitcnt lgkmcnt(0)"
                 : "=&v"(d[0]), "=&v"(d[1]), "=&v"(d[2]), "=&v"(d[3]) : "v"(base), "i"(O0), "i"(O1), "i"(O2), "i"(O3) : "memory");
}
__device__ __forceinline__ bf16x8 frag_lo_raw(u32x2 lo) { u32x4 w; w.x = lo.x; w.y = lo.y; w.z = 0u; w.w = 0u; return __builtin_bit_cast(bf16x8, w); }
__device__ __forceinline__ bf16x8 frag_pack_raw(f32x4 lo, u32x2 hi) { u32x4 w; w.x = pk2(lo.x, lo.y); w.y = pk2(lo.z, lo.w); w.z = hi.x; w.w = hi.y; return __builtin_bit_cast(bf16x8, w); }
template <int MODE> __device__ __forceinline__ void rwm_task(const Ctx& C, int bh, int ch) {
    unsigned char* ws = C.ws; const int lane = C.lane, g = lane >> 4, fr = lane & 15; const int b = bh >> 3, h = bh & 7;
    const bf16_t* pr = (const bf16_t*)(ws + WS_RW_R); const bf16_t* pk = (const bf16_t*)(ws + WS_RW_K); const bf16_t* pv = (const bf16_t*)(ws + WS_RW_V);
    const bf16_t* pa = (const bf16_t*)(ws + WS_RW_A); const bf16_t* pe = (const bf16_t*)(ws + WS_RW_E); const bf16_t* pg = (const bf16_t*)(ws + WS_RW_G);
    bf16_t* yo = (bf16_t*)(ws + WS_YM);
    float* PQ = (float*)(C.dout + DO_PQ);
    LAS unsigned char* my = C.lds + C.wave * RWM_LDS; const unsigned myb = (unsigned)(uintptr_t)my;
    LAS unsigned char* SI = my; LAS unsigned char* BI = my + 9216; LAS unsigned char* KI = my + 11264; LAS float* CL = (LAS float*)(my + 13312); LAS unsigned char* VI = my + 13824;
    const gfp in16 = (gfp)C.in[16], in17 = (gfp)C.in[17], in18 = (gfp)C.in[18], in19 = (gfp)C.in[19], in20 = (gfp)C.in[20];
    const size_t tok0 = (size_t)b * SEQ + (size_t)ch * RL;
    const f32x4 Z4 = (f32x4){0.f, 0.f, 0.f, 0.f};
    const float* sbase = PQ + ((size_t)((bh * RCH + (ch > 0 ? ch - 1 : 0)) * 2)) * 4096 + fr * 64 + 4 * g;
    int gv = g; asm volatile("" : "+v"(gv));
    f32x4 S[4][4];
#pragma unroll
    for (int vt = 0; vt < 4; ++vt)
#pragma unroll
        for (int kt = 0; kt < 4; ++kt) {
            if (MODE == 1) { f32x4 x;
#pragma unroll
                for (int r = 0; r < 4; ++r) x[r] = (vt == kt && 4 * gv + r == fr) ? 1.f : 0.f;
                S[vt][kt] = x; }
            else if (MODE == 2 && ch > 0) { gfp sp = (gfp)(sbase + 1024 * vt); asm volatile("" : "+v"(sp));
                S[vt][kt] = *(const __attribute__((address_space(1))) f32x4*)(sp + 16 * kt); }
            else S[vt][kt] = Z4; }
    const bool strict[4] = {4 * g + 0 < fr, 4 * g + 1 < fr, 4 * g + 2 < fr, 4 * g + 3 < fr};
    const bool incl[4] = {4 * g + 0 <= fr, 4 * g + 1 <= fr, 4 * g + 2 <= fr, 4 * g + 3 <= fr};
    const int qq = fr >> 2, p2 = fr & 3; const unsigned trb = myb + (unsigned)((4 * g + qq) * 128 + 8 * p2);
    RwIn nxt; rwm_fetch<MODE>(nxt, pe, pk, pa, pr, pv, pg, tok0, h, g, fr);
#pragma unroll 1
    for (int sub = 0; sub < RL / 16; ++sub) {
        const size_t t0 = tok0 + (size_t)sub * 16;
        int frl = fr, gl_ = g; asm volatile("" : "+v"(frl), "+v"(gl_));
        u32x4 gq[2], rq[2], vq[2];
        { const size_t ro0 = (t0 + frl) * 512 + h * 64 + 8 * gl_;
          if (MODE == 2) { gq[0] = *(const u32x4*)(pg + ro0); gq[1] = *(const u32x4*)(pg + ro0 + 32); rq[0] = *(const u32x4*)(pr + ro0); rq[1] = *(const u32x4*)(pr + ro0 + 32); }
          if (MODE != 1) { vq[0] = *(const u32x4*)(pv + ro0); vq[1] = *(const u32x4*)(pv + ro0 + 32); } }
        const RwIn cur = nxt; rwm_fetch<MODE>(nxt, pe, pk, pa, pr, pv, pg, tok0 + (size_t)(sub + 1 < RL / 16 ? sub + 1 : sub) * 16, h, gl_, frl);
#pragma unroll
        for (int vt = 0; vt < 4; ++vt)
#pragma unroll
            for (int kt = 0; kt < 4; ++kt)
                { u32x2 w; w.x = pk2(S[vt][kt][0], S[vt][kt][1]); w.y = pk2(S[vt][kt][2], S[vt][kt][3]); *(LAS u32x2*)(SI + fr * 144 + 8 * g + vt * 2304 + 32 * kt) = w; }
        bf16x8 kap[2], rtl[2]; float bcoef = 0.f;
        {
            float ssq = 0.f, bsum = 0.f;
#pragma unroll
            for (int k2 = 0; k2 < 2; ++k2) { const int c0 = 32 * k2 + 8 * g; float kv[8]; unpack8(cur.k[k2], kv);
                const f32x4 kk0 = *(const __attribute__((address_space(1))) f32x4*)(in16 + h * 64 + c0), kk1 = *(const __attribute__((address_space(1))) f32x4*)(in16 + h * 64 + c0 + 4); const float kkc[8] = {kk0.x, kk0.y, kk0.z, kk0.w, kk1.x, kk1.y, kk1.z, kk1.w};
#pragma unroll
                for (int j = 0; j < 8; ++j) { const float x = kv[j] * kkc[j]; ssq += x * x; } }
            ssq += __shfl_xor(ssq, 16); ssq += __shfl_xor(ssq, 32);
            const float rn = __builtin_amdgcn_rsqf(fmaxf(ssq, 1e-24f));
#pragma unroll
            for (int k2 = 0; k2 < 2; ++k2) { const int c0 = 32 * k2 + 8 * g; float ev[8], kv[8], aa[8], rv[8];
                __builtin_amdgcn_sched_barrier(0);
                unpack8(cur.e[k2], ev); unpack8(cur.k[k2], kv); unpack8(cur.a[k2], aa);
                if (MODE == 2) unpack8(rq[k2], rv);
                const f32x4 ka0 = *(const __attribute__((address_space(1))) f32x4*)(in17 + h * 64 + c0), ka1 = *(const __attribute__((address_space(1))) f32x4*)(in17 + h * 64 + c0 + 4); const float kac[8] = {ka0.x, ka0.y, ka0.z, ka0.w, ka1.x, ka1.y, ka1.z, ka1.w};
                const f32x4 kk0 = *(const __attribute__((address_space(1))) f32x4*)(in16 + h * 64 + c0), kk1 = *(const __attribute__((address_space(1))) f32x4*)(in16 + h * 64 + c0 + 4); const float kkc[8] = {kk0.x, kk0.y, kk0.z, kk0.w, kk1.x, kk1.y, kk1.z, kk1.w};
                float rkc[8];
                if (MODE == 2) { const f32x4 r0 = *(const __attribute__((address_space(1))) f32x4*)(in18 + h * 64 + c0), r1 = *(const __attribute__((address_space(1))) f32x4*)(in18 + h * 64 + c0 + 4); rkc[0] = r0.x; rkc[1] = r0.y; rkc[2] = r0.z; rkc[3] = r0.w; rkc[4] = r1.x; rkc[5] = r1.y; rkc[6] = r1.z; rkc[7] = r1.w; }
                float kt_[8], bt_[8], kxt_[8], rt_[8];
#pragma unroll
                for (int j = 0; j < 8; ++j) {
                    float c = ev[j]; c += dpp_f<0x111>(c); c += dpp_f<0x112>(c); c += dpp_f<0x114>(c); c += dpp_f<0x118>(c);
                    const float kx = kv[j] * (1.0f + (aa[j] - 1.0f) * kac[j]); const float kk = kv[j] * kkc[j] * rn;
                    const float e2 = __expf(c), e3 = __builtin_amdgcn_rcpf(e2), e1 = e3 * __expf(ev[j]);
                    kt_[j] = kk * e1; bt_[j] = kk * aa[j] * e2; kxt_[j] = kx * e2;
                    if (MODE == 2) { rt_[j] = rv[j] * e3; bsum += rv[j] * kx * rkc[j]; } else rt_[j] = 0.f;
                    if (fr == 15) CL[c0 + j] = e3;
                }
                kap[k2] = __builtin_bit_cast(bf16x8, pack8(kt_)); if (MODE == 2) rtl[k2] = __builtin_bit_cast(bf16x8, pack8(rt_));
                *(LAS u32x4*)(BI + fr * 128 + 64 * k2 + 16 * g) = pack8(bt_); *(LAS u32x4*)(KI + fr * 128 + 64 * k2 + 16 * g) = pack8(kxt_);
            }
            if (MODE == 2) { bsum += __shfl_xor(bsum, 16); bsum += __shfl_xor(bsum, 32); bcoef = bsum; }
        }
        bf16x8 bet[2], kxf[2];
#pragma unroll
        for (int k2 = 0; k2 < 2; ++k2) { bet[k2] = *(const LAS bf16x8*)(BI + fr * 128 + 64 * k2 + 16 * g); kxf[k2] = *(const LAS bf16x8*)(KI + fr * 128 + 64 * k2 + 16 * g); }
        u32x2 VT[4];
        if (MODE != 1) {
#pragma unroll
            for (int k2 = 0; k2 < 2; ++k2) *(LAS u32x4*)(VI + fr * 128 + 64 * k2 + 16 * g) = vq[k2];
            tr_read4_off<13824, 13824 + 32, 13824 + 64, 13824 + 96>(trb, VT);
        } else {
#pragma unroll
            for (int vt = 0; vt < 4; ++vt) { VT[vt].x = 0u; VT[vt].y = 0u; }
        }
        f32x4 AT = Z4, BmT = Z4, C1T = Z4, C2T = Z4;
#pragma unroll
        for (int k2 = 0; k2 < 2; ++k2) { AT = __builtin_amdgcn_mfma_f32_16x16x32_bf16(bet[k2], kap[k2], AT, 0, 0, 0);
            if (MODE != 1) BmT = __builtin_amdgcn_mfma_f32_16x16x32_bf16(kxf[k2], kap[k2], BmT, 0, 0, 0);
            if (MODE == 2) { C1T = __builtin_amdgcn_mfma_f32_16x16x32_bf16(bet[k2], rtl[k2], C1T, 0, 0, 0); C2T = __builtin_amdgcn_mfma_f32_16x16x32_bf16(kxf[k2], rtl[k2], C2T, 0, 0, 0); } }
#pragma unroll
        for (int r = 0; r < 4; ++r) { AT[r] = strict[r] ? AT[r] : 0.f; BmT[r] = strict[r] ? BmT[r] : 0.f; C1T[r] = incl[r] ? C1T[r] : 0.f; C2T[r] = incl[r] ? C2T[r] : 0.f; }
        float tr[16];
        int frv = fr; asm volatile("" : "+v"(frv));
#pragma unroll
        for (int c = 15; c >= 0; --c) { float s = (c == frv) ? 1.f : 0.f;
#pragma unroll
            for (int j = c + 1; j < 16; ++j) { const float ajc = __builtin_bit_cast(float, __builtin_amdgcn_readlane(__builtin_bit_cast(int, AT[c & 3]), j + 16 * (c >> 2))); s = fmaf(-tr[j], ajc, s); }
            tr[c] = s; }
        f32x4 Tq;
#pragma unroll
        for (int jj = 0; jj < 4; ++jj) Tq[jj] = g == 0 ? tr[jj] : (g == 1 ? tr[4 + jj] : (g == 2 ? tr[8 + jj] : tr[12 + jj]));
        const bf16x8 Tf = frag_pack_lo(Tq), Bmf = frag_pack_lo(BmT), Cf = frag_pack(C1T, C2T);
        f32x4 Zt[4], Yt[4];
#pragma unroll
        for (int vt = 0; vt < 4; ++vt) {
            const int v = 16 * vt + fr;
            const bf16x8 s0 = *(const LAS bf16x8*)(SI + v * 144 + 16 * g), s1 = *(const LAS bf16x8*)(SI + v * 144 + 64 + 16 * g);
            f32x4 rhs = __builtin_amdgcn_mfma_f32_16x16x32_bf16(kap[0], s0, Z4, 0, 0, 0); rhs = __builtin_amdgcn_mfma_f32_16x16x32_bf16(kap[1], s1, rhs, 0, 0, 0);
            if (MODE != 1) rhs = __builtin_amdgcn_mfma_f32_16x16x32_bf16(Bmf, frag_lo_raw(VT[vt]), rhs, 0, 0, 0);
            f32x4 z = __builtin_amdgcn_mfma_f32_16x16x32_bf16(Tf, frag_pack_lo(rhs), Z4, 0, 0, 0);
            Zt[vt] = -z;
            if (MODE == 2) { f32x4 y = __builtin_amdgcn_mfma_f32_16x16x32_bf16(rtl[0], s0, Z4, 0, 0, 0); y = __builtin_amdgcn_mfma_f32_16x16x32_bf16(rtl[1], s1, y, 0, 0, 0);
                Yt[vt] = __builtin_amdgcn_mfma_f32_16x16x32_bf16(Cf, frag_pack_raw(Zt[vt], VT[vt]), y, 0, 0, 0); }
        }
        if (MODE == 2) {
            u32x2 GT[4];
            {
#pragma unroll
                for (int k2 = 0; k2 < 2; ++k2) *(LAS u32x4*)(VI + fr * 128 + 64 * k2 + 16 * g) = gq[k2];
                tr_read4_off<13824, 13824 + 32, 13824 + 64, 13824 + 96>(trb, GT);
            }
#pragma unroll
            for (int r = 0; r < 4; ++r) {
                const float mean = row_sum_f(Yt[0][r] + Yt[1][r] + Yt[2][r] + Yt[3][r]) * (1.0f / 64.0f);
                const float d0 = Yt[0][r] - mean, d1 = Yt[1][r] - mean, d2 = Yt[2][r] - mean, d3 = Yt[3][r] - mean;
                const float rstd = rsqrtf(row_sum_f(d0 * d0 + d1 * d1 + d2 * d2 + d3 * d3) * (1.0f / 64.0f) + 64e-5f);
                const float bc = __shfl(bcoef, 4 * g + r); const float dd_[4] = {d0, d1, d2, d3}; const size_t ro = (t0 + 4 * gl_ + r) * 1024 + h * 64 + frl;
#pragma unroll
                for (int vt = 0; vt < 4; ++vt) { const unsigned gw2 = r < 2 ? GT[vt].x : GT[vt].y, vw2 = r < 2 ? VT[vt].x : VT[vt].y; const float gate = (r & 1) ? bfhi(gw2) : bflo(gw2), vval = (r & 1) ? bfhi(vw2) : bflo(vw2);
                    yo[ro + 16 * vt] = (bf16_t)f2bf((dd_[vt] * rstd * in19[h * 64 + 16 * vt + frl] + in20[h * 64 + 16 * vt + frl] + bc * vval) * gate); }
            }
        }
        {
            u32x2 db[4], dk[4], dd[8];
            tr_read4_off<9216, 9216 + 32, 9216 + 64, 9216 + 96>(trb, db); tr_read4_off<11264, 11264 + 32, 11264 + 64, 11264 + 96>(trb, dk);
#pragma unroll
            for (int kt = 0; kt < 4; ++kt) { dd[2 * kt] = db[kt]; dd[2 * kt + 1] = dk[kt]; }
            f32x4 gl[4];
#pragma unroll
            for (int kt = 0; kt < 4; ++kt) gl[kt] = *(const LAS f32x4*)(CL + 16 * kt + 4 * g);
#pragma unroll
            for (int vt = 0; vt < 4; ++vt) { const bf16x8 Af = frag_pack_raw(Zt[vt], VT[vt]);
#pragma unroll
                for (int kt = 0; kt < 4; ++kt) { u32x4 bw; bw.x = dd[2 * kt].x; bw.y = dd[2 * kt].y; bw.z = dd[2 * kt + 1].x; bw.w = dd[2 * kt + 1].y;
                    S[vt][kt] = __builtin_amdgcn_mfma_f32_16x16x32_bf16(__builtin_bit_cast(bf16x8, bw), Af, S[vt][kt], 0, 0, 0) * gl[kt]; } }
        }
    }
    if (MODE != 2) { float* dst = PQ + ((size_t)((bh * RCH + ch) * 2 + MODE)) * 4096 + fr * 64 + 4 * g;
#pragma unroll
        for (int vt = 0; vt < 4; ++vt)
#pragma unroll
            for (int kt = 0; kt < 4; ++kt) *(f32x4*)(dst + vt * 1024 + 16 * kt) = S[vt][kt]; }
}
__device__ __forceinline__ void p4_rwkv_pass1(const Ctx& C) {
    for (int task = C.gw; task < 32 * (RCH - 1) * 2; task += C.ngw) { const int mode = task & 1, rr = task >> 1, ch = rr % (RCH - 1), bh = rr / (RCH - 1);
        if (mode == 0) rwm_task<0>(C, bh, ch); else rwm_task<1>(C, bh, ch); }
}
__device__ __forceinline__ void p6_rwkv_pass3(const Ctx& C) {
    for (int task = (int)blockIdx.x + C.G * C.wave; task < 32 * RCH; task += C.G * NWAVES) rwm_task<2>(C, task / RCH, task % RCH);
}
__device__ __forceinline__ void p5_rwkv_carry(const Ctx& C) {
    float* PQ = (float*)(C.dout + DO_PQ); const int lane = C.lane, wave = C.wave, tid = C.tid;
    LAS float* ST = (LAS float*)C.lds;
    LAS float* PL = (LAS float*)(C.lds + 32768);
    for (int bh = blockIdx.x; bh < 32; bh += C.G) {
        for (int i = tid; i < 4096; i += NTHREADS) ST[i] = 0.f;
        const float* base = PQ + (size_t)(bh * RCH) * 2 * 4096;
        f32x4 pa = *(const f32x4*)(base + 4096 + tid * 8), pb = *(const f32x4*)(base + 4096 + tid * 8 + 4);
        f32x4 q0 = *(const f32x4*)(base + lane * 64 + 8 * wave), q1 = *(const f32x4*)(base + lane * 64 + 8 * wave + 4);
        __syncthreads();
        for (int ch = 0; ch < RCH - 1; ++ch) {
            LAS float* cur = ST + (ch & 1) * 4096; LAS float* nxt = ST + ((ch + 1) & 1) * 4096;
            float* Q = PQ + ((size_t)((bh * RCH + ch) * 2)) * 4096;
            *(LAS f32x4*)(PL + tid * 8) = pa; *(LAS f32x4*)(PL + tid * 8 + 4) = pb;
            float acc[8] = {q0.x, q0.y, q0.z, q0.w, q1.x, q1.y, q1.z, q1.w};
            __syncthreads();
            const int cn = ch + 1 < RCH - 1 ? ch + 1 : ch; const float* nb = PQ + ((size_t)((bh * RCH + cn) * 2)) * 4096;
            pa = *(const f32x4*)(nb + 4096 + tid * 8); pb = *(const f32x4*)(nb + 4096 + tid * 8 + 4);
            q0 = *(const f32x4*)(nb + lane * 64 + 8 * wave); q1 = *(const f32x4*)(nb + lane * 64 + 8 * wave + 4);
#pragma unroll 8
            for (int j = 0; j < 64; ++j) { const float sj = cur[j * 64 + lane]; const f32x4 p0 = *(const LAS f32x4*)(PL + j * 64 + 8 * wave), p1 = *(const LAS f32x4*)(PL + j * 64 + 8 * wave + 4);
                acc[0] = fmaf(sj, p0.x, acc[0]); acc[1] = fmaf(sj, p0.y, acc[1]); acc[2] = fmaf(sj, p0.z, acc[2]); acc[3] = fmaf(sj, p0.w, acc[3]);
                acc[4] = fmaf(sj, p1.x, acc[4]); acc[5] = fmaf(sj, p1.y, acc[5]); acc[6] = fmaf(sj, p1.z, acc[6]); acc[7] = fmaf(sj, p1.w, acc[7]); }
            *(f32x4*)(Q + lane * 64 + 8 * wave) = (f32x4){acc[0], acc[1], acc[2], acc[3]}; *(f32x4*)(Q + lane * 64 + 8 * wave + 4) = (f32x4){acc[4], acc[5], acc[6], acc[7]};
#pragma unroll
            for (int kk = 0; kk < 8; ++kk) nxt[(8 * wave + kk) * 64 + lane] = acc[kk];
            __syncthreads();
        }
    }
}

constexpr size_t WS_X1F8 = 165 * MiB;
constexpr float X1F8_S = 16.0f;
__device__ __forceinline__ void p8_ln1(const Ctx& C) {
    const bf16_t* pre = (const bf16_t*)(C.dout + 32 * MiB); bf16_t* x1b = (bf16_t*)(C.ws + WS_X1B); unsigned char* x1f8 = C.ws + WS_X1F8; const int lane = C.lane;
    const float* gam = C.in[26]; const float* bet = C.in[27];
    for (int t = C.gw; t < T; t += C.ngw) {
        const bf16_t* p = pre + (size_t)t * 1024 + 16 * lane; float v[16];
        unpack8(*(const u32x4*)p, v); unpack8(*(const u32x4*)(p + 8), v + 8);
        float s = 0.f;
#pragma unroll
        for (int j = 0; j < 16; ++j) s += v[j];
        const float mean = wave_sum(s) * (1.0f / 1024.0f); float s2 = 0.f;
#pragma unroll
        for (int j = 0; j < 16; ++j) { v[j] -= mean; s2 += v[j] * v[j]; }
        const float rstd = rsqrtf(wave_sum(s2) * (1.0f / 1024.0f) + 1e-5f);
        float o[16];
#pragma unroll
        for (int q = 0; q < 4; ++q) { const f32x4 gm = *(const f32x4*)(gam + 16 * lane + 4 * q), bt = *(const f32x4*)(bet + 16 * lane + 4 * q);
            o[4 * q] = v[4 * q] * rstd * gm.x + bt.x; o[4 * q + 1] = v[4 * q + 1] * rstd * gm.y + bt.y; o[4 * q + 2] = v[4 * q + 2] * rstd * gm.z + bt.z; o[4 * q + 3] = v[4 * q + 3] * rstd * gm.w + bt.w; }
        *(u32x4*)(x1b + (size_t)t * 1024 + 16 * lane) = pack8(o); *(u32x4*)(x1b + (size_t)t * 1024 + 16 * lane + 8) = pack8(o + 8);
        unsigned wh[4], wl[4];
#pragma unroll
        for (int q = 0; q < 4; ++q) { const float a0 = __builtin_amdgcn_fmed3f(o[4 * q] * X1F8_S, -448.f, 448.f), a1 = __builtin_amdgcn_fmed3f(o[4 * q + 1] * X1F8_S, -448.f, 448.f), a2 = __builtin_amdgcn_fmed3f(o[4 * q + 2] * X1F8_S, -448.f, 448.f), a3 = __builtin_amdgcn_fmed3f(o[4 * q + 3] * X1F8_S, -448.f, 448.f);
            int h = 0; h = __builtin_amdgcn_cvt_pk_fp8_f32(a0, a1, h, false); h = __builtin_amdgcn_cvt_pk_fp8_f32(a2, a3, h, true);
            const f32x2 b01 = __builtin_amdgcn_cvt_pk_f32_fp8(h, false), b23 = __builtin_amdgcn_cvt_pk_f32_fp8(h, true);
            int l = 0; l = __builtin_amdgcn_cvt_pk_fp8_f32((a0 - b01.x) * X1F8_S, (a1 - b01.y) * X1F8_S, l, false); l = __builtin_amdgcn_cvt_pk_fp8_f32((a2 - b23.x) * X1F8_S, (a3 - b23.y) * X1F8_S, l, true);
            wh[q] = (unsigned)h; wl[q] = (unsigned)l; }
        *(u32x4*)(x1f8 + (size_t)t * 2048 + 16 * lane) = (u32x4){wh[0], wh[1], wh[2], wh[3]}; *(u32x4*)(x1f8 + (size_t)t * 2048 + 1024 + 16 * lane) = (u32x4){wl[0], wl[1], wl[2], wl[3]};
    }
    cvt_rows_fp8<true>(G_(C.in[31]), C.ws + WS_VB, (size_t)16384 * 1024 / 16, PEER_V_SCALE, C.gt, C.ngt);
}

#define CE_DESC(a, b) do { const unsigned hi_ = k[a] > k[b] ? k[a] : k[b], lo_ = k[a] > k[b] ? k[b] : k[a]; k[a] = hi_; k[b] = lo_; } while (0)
__device__ __forceinline__ unsigned pop16_of8(unsigned (&k)[8], int fr) {
    CE_DESC(0, 1); CE_DESC(2, 3); CE_DESC(4, 5); CE_DESC(6, 7); CE_DESC(0, 2); CE_DESC(1, 3); CE_DESC(4, 6); CE_DESC(5, 7); CE_DESC(1, 2); CE_DESC(5, 6);
    CE_DESC(0, 4); CE_DESC(1, 5); CE_DESC(2, 6); CE_DESC(3, 7); CE_DESC(2, 4); CE_DESC(3, 5); CE_DESC(1, 2); CE_DESC(3, 4); CE_DESC(5, 6);
    unsigned res = 0u;
#pragma unroll
    for (int rd = 0; rd < 16; ++rd) {
        const unsigned m = row_max_u(k[0]); const bool mine = (k[0] == m);
#pragma unroll
        for (int j = 0; j < 7; ++j) k[j] = mine ? k[j + 1] : k[j];
        k[7] = mine ? 0u : k[7];
        res = (fr == rd) ? m : res;
    }
    return res;
}
__device__ __forceinline__ unsigned pop16_of4(unsigned (&k)[4], int fr) {
    CE_DESC(0, 1); CE_DESC(2, 3); CE_DESC(0, 2); CE_DESC(1, 3); CE_DESC(1, 2);
    unsigned res = 0u;
#pragma unroll
    for (int rd = 0; rd < 16; ++rd) {
        const unsigned m = row_max_u(k[0]); const bool mine = (k[0] == m);
        k[0] = mine ? k[1] : k[0]; k[1] = mine ? k[2] : k[1]; k[2] = mine ? k[3] : k[2]; k[3] = mine ? 0u : k[3];
        res = (fr == rd) ? m : res;
    }
    return res;
}
__device__ const unsigned char CAND_AB[64] = {
    0x00, 0x01, 0x02, 0x03, 0x04, 0x05, 0x06, 0x07, 0x08, 0x09, 0x0a, 0x0b, 0x0c, 0x0d, 0x0e, 0x0f,
    0x10, 0x11, 0x12, 0x13, 0x14, 0x15, 0x16, 0x17, 0x20, 0x21, 0x22, 0x23, 0x24, 0x30, 0x31, 0x32,
    0x33, 0x40, 0x41, 0x42, 0x50, 0x51, 0x60, 0x61, 0x70, 0x71, 0x80, 0x90, 0xa0, 0xb0, 0xc0, 0xd0,
    0xe0, 0xf0, 0xff, 0xff, 0xff, 0xff, 0xff, 0xff, 0xff, 0xff, 0xff, 0xff, 0xff, 0xff, 0xff, 0xff};
__device__ __forceinline__ void p10_peer_route(const Ctx& C) {
    unsigned char* ws = C.ws; const int lane = C.lane, g = lane >> 4, fr = lane & 15;
    const bf16_t* qp = (const bf16_t*)C.dout; const bf16_t* keys = (const bf16_t*)(ws + WS_KEYS);
    int* experts = (int*)(ws + WS_EXPERTS); float* pgates = (float*)(ws + WS_PGATES);
    const unsigned cand4 = *(const unsigned*)(CAND_AB + 4 * fr);
    LAS unsigned char* KL = C.lds;
#pragma unroll
    for (int pp = 0; pp < 8; ++pp) { const int p = C.wave + 8 * pp; const int row = 4 * p + g; const int c = fr ^ (2 * (row & 7));
        __builtin_amdgcn_global_load_lds((const unsigned*)((const char*)keys + row * 256 + 16 * c), (LAS unsigned*)(KL + 1024 * p), 16, 0, 0); }
    asm volatile("s_waitcnt vmcnt(0)" ::: "memory");
    __syncthreads();
    for (int task = C.gw; task < T / 2; task += C.ngw) {
        const int t0 = task * 2;
        unsigned sel[2][4];
#pragma unroll
        for (int p = 0; p < 2; ++p) {
            bf16x8 A[4];
#pragma unroll
            for (int kk = 0; kk < 4; ++kk) A[kk] = *(const bf16x8*)(qp + (size_t)(t0 + (fr >> 3)) * 2048 + (fr & 7) * 256 + p * 128 + 32 * kk + 8 * g);
            f32x4 acc[8];
#pragma unroll
            for (int i = 0; i < 8; ++i) { if ((i & 1) == 0) __builtin_amdgcn_sched_barrier(0); acc[i] = (f32x4){0.f, 0.f, 0.f, 0.f};
#pragma unroll
                for (int kk = 0; kk < 4; ++kk) { const int row = p * 128 + 16 * i + fr; const bf16x8 Bk = *(const LAS bf16x8*)(KL + row * 256 + 16 * ((4 * kk + g) ^ (2 * (row & 7))));
                    acc[i] = __builtin_amdgcn_mfma_f32_16x16x32_bf16(A[kk], Bk, acc[i], 0, 0, 0); } }
#pragma unroll
            for (int r = 0; r < 4; ++r) { __builtin_amdgcn_sched_barrier(0); unsigned k[8];
#pragma unroll
                for (int i = 0; i < 8; ++i) k[i] = (f2key(acc[i][r]) & 0xffffff80u) | (unsigned)(16 * i + fr);
                sel[p][r] = pop16_of8(k, fr); }
        }
#pragma unroll
        for (int r = 0; r < 4; ++r) {
            __builtin_amdgcn_sched_barrier(0);
            const float s1 = key2f(sel[0][r] & 0xffffff80u), s2 = key2f(sel[1][r] & 0xffffff80u);
            unsigned k[4];
#pragma unroll
            for (int j = 0; j < 4; ++j) {
                const unsigned ab = (cand4 >> (8 * j)) & 0xffu; const unsigned msk = ab == 0xffu ? 0u : 0xffffffffu;
                const float va = __builtin_bit_cast(float, __builtin_amdgcn_ds_bpermute((int)(4u * (16u * g + (ab >> 4))), __builtin_bit_cast(int, s1)));
                const float vb = __builtin_bit_cast(float, __builtin_amdgcn_ds_bpermute((int)(4u * (16u * g + (ab & 15u))), __builtin_bit_cast(int, s2)));
                k[j] = ((f2key(va + vb) & 0xffffff00u) | ab) & msk;
            }
            const unsigned top = pop16_of4(k, fr);
            const int a = (int)((top >> 4) & 15u), b = (int)(top & 15u);
            const int i1 = __builtin_amdgcn_ds_bpermute(4 * (16 * g + a), (int)(sel[0][r] & 0x7fu));
            const int i2 = __builtin_amdgcn_ds_bpermute(4 * (16 * g + b), (int)(sel[1][r] & 0x7fu));
            const float sc = key2f(top & 0xffffff00u);
            const float mx = key2f(row_max_u(top) & 0xffffff00u);
            const float ev = __expf(sc - mx); const float sm = row_sum_f(ev);
            const int row = 4 * g + r; const size_t o = (size_t)(t0 + (row >> 3)) * 128 + (row & 7) * 16 + fr;
            experts[o] = i1 * 128 + i2; pgates[o] = ev / sm;
        }
    }
}
#undef CE_DESC

__device__ __forceinline__ float gelu_erf(float x) { return 0.5f * x * (1.0f + erff(x * 0.7071067811865476f)); }
typedef __bf16 bf2_t __attribute__((ext_vector_type(2)));
__device__ __forceinline__ unsigned fp8x2_to_bf16x2(unsigned w, bool hi) { return hi ? __builtin_bit_cast(unsigned, __builtin_amdgcn_cvt_scalef32_pk_bf16_fp8(w, 1.0f, true)) : __builtin_bit_cast(unsigned, __builtin_amdgcn_cvt_scalef32_pk_bf16_fp8(w, 1.0f, false)); }
constexpr size_t WS_EC = 101 * MiB + 8 * MiB;
constexpr size_t WS_Y2 = 61 * MiB;
constexpr size_t WS_STAT = 125 * MiB;
constexpr int CW_PV = 512;
typedef _Float16 f16x2_t __attribute__((ext_vector_type(2)));
__device__ __forceinline__ unsigned h2splat(float v) { const _Float16 h = (_Float16)v; return __builtin_bit_cast(unsigned, (f16x2_t){h, h}); }
typedef int i32x8 __attribute__((ext_vector_type(8)));
constexpr int PU_NT = 4;
constexpr int CW_PU = 1536;
struct PuRows { u32x4 b[16]; u32x4 a0, a1; };
__device__ __forceinline__ void pu_load(PuRows& R, LAS const unsigned char* el, const unsigned char* ubx, const unsigned char* ap, bool arow) {
#pragma unroll
    for (int j = 0; j < 16; ++j) { const unsigned e = *(LAS const unsigned*)(el + 32 * j); R.b[j] = *(const u32x4*)(ubx + (size_t)e * 128); }
    R.a0 = (u32x4){0u, 0u, 0u, 0u}; R.a1 = (u32x4){0u, 0u, 0u, 0u};
    if (arow) { R.a0 = *(const u32x4*)ap; R.a1 = *(const u32x4*)(ap + 16); }
}
__device__ __forceinline__ void pu_compute(const PuRows& R, LAS unsigned char* wr, LAS const unsigned char* rd, float* pp, int lane) {
    const i32x8 A = (i32x8){(int)R.a0.x, (int)R.a0.y, (int)R.a0.z, (int)R.a0.w, (int)R.a1.x, (int)R.a1.y, (int)R.a1.z, (int)R.a1.w};
    float v[8];
#pragma unroll
    for (int tp = 0; tp < 4; ++tp) {
#pragma unroll
        for (int jj = 0; jj < 4; ++jj) *(LAS u32x4*)(wr + 1152 * jj) = R.b[4 * tp + jj];
#pragma unroll
        for (int u = 0; u < 2; ++u) { const u32x4 b0 = *(LAS const u32x4*)(rd + 2304 * u), b1 = *(LAS const u32x4*)(rd + 2304 * u + 16);
            const i32x8 B = (i32x8){(int)b0.x, (int)b0.y, (int)b0.z, (int)b0.w, (int)b1.x, (int)b1.y, (int)b1.z, (int)b1.w};
            const f32x4 acc = __builtin_amdgcn_mfma_scale_f32_16x16x128_f8f6f4(A, B, (f32x4){0.f, 0.f, 0.f, 0.f}, 0, 0, 0, 0, 0, 0);
            v[2 * tp + u] = fmaf(acc[1], 1.0f / X1F8_S, acc[0]); }
    }
    if (lane < 16) { *(f32x4*)pp = (f32x4){v[0], v[1], v[2], v[3]}; *(f32x4*)(pp + 4) = (f32x4){v[4], v[5], v[6], v[7]}; }
}
__device__ __forceinline__ void p11_peer_u(const Ctx& C, int rep_) {
    unsigned char* ws = C.ws; const int lane = C.lane, n = lane & 15, g = lane >> 4, rg = lane >> 3, ck = lane & 7;
    const unsigned char* ub = ws + WS_UB; const unsigned char* x1f8 = ws + WS_X1F8; const unsigned char* experts = ws + WS_EXPERTS;
    float* part = (float*)C.dout; unsigned* qv = (unsigned*)(ws + WS_CTL) + CW_PU + 32 * rep_;
    LAS unsigned char* my = C.lds + C.wave * 8192;
    LAS unsigned char* wr = my + 2048 + 144 * rg + 16 * ck; LAS const unsigned char* rd = my + 2048 + 144 * n + 32 * g;
    const bool arow = n < 2; const int x0 = (int)(xb_xcc_id() & 7u);
    for (int xo = 0; xo < 8; ++xo) {
        const int x = (x0 + xo) & 7;
        if (xo) { unsigned hd = 0; if (lane == 0) hd = __hip_atomic_load(qv + 64 * x, __ATOMIC_RELAXED, __HIP_MEMORY_SCOPE_AGENT); if ((int)__builtin_amdgcn_readfirstlane(hd) >= T) continue; }
        const unsigned char* ubx = ub + ((size_t)x << 21) + 16 * ck; const unsigned char* apx = x1f8 + (arow ? 1024 * n : 0) + 128 * x + 32 * g;
        float* ppx = part + (size_t)x * 128 + 8 * n;
        int tc, tn;
        { int a = 0; if (lane == 0) a = (int)__hip_atomic_fetch_add(qv + 64 * x, (unsigned)(2 * PU_NT), __ATOMIC_RELAXED, __HIP_MEMORY_SCOPE_AGENT); tc = __builtin_amdgcn_readfirstlane(a); tn = tc + PU_NT; }
        u32x4 s0, s1;
        if (tc < T) { s0 = *(const u32x4*)(experts + (size_t)tc * 512 + 16 * lane); s1 = *(const u32x4*)(experts + (size_t)tc * 512 + 1024 + 16 * lane); }
        while (tc < T) {
            *(LAS u32x4*)(my + 16 * lane) = s0; *(LAS u32x4*)(my + 1024 + 16 * lane) = s1;
            int a = 0; if (lane == 0) a = (int)__hip_atomic_fetch_add(qv + 64 * x, (unsigned)PU_NT, __ATOMIC_RELAXED, __HIP_MEMORY_SCOPE_AGENT);
            { const int tl = tn < T ? tn : T - PU_NT; s0 = *(const u32x4*)(experts + (size_t)tl * 512 + 16 * lane); s1 = *(const u32x4*)(experts + (size_t)tl * 512 + 1024 + 16 * lane); }
            PuRows Ra, Rb;
            pu_load(Ra, my + 4 * rg, ubx, apx + (size_t)tc * 2048, arow);
            __builtin_amdgcn_sched_barrier(0);
#pragma unroll
            for (int tt = 0; tt < PU_NT; tt += 2) {
                pu_load(Rb, my + 512 * (tt + 1) + 4 * rg, ubx, apx + (size_t)(tc + tt + 1) * 2048, arow);
                __builtin_amdgcn_sched_barrier(0);
                pu_compute(Ra, wr, rd, ppx + (size_t)(tc + tt) * 1024, lane);
                __builtin_amdgcn_sched_barrier(0);
                if (tt + 2 < PU_NT) pu_load(Ra, my + 512 * (tt + 2) + 4 * rg, ubx, apx + (size_t)(tc + tt + 2) * 2048, arow);
                __builtin_amdgcn_sched_barrier(0);
                pu_compute(Rb, wr, rd, ppx + (size_t)(tc + tt + 1) * 1024, lane);
                __builtin_amdgcn_sched_barrier(0);
            }
            tc = tn; tn = __builtin_amdgcn_readfirstlane(a);
        }
    }
}
__device__ __forceinline__ void p11_peer_combine(const Ctx& C) {
    unsigned char* ws = C.ws; const int lane = C.lane; const float* part = (const float*)C.dout;
    const int* experts = (const int*)(ws + WS_EXPERTS); const float* pgates = (const float*)(ws + WS_PGATES); unsigned char* ecb = ws + WS_EC;
    const int p0 = 2 * lane, k0 = 16 * (p0 & 7) + (p0 >> 3), k1 = k0 + 16;
    constexpr float us = 1.0f / (PEER_U_SCALE * X1F8_S), vs = 64.0f / PEER_V_SCALE;
    for (int t = C.gw; t < T; t += C.ngw) {
        f32x2 s = (f32x2){0.f, 0.f};
#pragma unroll
        for (int x = 0; x < 8; ++x) s += *(const f32x2*)(part + ((size_t)t * 8 + x) * 128 + p0);
        const int e0 = experts[(size_t)t * 128 + k0], e1 = experts[(size_t)t * 128 + k1]; const float g0 = pgates[(size_t)t * 128 + k0], g1 = pgates[(size_t)t * 128 + k1];
        *(u32x4*)(ecb + (size_t)t * 1024 + 16 * lane) = (u32x4){(unsigned)e0, h2splat(vs * g0 * gelu_erf(s.x * us)), (unsigned)e1, h2splat(vs * g1 * gelu_erf(s.y * us))};
    }
}
constexpr int PV_NT = 4;
struct PvRows { u32x4 r[16]; unsigned c[16]; unsigned xr; };
__device__ __forceinline__ void pv_load(PvRows& R, LAS const unsigned char* ecl, const unsigned char* vbx, const bf16_t* xp) {
#pragma unroll
    for (int j = 0; j < 16; ++j) { const u32x2 ec = *(LAS const u32x2*)(ecl + 64 * j); R.r[j] = *(const u32x4*)(vbx + (size_t)ec.x * 128); R.c[j] = ec.y; }
    R.xr = *(const unsigned*)xp;
}
__device__ __forceinline__ void pv_compute(const PvRows& R, bf16_t* yp, float* stp, int lane) {
    f16x2_t o2[8];
#pragma unroll
    for (int j = 0; j < 8; ++j) o2[j] = (f16x2_t){(_Float16)0.f, (_Float16)0.f};
#pragma unroll
    for (int j = 0; j < 16; ++j) {
        const f16x2_t cc = __builtin_bit_cast(f16x2_t, R.c[j]); const unsigned rw[4] = {R.r[j].x, R.r[j].y, R.r[j].z, R.r[j].w};
#pragma unroll
        for (int q = 0; q < 4; ++q) { const f16x2_t lo = __builtin_amdgcn_cvt_scalef32_pk_f16_fp8(rw[q], 1.0f, false), hi = __builtin_amdgcn_cvt_scalef32_pk_f16_fp8(rw[q], 1.0f, true);
            o2[2 * q] = __builtin_elementwise_fma(cc, lo, o2[2 * q]); o2[2 * q + 1] = __builtin_elementwise_fma(cc, hi, o2[2 * q + 1]); }
    }
    float o[16];
#pragma unroll
    for (int j = 0; j < 8; ++j) { o[2 * j] = (float)o2[j].x; o[2 * j + 1] = (float)o2[j].y; }
    float p[8];
#pragma unroll
    for (int d = 0; d < 8; ++d) { const auto s = __builtin_amdgcn_permlane32_swap(__float_as_uint(o[d]), __float_as_uint(o[d + 8]), false, false); p[d] = __uint_as_float(s[0]) + __uint_as_float(s[1]); }
    float q4[4];
#pragma unroll
    for (int d = 0; d < 4; ++d) { const auto s = __builtin_amdgcn_permlane16_swap(__float_as_uint(p[d]), __float_as_uint(p[d + 4]), false, false); q4[d] = __uint_as_float(s[0]) + __uint_as_float(s[1]); }
#pragma unroll
    for (int d = 0; d < 4; ++d) q4[d] += __uint_as_float((unsigned)__builtin_amdgcn_update_dpp(0, (int)__float_as_uint(q4[d]), 0x128, 0xf, 0xf, false));
    const bool b3 = (lane & 8) != 0;
    const float y0 = fmaf(b3 ? q4[2] : q4[0], 1.0f / 64.0f, ALPHA * bflo(R.xr)), y1 = fmaf(b3 ? q4[3] : q4[1], 1.0f / 64.0f, ALPHA * bfhi(R.xr));
    *(unsigned*)yp = pk2(y0, y1);
    const float s1 = wave_sum(y0 + y1), s2 = wave_sum(y0 * y0 + y1 * y1);
    if (lane == 0) *(f32x2*)stp = (f32x2){s1, s2};
}
__device__ __forceinline__ void p11_peer_v(const Ctx& C, int rep_) {
    unsigned char* ws = C.ws; const int lane = C.lane, rg = lane >> 3, ck = lane & 7;
    const bf16_t* x1b = (const bf16_t*)(ws + WS_X1B); const unsigned char* vb = ws + WS_VB; const unsigned char* ecb = ws + WS_EC;
    bf16_t* y2 = (bf16_t*)(ws + WS_Y2); float* stat = (float*)(ws + WS_STAT); unsigned* qv = (unsigned*)(ws + WS_CTL) + CW_PV + 32 * rep_;
    LAS unsigned char* my = C.lds + C.wave * 4096;
    const int colo = 16 * ck + 4 * (lane >> 4) + ((lane & 8) ? 2 : 0);
    const int x0 = (int)(xb_xcc_id() & 7u);
    for (int xo = 0; xo < 8; ++xo) {
        const int x = (x0 + xo) & 7;
        if (xo) { unsigned hd = 0; if (lane == 0) hd = __hip_atomic_load(qv + 64 * x, __ATOMIC_RELAXED, __HIP_MEMORY_SCOPE_AGENT); if ((int)__builtin_amdgcn_readfirstlane(hd) >= T) continue; }
        const unsigned char* vbx = vb + ((size_t)x << 21) + 16 * ck; const int cx = 128 * x + colo;
        int tc, tn;
        { int a = 0; if (lane == 0) a = (int)__hip_atomic_fetch_add(qv + 64 * x, (unsigned)(2 * PV_NT), __ATOMIC_RELAXED, __HIP_MEMORY_SCOPE_AGENT); tc = __builtin_amdgcn_readfirstlane(a); tn = tc + PV_NT; }
        u32x4 s[PV_NT];
        if (tc < T) {
#pragma unroll
            for (int q = 0; q < PV_NT; ++q) s[q] = *(const u32x4*)(ecb + (size_t)(tc + q) * 1024 + 16 * lane);
        }
        while (tc < T) {
#pragma unroll
            for (int q = 0; q < PV_NT; ++q) *(LAS u32x4*)(my + 1024 * q + 16 * lane) = s[q];
            int a = 0; if (lane == 0) a = (int)__hip_atomic_fetch_add(qv + 64 * x, (unsigned)PV_NT, __ATOMIC_RELAXED, __HIP_MEMORY_SCOPE_AGENT);
            { const int tl = tn < T ? tn : T - PV_NT;
#pragma unroll
              for (int q = 0; q < PV_NT; ++q) s[q] = *(const u32x4*)(ecb + (size_t)(tl + q) * 1024 + 16 * lane); }
            PvRows Ra, Rb;
            pv_load(Ra, my + 8 * rg, vbx, x1b + (size_t)tc * 1024 + cx);
            __builtin_amdgcn_sched_barrier(0);
#pragma unroll
            for (int tt = 0; tt < PV_NT; tt += 2) {
                pv_load(Rb, my + 1024 * (tt + 1) + 8 * rg, vbx, x1b + (size_t)(tc + tt + 1) * 1024 + cx);
                __builtin_amdgcn_sched_barrier(0);
                pv_compute(Ra, y2 + (size_t)(tc + tt) * 1024 + cx, stat + ((size_t)(tc + tt) * 8 + x) * 2, lane);
                __builtin_amdgcn_sched_barrier(0);
                if (tt + 2 < PV_NT) pv_load(Ra, my + 1024 * (tt + 2) + 8 * rg, vbx, x1b + (size_t)(tc + tt + 2) * 1024 + cx);
                __builtin_amdgcn_sched_barrier(0);
                pv_compute(Rb, y2 + (size_t)(tc + tt + 1) * 1024 + cx, stat + ((size_t)(tc + tt + 1) * 8 + x) * 2, lane);
                __builtin_amdgcn_sched_barrier(0);
            }
            tc = tn; tn = __builtin_amdgcn_readfirstlane(a);
        }
    }
}
__device__ __forceinline__ void p11_peer_ln2(const Ctx& C) {
    unsigned char* ws = C.ws; const int lane = C.lane; const bf16_t* y2 = (const bf16_t*)(ws + WS_Y2); const float* stat = (const float*)(ws + WS_STAT);
    float* out = (float*)C.dout; const float* gam = C.in[32]; const float* bet = C.in[33];
    for (int t = C.gw; t < T; t += C.ngw) {
        float s1 = 0.f, s2 = 0.f;
        if (lane < 8) { const f32x2 v = *(const f32x2*)(stat + ((size_t)t * 8 + lane) * 2); s1 = v.x; s2 = v.y; }
        s1 = wave_sum(s1); s2 = wave_sum(s2);
        const float mean = s1 * (1.0f / 1024.0f); const float var = fmaxf(s2 * (1.0f / 1024.0f) - mean * mean, 0.f); const float rstd = rsqrtf(var + 1e-5f);
        float o[16]; const bf16_t* yp = y2 + (size_t)t * 1024 + 16 * lane; unpack8(*(const u32x4*)yp, o); unpack8(*(const u32x4*)(yp + 8), o + 8);
#pragma unroll
        for (int q = 0; q < 4; ++q) { const int c0 = 16 * lane + 4 * q; const f32x4 gm = *(const f32x4*)(gam + c0), bt = *(const f32x4*)(bet + c0);
            *(f32x4*)(out + (size_t)t * 1024 + c0) = (f32x4){(o[4 * q] - mean) * rstd * gm.x + bt.x, (o[4 * q + 1] - mean) * rstd * gm.y + bt.y, (o[4 * q + 2] - mean) * rstd * gm.z + bt.z, (o[4 * q + 3] - mean) * rstd * gm.w + bt.w}; }
    }
}

constexpr int LDS_BYTES = 147456;
constexpr int LDS_MISC = 131072 + 256;
constexpr int NPHASE = 17;
constexpr int CW_BAR = 4096;

__global__ void __launch_bounds__(NTHREADS, 2) hybrid_fwd(Args args) {
    extern __shared__ __attribute__((aligned(16))) unsigned char lds_raw[];
    Ctx C;
    C.lds = (LAS unsigned char*)lds_raw;
    C.tid = threadIdx.x; C.lane = C.tid & 63; C.wave = __builtin_amdgcn_readfirstlane(C.tid >> 6);
    C.G = gridDim.x; C.gw = blockIdx.x * NWAVES + C.wave; C.ngw = C.G * NWAVES; C.gt = blockIdx.x * NTHREADS + C.tid; C.ngt = C.G * NTHREADS;
    C.in = args.in; C.ws = args.ws; C.dout = (unsigned char*)args.out;
    unsigned char* ws = args.ws; const float* const* in = args.in;
    volatile LAS unsigned* MISC = (volatile LAS unsigned*)(C.lds + LDS_MISC);
    if (C.tid < 64) MISC[C.tid] = 0u;
    __syncthreads();
    XcdBarrier bar; bar.bar = (unsigned*)(ws + WS_CTL) + CW_BAR; bar.x = 0; bar.st = nullptr;
    if (MK_N_LAUNCHES == 1) bar = xcd_barrier_post((unsigned*)(ws + WS_CTL) + CW_BAR, MISC + 8);
    const int lo = args.ph_lo, hi = args.ph_hi;
#define IN(k) (lo <= (k) && (k) < hi)
#define SEAM(k) do { if (IN(k) && IN((k) + 1)) xcd_barrier(bar); } while (0)
#define REP(k) for (int rep_ = 0; rep_ < (((PROBE_MASK >> (k)) & 1) ? 2 : 1); ++rep_)
    bf16_t* xb = (bf16_t*)(C.dout + DO_XB);

    if (IN(0)) REP(0) { p0_prologue(C); } SEAM(0);
    if (IN(1)) REP(1) {
        { pg8::Gemm gm{xb, (const bf16_t*)(ws + WS_WIN), T, 2816, 1024}; pg8::StaticOrder S; S.init(T, 2816, C.G, (int)blockIdx.x);
          EpiP1 E{(float*)(ws + WS_CSMALL), (bf16_t*)(ws + WS_RCOLS), (bf16_t*)(ws + WS_MEMQ)}; pg8::gemm_phase(C.lds, gm, S, E); }
        {
          const int nfull = (T / 256) * 11 % C.G; const int c2 = ((int)blockIdx.x - nfull + C.G) % C.G;
          pg8::Gemm gm{(const bf16_t*)(ws + WS_MEMB), (const bf16_t*)(ws + WS_WMEMKV), 1024, 1024, 1024}; pg8::StaticOrder S; S.init(1024, 1024, C.G, c2);
          EpiMemKV E{(bf16_t*)(ws + WS_KMEM), (bf16_t*)(ws + WS_VMEMT)}; pg8::gemm_phase(C.lds, gm, S, E); }
    } SEAM(1);
    if (IN(2)) REP(2) { p2_prep(C); } SEAM(2);
    if (IN(3)) REP(3) {
        { pg8::Gemm gm{(const bf16_t*)(ws + WS_LORAA), (const bf16_t*)(ws + WS_WLORA), T, 1536, 256}; pg8::StaticOrder S; S.init(T, 1536, C.G, (int)blockIdx.x);
          EpiLora E{(bf16_t*)(ws + WS_RW_E), (bf16_t*)(ws + WS_RW_A), (bf16_t*)(ws + WS_RW_G), in[11], in[13]}; pg8::gemm_phase(C.lds, gm, S, E); }
        { pg8::Gemm gm{(const bf16_t*)(ws + WS_CQN), (const bf16_t*)(ws + WS_WQ), T, 1280, 256}; pg8::StaticOrder S; S.init(T, 1280, C.G, C.G - 1 - (int)blockIdx.x);
          EpiQ E{(bf16_t*)(ws + WS_QLAT), (bf16_t*)(ws + WS_QIDX)}; pg8::gemm_phase(C.lds, gm, S, E); }
    } SEAM(3);
    if (IN(4)) { REP(17) { p4_indexer(C); } REP(18) { p4_memattn(C); } __syncthreads(); REP(19) { p4_rwkv_pass1(C); } } SEAM(4);
    if (IN(5)) { p5_rwkv_carry(C); __syncthreads(); REP(5) { p5_dsa_attn(C, rep_); } } SEAM(5);
    if (IN(6)) REP(6) { p6_rwkv_pass3(C); p6_late_weights(C); } SEAM(6);
    if (IN(7)) REP(7) {
        pg8::Gemm gm{xb, (const bf16_t*)(ws + WS_WG), T, 3072, 1024}; pg8::StaticOrder S; S.init(T, 3072, C.G, (int)blockIdx.x);
        EpiGates E{(bf16_t*)(ws + WS_GATES)}; pg8::gemm_phase(C.lds, gm, S, E);
    } SEAM(7);
    if (IN(8)) REP(8) {
        pg8::GemmM gm{(const bf16_t*)(ws + WS_OLAT), (const bf16_t*)(ws + WS_YM), (const bf16_t*)(ws + WS_WOV), T, 1024}; pg8::StaticOrder S; S.init(T, 1024, C.G, (int)blockIdx.x);
        MergeHook H{(const bf16_t*)(ws + WS_GATES), (bf16_t*)C.dout}; pg8::gemm_phase_merge(C.lds, gm, S, H);
    } SEAM(8);
    if (IN(9)) REP(9) {
        pg8::Gemm gm{(const bf16_t*)C.dout, (const bf16_t*)(ws + WS_WOUT), T, 1024, 1024}; pg8::StaticOrder S; S.init(T, 1024, C.G, (int)blockIdx.x);
        EpiWout E{G_(in[0]), (bf16_t*)(C.dout + 32 * MiB)}; pg8::gemm_phase(C.lds, gm, S, E);
    } SEAM(9);
    if (IN(10)) REP(10) { p8_ln1(C); } SEAM(10);
    if (IN(11)) REP(11) {
        pg8::Gemm gm{(const bf16_t*)(ws + WS_X1B), (const bf16_t*)(ws + WS_WPEER), T, 2048, 1024}; pg8::StaticOrder S; S.init(T, 2048, C.G, (int)blockIdx.x);
        EpiPeerQ E{(bf16_t*)C.dout}; pg8::gemm_phase(C.lds, gm, S, E);
    } SEAM(11);
    if (IN(12)) REP(12) { p10_peer_route(C); } SEAM(12);
    if (IN(13)) REP(13) { p11_peer_u(C, rep_); } SEAM(13);
    if (IN(14)) { p11_peer_combine(C); } SEAM(14);
    if (IN(15)) REP(15) { p11_peer_v(C, rep_); } SEAM(15);
    if (IN(16)) { p11_peer_ln2(C); }
#undef IN
#undef SEAM
}

extern "C" void kernel_launch(void* const* d_in, const int* in_sizes, int n_in, void* d_out, int out_size, void* d_ws, size_t ws_size, hipStream_t stream) {
    static int grid = 0;
    if (grid == 0) {
        if (n_in != 34 || out_size != T * D || ws_size < WS_END) { fprintf(stderr, "kernel_launch: unexpected problem (n_in %d out %d ws %zu)\n", n_in, out_size, ws_size); grid = -1; return; }
        int dev = 0, cus = 0, per_cu = 0;
        if (hipGetDevice(&dev) != hipSuccess || hipDeviceGetAttribute(&cus, hipDeviceAttributeMultiprocessorCount, dev) != hipSuccess) { grid = -1; return; }
        if (hipFuncSetAttribute((const void*)hybrid_fwd, hipFuncAttributeMaxDynamicSharedMemorySize, LDS_BYTES) != hipSuccess) { fprintf(stderr, "kernel_launch: hipFuncSetAttribute failed\n"); grid = -1; return; }
        if (hipOccupancyMaxActiveBlocksPerMultiprocessor(&per_cu, (const void*)hybrid_fwd, NTHREADS, LDS_BYTES) != hipSuccess || per_cu < 1) { fprintf(stderr, "kernel_launch: occupancy query says %d\n", per_cu); }
        (void)hipGetLastError();
        grid = cus;
    }
    if (grid < 0) return;
    (void)hipMemsetAsync((char*)d_ws + WS_CTL, 0, 1 * MiB, stream);
    Args a{};
    for (int i = 0; i < 34; ++i) a.in[i] = (const float*)d_in[i];
    a.out = (float*)d_out; a.ws = (unsigned char*)d_ws; a.li = 0; a.pad = 0;
    if (MK_N_LAUNCHES == 1) { a.ph_lo = 0; a.ph_hi = NPHASE; hipLaunchKernelGGL(hybrid_fwd, dim3(grid), dim3(NTHREADS), LDS_BYTES, stream, a); }
    else for (int p = 0; p < NPHASE; ++p) { a.ph_lo = p; a.ph_hi = p + 1; a.li = p; hipLaunchKernelGGL(hybrid_fwd, dim3(grid), dim3(NTHREADS), LDS_BYTES, stream, a); }
}
```

```cpp
#include <hip/hip_runtime.h>
#include <stdint.h>
#include <stdio.h>

#ifndef MK_N_LAUNCHES
#define MK_N_LAUNCHES 1
#endif

#ifndef PROBE_MASK
#define PROBE_MASK 0
#endif
#define LAS __attribute__((address_space(3)))
typedef unsigned short bf16_t;
typedef const __attribute__((address_space(1))) float* gfp;
#define G_(p) ((gfp)(p))
typedef short bf16x8 __attribute__((ext_vector_type(8)));
typedef float f32x4 __attribute__((ext_vector_type(4)));
typedef float f32x2 __attribute__((ext_vector_type(2)));
typedef unsigned u32x4 __attribute__((ext_vector_type(4)));
typedef unsigned u32x2 __attribute__((ext_vector_type(2)));

constexpr int NB = 4, SEQ = 4096, T = NB * SEQ, D = 1024;
constexpr int IN_W = 5800;
constexpr int RW = 512;
constexpr int NWAVES = 8, NTHREADS = 512;
constexpr float ALPHA = 1.189207115002721f;
constexpr int RCH = 32, RL = SEQ / RCH;

constexpr size_t MiB = 1u << 20;
constexpr size_t WS_CTL = 0;
constexpr size_t WS_WIN = 1 * MiB, WS_WG = 7 * MiB, WS_WLORA = 13 * MiB, WS_WQ = 14 * MiB, WS_WMEMKV = 15 * MiB, WS_WOV = 17 * MiB,
                 WS_WBRR = 19 * MiB, WS_WBRM = 20 * MiB, WS_WOUT = 21 * MiB, WS_WPEER = 23 * MiB, WS_KEYS = 27 * MiB;
constexpr size_t WS_CSMALL = 29 * MiB, WS_QLAT = 29 * MiB, WS_MERGEDB = 29 * MiB, WS_UB = 29 * MiB;
constexpr size_t WS_RCOLS = 61 * MiB, WS_QIDX = 61 * MiB, WS_YM = 69 * MiB, WS_OLAT = 101 * MiB, WS_VB = 45 * MiB, WS_EXPERTS = 93 * MiB, WS_PGATES = 101 * MiB;
constexpr size_t WS_MEMQ = 117 * MiB;
constexpr size_t WS_RW_R = 133 * MiB, WS_RW_K = 149 * MiB, WS_RW_V = 165 * MiB, WS_RW_A = 181 * MiB, WS_RW_E = 197 * MiB, WS_RW_G = 213 * MiB;
constexpr size_t WS_GATES = 133 * MiB, WS_X1B = 133 * MiB, WS_X1 = 165 * MiB;
constexpr size_t WS_CQN = 229 * MiB, WS_KVL = 237 * MiB, WS_KIDX = 241 * MiB, WS_WIDX = 242 * MiB, WS_LORAA = 243 * MiB, WS_IDX = 243 * MiB,
                 WS_KMEM = 251 * MiB, WS_VMEMT = 252 * MiB, WS_MEMB = 253 * MiB, WS_END = 256 * MiB;
constexpr size_t DO_XB = 0, DO_PQ = 32 * MiB;
constexpr size_t WS_XB2 = 29 * MiB;
constexpr int CW_DSAQ = 64;

typedef __bf16 bf2_hw __attribute__((ext_vector_type(2)));
__device__ __forceinline__ unsigned f2bf(float f) { return (unsigned)__builtin_bit_cast(unsigned short, (__bf16)f); }
__device__ __forceinline__ unsigned pk2(float lo, float hi) { bf2_hw r; r.x = (__bf16)lo; r.y = (__bf16)hi; return __builtin_bit_cast(unsigned, r); }
__device__ __forceinline__ float bflo(unsigned w) { return __uint_as_float(w << 16); }
__device__ __forceinline__ float bfhi(unsigned w) { return __uint_as_float(w & 0xffff0000u); }
__device__ __forceinline__ float bf1(bf16_t h) { return __uint_as_float(((unsigned)h) << 16); }
template <int CTRL, int RM = 0xF> __device__ __forceinline__ float dpp_f(float v) { return __builtin_bit_cast(float, __builtin_amdgcn_update_dpp(0, __builtin_bit_cast(int, v), CTRL, RM, 0xF, false)); }
template <int CTRL> __device__ __forceinline__ unsigned dpp_u(unsigned v) { return (unsigned)__builtin_amdgcn_update_dpp(0, (int)v, CTRL, 0xF, 0xF, false); }
__device__ __forceinline__ float wave_sum(float v) {
    v += dpp_f<0x111>(v); v += dpp_f<0x112>(v); v += dpp_f<0x114>(v); v += dpp_f<0x118>(v);
    v += dpp_f<0x142, 0xA>(v); v += dpp_f<0x143, 0xC>(v);
    return __builtin_bit_cast(float, __builtin_amdgcn_readlane(__builtin_bit_cast(int, v), 63));
}
__device__ __forceinline__ unsigned row_max_u(unsigned x) {
    unsigned y = dpp_u<0x128>(x); x = x > y ? x : y; y = dpp_u<0x124>(x); x = x > y ? x : y; y = dpp_u<0x122>(x); x = x > y ? x : y; y = dpp_u<0x121>(x); x = x > y ? x : y; return x; }
__device__ __forceinline__ float row_sum_f(float x) { x += dpp_f<0x128>(x); x += dpp_f<0x124>(x); x += dpp_f<0x122>(x); x += dpp_f<0x121>(x); return x; }
__device__ __forceinline__ float key2f(unsigned k) { const unsigned b = (k & 0x80000000u) ? (k & 0x7fffffffu) : ~k; return __uint_as_float(b); }
__device__ __forceinline__ float sigmoidf_(float x) { return 1.0f / (1.0f + __expf(-x)); }
__device__ __forceinline__ unsigned f2key(float f) { unsigned b = __float_as_uint(f); if (f == 0.0f) b = 0u; return (b & 0x80000000u) ? ~b : (b | 0x80000000u); }
__device__ __forceinline__ u32x4 pack8(const float* v) { u32x4 w; w.x = pk2(v[0], v[1]); w.y = pk2(v[2], v[3]); w.z = pk2(v[4], v[5]); w.w = pk2(v[6], v[7]); return w; }
__device__ __forceinline__ void unpack8(u32x4 w, float* v) { v[0] = bflo(w.x); v[1] = bfhi(w.x); v[2] = bflo(w.y); v[3] = bfhi(w.y); v[4] = bflo(w.z); v[5] = bfhi(w.z); v[6] = bflo(w.w); v[7] = bfhi(w.w); }

#define XB_TMO      128
#define XB_XCNT(j)  (256  + 64 * (j))
#define XB_XSUB(j)  (1280 + 64 * (j))
#define XB_XGEN(j)  (2304 + 64 * (j))
#define XB_TOP      3328
#define XB_TOPGEN   3392
#define XCD_BAR_WORDS 3456
#define XB_SPIN_CAP (1u << 18)

__device__ __forceinline__ unsigned xb_ld(unsigned* p)              { return __hip_atomic_load(p, __ATOMIC_RELAXED, __HIP_MEMORY_SCOPE_AGENT); }
__device__ __forceinline__ unsigned xb_add(unsigned* p, unsigned v) { return __hip_atomic_fetch_add(p, v, __ATOMIC_RELAXED, __HIP_MEMORY_SCOPE_AGENT); }
__device__ __forceinline__ unsigned xb_xcc_id() { return (unsigned)__builtin_amdgcn_s_getreg((3 << 11) | 20) & 0xFu; }
#define XB_SPIN(cond, bar) do { unsigned _sp = 0; while (cond) { __builtin_amdgcn_s_sleep(1); \
    if ((++_sp & 255u) == 0u) { if (xb_ld(&(bar)[XB_TMO])) break; if (_sp > XB_SPIN_CAP) { atomicAdd(&(bar)[XB_TMO], 1u); break; } } } } while (0)

struct XcdBarrier {
    unsigned* bar; unsigned x;
    volatile LAS unsigned* st;
};
__device__ __forceinline__ XcdBarrier xcd_barrier_post(unsigned* bar, volatile LAS unsigned* st) {
    XcdBarrier b; b.bar = bar; b.x = xb_xcc_id(); b.st = st;
    if (threadIdx.x == 0) (void)xb_add(&bar[XB_XCNT(b.x)], 1u);
    return b;
}
__device__ __forceinline__ void xcd_barrier_complete(unsigned* bar, unsigned x, unsigned& nloc, unsigned& nx) {
    const unsigned G = gridDim.x * gridDim.y * gridDim.z;
    unsigned sum, cnt, mine, sp = 0u;
    for (;;) {
        sum = 0u; cnt = 0u; mine = 0u;
#pragma unroll
        for (unsigned j = 0; j < 16; ++j) { const unsigned c = xb_ld(&bar[XB_XCNT(j)]); sum += c; cnt += (c > 0u) ? 1u : 0u; mine = (j == x) ? c : mine; }
        if (sum == G) break;
        __builtin_amdgcn_s_sleep(1);
        if ((++sp & 255u) == 0u) { if (xb_ld(&bar[XB_TMO])) break; if (sp > XB_SPIN_CAP) { atomicAdd(&bar[XB_TMO], 1u); break; } }
    }
    nloc = mine > 0u ? mine : 1u; nx = cnt > 0u ? cnt : 1u;
}
__device__ __forceinline__ void xcd_barrier(const XcdBarrier& b) {
    asm volatile("s_waitcnt vmcnt(0)" ::: "memory");
    __syncthreads();
    if (threadIdx.x == 0) {
        unsigned* bar = b.bar;
        __builtin_amdgcn_s_waitcnt(0);
        unsigned nloc = b.st[0], nx = b.st[1];
        if (nloc == 0u) { xcd_barrier_complete(bar, b.x, nloc, nx); b.st[0] = nloc; b.st[1] = nx; }
        const unsigned old = xb_add(&bar[XB_XSUB(b.x)], 1u);
        const unsigned gen = old / nloc;
        if (old + 1u == (gen + 1u) * nloc) {
            __builtin_amdgcn_fence(__ATOMIC_RELEASE, "agent");
            asm volatile("s_waitcnt vmcnt(0)" ::: "memory");
            const unsigned og = xb_add(&bar[XB_TOP], 1u);
            const unsigned tg = og / nx;
            if (og + 1u == (tg + 1u) * nx) xb_add(&bar[XB_TOPGEN], 1u);
            else XB_SPIN(xb_ld(&bar[XB_TOPGEN]) == tg, bar);
            __builtin_amdgcn_fence(__ATOMIC_ACQUIRE, "agent");
            xb_add(&bar[XB_XGEN(b.x)], 1u);
            asm volatile("s_waitcnt vmcnt(0)" ::: "memory");
        } else {
            XB_SPIN(xb_ld(&bar[XB_XGEN(b.x)]) == gen, bar);
            __builtin_amdgcn_fence(__ATOMIC_ACQUIRE, "agent");
            asm volatile("s_waitcnt vmcnt(0)" ::: "memory");
        }
    }
    __syncthreads();
}

namespace pg8 {
constexpr int BM = 256, BK = 64, HALF = 128, HTB = HALF * BK * 2, STAGE_BYTES = 8 * HTB, NXCD = 8, WGM = 8;
__device__ __forceinline__ int lds_byte(int r, int c) { const int st = (r >> 4) * 2 + (c >> 5), rr = r & 15, cc = c & 31, ob = rr * 64 + cc * 2; return st * 1024 + (ob ^ (((ob >> 9) & 1) << 5)); }
__device__ __forceinline__ void stage_rc(int b, int& R, int& C) { const int st = b / 1024, sb = b % 1024, swz = sb ^ (((sb >> 9) & 1) << 5); R = (st >> 1) * 16 + swz / 64; C = (st & 1) * 32 + (swz % 64) / 2; }
__device__ __forceinline__ int perm32(int rho) { const int n = rho >> 4, i = rho & 15; return 8 * (i >> 2) + 4 * n + (i & 3); }
struct Unit { int pm, pn; };
struct Gemm { const bf16_t* A; const bf16_t* Bt; int M, N, K; };
struct StaticOrder {
    int nM, nN, nwg, G, c;
    __device__ void init(int M, int N, int G_, int c_) { nM = M / BM; nN = N / BM; nwg = nM * nN; G = G_; c = c_; }
    __device__ bool next(int i, Unit& u) const {
        const long L = (long)i * G + c; if (L >= nwg) return false;
        int wgid = (int)L; { const int q = nwg / NXCD, r = nwg % NXCD, xcd = wgid % NXCD, off = wgid / NXCD; wgid = (xcd < r ? xcd * (q + 1) : r * (q + 1) + (xcd - r) * q) + off; }
        const int nig = WGM * nN, gid = wgid / nig, fm = gid * WGM, gsz = (nM - fm) < WGM ? (nM - fm) : WGM;
        u.pm = fm + ((wgid % nig) % gsz); u.pn = (wgid % nig) / gsz; return true;
    }
};
template <class Epi>
__device__ __forceinline__ void gemm_phase(LAS unsigned char* lds, const Gemm g, const StaticOrder& S, const Epi& E) {
    const int tid = threadIdx.x, wid = __builtin_amdgcn_readfirstlane(tid >> 6), lane = tid & 63, wr = wid >> 2, wc = wid & 3, fr = lane & 15, fq = lane >> 4;
    const int K = g.K, nt = K / BK;
    unsigned voffA[2], voffB[2];
#pragma unroll
    for (int i = 0; i < 2; ++i) { int R, C; stage_rc(tid * 16 + i * 8192, R, C); const int Rb = (R & ~31) + perm32(R & 31);
        voffA[i] = (unsigned)(R * K + C) * 2u; voffB[i] = (unsigned)(Rb * K + C) * 2u; }
    const size_t kstep = (size_t)(BK * 2);
    const size_t hstep = (size_t)HALF * K * 2;
    const size_t tstep = 2 * hstep;
    const unsigned ldsw = (unsigned)wid * 1024u;
    const int aoff = lds_byte(wr * 64 + fr, fq * 8), boff = lds_byte(wc * 32 + fr, fq * 8);
#define PG8_SA(b, h) (((b) * 2 + (h)) * HTB)
#define PG8_SB(b, h) ((4 + (b) * 2 + (h)) * HTB)
#define PG8_STAGE(bufoff, gbase, voff) do { _Pragma("unroll") for (int _i = 0; _i < 2; ++_i) \
        __builtin_amdgcn_global_load_lds((const unsigned*)((const char*)(gbase) + (voff)[_i]), (LAS unsigned*)(lds + (bufoff) + ldsw + _i * 8192), 16, 0, 0); } while (0)
#define PG8_LDA(dst, b, h) do { _Pragma("unroll") for (int m = 0; m < 4; ++m) _Pragma("unroll") for (int k = 0; k < 2; ++k) dst[m][k] = *(const LAS bf16x8*)(lds + PG8_SA(b, h) + aoff + m * 2048 + k * 1024); } while (0)
#define PG8_LDB(dst, b, h) do { _Pragma("unroll") for (int n = 0; n < 2; ++n) _Pragma("unroll") for (int k = 0; k < 2; ++k) dst[n][k] = *(const LAS bf16x8*)(lds + PG8_SB(b, h) + boff + n * 2048 + k * 1024); } while (0)
#define PG8_MMA(ai, bj, At, Bt) do { __builtin_amdgcn_s_setprio(1); _Pragma("unroll") for (int m = 0; m < 4; ++m) _Pragma("unroll") for (int n = 0; n < 2; ++n) _Pragma("unroll") for (int k = 0; k < 2; ++k) \
        acc[ai][bj][m][n] = __builtin_amdgcn_mfma_f32_16x16x32_bf16(Bt[n][k], At[m][k], acc[ai][bj][m][n], 0, 0, 0); __builtin_amdgcn_s_setprio(0); } while (0)
#define PG8_WAIT_V(n) asm volatile("s_waitcnt vmcnt(" #n ")" ::: "memory")
#define PG8_WAIT_L(n) asm volatile("s_waitcnt lgkmcnt(" #n ")" ::: "memory")
#define PG8_BAR __builtin_amdgcn_s_barrier()
#define PG8_SCHED __builtin_amdgcn_sched_barrier(0)
    Unit cur, nxt; int ui = 0;
    if (!S.next(0, cur)) return;
    f32x4 acc[2][2][4][2];
#pragma unroll
    for (int a = 0; a < 2; ++a)
#pragma unroll
        for (int b = 0; b < 2; ++b)
#pragma unroll
            for (int m = 0; m < 4; ++m)
#pragma unroll
                for (int n = 0; n < 2; ++n) acc[a][b][m][n] = (f32x4){0.f, 0.f, 0.f, 0.f};
    bf16x8 At[4][2], B0[2][2], B1[2][2];
    const char* cA = (const char*)g.A + (size_t)cur.pm * tstep; const char* cB = (const char*)g.Bt + (size_t)cur.pn * tstep;
    PG8_STAGE(PG8_SB(0, 0), cB, voffB); PG8_STAGE(PG8_SA(0, 0), cA, voffA); PG8_STAGE(PG8_SB(0, 1), cB + hstep, voffB); PG8_STAGE(PG8_SA(0, 1), cA + hstep, voffA);
    if (wr == 1) PG8_BAR;
    PG8_WAIT_V(4); PG8_BAR;
    PG8_STAGE(PG8_SB(1, 0), cB + kstep, voffB); PG8_STAGE(PG8_SA(1, 0), cA + kstep, voffA); PG8_STAGE(PG8_SB(1, 1), cB + hstep + kstep, voffB);
    PG8_WAIT_V(6); PG8_BAR;
    for (;;) {
        const bool has_next = S.next(ui + 1, nxt);
        const char* nA = has_next ? (const char*)g.A + (size_t)nxt.pm * tstep : cA; const char* nB = has_next ? (const char*)g.Bt + (size_t)nxt.pn * tstep : cB;
#pragma unroll 1
        for (int t = 0; t < nt; t += 2) {
            const bool last = (t == nt - 2);
            const char* a1 = cA + (size_t)(t + 1) * kstep;
            const char* a2 = last ? nA : cA + (size_t)(t + 2) * kstep; const char* b2 = last ? nB : cB + (size_t)(t + 2) * kstep;
            const char* a3 = a2 + kstep; const char* b3 = b2 + kstep;
            PG8_LDB(B0, 0, 0); PG8_SCHED; PG8_LDA(At, 0, 0); PG8_STAGE(PG8_SA(1, 1), a1 + hstep, voffA);
            PG8_WAIT_L(8); PG8_BAR; PG8_WAIT_L(0); PG8_MMA(0, 0, At, B0); PG8_BAR; PG8_SCHED;
            PG8_LDB(B1, 0, 1); PG8_STAGE(PG8_SB(0, 0), b2, voffB);
            PG8_BAR; PG8_WAIT_L(0); PG8_MMA(0, 1, At, B1); PG8_BAR;
            PG8_LDA(At, 0, 1); PG8_STAGE(PG8_SA(0, 0), a2, voffA);
            PG8_BAR; PG8_WAIT_L(0); PG8_MMA(1, 0, At, B0); PG8_BAR; PG8_SCHED;
            PG8_STAGE(PG8_SB(0, 1), b2 + hstep, voffB);
            PG8_WAIT_V(6); PG8_BAR; PG8_MMA(1, 1, At, B1); PG8_BAR;
            PG8_LDB(B0, 1, 0); PG8_SCHED; PG8_LDA(At, 1, 0); PG8_STAGE(PG8_SA(0, 1), a2 + hstep, voffA);
            PG8_WAIT_L(8); PG8_BAR; PG8_WAIT_L(0); PG8_MMA(0, 0, At, B0); PG8_BAR; PG8_SCHED;
            PG8_LDB(B1, 1, 1); PG8_STAGE(PG8_SB(1, 0), b3, voffB);
            PG8_BAR; PG8_WAIT_L(0); PG8_MMA(0, 1, At, B1); PG8_BAR;
            PG8_LDA(At, 1, 1); PG8_STAGE(PG8_SA(1, 0), a3, voffA);
            PG8_BAR; PG8_WAIT_L(0); PG8_MMA(1, 0, At, B0); PG8_BAR; PG8_SCHED;
            PG8_STAGE(PG8_SB(1, 1), b3 + hstep, voffB);
            PG8_WAIT_V(6); PG8_BAR; PG8_MMA(1, 1, At, B1); PG8_BAR;
        }
        {
            const int row0 = cur.pm * BM + wr * 64 + fr, col0 = cur.pn * BM + wc * 32 + 8 * fq;
#pragma unroll
            for (int ai = 0; ai < 2; ++ai)
#pragma unroll
                for (int m = 0; m < 4; ++m)
#pragma unroll
                    for (int bj = 0; bj < 2; ++bj) { E(row0 + ai * HALF + m * 16, col0 + bj * HALF, cur.pn, acc[ai][bj][m][0], acc[ai][bj][m][1]); if (Epi::SERIAL) __builtin_amdgcn_sched_barrier(0); }
        }
        if (!has_next) break;
#pragma unroll
        for (int a = 0; a < 2; ++a)
#pragma unroll
            for (int b = 0; b < 2; ++b)
#pragma unroll
                for (int m = 0; m < 4; ++m)
#pragma unroll
                    for (int n = 0; n < 2; ++n) acc[a][b][m][n] = (f32x4){0.f, 0.f, 0.f, 0.f};
        cur = nxt; cA = nA; cB = nB; ++ui;
    }
    PG8_WAIT_V(0);
    if (wr == 0) PG8_BAR;
    PG8_BAR;
#undef PG8_SA
#undef PG8_SB
#undef PG8_STAGE
#undef PG8_LDA
#undef PG8_LDB
#undef PG8_MMA
#undef PG8_WAIT_V
#undef PG8_WAIT_L
#undef PG8_BAR
#undef PG8_SCHED
}
struct GemmM { const bf16_t* A0; const bf16_t* A1; const bf16_t* Bt; int M, N; };
template <class Hook>
__device__ __forceinline__ void gemm_phase_merge(LAS unsigned char* lds, const GemmM g, const StaticOrder& S, const Hook& H) {
    const int tid = threadIdx.x, wid = __builtin_amdgcn_readfirstlane(tid >> 6), lane = tid & 63, wr = wid >> 2, wc = wid & 3, fr = lane & 15, fq = lane >> 4;
    constexpr int K = 2048, LDA = 1024, nt = K / BK, KS = 16;
    unsigned voffA[2], voffB[2];
#pragma unroll
    for (int i = 0; i < 2; ++i) { int R, C; stage_rc(tid * 16 + i * 8192, R, C); const int Rb = (R & ~31) + perm32(R & 31);
        voffA[i] = (unsigned)(R * LDA + C) * 2u; voffB[i] = (unsigned)(Rb * K + C) * 2u; }
    const size_t kstep = (size_t)(BK * 2);
    const size_t hstepA = (size_t)HALF * LDA * 2, tstepA = 2 * hstepA, hstepB = (size_t)HALF * K * 2, tstepB = 2 * hstepB;
    const unsigned ldsw = (unsigned)wid * 1024u;
    const int aoff = lds_byte(wr * 64 + fr, fq * 8), boff = lds_byte(wc * 32 + fr, fq * 8);
#define PG8_SA(b, h) (((b) * 2 + (h)) * HTB)
#define PG8_SB(b, h) ((4 + (b) * 2 + (h)) * HTB)
#define PG8_STAGE(bufoff, gbase, voff) do { _Pragma("unroll") for (int _i = 0; _i < 2; ++_i) \
        __builtin_amdgcn_global_load_lds((const unsigned*)((const char*)(gbase) + (voff)[_i]), (LAS unsigned*)(lds + (bufoff) + ldsw + _i * 8192), 16, 0, 0); } while (0)
#define PG8_LDA(dst, b, h) do { _Pragma("unroll") for (int m = 0; m < 4; ++m) _Pragma("unroll") for (int k = 0; k < 2; ++k) dst[m][k] = *(const LAS bf16x8*)(lds + PG8_SA(b, h) + aoff + m * 2048 + k * 1024); } while (0)
#define PG8_LDB(dst, b, h) do { _Pragma("unroll") for (int n = 0; n < 2; ++n) _Pragma("unroll") for (int k = 0; k < 2; ++k) dst[n][k] = *(const LAS bf16x8*)(lds + PG8_SB(b, h) + boff + n * 2048 + k * 1024); } while (0)
#define PG8_MMA(ai, bj, At, Bt) do { __builtin_amdgcn_s_setprio(1); _Pragma("unroll") for (int m = 0; m < 4; ++m) _Pragma("unroll") for (int n = 0; n < 2; ++n) _Pragma("unroll") for (int k = 0; k < 2; ++k) \
        acc[ai][bj][m][n] = __builtin_amdgcn_mfma_f32_16x16x32_bf16(Bt[n][k], At[m][k], acc[ai][bj][m][n], 0, 0, 0); __builtin_amdgcn_s_setprio(0); } while (0)
#define PG8_WAIT_V(n) asm volatile("s_waitcnt vmcnt(" #n ")" ::: "memory")
#define PG8_WAIT_L(n) asm volatile("s_waitcnt lgkmcnt(" #n ")" ::: "memory")
#define PG8_BAR __builtin_amdgcn_s_barrier()
#define PG8_SCHED __builtin_amdgcn_sched_barrier(0)
#define PG8_AT(b0, b1, t) ((t) < KS ? (b0) + (size_t)(t) * kstep : (b1) + (size_t)((t) - KS) * kstep)
    Unit cur, nxt; int ui = 0;
    if (!S.next(0, cur)) return;
    f32x4 acc[2][2][4][2];
#pragma unroll
    for (int a = 0; a < 2; ++a)
#pragma unroll
        for (int b = 0; b < 2; ++b)
#pragma unroll
            for (int m = 0; m < 4; ++m)
#pragma unroll
                for (int n = 0; n < 2; ++n) acc[a][b][m][n] = (f32x4){0.f, 0.f, 0.f, 0.f};
    bf16x8 At[4][2], B0[2][2], B1[2][2];
    const char* cA0 = (const char*)g.A0 + (size_t)cur.pm * tstepA; const char* cA1 = (const char*)g.A1 + (size_t)cur.pm * tstepA; const char* cB = (const char*)g.Bt + (size_t)cur.pn * tstepB;
    PG8_STAGE(PG8_SB(0, 0), cB, voffB); PG8_STAGE(PG8_SA(0, 0), cA0, voffA); PG8_STAGE(PG8_SB(0, 1), cB + hstepB, voffB); PG8_STAGE(PG8_SA(0, 1), cA0 + hstepA, voffA);
    if (wr == 1) PG8_BAR;
    PG8_WAIT_V(4); PG8_BAR;
    PG8_STAGE(PG8_SB(1, 0), cB + kstep, voffB); PG8_STAGE(PG8_SA(1, 0), cA0 + kstep, voffA); PG8_STAGE(PG8_SB(1, 1), cB + hstepB + kstep, voffB);
    PG8_WAIT_V(6); PG8_BAR;
    for (;;) {
        const bool has_next = S.next(ui + 1, nxt);
        const char* nA0 = has_next ? (const char*)g.A0 + (size_t)nxt.pm * tstepA : cA0; const char* nA1 = has_next ? (const char*)g.A1 + (size_t)nxt.pm * tstepA : cA1;
        const char* nB = has_next ? (const char*)g.Bt + (size_t)nxt.pn * tstepB : cB;
#pragma unroll 1
        for (int t = 0; t < nt; t += 2) {
            const bool last = (t == nt - 2);
            if (t == 16 || t == 24) H.rescale(acc, cur, t == 24 ? 1 : 0, wr, wc, fr, fq);
            const char* a1 = PG8_AT(cA0, cA1, t + 1);
            const char* a2 = last ? nA0 : PG8_AT(cA0, cA1, t + 2); const char* b2 = last ? nB : cB + (size_t)(t + 2) * kstep;
            const char* a3 = last ? nA0 + kstep : PG8_AT(cA0, cA1, t + 3); const char* b3 = b2 + kstep;
            PG8_LDB(B0, 0, 0); PG8_SCHED; PG8_LDA(At, 0, 0); PG8_STAGE(PG8_SA(1, 1), a1 + hstepA, voffA);
            PG8_WAIT_L(8); PG8_BAR; PG8_WAIT_L(0); PG8_MMA(0, 0, At, B0); PG8_BAR; PG8_SCHED;
            PG8_LDB(B1, 0, 1); PG8_STAGE(PG8_SB(0, 0), b2, voffB);
            PG8_BAR; PG8_WAIT_L(0); PG8_MMA(0, 1, At, B1); PG8_BAR;
            PG8_LDA(At, 0, 1); PG8_STAGE(PG8_SA(0, 0), a2, voffA);
            PG8_BAR; PG8_WAIT_L(0); PG8_MMA(1, 0, At, B0); PG8_BAR; PG8_SCHED;
            PG8_STAGE(PG8_SB(0, 1), b2 + hstepB, voffB);
            PG8_WAIT_V(6); PG8_BAR; PG8_MMA(1, 1, At, B1); PG8_BAR;
            PG8_LDB(B0, 1, 0); PG8_SCHED; PG8_LDA(At, 1, 0); PG8_STAGE(PG8_SA(0, 1), a2 + hstepA, voffA);
            PG8_WAIT_L(8); PG8_BAR; PG8_WAIT_L(0); PG8_MMA(0, 0, At, B0); PG8_BAR; PG8_SCHED;
            PG8_LDB(B1, 1, 1); PG8_STAGE(PG8_SB(1, 0), b3, voffB);
            PG8_BAR; PG8_WAIT_L(0); PG8_MMA(0, 1, At, B1); PG8_BAR;
            PG8_LDA(At, 1, 1); PG8_STAGE(PG8_SA(1, 0), a3, voffA);
            PG8_BAR; PG8_WAIT_L(0); PG8_MMA(1, 0, At, B0); PG8_BAR; PG8_SCHED;
            PG8_STAGE(PG8_SB(1, 1), b3 + hstepB, voffB);
            PG8_WAIT_V(6); PG8_BAR; PG8_MMA(1, 1, At, B1); PG8_BAR;
        }
        H.finish(acc, cur, wr, wc, fr, fq);
        if (!has_next) break;
#pragma unroll
        for (int a = 0; a < 2; ++a)
#pragma unroll
            for (int b = 0; b < 2; ++b)
#pragma unroll
                for (int m = 0; m < 4; ++m)
#pragma unroll
                    for (int n = 0; n < 2; ++n) acc[a][b][m][n] = (f32x4){0.f, 0.f, 0.f, 0.f};
        cur = nxt; cA0 = nA0; cA1 = nA1; cB = nB; ++ui;
    }
    PG8_WAIT_V(0);
    if (wr == 0) PG8_BAR;
    PG8_BAR;
#undef PG8_SA
#undef PG8_SB
#undef PG8_STAGE
#undef PG8_LDA
#undef PG8_LDB
#undef PG8_MMA
#undef PG8_WAIT_V
#undef PG8_WAIT_L
#undef PG8_BAR
#undef PG8_SCHED
#undef PG8_AT
}
}

struct Args { const float* in[34]; float* out; unsigned char* ws; int ph_lo, ph_hi, li, pad; };

struct Ctx {
    LAS unsigned char* lds;
    int tid, lane, wave, gw, ngw, gt, ngt, G;
    const float* const* in; unsigned char* ws; unsigned char* dout;
};

__device__ __forceinline__ void st8_bf16(bf16_t* p, f32x4 a, f32x4 b) { u32x4 w; w.x = pk2(a.x, a.y); w.y = pk2(a.z, a.w); w.z = pk2(b.x, b.y); w.w = pk2(b.z, b.w); *(u32x4*)p = w; }
struct EpiP1 { static constexpr bool SERIAL = false;
    float* cs; bf16_t* rc; bf16_t* mq;
    __device__ __forceinline__ void operator()(int row, int col, int pn, f32x4 a, f32x4 b) const {
        if (pn < 2) { float* p = cs + (size_t)row * 512 + col; *(f32x4*)p = a; *(f32x4*)(p + 4) = b; }
        else if (pn < 9) st8_bf16(rc + (size_t)row * 1792 + (col - 512), a, b);
        else st8_bf16(mq + (size_t)row * 512 + (col - 2304), a, b);
    }
};
struct EpiMemKV { static constexpr bool SERIAL = false;
    bf16_t* km; bf16_t* vt;
    __device__ __forceinline__ void operator()(int row, int col, int pn, f32x4 a, f32x4 b) const {
        const int bb = row >> 8, m = row & 255;
        if (col < 512) { const int h = col >> 7, d = col & 127; st8_bf16(km + ((size_t)((bb * 4 + h) * 256 + m)) * 128 + d, a, b); }
        else { const int c2 = col - 512, h = c2 >> 7, d = c2 & 127; bf16_t* p = vt + ((size_t)((bb * 4 + h) * 128 + d)) * 256 + m;
            p[0] = (bf16_t)f2bf(a.x); p[256] = (bf16_t)f2bf(a.y); p[512] = (bf16_t)f2bf(a.z); p[768] = (bf16_t)f2bf(a.w);
            p[1024] = (bf16_t)f2bf(b.x); p[1280] = (bf16_t)f2bf(b.y); p[1536] = (bf16_t)f2bf(b.z); p[1792] = (bf16_t)f2bf(b.w); }
    }
};
struct EpiLora { static constexpr bool SERIAL = true;
    bf16_t* e; bf16_t* a; bf16_t* g; const float* w0; const float* a0;
    __device__ __forceinline__ void operator()(int row, int col, int pn, f32x4 x, f32x4 y) const {
        float v[8] = {x.x, x.y, x.z, x.w, y.x, y.y, y.z, y.w};
        if (pn < 4) { const int c = col & 511; const float* bp = (pn < 2 ? w0 : a0) + c; const f32x4 b0 = *(const f32x4*)bp, b1 = *(const f32x4*)(bp + 4);
            const float bb[8] = {b0.x, b0.y, b0.z, b0.w, b1.x, b1.y, b1.z, b1.w}; const float sc = pn < 2 ? 0.6065306597126334f : 1.0f;
#pragma unroll
            for (int j = 0; j < 8; ++j) v[j] = sc * sigmoidf_(v[j] + bb[j]);
            *(u32x4*)((pn < 2 ? e : a) + (size_t)row * 512 + c) = pack8(v);
        } else *(u32x4*)(g + (size_t)row * 512 + (col - 1024)) = pack8(v);
    }
};
struct EpiQ { static constexpr bool SERIAL = false;
    bf16_t* ql; bf16_t* qi;
    __device__ __forceinline__ void operator()(int row, int col, int pn, f32x4 a, f32x4 b) const {
        if (pn < 4) st8_bf16(ql + (size_t)row * 1024 + col, a, b); else st8_bf16(qi + (size_t)row * 256 + (col - 1024), a, b);
    }
};
struct EpiGates { static constexpr bool SERIAL = true;
    bf16_t* o;
    __device__ __forceinline__ void operator()(int row, int col, int pn, f32x4 a, f32x4 b) const {
        float v[8] = {a.x, a.y, a.z, a.w, b.x, b.y, b.z, b.w};
#pragma unroll
        for (int j = 0; j < 8; ++j) v[j] = sigmoidf_(v[j]);
        *(u32x4*)(o + (size_t)row * 3072 + col) = pack8(v);
    }
};
struct MergeHook {
    const bf16_t* gates; bf16_t* mb;
    __device__ __forceinline__ void rescale(f32x4 (&acc)[2][2][4][2], const pg8::Unit& u, int idx, int wr, int wc, int fr, int fq) const {
        asm volatile("" : "+v"(fr), "+v"(fq));
        const int row0 = u.pm * 256 + wr * 64 + fr, col0 = u.pn * 256 + wc * 32 + 8 * fq;
#pragma unroll
        for (int ai = 0; ai < 2; ++ai)
#pragma unroll
            for (int mh = 0; mh < 2; ++mh) {
                u32x4 pa[2][2], pb[2][2];
#pragma unroll
                for (int mm = 0; mm < 2; ++mm)
#pragma unroll
                    for (int bj = 0; bj < 2; ++bj) { const bf16_t* gp = gates + (size_t)(row0 + ai * 128 + (2 * mh + mm) * 16) * 3072 + idx * 1024 + col0 + bj * 128; pa[mm][bj] = *(const u32x4*)gp; pb[mm][bj] = *(const u32x4*)(gp + 1024); }
                __builtin_amdgcn_sched_barrier(0);
#pragma unroll
                for (int mm = 0; mm < 2; ++mm)
#pragma unroll
                    for (int bj = 0; bj < 2; ++bj) { float a[8], b[8]; unpack8(pa[mm][bj], a); unpack8(pb[mm][bj], b); const int m = 2 * mh + mm;
#pragma unroll
                        for (int j = 0; j < 4; ++j) { acc[ai][bj][m][0][j] *= a[j] * __builtin_amdgcn_rcpf(b[j]); acc[ai][bj][m][1][j] *= a[4 + j] * __builtin_amdgcn_rcpf(b[4 + j]); } }
                __builtin_amdgcn_sched_barrier(0);
            }
    }
    __device__ __forceinline__ void finish(f32x4 (&acc)[2][2][4][2], const pg8::Unit& u, int wr, int wc, int fr, int fq) const {
        asm volatile("" : "+v"(fr), "+v"(fq));
        const int row0 = u.pm * 256 + wr * 64 + fr, col0 = u.pn * 256 + wc * 32 + 8 * fq;
#pragma unroll
        for (int ai = 0; ai < 2; ++ai)
#pragma unroll
            for (int m = 0; m < 4; ++m)
#pragma unroll
                for (int bj = 0; bj < 2; ++bj) { const int row = row0 + ai * 128 + m * 16, col = col0 + bj * 128;
                    float gv[8]; unpack8(*(const u32x4*)(gates + (size_t)row * 3072 + 2048 + col), gv);
                    const f32x4 x = acc[ai][bj][m][0], y = acc[ai][bj][m][1];
                    float v[8] = {x[0] * gv[0], x[1] * gv[1], x[2] * gv[2], x[3] * gv[3], y[0] * gv[4], y[1] * gv[5], y[2] * gv[6], y[3] * gv[7]};
                    *(u32x4*)(mb + (size_t)row * 1024 + col) = pack8(v); }
    }
};
struct EpiWout { static constexpr bool SERIAL = false;
    gfp x; bf16_t* pre;
    __device__ __forceinline__ void operator()(int row, int col, int pn, f32x4 a, f32x4 b) const {
        gfp xp = x + (size_t)row * 1024 + col; typedef const __attribute__((address_space(1))) f32x4* g4p;
        st8_bf16(pre + (size_t)row * 1024 + col, *(g4p)xp * ALPHA + a, *(g4p)(xp + 4) * ALPHA + b);
    }
};
struct EpiPeerQ { static constexpr bool SERIAL = false; bf16_t* o; __device__ __forceinline__ void operator()(int row, int col, int pn, f32x4 a, f32x4 b) const { st8_bf16(o + (size_t)row * 2048 + col, a, b); } };

template <int N, int K, class F> __device__ __forceinline__ void build_bt(bf16_t* dst, const F& f, int gt, int ngt) {
    constexpr int items = N * (K / 8);
    for (int i = gt; i < items; i += ngt) { const int n = i % N, k0 = (i / N) * 8; float v[8];
#pragma unroll
        for (int j = 0; j < 8; ++j) v[j] = f(n, k0 + j);
        *(u32x4*)(dst + (size_t)n * K + k0) = pack8(v); }
}
template <int N, int K, class F> __device__ __forceinline__ void build_bt_ld(bf16_t* dst, int ld, const F& f, int gt, int ngt) {
    constexpr int items = N * (K / 8);
    for (int i = gt; i < items; i += ngt) { const int n = i % N, k0 = (i / N) * 8; float v[8];
#pragma unroll
        for (int j = 0; j < 8; ++j) v[j] = f(n, k0 + j);
        *(u32x4*)(dst + (size_t)n * ld + k0) = pack8(v); }
}
struct FWin { gfp w; __device__ __forceinline__ float operator()(int n, int k) const { if (n < 424) return w[(size_t)k * IN_W + n]; if (n < 512) return 0.f; return w[(size_t)k * IN_W + n - 88]; } };
struct FWg { gfp w; __device__ __forceinline__ float operator()(int n, int k) const { return w[(size_t)k * IN_W + 2728 + n]; } };
struct FLora { gfp w2, a2, g2; __device__ __forceinline__ float operator()(int n, int k) const {
    if (n < 512) return k < 64 ? w2[k * 512 + n] : 0.f;
    if (n < 1024) return (k >= 64 && k < 128) ? a2[(k - 64) * 512 + n - 512] : 0.f;
    return k >= 128 ? g2[(k - 128) * 512 + n - 1024] : 0.f; } };
struct FWq { const float *uq, *uk, *iq; __device__ __forceinline__ float operator()(int n, int k) const {
    if (n >= 1024) return iq[k * 256 + n - 1024];
    const int h = n >> 7, c = n & 127; const float* a = uq + (size_t)k * 512 + h * 64; const float* b = uk + (size_t)(c * 8 + h) * 64; float s = 0.f;
#pragma unroll 8
    for (int d = 0; d < 64; ++d) s = fmaf(a[d], b[d], s);
    return s * 0.125f; } };
struct FWov { const float *uv, *br; __device__ __forceinline__ float operator()(int n, int k) const {
    const int h = k >> 7, c = k & 127; const float* a = uv + (size_t)(c * 8 + h) * 64; const float* b = br + (size_t)(h * 64) * 1024 + n; float s = 0.f;
#pragma unroll 8
    for (int d = 0; d < 64; ++d) s = fmaf(a[d], b[(size_t)d * 1024], s);
    return s; } };
struct FT { gfp w; int ld; __device__ __forceinline__ float operator()(int n, int k) const { return w[(size_t)k * ld + n]; } };

__device__ __forceinline__ void cvt_rows(gfp src, bf16_t* dst, size_t n8, int gt, int ngt) {
    for (size_t i = gt; i < n8; i += ngt) { const f32x4 a = *(const __attribute__((address_space(1))) f32x4*)(src + i * 8), b = *(const __attribute__((address_space(1))) f32x4*)(src + i * 8 + 4); st8_bf16(dst + i * 8, a, b); }
}
constexpr float PEER_U_SCALE = 64.0f, PEER_V_SCALE = 8.0f;
template <bool SLICED = false>
__device__ __forceinline__ void cvt_rows_fp8(gfp src, unsigned char* dst, size_t n16, float scale, int gt, int ngt) {
    for (size_t i = gt; i < n16; i += ngt) { typedef const __attribute__((address_space(1))) f32x4* g4p; gfp p = src + i * 16; u32x4 w;
        const f32x4 a = *(g4p)p * scale, b = *(g4p)(p + 4) * scale, c = *(g4p)(p + 8) * scale, d = *(g4p)(p + 12) * scale;
        int t = 0; t = __builtin_amdgcn_cvt_pk_fp8_f32(a.x, a.y, t, false); t = __builtin_amdgcn_cvt_pk_fp8_f32(a.z, a.w, t, true); w.x = (unsigned)t;
        t = 0; t = __builtin_amdgcn_cvt_pk_fp8_f32(b.x, b.y, t, false); t = __builtin_amdgcn_cvt_pk_fp8_f32(b.z, b.w, t, true); w.y = (unsigned)t;
        t = 0; t = __builtin_amdgcn_cvt_pk_fp8_f32(c.x, c.y, t, false); t = __builtin_amdgcn_cvt_pk_fp8_f32(c.z, c.w, t, true); w.z = (unsigned)t;
        t = 0; t = __builtin_amdgcn_cvt_pk_fp8_f32(d.x, d.y, t, false); t = __builtin_amdgcn_cvt_pk_fp8_f32(d.z, d.w, t, true); w.w = (unsigned)t;
        if (SLICED) *(u32x4*)(dst + (((i >> 3) & 7) << 21) + ((i >> 6) << 7) + ((i & 7) << 4)) = w; else *(u32x4*)(dst + i * 16) = w; }
}
__device__ __forceinline__ void p0_prologue(const Ctx& C) {
    const float* const* in = C.in; unsigned char* ws = C.ws;
    cvt_rows(G_(in[0]), (bf16_t*)(C.dout + DO_XB), (size_t)T * D / 8, C.gt, C.ngt);
    cvt_rows(G_(in[1]), (bf16_t*)(ws + WS_MEMB), (size_t)1024 * 1024 / 8, C.gt, C.ngt);
    cvt_rows(G_(in[29]), (bf16_t*)(ws + WS_KEYS), (size_t)2 * 128 * 128 / 8, C.gt, C.ngt);
    build_bt<2816, 1024>((bf16_t*)(ws + WS_WIN), FWin{G_(in[3])}, C.gt, C.ngt);
    build_bt<1536, 256>((bf16_t*)(ws + WS_WLORA), FLora{G_(in[12]), G_(in[14]), G_(in[15])}, C.gt, C.ngt);
    {
        bf16_t* dst = (bf16_t*)(ws + WS_WQ); const float* uq = in[6]; const float* uk = in[7];
        for (int item = C.gw; item < 4096; item += C.ngw) { const int n = item >> 2, k = (item & 3) * 64 + C.lane, h = n >> 7, c = n & 127;
            const float* a = uq + (size_t)k * 512 + h * 64; const float* bq = uk + (size_t)(c * 8 + h) * 64; float s = 0.f;
#pragma unroll
            for (int d4 = 0; d4 < 16; ++d4) { const f32x4 av = *(const f32x4*)(a + 4 * d4), bv = *(const f32x4*)(bq + 4 * d4); s += av.x * bv.x + av.y * bv.y + av.z * bv.z + av.w * bv.w; }
            dst[(size_t)n * 256 + k] = (bf16_t)f2bf(s * 0.125f); }
        build_bt<256, 256>(dst + 1024 * 256, FT{G_(in[9]), 256}, C.gt, C.ngt);
    }
    build_bt<1024, 1024>((bf16_t*)(ws + WS_WMEMKV), FT{G_(in[21]), 1024}, C.gt, C.ngt);
}
__device__ __forceinline__ void p6_late_weights(const Ctx& C0) {
    const int busy = (32 * RCH + C0.G - 1) / C0.G; Ctx C = C0;
    if (busy < NWAVES) { if (C0.wave < busy) return; C.gt = (int)blockIdx.x * (NWAVES - busy) * 64 + (C0.wave - busy) * 64 + C0.lane; C.ngt = C0.G * (NWAVES - busy) * 64; C.gw = C.gt >> 6; C.ngw = C.ngt >> 6; }
    const float* const* in = C.in; unsigned char* ws = C.ws;
    build_bt<3072, 1024>((bf16_t*)(ws + WS_WG), FWg{G_(in[3])}, C.gt, C.ngt);
    {
        bf16_t* dst = (bf16_t*)(ws + WS_WOV); const float* uv = in[8]; const float* br = in[22];
        for (int i = C.gt; i < 1024 * 128; i += C.ngt) { const int n = i & 1023, k0 = (i >> 10) * 8, h = k0 >> 7, c0 = k0 & 127; float acc[8];
#pragma unroll
            for (int j = 0; j < 8; ++j) acc[j] = 0.f;
            for (int d4 = 0; d4 < 16; ++d4) {
                float b[4];
#pragma unroll
                for (int q = 0; q < 4; ++q) b[q] = br[(size_t)(h * 64 + 4 * d4 + q) * 1024 + n];
#pragma unroll
                for (int j = 0; j < 8; ++j) { const f32x4 a = *(const f32x4*)(uv + (size_t)((c0 + j) * 8 + h) * 64 + 4 * d4); acc[j] += a.x * b[0] + a.y * b[1] + a.z * b[2] + a.w * b[3]; }
            }
            *(u32x4*)(dst + (size_t)n * 2048 + k0) = pack8(acc); }
    }
    build_bt_ld<1024, 512>((bf16_t*)(ws + WS_WOV) + 1024, 2048, FT{G_(in[23]), 1024}, C.gt, C.ngt);
    build_bt_ld<1024, 512>((bf16_t*)(ws + WS_WOV) + 1536, 2048, FT{G_(in[24]), 1024}, C.gt, C.ngt);
    build_bt<1024, 1024>((bf16_t*)(ws + WS_WOUT), FT{G_(in[25]), 1024}, C.gt, C.ngt);
    build_bt<2048, 1024>((bf16_t*)(ws + WS_WPEER), FT{G_(in[28]), 2048}, C.gt, C.ngt);
    cvt_rows_fp8<true>(G_(in[30]), ws + WS_UB, (size_t)16384 * 1024 / 16, PEER_U_SCALE, C.gt, C.ngt);
}

__device__ __forceinline__ void p2_prep(const Ctx& C) {
    const float* const* in = C.in; unsigned char* ws = C.ws; const int lane = C.lane;
    const float* csmall = (const float*)(ws + WS_CSMALL); const bf16_t* rcols = (const bf16_t*)(ws + WS_RCOLS);
    bf16_t* cqn = (bf16_t*)(ws + WS_CQN); bf16_t* kvl = (bf16_t*)(ws + WS_KVL); bf16_t* kidx = (bf16_t*)(ws + WS_KIDX); float* widx = (float*)(ws + WS_WIDX);
    bf16_t* rr = (bf16_t*)(ws + WS_RW_R); bf16_t* rk = (bf16_t*)(ws + WS_RW_K); bf16_t* rv = (bf16_t*)(ws + WS_RW_V); bf16_t* la = (bf16_t*)(ws + WS_LORAA);
    const float* mu = in[10];
    const f32x4 gq = *(const f32x4*)(in[4] + 4 * lane); const f32x2 gk = *(const f32x2*)(in[5] + 2 * lane);
    for (int t = C.gw; t < T; t += C.ngw) {
        const float* cs = csmall + (size_t)t * 512;
        {
            const f32x4 q = *(const f32x4*)(cs + 4 * lane);
            const float ss = wave_sum(q.x * q.x + q.y * q.y + q.z * q.z + q.w * q.w);
            const float rs = rsqrtf(ss * (1.0f / 256.0f) + 1e-6f);
            u32x2 w; w.x = pk2(q.x * rs * gq.x, q.y * rs * gq.y); w.y = pk2(q.z * rs * gq.z, q.w * rs * gq.w);
            *(u32x2*)(cqn + (size_t)t * 256 + 4 * lane) = w;
        }
        {
            const f32x2 k = *(const f32x2*)(cs + 256 + 2 * lane);
            const float ss = wave_sum(k.x * k.x + k.y * k.y);
            const float rs = rsqrtf(ss * (1.0f / 128.0f) + 1e-6f);
            *(unsigned*)(kvl + (size_t)t * 128 + 2 * lane) = pk2(k.x * rs * gk.x, k.y * rs * gk.y);
        }
        if (lane < 16) { const f32x2 k = *(const f32x2*)(cs + 384 + 2 * lane); *(unsigned*)(kidx + (size_t)t * 32 + 2 * lane) = pk2(k.x, k.y); }
        if (lane < 8) widx[(size_t)t * 8 + lane] = cs[416 + lane] * 0.0625f;
        const bf16_t* rc = rcols + (size_t)t * 1792; const bool hp = (t & (SEQ - 1)) != 0; const bf16_t* rp = hp ? rc - 1792 : rc;
#pragma unroll
        for (int seg = 0; seg < 3; ++seg) {
            float c[8], p[8], o[8];
            unpack8(*(const u32x4*)(rc + seg * 512 + 8 * lane), c); unpack8(*(const u32x4*)(rp + seg * 512 + 8 * lane), p);
            const f32x4 m0 = *(const f32x4*)(mu + seg * 512 + 8 * lane), m1 = *(const f32x4*)(mu + seg * 512 + 8 * lane + 4);
            const float mm[8] = {m0.x, m0.y, m0.z, m0.w, m1.x, m1.y, m1.z, m1.w};
#pragma unroll
            for (int j = 0; j < 8; ++j) { const float pv = hp ? p[j] : 0.f; o[j] = c[j] + (pv - c[j]) * mm[j]; }
            bf16_t* dst = (seg == 0 ? rr : (seg == 1 ? rk : rv)) + (size_t)t * 512 + 8 * lane;
            *(u32x4*)dst = pack8(o);
        }
        {
            const float cw = bf1(rc[1536 + lane]), pw = hp ? bf1(rp[1536 + lane]) : 0.f; const float wl = cw + (pw - cw) * mu[1536 + lane];
            const float ca = bf1(rc[1600 + lane]), pa = hp ? bf1(rp[1600 + lane]) : 0.f; const float al = ca + (pa - ca) * mu[1600 + lane];
            const unsigned cgw = *(const unsigned*)(rc + 1664 + 2 * lane), pgw = *(const unsigned*)(rp + 1664 + 2 * lane);
            const float cg0 = bflo(cgw), cg1 = bfhi(cgw), pg0 = hp ? bflo(pgw) : 0.f, pg1 = hp ? bfhi(pgw) : 0.f;
            const float g0 = cg0 + (pg0 - cg0) * mu[1664 + 2 * lane], g1 = cg1 + (pg1 - cg1) * mu[1664 + 2 * lane + 1];
            bf16_t* l = la + (size_t)t * 256;
            l[lane] = (bf16_t)f2bf(tanhf(wl)); l[64 + lane] = (bf16_t)f2bf(al);
            *(unsigned*)(l + 128 + 2 * lane) = pk2(sigmoidf_(g0), sigmoidf_(g1));
        }
    }
}

template <int NV> __device__ __forceinline__ unsigned kth_largest(const unsigned (&u)[NV], int k) {
    unsigned Tk = 0u;
    for (int bit = 31; bit >= 0; --bit) {
        const unsigned cand = Tk | (1u << bit); int cnt = 0;
#pragma unroll
        for (int j = 0; j < NV; ++j) cnt += __popcll(__ballot(u[j] >= cand));
        if (cnt >= k) Tk = cand;
    }
    return Tk;
}

__device__ __forceinline__ unsigned wave_max_u(unsigned x) {
    unsigned y;
    y = dpp_u<0x111>(x); x = x > y ? x : y; y = dpp_u<0x112>(x); x = x > y ? x : y; y = dpp_u<0x114>(x); x = x > y ? x : y; y = dpp_u<0x118>(x); x = x > y ? x : y;
    y = (unsigned)__builtin_amdgcn_update_dpp(0, (int)x, 0x142, 0xA, 0xF, false); x = x > y ? x : y;
    y = (unsigned)__builtin_amdgcn_update_dpp(0, (int)x, 0x143, 0xC, 0xF, false); x = x > y ? x : y;
    return (unsigned)__builtin_amdgcn_readlane((int)x, 63);
}
__device__ __forceinline__ int wave_sum_i(int x) {
    x += __builtin_amdgcn_update_dpp(0, x, 0x111, 0xF, 0xF, false); x += __builtin_amdgcn_update_dpp(0, x, 0x112, 0xF, 0xF, false);
    x += __builtin_amdgcn_update_dpp(0, x, 0x114, 0xF, 0xF, false); x += __builtin_amdgcn_update_dpp(0, x, 0x118, 0xF, 0xF, false);
    x += __builtin_amdgcn_update_dpp(0, x, 0x142, 0xA, 0xF, false); x += __builtin_amdgcn_update_dpp(0, x, 0x143, 0xC, 0xF, false);
    return __builtin_amdgcn_readlane(x, 63);
}
__device__ __forceinline__ float wave_max_f(float x) {
    const int ninf = (int)0xff800000u; float y;
    y = __builtin_bit_cast(float, __builtin_amdgcn_update_dpp(ninf, __builtin_bit_cast(int, x), 0x111, 0xF, 0xF, false)); x = fmaxf(x, y);
    y = __builtin_bit_cast(float, __builtin_amdgcn_update_dpp(ninf, __builtin_bit_cast(int, x), 0x112, 0xF, 0xF, false)); x = fmaxf(x, y);
    y = __builtin_bit_cast(float, __builtin_amdgcn_update_dpp(ninf, __builtin_bit_cast(int, x), 0x114, 0xF, 0xF, false)); x = fmaxf(x, y);
    y = __builtin_bit_cast(float, __builtin_amdgcn_update_dpp(ninf, __builtin_bit_cast(int, x), 0x118, 0xF, 0xF, false)); x = fmaxf(x, y);
    y = __builtin_bit_cast(float, __builtin_amdgcn_update_dpp(ninf, __builtin_bit_cast(int, x), 0x142, 0xA, 0xF, false)); x = fmaxf(x, y);
    y = __builtin_bit_cast(float, __builtin_amdgcn_update_dpp(ninf, __builtin_bit_cast(int, x), 0x143, 0xC, 0xF, false)); x = fmaxf(x, y);
    return __builtin_bit_cast(float, __builtin_amdgcn_readlane(__builtin_bit_cast(int, x), 63));
}
__device__ __forceinline__ int wave_scan_i(int x) {
    x += __builtin_amdgcn_update_dpp(0, x, 0x111, 0xF, 0xF, false); x += __builtin_amdgcn_update_dpp(0, x, 0x112, 0xF, 0xF, false);
    x += __builtin_amdgcn_update_dpp(0, x, 0x114, 0xF, 0xF, false); x += __builtin_amdgcn_update_dpp(0, x, 0x118, 0xF, 0xF, false);
    x += __builtin_amdgcn_update_dpp(0, x, 0x142, 0xA, 0xF, false); x += __builtin_amdgcn_update_dpp(0, x, 0x143, 0xC, 0xF, false);
    return x;
}
__device__ __forceinline__ int hist_find(u32x4 h, int K, int lane, int& chi, int& cnt) {
    const int ls = (int)(h.x + h.y + h.z + h.w); const int inc = wave_scan_i(ls); const int tot = __builtin_amdgcn_readlane(inc, 63);
    const int a3 = tot - inc, a2 = a3 + (int)h.w, a1 = a2 + (int)h.z, a0 = a1 + (int)h.y;
    int myb = -1, mya = 0, myc = 0;
    if (a3 < K && K <= a3 + (int)h.w) { myb = 3; mya = a3; myc = (int)h.w; }
    if (a2 < K && K <= a2 + (int)h.z) { myb = 2; mya = a2; myc = (int)h.z; }
    if (a1 < K && K <= a1 + (int)h.y) { myb = 1; mya = a1; myc = (int)h.y; }
    if (a0 < K && K <= a0 + (int)h.x) { myb = 0; mya = a0; myc = (int)h.x; }
    const unsigned long long m = __ballot(myb >= 0); const int src = m ? (int)__builtin_ctzll(m) : 0;
    chi = __builtin_amdgcn_readlane(mya, src); cnt = __builtin_amdgcn_readlane(myc, src);
    return 4 * src + __builtin_amdgcn_readlane(myb, src);
}
constexpr int LDS_HIST = 131072 + 4096;
__device__ __forceinline__ void p4_indexer(const Ctx& C) {
    unsigned char* ws = C.ws; const int lane = C.lane, wave = C.wave, g = lane >> 4, fr = lane & 15;
    const bf16_t* qidx = (const bf16_t*)(ws + WS_QIDX); const bf16_t* kidx = (const bf16_t*)(ws + WS_KIDX); const float* widx = (const float*)(ws + WS_WIDX);
    bf16_t* idxo = (bf16_t*)(ws + WS_IDX);
    constexpr int SCB = 8192 + 16;
    LAS unsigned char* SC = C.lds;
    LAS unsigned* H = (LAS unsigned*)(C.lds + LDS_HIST + wave * 1024);
    for (int u = blockIdx.x; u < 1024; u += C.G) {
        const int i4 = u >> 8, cc = u & 255, b = cc & 3, j = cc >> 2, qb = (i4 & 1) ? 64 * i4 + 63 - j : 64 * i4 + j;
        const int t0 = qb * 16, ntile = (t0 + 16 + 15) >> 4; const size_t tb = (size_t)b * SEQ; const size_t qrow = tb + t0 + fr;
        bf16x8 Bq[8];
#pragma unroll
        for (int h = 0; h < 8; ++h) Bq[h] = *(const bf16x8*)(qidx + qrow * 256 + h * 32 + 8 * g);
        const f32x4 w0 = *(const f32x4*)(widx + qrow * 8), w1 = *(const f32x4*)(widx + qrow * 8 + 4);
        const float wq[8] = {w0.x, w0.y, w0.z, w0.w, w1.x, w1.y, w1.z, w1.w};
        bf16x8 An[4];
#pragma unroll
        for (int q = 0; q < 4; ++q) { int i = wave + q * NWAVES; i = i < ntile ? i : ntile - 1; An[q] = *(const bf16x8*)(kidx + (tb + 16 * i + fr) * 32 + 8 * g); }
        for (int i0 = wave; i0 < ntile; i0 += 4 * NWAVES) {
            bf16x8 A[4];
#pragma unroll
            for (int q = 0; q < 4; ++q) A[q] = An[q];
#pragma unroll
            for (int q = 0; q < 4; ++q) { int i = i0 + 4 * NWAVES + q * NWAVES; i = i < ntile ? i : ntile - 1; An[q] = *(const bf16x8*)(kidx + (tb + 16 * i + fr) * 32 + 8 * g); }
#pragma unroll
            for (int q = 0; q < 4; ++q) {
                const int i = i0 + q * NWAVES;
                if (i < ntile) {
                    f32x4 sc = (f32x4){0.f, 0.f, 0.f, 0.f};
#pragma unroll
                    for (int h = 0; h < 8; ++h) { const f32x4 d = __builtin_amdgcn_mfma_f32_16x16x32_bf16(A[q], Bq[h], (f32x4){0.f, 0.f, 0.f, 0.f}, 0, 0, 0);
#pragma unroll
                        for (int r = 0; r < 4; ++r) sc[r] = fmaf(wq[h], fmaxf(d[r], 0.f), sc[r]); }
                    const int tq = t0 + fr, s0 = 16 * i + 4 * g; unsigned kq[4];
#pragma unroll
                    for (int r = 0; r < 4; ++r) { const unsigned hb = (unsigned)__builtin_bit_cast(unsigned short, (_Float16)sc[r]); const unsigned ky = (hb & 0x8000u) ? (~hb & 0xffffu) : (hb | 0x8000u); kq[r] = (s0 + r <= tq) ? ky : 0u; }
                    u32x2 w; w.x = kq[0] | (kq[1] << 16); w.y = kq[2] | (kq[3] << 16);
                    *(LAS u32x2*)(SC + fr * SCB + 2 * s0) = w;
                }
            }
        }
        __syncthreads();
#pragma unroll 1
        for (int rr = 0; rr < 2; ++rr) {
            const int row = wave + 8 * rr, tq = t0 + row; bf16_t* out = idxo + (tb + tq) * 256;
            if (tq < 256) {
#pragma unroll
                for (int jj = 0; jj < 4; ++jj) { const int s = jj * 64 + lane; if (s <= tq) out[s] = (bf16_t)s; }
            } else {
                unsigned kp[32];
#pragma unroll
                for (int d = 0; d < 32; ++d) { const int s2 = 2 * (64 * d + lane); unsigned w = *(const LAS unsigned*)(SC + row * SCB + 2 * s2); if (s2 > tq) w = 0u; kp[d] = w; }
                *(LAS u32x4*)(H + 4 * lane) = (u32x4){0u, 0u, 0u, 0u};
#pragma unroll
                for (int d = 0; d < 32; ++d) { const unsigned a = kp[d] & 0xffffu, bq_ = kp[d] >> 16;
                    if (a) __hip_atomic_fetch_add(H + (a >> 8), 1u, __ATOMIC_RELAXED, __HIP_MEMORY_SCOPE_WORKGROUP);
                    if (bq_) __hip_atomic_fetch_add(H + (bq_ >> 8), 1u, __ATOMIC_RELAXED, __HIP_MEMORY_SCOPE_WORKGROUP); }
                asm volatile("s_waitcnt lgkmcnt(0)" ::: "memory");
                int chi1, cnt1; const int b1 = hist_find(*(const LAS u32x4*)(H + 4 * lane), 256, lane, chi1, cnt1);
                asm volatile("s_waitcnt lgkmcnt(0)" ::: "memory");
                *(LAS u32x4*)(H + 4 * lane) = (u32x4){0u, 0u, 0u, 0u};
#pragma unroll
                for (int d = 0; d < 32; ++d) { const unsigned a = kp[d] & 0xffffu, bq_ = kp[d] >> 16;
                    if ((int)(a >> 8) == b1 && a) __hip_atomic_fetch_add(H + (a & 255u), 1u, __ATOMIC_RELAXED, __HIP_MEMORY_SCOPE_WORKGROUP);
                    if ((int)(bq_ >> 8) == b1 && bq_) __hip_atomic_fetch_add(H + (bq_ & 255u), 1u, __ATOMIC_RELAXED, __HIP_MEMORY_SCOPE_WORKGROUP); }
                asm volatile("s_waitcnt lgkmcnt(0)" ::: "memory");
                int chi2, cnt2; const int b2 = hist_find(*(const LAS u32x4*)(H + 4 * lane), 256 - chi1, lane, chi2, cnt2);
                const unsigned T16 = (unsigned)(b1 * 256 + b2); const int need = 256 - chi1 - chi2;
                const bool allties = (need == cnt2); const unsigned thr = allties ? T16 : T16 + 1u;
                unsigned mlo = 0u, mhi = 0u;
#pragma unroll
                for (int d = 0; d < 16; ++d) { const unsigned a = kp[d] & 0xffffu, bq_ = kp[d] >> 16; mlo |= (a >= thr ? 1u : 0u) << (2 * d); mlo |= (bq_ >= thr ? 1u : 0u) << (2 * d + 1); }
#pragma unroll
                for (int d = 16; d < 32; ++d) { const unsigned a = kp[d] & 0xffffu, bq_ = kp[d] >> 16; mhi |= (a >= thr ? 1u : 0u) << (2 * (d - 16)); mhi |= (bq_ >= thr ? 1u : 0u) << (2 * (d - 16) + 1); }
                LAS bf16_t* stage = (LAS bf16_t*)(SC + row * SCB);
                const int mycnt = __popc(mlo) + __popc(mhi); int base = wave_scan_i(mycnt) - mycnt;
                while (mlo) { const int bp = __builtin_ctz(mlo); stage[base++] = (bf16_t)(2 * (64 * (bp >> 1) + lane) + (bp & 1)); mlo &= mlo - 1u; }
                while (mhi) { const int bp = __builtin_ctz(mhi); stage[base++] = (bf16_t)(2 * (64 * ((bp >> 1) + 16) + lane) + (bp & 1)); mhi &= mhi - 1u; }
                if (!allties) {
                    int eqb = 0; const int pos0 = 256 - need;
#pragma unroll 4
                    for (int d = 0; d < 32; ++d) {
                        const bool eq0 = ((kp[d] & 0xffffu) == T16), eq1 = ((kp[d] >> 16) == T16);
                        const unsigned long long m0 = __ballot(eq0), m1 = __ballot(eq1);
                        const int below = (int)__builtin_amdgcn_mbcnt_hi((unsigned)(m0 >> 32), __builtin_amdgcn_mbcnt_lo((unsigned)m0, 0u)) + (int)__builtin_amdgcn_mbcnt_hi((unsigned)(m1 >> 32), __builtin_amdgcn_mbcnt_lo((unsigned)m1, 0u));
                        const int r0 = eqb + below, r1 = r0 + (eq0 ? 1 : 0);
                        if (eq0 && r0 < need) stage[pos0 + r0] = (bf16_t)(2 * (64 * d + lane));
                        if (eq1 && r1 < need) stage[pos0 + r1] = (bf16_t)(2 * (64 * d + lane) + 1);
                        eqb += __popcll(m0) + __popcll(m1);
                    }
                }
                asm volatile("s_waitcnt lgkmcnt(0)" ::: "memory");
                *(u32x2*)(out + 4 * lane) = *(const LAS u32x2*)(stage + 4 * lane);
            }
        }
        __syncthreads();
    }
}

__device__ __forceinline__ void p4_memattn(const Ctx& C) {
    unsigned char* ws = C.ws; const int lane = C.lane, wave = C.wave, g = lane >> 4, fr = lane & 15;
    const bf16_t* memq = (const bf16_t*)(ws + WS_MEMQ); const bf16_t* kmem = (const bf16_t*)(ws + WS_KMEM); const bf16_t* vmt = (const bf16_t*)(ws + WS_VMEMT);
    bf16_t* ymem = (bf16_t*)(ws + WS_YM) + 512;
    LAS unsigned char* KL = C.lds; LAS unsigned char* VL = C.lds + 65536;
    for (int su = blockIdx.x; su < 256; su += C.G) {
        const int bh = su >> 4, j = su & 15, b = bh >> 2, h = bh & 3;
        const char* kb = (const char*)(kmem + (size_t)(bh * 256) * 128); const char* vb = (const char*)(vmt + (size_t)(bh * 128) * 256);
#pragma unroll
        for (int pp = 0; pp < 8; ++pp) { const int p = wave + 8 * pp;
            { const int row = 4 * p + g; const int c = fr ^ (2 * (row & 7)); __builtin_amdgcn_global_load_lds((const unsigned*)(kb + row * 256 + 16 * c), (LAS unsigned*)(KL + 1024 * p), 16, 0, 0); }
            { const int row = 2 * p + (lane >> 5); const int c = (lane & 31) ^ (row & 15); __builtin_amdgcn_global_load_lds((const unsigned*)(vb + row * 512 + 16 * c), (LAS unsigned*)(VL + 1024 * p), 16, 0, 0); } }
        asm volatile("s_waitcnt vmcnt(0)" ::: "memory");
        __syncthreads();
#pragma unroll 1
        for (int u = 0; u < 2; ++u) {
            const int t0 = b * SEQ + (2 * j + u) * 128 + wave * 16;
            bf16x8 Bq[4];
#pragma unroll
            for (int kk = 0; kk < 4; ++kk) Bq[kk] = *(const bf16x8*)(memq + (size_t)(t0 + fr) * 512 + h * 128 + 32 * kk + 8 * g);
            f32x4 sc[16];
#pragma unroll
            for (int i = 0; i < 16; ++i) { if ((i & 1) == 0) __builtin_amdgcn_sched_barrier(0); f32x4 a = (f32x4){0.f, 0.f, 0.f, 0.f}; const int row = 16 * i + fr;
#pragma unroll
                for (int kk = 0; kk < 4; ++kk) { const bf16x8 A = *(const LAS bf16x8*)(KL + row * 256 + 16 * ((4 * kk + g) ^ (2 * (row & 7)))); a = __builtin_amdgcn_mfma_f32_16x16x32_bf16(A, Bq[kk], a, 0, 0, 0); }
                sc[i] = a; }
            const float scale = 0.08838834764831845f;
            float mx = -3.0e38f;
#pragma unroll
            for (int i = 0; i < 16; ++i)
#pragma unroll
                for (int r = 0; r < 4; ++r) { sc[i][r] *= scale; mx = fmaxf(mx, sc[i][r]); }
            mx = fmaxf(mx, __shfl_xor(mx, 16)); mx = fmaxf(mx, __shfl_xor(mx, 32));
            float sum = 0.f;
#pragma unroll
            for (int i = 0; i < 16; ++i)
#pragma unroll
                for (int r = 0; r < 4; ++r) { sc[i][r] = __expf(sc[i][r] - mx); sum += sc[i][r]; }
            sum += __shfl_xor(sum, 16); sum += __shfl_xor(sum, 32);
            const float inv = 1.0f / sum;
            bf16x8 Pb[8];
#pragma unroll
            for (int ks = 0; ks < 8; ++ks) { u32x4 w; w.x = pk2(sc[2 * ks][0] * inv, sc[2 * ks][1] * inv); w.y = pk2(sc[2 * ks][2] * inv, sc[2 * ks][3] * inv);
                w.z = pk2(sc[2 * ks + 1][0] * inv, sc[2 * ks + 1][1] * inv); w.w = pk2(sc[2 * ks + 1][2] * inv, sc[2 * ks + 1][3] * inv); Pb[ks] = __builtin_bit_cast(bf16x8, w); }
#pragma unroll
            for (int dt = 0; dt < 8; ++dt) {
                __builtin_amdgcn_sched_barrier(0);
                f32x4 o = (f32x4){0.f, 0.f, 0.f, 0.f}; const int row = 16 * dt + fr;
#pragma unroll
                for (int ks = 0; ks < 8; ++ks) { const int ch = 4 * ks + (g >> 1);
                    const u32x2 lo = *(const LAS u32x2*)(VL + row * 512 + 16 * (ch ^ (row & 15)) + 8 * (g & 1)), hi = *(const LAS u32x2*)(VL + row * 512 + 16 * ((ch + 2) ^ (row & 15)) + 8 * (g & 1));
                    u32x4 w; w.x = lo.x; w.y = lo.y; w.z = hi.x; w.w = hi.y;
                    o = __builtin_amdgcn_mfma_f32_16x16x32_bf16(__builtin_bit_cast(bf16x8, w), Pb[ks], o, 0, 0, 0); }
                u32x2 w; w.x = pk2(o[0], o[1]); w.y = pk2(o[2], o[3]);
                *(u32x2*)(ymem + (size_t)(t0 + fr) * 1024 + h * 128 + 16 * dt + 4 * g) = w;
            }
        }
        __syncthreads();
    }
}

constexpr int LDS_RELB = 131072 + 1024;
constexpr int LDS_LUT = LDS_RELB + 1024;
__device__ __forceinline__ void tr_read8(const unsigned (&a)[8], u32x2 (&d)[8]) {
    asm volatile("ds_read_b64_tr_b16 %0, %8\n\tds_read_b64_tr_b16 %1, %9\n\tds_read_b64_tr_b16 %2, %10\n\tds_read_b64_tr_b16 %3, %11\n\t"
                 "ds_read_b64_tr_b16 %4, %12\n\tds_read_b64_tr_b16 %5, %13\n\tds_read_b64_tr_b16 %6, %14\n\tds_read_b64_tr_b16 %7, %15\n\ts_waitcnt lgkmcnt(0)"
                 : "=&v"(d[0]), "=&v"(d[1]), "=&v"(d[2]), "=&v"(d[3]), "=&v"(d[4]), "=&v"(d[5]), "=&v"(d[6]), "=&v"(d[7])
                 : "v"(a[0]), "v"(a[1]), "v"(a[2]), "v"(a[3]), "v"(a[4]), "v"(a[5]), "v"(a[6]), "v"(a[7]) : "memory");
}
constexpr int LDS_DSAX = 131072 + 4096;
__device__ __forceinline__ void p5_dsa_attn(const Ctx& C, int qsel) {
    unsigned char* ws = C.ws; const int lane = C.lane, wave = C.wave, g = lane >> 4, fr = lane & 15;
    const bf16_t* qlat = (const bf16_t*)(ws + WS_QLAT); const bf16_t* kvl = (const bf16_t*)(ws + WS_KVL); const bf16_t* idxb = (const bf16_t*)(ws + WS_IDX);
    bf16_t* olat = (bf16_t*)(ws + WS_OLAT);
    LAS int* lut = (LAS int*)(C.lds + LDS_LUT);
    if (C.tid < 128) { const int n = C.tid; int bk = n; if (n >= 16) { bk = 16 + (int)(logf((float)n * (1.0f / 16.0f)) / 2.0794415416798357f * 16.0f); bk = bk > 31 ? 31 : bk; } lut[n] = bk; }
    __syncthreads();
    LAS unsigned char* my = C.lds + wave * 16384; const unsigned mybase = (unsigned)(uintptr_t)my;
    LAS bf16_t* IDXL = (LAS bf16_t*)(C.lds + LDS_DSAX + wave * 1024); LAS bf16_t* BKL = IDXL + 256;
    unsigned* qctr = (unsigned*)(ws + WS_CTL) + CW_DSAQ + 64 * qsel;
    const int qq = fr >> 2, p2 = fr & 3;
    bf16x8 Bbias;
    { float bv[8];
#pragma unroll
      for (int j = 0; j < 8; ++j) bv[j] = C.in[2][(8 * g + j) * 8 + (fr & 7)];
      Bbias = __builtin_bit_cast(bf16x8, pack8(bv)); }
    unsigned qkoff[2][4];
#pragma unroll
    for (int i = 0; i < 2; ++i) { const int ph = 4 * (fr & 7) + 2 * i + (fr >> 3);
#pragma unroll
        for (int kk = 0; kk < 4; ++kk) qkoff[i][kk] = (unsigned)(ph * 256 + 16 * ((4 * kk + g) ^ (2 * (ph & 7)))); }
    const int ph0 = 4 * (4 * (g & 1) + qq) + (g >> 1), ph1 = ph0 + 2;
    auto fetch_batch = [&]() -> int { int q0 = 0; if (lane == 0) q0 = (int)__hip_atomic_fetch_add(qctr, 4u, __ATOMIC_RELAXED, __HIP_MEMORY_SCOPE_AGENT); return __builtin_amdgcn_readfirstlane(q0); };
    int q = fetch_batch();
    u32x2 ixw = (u32x2){0u, 0u}; bf16x8 Bq[4];
    if (q < T) { ixw = *(const u32x2*)(idxb + (size_t)q * 256 + 4 * lane);
#pragma unroll
        for (int kk = 0; kk < 4; ++kk) Bq[kk] = *(const bf16x8*)(qlat + (size_t)q * 1024 + (fr & 7) * 128 + 32 * kk + 8 * g); }
    bool staged = false;
    while (q < T) {
        const int b = q >> 12, s = q & (SEQ - 1); const int nvalid = s + 1 < 256 ? s + 1 : 256;
        const char* kvb = (const char*)(kvl + (size_t)b * SEQ * 128);
        const int nsub = (nvalid + 31) >> 5;
#define DSA_STAGE(IXW, SS, NV, KVB) do { \
            int ix_[4] = {(int)((IXW).x & 0xffffu), (int)((IXW).x >> 16), (int)((IXW).y & 0xffffu), (int)((IXW).y >> 16)}; unsigned bk_[4]; \
            _Pragma("unroll") for (int j_ = 0; j_ < 4; ++j_) { if (4 * lane + j_ >= (NV)) ix_[j_] = 0; const int dist_ = (SS) - ix_[j_]; bk_[j_] = (unsigned)(dist_ >= 128 ? 31 : lut[dist_ < 0 ? 0 : dist_]); } \
            u32x2 wi_; wi_.x = (unsigned)ix_[0] | ((unsigned)ix_[1] << 16); wi_.y = (unsigned)ix_[2] | ((unsigned)ix_[3] << 16); *(LAS u32x2*)(IDXL + 4 * lane) = wi_; \
            u32x2 wb_; wb_.x = bk_[0] | (bk_[1] << 16); wb_.y = bk_[2] | (bk_[3] << 16); *(LAS u32x2*)(BKL + 4 * lane) = wb_; \
            asm volatile("s_waitcnt lgkmcnt(0)" ::: "memory"); \
            const u32x4 rw_ = *(const LAS u32x4*)(IDXL + 8 * g); const unsigned rws_[4] = {rw_.x, rw_.y, rw_.z, rw_.w}; \
            _Pragma("unroll") for (int p_ = 0; p_ < 8; ++p_) { const int srow_ = (int)((rws_[p_ >> 1] >> (16 * (p_ & 1))) & 0xffffu); const int c_ = fr ^ (2 * ((4 * p_ + g) & 7)); \
                __builtin_amdgcn_global_load_lds((const unsigned*)((KVB) + (size_t)srow_ * 256 + 16 * c_), (LAS unsigned*)(my + 1024 * p_), 16, 0, 0); } } while (0)
        if (!staged) { asm volatile("s_waitcnt vmcnt(0)" ::: "memory"); DSA_STAGE(ixw, s, nvalid, kvb); }
        int qn = ((q & 3) != 3) ? q + 1 : fetch_batch();
        u32x2 ixn = (u32x2){0u, 0u}; bf16x8 Bqn[4];
        if (qn < T) { ixn = *(const u32x2*)(idxb + (size_t)qn * 256 + 4 * lane);
#pragma unroll
            for (int kk = 0; kk < 4; ++kk) Bqn[kk] = *(const bf16x8*)(qlat + (size_t)qn * 1024 + (fr & 7) * 128 + 32 * kk + 8 * g); }
        else {
#pragma unroll
            for (int kk = 0; kk < 4; ++kk) Bqn[kk] = Bq[kk]; }
        float m_ref = 0.f, l_part = 0.f;
        f32x4 O[8];
#pragma unroll
        for (int cc = 0; cc < 8; ++cc) O[cc] = (f32x4){0.f, 0.f, 0.f, 0.f};
#pragma unroll
        for (int sc_ = 0; sc_ < 8; ++sc_) {
          if (sc_ < nsub) {
            LAS unsigned char* cur = my + (sc_ & 1) * 8192; const unsigned curb = mybase + (sc_ & 1) * 8192;
            if (sc_ + 1 < nsub) {
                LAS unsigned char* nb = my + ((sc_ + 1) & 1) * 8192;
                const u32x4 rw = *(const LAS u32x4*)(IDXL + 32 * (sc_ + 1) + 8 * g); const unsigned rws[4] = {rw.x, rw.y, rw.z, rw.w};
#pragma unroll
                for (int p = 0; p < 8; ++p) { const int srow = (int)((rws[p >> 1] >> (16 * (p & 1))) & 0xffffu); const int c = fr ^ (2 * ((4 * p + g) & 7));
                    __builtin_amdgcn_global_load_lds((const unsigned*)(kvb + (size_t)srow * 256 + 16 * c), (LAS unsigned*)(nb + 1024 * p), 16, 0, 0); }
                asm volatile("s_waitcnt vmcnt(8)" ::: "memory");
            } else asm volatile("s_waitcnt vmcnt(0)" ::: "memory");
            f32x4 sc[2];
#pragma unroll
            for (int i = 0; i < 2; ++i) {
                const int pos = (int)BKL[32 * sc_ + 16 * i + fr] - 8 * g;
                u32x4 oh; oh.x = (pos == 0 ? 0x3F80u : 0u) | (pos == 1 ? 0x3F800000u : 0u); oh.y = (pos == 2 ? 0x3F80u : 0u) | (pos == 3 ? 0x3F800000u : 0u);
                oh.z = (pos == 4 ? 0x3F80u : 0u) | (pos == 5 ? 0x3F800000u : 0u); oh.w = (pos == 6 ? 0x3F80u : 0u) | (pos == 7 ? 0x3F800000u : 0u);
                f32x4 a = __builtin_amdgcn_mfma_f32_16x16x32_bf16(__builtin_bit_cast(bf16x8, oh), Bbias, (f32x4){0.f, 0.f, 0.f, 0.f}, 0, 0, 0);
#pragma unroll
                for (int kk = 0; kk < 4; ++kk) a = __builtin_amdgcn_mfma_f32_16x16x32_bf16(*(const LAS bf16x8*)(cur + qkoff[i][kk]), Bq[kk], a, 0, 0, 0);
                sc[i] = a; }
            if (nvalid < 256) {
#pragma unroll
                for (int i = 0; i < 2; ++i)
#pragma unroll
                    for (int r = 0; r < 4; ++r) if (sc_ * 32 + 16 * i + 4 * g + r >= nvalid) sc[i][r] = -INFINITY;
            }
            if (sc_ == 0) { float mx = fmaxf(fmaxf(fmaxf(sc[0][0], sc[0][1]), fmaxf(sc[0][2], sc[0][3])), fmaxf(fmaxf(sc[1][0], sc[1][1]), fmaxf(sc[1][2], sc[1][3])));
                mx = fmaxf(mx, __shfl_xor(mx, 16)); mx = fmaxf(mx, __shfl_xor(mx, 32)); m_ref = mx; }
#pragma unroll
            for (int i = 0; i < 2; ++i)
#pragma unroll
                for (int r = 0; r < 4; ++r) { sc[i][r] = __expf(sc[i][r] - m_ref); l_part += sc[i][r]; }
            u32x4 w; w.x = pk2(sc[0][0], sc[0][1]); w.y = pk2(sc[0][2], sc[0][3]); w.z = pk2(sc[1][0], sc[1][1]); w.w = pk2(sc[1][2], sc[1][3]);
            const bf16x8 Pa = __builtin_bit_cast(bf16x8, w);
#pragma unroll
            for (int hf = 0; hf < 2; ++hf) {
                unsigned ad[8]; u32x2 dd[8];
#pragma unroll
                for (int c4 = 0; c4 < 4; ++c4) { const int chk = 2 * (4 * hf + c4) + (p2 >> 1);
                    ad[2 * c4] = curb + ph0 * 256 + 16 * (chk ^ (2 * (ph0 & 7))) + 8 * (p2 & 1); ad[2 * c4 + 1] = curb + ph1 * 256 + 16 * (chk ^ (2 * (ph1 & 7))) + 8 * (p2 & 1); }
                tr_read8(ad, dd);
#pragma unroll
                for (int c4 = 0; c4 < 4; ++c4) { u32x4 bw; bw.x = dd[2 * c4].x; bw.y = dd[2 * c4].y; bw.z = dd[2 * c4 + 1].x; bw.w = dd[2 * c4 + 1].y;
                    O[4 * hf + c4] = __builtin_amdgcn_mfma_f32_16x16x32_bf16(Pa, __builtin_bit_cast(bf16x8, bw), O[4 * hf + c4], 0, 0, 0); }
            }
            asm volatile("" ::: "memory");
          }
        }
        staged = false;
        if (qn < T) { const int bn = qn >> 12, sn = qn & (SEQ - 1); const int nvn = sn + 1 < 256 ? sn + 1 : 256; const char* kvbn = (const char*)(kvl + (size_t)bn * SEQ * 128);
            DSA_STAGE(ixn, sn, nvn, kvbn); staged = true; }
        float l_run = l_part; l_run += __shfl_xor(l_run, 16); l_run += __shfl_xor(l_run, 32);
        const float inv = 1.0f / l_run; float ir[4];
#pragma unroll
        for (int r = 0; r < 4; ++r) ir[r] = __shfl(inv, 4 * g + r);
        if (g < 2) {
#pragma unroll
            for (int cc = 0; cc < 8; ++cc)
#pragma unroll
                for (int r = 0; r < 4; ++r) olat[(size_t)q * 1024 + (4 * g + r) * 128 + 16 * cc + fr] = (bf16_t)f2bf(O[cc][r] * ir[r]);
        }
        q = qn; ixw = ixn;
#pragma unroll
        for (int kk = 0; kk < 4; ++kk) Bq[kk] = Bqn[kk];
    }
#undef DSA_STAGE
}

constexpr int RWM_LDS = 15872;
__device__ __forceinline__ bf16x8 frag_pack(f32x4 lo, f32x4 hi) { u32x4 w; w.x = pk2(lo.x, lo.y); w.y = pk2(lo.z, lo.w); w.z = pk2(hi.x, hi.y); w.w = pk2(hi.z, hi.w); return __builtin_bit_cast(bf16x8, w); }
__device__ __forceinline__ bf16x8 frag_pack_lo(f32x4 lo) { u32x4 w; w.x = pk2(lo.x, lo.y); w.y = pk2(lo.z, lo.w); w.z = 0u; w.w = 0u; return __builtin_bit_cast(bf16x8, w); }
struct RwIn { u32x4 e[2], k[2], a[2]; };
template <int MODE> __device__ __forceinline__ void rwm_fetch(RwIn& w, const bf16_t* pe, const bf16_t* pk, const bf16_t* pa, const bf16_t* pr, const bf16_t* pv, const bf16_t* pg, size_t t0, int h, int g, int fr) {
    const size_t rowoff = (t0 + fr) * 512 + h * 64;
#pragma unroll
    for (int k2 = 0; k2 < 2; ++k2) { const int c0 = 32 * k2 + 8 * g; w.e[k2] = *(const u32x4*)(pe + rowoff + c0); w.k[k2] = *(const u32x4*)(pk + rowoff + c0); w.a[k2] = *(const u32x4*)(pa + rowoff + c0);
        }
}
__device__ __forceinline__ void tr_read4(const unsigned (&a)[4], u32x2 (&d)[4]) {
    asm volatile("ds_read_b64_tr_b16 %0, %4\n\tds_read_b64_tr_b16 %1, %5\n\tds_read_b64_tr_b16 %2, %6\n\tds_read_b64_tr_b16 %3, %7\n\ts_waitcnt lgkmcnt(0)"
                 : "=&v"(d[0]), "=&v"(d[1]), "=&v"(d[2]), "=&v"(d[3]) : "v"(a[0]), "v"(a[1]), "v"(a[2]), "v"(a[3]) : "memory");
}
template <int O0, int O1, int O2, int O3> __device__ __forceinline__ void tr_read4_off(unsigned base, u32x2 (&d)[4]) {
    asm volatile("ds_read_b64_tr_b16 %0, %4 offset:%5\n\tds_read_b64_tr_b16 %1, %4 offset:%6\n\tds_read_b64_tr_b16 %2, %4 offset:%7\n\tds_read_b64_tr_b16 %3, %4 offset:%8\n\ts_waitcnt lgkmcnt(0)"
                 : "=&v"(d[0]), "=&v"(d[1]), "=&v"(d[2]), "=&v"(d[3]) : "v"(base), "i"(O0), "i"(O1), "i"(O2), "i"(O3) : "memory");
}
__device__ __forceinline__ bf16x8 frag_lo_raw(u32x2 lo) { u32x4 w; w.x = lo.x; w.y = lo.y; w.z = 0u; w.w = 0u; return __builtin_bit_cast(bf16x8, w); }
__device__ __forceinline__ bf16x8 frag_pack_raw(f32x4 lo, u32x2 hi) { u32x4 w; w.x = pk2(lo.x, lo.y); w.y = pk2(lo.z, lo.w); w.z = hi.x; w.w = hi.y; return __builtin_bit_cast(bf16x8, w); }
template <int MODE> __device__ __forceinline__ void rwm_task(const Ctx& C, int bh, int ch) {
    unsigned char* ws = C.ws; const int lane = C.lane, g = lane >> 4, fr = lane & 15; const int b = bh >> 3, h = bh & 7;
    const bf16_t* pr = (const bf16_t*)(ws + WS_RW_R); const bf16_t* pk = (const bf16_t*)(ws + WS_RW_K); const bf16_t* pv = (const bf16_t*)(ws + WS_RW_V);
    const bf16_t* pa = (const bf16_t*)(ws + WS_RW_A); const bf16_t* pe = (const bf16_t*)(ws + WS_RW_E); const bf16_t* pg = (const bf16_t*)(ws + WS_RW_G);
    bf16_t* yo = (bf16_t*)(ws + WS_YM);
    float* PQ = (float*)(C.dout + DO_PQ);
    LAS unsigned char* my = C.lds + C.wave * RWM_LDS; const unsigned myb = (unsigned)(uintptr_t)my;
    LAS unsigned char* SI = my; LAS unsigned char* BI = my + 9216; LAS unsigned char* KI = my + 11264; LAS float* CL = (LAS float*)(my + 13312); LAS unsigned char* VI = my + 13824;
    const gfp in16 = (gfp)C.in[16], in17 = (gfp)C.in[17], in18 = (gfp)C.in[18], in19 = (gfp)C.in[19], in20 = (gfp)C.in[20];
    const size_t tok0 = (size_t)b * SEQ + (size_t)ch * RL;
    const f32x4 Z4 = (f32x4){0.f, 0.f, 0.f, 0.f};
    const float* sbase = PQ + ((size_t)((bh * RCH + (ch > 0 ? ch - 1 : 0)) * 2)) * 4096 + fr * 64 + 4 * g;
    int gv = g; asm volatile("" : "+v"(gv));
    f32x4 S[4][4];
#pragma unroll
    for (int vt = 0; vt < 4; ++vt)
#pragma unroll
        for (int kt = 0; kt < 4; ++kt) {
            if (MODE == 1) { f32x4 x;
#pragma unroll
                for (int r = 0; r < 4; ++r) x[r] = (vt == kt && 4 * gv + r == fr) ? 1.f : 0.f;
                S[vt][kt] = x; }
            else if (MODE == 2 && ch > 0) { gfp sp = (gfp)(sbase + 1024 * vt); asm volatile("" : "+v"(sp));
                S[vt][kt] = *(const __attribute__((address_space(1))) f32x4*)(sp + 16 * kt); }
            else S[vt][kt] = Z4; }
    const bool strict[4] = {4 * g + 0 < fr, 4 * g + 1 < fr, 4 * g + 2 < fr, 4 * g + 3 < fr};
    const bool incl[4] = {4 * g + 0 <= fr, 4 * g + 1 <= fr, 4 * g + 2 <= fr, 4 * g + 3 <= fr};
    const int qq = fr >> 2, p2 = fr & 3; const unsigned trb = myb + (unsigned)((4 * g + qq) * 128 + 8 * p2);
    RwIn nxt; rwm_fetch<MODE>(nxt, pe, pk, pa, pr, pv, pg, tok0, h, g, fr);
#pragma unroll 1
    for (int sub = 0; sub < RL / 16; ++sub) {
        const size_t t0 = tok0 + (size_t)sub * 16;
        int frl = fr, gl_ = g; asm volatile("" : "+v"(frl), "+v"(gl_));
        u32x4 gq[2], rq[2], vq[2];
        { const size_t ro0 = (t0 + frl) * 512 + h * 64 + 8 * gl_;
          if (MODE == 2) { gq[0] = *(const u32x4*)(pg + ro0); gq[1] = *(const u32x4*)(pg + ro0 + 32); rq[0] = *(const u32x4*)(pr + ro0); rq[1] = *(const u32x4*)(pr + ro0 + 32); }
          if (MODE != 1) { vq[0] = *(const u32x4*)(pv + ro0); vq[1] = *(const u32x4*)(pv + ro0 + 32); } }
        const RwIn cur = nxt; rwm_fetch<MODE>(nxt, pe, pk, pa, pr, pv, pg, tok0 + (size_t)(sub + 1 < RL / 16 ? sub + 1 : sub) * 16, h, gl_, frl);
#pragma unroll
        for (int vt = 0; vt < 4; ++vt)
#pragma unroll
            for (int kt = 0; kt < 4; ++kt)
                { u32x2 w; w.x = pk2(S[vt][kt][0], S[vt][kt][1]); w.y = pk2(S[vt][kt][2], S[vt][kt][3]); *(LAS u32x2*)(SI + fr * 144 + 8 * g + vt * 2304 + 32 * kt) = w; }
        bf16x8 kap[2], rtl[2]; float bcoef = 0.f;
        {
            float ssq = 0.f, bsum = 0.f;
#pragma unroll
            for (int k2 = 0; k2 < 2; ++k2) { const int c0 = 32 * k2 + 8 * g; float kv[8]; unpack8(cur.k[k2], kv);
                const f32x4 kk0 = *(const __attribute__((address_space(1))) f32x4*)(in16 + h * 64 + c0), kk1 = *(const __attribute__((address_space(1))) f32x4*)(in16 + h * 64 + c0 + 4); const float kkc[8] = {kk0.x, kk0.y, kk0.z, kk0.w, kk1.x, kk1.y, kk1.z, kk1.w};
#pragma unroll
                for (int j = 0; j < 8; ++j) { const float x = kv[j] * kkc[j]; ssq += x * x; } }
            ssq += __shfl_xor(ssq, 16); ssq += __shfl_xor(ssq, 32);
            const float rn = __builtin_amdgcn_rsqf(fmaxf(ssq, 1e-24f));
#pragma unroll
            for (int k2 = 0; k2 < 2; ++k2) { const int c0 = 32 * k2 + 8 * g; float ev[8], kv[8], aa[8], rv[8];
                __builtin_amdgcn_sched_barrier(0);
                unpack8(cur.e[k2], ev); unpack8(cur.k[k2], kv); unpack8(cur.a[k2], aa);
                if (MODE == 2) unpack8(rq[k2], rv);
                const f32x4 ka0 = *(const __attribute__((address_space(1))) f32x4*)(in17 + h * 64 + c0), ka1 = *(const __attribute__((address_space(1))) f32x4*)(in17 + h * 64 + c0 + 4); const float kac[8] = {ka0.x, ka0.y, ka0.z, ka0.w, ka1.x, ka1.y, ka1.z, ka1.w};
                const f32x4 kk0 = *(const __attribute__((address_space(1))) f32x4*)(in16 + h * 64 + c0), kk1 = *(const __attribute__((address_space(1))) f32x4*)(in16 + h * 64 + c0 + 4); const float kkc[8] = {kk0.x, kk0.y, kk0.z, kk0.w, kk1.x, kk1.y, kk1.z, kk1.w};
                float rkc[8];
                if (MODE == 2) { const f32x4 r0 = *(const __attribute__((address_space(1))) f32x4*)(in18 + h * 64 + c0), r1 = *(const __attribute__((address_space(1))) f32x4*)(in18 + h * 64 + c0 + 4); rkc[0] = r0.x; rkc[1] = r0.y; rkc[2] = r0.z; rkc[3] = r0.w; rkc[4] = r1.x; rkc[5] = r1.y; rkc[6] = r1.z; rkc[7] = r1.w; }
                float kt_[8], bt_[8], kxt_[8], rt_[8];
#pragma unroll
                for (int j = 0; j < 8; ++j) {
                    float c = ev[j]; c += dpp_f<0x111>(c); c += dpp_f<0x112>(c); c += dpp_f<0x114>(c); c += dpp_f<0x118>(c);
                    const float kx = kv[j] * (1.0f + (aa[j] - 1.0f) * kac[j]); const float kk = kv[j] * kkc[j] * rn;
                    const float e2 = __expf(c), e3 = __builtin_amdgcn_rcpf(e2), e1 = e3 * __expf(ev[j]);
                    kt_[j] = kk * e1; bt_[j] = kk * aa[j] * e2; kxt_[j] = kx * e2;
                    if (MODE == 2) { rt_[j] = rv[j] * e3; bsum += rv[j] * kx * rkc[j]; } else rt_[j] = 0.f;
                    if (fr == 15) CL[c0 + j] = e3;
                }
                kap[k2] = __builtin_bit_cast(bf16x8, pack8(kt_)); if (MODE == 2) rtl[k2] = __builtin_bit_cast(bf16x8, pack8(rt_));
                *(LAS u32x4*)(BI + fr * 128 + 64 * k2 + 16 * g) = pack8(bt_); *(LAS u32x4*)(KI + fr * 128 + 64 * k2 + 16 * g) = pack8(kxt_);
            }
            if (MODE == 2) { bsum += __shfl_xor(bsum, 16); bsum += __shfl_xor(bsum, 32); bcoef = bsum; }
        }
        bf16x8 bet[2], kxf[2];
#pragma unroll
        for (int k2 = 0; k2 < 2; ++k2) { bet[k2] = *(const LAS bf16x8*)(BI + fr * 128 + 64 * k2 + 16 * g); kxf[k2] = *(const LAS bf16x8*)(KI + fr * 128 + 64 * k2 + 16 * g); }
        u32x2 VT[4];
        if (MODE != 1) {
#pragma unroll
            for (int k2 = 0; k2 < 2; ++k2) *(LAS u32x4*)(VI + fr * 128 + 64 * k2 + 16 * g) = vq[k2];
            tr_read4_off<13824, 13824 + 32, 13824 + 64, 13824 + 96>(trb, VT);
        } else {
#pragma unroll
            for (int vt = 0; vt < 4; ++vt) { VT[vt].x = 0u; VT[vt].y = 0u; }
        }
        f32x4 AT = Z4, BmT = Z4, C1T = Z4, C2T = Z4;
#pragma unroll
        for (int k2 = 0; k2 < 2; ++k2) { AT = __builtin_amdgcn_mfma_f32_16x16x32_bf16(bet[k2], kap[k2], AT, 0, 0, 0);
            if (MODE != 1) BmT = __builtin_amdgcn_mfma_f32_16x16x32_bf16(kxf[k2], kap[k2], BmT, 0, 0, 0);
            if (MODE == 2) { C1T = __builtin_amdgcn_mfma_f32_16x16x32_bf16(bet[k2], rtl[k2], C1T, 0, 0, 0); C2T = __builtin_amdgcn_mfma_f32_16x16x32_bf16(kxf[k2], rtl[k2], C2T, 0, 0, 0); } }
#pragma unroll
        for (int r = 0; r < 4; ++r) { AT[r] = strict[r] ? AT[r] : 0.f; BmT[r] = strict[r] ? BmT[r] : 0.f; C1T[r] = incl[r] ? C1T[r] : 0.f; C2T[r] = incl[r] ? C2T[r] : 0.f; }
        float tr[16];
        int frv = fr; asm volatile("" : "+v"(frv));
#pragma unroll
        for (int c = 15; c >= 0; --c) { float s = (c == frv) ? 1.f : 0.f;
#pragma unroll
            for (int j = c + 1; j < 16; ++j) { const float ajc = __builtin_bit_cast(float, __builtin_amdgcn_readlane(__builtin_bit_cast(int, AT[c & 3]), j + 16 * (c >> 2))); s = fmaf(-tr[j], ajc, s); }
            tr[c] = s; }
        f32x4 Tq;
#pragma unroll
        for (int jj = 0; jj < 4; ++jj) Tq[jj] = g == 0 ? tr[jj] : (g == 1 ? tr[4 + jj] : (g == 2 ? tr[8 + jj] : tr[12 + jj]));
        const bf16x8 Tf = frag_pack_lo(Tq), Bmf = frag_pack_lo(BmT), Cf = frag_pack(C1T, C2T);
        f32x4 Zt[4], Yt[4];
#pragma unroll
        for (int vt = 0; vt < 4; ++vt) {
            const int v = 16 * vt + fr;
            const bf16x8 s0 = *(const LAS bf16x8*)(SI + v * 144 + 16 * g), s1 = *(const LAS bf16x8*)(SI + v * 144 + 64 + 16 * g);
            f32x4 rhs = __builtin_amdgcn_mfma_f32_16x16x32_bf16(kap[0], s0, Z4, 0, 0, 0); rhs = __builtin_amdgcn_mfma_f32_16x16x32_bf16(kap[1], s1, rhs, 0, 0, 0);
            if (MODE != 1) rhs = __builtin_amdgcn_mfma_f32_16x16x32_bf16(Bmf, frag_lo_raw(VT[vt]), rhs, 0, 0, 0);
            f32x4 z = __builtin_amdgcn_mfma_f32_16x16x32_bf16(Tf, frag_pack_lo(rhs), Z4, 0, 0, 0);
            Zt[vt] = -z;
            if (MODE == 2) { f32x4 y = __builtin_amdgcn_mfma_f32_16x16x32_bf16(rtl[0], s0, Z4, 0, 0, 0); y = __builtin_amdgcn_mfma_f32_16x16x32_bf16(rtl[1], s1, y, 0, 0, 0);
                Yt[vt] = __builtin_amdgcn_mfma_f32_16x16x32_bf16(Cf, frag_pack_raw(Zt[vt], VT[vt]), y, 0, 0, 0); }
        }
        if (MODE == 2) {
            u32x2 GT[4];
            {
#pragma unroll
                for (int k2 = 0; k2 < 2; ++k2) *(LAS u32x4*)(VI + fr * 128 + 64 * k2 + 16 * g) = gq[k2];
                tr_read4_off<13824, 13824 + 32, 13824 + 64, 13824 + 96>(trb, GT);
            }
#pragma unroll
            for (int r = 0; r < 4; ++r) {
                const float mean = row_sum_f(Yt[0][r] + Yt[1][r] + Yt[2][r] + Yt[3][r]) * (1.0f / 64.0f);
                const float d0 = Yt[0][r] - mean, d1 = Yt[1][r] - mean, d2 = Yt[2][r] - mean, d3 = Yt[3][r] - mean;
                const float rstd = rsqrtf(row_sum_f(d0 * d0 + d1 * d1 + d2 * d2 + d3 * d3) * (1.0f / 64.0f) + 64e-5f);
                const float bc = __shfl(bcoef, 4 * g + r); const float dd_[4] = {d0, d1, d2, d3}; const size_t ro = (t0 + 4 * gl_ + r) * 1024 + h * 64 + frl;
#pragma unroll
                for (int vt = 0; vt < 4; ++vt) { const unsigned gw2 = r < 2 ? GT[vt].x : GT[vt].y, vw2 = r < 2 ? VT[vt].x : VT[vt].y; const float gate = (r & 1) ? bfhi(gw2) : bflo(gw2), vval = (r & 1) ? bfhi(vw2) : bflo(vw2);
                    yo[ro + 16 * vt] = (bf16_t)f2bf((dd_[vt] * rstd * in19[h * 64 + 16 * vt + frl] + in20[h * 64 + 16 * vt + frl] + bc * vval) * gate); }
            }
        }
        {
            u32x2 db[4], dk[4], dd[8];
            tr_read4_off<9216, 9216 + 32, 9216 + 64, 9216 + 96>(trb, db); tr_read4_off<11264, 11264 + 32, 11264 + 64, 11264 + 96>(trb, dk);
#pragma unroll
            for (int kt = 0; kt < 4; ++kt) { dd[2 * kt] = db[kt]; dd[2 * kt + 1] = dk[kt]; }
            f32x4 gl[4];
#pragma unroll
            for (int kt = 0; kt < 4; ++kt) gl[kt] = *(const LAS f32x4*)(CL + 16 * kt + 4 * g);
#pragma unroll
            for (int vt = 0; vt < 4; ++vt) { const bf16x8 Af = frag_pack_raw(Zt[vt], VT[vt]);
#pragma unroll
                for (int kt = 0; kt < 4; ++kt) { u32x4 bw; bw.x = dd[2 * kt].x; bw.y = dd[2 * kt].y; bw.z = dd[2 * kt + 1].x; bw.w = dd[2 * kt + 1].y;
                    S[vt][kt] = __builtin_amdgcn_mfma_f32_16x16x32_bf16(__builtin_bit_cast(bf16x8, bw), Af, S[vt][kt], 0, 0, 0) * gl[kt]; } }
        }
    }
    if (MODE != 2) { float* dst = PQ + ((size_t)((bh * RCH + ch) * 2 + MODE)) * 4096 + fr * 64 + 4 * g;
#pragma unroll
        for (int vt = 0; vt < 4; ++vt)
#pragma unroll
            for (int kt = 0; kt < 4; ++kt) *(f32x4*)(dst + vt * 1024 + 16 * kt) = S[vt][kt]; }
}
__device__ __forceinline__ void p4_rwkv_pass1(const Ctx& C) {
    for (int task = C.gw; task < 32 * (RCH - 1) * 2; task += C.ngw) { const int mode = task & 1, rr = task >> 1, ch = rr % (RCH - 1), bh = rr / (RCH - 1);
        if (mode == 0) rwm_task<0>(C, bh, ch); else rwm_task<1>(C, bh, ch); }
}
__device__ __forceinline__ void p6_rwkv_pass3(const Ctx& C) {
    for (int task = (int)blockIdx.x + C.G * C.wave; task < 32 * RCH; task += C.G * NWAVES) rwm_task<2>(C, task / RCH, task % RCH);
}
__device__ __forceinline__ void p5_rwkv_carry(const Ctx& C) {
    float* PQ = (float*)(C.dout + DO_PQ); const int lane = C.lane, wave = C.wave, tid = C.tid;
    LAS float* ST = (LAS float*)C.lds;
    LAS float* PL = (LAS float*)(C.lds + 32768);
    for (int bh = blockIdx.x; bh < 32; bh += C.G) {
        for (int i = tid; i < 4096; i += NTHREADS) ST[i] = 0.f;
        const float* base = PQ + (size_t)(bh * RCH) * 2 * 4096;
        f32x4 pa = *(const f32x4*)(base + 4096 + tid * 8), pb = *(const f32x4*)(base + 4096 + tid * 8 + 4);
        f32x4 q0 = *(const f32x4*)(base + lane * 64 + 8 * wave), q1 = *(const f32x4*)(base + lane * 64 + 8 * wave + 4);
        __syncthreads();
        for (int ch = 0; ch < RCH - 1; ++ch) {
            LAS float* cur = ST + (ch & 1) * 4096; LAS float* nxt = ST + ((ch + 1) & 1) * 4096;
            float* Q = PQ + ((size_t)((bh * RCH + ch) * 2)) * 4096;
            *(LAS f32x4*)(PL + tid * 8) = pa; *(LAS f32x4*)(PL + tid * 8 + 4) = pb;
            float acc[8] = {q0.x, q0.y, q0.z, q0.w, q1.x, q1.y, q1.z, q1.w};
            __syncthreads();
            const int cn = ch + 1 < RCH - 1 ? ch + 1 : ch; const float* nb = PQ + ((size_t)((bh * RCH + cn) * 2)) * 4096;
            pa = *(const f32x4*)(nb + 4096 + tid * 8); pb = *(const f32x4*)(nb + 4096 + tid * 8 + 4);
            q0 = *(const f32x4*)(nb + lane * 64 + 8 * wave); q1 = *(const f32x4*)(nb + lane * 64 + 8 * wave + 4);
#pragma unroll 8
            for (int j = 0; j < 64; ++j) { const float sj = cur[j * 64 + lane]; const f32x4 p0 = *(const LAS f32x4*)(PL + j * 64 + 8 * wave), p1 = *(const LAS f32x4*)(PL + j * 64 + 8 * wave + 4);
                acc[0] = fmaf(sj, p0.x, acc[0]); acc[1] = fmaf(sj, p0.y, acc[1]); acc[2] = fmaf(sj, p0.z, acc[2]); acc[3] = fmaf(sj, p0.w, acc[3]);
                acc[4] = fmaf(sj, p1.x, acc[4]); acc[5] = fmaf(sj, p1.y, acc[5]); acc[6] = fmaf(sj, p1.z, acc[6]); acc[7] = fmaf(sj, p1.w, acc[7]); }
            *(f32x4*)(Q + lane * 64 + 8 * wave) = (f32x4){acc[0], acc[1], acc[2], acc[3]}; *(f32x4*)(Q + lane * 64 + 8 * wave + 4) = (f32x4){acc[4], acc[5], acc[6], acc[7]};
#pragma unroll
            for (int kk = 0; kk < 8; ++kk) nxt[(8 * wave + kk) * 64 + lane] = acc[kk];
            __syncthreads();
        }
    }
}

constexpr size_t WS_X1F8 = 165 * MiB;
constexpr float X1F8_S = 16.0f;
__device__ __forceinline__ void p8_ln1(const Ctx& C) {
    const bf16_t* pre = (const bf16_t*)(C.dout + 32 * MiB); bf16_t* x1b = (bf16_t*)(C.ws + WS_X1B); unsigned char* x1f8 = C.ws + WS_X1F8; const int lane = C.lane;
    const float* gam = C.in[26]; const float* bet = C.in[27];
    for (int t = C.gw; t < T; t += C.ngw) {
        const bf16_t* p = pre + (size_t)t * 1024 + 16 * lane; float v[16];
        unpack8(*(const u32x4*)p, v); unpack8(*(const u32x4*)(p + 8), v + 8);
        float s = 0.f;
#pragma unroll
        for (int j = 0; j < 16; ++j) s += v[j];
        const float mean = wave_sum(s) * (1.0f / 1024.0f); float s2 = 0.f;
#pragma unroll
        for (int j = 0; j < 16; ++j) { v[j] -= mean; s2 += v[j] * v[j]; }
        const float rstd = rsqrtf(wave_sum(s2) * (1.0f / 1024.0f) + 1e-5f);
        float o[16];
#pragma unroll
        for (int q = 0; q < 4; ++q) { const f32x4 gm = *(const f32x4*)(gam + 16 * lane + 4 * q), bt = *(const f32x4*)(bet + 16 * lane + 4 * q);
            o[4 * q] = v[4 * q] * rstd * gm.x + bt.x; o[4 * q + 1] = v[4 * q + 1] * rstd * gm.y + bt.y; o[4 * q + 2] = v[4 * q + 2] * rstd * gm.z + bt.z; o[4 * q + 3] = v[4 * q + 3] * rstd * gm.w + bt.w; }
        *(u32x4*)(x1b + (size_t)t * 1024 + 16 * lane) = pack8(o); *(u32x4*)(x1b + (size_t)t * 1024 + 16 * lane + 8) = pack8(o + 8);
        unsigned wh[4], wl[4];
#pragma unroll
        for (int q = 0; q < 4; ++q) { const float a0 = __builtin_amdgcn_fmed3f(o[4 * q] * X1F8_S, -448.f, 448.f), a1 = __builtin_amdgcn_fmed3f(o[4 * q + 1] * X1F8_S, -448.f, 448.f), a2 = __builtin_amdgcn_fmed3f(o[4 * q + 2] * X1F8_S, -448.f, 448.f), a3 = __builtin_amdgcn_fmed3f(o[4 * q + 3] * X1F8_S, -448.f, 448.f);
            int h = 0; h = __builtin_amdgcn_cvt_pk_fp8_f32(a0, a1, h, false); h = __builtin_amdgcn_cvt_pk_fp8_f32(a2, a3, h, true);
            const f32x2 b01 = __builtin_amdgcn_cvt_pk_f32_fp8(h, false), b23 = __builtin_amdgcn_cvt_pk_f32_fp8(h, true);
            int l = 0; l = __builtin_amdgcn_cvt_pk_fp8_f32((a0 - b01.x) * X1F8_S, (a1 - b01.y) * X1F8_S, l, false); l = __builtin_amdgcn_cvt_pk_fp8_f32((a2 - b23.x) * X1F8_S, (a3 - b23.y) * X1F8_S, l, true);
            wh[q] = (unsigned)h; wl[q] = (unsigned)l; }
        *(u32x4*)(x1f8 + (size_t)t * 2048 + 16 * lane) = (u32x4){wh[0], wh[1], wh[2], wh[3]}; *(u32x4*)(x1f8 + (size_t)t * 2048 + 1024 + 16 * lane) = (u32x4){wl[0], wl[1], wl[2], wl[3]};
    }
    {
        typedef const __attribute__((address_space(1))) f32x4* g4p; gfp v = G_(C.in[31]); unsigned char* dst = C.ws + WS_VB;
        for (int i = C.gt; i < 2048 * 128; i += C.ngt) { const int ds = i & 127, r0 = (i >> 7) * 8; unsigned w[16];
#pragma unroll
            for (int r = 0; r < 8; ++r) { gfp p = v + (size_t)(r0 + r) * 1024 + 8 * ds; const f32x4 a = *(g4p)p * PEER_V_SCALE, b = *(g4p)(p + 4) * PEER_V_SCALE;
                int t0 = 0; t0 = __builtin_amdgcn_cvt_pk_fp8_f32(a.x, a.y, t0, false); t0 = __builtin_amdgcn_cvt_pk_fp8_f32(a.z, a.w, t0, true);
                int t1 = 0; t1 = __builtin_amdgcn_cvt_pk_fp8_f32(b.x, b.y, t1, false); t1 = __builtin_amdgcn_cvt_pk_fp8_f32(b.z, b.w, t1, true); w[2 * r] = (unsigned)t0; w[2 * r + 1] = (unsigned)t1; }
            unsigned char* d = dst + (size_t)ds * 131072 + (size_t)r0 * 8;
#pragma unroll
            for (int q = 0; q < 4; ++q) *(u32x4*)(d + 16 * q) = (u32x4){w[4 * q], w[4 * q + 1], w[4 * q + 2], w[4 * q + 3]}; }
    }
}

#define CE_DESC(a, b) do { const unsigned hi_ = k[a] > k[b] ? k[a] : k[b], lo_ = k[a] > k[b] ? k[b] : k[a]; k[a] = hi_; k[b] = lo_; } while (0)
__device__ __forceinline__ unsigned pop16_of8(unsigned (&k)[8], int fr) {
    CE_DESC(0, 1); CE_DESC(2, 3); CE_DESC(4, 5); CE_DESC(6, 7); CE_DESC(0, 2); CE_DESC(1, 3); CE_DESC(4, 6); CE_DESC(5, 7); CE_DESC(1, 2); CE_DESC(5, 6);
    CE_DESC(0, 4); CE_DESC(1, 5); CE_DESC(2, 6); CE_DESC(3, 7); CE_DESC(2, 4); CE_DESC(3, 5); CE_DESC(1, 2); CE_DESC(3, 4); CE_DESC(5, 6);
    unsigned res = 0u;
#pragma unroll
    for (int rd = 0; rd < 16; ++rd) {
        const unsigned m = row_max_u(k[0]); const bool mine = (k[0] == m);
#pragma unroll
        for (int j = 0; j < 7; ++j) k[j] = mine ? k[j + 1] : k[j];
        k[7] = mine ? 0u : k[7];
        res = (fr == rd) ? m : res;
    }
    return res;
}
__device__ __forceinline__ unsigned pop16_of4(unsigned (&k)[4], int fr) {
    CE_DESC(0, 1); CE_DESC(2, 3); CE_DESC(0, 2); CE_DESC(1, 3); CE_DESC(1, 2);
    unsigned res = 0u;
#pragma unroll
    for (int rd = 0; rd < 16; ++rd) {
        const unsigned m = row_max_u(k[0]); const bool mine = (k[0] == m);
        k[0] = mine ? k[1] : k[0]; k[1] = mine ? k[2] : k[1]; k[2] = mine ? k[3] : k[2]; k[3] = mine ? 0u : k[3];
        res = (fr == rd) ? m : res;
    }
    return res;
}
__device__ const unsigned char CAND_AB[64] = {
    0x00, 0x01, 0x02, 0x03, 0x04, 0x05, 0x06, 0x07, 0x08, 0x09, 0x0a, 0x0b, 0x0c, 0x0d, 0x0e, 0x0f,
    0x10, 0x11, 0x12, 0x13, 0x14, 0x15, 0x16, 0x17, 0x20, 0x21, 0x22, 0x23, 0x24, 0x30, 0x31, 0x32,
    0x33, 0x40, 0x41, 0x42, 0x50, 0x51, 0x60, 0x61, 0x70, 0x71, 0x80, 0x90, 0xa0, 0xb0, 0xc0, 0xd0,
    0xe0, 0xf0, 0xff, 0xff, 0xff, 0xff, 0xff, 0xff, 0xff, 0xff, 0xff, 0xff, 0xff, 0xff, 0xff, 0xff};
__device__ __forceinline__ void p10_peer_route(const Ctx& C) {
    unsigned char* ws = C.ws; const int lane = C.lane, g = lane >> 4, fr = lane & 15;
    const bf16_t* qp = (const bf16_t*)C.dout; const bf16_t* keys = (const bf16_t*)(ws + WS_KEYS);
    int* experts = (int*)(ws + WS_EXPERTS); float* pgates = (float*)(ws + WS_PGATES);
    const unsigned cand4 = *(const unsigned*)(CAND_AB + 4 * fr);
    LAS unsigned char* KL = C.lds;
#pragma unroll
    for (int pp = 0; pp < 8; ++pp) { const int p = C.wave + 8 * pp; const int row = 4 * p + g; const int c = fr ^ (2 * (row & 7));
        __builtin_amdgcn_global_load_lds((const unsigned*)((const char*)keys + row * 256 + 16 * c), (LAS unsigned*)(KL + 1024 * p), 16, 0, 0); }
    asm volatile("s_waitcnt vmcnt(0)" ::: "memory");
    __syncthreads();
    for (int task = C.gw; task < T / 2; task += C.ngw) {
        const int t0 = task * 2;
        unsigned sel[2][4];
#pragma unroll
        for (int p = 0; p < 2; ++p) {
            bf16x8 A[4];
#pragma unroll
            for (int kk = 0; kk < 4; ++kk) A[kk] = *(const bf16x8*)(qp + (size_t)(t0 + (fr >> 3)) * 2048 + (fr & 7) * 256 + p * 128 + 32 * kk + 8 * g);
            f32x4 acc[8];
#pragma unroll
            for (int i = 0; i < 8; ++i) { if ((i & 1) == 0) __builtin_amdgcn_sched_barrier(0); acc[i] = (f32x4){0.f, 0.f, 0.f, 0.f};
#pragma unroll
                for (int kk = 0; kk < 4; ++kk) { const int row = p * 128 + 16 * i + fr; const bf16x8 Bk = *(const LAS bf16x8*)(KL + row * 256 + 16 * ((4 * kk + g) ^ (2 * (row & 7))));
                    acc[i] = __builtin_amdgcn_mfma_f32_16x16x32_bf16(A[kk], Bk, acc[i], 0, 0, 0); } }
#pragma unroll
            for (int r = 0; r < 4; ++r) { __builtin_amdgcn_sched_barrier(0); unsigned k[8];
#pragma unroll
                for (int i = 0; i < 8; ++i) k[i] = (f2key(acc[i][r]) & 0xffffff80u) | (unsigned)(16 * i + fr);
                sel[p][r] = pop16_of8(k, fr); }
        }
#pragma unroll
        for (int r = 0; r < 4; ++r) {
            __builtin_amdgcn_sched_barrier(0);
            const float s1 = key2f(sel[0][r] & 0xffffff80u), s2 = key2f(sel[1][r] & 0xffffff80u);
            unsigned k[4];
#pragma unroll
            for (int j = 0; j < 4; ++j) {
                const unsigned ab = (cand4 >> (8 * j)) & 0xffu; const unsigned msk = ab == 0xffu ? 0u : 0xffffffffu;
                const float va = __builtin_bit_cast(float, __builtin_amdgcn_ds_bpermute((int)(4u * (16u * g + (ab >> 4))), __builtin_bit_cast(int, s1)));
                const float vb = __builtin_bit_cast(float, __builtin_amdgcn_ds_bpermute((int)(4u * (16u * g + (ab & 15u))), __builtin_bit_cast(int, s2)));
                k[j] = ((f2key(va + vb) & 0xffffff00u) | ab) & msk;
            }
            const unsigned top = pop16_of4(k, fr);
            const int a = (int)((top >> 4) & 15u), b = (int)(top & 15u);
            const int i1 = __builtin_amdgcn_ds_bpermute(4 * (16 * g + a), (int)(sel[0][r] & 0x7fu));
            const int i2 = __builtin_amdgcn_ds_bpermute(4 * (16 * g + b), (int)(sel[1][r] & 0x7fu));
            const float sc = key2f(top & 0xffffff00u);
            const float mx = key2f(row_max_u(top) & 0xffffff00u);
            const float ev = __expf(sc - mx); const float sm = row_sum_f(ev);
            const int row = 4 * g + r; const size_t o = (size_t)(t0 + (row >> 3)) * 128 + (row & 7) * 16 + fr;
            experts[o] = i1 * 128 + i2; pgates[o] = ev / sm;
        }
    }
}
#undef CE_DESC

__device__ __forceinline__ float gelu_erf(float x) { return 0.5f * x * (1.0f + erff(x * 0.7071067811865476f)); }
typedef __bf16 bf2_t __attribute__((ext_vector_type(2)));
__device__ __forceinline__ unsigned fp8x2_to_bf16x2(unsigned w, bool hi) { return hi ? __builtin_bit_cast(unsigned, __builtin_amdgcn_cvt_scalef32_pk_bf16_fp8(w, 1.0f, true)) : __builtin_bit_cast(unsigned, __builtin_amdgcn_cvt_scalef32_pk_bf16_fp8(w, 1.0f, false)); }
constexpr size_t WS_EC = 101 * MiB + 8 * MiB;
constexpr size_t WS_Y2 = 61 * MiB;
constexpr size_t WS_STAT = 125 * MiB;
constexpr int CW_PV = 512;
typedef _Float16 f16x2_t __attribute__((ext_vector_type(2)));
__device__ __forceinline__ unsigned h2splat(float v) { const _Float16 h = (_Float16)v; return __builtin_bit_cast(unsigned, (f16x2_t){h, h}); }
typedef int i32x8 __attribute__((ext_vector_type(8)));
constexpr int PU_NT = 4;
constexpr int CW_PU = 1536;
struct PuRows { u32x4 b[16]; u32x4 a0, a1; };
__device__ __forceinline__ void pu_load(PuRows& R, LAS const unsigned char* el, const unsigned char* ubx, const unsigned char* ap, bool arow) {
#pragma unroll
    for (int j = 0; j < 16; ++j) { const unsigned e = *(LAS const unsigned*)(el + 32 * j); R.b[j] = *(const u32x4*)(ubx + (size_t)e * 128); }
    R.a0 = (u32x4){0u, 0u, 0u, 0u}; R.a1 = (u32x4){0u, 0u, 0u, 0u};
    if (arow) { R.a0 = *(const u32x4*)ap; R.a1 = *(const u32x4*)(ap + 16); }
}
__device__ __forceinline__ void pu_compute(const PuRows& R, LAS unsigned char* wr, LAS const unsigned char* rd, float* pp, int lane) {
    const i32x8 A = (i32x8){(int)R.a0.x, (int)R.a0.y, (int)R.a0.z, (int)R.a0.w, (int)R.a1.x, (int)R.a1.y, (int)R.a1.z, (int)R.a1.w};
    float v[8];
#pragma unroll
    for (int tp = 0; tp < 4; ++tp) {
#pragma unroll
        for (int jj = 0; jj < 4; ++jj) *(LAS u32x4*)(wr + 1152 * jj) = R.b[4 * tp + jj];
#pragma unroll
        for (int u = 0; u < 2; ++u) { const u32x4 b0 = *(LAS const u32x4*)(rd + 2304 * u), b1 = *(LAS const u32x4*)(rd + 2304 * u + 16);
            const i32x8 B = (i32x8){(int)b0.x, (int)b0.y, (int)b0.z, (int)b0.w, (int)b1.x, (int)b1.y, (int)b1.z, (int)b1.w};
            const f32x4 acc = __builtin_amdgcn_mfma_scale_f32_16x16x128_f8f6f4(A, B, (f32x4){0.f, 0.f, 0.f, 0.f}, 0, 0, 0, 0, 0, 0);
            v[2 * tp + u] = fmaf(acc[1], 1.0f / X1F8_S, acc[0]); }
    }
    if (lane < 16) { *(f32x4*)pp = (f32x4){v[0], v[1], v[2], v[3]}; *(f32x4*)(pp + 4) = (f32x4){v[4], v[5], v[6], v[7]}; }
}
__device__ __forceinline__ void p11_peer_u(const Ctx& C, int rep_) {
    unsigned char* ws = C.ws; const int lane = C.lane, n = lane & 15, g = lane >> 4, rg = lane >> 3, ck = lane & 7;
    const unsigned char* ub = ws + WS_UB; const unsigned char* x1f8 = ws + WS_X1F8; const unsigned char* experts = ws + WS_EXPERTS;
    float* part = (float*)C.dout; unsigned* qv = (unsigned*)(ws + WS_CTL) + CW_PU + 32 * rep_;
    LAS unsigned char* my = C.lds + C.wave * 8192;
    LAS unsigned char* wr = my + 2048 + 144 * rg + 16 * ck; LAS const unsigned char* rd = my + 2048 + 144 * n + 32 * g;
    const bool arow = n < 2; const int x0 = (int)(xb_xcc_id() & 7u);
    for (int xo = 0; xo < 8; ++xo) {
        const int x = (x0 + xo) & 7;
        if (xo) { unsigned hd = 0; if (lane == 0) hd = __hip_atomic_load(qv + 64 * x, __ATOMIC_RELAXED, __HIP_MEMORY_SCOPE_AGENT); if ((int)__builtin_amdgcn_readfirstlane(hd) >= T) continue; }
        const unsigned char* ubx = ub + ((size_t)x << 21) + 16 * ck; const unsigned char* apx = x1f8 + (arow ? 1024 * n : 0) + 128 * x + 32 * g;
        float* ppx = part + (size_t)x * 128 + 8 * n;
        int tc, tn;
        { int a = 0; if (lane == 0) a = (int)__hip_atomic_fetch_add(qv + 64 * x, (unsigned)(2 * PU_NT), __ATOMIC_RELAXED, __HIP_MEMORY_SCOPE_AGENT); tc = __builtin_amdgcn_readfirstlane(a); tn = tc + PU_NT; }
        u32x4 s0, s1;
        if (tc < T) { s0 = *(const u32x4*)(experts + (size_t)tc * 512 + 16 * lane); s1 = *(const u32x4*)(experts + (size_t)tc * 512 + 1024 + 16 * lane); }
        while (tc < T) {
            *(LAS u32x4*)(my + 16 * lane) = s0; *(LAS u32x4*)(my + 1024 + 16 * lane) = s1;
            int a = 0; if (lane == 0) a = (int)__hip_atomic_fetch_add(qv + 64 * x, (unsigned)PU_NT, __ATOMIC_RELAXED, __HIP_MEMORY_SCOPE_AGENT);
            { const int tl = tn < T ? tn : T - PU_NT; s0 = *(const u32x4*)(experts + (size_t)tl * 512 + 16 * lane); s1 = *(const u32x4*)(experts + (size_t)tl * 512 + 1024 + 16 * lane); }
            PuRows Ra, Rb;
            pu_load(Ra, my + 4 * rg, ubx, apx + (size_t)tc * 2048, arow);
            __builtin_amdgcn_sched_barrier(0);
#pragma unroll
            for (int tt = 0; tt < PU_NT; tt += 2) {
                pu_load(Rb, my + 512 * (tt + 1) + 4 * rg, ubx, apx + (size_t)(tc + tt + 1) * 2048, arow);
                __builtin_amdgcn_sched_barrier(0);
                pu_compute(Ra, wr, rd, ppx + (size_t)(tc + tt) * 1024, lane);
                __builtin_amdgcn_sched_barrier(0);
                if (tt + 2 < PU_NT) pu_load(Ra, my + 512 * (tt + 2) + 4 * rg, ubx, apx + (size_t)(tc + tt + 2) * 2048, arow);
                __builtin_amdgcn_sched_barrier(0);
                pu_compute(Rb, wr, rd, ppx + (size_t)(tc + tt + 1) * 1024, lane);
                __builtin_amdgcn_sched_barrier(0);
            }
            tc = tn; tn = __builtin_amdgcn_readfirstlane(a);
        }
    }
}
__device__ __forceinline__ void p11_peer_combine(const Ctx& C) {
    unsigned char* ws = C.ws; const int lane = C.lane, wave = C.wave, tid = (int)threadIdx.x; const float* part = (const float*)C.dout;
    const int* experts = (const int*)(ws + WS_EXPERTS); const float* pgates = (const float*)(ws + WS_PGATES); unsigned char* ect = ws + WS_EC;
    const int p0 = 2 * lane, k0 = 16 * (p0 & 7) + (p0 >> 3), k1 = k0 + 16;
    constexpr float us = 1.0f / (PEER_U_SCALE * X1F8_S), vs = 64.0f / PEER_V_SCALE;
    LAS unsigned* tile = (LAS unsigned*)C.lds;
    for (int tg = (int)blockIdx.x; tg < T / 32; tg += C.G) {
#pragma unroll
        for (int j = 0; j < 4; ++j) {
            const int ti = 4 * wave + j, t = 32 * tg + ti;
            f32x2 s = (f32x2){0.f, 0.f};
#pragma unroll
            for (int x = 0; x < 8; ++x) s += *(const f32x2*)(part + ((size_t)t * 8 + x) * 128 + p0);
            const int e0 = experts[(size_t)t * 128 + k0], e1 = experts[(size_t)t * 128 + k1]; const float g0 = pgates[(size_t)t * 128 + k0], g1 = pgates[(size_t)t * 128 + k1];
            const unsigned c0 = (unsigned)__builtin_bit_cast(unsigned short, (_Float16)(vs * g0 * gelu_erf(s.x * us))), c1 = (unsigned)__builtin_bit_cast(unsigned short, (_Float16)(vs * g1 * gelu_erf(s.y * us)));
            tile[p0 * 33 + ti] = ((unsigned)e0 << 16) | c0; tile[(p0 + 1) * 33 + ti] = ((unsigned)e1 << 16) | c1;
        }
        __syncthreads();
        { const int p = tid >> 2, q = tid & 3; unsigned w[8];
#pragma unroll
          for (int j = 0; j < 8; ++j) w[j] = tile[p * 33 + 8 * q + j];
          unsigned char* dst = ect + (size_t)tg * 16384 + p * 128 + q * 32;
          *(u32x4*)dst = (u32x4){w[0], w[1], w[2], w[3]}; *(u32x4*)(dst + 16) = (u32x4){w[4], w[5], w[6], w[7]}; }
        __syncthreads();
    }
}
__device__ __forceinline__ void p11_peer_v(const Ctx& C, int rep_) {
    (void)rep_;
    unsigned char* ws = C.ws; const int lane = C.lane, wave = C.wave, tid = (int)threadIdx.x;
    const bf16_t* x1b = (const bf16_t*)(ws + WS_X1B); const unsigned char* vb8 = ws + WS_VB; const unsigned* ect = (const unsigned*)(ws + WS_EC); bf16_t* y2 = (bf16_t*)(ws + WS_Y2);
    const int nrep = C.G >= 128 ? C.G / 128 : 1, tper = T / nrep;
    LAS unsigned char* tab = C.lds;
    for (int u = (int)blockIdx.x; u < 128 * nrep; u += C.G) {
        const int ds = ((u & 7) << 4) | ((u >> 3) & 15), rep = u >> 7;
        {
            const unsigned char* src = vb8 + (size_t)ds * 131072 + 16 * tid;
#pragma unroll
            for (int i = 0; i < 16; ++i) *(LAS u32x4*)(tab + 8192 * i + 16 * tid) = *(const u32x4*)(src + 8192 * i);
        }
        __syncthreads();
        const int tbeg = rep * tper, ntb = tper / 64;
        for (int tbi = wave; tbi < ntb; tbi += NWAVES) {
            const int t = tbeg + 64 * tbi + lane;
            const u32x4 xr = *(const u32x4*)(x1b + (size_t)t * 1024 + 8 * ds);
            const unsigned* ep = ect + (size_t)(t >> 5) * 4096 + (t & 31);
            float acc[8];
#pragma unroll
            for (int j = 0; j < 8; ++j) acc[j] = 0.f;
#pragma unroll 1
            for (int kk = 0; kk < 128; kk += 32) {
                unsigned w[32];
#pragma unroll
                for (int k = 0; k < 32; ++k) w[k] = ep[(kk + k) * 32];
                f16x2_t h[4];
#pragma unroll
                for (int j = 0; j < 4; ++j) h[j] = (f16x2_t){(_Float16)0.f, (_Float16)0.f};
#pragma unroll
                for (int k = 0; k < 32; ++k) {
                    const u32x2 v = *(LAS const u32x2*)(tab + ((w[k] >> 13) & 0x7fff8u));
                    const _Float16 c = __builtin_bit_cast(_Float16, (unsigned short)(w[k] & 0xffffu)); const f16x2_t cc = (f16x2_t){c, c};
                    const f16x2_t v0 = __builtin_amdgcn_cvt_scalef32_pk_f16_fp8(v.x, 1.0f, false), v1 = __builtin_amdgcn_cvt_scalef32_pk_f16_fp8(v.x, 1.0f, true), v2 = __builtin_amdgcn_cvt_scalef32_pk_f16_fp8(v.y, 1.0f, false), v3 = __builtin_amdgcn_cvt_scalef32_pk_f16_fp8(v.y, 1.0f, true);
                    h[0] = __builtin_elementwise_fma(cc, v0, h[0]); h[1] = __builtin_elementwise_fma(cc, v1, h[1]); h[2] = __builtin_elementwise_fma(cc, v2, h[2]); h[3] = __builtin_elementwise_fma(cc, v3, h[3]);
                }
#pragma unroll
                for (int j = 0; j < 4; ++j) { acc[2 * j] += (float)h[j].x; acc[2 * j + 1] += (float)h[j].y; }
            }
            float xf[8]; unpack8(xr, xf);
#pragma unroll
            for (int j = 0; j < 8; ++j) acc[j] = fmaf(acc[j], 1.0f / 64.0f, ALPHA * xf[j]);
            *(u32x4*)(y2 + (size_t)t * 1024 + 8 * ds) = pack8(acc);
        }
        __syncthreads();
    }
}
__device__ __forceinline__ void p11_peer_ln2(const Ctx& C) {
    unsigned char* ws = C.ws; const int lane = C.lane; const bf16_t* y2 = (const bf16_t*)(ws + WS_Y2);
    float* out = (float*)C.dout; const float* gam = C.in[32]; const float* bet = C.in[33];
    for (int t = C.gw; t < T; t += C.ngw) {
        float o[16]; const bf16_t* yp = y2 + (size_t)t * 1024 + 16 * lane; unpack8(*(const u32x4*)yp, o); unpack8(*(const u32x4*)(yp + 8), o + 8);
        float s1 = 0.f;
#pragma unroll
        for (int j = 0; j < 16; ++j) s1 += o[j];
        const float mean = wave_sum(s1) * (1.0f / 1024.0f); float s2 = 0.f;
#pragma unroll
        for (int j = 0; j < 16; ++j) { o[j] -= mean; s2 += o[j] * o[j]; }
        const float rstd = rsqrtf(wave_sum(s2) * (1.0f / 1024.0f) + 1e-5f);
#pragma unroll
        for (int q = 0; q < 4; ++q) { const int c0 = 16 * lane + 4 * q; const f32x4 gm = *(const f32x4*)(gam + c0), bt = *(const f32x4*)(bet + c0);
            *(f32x4*)(out + (size_t)t * 1024 + c0) = (f32x4){o[4 * q] * rstd * gm.x + bt.x, o[4 * q + 1] * rstd * gm.y + bt.y, o[4 * q + 2] * rstd * gm.z + bt.z, o[4 * q + 3] * rstd * gm.w + bt.w}; }
    }
}

constexpr int LDS_BYTES = 147456;
constexpr int LDS_MISC = 131072 + 256;
constexpr int NPHASE = 17;
constexpr int CW_BAR = 4096;

__global__ void __launch_bounds__(NTHREADS, 2) hybrid_fwd(Args args) {
    extern __shared__ __attribute__((aligned(16))) unsigned char lds_raw[];
    Ctx C;
    C.lds = (LAS unsigned char*)lds_raw;
    C.tid = threadIdx.x; C.lane = C.tid & 63; C.wave = __builtin_amdgcn_readfirstlane(C.tid >> 6);
    C.G = gridDim.x; C.gw = blockIdx.x * NWAVES + C.wave; C.ngw = C.G * NWAVES; C.gt = blockIdx.x * NTHREADS + C.tid; C.ngt = C.G * NTHREADS;
    C.in = args.in; C.ws = args.ws; C.dout = (unsigned char*)args.out;
    unsigned char* ws = args.ws; const float* const* in = args.in;
    volatile LAS unsigned* MISC = (volatile LAS unsigned*)(C.lds + LDS_MISC);
    if (C.tid < 64) MISC[C.tid] = 0u;
    __syncthreads();
    XcdBarrier bar; bar.bar = (unsigned*)(ws + WS_CTL) + CW_BAR; bar.x = 0; bar.st = nullptr;
    if (MK_N_LAUNCHES == 1) bar = xcd_barrier_post((unsigned*)(ws + WS_CTL) + CW_BAR, MISC + 8);
    const int lo = args.ph_lo, hi = args.ph_hi;
#define IN(k) (lo <= (k) && (k) < hi)
#define SEAM(k) do { if (IN(k) && IN((k) + 1)) xcd_barrier(bar); } while (0)
#define REP(k) for (int rep_ = 0; rep_ < (((PROBE_MASK >> (k)) & 1) ? 2 : 1); ++rep_)
    bf16_t* xb = (bf16_t*)(C.dout + DO_XB);

    if (IN(0)) REP(0) { p0_prologue(C); } SEAM(0);
    if (IN(1)) REP(1) {
        { pg8::Gemm gm{xb, (const bf16_t*)(ws + WS_WIN), T, 2816, 1024}; pg8::StaticOrder S; S.init(T, 2816, C.G, (int)blockIdx.x);
          EpiP1 E{(float*)(ws + WS_CSMALL), (bf16_t*)(ws + WS_RCOLS), (bf16_t*)(ws + WS_MEMQ)}; pg8::gemm_phase(C.lds, gm, S, E); }
        {
          const int nfull = (T / 256) * 11 % C.G; const int c2 = ((int)blockIdx.x - nfull + C.G) % C.G;
          pg8::Gemm gm{(const bf16_t*)(ws + WS_MEMB), (const bf16_t*)(ws + WS_WMEMKV), 1024, 1024, 1024}; pg8::StaticOrder S; S.init(1024, 1024, C.G, c2);
          EpiMemKV E{(bf16_t*)(ws + WS_KMEM), (bf16_t*)(ws + WS_VMEMT)}; pg8::gemm_phase(C.lds, gm, S, E); }
    } SEAM(1);
    if (IN(2)) REP(2) { p2_prep(C); } SEAM(2);
    if (IN(3)) REP(3) {
        { pg8::Gemm gm{(const bf16_t*)(ws + WS_LORAA), (const bf16_t*)(ws + WS_WLORA), T, 1536, 256}; pg8::StaticOrder S; S.init(T, 1536, C.G, (int)blockIdx.x);
          EpiLora E{(bf16_t*)(ws + WS_RW_E), (bf16_t*)(ws + WS_RW_A), (bf16_t*)(ws + WS_RW_G), in[11], in[13]}; pg8::gemm_phase(C.lds, gm, S, E); }
        { pg8::Gemm gm{(const bf16_t*)(ws + WS_CQN), (const bf16_t*)(ws + WS_WQ), T, 1280, 256}; pg8::StaticOrder S; S.init(T, 1280, C.G, C.G - 1 - (int)blockIdx.x);
          EpiQ E{(bf16_t*)(ws + WS_QLAT), (bf16_t*)(ws + WS_QIDX)}; pg8::gemm_phase(C.lds, gm, S, E); }
    } SEAM(3);
    if (IN(4)) { REP(17) { p4_indexer(C); } REP(18) { p4_memattn(C); } __syncthreads(); REP(19) { p4_rwkv_pass1(C); } } SEAM(4);
    if (IN(5)) { p5_rwkv_carry(C); __syncthreads(); REP(5) { p5_dsa_attn(C, rep_); } } SEAM(5);
    if (IN(6)) REP(6) { p6_rwkv_pass3(C); p6_late_weights(C); } SEAM(6);
    if (IN(7)) REP(7) {
        pg8::Gemm gm{xb, (const bf16_t*)(ws + WS_WG), T, 3072, 1024}; pg8::StaticOrder S; S.init(T, 3072, C.G, (int)blockIdx.x);
        EpiGates E{(bf16_t*)(ws + WS_GATES)}; pg8::gemm_phase(C.lds, gm, S, E);
    } SEAM(7);
    if (IN(8)) REP(8) {
        pg8::GemmM gm{(const bf16_t*)(ws + WS_OLAT), (const bf16_t*)(ws + WS_YM), (const bf16_t*)(ws + WS_WOV), T, 1024}; pg8::StaticOrder S; S.init(T, 1024, C.G, (int)blockIdx.x);
        MergeHook H{(const bf16_t*)(ws + WS_GATES), (bf16_t*)C.dout}; pg8::gemm_phase_merge(C.lds, gm, S, H);
    } SEAM(8);
    if (IN(9)) REP(9) {
        pg8::Gemm gm{(const bf16_t*)C.dout, (const bf16_t*)(ws + WS_WOUT), T, 1024, 1024}; pg8::StaticOrder S; S.init(T, 1024, C.G, (int)blockIdx.x);
        EpiWout E{G_(in[0]), (bf16_t*)(C.dout + 32 * MiB)}; pg8::gemm_phase(C.lds, gm, S, E);
    } SEAM(9);
    if (IN(10)) REP(10) { p8_ln1(C); } SEAM(10);
    if (IN(11)) REP(11) {
        pg8::Gemm gm{(const bf16_t*)(ws + WS_X1B), (const bf16_t*)(ws + WS_WPEER), T, 2048, 1024}; pg8::StaticOrder S; S.init(T, 2048, C.G, (int)blockIdx.x);
        EpiPeerQ E{(bf16_t*)C.dout}; pg8::gemm_phase(C.lds, gm, S, E);
    } SEAM(11);
    if (IN(12)) REP(12) { p10_peer_route(C); } SEAM(12);
    if (IN(13)) REP(13) { p11_peer_u(C, rep_); } SEAM(13);
    if (IN(14)) { p11_peer_combine(C); } SEAM(14);
    if (IN(15)) REP(15) { p11_peer_v(C, rep_); } SEAM(15);
    if (IN(16)) { p11_peer_ln2(C); }
#undef IN
#undef SEAM
}

extern "C" void kernel_launch(void* const* d_in, const int* in_sizes, int n_in, void* d_out, int out_size, void* d_ws, size_t ws_size, hipStream_t stream) {
    static int grid = 0;
    if (grid == 0) {
        if (n_in != 34 || out_size != T * D || ws_size < WS_END) { fprintf(stderr, "kernel_launch: unexpected problem (n_in %d out %d ws %zu)\n", n_in, out_size, ws_size); grid = -1; return; }
        int dev = 0, cus = 0, per_cu = 0;
        if (hipGetDevice(&dev) != hipSuccess || hipDeviceGetAttribute(&cus, hipDeviceAttributeMultiprocessorCount, dev) != hipSuccess) { grid = -1; return; }
        if (hipFuncSetAttribute((const void*)hybrid_fwd, hipFuncAttributeMaxDynamicSharedMemorySize, LDS_BYTES) != hipSuccess) { fprintf(stderr, "kernel_launch: hipFuncSetAttribute failed\n"); grid = -1; return; }
        if (hipOccupancyMaxActiveBlocksPerMultiprocessor(&per_cu, (const void*)hybrid_fwd, NTHREADS, LDS_BYTES) != hipSuccess || per_cu < 1) { fprintf(stderr, "kernel_launch: occupancy query says %d\n", per_cu); }
        (void)hipGetLastError();
        grid = cus;
    }
    if (grid < 0) return;
    (void)hipMemsetAsync((char*)d_ws + WS_CTL, 0, 1 * MiB, stream);
    Args a{};
    for (int i = 0; i < 34; ++i) a.in[i] = (const float*)d_in[i];
    a.out = (float*)d_out; a.ws = (unsigned char*)d_ws; a.li = 0; a.pad = 0;
    if (MK_N_LAUNCHES == 1) { a.ph_lo = 0; a.ph_hi = NPHASE; hipLaunchKernelGGL(hybrid_fwd, dim3(grid), dim3(NTHREADS), LDS_BYTES, stream, a); }
    else for (int p = 0; p < NPHASE; ++p) { a.ph_lo = p; a.ph_hi = p + 1; a.li = p; hipLaunchKernelGGL(hybrid_fwd, dim3(grid), dim3(NTHREADS), LDS_BYTES, stream, a); }
}
```

```cpp
#include <hip/hip_runtime.h>
#include <stdint.h>
#include <stdio.h>

#ifndef MK_N_LAUNCHES
#define MK_N_LAUNCHES 1
#endif

#ifndef PROBE_MASK
#define PROBE_MASK 0
#endif
#define LAS __attribute__((address_space(3)))
typedef unsigned short bf16_t;
typedef const __attribute__((address_space(1))) float* gfp;
#define G_(p) ((gfp)(p))
typedef short bf16x8 __attribute__((ext_vector_type(8)));
typedef float f32x4 __attribute__((ext_vector_type(4)));
typedef float f32x2 __attribute__((ext_vector_type(2)));
typedef unsigned u32x4 __attribute__((ext_vector_type(4)));
typedef unsigned u32x2 __attribute__((ext_vector_type(2)));

constexpr int NB = 4, SEQ = 4096, T = NB * SEQ, D = 1024;
constexpr int IN_W = 5800;
constexpr int RW = 512;
constexpr int NWAVES = 8, NTHREADS = 512;
constexpr float ALPHA = 1.189207115002721f;
constexpr int RCH = 32, RL = SEQ / RCH;

constexpr size_t MiB = 1u << 20;
constexpr size_t WS_CTL = 0;
constexpr size_t WS_WIN = 1 * MiB, WS_WG = 7 * MiB, WS_WLORA = 13 * MiB, WS_WQ = 14 * MiB, WS_WMEMKV = 15 * MiB, WS_WOV = 17 * MiB,
                 WS_WBRR = 19 * MiB, WS_WBRM = 20 * MiB, WS_WOUT = 21 * MiB, WS_WPEER = 23 * MiB, WS_KEYS = 27 * MiB;
constexpr size_t WS_CSMALL = 29 * MiB, WS_QLAT = 29 * MiB, WS_MERGEDB = 29 * MiB, WS_UB = 29 * MiB;
constexpr size_t WS_RCOLS = 61 * MiB, WS_QIDX = 61 * MiB, WS_YM = 69 * MiB, WS_OLAT = 101 * MiB, WS_VB = 45 * MiB, WS_EXPERTS = 93 * MiB, WS_PGATES = 101 * MiB;
constexpr size_t WS_MEMQ = 117 * MiB;
constexpr size_t WS_RW_R = 133 * MiB, WS_RW_K = 149 * MiB, WS_RW_V = 165 * MiB, WS_RW_A = 181 * MiB, WS_RW_E = 197 * MiB, WS_RW_G = 213 * MiB;
constexpr size_t WS_GATES = 133 * MiB, WS_X1B = 133 * MiB, WS_X1 = 165 * MiB;
constexpr size_t WS_CQN = 229 * MiB, WS_KVL = 237 * MiB, WS_KIDX = 241 * MiB, WS_WIDX = 242 * MiB, WS_LORAA = 243 * MiB, WS_IDX = 243 * MiB,
                 WS_KMEM = 251 * MiB, WS_VMEMT = 252 * MiB, WS_MEMB = 253 * MiB, WS_END = 256 * MiB;
constexpr size_t DO_XB = 0, DO_PQ = 32 * MiB;
constexpr size_t WS_XB2 = 29 * MiB;
constexpr int CW_DSAQ = 64;

typedef __bf16 bf2_hw __attribute__((ext_vector_type(2)));
__device__ __forceinline__ unsigned f2bf(float f) { return (unsigned)__builtin_bit_cast(unsigned short, (__bf16)f); }
__device__ __forceinline__ unsigned pk2(float lo, float hi) { bf2_hw r; r.x = (__bf16)lo; r.y = (__bf16)hi; return __builtin_bit_cast(unsigned, r); }
__device__ __forceinline__ float bflo(unsigned w) { return __uint_as_float(w << 16); }
__device__ __forceinline__ float bfhi(unsigned w) { return __uint_as_float(w & 0xffff0000u); }
__device__ __forceinline__ float bf1(bf16_t h) { return __uint_as_float(((unsigned)h) << 16); }
template <int CTRL, int RM = 0xF> __device__ __forceinline__ float dpp_f(float v) { return __builtin_bit_cast(float, __builtin_amdgcn_update_dpp(0, __builtin_bit_cast(int, v), CTRL, RM, 0xF, false)); }
template <int CTRL> __device__ __forceinline__ unsigned dpp_u(unsigned v) { return (unsigned)__builtin_amdgcn_update_dpp(0, (int)v, CTRL, 0xF, 0xF, false); }
__device__ __forceinline__ float wave_sum(float v) {
    v += dpp_f<0x111>(v); v += dpp_f<0x112>(v); v += dpp_f<0x114>(v); v += dpp_f<0x118>(v);
    v += dpp_f<0x142, 0xA>(v); v += dpp_f<0x143, 0xC>(v);
    return __builtin_bit_cast(float, __builtin_amdgcn_readlane(__builtin_bit_cast(int, v), 63));
}
__device__ __forceinline__ unsigned row_max_u(unsigned x) {
    unsigned y = dpp_u<0x128>(x); x = x > y ? x : y; y = dpp_u<0x124>(x); x = x > y ? x : y; y = dpp_u<0x122>(x); x = x > y ? x : y; y = dpp_u<0x121>(x); x = x > y ? x : y; return x; }
__device__ __forceinline__ float row_sum_f(float x) { x += dpp_f<0x128>(x); x += dpp_f<0x124>(x); x += dpp_f<0x122>(x); x += dpp_f<0x121>(x); return x; }
__device__ __forceinline__ float key2f(unsigned k) { const unsigned b = (k & 0x80000000u) ? (k & 0x7fffffffu) : ~k; return __uint_as_float(b); }
__device__ __forceinline__ float sigmoidf_(float x) { return 1.0f / (1.0f + __expf(-x)); }
__device__ __forceinline__ unsigned f2key(float f) { unsigned b = __float_as_uint(f); if (f == 0.0f) b = 0u; return (b & 0x80000000u) ? ~b : (b | 0x80000000u); }
__device__ __forceinline__ u32x4 pack8(const float* v) { u32x4 w; w.x = pk2(v[0], v[1]); w.y = pk2(v[2], v[3]); w.z = pk2(v[4], v[5]); w.w = pk2(v[6], v[7]); return w; }
__device__ __forceinline__ void unpack8(u32x4 w, float* v) { v[0] = bflo(w.x); v[1] = bfhi(w.x); v[2] = bflo(w.y); v[3] = bfhi(w.y); v[4] = bflo(w.z); v[5] = bfhi(w.z); v[6] = bflo(w.w); v[7] = bfhi(w.w); }

#define XB_TMO      128
#define XB_XCNT(j)  (256  + 64 * (j))
#define XB_XSUB(j)  (1280 + 64 * (j))
#define XB_XGEN(j)  (2304 + 64 * (j))
#define XB_TOP      3328
#define XB_TOPGEN   3392
#define XCD_BAR_WORDS 3456
#define XB_SPIN_CAP (1u << 18)

__device__ __forceinline__ unsigned xb_ld(unsigned* p)              { return __hip_atomic_load(p, __ATOMIC_RELAXED, __HIP_MEMORY_SCOPE_AGENT); }
__device__ __forceinline__ unsigned xb_add(unsigned* p, unsigned v) { return __hip_atomic_fetch_add(p, v, __ATOMIC_RELAXED, __HIP_MEMORY_SCOPE_AGENT); }
__device__ __forceinline__ unsigned xb_xcc_id() { return (unsigned)__builtin_amdgcn_s_getreg((3 << 11) | 20) & 0xFu; }
#define XB_SPIN(cond, bar) do { unsigned _sp = 0; while (cond) { __builtin_amdgcn_s_sleep(1); \
    if ((++_sp & 255u) == 0u) { if (xb_ld(&(bar)[XB_TMO])) break; if (_sp > XB_SPIN_CAP) { atomicAdd(&(bar)[XB_TMO], 1u); break; } } } } while (0)

struct XcdBarrier {
    unsigned* bar; unsigned x;
    volatile LAS unsigned* st;
};
__device__ __forceinline__ XcdBarrier xcd_barrier_post(unsigned* bar, volatile LAS unsigned* st) {
    XcdBarrier b; b.bar = bar; b.x = xb_xcc_id(); b.st = st;
    if (threadIdx.x == 0) (void)xb_add(&bar[XB_XCNT(b.x)], 1u);
    return b;
}
__device__ __forceinline__ void xcd_barrier_complete(unsigned* bar, unsigned x, unsigned& nloc, unsigned& nx) {
    const unsigned G = gridDim.x * gridDim.y * gridDim.z;
    unsigned sum, cnt, mine, sp = 0u;
    for (;;) {
        sum = 0u; cnt = 0u; mine = 0u;
#pragma unroll
        for (unsigned j = 0; j < 16; ++j) { const unsigned c = xb_ld(&bar[XB_XCNT(j)]); sum += c; cnt += (c > 0u) ? 1u : 0u; mine = (j == x) ? c : mine; }
        if (sum == G) break;
        __builtin_amdgcn_s_sleep(1);
        if ((++sp & 255u) == 0u) { if (xb_ld(&bar[XB_TMO])) break; if (sp > XB_SPIN_CAP) { atomicAdd(&bar[XB_TMO], 1u); break; } }
    }
    nloc = mine > 0u ? mine : 1u; nx = cnt > 0u ? cnt : 1u;
}
__device__ __forceinline__ void xcd_barrier(const XcdBarrier& b) {
    asm volatile("s_waitcnt vmcnt(0)" ::: "memory");
    __syncthreads();
    if (threadIdx.x == 0) {
        unsigned* bar = b.bar;
        __builtin_amdgcn_s_waitcnt(0);
        unsigned nloc = b.st[0], nx = b.st[1];
        if (nloc == 0u) { xcd_barrier_complete(bar, b.x, nloc, nx); b.st[0] = nloc; b.st[1] = nx; }
        const unsigned old = xb_add(&bar[XB_XSUB(b.x)], 1u);
        const unsigned gen = old / nloc;
        if (old + 1u == (gen + 1u) * nloc) {
            __builtin_amdgcn_fence(__ATOMIC_RELEASE, "agent");
            asm volatile("s_waitcnt vmcnt(0)" ::: "memory");
            const unsigned og = xb_add(&bar[XB_TOP], 1u);
            const unsigned tg = og / nx;
            if (og + 1u == (tg + 1u) * nx) xb_add(&bar[XB_TOPGEN], 1u);
            else XB_SPIN(xb_ld(&bar[XB_TOPGEN]) == tg, bar);
            __builtin_amdgcn_fence(__ATOMIC_ACQUIRE, "agent");
            xb_add(&bar[XB_XGEN(b.x)], 1u);
            asm volatile("s_waitcnt vmcnt(0)" ::: "memory");
        } else {
            XB_SPIN(xb_ld(&bar[XB_XGEN(b.x)]) == gen, bar);
            __builtin_amdgcn_fence(__ATOMIC_ACQUIRE, "agent");
            asm volatile("s_waitcnt vmcnt(0)" ::: "memory");
        }
    }
    __syncthreads();
}

namespace pg8 {
constexpr int BM = 256, BK = 64, HALF = 128, HTB = HALF * BK * 2, STAGE_BYTES = 8 * HTB, NXCD = 8, WGM = 8;
__device__ __forceinline__ int lds_byte(int r, int c) { const int st = (r >> 4) * 2 + (c >> 5), rr = r & 15, cc = c & 31, ob = rr * 64 + cc * 2; return st * 1024 + (ob ^ (((ob >> 9) & 1) << 5)); }
__device__ __forceinline__ void stage_rc(int b, int& R, int& C) { const int st = b / 1024, sb = b % 1024, swz = sb ^ (((sb >> 9) & 1) << 5); R = (st >> 1) * 16 + swz / 64; C = (st & 1) * 32 + (swz % 64) / 2; }
__device__ __forceinline__ int perm32(int rho) { const int n = rho >> 4, i = rho & 15; return 8 * (i >> 2) + 4 * n + (i & 3); }
struct Unit { int pm, pn; };
struct Gemm { const bf16_t* A; const bf16_t* Bt; int M, N, K; };
struct StaticOrder {
    int nM, nN, nwg, G, c;
    __device__ void init(int M, int N, int G_, int c_) { nM = M / BM; nN = N / BM; nwg = nM * nN; G = G_; c = c_; }
    __device__ bool next(int i, Unit& u) const {
        const long L = (long)i * G + c; if (L >= nwg) return false;
        int wgid = (int)L; { const int q = nwg / NXCD, r = nwg % NXCD, xcd = wgid % NXCD, off = wgid / NXCD; wgid = (xcd < r ? xcd * (q + 1) : r * (q + 1) + (xcd - r) * q) + off; }
        const int nig = WGM * nN, gid = wgid / nig, fm = gid * WGM, gsz = (nM - fm) < WGM ? (nM - fm) : WGM;
        u.pm = fm + ((wgid % nig) % gsz); u.pn = (wgid % nig) / gsz; return true;
    }
};
template <class Epi>
__device__ __forceinline__ void gemm_phase(LAS unsigned char* lds, const Gemm g, const StaticOrder& S, const Epi& E) {
    const int tid = threadIdx.x, wid = __builtin_amdgcn_readfirstlane(tid >> 6), lane = tid & 63, wr = wid >> 2, wc = wid & 3, fr = lane & 15, fq = lane >> 4;
    const int K = g.K, nt = K / BK;
    unsigned voffA[2], voffB[2];
#pragma unroll
    for (int i = 0; i < 2; ++i) { int R, C; stage_rc(tid * 16 + i * 8192, R, C); const int Rb = (R & ~31) + perm32(R & 31);
        voffA[i] = (unsigned)(R * K + C) * 2u; voffB[i] = (unsigned)(Rb * K + C) * 2u; }
    const size_t kstep = (size_t)(BK * 2);
    const size_t hstep = (size_t)HALF * K * 2;
    const size_t tstep = 2 * hstep;
    const unsigned ldsw = (unsigned)wid * 1024u;
    const int aoff = lds_byte(wr * 64 + fr, fq * 8), boff = lds_byte(wc * 32 + fr, fq * 8);
#define PG8_SA(b, h) (((b) * 2 + (h)) * HTB)
#define PG8_SB(b, h) ((4 + (b) * 2 + (h)) * HTB)
#define PG8_STAGE(bufoff, gbase, voff) do { _Pragma("unroll") for (int _i = 0; _i < 2; ++_i) \
        __builtin_amdgcn_global_load_lds((const unsigned*)((const char*)(gbase) + (voff)[_i]), (LAS unsigned*)(lds + (bufoff) + ldsw + _i * 8192), 16, 0, 0); } while (0)
#define PG8_LDA(dst, b, h) do { _Pragma("unroll") for (int m = 0; m < 4; ++m) _Pragma("unroll") for (int k = 0; k < 2; ++k) dst[m][k] = *(const LAS bf16x8*)(lds + PG8_SA(b, h) + aoff + m * 2048 + k * 1024); } while (0)
#define PG8_LDB(dst, b, h) do { _Pragma("unroll") for (int n = 0; n < 2; ++n) _Pragma("unroll") for (int k = 0; k < 2; ++k) dst[n][k] = *(const LAS bf16x8*)(lds + PG8_SB(b, h) + boff + n * 2048 + k * 1024); } while (0)
#define PG8_MMA(ai, bj, At, Bt) do { __builtin_amdgcn_s_setprio(1); _Pragma("unroll") for (int m = 0; m < 4; ++m) _Pragma("unroll") for (int n = 0; n < 2; ++n) _Pragma("unroll") for (int k = 0; k < 2; ++k) \
        acc[ai][bj][m][n] = __builtin_amdgcn_mfma_f32_16x16x32_bf16(Bt[n][k], At[m][k], acc[ai][bj][m][n], 0, 0, 0); __builtin_amdgcn_s_setprio(0); } while (0)
#define PG8_WAIT_V(n) asm volatile("s_waitcnt vmcnt(" #n ")" ::: "memory")
#define PG8_WAIT_L(n) asm volatile("s_waitcnt lgkmcnt(" #n ")" ::: "memory")
#define PG8_BAR __builtin_amdgcn_s_barrier()
#define PG8_SCHED __builtin_amdgcn_sched_barrier(0)
    Unit cur, nxt; int ui = 0;
    if (!S.next(0, cur)) return;
    f32x4 acc[2][2][4][2];
#pragma unroll
    for (int a = 0; a < 2; ++a)
#pragma unroll
        for (int b = 0; b < 2; ++b)
#pragma unroll
            for (int m = 0; m < 4; ++m)
#pragma unroll
                for (int n = 0; n < 2; ++n) acc[a][b][m][n] = (f32x4){0.f, 0.f, 0.f, 0.f};
    bf16x8 At[4][2], B0[2][2], B1[2][2];
    const char* cA = (const char*)g.A + (size_t)cur.pm * tstep; const char* cB = (const char*)g.Bt + (size_t)cur.pn * tstep;
    PG8_STAGE(PG8_SB(0, 0), cB, voffB); PG8_STAGE(PG8_SA(0, 0), cA, voffA); PG8_STAGE(PG8_SB(0, 1), cB + hstep, voffB); PG8_STAGE(PG8_SA(0, 1), cA + hstep, voffA);
    if (wr == 1) PG8_BAR;
    PG8_WAIT_V(4); PG8_BAR;
    PG8_STAGE(PG8_SB(1, 0), cB + kstep, voffB); PG8_STAGE(PG8_SA(1, 0), cA + kstep, voffA); PG8_STAGE(PG8_SB(1, 1), cB + hstep + kstep, voffB);
    PG8_WAIT_V(6); PG8_BAR;
    for (;;) {
        const bool has_next = S.next(ui + 1, nxt);
        const char* nA = has_next ? (const char*)g.A + (size_t)nxt.pm * tstep : cA; const char* nB = has_next ? (const char*)g.Bt + (size_t)nxt.pn * tstep : cB;
#pragma unroll 1
        for (int t = 0; t < nt; t += 2) {
            const bool last = (t == nt - 2);
            const char* a1 = cA + (size_t)(t + 1) * kstep;
            const char* a2 = last ? nA : cA + (size_t)(t + 2) * kstep; const char* b2 = last ? nB : cB + (size_t)(t + 2) * kstep;
            const char* a3 = a2 + kstep; const char* b3 = b2 + kstep;
            PG8_LDB(B0, 0, 0); PG8_SCHED; PG8_LDA(At, 0, 0); PG8_STAGE(PG8_SA(1, 1), a1 + hstep, voffA);
            PG8_WAIT_L(8); PG8_BAR; PG8_WAIT_L(0); PG8_MMA(0, 0, At, B0); PG8_BAR; PG8_SCHED;
            PG8_LDB(B1, 0, 1); PG8_STAGE(PG8_SB(0, 0), b2, voffB);
            PG8_BAR; PG8_WAIT_L(0); PG8_MMA(0, 1, At, B1); PG8_BAR;
            PG8_LDA(At, 0, 1); PG8_STAGE(PG8_SA(0, 0), a2, voffA);
            PG8_BAR; PG8_WAIT_L(0); PG8_MMA(1, 0, At, B0); PG8_BAR; PG8_SCHED;
            PG8_STAGE(PG8_SB(0, 1), b2 + hstep, voffB);
            PG8_WAIT_V(6); PG8_BAR; PG8_MMA(1, 1, At, B1); PG8_BAR;
            PG8_LDB(B0, 1, 0); PG8_SCHED; PG8_LDA(At, 1, 0); PG8_STAGE(PG8_SA(0, 1), a2 + hstep, voffA);
            PG8_WAIT_L(8); PG8_BAR; PG8_WAIT_L(0); PG8_MMA(0, 0, At, B0); PG8_BAR; PG8_SCHED;
            PG8_LDB(B1, 1, 1); PG8_STAGE(PG8_SB(1, 0), b3, voffB);
            PG8_BAR; PG8_WAIT_L(0); PG8_MMA(0, 1, At, B1); PG8_BAR;
            PG8_LDA(At, 1, 1); PG8_STAGE(PG8_SA(1, 0), a3, voffA);
            PG8_BAR; PG8_WAIT_L(0); PG8_MMA(1, 0, At, B0); PG8_BAR; PG8_SCHED;
            PG8_STAGE(PG8_SB(1, 1), b3 + hstep, voffB);
            PG8_WAIT_V(6); PG8_BAR; PG8_MMA(1, 1, At, B1); PG8_BAR;
        }
        {
            const int row0 = cur.pm * BM + wr * 64 + fr, col0 = cur.pn * BM + wc * 32 + 8 * fq;
#pragma unroll
            for (int ai = 0; ai < 2; ++ai)
#pragma unroll
                for (int m = 0; m < 4; ++m)
#pragma unroll
                    for (int bj = 0; bj < 2; ++bj) { E(row0 + ai * HALF + m * 16, col0 + bj * HALF, cur.pn, acc[ai][bj][m][0], acc[ai][bj][m][1]); if (Epi::SERIAL) __builtin_amdgcn_sched_barrier(0); }
        }
        if (!has_next) break;
#pragma unroll
        for (int a = 0; a < 2; ++a)
#pragma unroll
            for (int b = 0; b < 2; ++b)
#pragma unroll
                for (int m = 0; m < 4; ++m)
#pragma unroll
                    for (int n = 0; n < 2; ++n) acc[a][b][m][n] = (f32x4){0.f, 0.f, 0.f, 0.f};
        cur = nxt; cA = nA; cB = nB; ++ui;
    }
    PG8_WAIT_V(0);
    if (wr == 0) PG8_BAR;
    PG8_BAR;
#undef PG8_SA
#undef PG8_SB
#undef PG8_STAGE
#undef PG8_LDA
#undef PG8_LDB
#undef PG8_MMA
#undef PG8_WAIT_V
#undef PG8_WAIT_L
#undef PG8_BAR
#undef PG8_SCHED
}
struct GemmM { const bf16_t* A0; const bf16_t* A1; const bf16_t* Bt; int M, N; };
template <class Hook>
__device__ __forceinline__ void gemm_phase_merge(LAS unsigned char* lds, const GemmM g, const StaticOrder& S, const Hook& H) {
    const int tid = threadIdx.x, wid = __builtin_amdgcn_readfirstlane(tid >> 6), lane = tid & 63, wr = wid >> 2, wc = wid & 3, fr = lane & 15, fq = lane >> 4;
    constexpr int K = 2048, LDA = 1024, nt = K / BK, KS = 16;
    unsigned voffA[2], voffB[2];
#pragma unroll
    for (int i = 0; i < 2; ++i) { int R, C; stage_rc(tid * 16 + i * 8192, R, C); const int Rb = (R & ~31) + perm32(R & 31);
        voffA[i] = (unsigned)(R * LDA + C) * 2u; voffB[i] = (unsigned)(Rb * K + C) * 2u; }
    const size_t kstep = (size_t)(BK * 2);
    const size_t hstepA = (size_t)HALF * LDA * 2, tstepA = 2 * hstepA, hstepB = (size_t)HALF * K * 2, tstepB = 2 * hstepB;
    const unsigned ldsw = (unsigned)wid * 1024u;
    const int aoff = lds_byte(wr * 64 + fr, fq * 8), boff = lds_byte(wc * 32 + fr, fq * 8);
#define PG8_SA(b, h) (((b) * 2 + (h)) * HTB)
#define PG8_SB(b, h) ((4 + (b) * 2 + (h)) * HTB)
#define PG8_STAGE(bufoff, gbase, voff) do { _Pragma("unroll") for (int _i = 0; _i < 2; ++_i) \
        __builtin_amdgcn_global_load_lds((const unsigned*)((const char*)(gbase) + (voff)[_i]), (LAS unsigned*)(lds + (bufoff) + ldsw + _i * 8192), 16, 0, 0); } while (0)
#define PG8_LDA(dst, b, h) do { _Pragma("unroll") for (int m = 0; m < 4; ++m) _Pragma("unroll") for (int k = 0; k < 2; ++k) dst[m][k] = *(const LAS bf16x8*)(lds + PG8_SA(b, h) + aoff + m * 2048 + k * 1024); } while (0)
#define PG8_LDB(dst, b, h) do { _Pragma("unroll") for (int n = 0; n < 2; ++n) _Pragma("unroll") for (int k = 0; k < 2; ++k) dst[n][k] = *(const LAS bf16x8*)(lds + PG8_SB(b, h) + boff + n * 2048 + k * 1024); } while (0)
#define PG8_MMA(ai, bj, At, Bt) do { __builtin_amdgcn_s_setprio(1); _Pragma("unroll") for (int m = 0; m < 4; ++m) _Pragma("unroll") for (int n = 0; n < 2; ++n) _Pragma("unroll") for (int k = 0; k < 2; ++k) \
        acc[ai][bj][m][n] = __builtin_amdgcn_mfma_f32_16x16x32_bf16(Bt[n][k], At[m][k], acc[ai][bj][m][n], 0, 0, 0); __builtin_amdgcn_s_setprio(0); } while (0)
#define PG8_WAIT_V(n) asm volatile("s_waitcnt vmcnt(" #n ")" ::: "memory")
#define PG8_WAIT_L(n) asm volatile("s_waitcnt lgkmcnt(" #n ")" ::: "memory")
#define PG8_BAR __builtin_amdgcn_s_barrier()
#define PG8_SCHED __builtin_amdgcn_sched_barrier(0)
#define PG8_AT(b0, b1, t) ((t) < KS ? (b0) + (size_t)(t) * kstep : (b1) + (size_t)((t) - KS) * kstep)
    Unit cur, nxt; int ui = 0;
    if (!S.next(0, cur)) return;
    f32x4 acc[2][2][4][2];
#pragma unroll
    for (int a = 0; a < 2; ++a)
#pragma unroll
        for (int b = 0; b < 2; ++b)
#pragma unroll
            for (int m = 0; m < 4; ++m)
#pragma unroll
                for (int n = 0; n < 2; ++n) acc[a][b][m][n] = (f32x4){0.f, 0.f, 0.f, 0.f};
    bf16x8 At[4][2], B0[2][2], B1[2][2];
    const char* cA0 = (const char*)g.A0 + (size_t)cur.pm * tstepA; const char* cA1 = (const char*)g.A1 + (size_t)cur.pm * tstepA; const char* cB = (const char*)g.Bt + (size_t)cur.pn * tstepB;
    PG8_STAGE(PG8_SB(0, 0), cB, voffB); PG8_STAGE(PG8_SA(0, 0), cA0, voffA); PG8_STAGE(PG8_SB(0, 1), cB + hstepB, voffB); PG8_STAGE(PG8_SA(0, 1), cA0 + hstepA, voffA);
    if (wr == 1) PG8_BAR;
    PG8_WAIT_V(4); PG8_BAR;
    PG8_STAGE(PG8_SB(1, 0), cB + kstep, voffB); PG8_STAGE(PG8_SA(1, 0), cA0 + kstep, voffA); PG8_STAGE(PG8_SB(1, 1), cB + hstepB + kstep, voffB);
    PG8_WAIT_V(6); PG8_BAR;
    for (;;) {
        const bool has_next = S.next(ui + 1, nxt);
        const char* nA0 = has_next ? (const char*)g.A0 + (size_t)nxt.pm * tstepA : cA0; const char* nA1 = has_next ? (const char*)g.A1 + (size_t)nxt.pm * tstepA : cA1;
        const char* nB = has_next ? (const char*)g.Bt + (size_t)nxt.pn * tstepB : cB;
#pragma unroll 1
        for (int t = 0; t < nt; t += 2) {
            const bool last = (t == nt - 2);
            if (t == 16 || t == 24) H.rescale(acc, cur, t == 24 ? 1 : 0, wr, wc, fr, fq);
            const char* a1 = PG8_AT(cA0, cA1, t + 1);
            const char* a2 = last ? nA0 : PG8_AT(cA0, cA1, t + 2); const char* b2 = last ? nB : cB + (size_t)(t + 2) * kstep;
            const char* a3 = last ? nA0 + kstep : PG8_AT(cA0, cA1, t + 3); const char* b3 = b2 + kstep;
            PG8_LDB(B0, 0, 0); PG8_SCHED; PG8_LDA(At, 0, 0); PG8_STAGE(PG8_SA(1, 1), a1 + hstepA, voffA);
            PG8_WAIT_L(8); PG8_BAR; PG8_WAIT_L(0); PG8_MMA(0, 0, At, B0); PG8_BAR; PG8_SCHED;
            PG8_LDB(B1, 0, 1); PG8_STAGE(PG8_SB(0, 0), b2, voffB);
            PG8_BAR; PG8_WAIT_L(0); PG8_MMA(0, 1, At, B1); PG8_BAR;
            PG8_LDA(At, 0, 1); PG8_STAGE(PG8_SA(0, 0), a2, voffA);
            PG8_BAR; PG8_WAIT_L(0); PG8_MMA(1, 0, At, B0); PG8_BAR; PG8_SCHED;
            PG8_STAGE(PG8_SB(0, 1), b2 + hstepB, voffB);
            PG8_WAIT_V(6); PG8_BAR; PG8_MMA(1, 1, At, B1); PG8_BAR;
            PG8_LDB(B0, 1, 0); PG8_SCHED; PG8_LDA(At, 1, 0); PG8_STAGE(PG8_SA(0, 1), a2 + hstepA, voffA);
            PG8_WAIT_L(8); PG8_BAR; PG8_WAIT_L(0); PG8_MMA(0, 0, At, B0); PG8_BAR; PG8_SCHED;
            PG8_LDB(B1, 1, 1); PG8_STAGE(PG8_SB(1, 0), b3, voffB);
            PG8_BAR; PG8_WAIT_L(0); PG8_MMA(0, 1, At, B1); PG8_BAR;
            PG8_LDA(At, 1, 1); PG8_STAGE(PG8_SA(1, 0), a3, voffA);
            PG8_BAR; PG8_WAIT_L(0); PG8_MMA(1, 0, At, B0); PG8_BAR; PG8_SCHED;
            PG8_STAGE(PG8_SB(1, 1), b3 + hstepB, voffB);
            PG8_WAIT_V(6); PG8_BAR; PG8_MMA(1, 1, At, B1); PG8_BAR;
        }
        H.finish(acc, cur, wr, wc, fr, fq);
        if (!has_next) break;
#pragma unroll
        for (int a = 0; a < 2; ++a)
#pragma unroll
            for (int b = 0; b < 2; ++b)
#pragma unroll
                for (int m = 0; m < 4; ++m)
#pragma unroll
                    for (int n = 0; n < 2; ++n) acc[a][b][m][n] = (f32x4){0.f, 0.f, 0.f, 0.f};
        cur = nxt; cA0 = nA0; cA1 = nA1; cB = nB; ++ui;
    }
    PG8_WAIT_V(0);
    if (wr == 0) PG8_BAR;
    PG8_BAR;
#undef PG8_SA
#undef PG8_SB
#undef PG8_STAGE
#undef PG8_LDA
#undef PG8_LDB
#undef PG8_MMA
#undef PG8_WAIT_V
#undef PG8_WAIT_L
#undef PG8_BAR
#undef PG8_SCHED
#undef PG8_AT
}
}

struct Args { const float* in[34]; float* out; unsigned char* ws; int ph_lo, ph_hi, li, pad; };

struct Ctx {
    LAS unsigned char* lds;
    int tid, lane, wave, gw, ngw, gt, ngt, G;
    const float* const* in; unsigned char* ws; unsigned char* dout;
};

__device__ __forceinline__ void st8_bf16(bf16_t* p, f32x4 a, f32x4 b) { u32x4 w; w.x = pk2(a.x, a.y); w.y = pk2(a.z, a.w); w.z = pk2(b.x, b.y); w.w = pk2(b.z, b.w); *(u32x4*)p = w; }
struct EpiP1 { static constexpr bool SERIAL = false;
    float* cs; bf16_t* rc; bf16_t* mq;
    __device__ __forceinline__ void operator()(int row, int col, int pn, f32x4 a, f32x4 b) const {
        if (pn < 2) { float* p = cs + (size_t)row * 512 + col; *(f32x4*)p = a; *(f32x4*)(p + 4) = b; }
        else if (pn < 9) st8_bf16(rc + (size_t)row * 1792 + (col - 512), a, b);
        else st8_bf16(mq + (size_t)row * 512 + (col - 2304), a, b);
    }
};
struct EpiMemKV { static constexpr bool SERIAL = false;
    bf16_t* km; bf16_t* vt;
    __device__ __forceinline__ void operator()(int row, int col, int pn, f32x4 a, f32x4 b) const {
        const int bb = row >> 8, m = row & 255;
        if (col < 512) { const int h = col >> 7, d = col & 127; st8_bf16(km + ((size_t)((bb * 4 + h) * 256 + m)) * 128 + d, a, b); }
        else { const int c2 = col - 512, h = c2 >> 7, d = c2 & 127; bf16_t* p = vt + ((size_t)((bb * 4 + h) * 128 + d)) * 256 + m;
            p[0] = (bf16_t)f2bf(a.x); p[256] = (bf16_t)f2bf(a.y); p[512] = (bf16_t)f2bf(a.z); p[768] = (bf16_t)f2bf(a.w);
            p[1024] = (bf16_t)f2bf(b.x); p[1280] = (bf16_t)f2bf(b.y); p[1536] = (bf16_t)f2bf(b.z); p[1792] = (bf16_t)f2bf(b.w); }
    }
};
struct EpiLora { static constexpr bool SERIAL = true;
    bf16_t* e; bf16_t* a; bf16_t* g; const float* w0; const float* a0;
    __device__ __forceinline__ void operator()(int row, int col, int pn, f32x4 x, f32x4 y) const {
        float v[8] = {x.x, x.y, x.z, x.w, y.x, y.y, y.z, y.w};
        if (pn < 4) { const int c = col & 511; const float* bp = (pn < 2 ? w0 : a0) + c; const f32x4 b0 = *(const f32x4*)bp, b1 = *(const f32x4*)(bp + 4);
            const float bb[8] = {b0.x, b0.y, b0.z, b0.w, b1.x, b1.y, b1.z, b1.w}; const float sc = pn < 2 ? 0.6065306597126334f : 1.0f;
#pragma unroll
            for (int j = 0; j < 8; ++j) v[j] = sc * sigmoidf_(v[j] + bb[j]);
            *(u32x4*)((pn < 2 ? e : a) + (size_t)row * 512 + c) = pack8(v);
        } else *(u32x4*)(g + (size_t)row * 512 + (col - 1024)) = pack8(v);
    }
};
struct EpiQ { static constexpr bool SERIAL = false;
    bf16_t* ql; bf16_t* qi;
    __device__ __forceinline__ void operator()(int row, int col, int pn, f32x4 a, f32x4 b) const {
        if (pn < 4) st8_bf16(ql + (size_t)row * 1024 + col, a, b); else st8_bf16(qi + (size_t)row * 256 + (col - 1024), a, b);
    }
};
struct EpiGates { static constexpr bool SERIAL = true;
    bf16_t* o;
    __device__ __forceinline__ void operator()(int row, int col, int pn, f32x4 a, f32x4 b) const {
        float v[8] = {a.x, a.y, a.z, a.w, b.x, b.y, b.z, b.w};
#pragma unroll
        for (int j = 0; j < 8; ++j) v[j] = sigmoidf_(v[j]);
        *(u32x4*)(o + (size_t)row * 3072 + col) = pack8(v);
    }
};
struct MergeHook {
    const bf16_t* gates; bf16_t* mb;
    __device__ __forceinline__ void rescale(f32x4 (&acc)[2][2][4][2], const pg8::Unit& u, int idx, int wr, int wc, int fr, int fq) const {
        asm volatile("" : "+v"(fr), "+v"(fq));
        const int row0 = u.pm * 256 + wr * 64 + fr, col0 = u.pn * 256 + wc * 32 + 8 * fq;
#pragma unroll
        for (int ai = 0; ai < 2; ++ai)
#pragma unroll
            for (int mh = 0; mh < 2; ++mh) {
                u32x4 pa[2][2], pb[2][2];
#pragma unroll
                for (int mm = 0; mm < 2; ++mm)
#pragma unroll
                    for (int bj = 0; bj < 2; ++bj) { const bf16_t* gp = gates + (size_t)(row0 + ai * 128 + (2 * mh + mm) * 16) * 3072 + idx * 1024 + col0 + bj * 128; pa[mm][bj] = *(const u32x4*)gp; pb[mm][bj] = *(const u32x4*)(gp + 1024); }
                __builtin_amdgcn_sched_barrier(0);
#pragma unroll
                for (int mm = 0; mm < 2; ++mm)
#pragma unroll
                    for (int bj = 0; bj < 2; ++bj) { float a[8], b[8]; unpack8(pa[mm][bj], a); unpack8(pb[mm][bj], b); const int m = 2 * mh + mm;
#pragma unroll
                        for (int j = 0; j < 4; ++j) { acc[ai][bj][m][0][j] *= a[j] * __builtin_amdgcn_rcpf(b[j]); acc[ai][bj][m][1][j] *= a[4 + j] * __builtin_amdgcn_rcpf(b[4 + j]); } }
                __builtin_amdgcn_sched_barrier(0);
            }
    }
    __device__ __forceinline__ void finish(f32x4 (&acc)[2][2][4][2], const pg8::Unit& u, int wr, int wc, int fr, int fq) const {
        asm volatile("" : "+v"(fr), "+v"(fq));
        const int row0 = u.pm * 256 + wr * 64 + fr, col0 = u.pn * 256 + wc * 32 + 8 * fq;
#pragma unroll
        for (int ai = 0; ai < 2; ++ai)
#pragma unroll
            for (int m = 0; m < 4; ++m)
#pragma unroll
                for (int bj = 0; bj < 2; ++bj) { const int row = row0 + ai * 128 + m * 16, col = col0 + bj * 128;
                    float gv[8]; unpack8(*(const u32x4*)(gates + (size_t)row * 3072 + 2048 + col), gv);
                    const f32x4 x = acc[ai][bj][m][0], y = acc[ai][bj][m][1];
                    float v[8] = {x[0] * gv[0], x[1] * gv[1], x[2] * gv[2], x[3] * gv[3], y[0] * gv[4], y[1] * gv[5], y[2] * gv[6], y[3] * gv[7]};
                    *(u32x4*)(mb + (size_t)row * 1024 + col) = pack8(v); }
    }
};
struct EpiWout { static constexpr bool SERIAL = false;
    gfp x; bf16_t* pre;
    __device__ __forceinline__ void operator()(int row, int col, int pn, f32x4 a, f32x4 b) const {
        gfp xp = x + (size_t)row * 1024 + col; typedef const __attribute__((address_space(1))) f32x4* g4p;
        st8_bf16(pre + (size_t)row * 1024 + col, *(g4p)xp * ALPHA + a, *(g4p)(xp + 4) * ALPHA + b);
    }
};
struct EpiPeerQ { static constexpr bool SERIAL = false; bf16_t* o; __device__ __forceinline__ void operator()(int row, int col, int pn, f32x4 a, f32x4 b) const { st8_bf16(o + (size_t)row * 2048 + col, a, b); } };

template <int N, int K, class F> __device__ __forceinline__ void build_bt(bf16_t* dst, const F& f, int gt, int ngt) {
    constexpr int items = N * (K / 8);
    for (int i = gt; i < items; i += ngt) { const int n = i % N, k0 = (i / N) * 8; float v[8];
#pragma unroll
        for (int j = 0; j < 8; ++j) v[j] = f(n, k0 + j);
        *(u32x4*)(dst + (size_t)n * K + k0) = pack8(v); }
}
template <int N, int K, class F> __device__ __forceinline__ void build_bt_ld(bf16_t* dst, int ld, const F& f, int gt, int ngt) {
    constexpr int items = N * (K / 8);
    for (int i = gt; i < items; i += ngt) { const int n = i % N, k0 = (i / N) * 8; float v[8];
#pragma unroll
        for (int j = 0; j < 8; ++j) v[j] = f(n, k0 + j);
        *(u32x4*)(dst + (size_t)n * ld + k0) = pack8(v); }
}
struct FWin { gfp w; __device__ __forceinline__ float operator()(int n, int k) const { if (n < 424) return w[(size_t)k * IN_W + n]; if (n < 512) return 0.f; return w[(size_t)k * IN_W + n - 88]; } };
struct FWg { gfp w; __device__ __forceinline__ float operator()(int n, int k) const { return w[(size_t)k * IN_W + 2728 + n]; } };
struct FLora { gfp w2, a2, g2; __device__ __forceinline__ float operator()(int n, int k) const {
    if (n < 512) return k < 64 ? w2[k * 512 + n] : 0.f;
    if (n < 1024) return (k >= 64 && k < 128) ? a2[(k - 64) * 512 + n - 512] : 0.f;
    return k >= 128 ? g2[(k - 128) * 512 + n - 1024] : 0.f; } };
struct FWq { const float *uq, *uk, *iq; __device__ __forceinline__ float operator()(int n, int k) const {
    if (n >= 1024) return iq[k * 256 + n - 1024];
    const int h = n >> 7, c = n & 127; const float* a = uq + (size_t)k * 512 + h * 64; const float* b = uk + (size_t)(c * 8 + h) * 64; float s = 0.f;
#pragma unroll 8
    for (int d = 0; d < 64; ++d) s = fmaf(a[d], b[d], s);
    return s * 0.125f; } };
struct FWov { const float *uv, *br; __device__ __forceinline__ float operator()(int n, int k) const {
    const int h = k >> 7, c = k & 127; const float* a = uv + (size_t)(c * 8 + h) * 64; const float* b = br + (size_t)(h * 64) * 1024 + n; float s = 0.f;
#pragma unroll 8
    for (int d = 0; d < 64; ++d) s = fmaf(a[d], b[(size_t)d * 1024], s);
    return s; } };
struct FT { gfp w; int ld; __device__ __forceinline__ float operator()(int n, int k) const { return w[(size_t)k * ld + n]; } };

__device__ __forceinline__ void cvt_rows(gfp src, bf16_t* dst, size_t n8, int gt, int ngt) {
    for (size_t i = gt; i < n8; i += ngt) { const f32x4 a = *(const __attribute__((address_space(1))) f32x4*)(src + i * 8), b = *(const __attribute__((address_space(1))) f32x4*)(src + i * 8 + 4); st8_bf16(dst + i * 8, a, b); }
}
constexpr float PEER_U_SCALE = 64.0f, PEER_V_SCALE = 8.0f;
template <bool SLICED = false>
__device__ __forceinline__ void cvt_rows_fp8(gfp src, unsigned char* dst, size_t n16, float scale, int gt, int ngt) {
    for (size_t i = gt; i < n16; i += ngt) { typedef const __attribute__((address_space(1))) f32x4* g4p; gfp p = src + i * 16; u32x4 w;
        const f32x4 a = *(g4p)p * scale, b = *(g4p)(p + 4) * scale, c = *(g4p)(p + 8) * scale, d = *(g4p)(p + 12) * scale;
        int t = 0; t = __builtin_amdgcn_cvt_pk_fp8_f32(a.x, a.y, t, false); t = __builtin_amdgcn_cvt_pk_fp8_f32(a.z, a.w, t, true); w.x = (unsigned)t;
        t = 0; t = __builtin_amdgcn_cvt_pk_fp8_f32(b.x, b.y, t, false); t = __builtin_amdgcn_cvt_pk_fp8_f32(b.z, b.w, t, true); w.y = (unsigned)t;
        t = 0; t = __builtin_amdgcn_cvt_pk_fp8_f32(c.x, c.y, t, false); t = __builtin_amdgcn_cvt_pk_fp8_f32(c.z, c.w, t, true); w.z = (unsigned)t;
        t = 0; t = __builtin_amdgcn_cvt_pk_fp8_f32(d.x, d.y, t, false); t = __builtin_amdgcn_cvt_pk_fp8_f32(d.z, d.w, t, true); w.w = (unsigned)t;
        if (SLICED) *(u32x4*)(dst + (((i >> 3) & 7) << 21) + ((i >> 6) << 7) + ((i & 7) << 4)) = w; else *(u32x4*)(dst + i * 16) = w; }
}
__device__ __forceinline__ void p0_prologue(const Ctx& C) {
    const float* const* in = C.in; unsigned char* ws = C.ws;
    cvt_rows(G_(in[0]), (bf16_t*)(C.dout + DO_XB), (size_t)T * D / 8, C.gt, C.ngt);
    cvt_rows(G_(in[1]), (bf16_t*)(ws + WS_MEMB), (size_t)1024 * 1024 / 8, C.gt, C.ngt);
    cvt_rows(G_(in[29]), (bf16_t*)(ws + WS_KEYS), (size_t)2 * 128 * 128 / 8, C.gt, C.ngt);
    build_bt<2816, 1024>((bf16_t*)(ws + WS_WIN), FWin{G_(in[3])}, C.gt, C.ngt);
    build_bt<1536, 256>((bf16_t*)(ws + WS_WLORA), FLora{G_(in[12]), G_(in[14]), G_(in[15])}, C.gt, C.ngt);
    {
        bf16_t* dst = (bf16_t*)(ws + WS_WQ); const float* uq = in[6]; const float* uk = in[7];
        for (int item = C.gw; item < 4096; item += C.ngw) { const int n = item >> 2, k = (item & 3) * 64 + C.lane, h = n >> 7, c = n & 127;
            const float* a = uq + (size_t)k * 512 + h * 64; const float* bq = uk + (size_t)(c * 8 + h) * 64; float s = 0.f;
#pragma unroll
            for (int d4 = 0; d4 < 16; ++d4) { const f32x4 av = *(const f32x4*)(a + 4 * d4), bv = *(const f32x4*)(bq + 4 * d4); s += av.x * bv.x + av.y * bv.y + av.z * bv.z + av.w * bv.w; }
            dst[(size_t)n * 256 + k] = (bf16_t)f2bf(s * 0.125f); }
        build_bt<256, 256>(dst + 1024 * 256, FT{G_(in[9]), 256}, C.gt, C.ngt);
    }
    build_bt<1024, 1024>((bf16_t*)(ws + WS_WMEMKV), FT{G_(in[21]), 1024}, C.gt, C.ngt);
}
__device__ __forceinline__ void p6_late_weights(const Ctx& C0) {
    const int busy = (32 * RCH + C0.G - 1) / C0.G; Ctx C = C0;
    if (busy < NWAVES) { if (C0.wave < busy) return; C.gt = (int)blockIdx.x * (NWAVES - busy) * 64 + (C0.wave - busy) * 64 + C0.lane; C.ngt = C0.G * (NWAVES - busy) * 64; C.gw = C.gt >> 6; C.ngw = C.ngt >> 6; }
    const float* const* in = C.in; unsigned char* ws = C.ws;
    build_bt<3072, 1024>((bf16_t*)(ws + WS_WG), FWg{G_(in[3])}, C.gt, C.ngt);
    {
        bf16_t* dst = (bf16_t*)(ws + WS_WOV); const float* uv = in[8]; const float* br = in[22];
        for (int i = C.gt; i < 1024 * 128; i += C.ngt) { const int n = i & 1023, k0 = (i >> 10) * 8, h = k0 >> 7, c0 = k0 & 127; float acc[8];
#pragma unroll
            for (int j = 0; j < 8; ++j) acc[j] = 0.f;
            for (int d4 = 0; d4 < 16; ++d4) {
                float b[4];
#pragma unroll
                for (int q = 0; q < 4; ++q) b[q] = br[(size_t)(h * 64 + 4 * d4 + q) * 1024 + n];
#pragma unroll
                for (int j = 0; j < 8; ++j) { const f32x4 a = *(const f32x4*)(uv + (size_t)((c0 + j) * 8 + h) * 64 + 4 * d4); acc[j] += a.x * b[0] + a.y * b[1] + a.z * b[2] + a.w * b[3]; }
            }
            *(u32x4*)(dst + (size_t)n * 2048 + k0) = pack8(acc); }
    }
    build_bt_ld<1024, 512>((bf16_t*)(ws + WS_WOV) + 1024, 2048, FT{G_(in[23]), 1024}, C.gt, C.ngt);
    build_bt_ld<1024, 512>((bf16_t*)(ws + WS_WOV) + 1536, 2048, FT{G_(in[24]), 1024}, C.gt, C.ngt);
    build_bt<1024, 1024>((bf16_t*)(ws + WS_WOUT), FT{G_(in[25]), 1024}, C.gt, C.ngt);
    build_bt<2048, 1024>((bf16_t*)(ws + WS_WPEER), FT{G_(in[28]), 2048}, C.gt, C.ngt);
    cvt_rows_fp8<true>(G_(in[30]), ws + WS_UB, (size_t)16384 * 1024 / 16, PEER_U_SCALE, C.gt, C.ngt);
}

__device__ __forceinline__ void p2_prep(const Ctx& C) {
    const float* const* in = C.in; unsigned char* ws = C.ws; const int lane = C.lane;
    const float* csmall = (const float*)(ws + WS_CSMALL); const bf16_t* rcols = (const bf16_t*)(ws + WS_RCOLS);
    bf16_t* cqn = (bf16_t*)(ws + WS_CQN); bf16_t* kvl = (bf16_t*)(ws + WS_KVL); bf16_t* kidx = (bf16_t*)(ws + WS_KIDX); float* widx = (float*)(ws + WS_WIDX);
    bf16_t* rr = (bf16_t*)(ws + WS_RW_R); bf16_t* rk = (bf16_t*)(ws + WS_RW_K); bf16_t* rv = (bf16_t*)(ws + WS_RW_V); bf16_t* la = (bf16_t*)(ws + WS_LORAA);
    const float* mu = in[10];
    const f32x4 gq = *(const f32x4*)(in[4] + 4 * lane); const f32x2 gk = *(const f32x2*)(in[5] + 2 * lane);
    for (int t = C.gw; t < T; t += C.ngw) {
        const float* cs = csmall + (size_t)t * 512;
        {
            const f32x4 q = *(const f32x4*)(cs + 4 * lane);
            const float ss = wave_sum(q.x * q.x + q.y * q.y + q.z * q.z + q.w * q.w);
            const float rs = rsqrtf(ss * (1.0f / 256.0f) + 1e-6f);
            u32x2 w; w.x = pk2(q.x * rs * gq.x, q.y * rs * gq.y); w.y = pk2(q.z * rs * gq.z, q.w * rs * gq.w);
            *(u32x2*)(cqn + (size_t)t * 256 + 4 * lane) = w;
        }
        {
            const f32x2 k = *(const f32x2*)(cs + 256 + 2 * lane);
            const float ss = wave_sum(k.x * k.x + k.y * k.y);
            const float rs = rsqrtf(ss * (1.0f / 128.0f) + 1e-6f);
            *(unsigned*)(kvl + (size_t)t * 128 + 2 * lane) = pk2(k.x * rs * gk.x, k.y * rs * gk.y);
        }
        if (lane < 16) { const f32x2 k = *(const f32x2*)(cs + 384 + 2 * lane); *(unsigned*)(kidx + (size_t)t * 32 + 2 * lane) = pk2(k.x, k.y); }
        if (lane < 8) widx[(size_t)t * 8 + lane] = cs[416 + lane] * 0.0625f;
        const bf16_t* rc = rcols + (size_t)t * 1792; const bool hp = (t & (SEQ - 1)) != 0; const bf16_t* rp = hp ? rc - 1792 : rc;
#pragma unroll
        for (int seg = 0; seg < 3; ++seg) {
            float c[8], p[8], o[8];
            unpack8(*(const u32x4*)(rc + seg * 512 + 8 * lane), c); unpack8(*(const u32x4*)(rp + seg * 512 + 8 * lane), p);
            const f32x4 m0 = *(const f32x4*)(mu + seg * 512 + 8 * lane), m1 = *(const f32x4*)(mu + seg * 512 + 8 * lane + 4);
            const float mm[8] = {m0.x, m0.y, m0.z, m0.w, m1.x, m1.y, m1.z, m1.w};
#pragma unroll
            for (int j = 0; j < 8; ++j) { const float pv = hp ? p[j] : 0.f; o[j] = c[j] + (pv - c[j]) * mm[j]; }
            bf16_t* dst = (seg == 0 ? rr : (seg == 1 ? rk : rv)) + (size_t)t * 512 + 8 * lane;
            *(u32x4*)dst = pack8(o);
        }
        {
            const float cw = bf1(rc[1536 + lane]), pw = hp ? bf1(rp[1536 + lane]) : 0.f; const float wl = cw + (pw - cw) * mu[1536 + lane];
            const float ca = bf1(rc[1600 + lane]), pa = hp ? bf1(rp[1600 + lane]) : 0.f; const float al = ca + (pa - ca) * mu[1600 + lane];
            const unsigned cgw = *(const unsigned*)(rc + 1664 + 2 * lane), pgw = *(const unsigned*)(rp + 1664 + 2 * lane);
            const float cg0 = bflo(cgw), cg1 = bfhi(cgw), pg0 = hp ? bflo(pgw) : 0.f, pg1 = hp ? bfhi(pgw) : 0.f;
            const float g0 = cg0 + (pg0 - cg0) * mu[1664 + 2 * lane], g1 = cg1 + (pg1 - cg1) * mu[1664 + 2 * lane + 1];
            bf16_t* l = la + (size_t)t * 256;
            l[lane] = (bf16_t)f2bf(tanhf(wl)); l[64 + lane] = (bf16_t)f2bf(al);
            *(unsigned*)(l + 128 + 2 * lane) = pk2(sigmoidf_(g0), sigmoidf_(g1));
        }
    }
}

template <int NV> __device__ __forceinline__ unsigned kth_largest(const unsigned (&u)[NV], int k) {
    unsigned Tk = 0u;
    for (int bit = 31; bit >= 0; --bit) {
        const unsigned cand = Tk | (1u << bit); int cnt = 0;
#pragma unroll
        for (int j = 0; j < NV; ++j) cnt += __popcll(__ballot(u[j] >= cand));
        if (cnt >= k) Tk = cand;
    }
    return Tk;
}

__device__ __forceinline__ unsigned wave_max_u(unsigned x) {
    unsigned y;
    y = dpp_u<0x111>(x); x = x > y ? x : y; y = dpp_u<0x112>(x); x = x > y ? x : y; y = dpp_u<0x114>(x); x = x > y ? x : y; y = dpp_u<0x118>(x); x = x > y ? x : y;
    y = (unsigned)__builtin_amdgcn_update_dpp(0, (int)x, 0x142, 0xA, 0xF, false); x = x > y ? x : y;
    y = (unsigned)__builtin_amdgcn_update_dpp(0, (int)x, 0x143, 0xC, 0xF, false); x = x > y ? x : y;
    return (unsigned)__builtin_amdgcn_readlane((int)x, 63);
}
__device__ __forceinline__ int wave_sum_i(int x) {
    x += __builtin_amdgcn_update_dpp(0, x, 0x111, 0xF, 0xF, false); x += __builtin_amdgcn_update_dpp(0, x, 0x112, 0xF, 0xF, false);
    x += __builtin_amdgcn_update_dpp(0, x, 0x114, 0xF, 0xF, false); x += __builtin_amdgcn_update_dpp(0, x, 0x118, 0xF, 0xF, false);
    x += __builtin_amdgcn_update_dpp(0, x, 0x142, 0xA, 0xF, false); x += __builtin_amdgcn_update_dpp(0, x, 0x143, 0xC, 0xF, false);
    return __builtin_amdgcn_readlane(x, 63);
}
__device__ __forceinline__ float wave_max_f(float x) {
    const int ninf = (int)0xff800000u; float y;
    y = __builtin_bit_cast(float, __builtin_amdgcn_update_dpp(ninf, __builtin_bit_cast(int, x), 0x111, 0xF, 0xF, false)); x = fmaxf(x, y);
    y = __builtin_bit_cast(float, __builtin_amdgcn_update_dpp(ninf, __builtin_bit_cast(int, x), 0x112, 0xF, 0xF, false)); x = fmaxf(x, y);
    y = __builtin_bit_cast(float, __builtin_amdgcn_update_dpp(ninf, __builtin_bit_cast(int, x), 0x114, 0xF, 0xF, false)); x = fmaxf(x, y);
    y = __builtin_bit_cast(float, __builtin_amdgcn_update_dpp(ninf, __builtin_bit_cast(int, x), 0x118, 0xF, 0xF, false)); x = fmaxf(x, y);
    y = __builtin_bit_cast(float, __builtin_amdgcn_update_dpp(ninf, __builtin_bit_cast(int, x), 0x142, 0xA, 0xF, false)); x = fmaxf(x, y);
    y = __builtin_bit_cast(float, __builtin_amdgcn_update_dpp(ninf, __builtin_bit_cast(int, x), 0x143, 0xC, 0xF, false)); x = fmaxf(x, y);
    return __builtin_bit_cast(float, __builtin_amdgcn_readlane(__builtin_bit_cast(int, x), 63));
}
__device__ __forceinline__ int wave_scan_i(int x) {
    x += __builtin_amdgcn_update_dpp(0, x, 0x111, 0xF, 0xF, false); x += __builtin_amdgcn_update_dpp(0, x, 0x112, 0xF, 0xF, false);
    x += __builtin_amdgcn_update_dpp(0, x, 0x114, 0xF, 0xF, false); x += __builtin_amdgcn_update_dpp(0, x, 0x118, 0xF, 0xF, false);
    x += __builtin_amdgcn_update_dpp(0, x, 0x142, 0xA, 0xF, false); x += __builtin_amdgcn_update_dpp(0, x, 0x143, 0xC, 0xF, false);
    return x;
}
__device__ __forceinline__ int hist_find(u32x4 h, int K, int lane, int& chi, int& cnt) {
    const int ls = (int)(h.x + h.y + h.z + h.w); const int inc = wave_scan_i(ls); const int tot = __builtin_amdgcn_readlane(inc, 63);
    const int a3 = tot - inc, a2 = a3 + (int)h.w, a1 = a2 + (int)h.z, a0 = a1 + (int)h.y;
    int myb = -1, mya = 0, myc = 0;
    if (a3 < K && K <= a3 + (int)h.w) { myb = 3; mya = a3; myc = (int)h.w; }
    if (a2 < K && K <= a2 + (int)h.z) { myb = 2; mya = a2; myc = (int)h.z; }
    if (a1 < K && K <= a1 + (int)h.y) { myb = 1; mya = a1; myc = (int)h.y; }
    if (a0 < K && K <= a0 + (int)h.x) { myb = 0; mya = a0; myc = (int)h.x; }
    const unsigned long long m = __ballot(myb >= 0); const int src = m ? (int)__builtin_ctzll(m) : 0;
    chi = __builtin_amdgcn_readlane(mya, src); cnt = __builtin_amdgcn_readlane(myc, src);
    return 4 * src + __builtin_amdgcn_readlane(myb, src);
}
constexpr int LDS_HIST = 131072 + 4096;
__device__ __forceinline__ void p4_indexer(const Ctx& C) {
    unsigned char* ws = C.ws; const int lane = C.lane, wave = C.wave, g = lane >> 4, fr = lane & 15;
    const bf16_t* qidx = (const bf16_t*)(ws + WS_QIDX); const bf16_t* kidx = (const bf16_t*)(ws + WS_KIDX); const float* widx = (const float*)(ws + WS_WIDX);
    bf16_t* idxo = (bf16_t*)(ws + WS_IDX);
    constexpr int SCB = 8192 + 16;
    LAS unsigned char* SC = C.lds;
    LAS unsigned* H = (LAS unsigned*)(C.lds + LDS_HIST + wave * 1024);
    for (int u = blockIdx.x; u < 1024; u += C.G) {
        const int i4 = u >> 8, cc = u & 255, b = cc & 3, j = cc >> 2, qb = (i4 & 1) ? 64 * i4 + 63 - j : 64 * i4 + j;
        const int t0 = qb * 16, ntile = (t0 + 16 + 15) >> 4; const size_t tb = (size_t)b * SEQ; const size_t qrow = tb + t0 + fr;
        bf16x8 Bq[8];
#pragma unroll
        for (int h = 0; h < 8; ++h) Bq[h] = *(const bf16x8*)(qidx + qrow * 256 + h * 32 + 8 * g);
        const f32x4 w0 = *(const f32x4*)(widx + qrow * 8), w1 = *(const f32x4*)(widx + qrow * 8 + 4);
        const float wq[8] = {w0.x, w0.y, w0.z, w0.w, w1.x, w1.y, w1.z, w1.w};
        bf16x8 An[4];
#pragma unroll
        for (int q = 0; q < 4; ++q) { int i = wave + q * NWAVES; i = i < ntile ? i : ntile - 1; An[q] = *(const bf16x8*)(kidx + (tb + 16 * i + fr) * 32 + 8 * g); }
        for (int i0 = wave; i0 < ntile; i0 += 4 * NWAVES) {
            bf16x8 A[4];
#pragma unroll
            for (int q = 0; q < 4; ++q) A[q] = An[q];
#pragma unroll
            for (int q = 0; q < 4; ++q) { int i = i0 + 4 * NWAVES + q * NWAVES; i = i < ntile ? i : ntile - 1; An[q] = *(const bf16x8*)(kidx + (tb + 16 * i + fr) * 32 + 8 * g); }
#pragma unroll
            for (int q = 0; q < 4; ++q) {
                const int i = i0 + q * NWAVES;
                if (i < ntile) {
                    f32x4 sc = (f32x4){0.f, 0.f, 0.f, 0.f};
#pragma unroll
                    for (int h = 0; h < 8; ++h) { const f32x4 d = __builtin_amdgcn_mfma_f32_16x16x32_bf16(A[q], Bq[h], (f32x4){0.f, 0.f, 0.f, 0.f}, 0, 0, 0);
#pragma unroll
                        for (int r = 0; r < 4; ++r) sc[r] = fmaf(wq[h], fmaxf(d[r], 0.f), sc[r]); }
                    const int tq = t0 + fr, s0 = 16 * i + 4 * g; unsigned kq[4];
#pragma unroll
                    for (int r = 0; r < 4; ++r) { const unsigned hb = (unsigned)__builtin_bit_cast(unsigned short, (_Float16)sc[r]); const unsigned ky = (hb & 0x8000u) ? (~hb & 0xffffu) : (hb | 0x8000u); kq[r] = (s0 + r <= tq) ? ky : 0u; }
                    u32x2 w; w.x = kq[0] | (kq[1] << 16); w.y = kq[2] | (kq[3] << 16);
                    *(LAS u32x2*)(SC + fr * SCB + 2 * s0) = w;
                }
            }
        }
        __syncthreads();
#pragma unroll 1
        for (int rr = 0; rr < 2; ++rr) {
            const int row = wave + 8 * rr, tq = t0 + row; bf16_t* out = idxo + (tb + tq) * 256;
            if (tq < 256) {
#pragma unroll
                for (int jj = 0; jj < 4; ++jj) { const int s = jj * 64 + lane; if (s <= tq) out[s] = (bf16_t)s; }
            } else {
                unsigned kp[32];
#pragma unroll
                for (int d = 0; d < 32; ++d) { const int s2 = 2 * (64 * d + lane); unsigned w = *(const LAS unsigned*)(SC + row * SCB + 2 * s2); if (s2 > tq) w = 0u; kp[d] = w; }
                *(LAS u32x4*)(H + 4 * lane) = (u32x4){0u, 0u, 0u, 0u};
#pragma unroll
                for (int d = 0; d < 32; ++d) { const unsigned a = kp[d] & 0xffffu, bq_ = kp[d] >> 16;
                    if (a) __hip_atomic_fetch_add(H + (a >> 8), 1u, __ATOMIC_RELAXED, __HIP_MEMORY_SCOPE_WORKGROUP);
                    if (bq_) __hip_atomic_fetch_add(H + (bq_ >> 8), 1u, __ATOMIC_RELAXED, __HIP_MEMORY_SCOPE_WORKGROUP); }
                asm volatile("s_waitcnt lgkmcnt(0)" ::: "memory");
                int chi1, cnt1; const int b1 = hist_find(*(const LAS u32x4*)(H + 4 * lane), 256, lane, chi1, cnt1);
                asm volatile("s_waitcnt lgkmcnt(0)" ::: "memory");
                *(LAS u32x4*)(H + 4 * lane) = (u32x4){0u, 0u, 0u, 0u};
#pragma unroll
                for (int d = 0; d < 32; ++d) { const unsigned a = kp[d] & 0xffffu, bq_ = kp[d] >> 16;
                    if ((int)(a >> 8) == b1 && a) __hip_atomic_fetch_add(H + (a & 255u), 1u, __ATOMIC_RELAXED, __HIP_MEMORY_SCOPE_WORKGROUP);
                    if ((int)(bq_ >> 8) == b1 && bq_) __hip_atomic_fetch_add(H + (bq_ & 255u), 1u, __ATOMIC_RELAXED, __HIP_MEMORY_SCOPE_WORKGROUP); }
                asm volatile("s_waitcnt lgkmcnt(0)" ::: "memory");
                int chi2, cnt2; const int b2 = hist_find(*(const LAS u32x4*)(H + 4 * lane), 256 - chi1, lane, chi2, cnt2);
                const unsigned T16 = (unsigned)(b1 * 256 + b2); const int need = 256 - chi1 - chi2;
                const bool allties = (need == cnt2); const unsigned thr = allties ? T16 : T16 + 1u;
                unsigned mlo = 0u, mhi = 0u;
#pragma unroll
                for (int d = 0; d < 16; ++d) { const unsigned a = kp[d] & 0xffffu, bq_ = kp[d] >> 16; mlo |= (a >= thr ? 1u : 0u) << (2 * d); mlo |= (bq_ >= thr ? 1u : 0u) << (2 * d + 1); }
#pragma unroll
                for (int d = 16; d < 32; ++d) { const unsigned a = kp[d] & 0xffffu, bq_ = kp[d] >> 16; mhi |= (a >= thr ? 1u : 0u) << (2 * (d - 16)); mhi |= (bq_ >= thr ? 1u : 0u) << (2 * (d - 16) + 1); }
                LAS bf16_t* stage = (LAS bf16_t*)(SC + row * SCB);
                const int mycnt = __popc(mlo) + __popc(mhi); int base = wave_scan_i(mycnt) - mycnt;
                while (mlo) { const int bp = __builtin_ctz(mlo); stage[base++] = (bf16_t)(2 * (64 * (bp >> 1) + lane) + (bp & 1)); mlo &= mlo - 1u; }
                while (mhi) { const int bp = __builtin_ctz(mhi); stage[base++] = (bf16_t)(2 * (64 * ((bp >> 1) + 16) + lane) + (bp & 1)); mhi &= mhi - 1u; }
                if (!allties) {
                    int eqb = 0; const int pos0 = 256 - need;
#pragma unroll 4
                    for (int d = 0; d < 32; ++d) {
                        const bool eq0 = ((kp[d] & 0xffffu) == T16), eq1 = ((kp[d] >> 16) == T16);
                        const unsigned long long m0 = __ballot(eq0), m1 = __ballot(eq1);
                        const int below = (int)__builtin_amdgcn_mbcnt_hi((unsigned)(m0 >> 32), __builtin_amdgcn_mbcnt_lo((unsigned)m0, 0u)) + (int)__builtin_amdgcn_mbcnt_hi((unsigned)(m1 >> 32), __builtin_amdgcn_mbcnt_lo((unsigned)m1, 0u));
                        const int r0 = eqb + below, r1 = r0 + (eq0 ? 1 : 0);
                        if (eq0 && r0 < need) stage[pos0 + r0] = (bf16_t)(2 * (64 * d + lane));
                        if (eq1 && r1 < need) stage[pos0 + r1] = (bf16_t)(2 * (64 * d + lane) + 1);
                        eqb += __popcll(m0) + __popcll(m1);
                    }
                }
                asm volatile("s_waitcnt lgkmcnt(0)" ::: "memory");
                *(u32x2*)(out + 4 * lane) = *(const LAS u32x2*)(stage + 4 * lane);
            }
        }
        __syncthreads();
    }
}

__device__ __forceinline__ void p4_memattn(const Ctx& C) {
    unsigned char* ws = C.ws; const int lane = C.lane, wave = C.wave, g = lane >> 4, fr = lane & 15;
    const bf16_t* memq = (const bf16_t*)(ws + WS_MEMQ); const bf16_t* kmem = (const bf16_t*)(ws + WS_KMEM); const bf16_t* vmt = (const bf16_t*)(ws + WS_VMEMT);
    bf16_t* ymem = (bf16_t*)(ws + WS_YM) + 512;
    LAS unsigned char* KL = C.lds; LAS unsigned char* VL = C.lds + 65536;
    for (int su = blockIdx.x; su < 256; su += C.G) {
        const int bh = su >> 4, j = su & 15, b = bh >> 2, h = bh & 3;
        const char* kb = (const char*)(kmem + (size_t)(bh * 256) * 128); const char* vb = (const char*)(vmt + (size_t)(bh * 128) * 256);
#pragma unroll
        for (int pp = 0; pp < 8; ++pp) { const int p = wave + 8 * pp;
            { const int row = 4 * p + g; const int c = fr ^ (2 * (row & 7)); __builtin_amdgcn_global_load_lds((const unsigned*)(kb + row * 256 + 16 * c), (LAS unsigned*)(KL + 1024 * p), 16, 0, 0); }
            { const int row = 2 * p + (lane >> 5); const int c = (lane & 31) ^ (row & 15); __builtin_amdgcn_global_load_lds((const unsigned*)(vb + row * 512 + 16 * c), (LAS unsigned*)(VL + 1024 * p), 16, 0, 0); } }
        asm volatile("s_waitcnt vmcnt(0)" ::: "memory");
        __syncthreads();
#pragma unroll 1
        for (int u = 0; u < 2; ++u) {
            const int t0 = b * SEQ + (2 * j + u) * 128 + wave * 16;
            bf16x8 Bq[4];
#pragma unroll
            for (int kk = 0; kk < 4; ++kk) Bq[kk] = *(const bf16x8*)(memq + (size_t)(t0 + fr) * 512 + h * 128 + 32 * kk + 8 * g);
            f32x4 sc[16];
#pragma unroll
            for (int i = 0; i < 16; ++i) { if ((i & 1) == 0) __builtin_amdgcn_sched_barrier(0); f32x4 a = (f32x4){0.f, 0.f, 0.f, 0.f}; const int row = 16 * i + fr;
#pragma unroll
                for (int kk = 0; kk < 4; ++kk) { const bf16x8 A = *(const LAS bf16x8*)(KL + row * 256 + 16 * ((4 * kk + g) ^ (2 * (row & 7)))); a = __builtin_amdgcn_mfma_f32_16x16x32_bf16(A, Bq[kk], a, 0, 0, 0); }
                sc[i] = a; }
            const float scale = 0.08838834764831845f;
            float mx = -3.0e38f;
#pragma unroll
            for (int i = 0; i < 16; ++i)
#pragma unroll
                for (int r = 0; r < 4; ++r) { sc[i][r] *= scale; mx = fmaxf(mx, sc[i][r]); }
            mx = fmaxf(mx, __shfl_xor(mx, 16)); mx = fmaxf(mx, __shfl_xor(mx, 32));
            float sum = 0.f;
#pragma unroll
            for (int i = 0; i < 16; ++i)
#pragma unroll
                for (int r = 0; r < 4; ++r) { sc[i][r] = __expf(sc[i][r] - mx); sum += sc[i][r]; }
            sum += __shfl_xor(sum, 16); sum += __shfl_xor(sum, 32);
            const float inv = 1.0f / sum;
            bf16x8 Pb[8];
#pragma unroll
            for (int ks = 0; ks < 8; ++ks) { u32x4 w; w.x = pk2(sc[2 * ks][0] * inv, sc[2 * ks][1] * inv); w.y = pk2(sc[2 * ks][2] * inv, sc[2 * ks][3] * inv);
                w.z = pk2(sc[2 * ks + 1][0] * inv, sc[2 * ks + 1][1] * inv); w.w = pk2(sc[2 * ks + 1][2] * inv, sc[2 * ks + 1][3] * inv); Pb[ks] = __builtin_bit_cast(bf16x8, w); }
#pragma unroll
            for (int dt = 0; dt < 8; ++dt) {
                __builtin_amdgcn_sched_barrier(0);
                f32x4 o = (f32x4){0.f, 0.f, 0.f, 0.f}; const int row = 16 * dt + fr;
#pragma unroll
                for (int ks = 0; ks < 8; ++ks) { const int ch = 4 * ks + (g >> 1);
                    const u32x2 lo = *(const LAS u32x2*)(VL + row * 512 + 16 * (ch ^ (row & 15)) + 8 * (g & 1)), hi = *(const LAS u32x2*)(VL + row * 512 + 16 * ((ch + 2) ^ (row & 15)) + 8 * (g & 1));
                    u32x4 w; w.x = lo.x; w.y = lo.y; w.z = hi.x; w.w = hi.y;
                    o = __builtin_amdgcn_mfma_f32_16x16x32_bf16(__builtin_bit_cast(bf16x8, w), Pb[ks], o, 0, 0, 0); }
                u32x2 w; w.x = pk2(o[0], o[1]); w.y = pk2(o[2], o[3]);
                *(u32x2*)(ymem + (size_t)(t0 + fr) * 1024 + h * 128 + 16 * dt + 4 * g) = w;
            }
        }
        __syncthreads();
    }
}

constexpr int LDS_RELB = 131072 + 1024;
constexpr int LDS_LUT = LDS_RELB + 1024;
__device__ __forceinline__ void tr_read8(const unsigned (&a)[8], u32x2 (&d)[8]) {
    asm volatile("ds_read_b64_tr_b16 %0, %8\n\tds_read_b64_tr_b16 %1, %9\n\tds_read_b64_tr_b16 %2, %10\n\tds_read_b64_tr_b16 %3, %11\n\t"
                 "ds_read_b64_tr_b16 %4, %12\n\tds_read_b64_tr_b16 %5, %13\n\tds_read_b64_tr_b16 %6, %14\n\tds_read_b64_tr_b16 %7, %15\n\ts_waitcnt lgkmcnt(0)"
                 : "=&v"(d[0]), "=&v"(d[1]), "=&v"(d[2]), "=&v"(d[3]), "=&v"(d[4]), "=&v"(d[5]), "=&v"(d[6]), "=&v"(d[7])
                 : "v"(a[0]), "v"(a[1]), "v"(a[2]), "v"(a[3]), "v"(a[4]), "v"(a[5]), "v"(a[6]), "v"(a[7]) : "memory");
}
constexpr int LDS_DSAX = 131072 + 4096;
__device__ __forceinline__ void p5_dsa_attn(const Ctx& C, int qsel) {
    unsigned char* ws = C.ws; const int lane = C.lane, wave = C.wave, g = lane >> 4, fr = lane & 15;
    const bf16_t* qlat = (const bf16_t*)(ws + WS_QLAT); const bf16_t* kvl = (const bf16_t*)(ws + WS_KVL); const bf16_t* idxb = (const bf16_t*)(ws + WS_IDX);
    bf16_t* olat = (bf16_t*)(ws + WS_OLAT);
    LAS int* lut = (LAS int*)(C.lds + LDS_LUT);
    if (C.tid < 128) { const int n = C.tid; int bk = n; if (n >= 16) { bk = 16 + (int)(logf((float)n * (1.0f / 16.0f)) / 2.0794415416798357f * 16.0f); bk = bk > 31 ? 31 : bk; } lut[n] = bk; }
    __syncthreads();
    LAS unsigned char* my = C.lds + wave * 16384; const unsigned mybase = (unsigned)(uintptr_t)my;
    LAS bf16_t* IDXL = (LAS bf16_t*)(C.lds + LDS_DSAX + wave * 1024); LAS bf16_t* BKL = IDXL + 256;
    unsigned* qctr = (unsigned*)(ws + WS_CTL) + CW_DSAQ + 64 * qsel;
    const int qq = fr >> 2, p2 = fr & 3;
    bf16x8 Bbias;
    { float bv[8];
#pragma unroll
      for (int j = 0; j < 8; ++j) bv[j] = C.in[2][(8 * g + j) * 8 + (fr & 7)];
      Bbias = __builtin_bit_cast(bf16x8, pack8(bv)); }
    unsigned qkoff[2][4];
#pragma unroll
    for (int i = 0; i < 2; ++i) { const int ph = 4 * (fr & 7) + 2 * i + (fr >> 3);
#pragma unroll
        for (int kk = 0; kk < 4; ++kk) qkoff[i][kk] = (unsigned)(ph * 256 + 16 * ((4 * kk + g) ^ (2 * (ph & 7)))); }
    const int ph0 = 4 * (4 * (g & 1) + qq) + (g >> 1), ph1 = ph0 + 2;
    auto fetch_batch = [&]() -> int { int q0 = 0; if (lane == 0) q0 = (int)__hip_atomic_fetch_add(qctr, 4u, __ATOMIC_RELAXED, __HIP_MEMORY_SCOPE_AGENT); return __builtin_amdgcn_readfirstlane(q0); };
    int q = fetch_batch();
    u32x2 ixw = (u32x2){0u, 0u}; bf16x8 Bq[4];
    if (q < T) { ixw = *(const u32x2*)(idxb + (size_t)q * 256 + 4 * lane);
#pragma unroll
        for (int kk = 0; kk < 4; ++kk) Bq[kk] = *(const bf16x8*)(qlat + (size_t)q * 1024 + (fr & 7) * 128 + 32 * kk + 8 * g); }
    bool staged = false;
    while (q < T) {
        const int b = q >> 12, s = q & (SEQ - 1); const int nvalid = s + 1 < 256 ? s + 1 : 256;
        const char* kvb = (const char*)(kvl + (size_t)b * SEQ * 128);
        const int nsub = (nvalid + 31) >> 5;
#define DSA_STAGE(IXW, SS, NV, KVB) do { \
            int ix_[4] = {(int)((IXW).x & 0xffffu), (int)((IXW).x >> 16), (int)((IXW).y & 0xffffu), (int)((IXW).y >> 16)}; unsigned bk_[4]; \
            _Pragma("unroll") for (int j_ = 0; j_ < 4; ++j_) { if (4 * lane + j_ >= (NV)) ix_[j_] = 0; const int dist_ = (SS) - ix_[j_]; bk_[j_] = (unsigned)(dist_ >= 128 ? 31 : lut[dist_ < 0 ? 0 : dist_]); } \
            u32x2 wi_; wi_.x = (unsigned)ix_[0] | ((unsigned)ix_[1] << 16); wi_.y = (unsigned)ix_[2] | ((unsigned)ix_[3] << 16); *(LAS u32x2*)(IDXL + 4 * lane) = wi_; \
            u32x2 wb_; wb_.x = bk_[0] | (bk_[1] << 16); wb_.y = bk_[2] | (bk_[3] << 16); *(LAS u32x2*)(BKL + 4 * lane) = wb_; \
            asm volatile("s_waitcnt lgkmcnt(0)" ::: "memory"); \
            const u32x4 rw_ = *(const LAS u32x4*)(IDXL + 8 * g); const unsigned rws_[4] = {rw_.x, rw_.y, rw_.z, rw_.w}; \
            _Pragma("unroll") for (int p_ = 0; p_ < 8; ++p_) { const int srow_ = (int)((rws_[p_ >> 1] >> (16 * (p_ & 1))) & 0xffffu); const int c_ = fr ^ (2 * ((4 * p_ + g) & 7)); \
                __builtin_amdgcn_global_load_lds((const unsigned*)((KVB) + (size_t)srow_ * 256 + 16 * c_), (LAS unsigned*)(my + 1024 * p_), 16, 0, 0); } } while (0)
        if (!staged) { asm volatile("s_waitcnt vmcnt(0)" ::: "memory"); DSA_STAGE(ixw, s, nvalid, kvb); }
        int qn = ((q & 3) != 3) ? q + 1 : fetch_batch();
        u32x2 ixn = (u32x2){0u, 0u}; bf16x8 Bqn[4];
        if (qn < T) { ixn = *(const u32x2*)(idxb + (size_t)qn * 256 + 4 * lane);
#pragma unroll
            for (int kk = 0; kk < 4; ++kk) Bqn[kk] = *(const bf16x8*)(qlat + (size_t)qn * 1024 + (fr & 7) * 128 + 32 * kk + 8 * g); }
        else {
#pragma unroll
            for (int kk = 0; kk < 4; ++kk) Bqn[kk] = Bq[kk]; }
        float m_ref = 0.f, l_part = 0.f;
        f32x4 O[8];
#pragma unroll
        for (int cc = 0; cc < 8; ++cc) O[cc] = (f32x4){0.f, 0.f, 0.f, 0.f};
#pragma unroll
        for (int sc_ = 0; sc_ < 8; ++sc_) {
          if (sc_ < nsub) {
            LAS unsigned char* cur = my + (sc_ & 1) * 8192; const unsigned curb = mybase + (sc_ & 1) * 8192;
            if (sc_ + 1 < nsub) {
                LAS unsigned char* nb = my + ((sc_ + 1) & 1) * 8192;
                const u32x4 rw = *(const LAS u32x4*)(IDXL + 32 * (sc_ + 1) + 8 * g); const unsigned rws[4] = {rw.x, rw.y, rw.z, rw.w};
#pragma unroll
                for (int p = 0; p < 8; ++p) { const int srow = (int)((rws[p >> 1] >> (16 * (p & 1))) & 0xffffu); const int c = fr ^ (2 * ((4 * p + g) & 7));
                    __builtin_amdgcn_global_load_lds((const unsigned*)(kvb + (size_t)srow * 256 + 16 * c), (LAS unsigned*)(nb + 1024 * p), 16, 0, 0); }
                asm volatile("s_waitcnt vmcnt(8)" ::: "memory");
            } else asm volatile("s_waitcnt vmcnt(0)" ::: "memory");
            f32x4 sc[2];
#pragma unroll
            for (int i = 0; i < 2; ++i) {
                const int pos = (int)BKL[32 * sc_ + 16 * i + fr] - 8 * g;
                u32x4 oh; oh.x = (pos == 0 ? 0x3F80u : 0u) | (pos == 1 ? 0x3F800000u : 0u); oh.y = (pos == 2 ? 0x3F80u : 0u) | (pos == 3 ? 0x3F800000u : 0u);
                oh.z = (pos == 4 ? 0x3F80u : 0u) | (pos == 5 ? 0x3F800000u : 0u); oh.w = (pos == 6 ? 0x3F80u : 0u) | (pos == 7 ? 0x3F800000u : 0u);
                f32x4 a = __builtin_amdgcn_mfma_f32_16x16x32_bf16(__builtin_bit_cast(bf16x8, oh), Bbias, (f32x4){0.f, 0.f, 0.f, 0.f}, 0, 0, 0);
#pragma unroll
                for (int kk = 0; kk < 4; ++kk) a = __builtin_amdgcn_mfma_f32_16x16x32_bf16(*(const LAS bf16x8*)(cur + qkoff[i][kk]), Bq[kk], a, 0, 0, 0);
                sc[i] = a; }
            if (nvalid < 256) {
#pragma unroll
                for (int i = 0; i < 2; ++i)
#pragma unroll
                    for (int r = 0; r < 4; ++r) if (sc_ * 32 + 16 * i + 4 * g + r >= nvalid) sc[i][r] = -INFINITY;
            }
            if (sc_ == 0) { float mx = fmaxf(fmaxf(fmaxf(sc[0][0], sc[0][1]), fmaxf(sc[0][2], sc[0][3])), fmaxf(fmaxf(sc[1][0], sc[1][1]), fmaxf(sc[1][2], sc[1][3])));
                mx = fmaxf(mx, __shfl_xor(mx, 16)); mx = fmaxf(mx, __shfl_xor(mx, 32)); m_ref = mx; }
#pragma unroll
            for (int i = 0; i < 2; ++i)
#pragma unroll
                for (int r = 0; r < 4; ++r) { sc[i][r] = __expf(sc[i][r] - m_ref); l_part += sc[i][r]; }
            u32x4 w; w.x = pk2(sc[0][0], sc[0][1]); w.y = pk2(sc[0][2], sc[0][3]); w.z = pk2(sc[1][0], sc[1][1]); w.w = pk2(sc[1][2], sc[1][3]);
            const bf16x8 Pa = __builtin_bit_cast(bf16x8, w);
#pragma unroll
            for (int hf = 0; hf < 2; ++hf) {
                unsigned ad[8]; u32x2 dd[8];
#pragma unroll
                for (int c4 = 0; c4 < 4; ++c4) { const int chk = 2 * (4 * hf + c4) + (p2 >> 1);
                    ad[2 * c4] = curb + ph0 * 256 + 16 * (chk ^ (2 * (ph0 & 7))) + 8 * (p2 & 1); ad[2 * c4 + 1] = curb + ph1 * 256 + 16 * (chk ^ (2 * (ph1 & 7))) + 8 * (p2 & 1); }
                tr_read8(ad, dd);
#pragma unroll
                for (int c4 = 0; c4 < 4; ++c4) { u32x4 bw; bw.x = dd[2 * c4].x; bw.y = dd[2 * c4].y; bw.z = dd[2 * c4 + 1].x; bw.w = dd[2 * c4 + 1].y;
                    O[4 * hf + c4] = __builtin_amdgcn_mfma_f32_16x16x32_bf16(Pa, __builtin_bit_cast(bf16x8, bw), O[4 * hf + c4], 0, 0, 0); }
            }
            asm volatile("" ::: "memory");
          }
        }
        staged = false;
        if (qn < T) { const int bn = qn >> 12, sn = qn & (SEQ - 1); const int nvn = sn + 1 < 256 ? sn + 1 : 256; const char* kvbn = (const char*)(kvl + (size_t)bn * SEQ * 128);
            DSA_STAGE(ixn, sn, nvn, kvbn); staged = true; }
        float l_run = l_part; l_run += __shfl_xor(l_run, 16); l_run += __shfl_xor(l_run, 32);
        const float inv = 1.0f / l_run; float ir[4];
#pragma unroll
        for (int r = 0; r < 4; ++r) ir[r] = __shfl(inv, 4 * g + r);
        if (g < 2) {
#pragma unroll
            for (int cc = 0; cc < 8; ++cc)
#pragma unroll
                for (int r = 0; r < 4; ++r) olat[(size_t)q * 1024 + (4 * g + r) * 128 + 16 * cc + fr] = (bf16_t)f2bf(O[cc][r] * ir[r]);
        }
        q = qn; ixw = ixn;
#pragma unroll
        for (int kk = 0; kk < 4; ++kk) Bq[kk] = Bqn[kk];
    }
#undef DSA_STAGE
}

constexpr int RWM_LDS = 15872;
__device__ __forceinline__ bf16x8 frag_pack(f32x4 lo, f32x4 hi) { u32x4 w; w.x = pk2(lo.x, lo.y); w.y = pk2(lo.z, lo.w); w.z = pk2(hi.x, hi.y); w.w = pk2(hi.z, hi.w); return __builtin_bit_cast(bf16x8, w); }
__device__ __forceinline__ bf16x8 frag_pack_lo(f32x4 lo) { u32x4 w; w.x = pk2(lo.x, lo.y); w.y = pk2(lo.z, lo.w); w.z = 0u; w.w = 0u; return __builtin_bit_cast(bf16x8, w); }
struct RwIn { u32x4 e[2], k[2], a[2]; };
template <int MODE> __device__ __forceinline__ void rwm_fetch(RwIn& w, const bf16_t* pe, const bf16_t* pk, const bf16_t* pa, const bf16_t* pr, const bf16_t* pv, const bf16_t* pg, size_t t0, int h, int g, int fr) {
    const size_t rowoff = (t0 + fr) * 512 + h * 64;
#pragma unroll
    for (int k2 = 0; k2 < 2; ++k2) { const int c0 = 32 * k2 + 8 * g; w.e[k2] = *(const u32x4*)(pe + rowoff + c0); w.k[k2] = *(const u32x4*)(pk + rowoff + c0); w.a[k2] = *(const u32x4*)(pa + rowoff + c0);
        }
}
__device__ __forceinline__ void tr_read4(const unsigned (&a)[4], u32x2 (&d)[4]) {
    asm volatile("ds_read_b64_tr_b16 %0, %4\n\tds_read_b64_tr_b16 %1, %5\n\tds_read_b64_tr_b16 %2, %6\n\tds_read_b64_tr_b16 %3, %7\n\ts_waitcnt lgkmcnt(0)"
                 : "=&v"(d[0]), "=&v"(d[1]), "=&v"(d[2]), "=&v"(d[3]) : "v"(a[0]), "v"(a[1]), "v"(a[2]), "v"(a[3]) : "memory");
}
template <int O0, int O1, int O2, int O3> __device__ __forceinline__ void tr_read4_off(unsigned base, u32x2 (&d)[4]) {
    asm volatile("ds_read_b64_tr_b16 %0, %4 offset:%5\n\tds_read_b64_tr_b16 %1, %4 offset:%6\n\tds_read_b64_tr_b16 %2, %4 offset:%7\n\tds_read_b64_tr_b16 %3, %4 offset:%8\n\ts_waitcnt lgkmcnt(0)"
                 : "=&v"(d[0]), "=&v"(d[1]), "=&v"(d[2]), "=&v"(d[3]) : "v"(base), "i"(O0), "i"(O1), "i"(O2), "i"(O3) : "memory");
}
__device__ __forceinline__ bf16x8 frag_lo_raw(u32x2 lo) { u32x4 w; w.x = lo.x; w.y = lo.y; w.z = 0u; w.w = 0u; return __builtin_bit_cast(bf16x8, w); }
__device__ __forceinline__ bf16x8 frag_pack_raw(f32x4 lo, u32x2 hi) { u32x4 w; w.x = pk2(lo.x, lo.y); w.y = pk2(lo.z, lo.w); w.z = hi.x; w.w = hi.y; return __builtin_bit_cast(bf16x8, w); }
template <int MODE> __device__ __forceinline__ void rwm_task(const Ctx& C, int bh, int ch) {
    unsigned char* ws = C.ws; const int lane = C.lane, g = lane >> 4, fr = lane & 15; const int b = bh >> 3, h = bh & 7;
    const bf16_t* pr = (const bf16_t*)(ws + WS_RW_R); const bf16_t* pk = (const bf16_t*)(ws + WS_RW_K); const bf16_t* pv = (const bf16_t*)(ws + WS_RW_V);
    const bf16_t* pa = (const bf16_t*)(ws + WS_RW_A); const bf16_t* pe = (const bf16_t*)(ws + WS_RW_E); const bf16_t* pg = (const bf16_t*)(ws + WS_RW_G);
    bf16_t* yo = (bf16_t*)(ws + WS_YM);
    float* PQ = (float*)(C.dout + DO_PQ);
    LAS unsigned char* my = C.lds + C.wave * RWM_LDS; const unsigned myb = (unsigned)(uintptr_t)my;
    LAS unsigned char* SI = my; LAS unsigned char* BI = my + 9216; LAS unsigned char* KI = my + 11264; LAS float* CL = (LAS float*)(my + 13312); LAS unsigned char* VI = my + 13824;
    const gfp in16 = (gfp)C.in[16], in17 = (gfp)C.in[17], in18 = (gfp)C.in[18], in19 = (gfp)C.in[19], in20 = (gfp)C.in[20];
    const size_t tok0 = (size_t)b * SEQ + (size_t)ch * RL;
    const f32x4 Z4 = (f32x4){0.f, 0.f, 0.f, 0.f};
    const float* sbase = PQ + ((size_t)((bh * RCH + (ch > 0 ? ch - 1 : 0)) * 2)) * 4096 + fr * 64 + 4 * g;
    int gv = g; asm volatile("" : "+v"(gv));
    f32x4 S[4][4];
#pragma unroll
    for (int vt = 0; vt < 4; ++vt)
#pragma unroll
        for (int kt = 0; kt < 4; ++kt) {
            if (MODE == 1) { f32x4 x;
#pragma unroll
                for (int r = 0; r < 4; ++r) x[r] = (vt == kt && 4 * gv + r == fr) ? 1.f : 0.f;
                S[vt][kt] = x; }
            else if (MODE == 2 && ch > 0) { gfp sp = (gfp)(sbase + 1024 * vt); asm volatile("" : "+v"(sp));
                S[vt][kt] = *(const __attribute__((address_space(1))) f32x4*)(sp + 16 * kt); }
            else S[vt][kt] = Z4; }
    const bool strict[4] = {4 * g + 0 < fr, 4 * g + 1 < fr, 4 * g + 2 < fr, 4 * g + 3 < fr};
    const bool incl[4] = {4 * g + 0 <= fr, 4 * g + 1 <= fr, 4 * g + 2 <= fr, 4 * g + 3 <= fr};
    const int qq = fr >> 2, p2 = fr & 3; const unsigned trb = myb + (unsigned)((4 * g + qq) * 128 + 8 * p2);
    RwIn nxt; rwm_fetch<MODE>(nxt, pe, pk, pa, pr, pv, pg, tok0, h, g, fr);
#pragma unroll 1
    for (int sub = 0; sub < RL / 16; ++sub) {
        const size_t t0 = tok0 + (size_t)sub * 16;
        int frl = fr, gl_ = g; asm volatile("" : "+v"(frl), "+v"(gl_));
        u32x4 gq[2], rq[2], vq[2];
        { const size_t ro0 = (t0 + frl) * 512 + h * 64 + 8 * gl_;
          if (MODE == 2) { gq[0] = *(const u32x4*)(pg + ro0); gq[1] = *(const u32x4*)(pg + ro0 + 32); rq[0] = *(const u32x4*)(pr + ro0); rq[1] = *(const u32x4*)(pr + ro0 + 32); }
          if (MODE != 1) { vq[0] = *(const u32x4*)(pv + ro0); vq[1] = *(const u32x4*)(pv + ro0 + 32); } }
        const RwIn cur = nxt; rwm_fetch<MODE>(nxt, pe, pk, pa, pr, pv, pg, tok0 + (size_t)(sub + 1 < RL / 16 ? sub + 1 : sub) * 16, h, gl_, frl);
#pragma unroll
        for (int vt = 0; vt < 4; ++vt)
#pragma unroll
            for (int kt = 0; kt < 4; ++kt)
                { u32x2 w; w.x = pk2(S[vt][kt][0], S[vt][kt][1]); w.y = pk2(S[vt][kt][2], S[vt][kt][3]); *(LAS u32x2*)(SI + fr * 144 + 8 * g + vt * 2304 + 32 * kt) = w; }
        bf16x8 kap[2], rtl[2]; float bcoef = 0.f;
        {
            float ssq = 0.f, bsum = 0.f;
#pragma unroll
            for (int k2 = 0; k2 < 2; ++k2) { const int c0 = 32 * k2 + 8 * g; float kv[8]; unpack8(cur.k[k2], kv);
                const f32x4 kk0 = *(const __attribute__((address_space(1))) f32x4*)(in16 + h * 64 + c0), kk1 = *(const __attribute__((address_space(1))) f32x4*)(in16 + h * 64 + c0 + 4); const float kkc[8] = {kk0.x, kk0.y, kk0.z, kk0.w, kk1.x, kk1.y, kk1.z, kk1.w};
#pragma unroll
                for (int j = 0; j < 8; ++j) { const float x = kv[j] * kkc[j]; ssq += x * x; } }
            ssq += __shfl_xor(ssq, 16); ssq += __shfl_xor(ssq, 32);
            const float rn = __builtin_amdgcn_rsqf(fmaxf(ssq, 1e-24f));
#pragma unroll
            for (int k2 = 0; k2 < 2; ++k2) { const int c0 = 32 * k2 + 8 * g; float ev[8], kv[8], aa[8], rv[8];
                __builtin_amdgcn_sched_barrier(0);
                unpack8(cur.e[k2], ev); unpack8(cur.k[k2], kv); unpack8(cur.a[k2], aa);
                if (MODE == 2) unpack8(rq[k2], rv);
                const f32x4 ka0 = *(const __attribute__((address_space(1))) f32x4*)(in17 + h * 64 + c0), ka1 = *(const __attribute__((address_space(1))) f32x4*)(in17 + h * 64 + c0 + 4); const float kac[8] = {ka0.x, ka0.y, ka0.z, ka0.w, ka1.x, ka1.y, ka1.z, ka1.w};
                const f32x4 kk0 = *(const __attribute__((address_space(1))) f32x4*)(in16 + h * 64 + c0), kk1 = *(const __attribute__((address_space(1))) f32x4*)(in16 + h * 64 + c0 + 4); const float kkc[8] = {kk0.x, kk0.y, kk0.z, kk0.w, kk1.x, kk1.y, kk1.z, kk1.w};
                float rkc[8];
                if (MODE == 2) { const f32x4 r0 = *(const __attribute__((address_space(1))) f32x4*)(in18 + h * 64 + c0), r1 = *(const __attribute__((address_space(1))) f32x4*)(in18 + h * 64 + c0 + 4); rkc[0] = r0.x; rkc[1] = r0.y; rkc[2] = r0.z; rkc[3] = r0.w; rkc[4] = r1.x; rkc[5] = r1.y; rkc[6] = r1.z; rkc[7] = r1.w; }
                float kt_[8], bt_[8], kxt_[8], rt_[8];
#pragma unroll
                for (int j = 0; j < 8; ++j) {
                    float c = ev[j]; c += dpp_f<0x111>(c); c += dpp_f<0x112>(c); c += dpp_f<0x114>(c); c += dpp_f<0x118>(c);
                    const float kx = kv[j] * (1.0f + (aa[j] - 1.0f) * kac[j]); const float kk = kv[j] * kkc[j] * rn;
                    const float e2 = __expf(c), e3 = __builtin_amdgcn_rcpf(e2), e1 = e3 * __expf(ev[j]);
                    kt_[j] = kk * e1; bt_[j] = kk * aa[j] * e2; kxt_[j] = kx * e2;
                    if (MODE == 2) { rt_[j] = rv[j] * e3; bsum += rv[j] * kx * rkc[j]; } else rt_[j] = 0.f;
                    if (fr == 15) CL[c0 + j] = e3;
                }
                kap[k2] = __builtin_bit_cast(bf16x8, pack8(kt_)); if (MODE == 2) rtl[k2] = __builtin_bit_cast(bf16x8, pack8(rt_));
                *(LAS u32x4*)(BI + fr * 128 + 64 * k2 + 16 * g) = pack8(bt_); *(LAS u32x4*)(KI + fr * 128 + 64 * k2 + 16 * g) = pack8(kxt_);
            }
            if (MODE == 2) { bsum += __shfl_xor(bsum, 16); bsum += __shfl_xor(bsum, 32); bcoef = bsum; }
        }
        bf16x8 bet[2], kxf[2];
#pragma unroll
        for (int k2 = 0; k2 < 2; ++k2) { bet[k2] = *(const LAS bf16x8*)(BI + fr * 128 + 64 * k2 + 16 * g); kxf[k2] = *(const LAS bf16x8*)(KI + fr * 128 + 64 * k2 + 16 * g); }
        u32x2 VT[4];
        if (MODE != 1) {
#pragma unroll
            for (int k2 = 0; k2 < 2; ++k2) *(LAS u32x4*)(VI + fr * 128 + 64 * k2 + 16 * g) = vq[k2];
            tr_read4_off<13824, 13824 + 32, 13824 + 64, 13824 + 96>(trb, VT);
        } else {
#pragma unroll
            for (int vt = 0; vt < 4; ++vt) { VT[vt].x = 0u; VT[vt].y = 0u; }
        }
        f32x4 AT = Z4, BmT = Z4, C1T = Z4, C2T = Z4;
#pragma unroll
        for (int k2 = 0; k2 < 2; ++k2) { AT = __builtin_amdgcn_mfma_f32_16x16x32_bf16(bet[k2], kap[k2], AT, 0, 0, 0);
            if (MODE != 1) BmT = __builtin_amdgcn_mfma_f32_16x16x32_bf16(kxf[k2], kap[k2], BmT, 0, 0, 0);
            if (MODE == 2) { C1T = __builtin_amdgcn_mfma_f32_16x16x32_bf16(bet[k2], rtl[k2], C1T, 0, 0, 0); C2T = __builtin_amdgcn_mfma_f32_16x16x32_bf16(kxf[k2], rtl[k2], C2T, 0, 0, 0); } }
#pragma unroll
        for (int r = 0; r < 4; ++r) { AT[r] = strict[r] ? AT[r] : 0.f; BmT[r] = strict[r] ? BmT[r] : 0.f; C1T[r] = incl[r] ? C1T[r] : 0.f; C2T[r] = incl[r] ? C2T[r] : 0.f; }
        float tr[16];
        int frv = fr; asm volatile("" : "+v"(frv));
#pragma unroll
        for (int c = 15; c >= 0; --c) { float s = (c == frv) ? 1.f : 0.f;
#pragma unroll
            for (int j = c + 1; j < 16; ++j) { const float ajc = __builtin_bit_cast(float, __builtin_amdgcn_readlane(__builtin_bit_cast(int, AT[c & 3]), j + 16 * (c >> 2))); s = fmaf(-tr[j], ajc, s); }
            tr[c] = s; }
        f32x4 Tq;
#pragma unroll
        for (int jj = 0; jj < 4; ++jj) Tq[jj] = g == 0 ? tr[jj] : (g == 1 ? tr[4 + jj] : (g == 2 ? tr[8 + jj] : tr[12 + jj]));
        const bf16x8 Tf = frag_pack_lo(Tq), Bmf = frag_pack_lo(BmT), Cf = frag_pack(C1T, C2T);
        f32x4 Zt[4], Yt[4];
#pragma unroll
        for (int vt = 0; vt < 4; ++vt) {
            const int v = 16 * vt + fr;
            const bf16x8 s0 = *(const LAS bf16x8*)(SI + v * 144 + 16 * g), s1 = *(const LAS bf16x8*)(SI + v * 144 + 64 + 16 * g);
            f32x4 rhs = __builtin_amdgcn_mfma_f32_16x16x32_bf16(kap[0], s0, Z4, 0, 0, 0); rhs = __builtin_amdgcn_mfma_f32_16x16x32_bf16(kap[1], s1, rhs, 0, 0, 0);
            if (MODE != 1) rhs = __builtin_amdgcn_mfma_f32_16x16x32_bf16(Bmf, frag_lo_raw(VT[vt]), rhs, 0, 0, 0);
            f32x4 z = __builtin_amdgcn_mfma_f32_16x16x32_bf16(Tf, frag_pack_lo(rhs), Z4, 0, 0, 0);
            Zt[vt] = -z;
            if (MODE == 2) { f32x4 y = __builtin_amdgcn_mfma_f32_16x16x32_bf16(rtl[0], s0, Z4, 0, 0, 0); y = __builtin_amdgcn_mfma_f32_16x16x32_bf16(rtl[1], s1, y, 0, 0, 0);
                Yt[vt] = __builtin_amdgcn_mfma_f32_16x16x32_bf16(Cf, frag_pack_raw(Zt[vt], VT[vt]), y, 0, 0, 0); }
        }
        if (MODE == 2) {
            u32x2 GT[4];
            {
#pragma unroll
                for (int k2 = 0; k2 < 2; ++k2) *(LAS u32x4*)(VI + fr * 128 + 64 * k2 + 16 * g) = gq[k2];
                tr_read4_off<13824, 13824 + 32, 13824 + 64, 13824 + 96>(trb, GT);
            }
#pragma unroll
            for (int r = 0; r < 4; ++r) {
                const float mean = row_sum_f(Yt[0][r] + Yt[1][r] + Yt[2][r] + Yt[3][r]) * (1.0f / 64.0f);
                const float d0 = Yt[0][r] - mean, d1 = Yt[1][r] - mean, d2 = Yt[2][r] - mean, d3 = Yt[3][r] - mean;
                const float rstd = rsqrtf(row_sum_f(d0 * d0 + d1 * d1 + d2 * d2 + d3 * d3) * (1.0f / 64.0f) + 64e-5f);
                const float bc = __shfl(bcoef, 4 * g + r); const float dd_[4] = {d0, d1, d2, d3}; const size_t ro = (t0 + 4 * gl_ + r) * 1024 + h * 64 + frl;
#pragma unroll
                for (int vt = 0; vt < 4; ++vt) { const unsigned gw2 = r < 2 ? GT[vt].x : GT[vt].y, vw2 = r < 2 ? VT[vt].x : VT[vt].y; const float gate = (r & 1) ? bfhi(gw2) : bflo(gw2), vval = (r & 1) ? bfhi(vw2) : bflo(vw2);
                    yo[ro + 16 * vt] = (bf16_t)f2bf((dd_[vt] * rstd * in19[h * 64 + 16 * vt + frl] + in20[h * 64 + 16 * vt + frl] + bc * vval) * gate); }
            }
        }
        {
            u32x2 db[4], dk[4], dd[8];
            tr_read4_off<9216, 9216 + 32, 9216 + 64, 9216 + 96>(trb, db); tr_read4_off<11264, 11264 + 32, 11264 + 64, 11264 + 96>(trb, dk);
#pragma unroll
            for (int kt = 0; kt < 4; ++kt) { dd[2 * kt] = db[kt]; dd[2 * kt + 1] = dk[kt]; }
            f32x4 gl[4];
#pragma unroll
            for (int kt = 0; kt < 4; ++kt) gl[kt] = *(const LAS f32x4*)(CL + 16 * kt + 4 * g);
#pragma unroll
            for (int vt = 0; vt < 4; ++vt) { const bf16x8 Af = frag_pack_raw(Zt[vt], VT[vt]);
#pragma unroll
                for (int kt = 0; kt < 4; ++kt) { u32x4 bw; bw.x = dd[2 * kt].x; bw.y = dd[2 * kt].y; bw.z = dd[2 * kt + 1].x; bw.w = dd[2 * kt + 1].y;
                    S[vt][kt] = __builtin_amdgcn_mfma_f32_16x16x32_bf16(__builtin_bit_cast(bf16x8, bw), Af, S[vt][kt], 0, 0, 0) * gl[kt]; } }
        }
    }
    if (MODE != 2) { float* dst = PQ + ((size_t)((bh * RCH + ch) * 2 + MODE)) * 4096 + fr * 64 + 4 * g;
#pragma unroll
        for (int vt = 0; vt < 4; ++vt)
#pragma unroll
            for (int kt = 0; kt < 4; ++kt) *(f32x4*)(dst + vt * 1024 + 16 * kt) = S[vt][kt]; }
}
__device__ __forceinline__ void p4_rwkv_pass1(const Ctx& C) {
    for (int task = C.gw; task < 32 * (RCH - 1) * 2; task += C.ngw) { const int mode = task & 1, rr = task >> 1, ch = rr % (RCH - 1), bh = rr / (RCH - 1);
        if (mode == 0) rwm_task<0>(C, bh, ch); else rwm_task<1>(C, bh, ch); }
}
__device__ __forceinline__ void p6_rwkv_pass3(const Ctx& C) {
    for (int task = (int)blockIdx.x + C.G * C.wave; task < 32 * RCH; task += C.G * NWAVES) rwm_task<2>(C, task / RCH, task % RCH);
}
__device__ __forceinline__ void p5_rwkv_carry(const Ctx& C) {
    float* PQ = (float*)(C.dout + DO_PQ); const int lane = C.lane, wave = C.wave, tid = C.tid;
    LAS float* ST = (LAS float*)C.lds;
    LAS float* PL = (LAS float*)(C.lds + 32768);
    for (int bh = blockIdx.x; bh < 32; bh += C.G) {
        for (int i = tid; i < 4096; i += NTHREADS) ST[i] = 0.f;
        const float* base = PQ + (size_t)(bh * RCH) * 2 * 4096;
        f32x4 pa = *(const f32x4*)(base + 4096 + tid * 8), pb = *(const f32x4*)(base + 4096 + tid * 8 + 4);
        f32x4 q0 = *(const f32x4*)(base + lane * 64 + 8 * wave), q1 = *(const f32x4*)(base + lane * 64 + 8 * wave + 4);
        __syncthreads();
        for (int ch = 0; ch < RCH - 1; ++ch) {
            LAS float* cur = ST + (ch & 1) * 4096; LAS float* nxt = ST + ((ch + 1) & 1) * 4096;
            float* Q = PQ + ((size_t)((bh * RCH + ch) * 2)) * 4096;
            *(LAS f32x4*)(PL + tid * 8) = pa; *(LAS f32x4*)(PL + tid * 8 + 4) = pb;
            float acc[8] = {q0.x, q0.y, q0.z, q0.w, q1.x, q1.y, q1.z, q1.w};
            __syncthreads();
            const int cn = ch + 1 < RCH - 1 ? ch + 1 : ch; const float* nb = PQ + ((size_t)((bh * RCH + cn) * 2)) * 4096;
            pa = *(const f32x4*)(nb + 4096 + tid * 8); pb = *(const f32x4*)(nb + 4096 + tid * 8 + 4);
            q0 = *(const f32x4*)(nb + lane * 64 + 8 * wave); q1 = *(const f32x4*)(nb + lane * 64 + 8 * wave + 4);
#pragma unroll 8
            for (int j = 0; j < 64; ++j) { const float sj = cur[j * 64 + lane]; const f32x4 p0 = *(const LAS f32x4*)(PL + j * 64 + 8 * wave), p1 = *(const LAS f32x4*)(PL + j * 64 + 8 * wave + 4);
                acc[0] = fmaf(sj, p0.x, acc[0]); acc[1] = fmaf(sj, p0.y, acc[1]); acc[2] = fmaf(sj, p0.z, acc[2]); acc[3] = fmaf(sj, p0.w, acc[3]);
                acc[4] = fmaf(sj, p1.x, acc[4]); acc[5] = fmaf(sj, p1.y, acc[5]); acc[6] = fmaf(sj, p1.z, acc[6]); acc[7] = fmaf(sj, p1.w, acc[7]); }
            *(f32x4*)(Q + lane * 64 + 8 * wave) = (f32x4){acc[0], acc[1], acc[2], acc[3]}; *(f32x4*)(Q + lane * 64 + 8 * wave + 4) = (f32x4){acc[4], acc[5], acc[6], acc[7]};
#pragma unroll
            for (int kk = 0; kk < 8; ++kk) nxt[(8 * wave + kk) * 64 + lane] = acc[kk];
            __syncthreads();
        }
    }
}

constexpr size_t WS_X1F8 = 165 * MiB;
constexpr float X1F8_S = 16.0f;
__device__ __forceinline__ void p8_ln1(const Ctx& C) {
    const bf16_t* pre = (const bf16_t*)(C.dout + 32 * MiB); bf16_t* x1b = (bf16_t*)(C.ws + WS_X1B); unsigned char* x1f8 = C.ws + WS_X1F8; const int lane = C.lane;
    const float* gam = C.in[26]; const float* bet = C.in[27];
    for (int t = C.gw; t < T; t += C.ngw) {
        const bf16_t* p = pre + (size_t)t * 1024 + 16 * lane; float v[16];
        unpack8(*(const u32x4*)p, v); unpack8(*(const u32x4*)(p + 8), v + 8);
        float s = 0.f;
#pragma unroll
        for (int j = 0; j < 16; ++j) s += v[j];
        const float mean = wave_sum(s) * (1.0f / 1024.0f); float s2 = 0.f;
#pragma unroll
        for (int j = 0; j < 16; ++j) { v[j] -= mean; s2 += v[j] * v[j]; }
        const float rstd = rsqrtf(wave_sum(s2) * (1.0f / 1024.0f) + 1e-5f);
        float o[16];
#pragma unroll
        for (int q = 0; q < 4; ++q) { const f32x4 gm = *(const f32x4*)(gam + 16 * lane + 4 * q), bt = *(const f32x4*)(bet + 16 * lane + 4 * q);
            o[4 * q] = v[4 * q] * rstd * gm.x + bt.x; o[4 * q + 1] = v[4 * q + 1] * rstd * gm.y + bt.y; o[4 * q + 2] = v[4 * q + 2] * rstd * gm.z + bt.z; o[4 * q + 3] = v[4 * q + 3] * rstd * gm.w + bt.w; }
        *(u32x4*)(x1b + (size_t)t * 1024 + 16 * lane) = pack8(o); *(u32x4*)(x1b + (size_t)t * 1024 + 16 * lane + 8) = pack8(o + 8);
        unsigned wh[4], wl[4];
#pragma unroll
        for (int q = 0; q < 4; ++q) { const float a0 = __builtin_amdgcn_fmed3f(o[4 * q] * X1F8_S, -448.f, 448.f), a1 = __builtin_amdgcn_fmed3f(o[4 * q + 1] * X1F8_S, -448.f, 448.f), a2 = __builtin_amdgcn_fmed3f(o[4 * q + 2] * X1F8_S, -448.f, 448.f), a3 = __builtin_amdgcn_fmed3f(o[4 * q + 3] * X1F8_S, -448.f, 448.f);
            int h = 0; h = __builtin_amdgcn_cvt_pk_fp8_f32(a0, a1, h, false); h = __builtin_amdgcn_cvt_pk_fp8_f32(a2, a3, h, true);
            const f32x2 b01 = __builtin_amdgcn_cvt_pk_f32_fp8(h, false), b23 = __builtin_amdgcn_cvt_pk_f32_fp8(h, true);
            int l = 0; l = __builtin_amdgcn_cvt_pk_fp8_f32((a0 - b01.x) * X1F8_S, (a1 - b01.y) * X1F8_S, l, false); l = __builtin_amdgcn_cvt_pk_fp8_f32((a2 - b23.x) * X1F8_S, (a3 - b23.y) * X1F8_S, l, true);
            wh[q] = (unsigned)h; wl[q] = (unsigned)l; }
        *(u32x4*)(x1f8 + (size_t)t * 2048 + 16 * lane) = (u32x4){wh[0], wh[1], wh[2], wh[3]}; *(u32x4*)(x1f8 + (size_t)t * 2048 + 1024 + 16 * lane) = (u32x4){wl[0], wl[1], wl[2], wl[3]};
    }
    {
        typedef const __attribute__((address_space(1))) f32x4* g4p; gfp v = G_(C.in[31]); unsigned char* dst = C.ws + WS_VB;
        for (int i = C.gt; i < 2048 * 128; i += C.ngt) { const int ds = i & 127, r0 = (i >> 7) * 8; unsigned w[16];
#pragma unroll
            for (int r = 0; r < 8; ++r) { gfp p = v + (size_t)(r0 + r) * 1024 + 8 * ds; const f32x4 a = *(g4p)p * PEER_V_SCALE, b = *(g4p)(p + 4) * PEER_V_SCALE;
                int t0 = 0; t0 = __builtin_amdgcn_cvt_pk_fp8_f32(a.x, a.y, t0, false); t0 = __builtin_amdgcn_cvt_pk_fp8_f32(a.z, a.w, t0, true);
                int t1 = 0; t1 = __builtin_amdgcn_cvt_pk_fp8_f32(b.x, b.y, t1, false); t1 = __builtin_amdgcn_cvt_pk_fp8_f32(b.z, b.w, t1, true); w[2 * r] = (unsigned)t0; w[2 * r + 1] = (unsigned)t1; }
            unsigned char* d = dst + (size_t)ds * 131072 + (size_t)r0 * 8;
#pragma unroll
            for (int q = 0; q < 4; ++q) *(u32x4*)(d + 16 * q) = (u32x4){w[4 * q], w[4 * q + 1], w[4 * q + 2], w[4 * q + 3]}; }
    }
}

#define CE_DESC(a, b) do { const unsigned hi_ = k[a] > k[b] ? k[a] : k[b], lo_ = k[a] > k[b] ? k[b] : k[a]; k[a] = hi_; k[b] = lo_; } while (0)
__device__ __forceinline__ unsigned pop16_of8(unsigned (&k)[8], int fr) {
    CE_DESC(0, 1); CE_DESC(2, 3); CE_DESC(4, 5); CE_DESC(6, 7); CE_DESC(0, 2); CE_DESC(1, 3); CE_DESC(4, 6); CE_DESC(5, 7); CE_DESC(1, 2); CE_DESC(5, 6);
    CE_DESC(0, 4); CE_DESC(1, 5); CE_DESC(2, 6); CE_DESC(3, 7); CE_DESC(2, 4); CE_DESC(3, 5); CE_DESC(1, 2); CE_DESC(3, 4); CE_DESC(5, 6);
    unsigned res = 0u;
#pragma unroll
    for (int rd = 0; rd < 16; ++rd) {
        const unsigned m = row_max_u(k[0]); const bool mine = (k[0] == m);
#pragma unroll
        for (int j = 0; j < 7; ++j) k[j] = mine ? k[j + 1] : k[j];
        k[7] = mine ? 0u : k[7];
        res = (fr == rd) ? m : res;
    }
    return res;
}
__device__ __forceinline__ unsigned pop16_of4(unsigned (&k)[4], int fr) {
    CE_DESC(0, 1); CE_DESC(2, 3); CE_DESC(0, 2); CE_DESC(1, 3); CE_DESC(1, 2);
    unsigned res = 0u;
#pragma unroll
    for (int rd = 0; rd < 16; ++rd) {
        const unsigned m = row_max_u(k[0]); const bool mine = (k[0] == m);
        k[0] = mine ? k[1] : k[0]; k[1] = mine ? k[2] : k[1]; k[2] = mine ? k[3] : k[2]; k[3] = mine ? 0u : k[3];
        res = (fr == rd) ? m : res;
    }
    return res;
}
__device__ const unsigned char CAND_AB[64] = {
    0x00, 0x01, 0x02, 0x03, 0x04, 0x05, 0x06, 0x07, 0x08, 0x09, 0x0a, 0x0b, 0x0c, 0x0d, 0x0e, 0x0f,
    0x10, 0x11, 0x12, 0x13, 0x14, 0x15, 0x16, 0x17, 0x20, 0x21, 0x22, 0x23, 0x24, 0x30, 0x31, 0x32,
    0x33, 0x40, 0x41, 0x42, 0x50, 0x51, 0x60, 0x61, 0x70, 0x71, 0x80, 0x90, 0xa0, 0xb0, 0xc0, 0xd0,
    0xe0, 0xf0, 0xff, 0xff, 0xff, 0xff, 0xff, 0xff, 0xff, 0xff, 0xff, 0xff, 0xff, 0xff, 0xff, 0xff};
__device__ __forceinline__ void p10_peer_route(const Ctx& C) {
    unsigned char* ws = C.ws; const int lane = C.lane, g = lane >> 4, fr = lane & 15;
    const bf16_t* qp = (const bf16_t*)C.dout; const bf16_t* keys = (const bf16_t*)(ws + WS_KEYS);
    int* experts = (int*)(ws + WS_EXPERTS); float* pgates = (float*)(ws + WS_PGATES);
    const unsigned cand4 = *(const unsigned*)(CAND_AB + 4 * fr);
    LAS unsigned char* KL = C.lds;
#pragma unroll
    for (int pp = 0; pp < 8; ++pp) { const int p = C.wave + 8 * pp; const int row = 4 * p + g; const int c = fr ^ (2 * (row & 7));
        __builtin_amdgcn_global_load_lds((const unsigned*)((const char*)keys + row * 256 + 16 * c), (LAS unsigned*)(KL + 1024 * p), 16, 0, 0); }
    asm volatile("s_waitcnt vmcnt(0)" ::: "memory");
    __syncthreads();
    bf16x8 An[2][4];
    { const int t0 = (C.gw < T / 2 ? C.gw : 0) * 2;
#pragma unroll
      for (int p = 0; p < 2; ++p)
#pragma unroll
        for (int kk = 0; kk < 4; ++kk) An[p][kk] = *(const bf16x8*)(qp + (size_t)(t0 + (fr >> 3)) * 2048 + (fr & 7) * 256 + p * 128 + 32 * kk + 8 * g); }
    for (int task = C.gw; task < T / 2; task += C.ngw) {
        const int t0 = task * 2;
        unsigned sel[2][4];
        bf16x8 Ac[2][4];
#pragma unroll
        for (int p = 0; p < 2; ++p)
#pragma unroll
            for (int kk = 0; kk < 4; ++kk) Ac[p][kk] = An[p][kk];
        { const int tn = (task + C.ngw < T / 2 ? task + C.ngw : task) * 2;
#pragma unroll
          for (int p = 0; p < 2; ++p)
#pragma unroll
            for (int kk = 0; kk < 4; ++kk) An[p][kk] = *(const bf16x8*)(qp + (size_t)(tn + (fr >> 3)) * 2048 + (fr & 7) * 256 + p * 128 + 32 * kk + 8 * g); }
#pragma unroll
        for (int p = 0; p < 2; ++p) {
            bf16x8 A[4];
#pragma unroll
            for (int kk = 0; kk < 4; ++kk) A[kk] = Ac[p][kk];
            f32x4 acc[8];
#pragma unroll
            for (int i = 0; i < 8; ++i) { if ((i & 1) == 0) __builtin_amdgcn_sched_barrier(0); acc[i] = (f32x4){0.f, 0.f, 0.f, 0.f};
#pragma unroll
                for (int kk = 0; kk < 4; ++kk) { const int row = p * 128 + 16 * i + fr; const bf16x8 Bk = *(const LAS bf16x8*)(KL + row * 256 + 16 * ((4 * kk + g) ^ (2 * (row & 7))));
                    acc[i] = __builtin_amdgcn_mfma_f32_16x16x32_bf16(A[kk], Bk, acc[i], 0, 0, 0); } }
#pragma unroll
            for (int r = 0; r < 4; ++r) { __builtin_amdgcn_sched_barrier(0); unsigned k[8];
#pragma unroll
                for (int i = 0; i < 8; ++i) k[i] = (f2key(acc[i][r]) & 0xffffff80u) | (unsigned)(16 * i + fr);
                sel[p][r] = pop16_of8(k, fr); }
        }
#pragma unroll
        for (int r = 0; r < 4; ++r) {
            __builtin_amdgcn_sched_barrier(0);
            const float s1 = key2f(sel[0][r] & 0xffffff80u), s2 = key2f(sel[1][r] & 0xffffff80u);
            unsigned k[4];
#pragma unroll
            for (int j = 0; j < 4; ++j) {
                const unsigned ab = (cand4 >> (8 * j)) & 0xffu; const unsigned msk = ab == 0xffu ? 0u : 0xffffffffu;
                const float va = __builtin_bit_cast(float, __builtin_amdgcn_ds_bpermute((int)(4u * (16u * g + (ab >> 4))), __builtin_bit_cast(int, s1)));
                const float vb = __builtin_bit_cast(float, __builtin_amdgcn_ds_bpermute((int)(4u * (16u * g + (ab & 15u))), __builtin_bit_cast(int, s2)));
                k[j] = ((f2key(va + vb) & 0xffffff00u) | ab) & msk;
            }
            const unsigned top = pop16_of4(k, fr);
            const int a = (int)((top >> 4) & 15u), b = (int)(top & 15u);
            const int i1 = __builtin_amdgcn_ds_bpermute(4 * (16 * g + a), (int)(sel[0][r] & 0x7fu));
            const int i2 = __builtin_amdgcn_ds_bpermute(4 * (16 * g + b), (int)(sel[1][r] & 0x7fu));
            const float sc = key2f(top & 0xffffff00u);
            const float mx = key2f(row_max_u(top) & 0xffffff00u);
            const float ev = __expf(sc - mx); const float sm = row_sum_f(ev);
            const int row = 4 * g + r; const size_t o = (size_t)(t0 + (row >> 3)) * 128 + (row & 7) * 16 + fr;
            experts[o] = i1 * 128 + i2; pgates[o] = ev / sm;
        }
    }
}
#undef CE_DESC

__device__ __forceinline__ float gelu_erf(float x) { return 0.5f * x * (1.0f + erff(x * 0.7071067811865476f)); }
typedef __bf16 bf2_t __attribute__((ext_vector_type(2)));
__device__ __forceinline__ unsigned fp8x2_to_bf16x2(unsigned w, bool hi) { return hi ? __builtin_bit_cast(unsigned, __builtin_amdgcn_cvt_scalef32_pk_bf16_fp8(w, 1.0f, true)) : __builtin_bit_cast(unsigned, __builtin_amdgcn_cvt_scalef32_pk_bf16_fp8(w, 1.0f, false)); }
constexpr size_t WS_EC = 101 * MiB + 8 * MiB;
constexpr size_t WS_Y2 = 61 * MiB;
constexpr size_t WS_STAT = 125 * MiB;
constexpr int CW_PV = 512;
typedef _Float16 f16x2_t __attribute__((ext_vector_type(2)));
__device__ __forceinline__ unsigned h2splat(float v) { const _Float16 h = (_Float16)v; return __builtin_bit_cast(unsigned, (f16x2_t){h, h}); }
typedef int i32x8 __attribute__((ext_vector_type(8)));
constexpr int PU_NT = 4;
constexpr int CW_PU = 1536;
struct PuRows { u32x4 b[16]; u32x4 a0, a1; };
__device__ __forceinline__ void pu_load(PuRows& R, LAS const unsigned char* el, const unsigned char* ubx, const unsigned char* ap, bool arow) {
#pragma unroll
    for (int j = 0; j < 16; ++j) { const unsigned e = *(LAS const unsigned*)(el + 32 * j); R.b[j] = *(const u32x4*)(ubx + (size_t)e * 128); }
    R.a0 = (u32x4){0u, 0u, 0u, 0u}; R.a1 = (u32x4){0u, 0u, 0u, 0u};
    if (arow) { R.a0 = *(const u32x4*)ap; R.a1 = *(const u32x4*)(ap + 16); }
}
__device__ __forceinline__ void pu_compute(const PuRows& R, LAS unsigned char* wr, LAS const unsigned char* rd, float* pp, int lane) {
    const i32x8 A = (i32x8){(int)R.a0.x, (int)R.a0.y, (int)R.a0.z, (int)R.a0.w, (int)R.a1.x, (int)R.a1.y, (int)R.a1.z, (int)R.a1.w};
    float v[8];
#pragma unroll
    for (int tp = 0; tp < 4; ++tp) {
#pragma unroll
        for (int jj = 0; jj < 4; ++jj) *(LAS u32x4*)(wr + 1152 * jj) = R.b[4 * tp + jj];
#pragma unroll
        for (int u = 0; u < 2; ++u) { const u32x4 b0 = *(LAS const u32x4*)(rd + 2304 * u), b1 = *(LAS const u32x4*)(rd + 2304 * u + 16);
            const i32x8 B = (i32x8){(int)b0.x, (int)b0.y, (int)b0.z, (int)b0.w, (int)b1.x, (int)b1.y, (int)b1.z, (int)b1.w};
            const f32x4 acc = __builtin_amdgcn_mfma_scale_f32_16x16x128_f8f6f4(A, B, (f32x4){0.f, 0.f, 0.f, 0.f}, 0, 0, 0, 0, 0, 0);
            v[2 * tp + u] = fmaf(acc[1], 1.0f / X1F8_S, acc[0]); }
    }
    if (lane < 16) { *(f32x4*)pp = (f32x4){v[0], v[1], v[2], v[3]}; *(f32x4*)(pp + 4) = (f32x4){v[4], v[5], v[6], v[7]}; }
}
__device__ __forceinline__ void p11_peer_u(const Ctx& C, int rep_) {
    unsigned char* ws = C.ws; const int lane = C.lane, n = lane & 15, g = lane >> 4, rg = lane >> 3, ck = lane & 7;
    const unsigned char* ub = ws + WS_UB; const unsigned char* x1f8 = ws + WS_X1F8; const unsigned char* experts = ws + WS_EXPERTS;
    float* part = (float*)C.dout; unsigned* qv = (unsigned*)(ws + WS_CTL) + CW_PU + 32 * rep_;
    LAS unsigned char* my = C.lds + C.wave * 8192;
    LAS unsigned char* wr = my + 2048 + 144 * rg + 16 * ck; LAS const unsigned char* rd = my + 2048 + 144 * n + 32 * g;
    const bool arow = n < 2; const int x0 = (int)(xb_xcc_id() & 7u);
    for (int xo = 0; xo < 8; ++xo) {
        const int x = (x0 + xo) & 7;
        if (xo) { unsigned hd = 0; if (lane == 0) hd = __hip_atomic_load(qv + 64 * x, __ATOMIC_RELAXED, __HIP_MEMORY_SCOPE_AGENT); if ((int)__builtin_amdgcn_readfirstlane(hd) >= T) continue; }
        const unsigned char* ubx = ub + ((size_t)x << 21) + 16 * ck; const unsigned char* apx = x1f8 + (arow ? 1024 * n : 0) + 128 * x + 32 * g;
        float* ppx = part + (size_t)x * 128 + 8 * n;
        int tc, tn;
        { int a = 0; if (lane == 0) a = (int)__hip_atomic_fetch_add(qv + 64 * x, (unsigned)(2 * PU_NT), __ATOMIC_RELAXED, __HIP_MEMORY_SCOPE_AGENT); tc = __builtin_amdgcn_readfirstlane(a); tn = tc + PU_NT; }
        u32x4 s0, s1;
        if (tc < T) { s0 = *(const u32x4*)(experts + (size_t)tc * 512 + 16 * lane); s1 = *(const u32x4*)(experts + (size_t)tc * 512 + 1024 + 16 * lane); }
        while (tc < T) {
            *(LAS u32x4*)(my + 16 * lane) = s0; *(LAS u32x4*)(my + 1024 + 16 * lane) = s1;
            int a = 0; if (lane == 0) a = (int)__hip_atomic_fetch_add(qv + 64 * x, (unsigned)PU_NT, __ATOMIC_RELAXED, __HIP_MEMORY_SCOPE_AGENT);
            { const int tl = tn < T ? tn : T - PU_NT; s0 = *(const u32x4*)(experts + (size_t)tl * 512 + 16 * lane); s1 = *(const u32x4*)(experts + (size_t)tl * 512 + 1024 + 16 * lane); }
            PuRows Ra, Rb;
            pu_load(Ra, my + 4 * rg, ubx, apx + (size_t)tc * 2048, arow);
            __builtin_amdgcn_sched_barrier(0);
#pragma unroll
            for (int tt = 0; tt < PU_NT; tt += 2) {
                pu_load(Rb, my + 512 * (tt + 1) + 4 * rg, ubx, apx + (size_t)(tc + tt + 1) * 2048, arow);
                __builtin_amdgcn_sched_barrier(0);
                pu_compute(Ra, wr, rd, ppx + (size_t)(tc + tt) * 1024, lane);
                __builtin_amdgcn_sched_barrier(0);
                if (tt + 2 < PU_NT) pu_load(Ra, my + 512 * (tt + 2) + 4 * rg, ubx, apx + (size_t)(tc + tt + 2) * 2048, arow);
                __builtin_amdgcn_sched_barrier(0);
                pu_compute(Rb, wr, rd, ppx + (size_t)(tc + tt + 1) * 1024, lane);
                __builtin_amdgcn_sched_barrier(0);
            }
            tc = tn; tn = __builtin_amdgcn_readfirstlane(a);
        }
    }
}
__device__ __forceinline__ void p11_peer_combine(const Ctx& C) {
    unsigned char* ws = C.ws; const int lane = C.lane, wave = C.wave, tid = (int)threadIdx.x; const float* part = (const float*)C.dout;
    const int* experts = (const int*)(ws + WS_EXPERTS); const float* pgates = (const float*)(ws + WS_PGATES); unsigned char* ect = ws + WS_EC;
    const int p0 = 2 * lane, k0 = 16 * (p0 & 7) + (p0 >> 3), k1 = k0 + 16;
    constexpr float us = 1.0f / (PEER_U_SCALE * X1F8_S), vs = 64.0f / PEER_V_SCALE;
    LAS unsigned* tile = (LAS unsigned*)C.lds;
    for (int tg = (int)blockIdx.x; tg < T / 32; tg += C.G) {
#pragma unroll
        for (int j = 0; j < 4; ++j) {
            const int ti = 4 * wave + j, t = 32 * tg + ti;
            f32x2 s = (f32x2){0.f, 0.f};
#pragma unroll
            for (int x = 0; x < 8; ++x) s += *(const f32x2*)(part + ((size_t)t * 8 + x) * 128 + p0);
            const int e0 = experts[(size_t)t * 128 + k0], e1 = experts[(size_t)t * 128 + k1]; const float g0 = pgates[(size_t)t * 128 + k0], g1 = pgates[(size_t)t * 128 + k1];
            const unsigned c0 = (unsigned)__builtin_bit_cast(unsigned short, (_Float16)(vs * g0 * gelu_erf(s.x * us))), c1 = (unsigned)__builtin_bit_cast(unsigned short, (_Float16)(vs * g1 * gelu_erf(s.y * us)));
            tile[p0 * 33 + ti] = ((unsigned)e0 << 16) | c0; tile[(p0 + 1) * 33 + ti] = ((unsigned)e1 << 16) | c1;
        }
        __syncthreads();
        { const int p = tid >> 2, q = tid & 3; unsigned w[8];
#pragma unroll
          for (int j = 0; j < 8; ++j) w[j] = tile[p * 33 + 8 * q + j];
          unsigned char* dst = ect + (size_t)tg * 16384 + p * 128 + q * 32;
          *(u32x4*)dst = (u32x4){w[0], w[1], w[2], w[3]}; *(u32x4*)(dst + 16) = (u32x4){w[4], w[5], w[6], w[7]}; }
        __syncthreads();
    }
}
__device__ __forceinline__ void p11_peer_v(const Ctx& C, int rep_) {
    (void)rep_;
    unsigned char* ws = C.ws; const int lane = C.lane, wave = C.wave, tid = (int)threadIdx.x;
    const bf16_t* x1b = (const bf16_t*)(ws + WS_X1B); const unsigned char* vb8 = ws + WS_VB; const unsigned* ect = (const unsigned*)(ws + WS_EC); bf16_t* y2 = (bf16_t*)(ws + WS_Y2);
    const int nrep = C.G >= 128 ? C.G / 128 : 1, tper = T / nrep;
    LAS unsigned char* tab = C.lds;
    for (int u = (int)blockIdx.x; u < 128 * nrep; u += C.G) {
        const int ds = ((u & 7) << 4) | ((u >> 3) & 15), rep = u >> 7;
        {
            const unsigned char* src = vb8 + (size_t)ds * 131072 + 16 * tid;
#pragma unroll
            for (int i = 0; i < 16; ++i) *(LAS u32x4*)(tab + 8192 * i + 16 * tid) = *(const u32x4*)(src + 8192 * i);
        }
        __syncthreads();
        const int tbeg = rep * tper, ntb = tper / 64;
        for (int tbi = wave; tbi < ntb; tbi += NWAVES) {
            const int t = tbeg + 64 * tbi + lane;
            const u32x4 xr = *(const u32x4*)(x1b + (size_t)t * 1024 + 8 * ds);
            const unsigned* ep = ect + (size_t)(t >> 5) * 4096 + (t & 31);
            float acc[8];
#pragma unroll
            for (int j = 0; j < 8; ++j) acc[j] = 0.f;
#pragma unroll 1
            for (int kk = 0; kk < 128; kk += 32) {
                unsigned w[32];
#pragma unroll
                for (int k = 0; k < 32; ++k) w[k] = ep[(kk + k) * 32];
                f16x2_t h[4];
#pragma unroll
                for (int j = 0; j < 4; ++j) h[j] = (f16x2_t){(_Float16)0.f, (_Float16)0.f};
#pragma unroll
                for (int k = 0; k < 32; ++k) {
                    const u32x2 v = *(LAS const u32x2*)(tab + ((w[k] >> 13) & 0x7fff8u));
                    const _Float16 c = __builtin_bit_cast(_Float16, (unsigned short)(w[k] & 0xffffu)); const f16x2_t cc = (f16x2_t){c, c};
                    const f16x2_t v0 = __builtin_amdgcn_cvt_scalef32_pk_f16_fp8(v.x, 1.0f, false), v1 = __builtin_amdgcn_cvt_scalef32_pk_f16_fp8(v.x, 1.0f, true), v2 = __builtin_amdgcn_cvt_scalef32_pk_f16_fp8(v.y, 1.0f, false), v3 = __builtin_amdgcn_cvt_scalef32_pk_f16_fp8(v.y, 1.0f, true);
                    h[0] = __builtin_elementwise_fma(cc, v0, h[0]); h[1] = __builtin_elementwise_fma(cc, v1, h[1]); h[2] = __builtin_elementwise_fma(cc, v2, h[2]); h[3] = __builtin_elementwise_fma(cc, v3, h[3]);
                }
#pragma unroll
                for (int j = 0; j < 4; ++j) { acc[2 * j] += (float)h[j].x; acc[2 * j + 1] += (float)h[j].y; }
            }
            float xf[8]; unpack8(xr, xf);
#pragma unroll
            for (int j = 0; j < 8; ++j) acc[j] = fmaf(acc[j], 1.0f / 64.0f, ALPHA * xf[j]);
            *(u32x4*)(y2 + (size_t)t * 1024 + 8 * ds) = pack8(acc);
        }
        __syncthreads();
    }
}
__device__ __forceinline__ void p11_peer_ln2(const Ctx& C) {
    unsigned char* ws = C.ws; const int lane = C.lane; const bf16_t* y2 = (const bf16_t*)(ws + WS_Y2);
    float* out = (float*)C.dout; const float* gam = C.in[32]; const float* bet = C.in[33];
    for (int t = C.gw; t < T; t += C.ngw) {
        float o[16]; const bf16_t* yp = y2 + (size_t)t * 1024 + 16 * lane; unpack8(*(const u32x4*)yp, o); unpack8(*(const u32x4*)(yp + 8), o + 8);
        float s1 = 0.f;
#pragma unroll
        for (int j = 0; j < 16; ++j) s1 += o[j];
        const float mean = wave_sum(s1) * (1.0f / 1024.0f); float s2 = 0.f;
#pragma unroll
        for (int j = 0; j < 16; ++j) { o[j] -= mean; s2 += o[j] * o[j]; }
        const float rstd = rsqrtf(wave_sum(s2) * (1.0f / 1024.0f) + 1e-5f);
#pragma unroll
        for (int q = 0; q < 4; ++q) { const int c0 = 16 * lane + 4 * q; const f32x4 gm = *(const f32x4*)(gam + c0), bt = *(const f32x4*)(bet + c0);
            *(f32x4*)(out + (size_t)t * 1024 + c0) = (f32x4){o[4 * q] * rstd * gm.x + bt.x, o[4 * q + 1] * rstd * gm.y + bt.y, o[4 * q + 2] * rstd * gm.z + bt.z, o[4 * q + 3] * rstd * gm.w + bt.w}; }
    }
}

constexpr int LDS_BYTES = 147456;
constexpr int LDS_MISC = 131072 + 256;
constexpr int NPHASE = 17;
constexpr int CW_BAR = 4096;

__global__ void __launch_bounds__(NTHREADS, 2) hybrid_fwd(Args args) {
    extern __shared__ __attribute__((aligned(16))) unsigned char lds_raw[];
    Ctx C;
    C.lds = (LAS unsigned char*)lds_raw;
    C.tid = threadIdx.x; C.lane = C.tid & 63; C.wave = __builtin_amdgcn_readfirstlane(C.tid >> 6);
    C.G = gridDim.x; C.gw = blockIdx.x * NWAVES + C.wave; C.ngw = C.G * NWAVES; C.gt = blockIdx.x * NTHREADS + C.tid; C.ngt = C.G * NTHREADS;
    C.in = args.in; C.ws = args.ws; C.dout = (unsigned char*)args.out;
    unsigned char* ws = args.ws; const float* const* in = args.in;
    volatile LAS unsigned* MISC = (volatile LAS unsigned*)(C.lds + LDS_MISC);
    if (C.tid < 64) MISC[C.tid] = 0u;
    __syncthreads();
    XcdBarrier bar; bar.bar = (unsigned*)(ws + WS_CTL) + CW_BAR; bar.x = 0; bar.st = nullptr;
    if (MK_N_LAUNCHES == 1) bar = xcd_barrier_post((unsigned*)(ws + WS_CTL) + CW_BAR, MISC + 8);
    const int lo = args.ph_lo, hi = args.ph_hi;
#define IN(k) (lo <= (k) && (k) < hi)
#define SEAM(k) do { if (IN(k) && IN((k) + 1)) xcd_barrier(bar); } while (0)
#define REP(k) for (int rep_ = 0; rep_ < (((PROBE_MASK >> (k)) & 1) ? 2 : 1); ++rep_)
    bf16_t* xb = (bf16_t*)(C.dout + DO_XB);

    if (IN(0)) REP(0) { p0_prologue(C); } SEAM(0);
    if (IN(1)) REP(1) {
        { pg8::Gemm gm{xb, (const bf16_t*)(ws + WS_WIN), T, 2816, 1024}; pg8::StaticOrder S; S.init(T, 2816, C.G, (int)blockIdx.x);
          EpiP1 E{(float*)(ws + WS_CSMALL), (bf16_t*)(ws + WS_RCOLS), (bf16_t*)(ws + WS_MEMQ)}; pg8::gemm_phase(C.lds, gm, S, E); }
        {
          const int nfull = (T / 256) * 11 % C.G; const int c2 = ((int)blockIdx.x - nfull + C.G) % C.G;
          pg8::Gemm gm{(const bf16_t*)(ws + WS_MEMB), (const bf16_t*)(ws + WS_WMEMKV), 1024, 1024, 1024}; pg8::StaticOrder S; S.init(1024, 1024, C.G, c2);
          EpiMemKV E{(bf16_t*)(ws + WS_KMEM), (bf16_t*)(ws + WS_VMEMT)}; pg8::gemm_phase(C.lds, gm, S, E); }
    } SEAM(1);
    if (IN(2)) REP(2) { p2_prep(C); } SEAM(2);
    if (IN(3)) REP(3) {
        { pg8::Gemm gm{(const bf16_t*)(ws + WS_LORAA), (const bf16_t*)(ws + WS_WLORA), T, 1536, 256}; pg8::StaticOrder S; S.init(T, 1536, C.G, (int)blockIdx.x);
          EpiLora E{(bf16_t*)(ws + WS_RW_E), (bf16_t*)(ws + WS_RW_A), (bf16_t*)(ws + WS_RW_G), in[11], in[13]}; pg8::gemm_phase(C.lds, gm, S, E); }
        { pg8::Gemm gm{(const bf16_t*)(ws + WS_CQN), (const bf16_t*)(ws + WS_WQ), T, 1280, 256}; pg8::StaticOrder S; S.init(T, 1280, C.G, C.G - 1 - (int)blockIdx.x);
          EpiQ E{(bf16_t*)(ws + WS_QLAT), (bf16_t*)(ws + WS_QIDX)}; pg8::gemm_phase(C.lds, gm, S, E); }
    } SEAM(3);
    if (IN(4)) { REP(17) { p4_indexer(C); } REP(18) { p4_memattn(C); } __syncthreads(); REP(19) { p4_rwkv_pass1(C); } } SEAM(4);
    if (IN(5)) { p5_rwkv_carry(C); __syncthreads(); REP(5) { p5_dsa_attn(C, rep_); } } SEAM(5);
    if (IN(6)) REP(6) { p6_rwkv_pass3(C); p6_late_weights(C); } SEAM(6);
    if (IN(7)) REP(7) {
        pg8::Gemm gm{xb, (const bf16_t*)(ws + WS_WG), T, 3072, 1024}; pg8::StaticOrder S; S.init(T, 3072, C.G, (int)blockIdx.x);
        EpiGates E{(bf16_t*)(ws + WS_GATES)}; pg8::gemm_phase(C.lds, gm, S, E);
    } SEAM(7);
    if (IN(8)) REP(8) {
        pg8::GemmM gm{(const bf16_t*)(ws + WS_OLAT), (const bf16_t*)(ws + WS_YM), (const bf16_t*)(ws + WS_WOV), T, 1024}; pg8::StaticOrder S; S.init(T, 1024, C.G, (int)blockIdx.x);
        MergeHook H{(const bf16_t*)(ws + WS_GATES), (bf16_t*)C.dout}; pg8::gemm_phase_merge(C.lds, gm, S, H);
    } SEAM(8);
    if (IN(9)) REP(9) {
        pg8::Gemm gm{(const bf16_t*)C.dout, (const bf16_t*)(ws + WS_WOUT), T, 1024, 1024}; pg8::StaticOrder S; S.init(T, 1024, C.G, (int)blockIdx.x);
        EpiWout E{G_(in[0]), (bf16_t*)(C.dout + 32 * MiB)}; pg8::gemm_phase(C.lds, gm, S, E);
    } SEAM(9);
    if (IN(10)) REP(10) { p8_ln1(C); } SEAM(10);
    if (IN(11)) REP(11) {
        pg8::Gemm gm{(const bf16_t*)(ws + WS_X1B), (const bf16_t*)(ws + WS_WPEER), T, 2048, 1024}; pg8::StaticOrder S; S.init(T, 2048, C.G, (int)blockIdx.x);
        EpiPeerQ E{(bf16_t*)C.dout}; pg8::gemm_phase(C.lds, gm, S, E);
    } SEAM(11);
    if (IN(12)) REP(12) { p10_peer_route(C); } SEAM(12);
    if (IN(13)) REP(13) { p11_peer_u(C, rep_); } SEAM(13);
    if (IN(14)) { p11_peer_combine(C); } SEAM(14);
    if (IN(15)) REP(15) { p11_peer_v(C, rep_); } SEAM(15);
    if (IN(16)) { p11_peer_ln2(C); }
#undef IN
#undef SEAM
}

extern "C" void kernel_launch(void* const* d_in, const int* in_sizes, int n_in, void* d_out, int out_size, void* d_ws, size_t ws_size, hipStream_t stream) {
    static int grid = 0;
    if (grid == 0) {
        if (n_in != 34 || out_size != T * D || ws_size < WS_END) { fprintf(stderr, "kernel_launch: unexpected problem (n_in %d out %d ws %zu)\n", n_in, out_size, ws_size); grid = -1; return; }
        int dev = 0, cus = 0, per_cu = 0;
        if (hipGetDevice(&dev) != hipSuccess || hipDeviceGetAttribute(&cus, hipDeviceAttributeMultiprocessorCount, dev) != hipSuccess) { grid = -1; return; }
        if (hipFuncSetAttribute((const void*)hybrid_fwd, hipFuncAttributeMaxDynamicSharedMemorySize, LDS_BYTES) != hipSuccess) { fprintf(stderr, "kernel_launch: hipFuncSetAttribute failed\n"); grid = -1; return; }
        if (hipOccupancyMaxActiveBlocksPerMultiprocessor(&per_cu, (const void*)hybrid_fwd, NTHREADS, LDS_BYTES) != hipSuccess || per_cu < 1) { fprintf(stderr, "kernel_launch: occupancy query says %d\n", per_cu); }
        (void)hipGetLastError();
        grid = cus;
    }
    if (grid < 0) return;
    (void)hipMemsetAsync((char*)d_ws + WS_CTL, 0, 1 * MiB, stream);
    Args a{};
    for (int i = 0; i < 34; ++i) a.in[i] = (const float*)d_in[i];
    a.out = (float*)d_out; a.ws = (unsigned char*)d_ws; a.li = 0; a.pad = 0;
    if (MK_N_LAUNCHES == 1) { a.ph_lo = 0; a.ph_hi = NPHASE; hipLaunchKernelGGL(hybrid_fwd, dim3(grid), dim3(NTHREADS), LDS_BYTES, stream, a); }
    else for (int p = 0; p < NPHASE; ++p) { a.ph_lo = p; a.ph_hi = p + 1; a.li = p; hipLaunchKernelGGL(hybrid_fwd, dim3(grid), dim3(NTHREADS), LDS_BYTES, stream, a); }
}
```
